# Optimizing an MI355X kernel written in HIP

```python
import math, functools
import jax, jax.numpy as jnp
from jax import lax
import numpy as np

D_MODEL = 2048
BATCH = 4
SEQ = 4096
DEPTH = 1

GRID_W = 64
CTX_LEN = 256

DN_HEADS = 16
DN_DK = 128
DN_DV = 128
DN_QK_W = DN_HEADS * DN_DK
DN_V_W = DN_HEADS * DN_DV
DN_CONV = 5
DN_CHUNK = 64
HY_W = D_MODEL
HY_ORDER = 2
HY_CONV = 3
HY_BANDS = 16
HY_EMB = 1 + 2 * HY_BANDS
HY_HIDDEN = 64
HY_FILTER_GAIN = 0.05
HY_DECAY_TARGET = 1e-2
HY_FAST_DECAY = 0.3
HY_SLOW_DECAY = 1.5
OFF_Q = 0
OFF_K = OFF_Q + DN_QK_W
OFF_V = OFF_K + DN_QK_W
OFF_Z = OFF_V + DN_V_W
OFF_AB = OFF_Z + DN_V_W
OFF_HY = OFF_AB + 4 * DN_HEADS
OFF_GATE = OFF_HY + 3 * HY_W
PROJ_W = OFF_GATE + 2 * D_MODEL
PEER_NKEYS = 128
PEER_EXPERTS = PEER_NKEYS * PEER_NKEYS
PEER_HEADS = 8
PEER_TOPK = 16
PEER_DKEY = 256
PEER_HALF = PEER_DKEY // 2
PEER_BLOCK = 128
DEEPNORM_ALPHA = (2 * DEPTH) ** 0.25
DEEPNORM_BETA = (8 * DEPTH) ** -0.25
LN_EPS = 1e-5
RMS_EPS = 1e-6

kernel_name = 'hybrid_gdn_hyena_peer_diffusion_block'

F32 = jnp.float32


def layer_norm(x, g, b):
    xf = x.astype(F32)
    mu = jnp.mean(xf, -1, keepdims=True)
    var = jnp.mean(jnp.square(xf - mu), -1, keepdims=True)
    return ((xf - mu) * lax.rsqrt(var + LN_EPS) * g.astype(F32) + b.astype(F32)).astype(x.dtype)


def rms_norm(x, w):
    xf = x.astype(F32)
    return xf * lax.rsqrt(jnp.mean(xf * xf, -1, keepdims=True) + RMS_EPS) * w.astype(F32)


def l2_normalize(x):
    xf = x.astype(F32)
    return xf * lax.rsqrt(jnp.sum(xf * xf, -1, keepdims=True) + 1e-6)


def dwconv_centered(x, w):
    k = w.shape[0]
    pad = k // 2
    n = x.shape[-2]
    xp = jnp.pad(x, [(0, 0)] * (x.ndim - 2) + [(pad, pad), (0, 0)])
    out = xp[..., 0:n, :] * w[0]
    for j in range(1, k):
        out = out + xp[..., j:j + n, :] * w[j]
    return out


def grid_row_conv(x, w, rows):
    b, n, ch = x.shape
    return dwconv_centered(x.reshape(b, rows, GRID_W, ch), w).reshape(b, n, ch)


def delta_inputs(proj, conv, conv_w, a_log, dt_bias):
    b, n, _ = proj.shape
    qkv = jax.nn.silu(conv(proj[..., OFF_Q:OFF_Z], conv_w).astype(F32))
    q = qkv[..., :DN_QK_W].reshape(b, n, DN_HEADS, DN_DK)
    k = qkv[..., DN_QK_W:2 * DN_QK_W].reshape(b, n, DN_HEADS, DN_DK)
    v = qkv[..., 2 * DN_QK_W:].reshape(b, n, DN_HEADS, DN_DV)
    q = l2_normalize(q) * (DN_DK ** -0.5)
    k = l2_normalize(k)
    ab = proj[..., OFF_AB:OFF_HY].astype(F32).reshape(b, n, 2, 2, DN_HEADS)
    g = -jnp.exp(a_log.astype(F32)) * jax.nn.softplus(ab[..., 0, :] + dt_bias.astype(F32))
    beta = jax.nn.sigmoid(ab[..., 1, :])
    bhn = lambda t: t.transpose(0, 2, 1, 3)
    return bhn(q), bhn(k), bhn(v), g.transpose(2, 0, 3, 1), beta.transpose(2, 0, 3, 1)


def gated_delta_chunked(q, k, v, g, beta, s0):
    b, h, t, dk = q.shape
    dv = v.shape[-1]
    c = DN_CHUNK
    nc = t // c
    chunks = lambda a: a.reshape(b, h, nc, c, *a.shape[3:])
    q, k, v = chunks(q), chunks(k), chunks(v)
    g = lax.cumsum(chunks(g), axis=3)
    beta = chunks(beta)
    kb = k * beta[..., None]
    vb = v * beta[..., None]
    tril = jnp.tril(jnp.ones((c, c), dtype=bool))
    strict = jnp.tril(jnp.ones((c, c), dtype=bool), -1)
    decay = jnp.exp(jnp.where(tril, g[..., :, None] - g[..., None, :], -jnp.inf))
    m = jnp.where(strict, jnp.einsum('bhncd,bhnmd->bhncm', kb, k) * decay, 0.0)
    a_mat = m + jnp.eye(c, dtype=F32)
    rhs = jnp.concatenate([vb, kb * jnp.exp(g)[..., None]], axis=-1)
    sol = lax.linalg.triangular_solve(a_mat, rhs, left_side=True, lower=True)
    u, w = sol[..., :dv], sol[..., dv:]
    attn = jnp.einsum('bhncd,bhnmd->bhncm', q, k) * decay

    def step(s, inp):
        q_i, k_i, u_i, w_i, g_i, a_i = inp
        v_new = u_i - jnp.einsum('bhcd,bhdv->bhcv', w_i, s)
        o = jnp.einsum('bhcd,bhdv->bhcv', q_i * jnp.exp(g_i)[..., None], s) + jnp.einsum('bhcm,bhmv->bhcv', a_i, v_new)
        g_last = g_i[..., -1]
        s = s * jnp.exp(g_last)[..., None, None] + jnp.einsum('bhcd,bhcv->bhdv', k_i * jnp.exp(g_last[..., None] - g_i)[..., None], v_new)
        return s, o

    xs = tuple(jnp.moveaxis(a, 2, 0) for a in (q, k, u, w, g, attn))
    s_final, o = lax.scan(step, s0, xs)
    return jnp.moveaxis(o, 0, 2).reshape(b, h, t, dv), s_final


def bidir_delta(q, k, v, g, beta, s0_fwd, s0_bwd):
    o_f, s_f = gated_delta_chunked(q, k, v, g[0], beta[0], s0_fwd)
    flip = lambda a: jnp.flip(a, axis=2)
    o_b, s_b = gated_delta_chunked(flip(q), flip(k), flip(v), flip(g[1]), flip(beta[1]), s0_bwd)
    return o_f + flip(o_b), s_f, s_b


def hyena_filters(n, w1, b1, w2, b2, w3, b3, freq):
    t = jnp.linspace(0.0, 1.0, n, dtype=F32)
    pos = jnp.arange(n, dtype=F32)
    bands = jnp.linspace(1e-4, HY_BANDS - 1, HY_BANDS, dtype=F32)
    ang = (2.0 * math.pi / n) * pos[:, None] * bands[None, :]
    z = jnp.concatenate([t[:, None], jnp.cos(ang), -jnp.sin(ang)], axis=-1)
    fr = freq.astype(F32)
    hid = jnp.sin(fr * (z @ w1.astype(F32) + b1.astype(F32)))
    hid = jnp.sin(fr * (hid @ w2.astype(F32) + b2.astype(F32)))
    filt = (hid @ w3.astype(F32) + b3.astype(F32)).reshape(n, 2, HY_ORDER, HY_W)
    deltas = jnp.abs(jnp.linspace(math.log(HY_DECAY_TARGET) / HY_SLOW_DECAY, math.log(HY_DECAY_TARGET) / HY_FAST_DECAY, HY_W, dtype=F32))
    filt = filt * jnp.exp(-t[:, None] * deltas[None, :])[:, None, None, :]
    circ = jnp.concatenate([filt[:, 0], jnp.zeros((1, HY_ORDER, HY_W), F32), filt[:0:-1, 1]], axis=0)
    return jnp.fft.rfft(circ, axis=0)


def long_conv(u, filt_f, skip):
    n = u.shape[1]
    y = jnp.fft.irfft(jnp.fft.rfft(u, n=2 * n, axis=1) * filt_f, n=2 * n, axis=1)[:, :n]
    return y + u * skip.astype(F32)


def hyena_mix(p, conv, conv_w, filt_f, skip):
    u = conv(p, conv_w).astype(F32)
    v, x1, x2 = u[..., :HY_W], u[..., HY_W:2 * HY_W], u[..., 2 * HY_W:]
    y = x1 * long_conv(v, filt_f[:, 0], skip[0])
    return x2 * long_conv(y, filt_f[:, 1], skip[1])


def merge_branches(o_dn, proj, y_hy, norm_w, w_pa, w_ph, w_out):
    b, n, _ = proj.shape
    dt = proj.dtype
    z = proj[..., OFF_Z:OFF_AB].astype(F32).reshape(b, n, DN_HEADS, DN_DV)
    o = (rms_norm(o_dn.transpose(0, 2, 1, 3), norm_w) * jax.nn.silu(z)).reshape(b, n, DN_V_W).astype(dt)
    gates = jax.nn.sigmoid(proj[..., OFF_GATE:].astype(F32))
    merged = gates[..., :D_MODEL] * (o @ w_pa) + gates[..., D_MODEL:] * (y_hy.astype(dt) @ w_ph)
    return merged.astype(dt) @ w_out


def peer_ffn(h, wq, subkeys, u_tab, v_tab):
    b, n, d = h.shape
    t = b * n
    hf = h.reshape(t, d)
    q = (hf @ wq).astype(F32).reshape(t, PEER_HEADS, 2, PEER_HALF)
    s = jnp.einsum('thpd,hpkd->thpk', q, subkeys.astype(F32))
    top_s, top_i = lax.top_k(s, PEER_TOPK)
    cand_s = (top_s[:, :, 0, :, None] + top_s[:, :, 1, None, :]).reshape(t, PEER_HEADS, PEER_TOPK * PEER_TOPK)
    cand_i = (top_i[:, :, 0, :, None] * PEER_NKEYS + top_i[:, :, 1, None, :]).reshape(t, PEER_HEADS, PEER_TOPK * PEER_TOPK)
    best_s, best_j = lax.top_k(cand_s, PEER_TOPK)
    idx = jnp.take_along_axis(cand_i, best_j, axis=-1).reshape(t, PEER_HEADS * PEER_TOPK)
    gate = jax.nn.softmax(best_s, axis=-1).reshape(t, PEER_HEADS * PEER_TOPK)
    nb = t // PEER_BLOCK

    def block(args):
        xb, ib, gb = args
        act = jax.nn.gelu(jnp.einsum('tkd,td->tk', u_tab[ib], xb).astype(F32), approximate=False)
        return jnp.einsum('tk,tkd->td', (gb * act).astype(xb.dtype), v_tab[ib])

    y = lax.map(block, (hf.reshape(nb, PEER_BLOCK, d), idx.reshape(nb, PEER_BLOCK, -1), gate.reshape(nb, PEER_BLOCK, -1)))
    return y.reshape(b, n, d)


def setup_inputs(seed: int = 0) -> dict:
    key = jax.random.key(seed)
    ks = jax.random.split(key, 40)
    nrm = lambda k, shape, s: jax.random.normal(k, shape, F32) * s
    L = DEPTH
    dt = jnp.exp(jax.random.uniform(ks[8], (L, 2, DN_HEADS), F32, math.log(1e-3), math.log(1e-1)))
    return {
        'x': nrm(ks[0], (BATCH, SEQ, D_MODEL), 1.0),
        'c': nrm(ks[1], (BATCH, D_MODEL), 1.0),
        'ctx': nrm(ks[2], (BATCH, CTX_LEN, D_MODEL), 1.0),
        'c_ctx': nrm(ks[3], (D_MODEL,), 1.0),
        'w_ada': nrm(ks[4], (L, D_MODEL, 6 * D_MODEL), D_MODEL ** -0.5),
        'b_ada': nrm(ks[5], (L, 6 * D_MODEL), 0.02),
        'w_in': nrm(ks[6], (L, D_MODEL, PROJ_W), D_MODEL ** -0.5),
        'dn_conv_w': nrm(ks[7], (L, DN_CONV, 2 * DN_QK_W + DN_V_W), DN_CONV ** -0.5),
        'dn_a_log': jnp.log(jax.random.uniform(ks[9], (L, 2, DN_HEADS), F32, 1.0, 16.0)),
        'dn_dt_bias': dt + jnp.log(-jnp.expm1(-dt)),
        'dn_norm_w': 1.0 + nrm(ks[10], (L, DN_DV), 0.02),
        'hy_conv_w': nrm(ks[11], (L, HY_CONV, 3 * HY_W), HY_CONV ** -0.5),
        'hy_w1': nrm(ks[12], (L, HY_EMB, HY_HIDDEN), HY_EMB ** -0.5),
        'hy_b1': nrm(ks[13], (L, HY_HIDDEN), 0.02),
        'hy_w2': nrm(ks[14], (L, HY_HIDDEN, HY_HIDDEN), HY_HIDDEN ** -0.5),
        'hy_b2': nrm(ks[15], (L, HY_HIDDEN), 0.02),
        'hy_w3': nrm(ks[16], (L, HY_HIDDEN, 2 * HY_ORDER * HY_W), HY_FILTER_GAIN * HY_HIDDEN ** -0.5),
        'hy_b3': nrm(ks[17], (L, 2 * HY_ORDER * HY_W), 0.005),
        'hy_freq': 1.0 + nrm(ks[18], (L, HY_HIDDEN), 0.02),
        'hy_skip': nrm(ks[19], (L, HY_ORDER, HY_W), 0.5),
        'w_branch_dn': nrm(ks[20], (L, DN_V_W, D_MODEL), DN_V_W ** -0.5),
        'w_branch_hy': nrm(ks[21], (L, HY_W, D_MODEL), HY_W ** -0.5),
        'w_out': nrm(ks[22], (L, D_MODEL, D_MODEL), DEEPNORM_BETA * D_MODEL ** -0.5),
        'ln1_g': 1.0 + nrm(ks[23], (L, D_MODEL), 0.02),
        'ln1_b': nrm(ks[24], (L, D_MODEL), 0.02),
        'peer_wq': nrm(ks[25], (L, D_MODEL, PEER_HEADS * PEER_DKEY), D_MODEL ** -0.5),
        'peer_subkeys': nrm(ks[26], (L, PEER_HEADS, 2, PEER_NKEYS, PEER_HALF), PEER_HALF ** -0.5),
        'peer_u': nrm(ks[27], (L, PEER_EXPERTS, D_MODEL), D_MODEL ** -0.5),
        'peer_v': nrm(ks[28], (L, PEER_EXPERTS, D_MODEL), DEEPNORM_BETA),
        'ln2_g': 1.0 + nrm(ks[29], (L, D_MODEL), 0.02),
        'ln2_b': nrm(ks[30], (L, D_MODEL), 0.02),
    }


def reference(x, c, ctx, c_ctx, w_ada, b_ada, w_in, dn_conv_w, dn_a_log, dn_dt_bias, dn_norm_w, hy_conv_w, hy_w1, hy_b1, hy_w2, hy_b2, hy_w3, hy_b3, hy_freq, hy_skip, w_branch_dn, w_branch_hy, w_out, ln1_g, ln1_b, peer_wq, peer_subkeys, peer_u, peer_v, ln2_g, ln2_b):
    b, n, _ = x.shape
    rows = n // GRID_W
    n_ctx = ctx.shape[1]
    lat_conv = functools.partial(grid_row_conv, rows=rows)
    xc = ctx
    for l in range(DEPTH):
        mod = jax.nn.silu(c) @ w_ada[l] + b_ada[l]
        mod_c = jax.nn.silu(c_ctx) @ w_ada[l] + b_ada[l]
        sh1, sc1, g1, sh2, sc2, g2 = jnp.split(mod[:, None, :], 6, axis=-1)
        sh1c, sc1c, g1c, sh2c, sc2c, g2c = jnp.split(mod_c, 6)

        h = x * (1.0 + sc1) + sh1
        hc = xc * (1.0 + sc1c) + sh1c
        proj = h @ w_in[l]
        proj_c = hc @ w_in[l]

        qc, kc, vc, gc, bc = delta_inputs(proj_c, dwconv_centered, dn_conv_w[l], dn_a_log[l], dn_dt_bias[l])
        zero = jnp.zeros((b, DN_HEADS, DN_DK, DN_DV), F32)
        o_c, s_fwd, s_bwd = bidir_delta(qc, kc, vc, gc, bc, zero, zero)
        ql, kl, vl, gl, bl = delta_inputs(proj, lat_conv, dn_conv_w[l], dn_a_log[l], dn_dt_bias[l])
        o_l, _, _ = bidir_delta(ql, kl, vl, gl, bl, s_fwd, s_bwd)

        filt_l = hyena_filters(n, hy_w1[l], hy_b1[l], hy_w2[l], hy_b2[l], hy_w3[l], hy_b3[l], hy_freq[l])
        y_hy = hyena_mix(proj[..., OFF_HY:OFF_GATE], lat_conv, hy_conv_w[l], filt_l, hy_skip[l])

        mix = merge_branches(o_l, proj, y_hy, dn_norm_w[l], w_branch_dn[l], w_branch_hy[l], w_out[l])
        x_new = layer_norm(DEEPNORM_ALPHA * x + g1 * mix, ln1_g[l], ln1_b[l])

        h2 = x_new * (1.0 + sc2) + sh2
        y_peer = peer_ffn(h2, peer_wq[l], peer_subkeys[l], peer_u[l], peer_v[l])
        x_new = layer_norm(DEEPNORM_ALPHA * x_new + g2 * y_peer, ln2_g[l], ln2_b[l])

        if l < DEPTH - 1:
            filt_c = hyena_filters(n_ctx, hy_w1[l], hy_b1[l], hy_w2[l], hy_b2[l], hy_w3[l], hy_b3[l], hy_freq[l])
            y_hy_c = hyena_mix(proj_c[..., OFF_HY:OFF_GATE], dwconv_centered, hy_conv_w[l], filt_c, hy_skip[l])
            mix_c = merge_branches(o_c, proj_c, y_hy_c, dn_norm_w[l], w_branch_dn[l], w_branch_hy[l], w_out[l])
            xc = layer_norm(DEEPNORM_ALPHA * xc + g1c * mix_c, ln1_g[l], ln1_b[l])
            hc2 = xc * (1.0 + sc2c) + sh2c
            xc = layer_norm(DEEPNORM_ALPHA * xc + g2c * peer_ffn(hc2, peer_wq[l], peer_subkeys[l], peer_u[l], peer_v[l]), ln2_g[l], ln2_b[l])
        x = x_new
    return x
```

```cpp
#include <hip/hip_runtime.h>
#include <hip/hip_cooperative_groups.h>
#include <cstdio>
#include <cstdint>
namespace cg = cooperative_groups;

#ifndef DBG_MODE
#define DBG_MODE 0
#endif

namespace pg8 {
#define PG8_LAS __attribute__((address_space(3)))
typedef unsigned short bf16_t;
typedef short bf16x8 __attribute__((ext_vector_type(8)));
typedef float f32x4 __attribute__((ext_vector_type(4)));
typedef unsigned u32x4 __attribute__((ext_vector_type(4)));
constexpr int BM = 256, BK = 64, HALF = 128, HTB = HALF * BK * 2, STAGE_BYTES = 8 * HTB, NXCD = 8, WGM = 8;

__host__ __device__ __forceinline__ int lds_byte(int r, int c) { const int st = (r >> 4) * 2 + (c >> 5), rr = r & 15, cc = c & 31, ob = rr * 64 + cc * 2; return st * 1024 + (ob ^ (((ob >> 9) & 1) << 5)); }
__host__ __device__ __forceinline__ void stage_rc(int b, int& R, int& C) { const int st = b / 1024, sb = b % 1024, swz = sb ^ (((sb >> 9) & 1) << 5); R = (st >> 1) * 16 + swz / 64; C = (st & 1) * 32 + (swz % 64) / 2; }
__host__ __device__ __forceinline__ int perm32(int rho) { const int n = rho >> 4, i = rho & 15; return 8 * (i >> 2) + 4 * n + (i & 3); }

struct Unit { int pm, pn; };
struct Gemm { const bf16_t* A; const bf16_t* Bt; int M, N, K; };

struct StaticOrder {
    int nM, nN, nwg, G, c;
    __host__ __device__ void init(int M, int N, int G_, int c_) { nM = M / BM; nN = N / BM; nwg = nM * nN; G = G_; c = c_; }
    __host__ __device__ bool next(int i, Unit& u) const {
        const long L = (long)i * G + c; if (L >= nwg) return false;
        int wgid = (int)L; { const int q = nwg / NXCD, r = nwg % NXCD, xcd = wgid % NXCD, off = wgid / NXCD; wgid = (xcd < r ? xcd * (q + 1) : r * (q + 1) + (xcd - r) * q) + off; }
        const int nig = WGM * nN, gid = wgid / nig, fm = gid * WGM, gsz = (nM - fm) < WGM ? (nM - fm) : WGM;
        u.pm = fm + ((wgid % nig) % gsz); u.pn = (wgid % nig) / gsz; return true;
    }
    __device__ __forceinline__ void a_ready(const Unit&) const {}
    __device__ __forceinline__ void done(const Unit&) const {}
};

__device__ __forceinline__ unsigned cvt_pk_bf16(float lo, float hi) { unsigned r; asm volatile("v_cvt_pk_bf16_f32 %0, %1, %2" : "=v"(r) : "v"(lo), "v"(hi)); return r; }

template <class F> struct EpiGen {
    static constexpr bool PERM = true, AFTER_DRAIN = false;
    F f;
    __device__ __forceinline__ void operator()(const f32x4 (&acc)[2][2][4][2], const Unit& u, int wr, int wc, int fr, int fq) const {
        const int row0 = u.pm * BM + wr * 64 + fr, col0 = u.pn * BM + wc * 32 + 8 * fq;
#pragma unroll
        for (int ai = 0; ai < 2; ++ai)
#pragma unroll
            for (int m = 0; m < 4; ++m)
#pragma unroll
                for (int bj = 0; bj < 2; ++bj) f(row0 + ai * HALF + m * 16, col0 + bj * HALF, acc[ai][bj][m][0], acc[ai][bj][m][1]);
    }
};

template <class Epi, class Sched>
__device__ __forceinline__ void gemm_phase(PG8_LAS unsigned char* lds, const Gemm g, const Sched& S, const Epi& E) {
    const int tid = threadIdx.x, wid = __builtin_amdgcn_readfirstlane(tid >> 6), lane = tid & 63, wr = wid >> 2, wc = wid & 3, fr = lane & 15, fq = lane >> 4;
    const int K = g.K, nt = K / BK;
    unsigned voffA[2], voffB[2];
#pragma unroll
    for (int i = 0; i < 2; ++i) { int R, C; stage_rc(tid * 16 + i * 8192, R, C); const int Rb = Epi::PERM ? ((R & ~31) + perm32(R & 31)) : R;
        voffA[i] = (unsigned)(R * K + C) * 2u; voffB[i] = (unsigned)(Rb * K + C) * 2u; }
    const size_t kstep = (size_t)(BK * 2);
    const size_t hstep = (size_t)HALF * K * 2;
    const size_t tstep = 2 * hstep;
    const unsigned ldsw = (unsigned)wid * 1024u;
    const int aoff = lds_byte(wr * 64 + fr, fq * 8), boff = lds_byte(wc * 32 + fr, fq * 8);
#define PG8_SA(b, h) (((b) * 2 + (h)) * HTB)
#define PG8_SB(b, h) ((4 + (b) * 2 + (h)) * HTB)
#define PG8_STAGE(bufoff, gbase, voff) do { _Pragma("unroll") for (int _i = 0; _i < 2; ++_i) \
        __builtin_amdgcn_global_load_lds((const unsigned*)((const char*)(gbase) + (voff)[_i]), (PG8_LAS unsigned*)(lds + (bufoff) + ldsw + _i * 8192), 16, 0, 0); } while (0)
#define PG8_LDA(dst, b, h) do { _Pragma("unroll") for (int m = 0; m < 4; ++m) _Pragma("unroll") for (int k = 0; k < 2; ++k) dst[m][k] = *(const PG8_LAS bf16x8*)(lds + PG8_SA(b, h) + aoff + m * 2048 + k * 1024); } while (0)
#define PG8_LDB(dst, b, h) do { _Pragma("unroll") for (int n = 0; n < 2; ++n) _Pragma("unroll") for (int k = 0; k < 2; ++k) dst[n][k] = *(const PG8_LAS bf16x8*)(lds + PG8_SB(b, h) + boff + n * 2048 + k * 1024); } while (0)
#define PG8_MMA(ai, bj, At, Bt) do { __builtin_amdgcn_s_setprio(1); _Pragma("unroll") for (int m = 0; m < 4; ++m) _Pragma("unroll") for (int n = 0; n < 2; ++n) _Pragma("unroll") for (int k = 0; k < 2; ++k) \
        acc[ai][bj][m][n] = __builtin_amdgcn_mfma_f32_16x16x32_bf16(Bt[n][k], At[m][k], acc[ai][bj][m][n], 0, 0, 0); __builtin_amdgcn_s_setprio(0); } while (0)
#define PG8_WAIT_V(n) asm volatile("s_waitcnt vmcnt(" #n ")" ::: "memory")
#define PG8_WAIT_L(n) asm volatile("s_waitcnt lgkmcnt(" #n ")" ::: "memory")
#define PG8_BAR __builtin_amdgcn_s_barrier()
#define PG8_SCHED __builtin_amdgcn_sched_barrier(0)
    Unit cur, nxt; int ui = 0;
    if (!S.next(0, cur)) return;
    f32x4 acc[2][2][4][2];
#pragma unroll
    for (int a = 0; a < 2; ++a)
#pragma unroll
        for (int b = 0; b < 2; ++b)
#pragma unroll
            for (int m = 0; m < 4; ++m)
#pragma unroll
                for (int n = 0; n < 2; ++n) acc[a][b][m][n] = (f32x4){0.f, 0.f, 0.f, 0.f};
    bf16x8 At[4][2], B0[2][2], B1[2][2];
    const char* cA = (const char*)g.A + (size_t)cur.pm * tstep; const char* cB = (const char*)g.Bt + (size_t)cur.pn * tstep;
    S.a_ready(cur);
    PG8_STAGE(PG8_SB(0, 0), cB, voffB); PG8_STAGE(PG8_SA(0, 0), cA, voffA); PG8_STAGE(PG8_SB(0, 1), cB + hstep, voffB); PG8_STAGE(PG8_SA(0, 1), cA + hstep, voffA);
    if (wr == 1) PG8_BAR;
    PG8_WAIT_V(4); PG8_BAR;
    PG8_STAGE(PG8_SB(1, 0), cB + kstep, voffB); PG8_STAGE(PG8_SA(1, 0), cA + kstep, voffA); PG8_STAGE(PG8_SB(1, 1), cB + hstep + kstep, voffB);
    PG8_WAIT_V(6); PG8_BAR;
    for (;;) {
        const bool has_next = S.next(ui + 1, nxt);
        const char* nA = has_next ? (const char*)g.A + (size_t)nxt.pm * tstep : cA; const char* nB = has_next ? (const char*)g.Bt + (size_t)nxt.pn * tstep : cB;
        for (int t = 0; t < nt; t += 2) {
            const bool last = (t == nt - 2);
            const char* a1 = cA + (size_t)(t + 1) * kstep;
            const char* a2 = last ? nA : cA + (size_t)(t + 2) * kstep; const char* b2 = last ? nB : cB + (size_t)(t + 2) * kstep;
            const char* a3 = a2 + kstep; const char* b3 = b2 + kstep;
            if (last && has_next) S.a_ready(nxt);
            PG8_LDB(B0, 0, 0); PG8_SCHED; PG8_LDA(At, 0, 0); PG8_STAGE(PG8_SA(1, 1), a1 + hstep, voffA);
            PG8_WAIT_L(8); PG8_BAR; PG8_WAIT_L(0); PG8_MMA(0, 0, At, B0); PG8_BAR; PG8_SCHED;
            PG8_LDB(B1, 0, 1); PG8_STAGE(PG8_SB(0, 0), b2, voffB);
            PG8_BAR; PG8_WAIT_L(0); PG8_MMA(0, 1, At, B1); PG8_BAR;
            PG8_LDA(At, 0, 1); PG8_STAGE(PG8_SA(0, 0), a2, voffA);
            PG8_BAR; PG8_WAIT_L(0); PG8_MMA(1, 0, At, B0); PG8_BAR; PG8_SCHED;
            PG8_STAGE(PG8_SB(0, 1), b2 + hstep, voffB);
            PG8_WAIT_V(6); PG8_BAR; PG8_MMA(1, 1, At, B1); PG8_BAR;
            PG8_LDB(B0, 1, 0); PG8_SCHED; PG8_LDA(At, 1, 0); PG8_STAGE(PG8_SA(0, 1), a2 + hstep, voffA);
            PG8_WAIT_L(8); PG8_BAR; PG8_WAIT_L(0); PG8_MMA(0, 0, At, B0); PG8_BAR; PG8_SCHED;
            PG8_LDB(B1, 1, 1); PG8_STAGE(PG8_SB(1, 0), b3, voffB);
            PG8_BAR; PG8_WAIT_L(0); PG8_MMA(0, 1, At, B1); PG8_BAR;
            PG8_LDA(At, 1, 1); PG8_STAGE(PG8_SA(1, 0), a3, voffA);
            PG8_BAR; PG8_WAIT_L(0); PG8_MMA(1, 0, At, B0); PG8_BAR; PG8_SCHED;
            PG8_STAGE(PG8_SB(1, 1), b3 + hstep, voffB);
            PG8_WAIT_V(6); PG8_BAR; PG8_MMA(1, 1, At, B1); PG8_BAR;
        }
        E(acc, cur, wr, wc, fr, fq); S.done(cur);
        if (!has_next) break;
#pragma unroll
        for (int a = 0; a < 2; ++a)
#pragma unroll
            for (int b = 0; b < 2; ++b)
#pragma unroll
                for (int m = 0; m < 4; ++m)
#pragma unroll
                    for (int n = 0; n < 2; ++n) acc[a][b][m][n] = (f32x4){0.f, 0.f, 0.f, 0.f};
        cur = nxt; cA = nA; cB = nB; ++ui;
    }
    PG8_WAIT_V(0);
    if (wr == 0) PG8_BAR;
    PG8_BAR;
#undef PG8_SA
#undef PG8_SB
#undef PG8_STAGE
#undef PG8_LDA
#undef PG8_LDB
#undef PG8_MMA
#undef PG8_WAIT_V
#undef PG8_WAIT_L
#undef PG8_BAR
#undef PG8_SCHED
}
}

typedef unsigned short bf16_t;
typedef float f32x4 __attribute__((ext_vector_type(4)));
typedef unsigned u32x4 __attribute__((ext_vector_type(4)));
#define LAS __attribute__((address_space(3)))

constexpr int NT = 512;
constexpr int LDS_BYTES = 160 * 1024;
constexpr int D = 2048, NB = 4, SEQ = 4096, CTXL = 256;
constexpr int MT = NB * SEQ;
constexpr int MC = NB * CTXL;
constexpr int MA = MT + MC;
constexpr int NQKVP = 6400;
constexpr int PQ_LD = 6144;
constexpr int NHY = 6144, NZG = 6144;
constexpr int WT_ROWS = NQKVP + NHY + NZG;
constexpr int WT_HY0 = NQKVP, WT_ZG0 = NQKVP + NHY;
constexpr float ALPHA = 1.189207115002721f;

constexpr size_t MiB = (size_t)1 << 20;
constexpr size_t WS_MOD = 0, WS_HID2 = 1 * MiB, WS_SW = 2 * MiB, WS_HA = 34 * MiB, WS_WT = 102 * MiB, WS_RA = 175 * MiB, WS_RB = 367 * MiB, WS_AB = 580 * MiB, WS_END = 585 * MiB;

struct Args { const float* in[31]; float* out; unsigned char* ws; int ph_lo, ph_hi; };
typedef const __attribute__((address_space(4))) Args* KA;

__device__ __forceinline__ unsigned f2bf(float f) { unsigned u = __float_as_uint(f); return (u + 0x7fffu + ((u >> 16) & 1u)) >> 16; }
__device__ __forceinline__ unsigned pk2(float lo, float hi) { return f2bf(lo) | (f2bf(hi) << 16); }
__device__ __forceinline__ float bflo(unsigned w) { return __uint_as_float(w << 16); }
__device__ __forceinline__ float bfhi(unsigned w) { return __uint_as_float(w & 0xffff0000u); }
__device__ __forceinline__ float bf2f(bf16_t b) { return __uint_as_float(((unsigned)b) << 16); }
__device__ __forceinline__ void unpack8(const u32x4 w, float (&o)[8]) { o[0] = bflo(w.x); o[1] = bfhi(w.x); o[2] = bflo(w.y); o[3] = bfhi(w.y); o[4] = bflo(w.z); o[5] = bfhi(w.z); o[6] = bflo(w.w); o[7] = bfhi(w.w); }
__device__ __forceinline__ u32x4 pack8(const float (&v)[8]) { u32x4 w; w.x = pk2(v[0], v[1]); w.y = pk2(v[2], v[3]); w.z = pk2(v[4], v[5]); w.w = pk2(v[6], v[7]); return w; }
__device__ __forceinline__ float sigmoidf_(float x) { return 1.0f / (1.0f + expf(-x)); }
__device__ __forceinline__ float siluf_(float x) { return x / (1.0f + expf(-x)); }
__device__ __forceinline__ float wave_sum(float v) {
#pragma unroll
    for (int o = 32; o > 0; o >>= 1) v += __shfl_xor(v, o, 64);
    return v;
}
__device__ __forceinline__ float wave_max(float v) {
#pragma unroll
    for (int o = 32; o > 0; o >>= 1) v = fmaxf(v, __shfl_xor(v, o, 64));
    return v;
}

__device__ void p0_mod_hid2(KA a, float* lf) {
    const int tid = threadIdx.x, bid = blockIdx.x;
    if (bid < 192) {
        const float* c = a->in[1]; const float* cc = a->in[3]; const float* w_ada = a->in[4]; const float* b_ada = a->in[5];
        float* mod = (float*)(a->ws + WS_MOD);
        for (int i = tid; i < 5 * 2048; i += NT) { const int r = i >> 11, k = i & 2047; const float v = (r < 4) ? c[r * 2048 + k] : cc[k]; lf[i] = siluf_(v); }
        __syncthreads();
        const int cl = tid & 63, kg = tid >> 6, col = bid * 64 + cl;
        float a0 = 0.f, a1 = 0.f, a2 = 0.f, a3 = 0.f, a4 = 0.f;
#pragma unroll 8
        for (int k = kg * 256; k < kg * 256 + 256; ++k) {
            const float w = w_ada[(size_t)k * 12288 + col];
            a0 += lf[k] * w; a1 += lf[2048 + k] * w; a2 += lf[4096 + k] * w; a3 += lf[6144 + k] * w; a4 += lf[8192 + k] * w;
        }
        float* red = lf + 5 * 2048;
        red[(kg * 5 + 0) * 64 + cl] = a0; red[(kg * 5 + 1) * 64 + cl] = a1; red[(kg * 5 + 2) * 64 + cl] = a2; red[(kg * 5 + 3) * 64 + cl] = a3; red[(kg * 5 + 4) * 64 + cl] = a4;
        __syncthreads();
        if (tid < 320) { const int r = tid >> 6; float s = 0.f;
#pragma unroll
            for (int g = 0; g < 8; ++g) s += red[(g * 5 + r) * 64 + cl];
            mod[r * 12288 + col] = s + b_ada[col]; }
        __syncthreads();
    } else {
        const float* w1 = a->in[12]; const float* b1 = a->in[13]; const float* w2 = a->in[14]; const float* b2 = a->in[15]; const float* freq = a->in[18];
        float* hid2 = (float*)(a->ws + WS_HID2);
        const int pb = (bid - 192) * 64, j = tid & 63, pl = tid >> 6;
        const float fj = freq[j];
        for (int it = 0; it < 8; ++it) {
            const int pos = pb + it * 8 + pl;
            const float tt = (float)pos * (1.0f / 4095.0f);
            float s1 = tt * w1[j];
            const float base = (6.283185307179586f / 4096.0f) * (float)pos;
            for (int e = 0; e < 16; ++e) {
                const float band = 1e-4f + (float)e * ((15.0f - 1e-4f) / 15.0f);
                const float ang = base * band;
                s1 += cosf(ang) * w1[(1 + e) * 64 + j] - sinf(ang) * w1[(17 + e) * 64 + j];
            }
            lf[pl * 64 + j] = sinf(fj * (s1 + b1[j]));
            __syncthreads();
            float s2 = 0.f;
            for (int i = 0; i < 64; ++i) s2 += lf[pl * 64 + i] * w2[i * 64 + j];
            hid2[pos * 64 + j] = sinf(fj * (s2 + b2[j]));
            __syncthreads();
        }
    }
}

__device__ void transpose_unit(const float* src, int ldn, int n0src, bf16_t* dst, int nb, int kb, float* tile) {
    const int tid = threadIdx.x, r = tid >> 4, c4 = tid & 15;
#pragma unroll
    for (int i = 0; i < 4; ++i) {
        const int kk = i * 32 + r;
        f32x4 v = (f32x4){0.f, 0.f, 0.f, 0.f};
        if (n0src >= 0) v = *(const f32x4*)(src + (size_t)(kb * 128 + kk) * ldn + n0src + c4 * 4);
        float* t = tile + kk * 65 + c4 * 4; t[0] = v.x; t[1] = v.y; t[2] = v.z; t[3] = v.w;
    }
    __syncthreads();
#pragma unroll
    for (int i = 0; i < 2; ++i) {
        const int chunk = tid + i * NT, nr = chunk >> 4, kc = chunk & 15;
        const float* t = tile + (kc * 8) * 65 + nr;
        u32x4 w; w.x = pk2(t[0], t[65]); w.y = pk2(t[130], t[195]); w.z = pk2(t[260], t[325]); w.w = pk2(t[390], t[455]);
        *(u32x4*)(dst + (size_t)(nb * 64 + nr) * 2048 + kb * 128 + kc * 8) = w;
    }
    __syncthreads();
}
__device__ __forceinline__ int win_colmap(int np) {
    if (np < 6144) return np;
    if (np < 6208) return 8192 + (np - 6144);
    if (np < 6400) return -1;
    if (np < 12544) return 8256 + (np - 6400);
    if (np < 14592) return 6144 + (np - 12544);
    return 14400 + (np - 14592);
}
__device__ void p0_transposes(KA a, float* lf) {
    bf16_t* WT = (bf16_t*)(a->ws + WS_WT); bf16_t* SW = (bf16_t*)(a->ws + WS_SW);
    const int NU_WT = (WT_ROWS / 64) * 16, NU_SW = 4 * 32 * 16;
    for (int u = blockIdx.x; u < NU_WT + NU_SW; u += gridDim.x) {
        if (u < NU_WT) { const int nb = u >> 4, kb = u & 15; transpose_unit(a->in[6], 18496, win_colmap(nb * 64), WT, nb, kb, lf); }
        else { const int v = u - NU_WT, mtx = v >> 9, nb = (v >> 4) & 31, kb = v & 15;
            const float* src = (mtx == 0) ? a->in[20] : (mtx == 1) ? a->in[21] : (mtx == 2) ? a->in[22] : a->in[25];
            transpose_unit(src, 2048, nb * 64, SW + (size_t)mtx * 2048 * 2048, nb, kb, lf); }
    }
}

__device__ void p1_ha(KA a) {
    const float* mod = (const float*)(a->ws + WS_MOD); bf16_t* HA = (bf16_t*)(a->ws + WS_HA);
    const size_t nthr = (size_t)gridDim.x * NT;
    for (size_t i = (size_t)blockIdx.x * NT + threadIdx.x; i < (size_t)MA * 256; i += nthr) {
        const int row = (int)(i >> 8), k8 = (int)(i & 255) * 8;
        const float* sp; int mr;
        if (row < MT) { sp = a->in[0] + (size_t)row * 2048 + k8; mr = row >> 12; } else { sp = a->in[2] + (size_t)(row - MT) * 2048 + k8; mr = 4; }
        const f32x4 x0 = *(const f32x4*)sp, x1 = *(const f32x4*)(sp + 4);
        const float* mp = mod + mr * 12288 + k8;
        const f32x4 h0 = *(const f32x4*)mp, h1 = *(const f32x4*)(mp + 4), s0 = *(const f32x4*)(mp + 2048), s1 = *(const f32x4*)(mp + 2052);
        float v[8];
#pragma unroll
        for (int e = 0; e < 4; ++e) { v[e] = x0[e] * (1.0f + s0[e]) + h0[e]; v[4 + e] = x1[e] * (1.0f + s1[e]) + h1[e]; }
        *(u32x4*)(HA + (size_t)row * 2048 + k8) = pack8(v);
    }
}

struct FStoreBf16 { bf16_t* O; int ldc;
    __device__ __forceinline__ void operator()(int row, int col, const f32x4 v0, const f32x4 v1) const {
        u32x4 w; w.x = pg8::cvt_pk_bf16(v0[0], v0[1]); w.y = pg8::cvt_pk_bf16(v0[2], v0[3]); w.z = pg8::cvt_pk_bf16(v1[0], v1[1]); w.w = pg8::cvt_pk_bf16(v1[2], v1[3]);
        *(u32x4*)(O + (size_t)row * ldc + col) = w; } };
struct FStoreQKV { bf16_t* PQ; float* AB;
    __device__ __forceinline__ void operator()(int row, int col, const f32x4 v0, const f32x4 v1) const {
        if (col < 6144) { u32x4 w; w.x = pg8::cvt_pk_bf16(v0[0], v0[1]); w.y = pg8::cvt_pk_bf16(v0[2], v0[3]); w.z = pg8::cvt_pk_bf16(v1[0], v1[1]); w.w = pg8::cvt_pk_bf16(v1[2], v1[3]);
            *(u32x4*)(PQ + (size_t)row * PQ_LD + col) = w; }
        else if (col < 6208) { float* p = AB + (size_t)row * 64 + (col - 6144); *(f32x4*)p = v0; *(f32x4*)(p + 4) = v1; } } };
struct FStoreF32 { float* O; int ldc;
    __device__ __forceinline__ void operator()(int row, int col, const f32x4 v0, const f32x4 v1) const { float* p = O + (size_t)row * ldc + col; *(f32x4*)p = v0; *(f32x4*)(p + 4) = v1; } };
struct FGatePA { const bf16_t* ZG; bf16_t* MG;
    __device__ __forceinline__ void operator()(int row, int col, const f32x4 v0, const f32x4 v1) const {
        float g[8]; unpack8(*(const u32x4*)(ZG + (size_t)row * NZG + 2048 + col), g);
        float o[8];
#pragma unroll
        for (int e = 0; e < 4; ++e) { o[e] = sigmoidf_(g[e]) * v0[e]; o[4 + e] = sigmoidf_(g[4 + e]) * v1[e]; }
        *(u32x4*)(MG + (size_t)row * 2048 + col) = pack8(o); } };
struct FGatePH { const bf16_t* ZG; bf16_t* MG;
    __device__ __forceinline__ void operator()(int row, int col, const f32x4 v0, const f32x4 v1) const {
        float g[8], t[8]; unpack8(*(const u32x4*)(ZG + (size_t)row * NZG + 4096 + col), g); unpack8(*(const u32x4*)(MG + (size_t)row * 2048 + col), t);
        float o[8];
#pragma unroll
        for (int e = 0; e < 4; ++e) { o[e] = t[e] + sigmoidf_(g[e]) * v0[e]; o[4 + e] = t[4 + e] + sigmoidf_(g[4 + e]) * v1[e]; }
        *(u32x4*)(MG + (size_t)row * 2048 + col) = pack8(o); } };
struct FOut { const float* x; const float* mod; float* T3;
    __device__ __forceinline__ void operator()(int row, int col, const f32x4 v0, const f32x4 v1) const {
        const float* xp = x + (size_t)row * 2048 + col; const float* gp = mod + (row >> 12) * 12288 + 4096 + col;
        const f32x4 x0 = *(const f32x4*)xp, x1 = *(const f32x4*)(xp + 4), g0 = *(const f32x4*)gp, g1 = *(const f32x4*)(gp + 4);
        float* p = T3 + (size_t)row * 2048 + col;
#if DBG_MODE == 1
        *(f32x4*)p = ALPHA * x0; *(f32x4*)(p + 4) = ALPHA * x1;
#else
        *(f32x4*)p = ALPHA * x0 + g0 * v0; *(f32x4*)(p + 4) = ALPHA * x1 + g1 * v1;
#endif
    } };

template <class F> __device__ __forceinline__ void run_gemm(unsigned char* lds, const bf16_t* A, const bf16_t* Bt, int M, int N, const F& f) {
    pg8::Gemm g{A, Bt, M, N, 2048}; pg8::StaticOrder S; S.init(M, N, (int)gridDim.x, (int)blockIdx.x);
    pg8::EpiGen<F> E{f};
    pg8::gemm_phase<pg8::EpiGen<F>, pg8::StaticOrder>((PG8_LAS unsigned char*)lds, g, S, E);
}

__device__ __forceinline__ void conv3_load8(const bf16_t* rowp, int s0, float w0, float w1, float w2, float (&o)[8]) {
    float p[8]; unpack8(*(const u32x4*)(rowp + s0), p);
    const float prev = (s0 & 63) ? bf2f(rowp[s0 - 1]) : 0.0f;
    const float next = ((s0 + 8) & 63) ? bf2f(rowp[s0 + 8]) : 0.0f;
#pragma unroll
    for (int e = 0; e < 8; ++e) { const float l = (e == 0) ? prev : p[e > 0 ? e - 1 : 0]; const float r = (e == 7) ? next : p[e < 7 ? e + 1 : 7]; o[e] = w0 * l + w1 * p[e] + w2 * r; }
}
__device__ __forceinline__ void longconv(const float* H, const float* U, int tid, float (&acc)[8][4]) {
#pragma unroll
    for (int j = 0; j < 8; ++j) { acc[j][0] = 0.f; acc[j][1] = 0.f; acc[j][2] = 0.f; acc[j][3] = 0.f; }
    const float* Hb = H + 8 * (511 + tid);
#pragma unroll 1
    for (int s0 = 0; s0 < 4096; s0 += 8) {
        const f32x4* hp = (const f32x4*)(Hb - s0);
        const f32x4 h0 = hp[0], h1 = hp[1], h2 = hp[2], h3 = hp[3];
        const float w[16] = {h0.x, h0.y, h0.z, h0.w, h1.x, h1.y, h1.z, h1.w, h2.x, h2.y, h2.z, h2.w, h3.x, h3.y, h3.z, h3.w};
#pragma unroll
        for (int e = 0; e < 8; ++e) {
            const f32x4 u = *(const f32x4*)(U + (s0 + e) * 4);
#pragma unroll
            for (int j = 0; j < 8; ++j) { const float hv = w[7 - e + j]; acc[j][0] += hv * u.x; acc[j][1] += hv * u.y; acc[j][2] += hv * u.z; acc[j][3] += hv * u.w; }
        }
    }
}
__device__ void hyena_item(KA a, int c, float* lf) {
    float* H1 = lf; float* H2 = lf + 8192; float* U = lf + 16384; float* W3 = lf + 32768;
    const int tid = threadIdx.x;
    const float* hid2 = (const float*)(a->ws + WS_HID2);
    const float* w3 = a->in[16]; const float* b3 = a->in[17]; const float* cw = a->in[11]; const float* skip = a->in[19];
    const bf16_t* PHT = (const bf16_t*)(a->ws + WS_RA);
    bf16_t* YT = (bf16_t*)a->out;
    if (tid < 256) { const int q = tid >> 6, j = tid & 63; W3[q * 64 + j] = w3[(size_t)j * 8192 + (q >> 1) * 4096 + (q & 1) * 2048 + c]; }
    if (tid == 0) { H1[8191] = 0.f; H2[8191] = 0.f; }
    __syncthreads();
    {
        const float delta = 3.0701134573253944f + 12.280453829301578f * ((float)c * (1.0f / 2047.0f));
        float bq[4];
#pragma unroll
        for (int q = 0; q < 4; ++q) bq[q] = b3[(q >> 1) * 4096 + (q & 1) * 2048 + c];
#pragma unroll 1
        for (int i = 0; i < 8; ++i) {
            const int d = tid + i * NT;
            const f32x4* hp = (const f32x4*)(hid2 + d * 64);
            float f0 = 0.f, f1 = 0.f, f2 = 0.f, f3 = 0.f;
#pragma unroll 4
            for (int j4 = 0; j4 < 16; ++j4) {
                const f32x4 hv = hp[j4];
#pragma unroll
                for (int e = 0; e < 4; ++e) { const int j = j4 * 4 + e; f0 += hv[e] * W3[j]; f1 += hv[e] * W3[64 + j]; f2 += hv[e] * W3[128 + j]; f3 += hv[e] * W3[192 + j]; }
            }
            const float win = expf(-((float)d * (1.0f / 4095.0f)) * delta);
            H1[4095 + d] = (f0 + bq[0]) * win; H2[4095 + d] = (f1 + bq[1]) * win;
            if (d >= 1) { H1[4095 - d] = (f2 + bq[2]) * win; H2[4095 - d] = (f3 + bq[3]) * win; }
        }
    }
    const int t0 = tid * 8;
    const bf16_t* rv = PHT + (size_t)c * MT; const bf16_t* rx1 = PHT + (size_t)(2048 + c) * MT; const bf16_t* rx2 = PHT + (size_t)(4096 + c) * MT;
    {
        const float w0 = cw[c], w1 = cw[6144 + c], w2 = cw[12288 + c];
#pragma unroll
        for (int b = 0; b < 4; ++b) { float o[8]; conv3_load8(rv + b * 4096, t0, w0, w1, w2, o);
#pragma unroll
            for (int e = 0; e < 8; ++e) U[(t0 + e) * 4 + b] = o[e]; }
    }
    __syncthreads();
    float acc[8][4];
    longconv(H1, U, tid, acc);
    {
        const float w0 = cw[2048 + c], w1 = cw[6144 + 2048 + c], w2 = cw[12288 + 2048 + c], sk = skip[c];
        float y1[8][4];
#pragma unroll
        for (int b = 0; b < 4; ++b) { float o[8]; conv3_load8(rx1 + b * 4096, t0, w0, w1, w2, o);
#pragma unroll
            for (int e = 0; e < 8; ++e) y1[e][b] = o[e] * (acc[e][b] + sk * U[(t0 + e) * 4 + b]); }
        __syncthreads();
#pragma unroll
        for (int e = 0; e < 8; ++e) *(f32x4*)(U + (t0 + e) * 4) = (f32x4){y1[e][0], y1[e][1], y1[e][2], y1[e][3]};
    }
    __syncthreads();
    longconv(H2, U, tid, acc);
    {
        const float w0 = cw[4096 + c], w1 = cw[6144 + 4096 + c], w2 = cw[12288 + 4096 + c], sk = skip[2048 + c];
#pragma unroll
        for (int b = 0; b < 4; ++b) { float o[8]; conv3_load8(rx2 + b * 4096, t0, w0, w1, w2, o);
            float y[8];
#pragma unroll
            for (int e = 0; e < 8; ++e) y[e] = o[e] * (acc[e][b] + sk * U[(t0 + e) * 4 + b]);
            *(u32x4*)(YT + (size_t)c * MT + b * 4096 + t0) = pack8(y); }
    }
    __syncthreads();
}

__device__ void qkvpost_unit(KA a, int unit, unsigned char* lds) {
    const int tid = threadIdx.x;
    int ntok, row0, wh;
    if (unit < 12288) { const int gr = unit / 48; wh = unit % 48; ntok = 64; row0 = gr * 64; }
    else { const int uu = unit - 12288; const int b = uu / 48; wh = uu % 48; ntok = 256; row0 = MT + b * 256; }
    const int which = wh >> 4, h = wh & 15, colbase = which * 2048 + h * 128;
    bf16_t* PQ = (bf16_t*)(a->ws + WS_RB);
    bf16_t* raw = (bf16_t*)lds; float* wl = (float*)(lds + 65536);
    const float* cwt = a->in[7];
    for (int i = tid; i < ntok * 16; i += NT) { const int r = i >> 4, c8 = i & 15; *(u32x4*)(raw + r * 128 + c8 * 8) = *(const u32x4*)(PQ + (size_t)(row0 + r) * PQ_LD + colbase + c8 * 8); }
    for (int i = tid; i < 640; i += NT) wl[i] = cwt[(i >> 7) * 6144 + colbase + (i & 127)];
    __syncthreads();
    const int r = tid >> 3, cg = tid & 7;
    for (int rb = 0; rb < ntok / 64; ++rb) {
        const int tok = rb * 64 + r;
        float v[16]; float ss = 0.f;
#pragma unroll
        for (int e = 0; e < 16; ++e) {
            const int ch = cg * 16 + e; float acc = 0.f;
#pragma unroll
            for (int j = 0; j < 5; ++j) { const int tt = tok + j - 2; if (tt >= 0 && tt < ntok) acc += wl[j * 128 + ch] * bf2f(raw[tt * 128 + ch]); }
            const float s = siluf_(acc); v[e] = s; ss += s * s;
        }
        if (which < 2) {
            ss += __shfl_xor(ss, 1, 64); ss += __shfl_xor(ss, 2, 64); ss += __shfl_xor(ss, 4, 64);
            const float sc = rsqrtf(ss + 1e-6f) * (which == 0 ? 0.08838834764831845f : 1.0f);
#pragma unroll
            for (int e = 0; e < 16; ++e) v[e] *= sc;
        }
        bf16_t* op = PQ + (size_t)(row0 + tok) * PQ_LD + colbase + cg * 16;
        u32x4 w0, w1;
        w0.x = pk2(v[0], v[1]); w0.y = pk2(v[2], v[3]); w0.z = pk2(v[4], v[5]); w0.w = pk2(v[6], v[7]);
        w1.x = pk2(v[8], v[9]); w1.y = pk2(v[10], v[11]); w1.z = pk2(v[12], v[13]); w1.w = pk2(v[14], v[15]);
        *(u32x4*)op = w0; *(u32x4*)(op + 8) = w1;
    }
    __syncthreads();
}

__device__ void delta_item(KA a, int item, float* lf) {
    const int tid = threadIdx.x, dv = tid & 63, kg = tid >> 6;
    const int dvh = item & 1, dir = (item >> 1) & 1, h = (item >> 2) & 15, b = item >> 6;
    float* qs = lf; float* ks = lf + 8192; float* vs = lf + 16384; float* gs = lf + 20480; float* bs = lf + 20544; float* red = lf + 20608; float* ob = lf + 22656;
    const bf16_t* PQ = (const bf16_t*)(a->ws + WS_RB); const float* AB = (const float*)(a->ws + WS_AB);
    bf16_t* O = (bf16_t*)(a->ws + WS_RA) + (size_t)dir * MT * 2048;
    const float Aexp = expf(a->in[8][dir * 16 + h]); const float dtb = a->in[9][dir * 16 + h];
    float S[16];
#pragma unroll
    for (int j = 0; j < 16; ++j) S[j] = 0.f;
    for (int seg = 0; seg < 2; ++seg) {
        const int T = seg ? SEQ : CTXL; const int rbase = seg ? b * SEQ : MT + b * CTXL;
        for (int ch = 0; ch < T / 64; ++ch) {
            __syncthreads();
            {
                const int i = tid >> 3, p = ch * 64 + i, tok = dir ? (T - 1 - p) : p; const size_t row = (size_t)(rbase + tok);
                const int c0 = (tid & 7) * 16;
                const bf16_t* qp = PQ + row * PQ_LD + h * 128 + c0;
                float t8[8];
                unpack8(*(const u32x4*)qp, t8);
#pragma unroll
                for (int e = 0; e < 8; ++e) qs[i * 128 + c0 + e] = t8[e];
                unpack8(*(const u32x4*)(qp + 8), t8);
#pragma unroll
                for (int e = 0; e < 8; ++e) qs[i * 128 + c0 + 8 + e] = t8[e];
                unpack8(*(const u32x4*)(qp + 2048), t8);
#pragma unroll
                for (int e = 0; e < 8; ++e) ks[i * 128 + c0 + e] = t8[e];
                unpack8(*(const u32x4*)(qp + 2048 + 8), t8);
#pragma unroll
                for (int e = 0; e < 8; ++e) ks[i * 128 + c0 + 8 + e] = t8[e];
                const int c0v = (tid & 7) * 8;
                unpack8(*(const u32x4*)(PQ + row * PQ_LD + 4096 + h * 128 + dvh * 64 + c0v), t8);
#pragma unroll
                for (int e = 0; e < 8; ++e) vs[i * 64 + c0v + e] = t8[e];
                if ((tid & 7) == 0) {
                    const float ab0 = AB[row * 64 + dir * 32 + h], ab1 = AB[row * 64 + dir * 32 + 16 + h];
                    const float xx = ab0 + dtb; const float sp = (xx > 20.0f) ? xx : log1pf(expf(xx));
                    gs[i] = expf(-Aexp * sp); bs[i] = sigmoidf_(ab1);
                }
            }
            __syncthreads();
            {
                float pr = 0.f;
#pragma unroll
                for (int j = 0; j < 16; ++j) pr += ks[kg * 16 + j] * S[j];
                red[(0 * 2 + 0) * 512 + kg * 64 + dv] = pr;
            }
            __syncthreads();
            for (int i = 0; i < 64; ++i) {
                const int buf = i & 1;
                const float* rr = red + (buf * 2 + 0) * 512 + dv;
                const float r = ((rr[0] + rr[64]) + (rr[128] + rr[192])) + ((rr[256] + rr[320]) + (rr[384] + rr[448]));
                if (i > 0 && kg == 0) { const float* ro = red + (buf * 2 + 1) * 512 + dv;
                    ob[(i - 1) * 64 + dv] = ((ro[0] + ro[64]) + (ro[128] + ro[192])) + ((ro[256] + ro[320]) + (ro[384] + ro[448])); }
                const float eg = gs[i], coef = bs[i] * (vs[i * 64 + dv] - eg * r);
                float po = 0.f, pr = 0.f;
                const float* kp = ks + i * 128 + kg * 16; const float* qp = qs + i * 128 + kg * 16; const float* kn = ks + ((i + 1) & 63) * 128 + kg * 16;
#pragma unroll
                for (int j = 0; j < 16; ++j) { S[j] = eg * S[j] + kp[j] * coef; po += qp[j] * S[j]; pr += kn[j] * S[j]; }
                red[((buf ^ 1) * 2 + 0) * 512 + kg * 64 + dv] = pr;
                red[((buf ^ 1) * 2 + 1) * 512 + kg * 64 + dv] = po;
                __syncthreads();
            }
            if (kg == 0) { const float* ro = red + (0 * 2 + 1) * 512 + dv;
                ob[63 * 64 + dv] = ((ro[0] + ro[64]) + (ro[128] + ro[192])) + ((ro[256] + ro[320]) + (ro[384] + ro[448])); }
            __syncthreads();
            if (seg == 1) {
                const int i = tid >> 3, c8 = (tid & 7) * 8, p = ch * 64 + i, tok = dir ? (T - 1 - p) : p;
                float o8[8];
#pragma unroll
                for (int e = 0; e < 8; ++e) o8[e] = ob[i * 64 + c8 + e];
                *(u32x4*)(O + (size_t)(b * SEQ + tok) * 2048 + h * 128 + dvh * 64 + c8) = pack8(o8);
            }
        }
    }
    __syncthreads();
}

__device__ void ytrans_unit(const bf16_t* YT, bf16_t* Y, int unit, bf16_t* tile) {
    const int tid = threadIdx.x, cb = unit & 31, tb = unit >> 5, r = tid >> 3, c8 = (tid & 7) * 8;
    *(u32x4*)(tile + r * 72 + c8) = *(const u32x4*)(YT + (size_t)(cb * 64 + r) * MT + tb * 64 + c8);
    __syncthreads();
    u32x4 w;
    w.x = (unsigned)tile[(c8 + 0) * 72 + r] | ((unsigned)tile[(c8 + 1) * 72 + r] << 16);
    w.y = (unsigned)tile[(c8 + 2) * 72 + r] | ((unsigned)tile[(c8 + 3) * 72 + r] << 16);
    w.z = (unsigned)tile[(c8 + 4) * 72 + r] | ((unsigned)tile[(c8 + 5) * 72 + r] << 16);
    w.w = (unsigned)tile[(c8 + 6) * 72 + r] | ((unsigned)tile[(c8 + 7) * 72 + r] << 16);
    *(u32x4*)(Y + (size_t)(tb * 64 + r) * 2048 + cb * 64 + c8) = w;
    __syncthreads();
}

__device__ void p6_on(KA a) {
    const bf16_t* OF = (const bf16_t*)(a->ws + WS_RA); const bf16_t* OB = OF + (size_t)MT * 2048;
    const bf16_t* ZG = (const bf16_t*)(a->ws + WS_RB); bf16_t* ON = (bf16_t*)(a->ws + WS_HA);
    const float* nw = a->in[10];
    const size_t nthr = (size_t)gridDim.x * NT;
    for (size_t i = (size_t)blockIdx.x * NT + threadIdx.x; i < (size_t)MT * 256; i += nthr) {
        const int row = (int)(i >> 8), c8 = (int)(i & 255) * 8;
        float f[8], g[8], z[8];
        unpack8(*(const u32x4*)(OF + (size_t)row * 2048 + c8), f); unpack8(*(const u32x4*)(OB + (size_t)row * 2048 + c8), g);
        unpack8(*(const u32x4*)(ZG + (size_t)row * NZG + c8), z);
        float ss = 0.f;
#pragma unroll
        for (int e = 0; e < 8; ++e) { f[e] += g[e]; ss += f[e] * f[e]; }
        ss += __shfl_xor(ss, 1, 64); ss += __shfl_xor(ss, 2, 64); ss += __shfl_xor(ss, 4, 64); ss += __shfl_xor(ss, 8, 64);
        const float rs = rsqrtf(ss * (1.0f / 128.0f) + 1e-6f);
        float o[8];
#pragma unroll
        for (int e = 0; e < 8; ++e) o[e] = f[e] * rs * nw[(c8 & 127) + e] * siluf_(z[e]);
        *(u32x4*)(ON + (size_t)row * 2048 + c8) = pack8(o);
    }
}

__device__ void p8_tables(KA a) {
    bf16_t* U16 = (bf16_t*)(a->ws + WS_RA); bf16_t* V16 = U16 + (size_t)MT * 2048;
    const size_t nthr = (size_t)gridDim.x * NT, n8 = (size_t)16384 * 256;
    for (size_t i = (size_t)blockIdx.x * NT + threadIdx.x; i < 2 * n8; i += nthr) {
        const size_t j = (i < n8) ? i : i - n8; const float* sp = ((i < n8) ? a->in[27] : a->in[28]) + j * 8;
        const f32x4 x0 = *(const f32x4*)sp, x1 = *(const f32x4*)(sp + 4);
        u32x4 w; w.x = pk2(x0[0], x0[1]); w.y = pk2(x0[2], x0[3]); w.z = pk2(x1[0], x1[1]); w.w = pk2(x1[2], x1[3]);
        *(u32x4*)(((i < n8) ? U16 : V16) + j * 8) = w;
    }
}

__device__ void p9_ln1(KA a) {
    const float* mod = (const float*)(a->ws + WS_MOD); bf16_t* H2 = (bf16_t*)(a->ws + WS_RA) + (size_t)2 * MT * 2048;
    const float* g = a->in[23]; const float* bb = a->in[24];
    const int lane = threadIdx.x & 63, wv = blockIdx.x * 8 + (threadIdx.x >> 6), nwv = gridDim.x * 8;
    for (int row = wv; row < MT; row += nwv) {
        float* rp = a->out + (size_t)row * 2048;
        float v[32]; float s = 0.f;
#pragma unroll
        for (int i = 0; i < 4; ++i) { const f32x4 x0 = *(const f32x4*)(rp + i * 512 + lane * 8), x1 = *(const f32x4*)(rp + i * 512 + lane * 8 + 4);
#pragma unroll
            for (int e = 0; e < 4; ++e) { v[i * 8 + e] = x0[e]; v[i * 8 + 4 + e] = x1[e]; s += x0[e] + x1[e]; } }
        const float mu = wave_sum(s) * (1.0f / 2048.0f);
        float q = 0.f;
#pragma unroll
        for (int e = 0; e < 32; ++e) { const float d = v[e] - mu; q += d * d; }
        const float rstd = rsqrtf(wave_sum(q) * (1.0f / 2048.0f) + 1e-5f);
        const float* mp = mod + (row >> 12) * 12288;
#pragma unroll
        for (int i = 0; i < 4; ++i) {
            const int col = i * 512 + lane * 8;
            float xn[8], h[8];
#pragma unroll
            for (int e = 0; e < 8; ++e) { xn[e] = (v[i * 8 + e] - mu) * rstd * g[col + e] + bb[col + e]; h[e] = xn[e] * (1.0f + mp[8192 + col + e]) + mp[6144 + col + e]; }
            *(f32x4*)(rp + col) = (f32x4){xn[0], xn[1], xn[2], xn[3]}; *(f32x4*)(rp + col + 4) = (f32x4){xn[4], xn[5], xn[6], xn[7]};
            *(u32x4*)(H2 + (size_t)row * 2048 + col) = pack8(h);
        }
    }
}

__device__ __forceinline__ void topk16_2(float v0, float v1, int lane, float& rs, int& ri) {
    rs = -INFINITY; ri = 0;
    for (int it = 0; it < 16; ++it) {
        const float wm = wave_max(fmaxf(v0, v1));
        const unsigned long long b0 = __ballot(v0 == wm), b1 = __ballot(v1 == wm);
        int key;
        if (b0) { const int l = __ffsll((long long)b0) - 1; key = l; if (lane == l) v0 = -INFINITY; }
        else { const int l = __ffsll((long long)b1) - 1; key = 64 + l; if (lane == l) v1 = -INFINITY; }
        if (lane == it) { rs = wm; ri = key; }
    }
}
__device__ __forceinline__ void topk16_4(float c0, float c1, float c2, float c3, int lane, float& rs, int& ri) {
    rs = -INFINITY; ri = 0;
    for (int it = 0; it < 16; ++it) {
        const float wm = wave_max(fmaxf(fmaxf(c0, c1), fmaxf(c2, c3)));
        const unsigned long long b0 = __ballot(c0 == wm), b1 = __ballot(c1 == wm), b2 = __ballot(c2 == wm), b3 = __ballot(c3 == wm);
        const unsigned long long ball = b0 | b1 | b2 | b3;
        const int l = __ffsll((long long)ball) - 1;
        const int r = ((b0 >> l) & 1ull) ? 0 : ((b1 >> l) & 1ull) ? 1 : ((b2 >> l) & 1ull) ? 2 : 3;
        if (lane == l) { if (r == 0) c0 = -INFINITY; else if (r == 1) c1 = -INFINITY; else if (r == 2) c2 = -INFINITY; else c3 = -INFINITY; }
        if (lane == it) { rs = wm; ri = l * 4 + r; }
    }
}
__device__ void peer_unit(KA a, int unit, unsigned char* lds) {
    const int tid = threadIdx.x, lane = tid & 63, wid = tid >> 6;
    float* SK = (float*)lds; float* QT = (float*)(lds + 66048); float* SC = (float*)(lds + 82432);
    int* IGI = (int*)(lds + 98816); float* IGG = (float*)(lds + 115200);
    const int tok0 = unit * 32;
    const float* Qp = (const float*)(a->ws + WS_RB); const float* subk = a->in[26];
    const bf16_t* U16 = (const bf16_t*)(a->ws + WS_RA); const bf16_t* V16 = U16 + (size_t)MT * 2048; const bf16_t* H2 = V16 + (size_t)MT * 2048;
    const float* mod = (const float*)(a->ws + WS_MOD);
    for (int h = 0; h < 8; ++h) {
        float tps[2][4]; int tpi[2][4];
#pragma unroll
        for (int p = 0; p < 2; ++p) {
            __syncthreads();
            for (int i = tid; i < 128 * 32; i += NT) { const int key = i >> 5, d4 = (i & 31) * 4; const f32x4 v = *(const f32x4*)(subk + (size_t)((h * 2 + p) * 128 + key) * 128 + d4);
                float* t = SK + key * 129 + d4; t[0] = v.x; t[1] = v.y; t[2] = v.z; t[3] = v.w; }
            for (int i = tid; i < 32 * 32; i += NT) { const int r = i >> 5, d4 = (i & 31) * 4; *(f32x4*)(QT + r * 128 + d4) = *(const f32x4*)(Qp + (size_t)(tok0 + r) * 2048 + h * 256 + p * 128 + d4); }
            __syncthreads();
            {
                const int key = tid & 127, tg = tid >> 7;
                float s[8];
#pragma unroll
                for (int e = 0; e < 8; ++e) s[e] = 0.f;
                for (int d4 = 0; d4 < 32; ++d4) {
                    const float* sp = SK + key * 129 + d4 * 4; const float k0 = sp[0], k1 = sp[1], k2 = sp[2], k3 = sp[3];
#pragma unroll
                    for (int e = 0; e < 8; ++e) { const f32x4 q = *(const f32x4*)(QT + (tg * 8 + e) * 128 + d4 * 4); s[e] += (k0 * q.x + k1 * q.y) + (k2 * q.z + k3 * q.w); }
                }
#pragma unroll
                for (int e = 0; e < 8; ++e) SC[(tg * 8 + e) * 128 + key] = s[e];
            }
            __syncthreads();
#pragma unroll
            for (int rr = 0; rr < 4; ++rr) { const int row = wid * 4 + rr; topk16_2(SC[row * 128 + lane], SC[row * 128 + 64 + lane], lane, tps[p][rr], tpi[p][rr]); }
        }
#pragma unroll
        for (int rr = 0; rr < 4; ++rr) {
            const int row = wid * 4 + rr;
            const float s0 = __shfl(tps[0][rr], lane >> 2, 64);
            const float c0 = s0 + __shfl(tps[1][rr], 4 * (lane & 3) + 0, 64), c1 = s0 + __shfl(tps[1][rr], 4 * (lane & 3) + 1, 64),
                        c2 = s0 + __shfl(tps[1][rr], 4 * (lane & 3) + 2, 64), c3 = s0 + __shfl(tps[1][rr], 4 * (lane & 3) + 3, 64);
            float bs; int bc; topk16_4(c0, c1, c2, c3, lane, bs, bc);
            const int e0 = __shfl(tpi[0][rr], (bc >> 4) & 15, 64), e1 = __shfl(tpi[1][rr], bc & 15, 64);
            const float mx = __shfl(bs, 0, 64);
            const float ex = (lane < 16) ? expf(bs - mx) : 0.f;
            const float sm = wave_sum(ex);
            if (lane < 16) { IGI[row * 128 + h * 16 + lane] = e0 * 128 + e1; IGG[row * 128 + h * 16 + lane] = ex / sm; }
        }
    }
    __syncthreads();
    for (int rr = 0; rr < 4; ++rr) {
        const int row = wid * 4 + rr, tok = tok0 + row;
        float hx[32], y[32];
#pragma unroll
        for (int i = 0; i < 4; ++i) { float t8[8]; unpack8(*(const u32x4*)(H2 + (size_t)tok * 2048 + i * 512 + lane * 8), t8);
#pragma unroll
            for (int e = 0; e < 8; ++e) { hx[i * 8 + e] = t8[e]; y[i * 8 + e] = 0.f; } }
#if DBG_MODE != 2
#pragma unroll 2
        for (int e = 0; e < 128; ++e) {
            const int idx = __builtin_amdgcn_readfirstlane(IGI[row * 128 + e]); const float gt = IGG[row * 128 + e];
            const bf16_t* up = U16 + (size_t)idx * 2048 + lane * 8; const bf16_t* vp = V16 + (size_t)idx * 2048 + lane * 8;
            const u32x4 u0 = *(const u32x4*)up, u1 = *(const u32x4*)(up + 512), u2 = *(const u32x4*)(up + 1024), u3 = *(const u32x4*)(up + 1536);
            const u32x4 v0 = *(const u32x4*)vp, v1 = *(const u32x4*)(vp + 512), v2 = *(const u32x4*)(vp + 1024), v3 = *(const u32x4*)(vp + 1536);
            float t8[8]; float dot = 0.f;
            unpack8(u0, t8);
#pragma unroll
            for (int k = 0; k < 8; ++k) dot += t8[k] * hx[k];
            unpack8(u1, t8);
#pragma unroll
            for (int k = 0; k < 8; ++k) dot += t8[k] * hx[8 + k];
            unpack8(u2, t8);
#pragma unroll
            for (int k = 0; k < 8; ++k) dot += t8[k] * hx[16 + k];
            unpack8(u3, t8);
#pragma unroll
            for (int k = 0; k < 8; ++k) dot += t8[k] * hx[24 + k];
            dot = wave_sum(dot);
            const float cf = gt * 0.5f * dot * (1.0f + erff(dot * 0.7071067811865476f));
            unpack8(v0, t8);
#pragma unroll
            for (int k = 0; k < 8; ++k) y[k] += cf * t8[k];
            unpack8(v1, t8);
#pragma unroll
            for (int k = 0; k < 8; ++k) y[8 + k] += cf * t8[k];
            unpack8(v2, t8);
#pragma unroll
            for (int k = 0; k < 8; ++k) y[16 + k] += cf * t8[k];
            unpack8(v3, t8);
#pragma unroll
            for (int k = 0; k < 8; ++k) y[24 + k] += cf * t8[k];
        }
#endif
        float* rp = a->out + (size_t)tok * 2048; const float* mp = mod + (tok >> 12) * 12288 + 10240;
        float val[32]; float s = 0.f;
#pragma unroll
        for (int i = 0; i < 4; ++i) { const int col = i * 512 + lane * 8; const f32x4 x0 = *(const f32x4*)(rp + col), x1 = *(const f32x4*)(rp + col + 4);
#pragma unroll
            for (int e = 0; e < 4; ++e) { val[i * 8 + e] = ALPHA * x0[e] + mp[col + e] * y[i * 8 + e]; val[i * 8 + 4 + e] = ALPHA * x1[e] + mp[col + 4 + e] * y[i * 8 + 4 + e]; s += val[i * 8 + e] + val[i * 8 + 4 + e]; } }
        const float mu = wave_sum(s) * (1.0f / 2048.0f);
        float q = 0.f;
#pragma unroll
        for (int e = 0; e < 32; ++e) { const float d = val[e] - mu; q += d * d; }
        const float rstd = rsqrtf(wave_sum(q) * (1.0f / 2048.0f) + 1e-5f);
        const float* g = a->in[29]; const float* bb = a->in[30];
#pragma unroll
        for (int i = 0; i < 4; ++i) { const int col = i * 512 + lane * 8; float o[8];
#pragma unroll
            for (int e = 0; e < 8; ++e) o[e] = (val[i * 8 + e] - mu) * rstd * g[col + e] + bb[col + e];
            *(f32x4*)(rp + col) = (f32x4){o[0], o[1], o[2], o[3]}; *(f32x4*)(rp + col + 4) = (f32x4){o[4], o[5], o[6], o[7]}; }
    }
    __syncthreads();
}

__global__ void __launch_bounds__(NT, 2) fwd_mega(Args a_) {
    KA a = (KA)__builtin_amdgcn_kernarg_segment_ptr();
    extern __shared__ __attribute__((aligned(16))) unsigned char lds[];
    cg::grid_group grid = cg::this_grid();
    float* lf = (float*)lds;
    const int lo = a->ph_lo, hi = a->ph_hi;
#define IN(k) (lo <= (k) && (k) < hi)
#define SEAM(k) do { if (IN(k) && IN((k) + 1)) grid.sync(); asm volatile("" : "+s"(a)); } while (0)
    unsigned char* ws = a->ws;
    bf16_t* HA = (bf16_t*)(ws + WS_HA); bf16_t* WT = (bf16_t*)(ws + WS_WT); bf16_t* SW = (bf16_t*)(ws + WS_SW);
    bf16_t* RA = (bf16_t*)(ws + WS_RA); bf16_t* RB = (bf16_t*)(ws + WS_RB);
    const float* mod = (const float*)(ws + WS_MOD);

    if (IN(0)) { p0_mod_hid2(a, lf); p0_transposes(a, lf); }
    SEAM(0);
    if (IN(1)) { p1_ha(a); }
    SEAM(1);
    if (IN(2)) {
        run_gemm(lds, WT + (size_t)WT_HY0 * 2048, HA, NHY, MT, FStoreBf16{RA, MT});
        run_gemm(lds, HA, WT, MA, NQKVP, FStoreQKV{RB, (float*)(ws + WS_AB)});
    }
    SEAM(2);
    if (IN(3)) {
        for (int c = blockIdx.x; c < 2048; c += gridDim.x) hyena_item(a, c, lf);
        for (int u = blockIdx.x; u < 12288 + 192; u += gridDim.x) qkvpost_unit(a, u, lds);
    }
    SEAM(3);
    if (IN(4)) { for (int it = blockIdx.x; it < 256; it += gridDim.x) delta_item(a, it, lf); }
    SEAM(4);
    if (IN(5)) {
        run_gemm(lds, HA, WT + (size_t)WT_ZG0 * 2048, MT, NZG, FStoreBf16{RB, NZG});
        for (int u = blockIdx.x; u < 8192; u += gridDim.x) ytrans_unit((const bf16_t*)a->out, RA + (size_t)2 * MT * 2048, u, (bf16_t*)lds);
    }
    SEAM(5);
    if (IN(6)) { p6_on(a); }
    SEAM(6);
    if (IN(7)) {
        run_gemm(lds, HA  , SW, MT, D, FGatePA{RB, WT  });
        run_gemm(lds, RA + (size_t)2 * MT * 2048  , SW + (size_t)1 * D * D, MT, D, FGatePH{RB, WT  });
    }
    SEAM(7);
    if (IN(8)) {
        run_gemm(lds, WT  , SW + (size_t)2 * D * D, MT, D, FOut{a->in[0], mod, a->out});
        p8_tables(a);
    }
    SEAM(8);
    if (IN(9)) { p9_ln1(a); }
    SEAM(9);
    if (IN(10)) { run_gemm(lds, RA + (size_t)2 * MT * 2048  , SW + (size_t)3 * D * D, MT, D, FStoreF32{(float*)(ws + WS_RB), D}); }
    SEAM(10);
    if (IN(11)) { for (int u = blockIdx.x; u < MT / 32; u += gridDim.x) peer_unit(a, u, lds); }
#undef IN
#undef SEAM
}

extern "C" void kernel_launch(void* const* d_in, const int* in_sizes, int n_in, void* d_out, int out_size, void* d_ws, size_t ws_size, hipStream_t stream) {
    static int grid = 0;
    if (grid == 0) {
        if (n_in != 31 || out_size != MT * D || ws_size < WS_END) { fprintf(stderr, "kernel_launch: unexpected problem shape / workspace (%d inputs, out %d, ws %zu)\n", n_in, out_size, ws_size); grid = -1; return; }
        int dev = 0, cus = 0, per_cu = 0;
        (void)hipGetDevice(&dev);
        (void)hipDeviceGetAttribute(&cus, hipDeviceAttributeMultiprocessorCount, dev);
        (void)hipFuncSetAttribute((const void*)fwd_mega, hipFuncAttributeMaxDynamicSharedMemorySize, LDS_BYTES);
        (void)hipOccupancyMaxActiveBlocksPerMultiprocessor(&per_cu, (const void*)fwd_mega, NT, LDS_BYTES);
        if (per_cu < 1) per_cu = 1;
        grid = cus * per_cu;
        (void)hipGetLastError();
    }
    if (grid < 0) return;
    Args a{};
    for (int i = 0; i < 31; ++i) a.in[i] = (const float*)d_in[i];
    a.out = (float*)d_out; a.ws = (unsigned char*)d_ws; a.ph_lo = 0; a.ph_hi = 12;
    void* args[] = {&a};
    hipError_t e = hipLaunchCooperativeKernel((const void*)fwd_mega, dim3(grid), dim3(NT), args, LDS_BYTES, stream);
    if (e != hipSuccess) fprintf(stderr, "cooperative launch failed: %s (grid %d)\n", hipGetErrorString(e), grid);
}
```

```cpp
#include <hip/hip_runtime.h>
#include <hip/hip_cooperative_groups.h>
#include <cstdio>
#include <cstdint>
namespace cg = cooperative_groups;

#ifndef DBG_MODE
#define DBG_MODE 0
#endif

namespace pg8 {
#define PG8_LAS __attribute__((address_space(3)))
typedef unsigned short bf16_t;
typedef short bf16x8 __attribute__((ext_vector_type(8)));
typedef float f32x4 __attribute__((ext_vector_type(4)));
typedef unsigned u32x4 __attribute__((ext_vector_type(4)));
constexpr int BM = 256, BK = 64, HALF = 128, HTB = HALF * BK * 2, STAGE_BYTES = 8 * HTB, NXCD = 8, WGM = 8;

__host__ __device__ __forceinline__ int lds_byte(int r, int c) { const int st = (r >> 4) * 2 + (c >> 5), rr = r & 15, cc = c & 31, ob = rr * 64 + cc * 2; return st * 1024 + (ob ^ (((ob >> 9) & 1) << 5)); }
__host__ __device__ __forceinline__ void stage_rc(int b, int& R, int& C) { const int st = b / 1024, sb = b % 1024, swz = sb ^ (((sb >> 9) & 1) << 5); R = (st >> 1) * 16 + swz / 64; C = (st & 1) * 32 + (swz % 64) / 2; }
__host__ __device__ __forceinline__ int perm32(int rho) { const int n = rho >> 4, i = rho & 15; return 8 * (i >> 2) + 4 * n + (i & 3); }

struct Unit { int pm, pn; };
struct Gemm { const bf16_t* A; const bf16_t* Bt; int M, N, K; };

struct StaticOrder {
    int nM, nN, nwg, G, c;
    __host__ __device__ void init(int M, int N, int G_, int c_) { nM = M / BM; nN = N / BM; nwg = nM * nN; G = G_; c = c_; }
    __host__ __device__ bool next(int i, Unit& u) const {
        const long L = (long)i * G + c; if (L >= nwg) return false;
        int wgid = (int)L; { const int q = nwg / NXCD, r = nwg % NXCD, xcd = wgid % NXCD, off = wgid / NXCD; wgid = (xcd < r ? xcd * (q + 1) : r * (q + 1) + (xcd - r) * q) + off; }
        const int nig = WGM * nN, gid = wgid / nig, fm = gid * WGM, gsz = (nM - fm) < WGM ? (nM - fm) : WGM;
        u.pm = fm + ((wgid % nig) % gsz); u.pn = (wgid % nig) / gsz; return true;
    }
    __device__ __forceinline__ void a_ready(const Unit&) const {}
    __device__ __forceinline__ void done(const Unit&) const {}
};

__device__ __forceinline__ unsigned cvt_pk_bf16(float lo, float hi) { unsigned r; asm volatile("v_cvt_pk_bf16_f32 %0, %1, %2" : "=v"(r) : "v"(lo), "v"(hi)); return r; }

template <class F> struct EpiGen {
    static constexpr bool PERM = true, AFTER_DRAIN = false;
    F f;
    __device__ __forceinline__ void operator()(const f32x4 (&acc)[2][2][4][2], const Unit& u, int wr, int wc, int fr, int fq) const {
        const int row0 = u.pm * BM + wr * 64 + fr, col0 = u.pn * BM + wc * 32 + 8 * fq;
#pragma unroll
        for (int ai = 0; ai < 2; ++ai)
#pragma unroll
            for (int m = 0; m < 4; ++m)
#pragma unroll
                for (int bj = 0; bj < 2; ++bj) f(row0 + ai * HALF + m * 16, col0 + bj * HALF, acc[ai][bj][m][0], acc[ai][bj][m][1]);
    }
};

template <class Epi, class Sched>
__device__ __forceinline__ void gemm_phase(PG8_LAS unsigned char* lds, const Gemm g, const Sched& S, const Epi& E) {
    const int tid = threadIdx.x, wid = __builtin_amdgcn_readfirstlane(tid >> 6), lane = tid & 63, wr = wid >> 2, wc = wid & 3, fr = lane & 15, fq = lane >> 4;
    const int K = g.K, nt = K / BK;
    unsigned voffA[2], voffB[2];
#pragma unroll
    for (int i = 0; i < 2; ++i) { int R, C; stage_rc(tid * 16 + i * 8192, R, C); const int Rb = Epi::PERM ? ((R & ~31) + perm32(R & 31)) : R;
        voffA[i] = (unsigned)(R * K + C) * 2u; voffB[i] = (unsigned)(Rb * K + C) * 2u; }
    const size_t kstep = (size_t)(BK * 2);
    const size_t hstep = (size_t)HALF * K * 2;
    const size_t tstep = 2 * hstep;
    const unsigned ldsw = (unsigned)wid * 1024u;
    const int aoff = lds_byte(wr * 64 + fr, fq * 8), boff = lds_byte(wc * 32 + fr, fq * 8);
#define PG8_SA(b, h) (((b) * 2 + (h)) * HTB)
#define PG8_SB(b, h) ((4 + (b) * 2 + (h)) * HTB)
#define PG8_STAGE(bufoff, gbase, voff) do { _Pragma("unroll") for (int _i = 0; _i < 2; ++_i) \
        __builtin_amdgcn_global_load_lds((const unsigned*)((const char*)(gbase) + (voff)[_i]), (PG8_LAS unsigned*)(lds + (bufoff) + ldsw + _i * 8192), 16, 0, 0); } while (0)
#define PG8_LDA(dst, b, h) do { _Pragma("unroll") for (int m = 0; m < 4; ++m) _Pragma("unroll") for (int k = 0; k < 2; ++k) dst[m][k] = *(const PG8_LAS bf16x8*)(lds + PG8_SA(b, h) + aoff + m * 2048 + k * 1024); } while (0)
#define PG8_LDB(dst, b, h) do { _Pragma("unroll") for (int n = 0; n < 2; ++n) _Pragma("unroll") for (int k = 0; k < 2; ++k) dst[n][k] = *(const PG8_LAS bf16x8*)(lds + PG8_SB(b, h) + boff + n * 2048 + k * 1024); } while (0)
#define PG8_MMA(ai, bj, At, Bt) do { __builtin_amdgcn_s_setprio(1); _Pragma("unroll") for (int m = 0; m < 4; ++m) _Pragma("unroll") for (int n = 0; n < 2; ++n) _Pragma("unroll") for (int k = 0; k < 2; ++k) \
        acc[ai][bj][m][n] = __builtin_amdgcn_mfma_f32_16x16x32_bf16(Bt[n][k], At[m][k], acc[ai][bj][m][n], 0, 0, 0); __builtin_amdgcn_s_setprio(0); } while (0)
#define PG8_WAIT_V(n) asm volatile("s_waitcnt vmcnt(" #n ")" ::: "memory")
#define PG8_WAIT_L(n) asm volatile("s_waitcnt lgkmcnt(" #n ")" ::: "memory")
#define PG8_BAR __builtin_amdgcn_s_barrier()
#define PG8_SCHED __builtin_amdgcn_sched_barrier(0)
    Unit cur, nxt; int ui = 0;
    if (!S.next(0, cur)) return;
    f32x4 acc[2][2][4][2];
#pragma unroll
    for (int a = 0; a < 2; ++a)
#pragma unroll
        for (int b = 0; b < 2; ++b)
#pragma unroll
            for (int m = 0; m < 4; ++m)
#pragma unroll
                for (int n = 0; n < 2; ++n) acc[a][b][m][n] = (f32x4){0.f, 0.f, 0.f, 0.f};
    bf16x8 At[4][2], B0[2][2], B1[2][2];
    const char* cA = (const char*)g.A + (size_t)cur.pm * tstep; const char* cB = (const char*)g.Bt + (size_t)cur.pn * tstep;
    S.a_ready(cur);
    PG8_STAGE(PG8_SB(0, 0), cB, voffB); PG8_STAGE(PG8_SA(0, 0), cA, voffA); PG8_STAGE(PG8_SB(0, 1), cB + hstep, voffB); PG8_STAGE(PG8_SA(0, 1), cA + hstep, voffA);
    if (wr == 1) PG8_BAR;
    PG8_WAIT_V(4); PG8_BAR;
    PG8_STAGE(PG8_SB(1, 0), cB + kstep, voffB); PG8_STAGE(PG8_SA(1, 0), cA + kstep, voffA); PG8_STAGE(PG8_SB(1, 1), cB + hstep + kstep, voffB);
    PG8_WAIT_V(6); PG8_BAR;
    for (;;) {
        const bool has_next = S.next(ui + 1, nxt);
        const char* nA = has_next ? (const char*)g.A + (size_t)nxt.pm * tstep : cA; const char* nB = has_next ? (const char*)g.Bt + (size_t)nxt.pn * tstep : cB;
        for (int t = 0; t < nt; t += 2) {
            const bool last = (t == nt - 2);
            const char* a1 = cA + (size_t)(t + 1) * kstep;
            const char* a2 = last ? nA : cA + (size_t)(t + 2) * kstep; const char* b2 = last ? nB : cB + (size_t)(t + 2) * kstep;
            const char* a3 = a2 + kstep; const char* b3 = b2 + kstep;
            if (last && has_next) S.a_ready(nxt);
            PG8_LDB(B0, 0, 0); PG8_SCHED; PG8_LDA(At, 0, 0); PG8_STAGE(PG8_SA(1, 1), a1 + hstep, voffA);
            PG8_WAIT_L(8); PG8_BAR; PG8_WAIT_L(0); PG8_MMA(0, 0, At, B0); PG8_BAR; PG8_SCHED;
            PG8_LDB(B1, 0, 1); PG8_STAGE(PG8_SB(0, 0), b2, voffB);
            PG8_BAR; PG8_WAIT_L(0); PG8_MMA(0, 1, At, B1); PG8_BAR;
            PG8_LDA(At, 0, 1); PG8_STAGE(PG8_SA(0, 0), a2, voffA);
            PG8_BAR; PG8_WAIT_L(0); PG8_MMA(1, 0, At, B0); PG8_BAR; PG8_SCHED;
            PG8_STAGE(PG8_SB(0, 1), b2 + hstep, voffB);
            PG8_WAIT_V(6); PG8_BAR; PG8_MMA(1, 1, At, B1); PG8_BAR;
            PG8_LDB(B0, 1, 0); PG8_SCHED; PG8_LDA(At, 1, 0); PG8_STAGE(PG8_SA(0, 1), a2 + hstep, voffA);
            PG8_WAIT_L(8); PG8_BAR; PG8_WAIT_L(0); PG8_MMA(0, 0, At, B0); PG8_BAR; PG8_SCHED;
            PG8_LDB(B1, 1, 1); PG8_STAGE(PG8_SB(1, 0), b3, voffB);
            PG8_BAR; PG8_WAIT_L(0); PG8_MMA(0, 1, At, B1); PG8_BAR;
            PG8_LDA(At, 1, 1); PG8_STAGE(PG8_SA(1, 0), a3, voffA);
            PG8_BAR; PG8_WAIT_L(0); PG8_MMA(1, 0, At, B0); PG8_BAR; PG8_SCHED;
            PG8_STAGE(PG8_SB(1, 1), b3 + hstep, voffB);
            PG8_WAIT_V(6); PG8_BAR; PG8_MMA(1, 1, At, B1); PG8_BAR;
        }
        E(acc, cur, wr, wc, fr, fq); S.done(cur);
        if (!has_next) break;
#pragma unroll
        for (int a = 0; a < 2; ++a)
#pragma unroll
            for (int b = 0; b < 2; ++b)
#pragma unroll
                for (int m = 0; m < 4; ++m)
#pragma unroll
                    for (int n = 0; n < 2; ++n) acc[a][b][m][n] = (f32x4){0.f, 0.f, 0.f, 0.f};
        cur = nxt; cA = nA; cB = nB; ++ui;
    }
    PG8_WAIT_V(0);
    if (wr == 0) PG8_BAR;
    PG8_BAR;
#undef PG8_SA
#undef PG8_SB
#undef PG8_STAGE
#undef PG8_LDA
#undef PG8_LDB
#undef PG8_MMA
#undef PG8_WAIT_V
#undef PG8_WAIT_L
#undef PG8_BAR
#undef PG8_SCHED
}
}

typedef unsigned short bf16_t;
typedef float f32x4 __attribute__((ext_vector_type(4)));
typedef unsigned u32x4 __attribute__((ext_vector_type(4)));
#define LAS __attribute__((address_space(3)))

constexpr int NT = 512;
constexpr int LDS_BYTES = 160 * 1024;
constexpr int D = 2048, NB = 4, SEQ = 4096, CTXL = 256;
constexpr int MT = NB * SEQ;
constexpr int MC = NB * CTXL;
constexpr int MA = MT + MC;
constexpr int NQKVP = 6400;
constexpr int PQ_LD = 6144;
constexpr int NHY = 6144, NZG = 6144;
constexpr int WT_ROWS = NQKVP + NHY + NZG;
constexpr int WT_HY0 = NQKVP, WT_ZG0 = NQKVP + NHY;
constexpr float ALPHA = 1.189207115002721f;

constexpr size_t MiB = (size_t)1 << 20;
constexpr size_t WS_MOD = 0, WS_HID2 = 1 * MiB, WS_SW = 2 * MiB, WS_HA = 34 * MiB, WS_WT = 102 * MiB, WS_RA = 175 * MiB, WS_RB = 367 * MiB, WS_AB = 580 * MiB, WS_END = 585 * MiB;

struct Args { const float* in[31]; float* out; unsigned char* ws; int ph_lo, ph_hi; };
typedef const __attribute__((address_space(4))) Args* KA;

__device__ __forceinline__ unsigned f2bf(float f) { unsigned u = __float_as_uint(f); return (u + 0x7fffu + ((u >> 16) & 1u)) >> 16; }
__device__ __forceinline__ unsigned pk2(float lo, float hi) { return f2bf(lo) | (f2bf(hi) << 16); }
__device__ __forceinline__ float bflo(unsigned w) { return __uint_as_float(w << 16); }
__device__ __forceinline__ float bfhi(unsigned w) { return __uint_as_float(w & 0xffff0000u); }
__device__ __forceinline__ float bf2f(bf16_t b) { return __uint_as_float(((unsigned)b) << 16); }
__device__ __forceinline__ void unpack8(const u32x4 w, float (&o)[8]) { o[0] = bflo(w.x); o[1] = bfhi(w.x); o[2] = bflo(w.y); o[3] = bfhi(w.y); o[4] = bflo(w.z); o[5] = bfhi(w.z); o[6] = bflo(w.w); o[7] = bfhi(w.w); }
__device__ __forceinline__ u32x4 pack8(const float (&v)[8]) { u32x4 w; w.x = pk2(v[0], v[1]); w.y = pk2(v[2], v[3]); w.z = pk2(v[4], v[5]); w.w = pk2(v[6], v[7]); return w; }
__device__ __forceinline__ float sigmoidf_(float x) { return 1.0f / (1.0f + expf(-x)); }
__device__ __forceinline__ float siluf_(float x) { return x / (1.0f + expf(-x)); }
__device__ __forceinline__ float wave_sum(float v) {
#pragma unroll
    for (int o = 32; o > 0; o >>= 1) v += __shfl_xor(v, o, 64);
    return v;
}
__device__ __forceinline__ float wave_max(float v) {
#pragma unroll
    for (int o = 32; o > 0; o >>= 1) v = fmaxf(v, __shfl_xor(v, o, 64));
    return v;
}

__device__ void p0_mod_hid2(KA a, float* lf) {
    const int tid = threadIdx.x, bid = blockIdx.x;
    if (bid < 192) {
        const float* c = a->in[1]; const float* cc = a->in[3]; const float* w_ada = a->in[4]; const float* b_ada = a->in[5];
        float* mod = (float*)(a->ws + WS_MOD);
        for (int i = tid; i < 5 * 2048; i += NT) { const int r = i >> 11, k = i & 2047; const float v = (r < 4) ? c[r * 2048 + k] : cc[k]; lf[i] = siluf_(v); }
        __syncthreads();
        const int cl = tid & 63, kg = tid >> 6, col = bid * 64 + cl;
        float a0 = 0.f, a1 = 0.f, a2 = 0.f, a3 = 0.f, a4 = 0.f;
#pragma unroll 8
        for (int k = kg * 256; k < kg * 256 + 256; ++k) {
            const float w = w_ada[(size_t)k * 12288 + col];
            a0 += lf[k] * w; a1 += lf[2048 + k] * w; a2 += lf[4096 + k] * w; a3 += lf[6144 + k] * w; a4 += lf[8192 + k] * w;
        }
        float* red = lf + 5 * 2048;
        red[(kg * 5 + 0) * 64 + cl] = a0; red[(kg * 5 + 1) * 64 + cl] = a1; red[(kg * 5 + 2) * 64 + cl] = a2; red[(kg * 5 + 3) * 64 + cl] = a3; red[(kg * 5 + 4) * 64 + cl] = a4;
        __syncthreads();
        if (tid < 320) { const int r = tid >> 6; float s = 0.f;
#pragma unroll
            for (int g = 0; g < 8; ++g) s += red[(g * 5 + r) * 64 + cl];
            mod[r * 12288 + col] = s + b_ada[col]; }
        __syncthreads();
    } else {
        const float* w1 = a->in[12]; const float* b1 = a->in[13]; const float* w2 = a->in[14]; const float* b2 = a->in[15]; const float* freq = a->in[18];
        float* hid2 = (float*)(a->ws + WS_HID2);
        const int pb = (bid - 192) * 64, j = tid & 63, pl = tid >> 6;
        const float fj = freq[j];
        for (int it = 0; it < 8; ++it) {
            const int pos = pb + it * 8 + pl;
            const float tt = (float)pos * (1.0f / 4095.0f);
            float s1 = tt * w1[j];
            const float base = (6.283185307179586f / 4096.0f) * (float)pos;
            for (int e = 0; e < 16; ++e) {
                const float band = 1e-4f + (float)e * ((15.0f - 1e-4f) / 15.0f);
                const float ang = base * band;
                s1 += cosf(ang) * w1[(1 + e) * 64 + j] - sinf(ang) * w1[(17 + e) * 64 + j];
            }
            lf[pl * 64 + j] = sinf(fj * (s1 + b1[j]));
            __syncthreads();
            float s2 = 0.f;
            for (int i = 0; i < 64; ++i) s2 += lf[pl * 64 + i] * w2[i * 64 + j];
            hid2[pos * 64 + j] = sinf(fj * (s2 + b2[j]));
            __syncthreads();
        }
    }
}

__device__ void transpose_unit(const float* src, int ldn, int n0src, bf16_t* dst, int nb, int kb, float* tile) {
    const int tid = threadIdx.x, r = tid >> 4, c4 = tid & 15;
#pragma unroll
    for (int i = 0; i < 4; ++i) {
        const int kk = i * 32 + r;
        f32x4 v = (f32x4){0.f, 0.f, 0.f, 0.f};
        if (n0src >= 0) v = *(const f32x4*)(src + (size_t)(kb * 128 + kk) * ldn + n0src + c4 * 4);
        float* t = tile + kk * 65 + c4 * 4; t[0] = v.x; t[1] = v.y; t[2] = v.z; t[3] = v.w;
    }
    __syncthreads();
#pragma unroll
    for (int i = 0; i < 2; ++i) {
        const int chunk = tid + i * NT, nr = chunk >> 4, kc = chunk & 15;
        const float* t = tile + (kc * 8) * 65 + nr;
        u32x4 w; w.x = pk2(t[0], t[65]); w.y = pk2(t[130], t[195]); w.z = pk2(t[260], t[325]); w.w = pk2(t[390], t[455]);
        *(u32x4*)(dst + (size_t)(nb * 64 + nr) * 2048 + kb * 128 + kc * 8) = w;
    }
    __syncthreads();
}
__device__ __forceinline__ int win_colmap(int np) {
    if (np < 6144) return np;
    if (np < 6208) return 8192 + (np - 6144);
    if (np < 6400) return -1;
    if (np < 12544) return 8256 + (np - 6400);
    if (np < 14592) return 6144 + (np - 12544);
    return 14400 + (np - 14592);
}
__device__ void p0_transposes(KA a, float* lf) {
    bf16_t* WT = (bf16_t*)(a->ws + WS_WT); bf16_t* SW = (bf16_t*)(a->ws + WS_SW);
    const int NU_WT = (WT_ROWS / 64) * 16, NU_SW = 4 * 32 * 16;
    for (int u = blockIdx.x; u < NU_WT + NU_SW; u += gridDim.x) {
        if (u < NU_WT) { const int nb = u >> 4, kb = u & 15; transpose_unit(a->in[6], 18496, win_colmap(nb * 64), WT, nb, kb, lf); }
        else { const int v = u - NU_WT, mtx = v >> 9, nb = (v >> 4) & 31, kb = v & 15;
            const float* src = (mtx == 0) ? a->in[20] : (mtx == 1) ? a->in[21] : (mtx == 2) ? a->in[22] : a->in[25];
            transpose_unit(src, 2048, nb * 64, SW + (size_t)mtx * 2048 * 2048, nb, kb, lf); }
    }
}

__device__ void p1_ha(KA a) {
    const float* mod = (const float*)(a->ws + WS_MOD); bf16_t* HA = (bf16_t*)(a->ws + WS_HA);
    const size_t nthr = (size_t)gridDim.x * NT;
    for (size_t i = (size_t)blockIdx.x * NT + threadIdx.x; i < (size_t)MA * 256; i += nthr) {
        const int row = (int)(i >> 8), k8 = (int)(i & 255) * 8;
        const float* sp; int mr;
        if (row < MT) { sp = a->in[0] + (size_t)row * 2048 + k8; mr = row >> 12; } else { sp = a->in[2] + (size_t)(row - MT) * 2048 + k8; mr = 4; }
        const f32x4 x0 = *(const f32x4*)sp, x1 = *(const f32x4*)(sp + 4);
        const float* mp = mod + mr * 12288 + k8;
        const f32x4 h0 = *(const f32x4*)mp, h1 = *(const f32x4*)(mp + 4), s0 = *(const f32x4*)(mp + 2048), s1 = *(const f32x4*)(mp + 2052);
        float v[8];
#pragma unroll
        for (int e = 0; e < 4; ++e) { v[e] = x0[e] * (1.0f + s0[e]) + h0[e]; v[4 + e] = x1[e] * (1.0f + s1[e]) + h1[e]; }
        *(u32x4*)(HA + (size_t)row * 2048 + k8) = pack8(v);
    }
}

struct FStoreBf16 { bf16_t* O; int ldc;
    __device__ __forceinline__ void operator()(int row, int col, const f32x4 v0, const f32x4 v1) const {
        u32x4 w; w.x = pg8::cvt_pk_bf16(v0[0], v0[1]); w.y = pg8::cvt_pk_bf16(v0[2], v0[3]); w.z = pg8::cvt_pk_bf16(v1[0], v1[1]); w.w = pg8::cvt_pk_bf16(v1[2], v1[3]);
        *(u32x4*)(O + (size_t)row * ldc + col) = w; } };
struct FStoreQKV { bf16_t* PQ; float* AB;
    __device__ __forceinline__ void operator()(int row, int col, const f32x4 v0, const f32x4 v1) const {
        if (col < 6144) { u32x4 w; w.x = pg8::cvt_pk_bf16(v0[0], v0[1]); w.y = pg8::cvt_pk_bf16(v0[2], v0[3]); w.z = pg8::cvt_pk_bf16(v1[0], v1[1]); w.w = pg8::cvt_pk_bf16(v1[2], v1[3]);
            *(u32x4*)(PQ + (size_t)row * PQ_LD + col) = w; }
        else if (col < 6208) { float* p = AB + (size_t)row * 64 + (col - 6144); *(f32x4*)p = v0; *(f32x4*)(p + 4) = v1; } } };
struct FStoreF32 { float* O; int ldc;
    __device__ __forceinline__ void operator()(int row, int col, const f32x4 v0, const f32x4 v1) const { float* p = O + (size_t)row * ldc + col; *(f32x4*)p = v0; *(f32x4*)(p + 4) = v1; } };
struct FGatePA { const bf16_t* ZG; bf16_t* MG;
    __device__ __forceinline__ void operator()(int row, int col, const f32x4 v0, const f32x4 v1) const {
        float g[8]; unpack8(*(const u32x4*)(ZG + (size_t)row * NZG + 2048 + col), g);
        float o[8];
#pragma unroll
        for (int e = 0; e < 4; ++e) { o[e] = sigmoidf_(g[e]) * v0[e]; o[4 + e] = sigmoidf_(g[4 + e]) * v1[e]; }
        *(u32x4*)(MG + (size_t)row * 2048 + col) = pack8(o); } };
struct FGatePH { const bf16_t* ZG; bf16_t* MG;
    __device__ __forceinline__ void operator()(int row, int col, const f32x4 v0, const f32x4 v1) const {
        float g[8], t[8]; unpack8(*(const u32x4*)(ZG + (size_t)row * NZG + 4096 + col), g); unpack8(*(const u32x4*)(MG + (size_t)row * 2048 + col), t);
        float o[8];
#pragma unroll
        for (int e = 0; e < 4; ++e) { o[e] = t[e] + sigmoidf_(g[e]) * v0[e]; o[4 + e] = t[4 + e] + sigmoidf_(g[4 + e]) * v1[e]; }
        *(u32x4*)(MG + (size_t)row * 2048 + col) = pack8(o); } };
struct FOut { const float* x; const float* mod; float* T3;
    __device__ __forceinline__ void operator()(int row, int col, const f32x4 v0, const f32x4 v1) const {
        const float* xp = x + (size_t)row * 2048 + col; const float* gp = mod + (row >> 12) * 12288 + 4096 + col;
        const f32x4 x0 = *(const f32x4*)xp, x1 = *(const f32x4*)(xp + 4), g0 = *(const f32x4*)gp, g1 = *(const f32x4*)(gp + 4);
        float* p = T3 + (size_t)row * 2048 + col;
#if DBG_MODE == 1
        *(f32x4*)p = ALPHA * x0; *(f32x4*)(p + 4) = ALPHA * x1;
#else
        *(f32x4*)p = ALPHA * x0 + g0 * v0; *(f32x4*)(p + 4) = ALPHA * x1 + g1 * v1;
#endif
    } };

template <class F> __device__ __forceinline__ void run_gemm(unsigned char* lds, const bf16_t* A, const bf16_t* Bt, int M, int N, const F& f) {
    pg8::Gemm g{A, Bt, M, N, 2048}; pg8::StaticOrder S; S.init(M, N, (int)gridDim.x, (int)blockIdx.x);
    pg8::EpiGen<F> E{f};
    pg8::gemm_phase<pg8::EpiGen<F>, pg8::StaticOrder>((PG8_LAS unsigned char*)lds, g, S, E);
}

typedef float f32x2 __attribute__((ext_vector_type(2)));
constexpr int HY_Z = 0, HY_F = 69632, HY_TW4 = 139264, HY_TW8 = 141312, HY_TW32 = 143360, HY_W3 = 143488;
__device__ __forceinline__ f32x2 cmul(const f32x2 a, const f32x2 b) { return (f32x2){a.x * b.x - a.y * b.y, a.x * b.y + a.y * b.x}; }
__device__ __forceinline__ f32x2 cmulc(const f32x2 a, const f32x2 b) { return (f32x2){a.x * b.x + a.y * b.y, a.y * b.x - a.x * b.y}; }
template <bool INV> __device__ __forceinline__ f32x2 ctw(const f32x2 v, const float wr, const float wi) {
    return INV ? (f32x2){v.x * wr + v.y * wi, v.y * wr - v.x * wi} : (f32x2){v.x * wr - v.y * wi, v.y * wr + v.x * wi};
}
template <bool INV> __device__ __forceinline__ void dft16(f32x2 (&x)[16]) {
    constexpr float C = 0.9238795325112867f, S = 0.3826834323650898f, R = 0.7071067811865476f;
    f32x2 A[4][4];
#pragma unroll
    for (int q0 = 0; q0 < 4; ++q0) {
        const f32x2 a = x[q0], b = x[4 + q0], c = x[8 + q0], d = x[12 + q0];
        const f32x2 t0 = a + c, t1 = a - c, t2 = b + d, t3 = b - d;
        const f32x2 m = (f32x2){t3.y, -t3.x};
        A[q0][0] = t0 + t2; A[q0][2] = t0 - t2;
        A[q0][1] = INV ? (t1 - m) : (t1 + m); A[q0][3] = INV ? (t1 + m) : (t1 - m);
    }
    A[1][1] = ctw<INV>(A[1][1], C, -S); A[1][2] = ctw<INV>(A[1][2], R, -R); A[1][3] = ctw<INV>(A[1][3], S, -C);
    A[2][1] = ctw<INV>(A[2][1], R, -R); A[2][2] = ctw<INV>(A[2][2], 0.f, -1.f); A[2][3] = ctw<INV>(A[2][3], -R, -R);
    A[3][1] = ctw<INV>(A[3][1], S, -C); A[3][2] = ctw<INV>(A[3][2], -R, -R); A[3][3] = ctw<INV>(A[3][3], -C, S);
#pragma unroll
    for (int s = 0; s < 4; ++s) {
        const f32x2 t0 = A[0][s] + A[2][s], t1 = A[0][s] - A[2][s], t2 = A[1][s] + A[3][s], t3 = A[1][s] - A[3][s];
        const f32x2 m = (f32x2){t3.y, -t3.x};
        x[s] = t0 + t2; x[s + 8] = t0 - t2;
        x[s + 4] = INV ? (t1 - m) : (t1 + m); x[s + 12] = INV ? (t1 + m) : (t1 - m);
    }
}
template <bool INV> __device__ __forceinline__ void apply_tw(f32x2 (&x)[16], const f32x2 w) {
    f32x2 wr = w;
#pragma unroll
    for (int r = 1; r < 16; ++r) { x[r] = INV ? cmulc(x[r], wr) : cmul(x[r], wr); if (r < 15) wr = cmul(wr, w); }
}
__device__ __forceinline__ void fft_pass2_fwd(f32x2* B, int t, const f32x2* TW4) {
    const int base = 272 * (t >> 4) + (t & 15); f32x2 x[16];
#pragma unroll
    for (int q = 0; q < 16; ++q) x[q] = B[base + 17 * q];
    dft16<false>(x); apply_tw<false>(x, TW4[16 * (t & 15)]);
#pragma unroll
    for (int q = 0; q < 16; ++q) B[base + 17 * q] = x[q];
}
__device__ __forceinline__ void fft_pass2_inv(f32x2* B, int t, const f32x2* TW4) {
    const int base = 272 * (t >> 4) + (t & 15); f32x2 x[16];
#pragma unroll
    for (int q = 0; q < 16; ++q) x[q] = B[base + 17 * q];
    apply_tw<true>(x, TW4[16 * (t & 15)]); dft16<true>(x);
#pragma unroll
    for (int q = 0; q < 16; ++q) B[base + 17 * q] = x[q];
}
__device__ __forceinline__ float conv3_lane(float c, int lane, float w0, float w1, float w2) {
    float up = __shfl_up(c, 1, 64), dn = __shfl_down(c, 1, 64);
    up = (lane == 0) ? 0.f : up; dn = (lane == 63) ? 0.f : dn;
    return w0 * up + w1 * c + w2 * dn;
}
__device__ void hyena_setup(unsigned char* lds) {
    const int tid = threadIdx.x;
    f32x2* TW4 = (f32x2*)(lds + HY_TW4); f32x2* TW8 = (f32x2*)(lds + HY_TW8); f32x2* TW32 = (f32x2*)(lds + HY_TW32);
    if (tid < 256) { const float a4 = -6.283185307179586f * (float)tid * (1.0f / 4096.0f), a8 = -6.283185307179586f * (float)tid * (1.0f / 8192.0f);
        TW4[tid] = (f32x2){cosf(a4), sinf(a4)}; TW8[tid] = (f32x2){cosf(a8), sinf(a8)}; }
    if (tid < 16) { const float a = -6.283185307179586f * (float)tid * (1.0f / 32.0f); TW32[tid] = (f32x2){cosf(a), sinf(a)}; }
    __syncthreads();
}
struct HyCtx { f32x2* Z; f32x2* Fb0; const f32x2* TW4; const f32x2* TW32; const bf16_t* rv; const bf16_t* rx1; const bf16_t* rx2; bf16_t* YTc; float* Y1S;
    f32x2 w8t, w4t; float cv0, cv1, cv2, cx0, cx1, cx2, cy0, cy1, cy2, sk0, sk1; int tid, br, t, lane, p1; };
template <int ORDER> __device__ __forceinline__ void hyena_conv(const HyCtx& K, int pr) {
    f32x2* Z = K.Z; const f32x2* TW4 = K.TW4; const f32x2* TW32 = K.TW32;
    const bf16_t* rv = K.rv; const bf16_t* rx1 = K.rx1; const bf16_t* rx2 = K.rx2; float* Y1S = K.Y1S;
    int tid = K.tid; asm volatile("" : "+v"(tid));
    const f32x2 w8t = K.w8t, w4t = K.w4t; const int br = tid >> 8, t = tid & 255, lane = tid & 63, p1 = t + (t >> 4);
    f32x2* Zb = K.Z + br * 4352; f32x2* Fb = K.Fb0 + br * 4352;
    const float cv0 = K.cv0, cv1 = K.cv1, cv2 = K.cv2, cx0 = K.cx0, cx1 = K.cx1, cx2 = K.cx2, cy0 = K.cy0, cy1 = K.cy1, cy2 = K.cy2, sk0 = K.sk0, sk1 = K.sk1;
        const int ba = 2 * pr * 4096, bb = ba + 4096;
        {
            f32x2 x[16];
#pragma unroll
            for (int q = 0; q < 16; ++q) {
                const int n = t + 256 * q; float ua, ub;
                if (ORDER == 0) { ua = conv3_lane(bf2f(rv[ba + n]), lane, cv0, cv1, cv2); ub = conv3_lane(bf2f(rv[bb + n]), lane, cv0, cv1, cv2); }
                else { ua = Y1S[n]; ub = Y1S[4096 + n]; }
                const f32x2 z = (f32x2){ua, ub};
                x[q] = br ? cmul(z, cmul(w8t, TW32[q])) : z;
            }
            dft16<false>(x); apply_tw<false>(x, w4t);
#pragma unroll
            for (int q = 0; q < 16; ++q) Zb[p1 + 272 * q] = x[q];
        }
        __syncthreads();
        fft_pass2_fwd(Zb, t, TW4);
        __syncthreads();
        {
            f32x2 x[16];
#pragma unroll
            for (int q = 0; q < 16; ++q) x[q] = Zb[17 * t + q];
            dft16<false>(x);
#pragma unroll
            for (int r = 0; r < 16; ++r) {
                const int p = 16 * t + r; int pp;
                if (br) pp = 4095 - p;
                else { const int m = (r << 8) | ((t & 15) << 4) | (t >> 4); const int mp = (4096 - m) & 4095; pp = ((mp & 15) << 8) | (mp & 0xF0) | (mp >> 8); }
                const f32x2 fk = Fb[p + (p >> 4)], fc = Fb[pp + (pp >> 4)];
                f32x2 H;
                if (ORDER == 0) H = (f32x2){0.5f * (fk.x + fc.x), 0.5f * (fk.y - fc.y)};
                else H = (f32x2){0.5f * (fk.y + fc.y), -0.5f * (fk.x - fc.x)};
                x[r] = cmul(x[r], H);
            }
            dft16<true>(x);
#pragma unroll
            for (int q = 0; q < 16; ++q) Zb[17 * t + q] = x[q];
        }
        __syncthreads();
        fft_pass2_inv(Zb, t, TW4);
        __syncthreads();
        {
            f32x2 x[16];
#pragma unroll
            for (int q = 0; q < 16; ++q) x[q] = Zb[p1 + 272 * q];
            apply_tw<true>(x, w4t); dft16<true>(x);
            if (br) {
#pragma unroll
                for (int q = 0; q < 16; ++q) x[q] = cmulc(x[q], cmul(w8t, TW32[q]));
            }
#pragma unroll
            for (int q = 0; q < 16; ++q) Zb[p1 + 272 * q] = x[q];
        }
        __syncthreads();
#pragma unroll
        for (int i = 0; i < 8; ++i) {
            const int n = tid + i * NT, pn = n + (n >> 4);
            const f32x2 e0 = Z[pn], e1 = Z[4352 + pn];
            const float ca = (e0.x + e1.x) * (1.0f / 8192.0f), cb = (e0.y + e1.y) * (1.0f / 8192.0f);
            if (ORDER == 0) {
                const float va = conv3_lane(bf2f(rv[ba + n]), lane, cv0, cv1, cv2), vb = conv3_lane(bf2f(rv[bb + n]), lane, cv0, cv1, cv2);
                const float xa = conv3_lane(bf2f(rx1[ba + n]), lane, cx0, cx1, cx2), xb = conv3_lane(bf2f(rx1[bb + n]), lane, cx0, cx1, cx2);
                Y1S[n] = xa * (ca + sk0 * va); Y1S[4096 + n] = xb * (cb + sk0 * vb);
            } else {
                const float ya = Y1S[n], yb = Y1S[4096 + n];
                const float xa = conv3_lane(bf2f(rx2[ba + n]), lane, cy0, cy1, cy2), xb = conv3_lane(bf2f(rx2[bb + n]), lane, cy0, cy1, cy2);
                K.YTc[ba + n] = (bf16_t)f2bf(xa * (ca + sk1 * ya)); K.YTc[bb + n] = (bf16_t)f2bf(xb * (cb + sk1 * yb));
            }
        }
        __syncthreads();
}
__device__ void hyena_item(KA a, int c, unsigned char* lds) {
    f32x2* Z = (f32x2*)(lds + HY_Z); f32x2* F = (f32x2*)(lds + HY_F);
    const f32x2* TW4 = (const f32x2*)(lds + HY_TW4); const f32x2* TW8 = (const f32x2*)(lds + HY_TW8); const f32x2* TW32 = (const f32x2*)(lds + HY_TW32);
    float* W3 = (float*)(lds + HY_W3);
    int tid = threadIdx.x; asm volatile("" : "+v"(tid));
    const int br = tid >> 8, t = tid & 255, lane = tid & 63;
    f32x2* Zb = Z + br * 4352; f32x2* Fb = F + br * 4352;
    const float* hid2 = (const float*)(a->ws + WS_HID2);
    const float* w3 = a->in[16]; const float* b3 = a->in[17]; const float* cw = a->in[11]; const float* skip = a->in[19];
    const bf16_t* PHT = (const bf16_t*)(a->ws + WS_RA);
    bf16_t* YT = (bf16_t*)a->out;
    float* Y1S = a->out + (size_t)16 * 1024 * 1024 + (size_t)blockIdx.x * 16384;
    if (tid < 256) { const int q = tid >> 6, j = tid & 63; W3[q * 64 + j] = w3[(size_t)j * 8192 + (q >> 1) * 4096 + (q & 1) * 2048 + c]; }
    __syncthreads();
    {
        const float delta = 3.0701134573253944f + 12.280453829301578f * ((float)c * (1.0f / 2047.0f));
        float bq[4];
#pragma unroll
        for (int q = 0; q < 4; ++q) bq[q] = b3[(q >> 1) * 4096 + (q & 1) * 2048 + c];
#pragma unroll 1
        for (int i = 0; i < 8; ++i) {
            const int d = tid + i * NT;
            const f32x4* hp = (const f32x4*)(hid2 + d * 64);
            float f0 = 0.f, f1 = 0.f, f2 = 0.f, f3 = 0.f;
#pragma unroll 4
            for (int j4 = 0; j4 < 16; ++j4) {
                const f32x4 hv = hp[j4];
#pragma unroll
                for (int e = 0; e < 4; ++e) { const int j = j4 * 4 + e; f0 += hv[e] * W3[j]; f1 += hv[e] * W3[64 + j]; f2 += hv[e] * W3[128 + j]; f3 += hv[e] * W3[192 + j]; }
            }
            const float win = expf(-((float)d * (1.0f / 4095.0f)) * delta);
            Z[d] = (f32x2){(f0 + bq[0]) * win, (f1 + bq[1]) * win};
            Z[4096 + d] = (f32x2){(f2 + bq[2]) * win, (f3 + bq[3]) * win};
        }
    }
    __syncthreads();
    const f32x2 w8t = TW8[t], w4t = TW4[t];
    const int p1 = t + (t >> 4);
    {
        f32x2 x[16];
#pragma unroll
        for (int q = 0; q < 16; ++q) {
            const int n = t + 256 * q;
            const f32x2 av = Z[n]; f32x2 bv = Z[8192 - (n ? n : 1)]; if (n == 0) bv = (f32x2){0.f, 0.f};
            x[q] = br ? cmul(av - bv, cmul(w8t, TW32[q])) : (av + bv);
        }
        dft16<false>(x); apply_tw<false>(x, w4t);
#pragma unroll
        for (int q = 0; q < 16; ++q) Fb[p1 + 272 * q] = x[q];
    }
    __syncthreads();
    fft_pass2_fwd(Fb, t, TW4);
    __syncthreads();
    {   f32x2 x[16];
#pragma unroll
        for (int q = 0; q < 16; ++q) x[q] = Fb[17 * t + q];
        dft16<false>(x);
#pragma unroll
        for (int q = 0; q < 16; ++q) Fb[17 * t + q] = x[q];
    }
    __syncthreads();
    const float cv0 = cw[c], cv1 = cw[6144 + c], cv2 = cw[12288 + c];
    const float cx0 = cw[2048 + c], cx1 = cw[6144 + 2048 + c], cx2 = cw[12288 + 2048 + c];
    const float cy0 = cw[4096 + c], cy1 = cw[6144 + 4096 + c], cy2 = cw[12288 + 4096 + c];
    const float sk0 = skip[c], sk1 = skip[2048 + c];
    const bf16_t* rv = PHT + (size_t)c * MT; const bf16_t* rx1 = PHT + (size_t)(2048 + c) * MT; const bf16_t* rx2 = PHT + (size_t)(4096 + c) * MT;
    HyCtx K; K.Z = Z; K.Fb0 = F; K.TW4 = TW4; K.TW32 = TW32; K.rv = rv; K.rx1 = rx1; K.rx2 = rx2; K.YTc = YT + (size_t)c * MT; K.Y1S = Y1S;
    K.w8t = w8t; K.w4t = w4t; K.cv0 = cv0; K.cv1 = cv1; K.cv2 = cv2; K.cx0 = cx0; K.cx1 = cx1; K.cx2 = cx2; K.cy0 = cy0; K.cy1 = cy1; K.cy2 = cy2; K.sk0 = sk0; K.sk1 = sk1;
    K.tid = tid; K.br = br; K.t = t; K.lane = lane; K.p1 = p1;
#pragma unroll 1
    for (int pr = 0; pr < 2; ++pr) { hyena_conv<0>(K, pr); hyena_conv<1>(K, pr); }
}

__device__ void qkvpost_unit(KA a, int unit, unsigned char* lds) {
    const int tid = threadIdx.x;
    int ntok, row0, wh;
    if (unit < 12288) { const int gr = unit / 48; wh = unit % 48; ntok = 64; row0 = gr * 64; }
    else { const int uu = unit - 12288; const int b = uu / 48; wh = uu % 48; ntok = 256; row0 = MT + b * 256; }
    const int which = wh >> 4, h = wh & 15, colbase = which * 2048 + h * 128;
    bf16_t* PQ = (bf16_t*)(a->ws + WS_RB);
    bf16_t* raw = (bf16_t*)lds; float* wl = (float*)(lds + 65536);
    const float* cwt = a->in[7];
    for (int i = tid; i < ntok * 16; i += NT) { const int r = i >> 4, c8 = i & 15; *(u32x4*)(raw + r * 128 + c8 * 8) = *(const u32x4*)(PQ + (size_t)(row0 + r) * PQ_LD + colbase + c8 * 8); }
    for (int i = tid; i < 640; i += NT) wl[i] = cwt[(i >> 7) * 6144 + colbase + (i & 127)];
    __syncthreads();
    const int r = tid >> 3, cg = tid & 7;
    for (int rb = 0; rb < ntok / 64; ++rb) {
        const int tok = rb * 64 + r;
        float v[16]; float ss = 0.f;
#pragma unroll
        for (int e = 0; e < 16; ++e) {
            const int ch = cg * 16 + e; float acc = 0.f;
#pragma unroll
            for (int j = 0; j < 5; ++j) { const int tt = tok + j - 2; if (tt >= 0 && tt < ntok) acc += wl[j * 128 + ch] * bf2f(raw[tt * 128 + ch]); }
            const float s = siluf_(acc); v[e] = s; ss += s * s;
        }
        if (which < 2) {
            ss += __shfl_xor(ss, 1, 64); ss += __shfl_xor(ss, 2, 64); ss += __shfl_xor(ss, 4, 64);
            const float sc = rsqrtf(ss + 1e-6f) * (which == 0 ? 0.08838834764831845f : 1.0f);
#pragma unroll
            for (int e = 0; e < 16; ++e) v[e] *= sc;
        }
        bf16_t* op = PQ + (size_t)(row0 + tok) * PQ_LD + colbase + cg * 16;
        u32x4 w0, w1;
        w0.x = pk2(v[0], v[1]); w0.y = pk2(v[2], v[3]); w0.z = pk2(v[4], v[5]); w0.w = pk2(v[6], v[7]);
        w1.x = pk2(v[8], v[9]); w1.y = pk2(v[10], v[11]); w1.z = pk2(v[12], v[13]); w1.w = pk2(v[14], v[15]);
        *(u32x4*)op = w0; *(u32x4*)(op + 8) = w1;
    }
    __syncthreads();
}

__device__ void delta_item(KA a, int item, float* lf) {
    const int tid = threadIdx.x, dv = tid & 63, kg = tid >> 6;
    const int dvh = item & 1, dir = (item >> 1) & 1, h = (item >> 2) & 15, b = item >> 6;
    float* qs = lf; float* ks = lf + 8192; float* vs = lf + 16384; float* gs = lf + 20480; float* bs = lf + 20544; float* red = lf + 20608; float* ob = lf + 22656;
    const bf16_t* PQ = (const bf16_t*)(a->ws + WS_RB); const float* AB = (const float*)(a->ws + WS_AB);
    bf16_t* O = (bf16_t*)(a->ws + WS_RA) + (size_t)dir * MT * 2048;
    const float Aexp = expf(a->in[8][dir * 16 + h]); const float dtb = a->in[9][dir * 16 + h];
    float S[16];
#pragma unroll
    for (int j = 0; j < 16; ++j) S[j] = 0.f;
    for (int seg = 0; seg < 2; ++seg) {
        const int T = seg ? SEQ : CTXL; const int rbase = seg ? b * SEQ : MT + b * CTXL;
        for (int ch = 0; ch < T / 64; ++ch) {
            __syncthreads();
            {
                const int i = tid >> 3, p = ch * 64 + i, tok = dir ? (T - 1 - p) : p; const size_t row = (size_t)(rbase + tok);
                const int c0 = (tid & 7) * 16;
                const bf16_t* qp = PQ + row * PQ_LD + h * 128 + c0;
                float t8[8];
                unpack8(*(const u32x4*)qp, t8);
#pragma unroll
                for (int e = 0; e < 8; ++e) qs[i * 128 + c0 + e] = t8[e];
                unpack8(*(const u32x4*)(qp + 8), t8);
#pragma unroll
                for (int e = 0; e < 8; ++e) qs[i * 128 + c0 + 8 + e] = t8[e];
                unpack8(*(const u32x4*)(qp + 2048), t8);
#pragma unroll
                for (int e = 0; e < 8; ++e) ks[i * 128 + c0 + e] = t8[e];
                unpack8(*(const u32x4*)(qp + 2048 + 8), t8);
#pragma unroll
                for (int e = 0; e < 8; ++e) ks[i * 128 + c0 + 8 + e] = t8[e];
                const int c0v = (tid & 7) * 8;
                unpack8(*(const u32x4*)(PQ + row * PQ_LD + 4096 + h * 128 + dvh * 64 + c0v), t8);
#pragma unroll
                for (int e = 0; e < 8; ++e) vs[i * 64 + c0v + e] = t8[e];
                if ((tid & 7) == 0) {
                    const float ab0 = AB[row * 64 + dir * 32 + h], ab1 = AB[row * 64 + dir * 32 + 16 + h];
                    const float xx = ab0 + dtb; const float sp = (xx > 20.0f) ? xx : log1pf(expf(xx));
                    gs[i] = expf(-Aexp * sp); bs[i] = sigmoidf_(ab1);
                }
            }
            __syncthreads();
            {
                float pr = 0.f;
#pragma unroll
                for (int j = 0; j < 16; ++j) pr += ks[kg * 16 + j] * S[j];
                red[(0 * 2 + 0) * 512 + kg * 64 + dv] = pr;
            }
            __syncthreads();
            for (int i = 0; i < 64; ++i) {
                const int buf = i & 1;
                const float* rr = red + (buf * 2 + 0) * 512 + dv;
                const float r = ((rr[0] + rr[64]) + (rr[128] + rr[192])) + ((rr[256] + rr[320]) + (rr[384] + rr[448]));
                if (i > 0 && kg == 0) { const float* ro = red + (buf * 2 + 1) * 512 + dv;
                    ob[(i - 1) * 64 + dv] = ((ro[0] + ro[64]) + (ro[128] + ro[192])) + ((ro[256] + ro[320]) + (ro[384] + ro[448])); }
                const float eg = gs[i], coef = bs[i] * (vs[i * 64 + dv] - eg * r);
                float po = 0.f, pr = 0.f;
                const float* kp = ks + i * 128 + kg * 16; const float* qp = qs + i * 128 + kg * 16; const float* kn = ks + ((i + 1) & 63) * 128 + kg * 16;
#pragma unroll
                for (int j = 0; j < 16; ++j) { S[j] = eg * S[j] + kp[j] * coef; po += qp[j] * S[j]; pr += kn[j] * S[j]; }
                red[((buf ^ 1) * 2 + 0) * 512 + kg * 64 + dv] = pr;
                red[((buf ^ 1) * 2 + 1) * 512 + kg * 64 + dv] = po;
                __syncthreads();
            }
            if (kg == 0) { const float* ro = red + (0 * 2 + 1) * 512 + dv;
                ob[63 * 64 + dv] = ((ro[0] + ro[64]) + (ro[128] + ro[192])) + ((ro[256] + ro[320]) + (ro[384] + ro[448])); }
            __syncthreads();
            if (seg == 1) {
                const int i = tid >> 3, c8 = (tid & 7) * 8, p = ch * 64 + i, tok = dir ? (T - 1 - p) : p;
                float o8[8];
#pragma unroll
                for (int e = 0; e < 8; ++e) o8[e] = ob[i * 64 + c8 + e];
                *(u32x4*)(O + (size_t)(b * SEQ + tok) * 2048 + h * 128 + dvh * 64 + c8) = pack8(o8);
            }
        }
    }
    __syncthreads();
}

__device__ void ytrans_unit(const bf16_t* YT, bf16_t* Y, int unit, bf16_t* tile) {
    const int tid = threadIdx.x, cb = unit & 31, tb = unit >> 5, r = tid >> 3, c8 = (tid & 7) * 8;
    *(u32x4*)(tile + r * 72 + c8) = *(const u32x4*)(YT + (size_t)(cb * 64 + r) * MT + tb * 64 + c8);
    __syncthreads();
    u32x4 w;
    w.x = (unsigned)tile[(c8 + 0) * 72 + r] | ((unsigned)tile[(c8 + 1) * 72 + r] << 16);
    w.y = (unsigned)tile[(c8 + 2) * 72 + r] | ((unsigned)tile[(c8 + 3) * 72 + r] << 16);
    w.z = (unsigned)tile[(c8 + 4) * 72 + r] | ((unsigned)tile[(c8 + 5) * 72 + r] << 16);
    w.w = (unsigned)tile[(c8 + 6) * 72 + r] | ((unsigned)tile[(c8 + 7) * 72 + r] << 16);
    *(u32x4*)(Y + (size_t)(tb * 64 + r) * 2048 + cb * 64 + c8) = w;
    __syncthreads();
}

__device__ void p6_on(KA a) {
    const bf16_t* OF = (const bf16_t*)(a->ws + WS_RA); const bf16_t* OB = OF + (size_t)MT * 2048;
    const bf16_t* ZG = (const bf16_t*)(a->ws + WS_RB); bf16_t* ON = (bf16_t*)(a->ws + WS_HA);
    const float* nw = a->in[10];
    const size_t nthr = (size_t)gridDim.x * NT;
    for (size_t i = (size_t)blockIdx.x * NT + threadIdx.x; i < (size_t)MT * 256; i += nthr) {
        const int row = (int)(i >> 8), c8 = (int)(i & 255) * 8;
        float f[8], g[8], z[8];
        unpack8(*(const u32x4*)(OF + (size_t)row * 2048 + c8), f); unpack8(*(const u32x4*)(OB + (size_t)row * 2048 + c8), g);
        unpack8(*(const u32x4*)(ZG + (size_t)row * NZG + c8), z);
        float ss = 0.f;
#pragma unroll
        for (int e = 0; e < 8; ++e) { f[e] += g[e]; ss += f[e] * f[e]; }
        ss += __shfl_xor(ss, 1, 64); ss += __shfl_xor(ss, 2, 64); ss += __shfl_xor(ss, 4, 64); ss += __shfl_xor(ss, 8, 64);
        const float rs = rsqrtf(ss * (1.0f / 128.0f) + 1e-6f);
        float o[8];
#pragma unroll
        for (int e = 0; e < 8; ++e) o[e] = f[e] * rs * nw[(c8 & 127) + e] * siluf_(z[e]);
        *(u32x4*)(ON + (size_t)row * 2048 + c8) = pack8(o);
    }
}

__device__ void p8_tables(KA a) {
    bf16_t* U16 = (bf16_t*)(a->ws + WS_RA); bf16_t* V16 = U16 + (size_t)MT * 2048;
    const size_t nthr = (size_t)gridDim.x * NT, n8 = (size_t)16384 * 256;
    for (size_t i = (size_t)blockIdx.x * NT + threadIdx.x; i < 2 * n8; i += nthr) {
        const size_t j = (i < n8) ? i : i - n8; const float* sp = ((i < n8) ? a->in[27] : a->in[28]) + j * 8;
        const f32x4 x0 = *(const f32x4*)sp, x1 = *(const f32x4*)(sp + 4);
        u32x4 w; w.x = pk2(x0[0], x0[1]); w.y = pk2(x0[2], x0[3]); w.z = pk2(x1[0], x1[1]); w.w = pk2(x1[2], x1[3]);
        *(u32x4*)(((i < n8) ? U16 : V16) + j * 8) = w;
    }
}

__device__ void p9_ln1(KA a) {
    const float* mod = (const float*)(a->ws + WS_MOD); bf16_t* H2 = (bf16_t*)(a->ws + WS_RA) + (size_t)2 * MT * 2048;
    const float* g = a->in[23]; const float* bb = a->in[24];
    const int lane = threadIdx.x & 63, wv = blockIdx.x * 8 + (threadIdx.x >> 6), nwv = gridDim.x * 8;
    for (int row = wv; row < MT; row += nwv) {
        float* rp = a->out + (size_t)row * 2048;
        float v[32]; float s = 0.f;
#pragma unroll
        for (int i = 0; i < 4; ++i) { const f32x4 x0 = *(const f32x4*)(rp + i * 512 + lane * 8), x1 = *(const f32x4*)(rp + i * 512 + lane * 8 + 4);
#pragma unroll
            for (int e = 0; e < 4; ++e) { v[i * 8 + e] = x0[e]; v[i * 8 + 4 + e] = x1[e]; s += x0[e] + x1[e]; } }
        const float mu = wave_sum(s) * (1.0f / 2048.0f);
        float q = 0.f;
#pragma unroll
        for (int e = 0; e < 32; ++e) { const float d = v[e] - mu; q += d * d; }
        const float rstd = rsqrtf(wave_sum(q) * (1.0f / 2048.0f) + 1e-5f);
        const float* mp = mod + (row >> 12) * 12288;
#pragma unroll
        for (int i = 0; i < 4; ++i) {
            const int col = i * 512 + lane * 8;
            float xn[8], h[8];
#pragma unroll
            for (int e = 0; e < 8; ++e) { xn[e] = (v[i * 8 + e] - mu) * rstd * g[col + e] + bb[col + e]; h[e] = xn[e] * (1.0f + mp[8192 + col + e]) + mp[6144 + col + e]; }
            *(f32x4*)(rp + col) = (f32x4){xn[0], xn[1], xn[2], xn[3]}; *(f32x4*)(rp + col + 4) = (f32x4){xn[4], xn[5], xn[6], xn[7]};
            *(u32x4*)(H2 + (size_t)row * 2048 + col) = pack8(h);
        }
    }
}

__device__ __forceinline__ void topk16_2(float v0, float v1, int lane, float& rs, int& ri) {
    rs = -INFINITY; ri = 0;
    for (int it = 0; it < 16; ++it) {
        const float wm = wave_max(fmaxf(v0, v1));
        const unsigned long long b0 = __ballot(v0 == wm), b1 = __ballot(v1 == wm);
        int key;
        if (b0) { const int l = __ffsll((long long)b0) - 1; key = l; if (lane == l) v0 = -INFINITY; }
        else { const int l = __ffsll((long long)b1) - 1; key = 64 + l; if (lane == l) v1 = -INFINITY; }
        if (lane == it) { rs = wm; ri = key; }
    }
}
__device__ __forceinline__ void topk16_4(float c0, float c1, float c2, float c3, int lane, float& rs, int& ri) {
    rs = -INFINITY; ri = 0;
    for (int it = 0; it < 16; ++it) {
        const float wm = wave_max(fmaxf(fmaxf(c0, c1), fmaxf(c2, c3)));
        const unsigned long long b0 = __ballot(c0 == wm), b1 = __ballot(c1 == wm), b2 = __ballot(c2 == wm), b3 = __ballot(c3 == wm);
        const unsigned long long ball = b0 | b1 | b2 | b3;
        const int l = __ffsll((long long)ball) - 1;
        const int r = ((b0 >> l) & 1ull) ? 0 : ((b1 >> l) & 1ull) ? 1 : ((b2 >> l) & 1ull) ? 2 : 3;
        if (lane == l) { if (r == 0) c0 = -INFINITY; else if (r == 1) c1 = -INFINITY; else if (r == 2) c2 = -INFINITY; else c3 = -INFINITY; }
        if (lane == it) { rs = wm; ri = l * 4 + r; }
    }
}
__device__ void peer_unit(KA a, int unit, unsigned char* lds) {
    const int tid = threadIdx.x, lane = tid & 63, wid = tid >> 6;
    float* SK = (float*)lds; float* QT = (float*)(lds + 66048); float* SC = (float*)(lds + 82432);
    int* IGI = (int*)(lds + 98816); float* IGG = (float*)(lds + 115200);
    const int tok0 = unit * 32;
    const float* Qp = (const float*)(a->ws + WS_RB); const float* subk = a->in[26];
    const bf16_t* U16 = (const bf16_t*)(a->ws + WS_RA); const bf16_t* V16 = U16 + (size_t)MT * 2048; const bf16_t* H2 = V16 + (size_t)MT * 2048;
    const float* mod = (const float*)(a->ws + WS_MOD);
    for (int h = 0; h < 8; ++h) {
        float tps[2][4]; int tpi[2][4];
#pragma unroll
        for (int p = 0; p < 2; ++p) {
            __syncthreads();
            for (int i = tid; i < 128 * 32; i += NT) { const int key = i >> 5, d4 = (i & 31) * 4; const f32x4 v = *(const f32x4*)(subk + (size_t)((h * 2 + p) * 128 + key) * 128 + d4);
                float* t = SK + key * 129 + d4; t[0] = v.x; t[1] = v.y; t[2] = v.z; t[3] = v.w; }
            for (int i = tid; i < 32 * 32; i += NT) { const int r = i >> 5, d4 = (i & 31) * 4; *(f32x4*)(QT + r * 128 + d4) = *(const f32x4*)(Qp + (size_t)(tok0 + r) * 2048 + h * 256 + p * 128 + d4); }
            __syncthreads();
            {
                const int key = tid & 127, tg = tid >> 7;
                float s[8];
#pragma unroll
                for (int e = 0; e < 8; ++e) s[e] = 0.f;
                for (int d4 = 0; d4 < 32; ++d4) {
                    const float* sp = SK + key * 129 + d4 * 4; const float k0 = sp[0], k1 = sp[1], k2 = sp[2], k3 = sp[3];
#pragma unroll
                    for (int e = 0; e < 8; ++e) { const f32x4 q = *(const f32x4*)(QT + (tg * 8 + e) * 128 + d4 * 4); s[e] += (k0 * q.x + k1 * q.y) + (k2 * q.z + k3 * q.w); }
                }
#pragma unroll
                for (int e = 0; e < 8; ++e) SC[(tg * 8 + e) * 128 + key] = s[e];
            }
            __syncthreads();
#pragma unroll
            for (int rr = 0; rr < 4; ++rr) { const int row = wid * 4 + rr; topk16_2(SC[row * 128 + lane], SC[row * 128 + 64 + lane], lane, tps[p][rr], tpi[p][rr]); }
        }
#pragma unroll
        for (int rr = 0; rr < 4; ++rr) {
            const int row = wid * 4 + rr;
            const float s0 = __shfl(tps[0][rr], lane >> 2, 64);
            const float c0 = s0 + __shfl(tps[1][rr], 4 * (lane & 3) + 0, 64), c1 = s0 + __shfl(tps[1][rr], 4 * (lane & 3) + 1, 64),
                        c2 = s0 + __shfl(tps[1][rr], 4 * (lane & 3) + 2, 64), c3 = s0 + __shfl(tps[1][rr], 4 * (lane & 3) + 3, 64);
            float bs; int bc; topk16_4(c0, c1, c2, c3, lane, bs, bc);
            const int e0 = __shfl(tpi[0][rr], (bc >> 4) & 15, 64), e1 = __shfl(tpi[1][rr], bc & 15, 64);
            const float mx = __shfl(bs, 0, 64);
            const float ex = (lane < 16) ? expf(bs - mx) : 0.f;
            const float sm = wave_sum(ex);
            if (lane < 16) { IGI[row * 128 + h * 16 + lane] = e0 * 128 + e1; IGG[row * 128 + h * 16 + lane] = ex / sm; }
        }
    }
    __syncthreads();
    for (int rr = 0; rr < 4; ++rr) {
        const int row = wid * 4 + rr, tok = tok0 + row;
        float hx[32], y[32];
#pragma unroll
        for (int i = 0; i < 4; ++i) { float t8[8]; unpack8(*(const u32x4*)(H2 + (size_t)tok * 2048 + i * 512 + lane * 8), t8);
#pragma unroll
            for (int e = 0; e < 8; ++e) { hx[i * 8 + e] = t8[e]; y[i * 8 + e] = 0.f; } }
#if DBG_MODE != 2
#pragma unroll 2
        for (int e = 0; e < 128; ++e) {
            const int idx = __builtin_amdgcn_readfirstlane(IGI[row * 128 + e]); const float gt = IGG[row * 128 + e];
            const bf16_t* up = U16 + (size_t)idx * 2048 + lane * 8; const bf16_t* vp = V16 + (size_t)idx * 2048 + lane * 8;
            const u32x4 u0 = *(const u32x4*)up, u1 = *(const u32x4*)(up + 512), u2 = *(const u32x4*)(up + 1024), u3 = *(const u32x4*)(up + 1536);
            const u32x4 v0 = *(const u32x4*)vp, v1 = *(const u32x4*)(vp + 512), v2 = *(const u32x4*)(vp + 1024), v3 = *(const u32x4*)(vp + 1536);
            float t8[8]; float dot = 0.f;
            unpack8(u0, t8);
#pragma unroll
            for (int k = 0; k < 8; ++k) dot += t8[k] * hx[k];
            unpack8(u1, t8);
#pragma unroll
            for (int k = 0; k < 8; ++k) dot += t8[k] * hx[8 + k];
            unpack8(u2, t8);
#pragma unroll
            for (int k = 0; k < 8; ++k) dot += t8[k] * hx[16 + k];
            unpack8(u3, t8);
#pragma unroll
            for (int k = 0; k < 8; ++k) dot += t8[k] * hx[24 + k];
            dot = wave_sum(dot);
            const float cf = gt * 0.5f * dot * (1.0f + erff(dot * 0.7071067811865476f));
            unpack8(v0, t8);
#pragma unroll
            for (int k = 0; k < 8; ++k) y[k] += cf * t8[k];
            unpack8(v1, t8);
#pragma unroll
            for (int k = 0; k < 8; ++k) y[8 + k] += cf * t8[k];
            unpack8(v2, t8);
#pragma unroll
            for (int k = 0; k < 8; ++k) y[16 + k] += cf * t8[k];
            unpack8(v3, t8);
#pragma unroll
            for (int k = 0; k < 8; ++k) y[24 + k] += cf * t8[k];
        }
#endif
        float* rp = a->out + (size_t)tok * 2048; const float* mp = mod + (tok >> 12) * 12288 + 10240;
        float val[32]; float s = 0.f;
#pragma unroll
        for (int i = 0; i < 4; ++i) { const int col = i * 512 + lane * 8; const f32x4 x0 = *(const f32x4*)(rp + col), x1 = *(const f32x4*)(rp + col + 4);
#pragma unroll
            for (int e = 0; e < 4; ++e) { val[i * 8 + e] = ALPHA * x0[e] + mp[col + e] * y[i * 8 + e]; val[i * 8 + 4 + e] = ALPHA * x1[e] + mp[col + 4 + e] * y[i * 8 + 4 + e]; s += val[i * 8 + e] + val[i * 8 + 4 + e]; } }
        const float mu = wave_sum(s) * (1.0f / 2048.0f);
        float q = 0.f;
#pragma unroll
        for (int e = 0; e < 32; ++e) { const float d = val[e] - mu; q += d * d; }
        const float rstd = rsqrtf(wave_sum(q) * (1.0f / 2048.0f) + 1e-5f);
        const float* g = a->in[29]; const float* bb = a->in[30];
#pragma unroll
        for (int i = 0; i < 4; ++i) { const int col = i * 512 + lane * 8; float o[8];
#pragma unroll
            for (int e = 0; e < 8; ++e) o[e] = (val[i * 8 + e] - mu) * rstd * g[col + e] + bb[col + e];
            *(f32x4*)(rp + col) = (f32x4){o[0], o[1], o[2], o[3]}; *(f32x4*)(rp + col + 4) = (f32x4){o[4], o[5], o[6], o[7]}; }
    }
    __syncthreads();
}

__global__ void __launch_bounds__(NT, 2) fwd_mega(Args a_) {
    KA a = (KA)__builtin_amdgcn_kernarg_segment_ptr();
    extern __shared__ __attribute__((aligned(16))) unsigned char lds[];
    cg::grid_group grid = cg::this_grid();
    float* lf = (float*)lds;
    const int lo = a->ph_lo, hi = a->ph_hi;
#define IN(k) (lo <= (k) && (k) < hi)
#define SEAM(k) do { if (IN(k) && IN((k) + 1)) grid.sync(); asm volatile("" : "+s"(a)); } while (0)
    unsigned char* ws = a->ws;
    bf16_t* HA = (bf16_t*)(ws + WS_HA); bf16_t* WT = (bf16_t*)(ws + WS_WT); bf16_t* SW = (bf16_t*)(ws + WS_SW);
    bf16_t* RA = (bf16_t*)(ws + WS_RA); bf16_t* RB = (bf16_t*)(ws + WS_RB);
    const float* mod = (const float*)(ws + WS_MOD);

    if (IN(0)) { p0_mod_hid2(a, lf); p0_transposes(a, lf); }
    SEAM(0);
    if (IN(1)) { p1_ha(a); }
    SEAM(1);
    if (IN(2)) {
        run_gemm(lds, WT + (size_t)WT_HY0 * 2048, HA, NHY, MT, FStoreBf16{RA, MT});
        run_gemm(lds, HA, WT, MA, NQKVP, FStoreQKV{RB, (float*)(ws + WS_AB)});
    }
    SEAM(2);
    if (IN(3)) {
        hyena_setup(lds);
        for (int c = blockIdx.x; c < 2048; c += gridDim.x) hyena_item(a, c, lds);
        for (int u = blockIdx.x; u < 12288 + 192; u += gridDim.x) qkvpost_unit(a, u, lds);
    }
    SEAM(3);
    if (IN(4)) { for (int it = blockIdx.x; it < 256; it += gridDim.x) delta_item(a, it, lf); }
    SEAM(4);
    if (IN(5)) {
        run_gemm(lds, HA, WT + (size_t)WT_ZG0 * 2048, MT, NZG, FStoreBf16{RB, NZG});
        for (int u = blockIdx.x; u < 8192; u += gridDim.x) ytrans_unit((const bf16_t*)a->out, RA + (size_t)2 * MT * 2048, u, (bf16_t*)lds);
    }
    SEAM(5);
    if (IN(6)) { p6_on(a); }
    SEAM(6);
    if (IN(7)) {
        run_gemm(lds, HA  , SW, MT, D, FGatePA{RB, WT  });
        run_gemm(lds, RA + (size_t)2 * MT * 2048  , SW + (size_t)1 * D * D, MT, D, FGatePH{RB, WT  });
    }
    SEAM(7);
    if (IN(8)) {
        run_gemm(lds, WT  , SW + (size_t)2 * D * D, MT, D, FOut{a->in[0], mod, a->out});
        p8_tables(a);
    }
    SEAM(8);
    if (IN(9)) { p9_ln1(a); }
    SEAM(9);
    if (IN(10)) { run_gemm(lds, RA + (size_t)2 * MT * 2048  , SW + (size_t)3 * D * D, MT, D, FStoreF32{(float*)(ws + WS_RB), D}); }
    SEAM(10);
    if (IN(11)) { for (int u = blockIdx.x; u < MT / 32; u += gridDim.x) peer_unit(a, u, lds); }
#undef IN
#undef SEAM
}

extern "C" void kernel_launch(void* const* d_in, const int* in_sizes, int n_in, void* d_out, int out_size, void* d_ws, size_t ws_size, hipStream_t stream) {
    static int grid = 0;
    if (grid == 0) {
        if (n_in != 31 || out_size != MT * D || ws_size < WS_END) { fprintf(stderr, "kernel_launch: unexpected problem shape / workspace (%d inputs, out %d, ws %zu)\n", n_in, out_size, ws_size); grid = -1; return; }
        int dev = 0, cus = 0, per_cu = 0;
        (void)hipGetDevice(&dev);
        (void)hipDeviceGetAttribute(&cus, hipDeviceAttributeMultiprocessorCount, dev);
        (void)hipFuncSetAttribute((const void*)fwd_mega, hipFuncAttributeMaxDynamicSharedMemorySize, LDS_BYTES);
        (void)hipOccupancyMaxActiveBlocksPerMultiprocessor(&per_cu, (const void*)fwd_mega, NT, LDS_BYTES);
        if (per_cu < 1) per_cu = 1;
        grid = cus * per_cu;
        (void)hipGetLastError();
    }
    if (grid < 0) return;
    Args a{};
    for (int i = 0; i < 31; ++i) a.in[i] = (const float*)d_in[i];
    a.out = (float*)d_out; a.ws = (unsigned char*)d_ws; a.ph_lo = 0; a.ph_hi = 12;
    void* args[] = {&a};
    hipError_t e = hipLaunchCooperativeKernel((const void*)fwd_mega, dim3(grid), dim3(NT), args, LDS_BYTES, stream);
    if (e != hipSuccess) fprintf(stderr, "cooperative launch failed: %s (grid %d)\n", hipGetErrorString(e), grid);
}
```

```cpp
#include <hip/hip_runtime.h>
#include <hip/hip_cooperative_groups.h>
#include <cstdio>
#include <cstdint>
namespace cg = cooperative_groups;

#ifndef DBG_MODE
#define DBG_MODE 0
#endif

__device__ __forceinline__ int tid_opaque() { int t = threadIdx.x; asm volatile("" : "+v"(t)); return t; }

namespace pg8 {
#define PG8_LAS __attribute__((address_space(3)))
typedef unsigned short bf16_t;
typedef short bf16x8 __attribute__((ext_vector_type(8)));
typedef float f32x4 __attribute__((ext_vector_type(4)));
typedef unsigned u32x4 __attribute__((ext_vector_type(4)));
constexpr int BM = 256, BK = 64, HALF = 128, HTB = HALF * BK * 2, STAGE_BYTES = 8 * HTB, NXCD = 8, WGM = 8;

__host__ __device__ __forceinline__ int lds_byte(int r, int c) { const int st = (r >> 4) * 2 + (c >> 5), rr = r & 15, cc = c & 31, ob = rr * 64 + cc * 2; return st * 1024 + (ob ^ (((ob >> 9) & 1) << 5)); }
__host__ __device__ __forceinline__ void stage_rc(int b, int& R, int& C) { const int st = b / 1024, sb = b % 1024, swz = sb ^ (((sb >> 9) & 1) << 5); R = (st >> 1) * 16 + swz / 64; C = (st & 1) * 32 + (swz % 64) / 2; }
__host__ __device__ __forceinline__ int perm32(int rho) { const int n = rho >> 4, i = rho & 15; return 8 * (i >> 2) + 4 * n + (i & 3); }

struct Unit { int pm, pn; };
struct Gemm { const bf16_t* A; const bf16_t* Bt; int M, N, K; };

struct StaticOrder {
    int nM, nN, nwg, G, c;
    __host__ __device__ void init(int M, int N, int G_, int c_) { nM = M / BM; nN = N / BM; nwg = nM * nN; G = G_; c = c_; }
    __host__ __device__ bool next(int i, Unit& u) const {
        const long L = (long)i * G + c; if (L >= nwg) return false;
        int wgid = (int)L; { const int q = nwg / NXCD, r = nwg % NXCD, xcd = wgid % NXCD, off = wgid / NXCD; wgid = (xcd < r ? xcd * (q + 1) : r * (q + 1) + (xcd - r) * q) + off; }
        const int nig = WGM * nN, gid = wgid / nig, fm = gid * WGM, gsz = (nM - fm) < WGM ? (nM - fm) : WGM;
        u.pm = fm + ((wgid % nig) % gsz); u.pn = (wgid % nig) / gsz; return true;
    }
    __device__ __forceinline__ void a_ready(const Unit&) const {}
    __device__ __forceinline__ void done(const Unit&) const {}
};

__device__ __forceinline__ unsigned cvt_pk_bf16(float lo, float hi) { unsigned r; asm volatile("v_cvt_pk_bf16_f32 %0, %1, %2" : "=v"(r) : "v"(lo), "v"(hi)); return r; }

template <class F> struct EpiGen {
    static constexpr bool PERM = true, AFTER_DRAIN = false;
    F f;
    __device__ __forceinline__ void operator()(const f32x4 (&acc)[2][2][4][2], const Unit& u, int wr, int wc, int fr, int fq) const {
        const int row0 = u.pm * BM + wr * 64 + fr, col0 = u.pn * BM + wc * 32 + 8 * fq;
#pragma unroll
        for (int ai = 0; ai < 2; ++ai)
#pragma unroll
            for (int m = 0; m < 4; ++m)
#pragma unroll
                for (int bj = 0; bj < 2; ++bj) f(row0 + ai * HALF + m * 16, col0 + bj * HALF, acc[ai][bj][m][0], acc[ai][bj][m][1]);
    }
};

template <class Epi, class Sched>
__device__ __forceinline__ void gemm_phase(PG8_LAS unsigned char* lds, const Gemm g, const Sched& S, const Epi& E) {
    const int tid = tid_opaque(), wid = __builtin_amdgcn_readfirstlane(tid >> 6), lane = tid & 63, wr = wid >> 2, wc = wid & 3, fr = lane & 15, fq = lane >> 4;
    const int K = g.K, nt = K / BK;
    unsigned voffA[2], voffB[2];
#pragma unroll
    for (int i = 0; i < 2; ++i) { int R, C; stage_rc(tid * 16 + i * 8192, R, C); const int Rb = Epi::PERM ? ((R & ~31) + perm32(R & 31)) : R;
        voffA[i] = (unsigned)(R * K + C) * 2u; voffB[i] = (unsigned)(Rb * K + C) * 2u; }
    const size_t kstep = (size_t)(BK * 2);
    const size_t hstep = (size_t)HALF * K * 2;
    const size_t tstep = 2 * hstep;
    const unsigned ldsw = (unsigned)wid * 1024u;
    const int aoff = lds_byte(wr * 64 + fr, fq * 8), boff = lds_byte(wc * 32 + fr, fq * 8);
#define PG8_SA(b, h) (((b) * 2 + (h)) * HTB)
#define PG8_SB(b, h) ((4 + (b) * 2 + (h)) * HTB)
#define PG8_STAGE(bufoff, gbase, voff) do { _Pragma("unroll") for (int _i = 0; _i < 2; ++_i) \
        __builtin_amdgcn_global_load_lds((const unsigned*)((const char*)(gbase) + (voff)[_i]), (PG8_LAS unsigned*)(lds + (bufoff) + ldsw + _i * 8192), 16, 0, 0); } while (0)
#define PG8_LDA(dst, b, h) do { _Pragma("unroll") for (int m = 0; m < 4; ++m) _Pragma("unroll") for (int k = 0; k < 2; ++k) dst[m][k] = *(const PG8_LAS bf16x8*)(lds + PG8_SA(b, h) + aoff + m * 2048 + k * 1024); } while (0)
#define PG8_LDB(dst, b, h) do { _Pragma("unroll") for (int n = 0; n < 2; ++n) _Pragma("unroll") for (int k = 0; k < 2; ++k) dst[n][k] = *(const PG8_LAS bf16x8*)(lds + PG8_SB(b, h) + boff + n * 2048 + k * 1024); } while (0)
#define PG8_MMA(ai, bj, At, Bt) do { __builtin_amdgcn_s_setprio(1); _Pragma("unroll") for (int m = 0; m < 4; ++m) _Pragma("unroll") for (int n = 0; n < 2; ++n) _Pragma("unroll") for (int k = 0; k < 2; ++k) \
        acc[ai][bj][m][n] = __builtin_amdgcn_mfma_f32_16x16x32_bf16(Bt[n][k], At[m][k], acc[ai][bj][m][n], 0, 0, 0); __builtin_amdgcn_s_setprio(0); } while (0)
#define PG8_WAIT_V(n) asm volatile("s_waitcnt vmcnt(" #n ")" ::: "memory")
#define PG8_WAIT_L(n) asm volatile("s_waitcnt lgkmcnt(" #n ")" ::: "memory")
#define PG8_BAR __builtin_amdgcn_s_barrier()
#define PG8_SCHED __builtin_amdgcn_sched_barrier(0)
    Unit cur, nxt; int ui = 0;
    if (!S.next(0, cur)) return;
    f32x4 acc[2][2][4][2];
#pragma unroll
    for (int a = 0; a < 2; ++a)
#pragma unroll
        for (int b = 0; b < 2; ++b)
#pragma unroll
            for (int m = 0; m < 4; ++m)
#pragma unroll
                for (int n = 0; n < 2; ++n) acc[a][b][m][n] = (f32x4){0.f, 0.f, 0.f, 0.f};
    bf16x8 At[4][2], B0[2][2], B1[2][2];
    const char* cA = (const char*)g.A + (size_t)cur.pm * tstep; const char* cB = (const char*)g.Bt + (size_t)cur.pn * tstep;
    S.a_ready(cur);
    PG8_STAGE(PG8_SB(0, 0), cB, voffB); PG8_STAGE(PG8_SA(0, 0), cA, voffA); PG8_STAGE(PG8_SB(0, 1), cB + hstep, voffB); PG8_STAGE(PG8_SA(0, 1), cA + hstep, voffA);
    if (wr == 1) PG8_BAR;
    PG8_WAIT_V(4); PG8_BAR;
    PG8_STAGE(PG8_SB(1, 0), cB + kstep, voffB); PG8_STAGE(PG8_SA(1, 0), cA + kstep, voffA); PG8_STAGE(PG8_SB(1, 1), cB + hstep + kstep, voffB);
    PG8_WAIT_V(6); PG8_BAR;
    for (;;) {
        const bool has_next = S.next(ui + 1, nxt);
        const char* nA = has_next ? (const char*)g.A + (size_t)nxt.pm * tstep : cA; const char* nB = has_next ? (const char*)g.Bt + (size_t)nxt.pn * tstep : cB;
        for (int t = 0; t < nt; t += 2) {
            const bool last = (t == nt - 2);
            const char* a1 = cA + (size_t)(t + 1) * kstep;
            const char* a2 = last ? nA : cA + (size_t)(t + 2) * kstep; const char* b2 = last ? nB : cB + (size_t)(t + 2) * kstep;
            const char* a3 = a2 + kstep; const char* b3 = b2 + kstep;
            if (last && has_next) S.a_ready(nxt);
            PG8_LDB(B0, 0, 0); PG8_SCHED; PG8_LDA(At, 0, 0); PG8_STAGE(PG8_SA(1, 1), a1 + hstep, voffA);
            PG8_WAIT_L(8); PG8_BAR; PG8_WAIT_L(0); PG8_MMA(0, 0, At, B0); PG8_BAR; PG8_SCHED;
            PG8_LDB(B1, 0, 1); PG8_STAGE(PG8_SB(0, 0), b2, voffB);
            PG8_BAR; PG8_WAIT_L(0); PG8_MMA(0, 1, At, B1); PG8_BAR;
            PG8_LDA(At, 0, 1); PG8_STAGE(PG8_SA(0, 0), a2, voffA);
            PG8_BAR; PG8_WAIT_L(0); PG8_MMA(1, 0, At, B0); PG8_BAR; PG8_SCHED;
            PG8_STAGE(PG8_SB(0, 1), b2 + hstep, voffB);
            PG8_WAIT_V(6); PG8_BAR; PG8_MMA(1, 1, At, B1); PG8_BAR;
            PG8_LDB(B0, 1, 0); PG8_SCHED; PG8_LDA(At, 1, 0); PG8_STAGE(PG8_SA(0, 1), a2 + hstep, voffA);
            PG8_WAIT_L(8); PG8_BAR; PG8_WAIT_L(0); PG8_MMA(0, 0, At, B0); PG8_BAR; PG8_SCHED;
            PG8_LDB(B1, 1, 1); PG8_STAGE(PG8_SB(1, 0), b3, voffB);
            PG8_BAR; PG8_WAIT_L(0); PG8_MMA(0, 1, At, B1); PG8_BAR;
            PG8_LDA(At, 1, 1); PG8_STAGE(PG8_SA(1, 0), a3, voffA);
            PG8_BAR; PG8_WAIT_L(0); PG8_MMA(1, 0, At, B0); PG8_BAR; PG8_SCHED;
            PG8_STAGE(PG8_SB(1, 1), b3 + hstep, voffB);
            PG8_WAIT_V(6); PG8_BAR; PG8_MMA(1, 1, At, B1); PG8_BAR;
        }
        E(acc, cur, wr, wc, fr, fq); S.done(cur);
        if (!has_next) break;
#pragma unroll
        for (int a = 0; a < 2; ++a)
#pragma unroll
            for (int b = 0; b < 2; ++b)
#pragma unroll
                for (int m = 0; m < 4; ++m)
#pragma unroll
                    for (int n = 0; n < 2; ++n) acc[a][b][m][n] = (f32x4){0.f, 0.f, 0.f, 0.f};
        cur = nxt; cA = nA; cB = nB; ++ui;
    }
    PG8_WAIT_V(0);
    if (wr == 0) PG8_BAR;
    PG8_BAR;
#undef PG8_SA
#undef PG8_SB
#undef PG8_STAGE
#undef PG8_LDA
#undef PG8_LDB
#undef PG8_MMA
#undef PG8_WAIT_V
#undef PG8_WAIT_L
#undef PG8_BAR
#undef PG8_SCHED
}
}

typedef unsigned short bf16_t;
typedef float f32x4 __attribute__((ext_vector_type(4)));
typedef unsigned u32x4 __attribute__((ext_vector_type(4)));
#define LAS __attribute__((address_space(3)))

constexpr int NT = 512;
constexpr int LDS_BYTES = 160 * 1024;
constexpr int D = 2048, NB = 4, SEQ = 4096, CTXL = 256;
constexpr int MT = NB * SEQ;
constexpr int MC = NB * CTXL;
constexpr int MA = MT + MC;
constexpr int NQKVP = 6400;
constexpr int PQ_LD = 6144;
constexpr int NHY = 6144, NZG = 6144;
constexpr int WT_ROWS = NQKVP + NHY + NZG;
constexpr int WT_HY0 = NQKVP, WT_ZG0 = NQKVP + NHY;
constexpr float ALPHA = 1.189207115002721f;

constexpr size_t MiB = (size_t)1 << 20;
constexpr size_t WS_MOD = 0, WS_HID2 = 1 * MiB, WS_SW = 2 * MiB, WS_HA = 34 * MiB, WS_WT = 102 * MiB, WS_RA = 175 * MiB, WS_RB = 367 * MiB, WS_AB = 580 * MiB, WS_END = 658 * MiB;

struct Args { const float* in[31]; float* out; unsigned char* ws; int ph_lo, ph_hi; };
typedef const __attribute__((address_space(4))) Args* KA;

__device__ __forceinline__ unsigned f2bf(float f) { unsigned u = __float_as_uint(f); return (u + 0x7fffu + ((u >> 16) & 1u)) >> 16; }
__device__ __forceinline__ unsigned pk2(float lo, float hi) { return f2bf(lo) | (f2bf(hi) << 16); }
__device__ __forceinline__ float bflo(unsigned w) { return __uint_as_float(w << 16); }
__device__ __forceinline__ float bfhi(unsigned w) { return __uint_as_float(w & 0xffff0000u); }
__device__ __forceinline__ float bf2f(bf16_t b) { return __uint_as_float(((unsigned)b) << 16); }
__device__ __forceinline__ void unpack8(const u32x4 w, float (&o)[8]) { o[0] = bflo(w.x); o[1] = bfhi(w.x); o[2] = bflo(w.y); o[3] = bfhi(w.y); o[4] = bflo(w.z); o[5] = bfhi(w.z); o[6] = bflo(w.w); o[7] = bfhi(w.w); }
__device__ __forceinline__ u32x4 pack8(const float (&v)[8]) { u32x4 w; w.x = pk2(v[0], v[1]); w.y = pk2(v[2], v[3]); w.z = pk2(v[4], v[5]); w.w = pk2(v[6], v[7]); return w; }
__device__ __forceinline__ float sigmoidf_(float x) { return 1.0f / (1.0f + expf(-x)); }
__device__ __forceinline__ float siluf_(float x) { return x / (1.0f + expf(-x)); }
__device__ __forceinline__ float wave_sum(float v) {
#pragma unroll
    for (int o = 32; o > 0; o >>= 1) v += __shfl_xor(v, o, 64);
    return v;
}
__device__ __forceinline__ float wave_max(float v) {
#pragma unroll
    for (int o = 32; o > 0; o >>= 1) v = fmaxf(v, __shfl_xor(v, o, 64));
    return v;
}

__device__ void p0_mod_hid2(KA a, float* lf) {
    const int tid = tid_opaque(), bid = blockIdx.x;
    if (bid < 192) {
        const float* c = a->in[1]; const float* cc = a->in[3]; const float* w_ada = a->in[4]; const float* b_ada = a->in[5];
        float* mod = (float*)(a->ws + WS_MOD);
        for (int i = tid; i < 5 * 2048; i += NT) { const int r = i >> 11, k = i & 2047; const float v = (r < 4) ? c[r * 2048 + k] : cc[k]; lf[i] = siluf_(v); }
        __syncthreads();
        const int cl = tid & 63, kg = tid >> 6, col = bid * 64 + cl;
        float a0 = 0.f, a1 = 0.f, a2 = 0.f, a3 = 0.f, a4 = 0.f;
#pragma unroll 8
        for (int k = kg * 256; k < kg * 256 + 256; ++k) {
            const float w = w_ada[(size_t)k * 12288 + col];
            a0 += lf[k] * w; a1 += lf[2048 + k] * w; a2 += lf[4096 + k] * w; a3 += lf[6144 + k] * w; a4 += lf[8192 + k] * w;
        }
        float* red = lf + 5 * 2048;
        red[(kg * 5 + 0) * 64 + cl] = a0; red[(kg * 5 + 1) * 64 + cl] = a1; red[(kg * 5 + 2) * 64 + cl] = a2; red[(kg * 5 + 3) * 64 + cl] = a3; red[(kg * 5 + 4) * 64 + cl] = a4;
        __syncthreads();
        if (tid < 320) { const int r = tid >> 6; float s = 0.f;
#pragma unroll
            for (int g = 0; g < 8; ++g) s += red[(g * 5 + r) * 64 + cl];
            mod[r * 12288 + col] = s + b_ada[col]; }
        __syncthreads();
    } else {
        const float* w1 = a->in[12]; const float* b1 = a->in[13]; const float* w2 = a->in[14]; const float* b2 = a->in[15]; const float* freq = a->in[18];
        float* hid2 = (float*)(a->ws + WS_HID2);
        const int pb = (bid - 192) * 64, j = tid & 63, pl = tid >> 6;
        const float fj = freq[j];
        for (int it = 0; it < 8; ++it) {
            const int pos = pb + it * 8 + pl;
            const float tt = (float)pos * (1.0f / 4095.0f);
            float s1 = tt * w1[j];
            const float base = (6.283185307179586f / 4096.0f) * (float)pos;
            for (int e = 0; e < 16; ++e) {
                const float band = 1e-4f + (float)e * ((15.0f - 1e-4f) / 15.0f);
                const float ang = base * band;
                s1 += cosf(ang) * w1[(1 + e) * 64 + j] - sinf(ang) * w1[(17 + e) * 64 + j];
            }
            lf[pl * 64 + j] = sinf(fj * (s1 + b1[j]));
            __syncthreads();
            float s2 = 0.f;
            for (int i = 0; i < 64; ++i) s2 += lf[pl * 64 + i] * w2[i * 64 + j];
            hid2[pos * 64 + j] = sinf(fj * (s2 + b2[j]));
            __syncthreads();
        }
    }
}

__device__ void transpose_unit(const float* src, int ldn, int n0src, bf16_t* dst, int nb, int kb, float* tile) {
    const int tid = tid_opaque(), r = tid >> 4, c4 = tid & 15;
#pragma unroll
    for (int i = 0; i < 4; ++i) {
        const int kk = i * 32 + r;
        f32x4 v = (f32x4){0.f, 0.f, 0.f, 0.f};
        if (n0src >= 0) v = *(const f32x4*)(src + (size_t)(kb * 128 + kk) * ldn + n0src + c4 * 4);
        float* t = tile + kk * 65 + c4 * 4; t[0] = v.x; t[1] = v.y; t[2] = v.z; t[3] = v.w;
    }
    __syncthreads();
#pragma unroll
    for (int i = 0; i < 2; ++i) {
        const int chunk = tid + i * NT, nr = chunk >> 4, kc = chunk & 15;
        const float* t = tile + (kc * 8) * 65 + nr;
        u32x4 w; w.x = pk2(t[0], t[65]); w.y = pk2(t[130], t[195]); w.z = pk2(t[260], t[325]); w.w = pk2(t[390], t[455]);
        *(u32x4*)(dst + (size_t)(nb * 64 + nr) * 2048 + kb * 128 + kc * 8) = w;
    }
    __syncthreads();
}
__device__ __forceinline__ int win_colmap(int np) {
    if (np < 6144) return np;
    if (np < 6208) return 8192 + (np - 6144);
    if (np < 6400) return -1;
    if (np < 12544) return 8256 + (np - 6400);
    if (np < 14592) return 6144 + (np - 12544);
    return 14400 + (np - 14592);
}
__device__ void p0_transposes(KA a, float* lf) {
    bf16_t* WT = (bf16_t*)(a->ws + WS_WT); bf16_t* SW = (bf16_t*)(a->ws + WS_SW);
    const int NU_WT = (WT_ROWS / 64) * 16, NU_SW = 4 * 32 * 16;
    for (int u = blockIdx.x; u < NU_WT + NU_SW; u += gridDim.x) {
        if (u < NU_WT) { const int nb = u >> 4, kb = u & 15; transpose_unit(a->in[6], 18496, win_colmap(nb * 64), WT, nb, kb, lf); }
        else { const int v = u - NU_WT, mtx = v >> 9, nb = (v >> 4) & 31, kb = v & 15;
            const float* src = (mtx == 0) ? a->in[20] : (mtx == 1) ? a->in[21] : (mtx == 2) ? a->in[22] : a->in[25];
            transpose_unit(src, 2048, nb * 64, SW + (size_t)mtx * 2048 * 2048, nb, kb, lf); }
    }
}

__device__ void p1_ha(KA a) {
    const float* mod = (const float*)(a->ws + WS_MOD); bf16_t* HA = (bf16_t*)(a->ws + WS_HA);
    const size_t nthr = (size_t)gridDim.x * NT;
    for (size_t i = (size_t)blockIdx.x * NT + tid_opaque(); i < (size_t)MA * 256; i += nthr) {
        const int row = (int)(i >> 8), k8 = (int)(i & 255) * 8;
        const float* sp; int mr;
        if (row < MT) { sp = a->in[0] + (size_t)row * 2048 + k8; mr = row >> 12; } else { sp = a->in[2] + (size_t)(row - MT) * 2048 + k8; mr = 4; }
        const f32x4 x0 = *(const f32x4*)sp, x1 = *(const f32x4*)(sp + 4);
        const float* mp = mod + mr * 12288 + k8;
        const f32x4 h0 = *(const f32x4*)mp, h1 = *(const f32x4*)(mp + 4), s0 = *(const f32x4*)(mp + 2048), s1 = *(const f32x4*)(mp + 2052);
        float v[8];
#pragma unroll
        for (int e = 0; e < 4; ++e) { v[e] = x0[e] * (1.0f + s0[e]) + h0[e]; v[4 + e] = x1[e] * (1.0f + s1[e]) + h1[e]; }
        *(u32x4*)(HA + (size_t)row * 2048 + k8) = pack8(v);
    }
}

struct FStoreBf16 { bf16_t* O; int ldc;
    __device__ __forceinline__ void operator()(int row, int col, const f32x4 v0, const f32x4 v1) const {
        u32x4 w; w.x = pg8::cvt_pk_bf16(v0[0], v0[1]); w.y = pg8::cvt_pk_bf16(v0[2], v0[3]); w.z = pg8::cvt_pk_bf16(v1[0], v1[1]); w.w = pg8::cvt_pk_bf16(v1[2], v1[3]);
        *(u32x4*)(O + (size_t)row * ldc + col) = w; } };
struct FStoreQKV { bf16_t* PQ; float* AB;
    __device__ __forceinline__ void operator()(int row, int col, const f32x4 v0, const f32x4 v1) const {
        if (col < 6144) { u32x4 w; w.x = pg8::cvt_pk_bf16(v0[0], v0[1]); w.y = pg8::cvt_pk_bf16(v0[2], v0[3]); w.z = pg8::cvt_pk_bf16(v1[0], v1[1]); w.w = pg8::cvt_pk_bf16(v1[2], v1[3]);
            *(u32x4*)(PQ + (size_t)row * PQ_LD + col) = w; }
        else if (col < 6208) { float* p = AB + (size_t)row * 64 + (col - 6144); *(f32x4*)p = v0; *(f32x4*)(p + 4) = v1; } } };
struct FStoreF32 { float* O; int ldc;
    __device__ __forceinline__ void operator()(int row, int col, const f32x4 v0, const f32x4 v1) const { float* p = O + (size_t)row * ldc + col; *(f32x4*)p = v0; *(f32x4*)(p + 4) = v1; } };
struct FGatePA { const bf16_t* ZG; bf16_t* MG;
    __device__ __forceinline__ void operator()(int row, int col, const f32x4 v0, const f32x4 v1) const {
        float g[8]; unpack8(*(const u32x4*)(ZG + (size_t)row * NZG + 2048 + col), g);
        float o[8];
#pragma unroll
        for (int e = 0; e < 4; ++e) { o[e] = sigmoidf_(g[e]) * v0[e]; o[4 + e] = sigmoidf_(g[4 + e]) * v1[e]; }
        *(u32x4*)(MG + (size_t)row * 2048 + col) = pack8(o); } };
struct FGatePH { const bf16_t* ZG; bf16_t* MG;
    __device__ __forceinline__ void operator()(int row, int col, const f32x4 v0, const f32x4 v1) const {
        float g[8], t[8]; unpack8(*(const u32x4*)(ZG + (size_t)row * NZG + 4096 + col), g); unpack8(*(const u32x4*)(MG + (size_t)row * 2048 + col), t);
        float o[8];
#pragma unroll
        for (int e = 0; e < 4; ++e) { o[e] = t[e] + sigmoidf_(g[e]) * v0[e]; o[4 + e] = t[4 + e] + sigmoidf_(g[4 + e]) * v1[e]; }
        *(u32x4*)(MG + (size_t)row * 2048 + col) = pack8(o); } };
struct FOut { const float* x; const float* mod; float* T3;
    __device__ __forceinline__ void operator()(int row, int col, const f32x4 v0, const f32x4 v1) const {
        const float* xp = x + (size_t)row * 2048 + col; const float* gp = mod + (row >> 12) * 12288 + 4096 + col;
        const f32x4 x0 = *(const f32x4*)xp, x1 = *(const f32x4*)(xp + 4), g0 = *(const f32x4*)gp, g1 = *(const f32x4*)(gp + 4);
        float* p = T3 + (size_t)row * 2048 + col;
#if DBG_MODE == 1
        *(f32x4*)p = ALPHA * x0; *(f32x4*)(p + 4) = ALPHA * x1;
#else
        *(f32x4*)p = ALPHA * x0 + g0 * v0; *(f32x4*)(p + 4) = ALPHA * x1 + g1 * v1;
#endif
    } };

template <class F> __device__ __forceinline__ void run_gemm(unsigned char* lds, const bf16_t* A, const bf16_t* Bt, int M, int N, const F& f) {
    pg8::Gemm g{A, Bt, M, N, 2048}; pg8::StaticOrder S; S.init(M, N, (int)gridDim.x, (int)blockIdx.x);
    pg8::EpiGen<F> E{f};
    pg8::gemm_phase<pg8::EpiGen<F>, pg8::StaticOrder>((PG8_LAS unsigned char*)lds, g, S, E);
}

typedef float f32x2 __attribute__((ext_vector_type(2)));
constexpr int HY_Z = 0, HY_F = 69632, HY_TW4 = 139264, HY_TW8 = 141312, HY_TW32 = 143360, HY_W3 = 143488;
__device__ __forceinline__ f32x2 cmul(const f32x2 a, const f32x2 b) { return (f32x2){a.x * b.x - a.y * b.y, a.x * b.y + a.y * b.x}; }
__device__ __forceinline__ f32x2 cmulc(const f32x2 a, const f32x2 b) { return (f32x2){a.x * b.x + a.y * b.y, a.y * b.x - a.x * b.y}; }
template <bool INV> __device__ __forceinline__ f32x2 ctw(const f32x2 v, const float wr, const float wi) {
    return INV ? (f32x2){v.x * wr + v.y * wi, v.y * wr - v.x * wi} : (f32x2){v.x * wr - v.y * wi, v.y * wr + v.x * wi};
}
template <bool INV> __device__ __forceinline__ void dft16(f32x2 (&x)[16]) {
    constexpr float C = 0.9238795325112867f, S = 0.3826834323650898f, R = 0.7071067811865476f;
    f32x2 A[4][4];
#pragma unroll
    for (int q0 = 0; q0 < 4; ++q0) {
        const f32x2 a = x[q0], b = x[4 + q0], c = x[8 + q0], d = x[12 + q0];
        const f32x2 t0 = a + c, t1 = a - c, t2 = b + d, t3 = b - d;
        const f32x2 m = (f32x2){t3.y, -t3.x};
        A[q0][0] = t0 + t2; A[q0][2] = t0 - t2;
        A[q0][1] = INV ? (t1 - m) : (t1 + m); A[q0][3] = INV ? (t1 + m) : (t1 - m);
    }
    A[1][1] = ctw<INV>(A[1][1], C, -S); A[1][2] = ctw<INV>(A[1][2], R, -R); A[1][3] = ctw<INV>(A[1][3], S, -C);
    A[2][1] = ctw<INV>(A[2][1], R, -R); A[2][2] = ctw<INV>(A[2][2], 0.f, -1.f); A[2][3] = ctw<INV>(A[2][3], -R, -R);
    A[3][1] = ctw<INV>(A[3][1], S, -C); A[3][2] = ctw<INV>(A[3][2], -R, -R); A[3][3] = ctw<INV>(A[3][3], -C, S);
#pragma unroll
    for (int s = 0; s < 4; ++s) {
        const f32x2 t0 = A[0][s] + A[2][s], t1 = A[0][s] - A[2][s], t2 = A[1][s] + A[3][s], t3 = A[1][s] - A[3][s];
        const f32x2 m = (f32x2){t3.y, -t3.x};
        x[s] = t0 + t2; x[s + 8] = t0 - t2;
        x[s + 4] = INV ? (t1 - m) : (t1 + m); x[s + 12] = INV ? (t1 + m) : (t1 - m);
    }
}
template <bool INV> __device__ __forceinline__ void apply_tw(f32x2 (&x)[16], const f32x2 w) {
    f32x2 wr = w;
#pragma unroll
    for (int r = 1; r < 16; ++r) { x[r] = INV ? cmulc(x[r], wr) : cmul(x[r], wr); if (r < 15) wr = cmul(wr, w); }
}
__device__ __forceinline__ void fft_pass2_fwd(f32x2* B, int t, const f32x2* TW4) {
    const int base = 272 * (t >> 4) + (t & 15); f32x2 x[16];
#pragma unroll
    for (int q = 0; q < 16; ++q) x[q] = B[base + 17 * q];
    dft16<false>(x); apply_tw<false>(x, TW4[16 * (t & 15)]);
#pragma unroll
    for (int q = 0; q < 16; ++q) B[base + 17 * q] = x[q];
}
__device__ __forceinline__ void fft_pass2_inv(f32x2* B, int t, const f32x2* TW4) {
    const int base = 272 * (t >> 4) + (t & 15); f32x2 x[16];
#pragma unroll
    for (int q = 0; q < 16; ++q) x[q] = B[base + 17 * q];
    apply_tw<true>(x, TW4[16 * (t & 15)]); dft16<true>(x);
#pragma unroll
    for (int q = 0; q < 16; ++q) B[base + 17 * q] = x[q];
}
__device__ __forceinline__ float conv3_lane(float c, int lane, float w0, float w1, float w2) {
    float up = __shfl_up(c, 1, 64), dn = __shfl_down(c, 1, 64);
    up = (lane == 0) ? 0.f : up; dn = (lane == 63) ? 0.f : dn;
    return w0 * up + w1 * c + w2 * dn;
}
__device__ void hyena_setup(unsigned char* lds) {
    const int tid = tid_opaque();
    f32x2* TW4 = (f32x2*)(lds + HY_TW4); f32x2* TW8 = (f32x2*)(lds + HY_TW8); f32x2* TW32 = (f32x2*)(lds + HY_TW32);
    if (tid < 256) { const float a4 = -6.283185307179586f * (float)tid * (1.0f / 4096.0f), a8 = -6.283185307179586f * (float)tid * (1.0f / 8192.0f);
        TW4[tid] = (f32x2){cosf(a4), sinf(a4)}; TW8[tid] = (f32x2){cosf(a8), sinf(a8)}; }
    if (tid < 16) { const float a = -6.283185307179586f * (float)tid * (1.0f / 32.0f); TW32[tid] = (f32x2){cosf(a), sinf(a)}; }
    __syncthreads();
}
struct HyCtx { f32x2* Z; f32x2* Fb0; const f32x2* TW4; const f32x2* TW32; const bf16_t* rv; const bf16_t* rx1; const bf16_t* rx2; bf16_t* YTc; float* Y1S;
    f32x2 w8t, w4t; float cv0, cv1, cv2, cx0, cx1, cx2, cy0, cy1, cy2, sk0, sk1; int tid, br, t, lane, p1; };
template <int ORDER> __device__ __forceinline__ void hyena_conv(const HyCtx& K, int pr) {
    f32x2* Z = K.Z; const f32x2* TW4 = K.TW4; const f32x2* TW32 = K.TW32;
    const bf16_t* rv = K.rv; const bf16_t* rx1 = K.rx1; const bf16_t* rx2 = K.rx2; float* Y1S = K.Y1S;
    int tid = K.tid; asm volatile("" : "+v"(tid));
    const f32x2 w8t = K.w8t, w4t = K.w4t; const int br = tid >> 8, t = tid & 255, lane = tid & 63, p1 = t + (t >> 4);
    f32x2* Zb = K.Z + br * 4352; f32x2* Fb = K.Fb0 + br * 4352;
    const float cv0 = K.cv0, cv1 = K.cv1, cv2 = K.cv2, cx0 = K.cx0, cx1 = K.cx1, cx2 = K.cx2, cy0 = K.cy0, cy1 = K.cy1, cy2 = K.cy2, sk0 = K.sk0, sk1 = K.sk1;
        const int ba = 2 * pr * 4096, bb = ba + 4096;
        {
            f32x2 x[16];
#pragma unroll
            for (int q = 0; q < 16; ++q) {
                const int n = t + 256 * q; float ua, ub;
                if (ORDER == 0) { ua = conv3_lane(bf2f(rv[ba + n]), lane, cv0, cv1, cv2); ub = conv3_lane(bf2f(rv[bb + n]), lane, cv0, cv1, cv2); }
                else { ua = Y1S[n]; ub = Y1S[4096 + n]; }
                const f32x2 z = (f32x2){ua, ub};
                x[q] = br ? cmul(z, cmul(w8t, TW32[q])) : z;
            }
            dft16<false>(x); apply_tw<false>(x, w4t);
#pragma unroll
            for (int q = 0; q < 16; ++q) Zb[p1 + 272 * q] = x[q];
        }
        __syncthreads();
        fft_pass2_fwd(Zb, t, TW4);
        __syncthreads();
        {
            f32x2 x[16];
#pragma unroll
            for (int q = 0; q < 16; ++q) x[q] = Zb[17 * t + q];
            dft16<false>(x);
#pragma unroll
            for (int r = 0; r < 16; ++r) {
                const int p = 16 * t + r; int pp;
                if (br) pp = 4095 - p;
                else { const int m = (r << 8) | ((t & 15) << 4) | (t >> 4); const int mp = (4096 - m) & 4095; pp = ((mp & 15) << 8) | (mp & 0xF0) | (mp >> 8); }
                const f32x2 fk = Fb[p + (p >> 4)], fc = Fb[pp + (pp >> 4)];
                f32x2 H;
                if (ORDER == 0) H = (f32x2){0.5f * (fk.x + fc.x), 0.5f * (fk.y - fc.y)};
                else H = (f32x2){0.5f * (fk.y + fc.y), -0.5f * (fk.x - fc.x)};
                x[r] = cmul(x[r], H);
            }
            dft16<true>(x);
#pragma unroll
            for (int q = 0; q < 16; ++q) Zb[17 * t + q] = x[q];
        }
        __syncthreads();
        fft_pass2_inv(Zb, t, TW4);
        __syncthreads();
        {
            f32x2 x[16];
#pragma unroll
            for (int q = 0; q < 16; ++q) x[q] = Zb[p1 + 272 * q];
            apply_tw<true>(x, w4t); dft16<true>(x);
            if (br) {
#pragma unroll
                for (int q = 0; q < 16; ++q) x[q] = cmulc(x[q], cmul(w8t, TW32[q]));
            }
#pragma unroll
            for (int q = 0; q < 16; ++q) Zb[p1 + 272 * q] = x[q];
        }
        __syncthreads();
#pragma unroll
        for (int i = 0; i < 8; ++i) {
            const int n = tid + i * NT, pn = n + (n >> 4);
            const f32x2 e0 = Z[pn], e1 = Z[4352 + pn];
            const float ca = (e0.x + e1.x) * (1.0f / 8192.0f), cb = (e0.y + e1.y) * (1.0f / 8192.0f);
            if (ORDER == 0) {
                const float va = conv3_lane(bf2f(rv[ba + n]), lane, cv0, cv1, cv2), vb = conv3_lane(bf2f(rv[bb + n]), lane, cv0, cv1, cv2);
                const float xa = conv3_lane(bf2f(rx1[ba + n]), lane, cx0, cx1, cx2), xb = conv3_lane(bf2f(rx1[bb + n]), lane, cx0, cx1, cx2);
                Y1S[n] = xa * (ca + sk0 * va); Y1S[4096 + n] = xb * (cb + sk0 * vb);
            } else {
                const float ya = Y1S[n], yb = Y1S[4096 + n];
                const float xa = conv3_lane(bf2f(rx2[ba + n]), lane, cy0, cy1, cy2), xb = conv3_lane(bf2f(rx2[bb + n]), lane, cy0, cy1, cy2);
                K.YTc[ba + n] = (bf16_t)f2bf(xa * (ca + sk1 * ya)); K.YTc[bb + n] = (bf16_t)f2bf(xb * (cb + sk1 * yb));
            }
        }
        __syncthreads();
}
__device__ void hyena_item(KA a, int c, unsigned char* lds) {
    f32x2* Z = (f32x2*)(lds + HY_Z); f32x2* F = (f32x2*)(lds + HY_F);
    const f32x2* TW4 = (const f32x2*)(lds + HY_TW4); const f32x2* TW8 = (const f32x2*)(lds + HY_TW8); const f32x2* TW32 = (const f32x2*)(lds + HY_TW32);
    float* W3 = (float*)(lds + HY_W3);
    int tid = tid_opaque(); asm volatile("" : "+v"(tid));
    const int br = tid >> 8, t = tid & 255, lane = tid & 63;
    f32x2* Zb = Z + br * 4352; f32x2* Fb = F + br * 4352;
    const float* hid2 = (const float*)(a->ws + WS_HID2);
    const float* w3 = a->in[16]; const float* b3 = a->in[17]; const float* cw = a->in[11]; const float* skip = a->in[19];
    const bf16_t* PHT = (const bf16_t*)(a->ws + WS_RA);
    bf16_t* YT = (bf16_t*)a->out;
    float* Y1S = a->out + (size_t)16 * 1024 * 1024 + (size_t)blockIdx.x * 16384;
    if (tid < 256) { const int q = tid >> 6, j = tid & 63; W3[q * 64 + j] = w3[(size_t)j * 8192 + (q >> 1) * 4096 + (q & 1) * 2048 + c]; }
    __syncthreads();
    {
        const float delta = 3.0701134573253944f + 12.280453829301578f * ((float)c * (1.0f / 2047.0f));
        float bq[4];
#pragma unroll
        for (int q = 0; q < 4; ++q) bq[q] = b3[(q >> 1) * 4096 + (q & 1) * 2048 + c];
#pragma unroll 1
        for (int i = 0; i < 8; ++i) {
            const int d = tid + i * NT;
            const f32x4* hp = (const f32x4*)(hid2 + d * 64);
            float f0 = 0.f, f1 = 0.f, f2 = 0.f, f3 = 0.f;
#pragma unroll 4
            for (int j4 = 0; j4 < 16; ++j4) {
                const f32x4 hv = hp[j4];
#pragma unroll
                for (int e = 0; e < 4; ++e) { const int j = j4 * 4 + e; f0 += hv[e] * W3[j]; f1 += hv[e] * W3[64 + j]; f2 += hv[e] * W3[128 + j]; f3 += hv[e] * W3[192 + j]; }
            }
            const float win = expf(-((float)d * (1.0f / 4095.0f)) * delta);
            Z[d] = (f32x2){(f0 + bq[0]) * win, (f1 + bq[1]) * win};
            Z[4096 + d] = (f32x2){(f2 + bq[2]) * win, (f3 + bq[3]) * win};
        }
    }
    __syncthreads();
    const f32x2 w8t = TW8[t], w4t = TW4[t];
    const int p1 = t + (t >> 4);
    {
        f32x2 x[16];
#pragma unroll
        for (int q = 0; q < 16; ++q) {
            const int n = t + 256 * q;
            const f32x2 av = Z[n]; f32x2 bv = Z[8192 - (n ? n : 1)]; if (n == 0) bv = (f32x2){0.f, 0.f};
            x[q] = br ? cmul(av - bv, cmul(w8t, TW32[q])) : (av + bv);
        }
        dft16<false>(x); apply_tw<false>(x, w4t);
#pragma unroll
        for (int q = 0; q < 16; ++q) Fb[p1 + 272 * q] = x[q];
    }
    __syncthreads();
    fft_pass2_fwd(Fb, t, TW4);
    __syncthreads();
    {   f32x2 x[16];
#pragma unroll
        for (int q = 0; q < 16; ++q) x[q] = Fb[17 * t + q];
        dft16<false>(x);
#pragma unroll
        for (int q = 0; q < 16; ++q) Fb[17 * t + q] = x[q];
    }
    __syncthreads();
    const float cv0 = cw[c], cv1 = cw[6144 + c], cv2 = cw[12288 + c];
    const float cx0 = cw[2048 + c], cx1 = cw[6144 + 2048 + c], cx2 = cw[12288 + 2048 + c];
    const float cy0 = cw[4096 + c], cy1 = cw[6144 + 4096 + c], cy2 = cw[12288 + 4096 + c];
    const float sk0 = skip[c], sk1 = skip[2048 + c];
    const bf16_t* rv = PHT + (size_t)c * MT; const bf16_t* rx1 = PHT + (size_t)(2048 + c) * MT; const bf16_t* rx2 = PHT + (size_t)(4096 + c) * MT;
    HyCtx K; K.Z = Z; K.Fb0 = F; K.TW4 = TW4; K.TW32 = TW32; K.rv = rv; K.rx1 = rx1; K.rx2 = rx2; K.YTc = YT + (size_t)c * MT; K.Y1S = Y1S;
    K.w8t = w8t; K.w4t = w4t; K.cv0 = cv0; K.cv1 = cv1; K.cv2 = cv2; K.cx0 = cx0; K.cx1 = cx1; K.cx2 = cx2; K.cy0 = cy0; K.cy1 = cy1; K.cy2 = cy2; K.sk0 = sk0; K.sk1 = sk1;
    K.tid = tid; K.br = br; K.t = t; K.lane = lane; K.p1 = p1;
#pragma unroll 1
    for (int pr = 0; pr < 2; ++pr) { hyena_conv<0>(K, pr); hyena_conv<1>(K, pr); }
}

__device__ void qkvpost_unit(KA a, int unit, unsigned char* lds) {
    const int tid = tid_opaque();
    int ntok, row0, wh;
    if (unit < 12288) { const int gr = unit / 48; wh = unit % 48; ntok = 64; row0 = gr * 64; }
    else { const int uu = unit - 12288; const int b = uu / 48; wh = uu % 48; ntok = 256; row0 = MT + b * 256; }
    const int which = wh >> 4, h = wh & 15, colbase = which * 2048 + h * 128;
    bf16_t* PQ = (bf16_t*)(a->ws + WS_RB);
    bf16_t* raw = (bf16_t*)lds; float* wl = (float*)(lds + 65536);
    const float* cwt = a->in[7];
    for (int i = tid; i < ntok * 16; i += NT) { const int r = i >> 4, c8 = i & 15; *(u32x4*)(raw + r * 128 + c8 * 8) = *(const u32x4*)(PQ + (size_t)(row0 + r) * PQ_LD + colbase + c8 * 8); }
    for (int i = tid; i < 640; i += NT) wl[i] = cwt[(i >> 7) * 6144 + colbase + (i & 127)];
    __syncthreads();
    const int r = tid >> 3, cg = tid & 7;
    for (int rb = 0; rb < ntok / 64; ++rb) {
        const int tok = rb * 64 + r;
        float v[16]; float ss = 0.f;
#pragma unroll
        for (int e = 0; e < 16; ++e) {
            const int ch = cg * 16 + e; float acc = 0.f;
#pragma unroll
            for (int j = 0; j < 5; ++j) { const int tt = tok + j - 2; if (tt >= 0 && tt < ntok) acc += wl[j * 128 + ch] * bf2f(raw[tt * 128 + ch]); }
            const float s = siluf_(acc); v[e] = s; ss += s * s;
        }
        if (which < 2) {
            ss += __shfl_xor(ss, 1, 64); ss += __shfl_xor(ss, 2, 64); ss += __shfl_xor(ss, 4, 64);
            const float sc = rsqrtf(ss + 1e-6f) * (which == 0 ? 0.08838834764831845f : 1.0f);
#pragma unroll
            for (int e = 0; e < 16; ++e) v[e] *= sc;
        }
        bf16_t* op = PQ + (size_t)(row0 + tok) * PQ_LD + colbase + cg * 16;
        u32x4 w0, w1;
        w0.x = pk2(v[0], v[1]); w0.y = pk2(v[2], v[3]); w0.z = pk2(v[4], v[5]); w0.w = pk2(v[6], v[7]);
        w1.x = pk2(v[8], v[9]); w1.y = pk2(v[10], v[11]); w1.z = pk2(v[12], v[13]); w1.w = pk2(v[14], v[15]);
        *(u32x4*)op = w0; *(u32x4*)(op + 8) = w1;
    }
    __syncthreads();
}

typedef short bf16x8 __attribute__((ext_vector_type(8)));
typedef unsigned u32x2 __attribute__((ext_vector_type(2)));
constexpr size_t WS_TS = 585 * MiB, WS_GCB = 653 * MiB;
#define MFMA16(a, b, c) __builtin_amdgcn_mfma_f32_16x16x32_bf16((a), (b), (c), 0, 0, 0)
__device__ __forceinline__ u32x2 pk4(float a, float b, float c, float d) { u32x2 w; w.x = pk2(a, b); w.y = pk2(c, d); return w; }

__device__ void tprep_wave(KA a, int pid, unsigned char* wl) {
    const int lane = tid_opaque() & 63, fr = lane & 15, fq = lane >> 4;
    const int sid = pid / 68, cidx = pid - sid * 68, dir = sid & 1, h = (sid >> 1) & 15, b = sid >> 5;
    bf16_t* kt = (bf16_t*)wl; float* Mf = (float*)wl; float* gcs = (float*)(wl + 17408); float* bes = gcs + 64;
    const bf16_t* PQ = (const bf16_t*)(a->ws + WS_RB); const float* AB = (const float*)(a->ws + WS_AB);
    bf16_t* TS = (bf16_t*)(a->ws + WS_TS) + (size_t)pid * 4096; float* GCB = (float*)(a->ws + WS_GCB) + (size_t)pid * 128;
    int rbase, Tn, p0;
    if (cidx < 4) { rbase = MT + b * CTXL; Tn = CTXL; p0 = cidx * 64; } else { rbase = b * SEQ; Tn = SEQ; p0 = (cidx - 4) * 64; }
#pragma unroll 4
    for (int it = 0; it < 16; ++it) {
        const int i = it * 4 + fq, p = p0 + i, tok = dir ? (Tn - 1 - p) : p;
        *(u32x4*)(kt + i * 136 + fr * 8) = *(const u32x4*)(PQ + (size_t)(rbase + tok) * PQ_LD + 2048 + h * 128 + fr * 8);
    }
    {
        const int p = p0 + lane, tok = dir ? (Tn - 1 - p) : p; const size_t row = (size_t)(rbase + tok);
        const float ab0 = AB[row * 64 + dir * 32 + h], ab1 = AB[row * 64 + dir * 32 + 16 + h];
        const float xx = ab0 + a->in[9][dir * 16 + h]; const float sp = (xx > 20.0f) ? xx : log1pf(expf(xx));
        float gc = -expf(a->in[8][dir * 16 + h]) * sp;
#pragma unroll
        for (int o = 1; o < 64; o <<= 1) { const float tt = __shfl_up(gc, o, 64); if (lane >= o) gc += tt; }
        const float be = sigmoidf_(ab1);
        gcs[lane] = gc; bes[lane] = be; GCB[lane] = gc; GCB[64 + lane] = be;
    }
    f32x4 acc[10];
#pragma unroll
    for (int i = 0; i < 10; ++i) acc[i] = (f32x4){0.f, 0.f, 0.f, 0.f};
#pragma unroll
    for (int kk = 0; kk < 4; ++kk) {
        bf16x8 fg[4];
#pragma unroll
        for (int ct = 0; ct < 4; ++ct) fg[ct] = *(const bf16x8*)(kt + (ct * 16 + fr) * 136 + kk * 32 + fq * 8);
#pragma unroll
        for (int ct = 0; ct < 4; ++ct)
#pragma unroll
            for (int mt = 0; mt <= ct; ++mt) acc[ct * (ct + 1) / 2 + mt] = MFMA16(fg[ct], fg[mt], acc[ct * (ct + 1) / 2 + mt]);
    }
    float gcr[4][4], ber[4][4];
#pragma unroll
    for (int ct = 0; ct < 4; ++ct)
#pragma unroll
        for (int r = 0; r < 4; ++r) { gcr[ct][r] = gcs[ct * 16 + 4 * fq + r]; ber[ct][r] = bes[ct * 16 + 4 * fq + r]; }
    float gcm[4];
#pragma unroll
    for (int mt = 0; mt < 4; ++mt) gcm[mt] = gcs[mt * 16 + fr];
    asm volatile("s_waitcnt lgkmcnt(0)" ::: "memory");
#pragma unroll
    for (int ct = 0; ct < 4; ++ct)
#pragma unroll
        for (int mt = 0; mt <= ct; ++mt)
#pragma unroll
            for (int r = 0; r < 4; ++r) {
                const int c = ct * 16 + 4 * fq + r, m = mt * 16 + fr;
                Mf[c * 68 + m] = (m < c) ? ber[ct][r] * acc[ct * (ct + 1) / 2 + mt][r] * expf(gcr[ct][r] - gcm[mt]) : 0.0f;
            }
    asm volatile("s_waitcnt lgkmcnt(0)" ::: "memory");
    Mf[lane] = (lane == 0) ? 1.0f : 0.0f;
    asm volatile("s_waitcnt lgkmcnt(0)" ::: "memory");
#pragma unroll 1
    for (int i = 1; i < 64; ++i) {
        const float* mr = Mf + i * 68;
        float s0 = 0.f, s1 = 0.f, s2 = 0.f, s3 = 0.f;
        int m = 0;
#pragma unroll 1
        for (; m + 4 <= i; m += 4) {
            const f32x4 mv = *(const f32x4*)(mr + m);
            s0 -= mv.x * Mf[m * 68 + lane]; s1 -= mv.y * Mf[(m + 1) * 68 + lane]; s2 -= mv.z * Mf[(m + 2) * 68 + lane]; s3 -= mv.w * Mf[(m + 3) * 68 + lane];
        }
#pragma unroll 1
        for (; m < i; ++m) s0 -= mr[m] * Mf[m * 68 + lane];
        const float tv = ((s0 + s1) + (s2 + s3)) + ((lane == i) ? 1.0f : 0.0f);
        asm volatile("s_waitcnt lgkmcnt(0)" ::: "memory");
        Mf[i * 68 + lane] = tv;
        asm volatile("s_waitcnt lgkmcnt(0)" ::: "memory");
    }
#pragma unroll
    for (int it = 0; it < 8; ++it) {
        const int row = it * 8 + (lane >> 3), c8 = (lane & 7) * 8;
        const f32x4 x0 = *(const f32x4*)(Mf + row * 68 + c8), x1 = *(const f32x4*)(Mf + row * 68 + c8 + 4);
        u32x4 wv; wv.x = pk2(x0[0], x0[1]); wv.y = pk2(x0[2], x0[3]); wv.z = pk2(x1[0], x1[1]); wv.w = pk2(x1[2], x1[3]);
        *(u32x4*)(TS + row * 64 + c8) = wv;
    }
    asm volatile("s_waitcnt lgkmcnt(0)" ::: "memory");
}

constexpr int DL_QN = 0, DL_KN = 17408, DL_WN = 34816, DL_ST = 52224, DL_KT = 69632, DL_VT = 88064, DL_T1 = 97280, DL_T2 = 106496, DL_AT = 115712, DL_VN = 124928, DL_VD = 134144, DL_GS = 143360;
struct DStage { u32x4 q0, q1, k0, k1, v, t; f32x4 g0, g1, b0, b1; float bi, gl, g63; };
__device__ __forceinline__ void dstage_load(DStage& R, const bf16_t* PQ, const bf16_t* TS, const float* GCB, int sid, int cidx, int dir, int h, int b, int dvh, int tid) {
    const int i = tid >> 3, part = tid & 7;
    int rbase, Tn, p0;
    if (cidx < 4) { rbase = MT + b * CTXL; Tn = CTXL; p0 = cidx * 64; } else { rbase = b * SEQ; Tn = SEQ; p0 = (cidx - 4) * 64; }
    const int p = p0 + i, tok = dir ? (Tn - 1 - p) : p;
    const bf16_t* rp = PQ + (size_t)(rbase + tok) * PQ_LD + h * 128;
    R.q0 = *(const u32x4*)(rp + part * 16); R.q1 = *(const u32x4*)(rp + part * 16 + 8);
    R.k0 = *(const u32x4*)(rp + 2048 + part * 16); R.k1 = *(const u32x4*)(rp + 2048 + part * 16 + 8);
    R.v = *(const u32x4*)(rp + 4096 + dvh * 64 + part * 8);
    const size_t pid = (size_t)sid * 68 + cidx;
    R.t = *(const u32x4*)(TS + pid * 4096 + i * 64 + part * 8);
    const float* gp = GCB + pid * 128;
    R.g0 = *(const f32x4*)(gp + part * 8); R.g1 = *(const f32x4*)(gp + part * 8 + 4);
    R.b0 = *(const f32x4*)(gp + 64 + part * 8); R.b1 = *(const f32x4*)(gp + 64 + part * 8 + 4);
    R.bi = gp[64 + i]; R.gl = gp[tid & 63]; R.g63 = gp[63];
}
__device__ __forceinline__ void dstage_store(const DStage& R, unsigned char* lds, int tid) {
    const int i = tid >> 3, part = tid & 7;
    bf16_t* QN = (bf16_t*)(lds + DL_QN); bf16_t* KN = (bf16_t*)(lds + DL_KN); bf16_t* KT = (bf16_t*)(lds + DL_KT); bf16_t* VT = (bf16_t*)(lds + DL_VT);
    bf16_t* T1 = (bf16_t*)(lds + DL_T1); bf16_t* T2 = (bf16_t*)(lds + DL_T2); float* GS = (float*)(lds + DL_GS);
    *(u32x4*)(QN + i * 136 + part * 16) = R.q0; *(u32x4*)(QN + i * 136 + part * 16 + 8) = R.q1;
    *(u32x4*)(KN + i * 136 + part * 16) = R.k0; *(u32x4*)(KN + i * 136 + part * 16 + 8) = R.k1;
    const unsigned kw[8] = {R.k0.x, R.k0.y, R.k0.z, R.k0.w, R.k1.x, R.k1.y, R.k1.z, R.k1.w};
#pragma unroll
    for (int e = 0; e < 8; ++e) { KT[(part * 16 + 2 * e) * 72 + i] = (bf16_t)(kw[e] & 0xffffu); KT[(part * 16 + 2 * e + 1) * 72 + i] = (bf16_t)(kw[e] >> 16); }
    float v8[8]; unpack8(R.v, v8);
#pragma unroll
    for (int e = 0; e < 8; ++e) VT[(part * 8 + e) * 72 + i] = (bf16_t)f2bf(v8[e]);
    float t8[8]; unpack8(R.t, t8);
    const float gm[8] = {R.g0.x, R.g0.y, R.g0.z, R.g0.w, R.g1.x, R.g1.y, R.g1.z, R.g1.w};
    const float bm[8] = {R.b0.x, R.b0.y, R.b0.z, R.b0.w, R.b1.x, R.b1.y, R.b1.z, R.b1.w};
    float a1[8], a2[8];
#pragma unroll
    for (int e = 0; e < 8; ++e) { a2[e] = t8[e] * bm[e]; a1[e] = a2[e] * expf(gm[e]); }
    *(u32x4*)(T1 + i * 72 + part * 8) = pack8(a1); *(u32x4*)(T2 + i * 72 + part * 8) = pack8(a2);
    if (tid < 64) { GS[tid] = R.gl; GS[64 + tid] = expf(R.gl); GS[128 + tid] = expf(R.g63 - R.gl); }
}
__device__ void delta_item(KA a, int item, unsigned char* lds) {
    const int tid = tid_opaque(), lane = tid & 63, w = tid >> 6, fr = lane & 15, fq = lane >> 4;
    const int dvh = item & 1, dir = (item >> 1) & 1, h = (item >> 2) & 15, b = item >> 6, sid = (b * 16 + h) * 2 + dir;
    const bf16_t* PQ = (const bf16_t*)(a->ws + WS_RB); const bf16_t* TS = (const bf16_t*)(a->ws + WS_TS); const float* GCB = (const float*)(a->ws + WS_GCB);
    bf16_t* O = (bf16_t*)(a->ws + WS_RA) + (size_t)dir * MT * 2048;
    const bf16_t* QN = (const bf16_t*)(lds + DL_QN); const bf16_t* KN = (const bf16_t*)(lds + DL_KN); bf16_t* WN = (bf16_t*)(lds + DL_WN); bf16_t* ST = (bf16_t*)(lds + DL_ST);
    const bf16_t* KT = (const bf16_t*)(lds + DL_KT); const bf16_t* VT = (const bf16_t*)(lds + DL_VT); const bf16_t* T1 = (const bf16_t*)(lds + DL_T1); const bf16_t* T2 = (const bf16_t*)(lds + DL_T2);
    bf16_t* AT = (bf16_t*)(lds + DL_AT); bf16_t* VN = (bf16_t*)(lds + DL_VN); bf16_t* VD = (bf16_t*)(lds + DL_VD); const float* GS = (const float*)(lds + DL_GS);
    __syncthreads();
    for (int i = tid; i < 64 * 136 / 2; i += NT) ((unsigned*)ST)[i] = 0u;
    f32x4 sacc[4];
#pragma unroll
    for (int i = 0; i < 4; ++i) sacc[i] = (f32x4){0.f, 0.f, 0.f, 0.f};
    DStage R;
    dstage_load(R, PQ, TS, GCB, sid, 0, dir, h, b, dvh, tid);
#pragma unroll 1
    for (int cidx = 0; cidx < 68; ++cidx) {
        dstage_store(R, lds, tid);
        __syncthreads();
        if (cidx + 1 < 68) dstage_load(R, PQ, TS, GCB, sid, cidx + 1, dir, h, b, dvh, tid);
#pragma unroll
        for (int ti = 0; ti < 2; ++ti) {
            const int idx = w * 2 + ti, mt = idx >> 2, ct = idx & 3;
            f32x4 acc = (f32x4){0.f, 0.f, 0.f, 0.f};
            if (mt <= ct) {
#pragma unroll
                for (int kk = 0; kk < 4; ++kk) {
                    const bf16x8 af = *(const bf16x8*)(KN + (mt * 16 + fr) * 136 + kk * 32 + fq * 8), bfg = *(const bf16x8*)(QN + (ct * 16 + fr) * 136 + kk * 32 + fq * 8);
                    acc = MFMA16(af, bfg, acc);
                }
            }
            const int c = ct * 16 + fr; const float gcc = GS[c];
            float o4[4];
#pragma unroll
            for (int r = 0; r < 4; ++r) { const int m = mt * 16 + 4 * fq + r; o4[r] = (m <= c) ? acc[r] * expf(gcc - GS[m]) : 0.0f; }
            *(u32x2*)(AT + c * 72 + mt * 16 + 4 * fq) = pk4(o4[0], o4[1], o4[2], o4[3]);
        }
        {
            bf16x8 af[2];
#pragma unroll
            for (int kk = 0; kk < 2; ++kk) af[kk] = *(const bf16x8*)(KT + (w * 16 + fr) * 72 + kk * 32 + fq * 8);
#pragma unroll
            for (int ct = 0; ct < 4; ++ct) {
                f32x4 acc = (f32x4){0.f, 0.f, 0.f, 0.f};
#pragma unroll
                for (int kk = 0; kk < 2; ++kk) acc = MFMA16(af[kk], *(const bf16x8*)(T1 + (ct * 16 + fr) * 72 + kk * 32 + fq * 8), acc);
                *(u32x2*)(WN + (ct * 16 + fr) * 136 + w * 16 + 4 * fq) = pk4(-acc[0], -acc[1], -acc[2], -acc[3]);
            }
        }
        const int ctu = w >> 1, dv0 = 2 * (w & 1);
        f32x4 uacc[2];
        {
            bf16x8 af[2];
#pragma unroll
            for (int kk = 0; kk < 2; ++kk) af[kk] = *(const bf16x8*)(T2 + (ctu * 16 + fr) * 72 + kk * 32 + fq * 8);
#pragma unroll
            for (int j = 0; j < 2; ++j) { uacc[j] = (f32x4){0.f, 0.f, 0.f, 0.f};
#pragma unroll
                for (int kk = 0; kk < 2; ++kk) uacc[j] = MFMA16(af[kk], *(const bf16x8*)(VT + ((dv0 + j) * 16 + fr) * 72 + kk * 32 + fq * 8), uacc[j]); }
        }
        __syncthreads();
        {
            bf16x8 af[4];
#pragma unroll
            for (int kk = 0; kk < 4; ++kk) af[kk] = *(const bf16x8*)(WN + (ctu * 16 + fr) * 136 + kk * 32 + fq * 8);
            float ed[4];
#pragma unroll
            for (int r = 0; r < 4; ++r) ed[r] = GS[128 + ctu * 16 + 4 * fq + r];
#pragma unroll
            for (int j = 0; j < 2; ++j) {
#pragma unroll
                for (int kk = 0; kk < 4; ++kk) uacc[j] = MFMA16(af[kk], *(const bf16x8*)(ST + ((dv0 + j) * 16 + fr) * 136 + kk * 32 + fq * 8), uacc[j]);
                const int dv = (dv0 + j) * 16 + fr;
                *(u32x2*)(VN + dv * 72 + ctu * 16 + 4 * fq) = pk4(uacc[j][0], uacc[j][1], uacc[j][2], uacc[j][3]);
                *(u32x2*)(VD + dv * 72 + ctu * 16 + 4 * fq) = pk4(uacc[j][0] * ed[0], uacc[j][1] * ed[1], uacc[j][2] * ed[2], uacc[j][3] * ed[3]);
            }
        }
        __syncthreads();
        {
            const int dvt = w >> 1, c0 = 2 * (w & 1);
            bf16x8 af[4], vf[2];
#pragma unroll
            for (int kk = 0; kk < 4; ++kk) af[kk] = *(const bf16x8*)(ST + (dvt * 16 + fr) * 136 + kk * 32 + fq * 8);
#pragma unroll
            for (int kk = 0; kk < 2; ++kk) vf[kk] = *(const bf16x8*)(VN + (dvt * 16 + fr) * 72 + kk * 32 + fq * 8);
#pragma unroll
            for (int j = 0; j < 2; ++j) {
                const int c = (c0 + j) * 16 + fr;
                f32x4 acc = (f32x4){0.f, 0.f, 0.f, 0.f};
#pragma unroll
                for (int kk = 0; kk < 4; ++kk) acc = MFMA16(af[kk], *(const bf16x8*)(QN + c * 136 + kk * 32 + fq * 8), acc);
                const float eg = GS[64 + c];
                acc = acc * eg;
#pragma unroll
                for (int kk = 0; kk < 2; ++kk) acc = MFMA16(vf[kk], *(const bf16x8*)(AT + c * 72 + kk * 32 + fq * 8), acc);
                if (cidx >= 4) {
                    const int p = (cidx - 4) * 64 + c, tok = dir ? (SEQ - 1 - p) : p;
                    *(u32x2*)(O + (size_t)(b * SEQ + tok) * 2048 + h * 128 + dvh * 64 + dvt * 16 + 4 * fq) = pk4(acc[0], acc[1], acc[2], acc[3]);
                }
            }
        }
        {
            const float eg63 = GS[64 + 63];
            bf16x8 af[2];
#pragma unroll
            for (int kk = 0; kk < 2; ++kk) af[kk] = *(const bf16x8*)(KT + (w * 16 + fr) * 72 + kk * 32 + fq * 8);
#pragma unroll
            for (int j = 0; j < 4; ++j) {
                sacc[j] = sacc[j] * eg63;
#pragma unroll
                for (int kk = 0; kk < 2; ++kk) sacc[j] = MFMA16(af[kk], *(const bf16x8*)(VD + (j * 16 + fr) * 72 + kk * 32 + fq * 8), sacc[j]);
            }
        }
        __syncthreads();
#pragma unroll
        for (int j = 0; j < 4; ++j) *(u32x2*)(ST + (j * 16 + fr) * 136 + w * 16 + 4 * fq) = pk4(sacc[j][0], sacc[j][1], sacc[j][2], sacc[j][3]);
    }
    __syncthreads();
}

__device__ void ytrans_unit(const bf16_t* YT, bf16_t* Y, int unit, bf16_t* tile) {
    const int tid = tid_opaque(), cb = unit & 31, tb = unit >> 5, r = tid >> 3, c8 = (tid & 7) * 8;
    *(u32x4*)(tile + r * 72 + c8) = *(const u32x4*)(YT + (size_t)(cb * 64 + r) * MT + tb * 64 + c8);
    __syncthreads();
    u32x4 w;
    w.x = (unsigned)tile[(c8 + 0) * 72 + r] | ((unsigned)tile[(c8 + 1) * 72 + r] << 16);
    w.y = (unsigned)tile[(c8 + 2) * 72 + r] | ((unsigned)tile[(c8 + 3) * 72 + r] << 16);
    w.z = (unsigned)tile[(c8 + 4) * 72 + r] | ((unsigned)tile[(c8 + 5) * 72 + r] << 16);
    w.w = (unsigned)tile[(c8 + 6) * 72 + r] | ((unsigned)tile[(c8 + 7) * 72 + r] << 16);
    *(u32x4*)(Y + (size_t)(tb * 64 + r) * 2048 + cb * 64 + c8) = w;
    __syncthreads();
}

__device__ void p6_on(KA a) {
    const bf16_t* OF = (const bf16_t*)(a->ws + WS_RA); const bf16_t* OB = OF + (size_t)MT * 2048;
    const bf16_t* ZG = (const bf16_t*)(a->ws + WS_RB); bf16_t* ON = (bf16_t*)(a->ws + WS_HA);
    const float* nw = a->in[10];
    const size_t nthr = (size_t)gridDim.x * NT;
    for (size_t i = (size_t)blockIdx.x * NT + tid_opaque(); i < (size_t)MT * 256; i += nthr) {
        const int row = (int)(i >> 8), c8 = (int)(i & 255) * 8;
        float f[8], g[8], z[8];
        unpack8(*(const u32x4*)(OF + (size_t)row * 2048 + c8), f); unpack8(*(const u32x4*)(OB + (size_t)row * 2048 + c8), g);
        unpack8(*(const u32x4*)(ZG + (size_t)row * NZG + c8), z);
        float ss = 0.f;
#pragma unroll
        for (int e = 0; e < 8; ++e) { f[e] += g[e]; ss += f[e] * f[e]; }
        ss += __shfl_xor(ss, 1, 64); ss += __shfl_xor(ss, 2, 64); ss += __shfl_xor(ss, 4, 64); ss += __shfl_xor(ss, 8, 64);
        const float rs = rsqrtf(ss * (1.0f / 128.0f) + 1e-6f);
        float o[8];
#pragma unroll
        for (int e = 0; e < 8; ++e) o[e] = f[e] * rs * nw[(c8 & 127) + e] * siluf_(z[e]);
        *(u32x4*)(ON + (size_t)row * 2048 + c8) = pack8(o);
    }
}

__device__ void p8_tables(KA a) {
    bf16_t* U16 = (bf16_t*)(a->ws + WS_RA); bf16_t* V16 = U16 + (size_t)MT * 2048;
    const size_t nthr = (size_t)gridDim.x * NT, n8 = (size_t)16384 * 256;
    for (size_t i = (size_t)blockIdx.x * NT + tid_opaque(); i < 2 * n8; i += nthr) {
        const size_t j = (i < n8) ? i : i - n8; const float* sp = ((i < n8) ? a->in[27] : a->in[28]) + j * 8;
        const f32x4 x0 = *(const f32x4*)sp, x1 = *(const f32x4*)(sp + 4);
        u32x4 w; w.x = pk2(x0[0], x0[1]); w.y = pk2(x0[2], x0[3]); w.z = pk2(x1[0], x1[1]); w.w = pk2(x1[2], x1[3]);
        *(u32x4*)(((i < n8) ? U16 : V16) + j * 8) = w;
    }
}

__device__ void p9_ln1(KA a) {
    const float* mod = (const float*)(a->ws + WS_MOD); bf16_t* H2 = (bf16_t*)(a->ws + WS_RA) + (size_t)2 * MT * 2048;
    const float* g = a->in[23]; const float* bb = a->in[24];
    const int lane = tid_opaque() & 63, wv = blockIdx.x * 8 + (tid_opaque() >> 6), nwv = gridDim.x * 8;
    for (int row = wv; row < MT; row += nwv) {
        float* rp = a->out + (size_t)row * 2048;
        float v[32]; float s = 0.f;
#pragma unroll
        for (int i = 0; i < 4; ++i) { const f32x4 x0 = *(const f32x4*)(rp + i * 512 + lane * 8), x1 = *(const f32x4*)(rp + i * 512 + lane * 8 + 4);
#pragma unroll
            for (int e = 0; e < 4; ++e) { v[i * 8 + e] = x0[e]; v[i * 8 + 4 + e] = x1[e]; s += x0[e] + x1[e]; } }
        const float mu = wave_sum(s) * (1.0f / 2048.0f);
        float q = 0.f;
#pragma unroll
        for (int e = 0; e < 32; ++e) { const float d = v[e] - mu; q += d * d; }
        const float rstd = rsqrtf(wave_sum(q) * (1.0f / 2048.0f) + 1e-5f);
        const float* mp = mod + (row >> 12) * 12288;
#pragma unroll
        for (int i = 0; i < 4; ++i) {
            const int col = i * 512 + lane * 8;
            float xn[8], h[8];
#pragma unroll
            for (int e = 0; e < 8; ++e) { xn[e] = (v[i * 8 + e] - mu) * rstd * g[col + e] + bb[col + e]; h[e] = xn[e] * (1.0f + mp[8192 + col + e]) + mp[6144 + col + e]; }
            *(f32x4*)(rp + col) = (f32x4){xn[0], xn[1], xn[2], xn[3]}; *(f32x4*)(rp + col + 4) = (f32x4){xn[4], xn[5], xn[6], xn[7]};
            *(u32x4*)(H2 + (size_t)row * 2048 + col) = pack8(h);
        }
    }
}

__device__ __forceinline__ void topk16_2(float v0, float v1, int lane, float& rs, int& ri) {
    rs = -INFINITY; ri = 0;
    for (int it = 0; it < 16; ++it) {
        const float wm = wave_max(fmaxf(v0, v1));
        const unsigned long long b0 = __ballot(v0 == wm), b1 = __ballot(v1 == wm);
        int key;
        if (b0) { const int l = __ffsll((long long)b0) - 1; key = l; if (lane == l) v0 = -INFINITY; }
        else { const int l = __ffsll((long long)b1) - 1; key = 64 + l; if (lane == l) v1 = -INFINITY; }
        if (lane == it) { rs = wm; ri = key; }
    }
}
__device__ __forceinline__ void topk16_4(float c0, float c1, float c2, float c3, int lane, float& rs, int& ri) {
    rs = -INFINITY; ri = 0;
    for (int it = 0; it < 16; ++it) {
        const float wm = wave_max(fmaxf(fmaxf(c0, c1), fmaxf(c2, c3)));
        const unsigned long long b0 = __ballot(c0 == wm), b1 = __ballot(c1 == wm), b2 = __ballot(c2 == wm), b3 = __ballot(c3 == wm);
        const unsigned long long ball = b0 | b1 | b2 | b3;
        const int l = __ffsll((long long)ball) - 1;
        const int r = ((b0 >> l) & 1ull) ? 0 : ((b1 >> l) & 1ull) ? 1 : ((b2 >> l) & 1ull) ? 2 : 3;
        if (lane == l) { if (r == 0) c0 = -INFINITY; else if (r == 1) c1 = -INFINITY; else if (r == 2) c2 = -INFINITY; else c3 = -INFINITY; }
        if (lane == it) { rs = wm; ri = l * 4 + r; }
    }
}
__device__ void peer_unit(KA a, int unit, unsigned char* lds) {
    const int tid = tid_opaque(), lane = tid & 63, wid = tid >> 6;
    float* SK = (float*)lds; float* QT = (float*)(lds + 66048); float* SC = (float*)(lds + 82432);
    int* IGI = (int*)(lds + 98816); float* IGG = (float*)(lds + 115200);
    const int tok0 = unit * 32;
    const float* Qp = (const float*)(a->ws + WS_RB); const float* subk = a->in[26];
    const bf16_t* U16 = (const bf16_t*)(a->ws + WS_RA); const bf16_t* V16 = U16 + (size_t)MT * 2048; const bf16_t* H2 = V16 + (size_t)MT * 2048;
    const float* mod = (const float*)(a->ws + WS_MOD);
    for (int h = 0; h < 8; ++h) {
        float tps[2][4]; int tpi[2][4];
#pragma unroll
        for (int p = 0; p < 2; ++p) {
            __syncthreads();
            for (int i = tid; i < 128 * 32; i += NT) { const int key = i >> 5, d4 = (i & 31) * 4; const f32x4 v = *(const f32x4*)(subk + (size_t)((h * 2 + p) * 128 + key) * 128 + d4);
                float* t = SK + key * 129 + d4; t[0] = v.x; t[1] = v.y; t[2] = v.z; t[3] = v.w; }
            for (int i = tid; i < 32 * 32; i += NT) { const int r = i >> 5, d4 = (i & 31) * 4; *(f32x4*)(QT + r * 128 + d4) = *(const f32x4*)(Qp + (size_t)(tok0 + r) * 2048 + h * 256 + p * 128 + d4); }
            __syncthreads();
            {
                const int key = tid & 127, tg = tid >> 7;
                float s[8];
#pragma unroll
                for (int e = 0; e < 8; ++e) s[e] = 0.f;
                for (int d4 = 0; d4 < 32; ++d4) {
                    const float* sp = SK + key * 129 + d4 * 4; const float k0 = sp[0], k1 = sp[1], k2 = sp[2], k3 = sp[3];
#pragma unroll
                    for (int e = 0; e < 8; ++e) { const f32x4 q = *(const f32x4*)(QT + (tg * 8 + e) * 128 + d4 * 4); s[e] += (k0 * q.x + k1 * q.y) + (k2 * q.z + k3 * q.w); }
                }
#pragma unroll
                for (int e = 0; e < 8; ++e) SC[(tg * 8 + e) * 128 + key] = s[e];
            }
            __syncthreads();
#pragma unroll
            for (int rr = 0; rr < 4; ++rr) { const int row = wid * 4 + rr; topk16_2(SC[row * 128 + lane], SC[row * 128 + 64 + lane], lane, tps[p][rr], tpi[p][rr]); }
        }
#pragma unroll
        for (int rr = 0; rr < 4; ++rr) {
            const int row = wid * 4 + rr;
            const float s0 = __shfl(tps[0][rr], lane >> 2, 64);
            const float c0 = s0 + __shfl(tps[1][rr], 4 * (lane & 3) + 0, 64), c1 = s0 + __shfl(tps[1][rr], 4 * (lane & 3) + 1, 64),
                        c2 = s0 + __shfl(tps[1][rr], 4 * (lane & 3) + 2, 64), c3 = s0 + __shfl(tps[1][rr], 4 * (lane & 3) + 3, 64);
            float bs; int bc; topk16_4(c0, c1, c2, c3, lane, bs, bc);
            const int e0 = __shfl(tpi[0][rr], (bc >> 4) & 15, 64), e1 = __shfl(tpi[1][rr], bc & 15, 64);
            const float mx = __shfl(bs, 0, 64);
            const float ex = (lane < 16) ? expf(bs - mx) : 0.f;
            const float sm = wave_sum(ex);
            if (lane < 16) { IGI[row * 128 + h * 16 + lane] = e0 * 128 + e1; IGG[row * 128 + h * 16 + lane] = ex / sm; }
        }
    }
    __syncthreads();
    for (int rr = 0; rr < 4; ++rr) {
        const int row = wid * 4 + rr, tok = tok0 + row;
        float hx[32], y[32];
#pragma unroll
        for (int i = 0; i < 4; ++i) { float t8[8]; unpack8(*(const u32x4*)(H2 + (size_t)tok * 2048 + i * 512 + lane * 8), t8);
#pragma unroll
            for (int e = 0; e < 8; ++e) { hx[i * 8 + e] = t8[e]; y[i * 8 + e] = 0.f; } }
#if DBG_MODE != 2
#pragma unroll 2
        for (int e = 0; e < 128; ++e) {
            const int idx = __builtin_amdgcn_readfirstlane(IGI[row * 128 + e]); const float gt = IGG[row * 128 + e];
            const bf16_t* up = U16 + (size_t)idx * 2048 + lane * 8; const bf16_t* vp = V16 + (size_t)idx * 2048 + lane * 8;
            const u32x4 u0 = *(const u32x4*)up, u1 = *(const u32x4*)(up + 512), u2 = *(const u32x4*)(up + 1024), u3 = *(const u32x4*)(up + 1536);
            const u32x4 v0 = *(const u32x4*)vp, v1 = *(const u32x4*)(vp + 512), v2 = *(const u32x4*)(vp + 1024), v3 = *(const u32x4*)(vp + 1536);
            float t8[8]; float dot = 0.f;
            unpack8(u0, t8);
#pragma unroll
            for (int k = 0; k < 8; ++k) dot += t8[k] * hx[k];
            unpack8(u1, t8);
#pragma unroll
            for (int k = 0; k < 8; ++k) dot += t8[k] * hx[8 + k];
            unpack8(u2, t8);
#pragma unroll
            for (int k = 0; k < 8; ++k) dot += t8[k] * hx[16 + k];
            unpack8(u3, t8);
#pragma unroll
            for (int k = 0; k < 8; ++k) dot += t8[k] * hx[24 + k];
            dot = wave_sum(dot);
            const float cf = gt * 0.5f * dot * (1.0f + erff(dot * 0.7071067811865476f));
            unpack8(v0, t8);
#pragma unroll
            for (int k = 0; k < 8; ++k) y[k] += cf * t8[k];
            unpack8(v1, t8);
#pragma unroll
            for (int k = 0; k < 8; ++k) y[8 + k] += cf * t8[k];
            unpack8(v2, t8);
#pragma unroll
            for (int k = 0; k < 8; ++k) y[16 + k] += cf * t8[k];
            unpack8(v3, t8);
#pragma unroll
            for (int k = 0; k < 8; ++k) y[24 + k] += cf * t8[k];
        }
#endif
        float* rp = a->out + (size_t)tok * 2048; const float* mp = mod + (tok >> 12) * 12288 + 10240;
        float val[32]; float s = 0.f;
#pragma unroll
        for (int i = 0; i < 4; ++i) { const int col = i * 512 + lane * 8; const f32x4 x0 = *(const f32x4*)(rp + col), x1 = *(const f32x4*)(rp + col + 4);
#pragma unroll
            for (int e = 0; e < 4; ++e) { val[i * 8 + e] = ALPHA * x0[e] + mp[col + e] * y[i * 8 + e]; val[i * 8 + 4 + e] = ALPHA * x1[e] + mp[col + 4 + e] * y[i * 8 + 4 + e]; s += val[i * 8 + e] + val[i * 8 + 4 + e]; } }
        const float mu = wave_sum(s) * (1.0f / 2048.0f);
        float q = 0.f;
#pragma unroll
        for (int e = 0; e < 32; ++e) { const float d = val[e] - mu; q += d * d; }
        const float rstd = rsqrtf(wave_sum(q) * (1.0f / 2048.0f) + 1e-5f);
        const float* g = a->in[29]; const float* bb = a->in[30];
#pragma unroll
        for (int i = 0; i < 4; ++i) { const int col = i * 512 + lane * 8; float o[8];
#pragma unroll
            for (int e = 0; e < 8; ++e) o[e] = (val[i * 8 + e] - mu) * rstd * g[col + e] + bb[col + e];
            *(f32x4*)(rp + col) = (f32x4){o[0], o[1], o[2], o[3]}; *(f32x4*)(rp + col + 4) = (f32x4){o[4], o[5], o[6], o[7]}; }
    }
    __syncthreads();
}

__global__ void __launch_bounds__(NT, 2) fwd_mega(Args a_) {
    KA a = (KA)__builtin_amdgcn_kernarg_segment_ptr();
    extern __shared__ __attribute__((aligned(16))) unsigned char lds[];
    cg::grid_group grid = cg::this_grid();
    float* lf = (float*)lds;
    const int lo = a->ph_lo, hi = a->ph_hi;
#define IN(k) (lo <= (k) && (k) < hi)
#define SEAM(k) do { if (IN(k) && IN((k) + 1)) grid.sync(); asm volatile("" : "+s"(a)); } while (0)
    unsigned char* ws = a->ws;
    bf16_t* HA = (bf16_t*)(ws + WS_HA); bf16_t* WT = (bf16_t*)(ws + WS_WT); bf16_t* SW = (bf16_t*)(ws + WS_SW);
    bf16_t* RA = (bf16_t*)(ws + WS_RA); bf16_t* RB = (bf16_t*)(ws + WS_RB);
    const float* mod = (const float*)(ws + WS_MOD);

    if (IN(0)) { p0_mod_hid2(a, lf); p0_transposes(a, lf); }
    SEAM(0);
    if (IN(1)) { p1_ha(a); }
    SEAM(1);
    if (IN(2)) {
        run_gemm(lds, WT + (size_t)WT_HY0 * 2048, HA, NHY, MT, FStoreBf16{RA, MT});
        run_gemm(lds, HA, WT, MA, NQKVP, FStoreQKV{RB, (float*)(ws + WS_AB)});
    }
    SEAM(2);
    if (IN(3)) {
        hyena_setup(lds);
        for (int c = blockIdx.x; c < 2048; c += gridDim.x) hyena_item(a, c, lds);
        for (int u = blockIdx.x; u < 12288 + 192; u += gridDim.x) qkvpost_unit(a, u, lds);
    }
    SEAM(3);
    if (IN(4)) {
        { const int wv = tid_opaque() >> 6; for (int pid = blockIdx.x * 8 + wv; pid < 8704; pid += gridDim.x * 8) tprep_wave(a, pid, lds + wv * 17920); }
        grid.sync();
        for (int it = blockIdx.x; it < 256; it += gridDim.x) delta_item(a, it, lds);
    }
    SEAM(4);
    if (IN(5)) {
        run_gemm(lds, HA, WT + (size_t)WT_ZG0 * 2048, MT, NZG, FStoreBf16{RB, NZG});
        for (int u = blockIdx.x; u < 8192; u += gridDim.x) ytrans_unit((const bf16_t*)a->out, RA + (size_t)2 * MT * 2048, u, (bf16_t*)lds);
    }
    SEAM(5);
    if (IN(6)) { p6_on(a); }
    SEAM(6);
    if (IN(7)) {
        run_gemm(lds, HA  , SW, MT, D, FGatePA{RB, WT  });
        run_gemm(lds, RA + (size_t)2 * MT * 2048  , SW + (size_t)1 * D * D, MT, D, FGatePH{RB, WT  });
    }
    SEAM(7);
    if (IN(8)) {
        run_gemm(lds, WT  , SW + (size_t)2 * D * D, MT, D, FOut{a->in[0], mod, a->out});
        p8_tables(a);
    }
    SEAM(8);
    if (IN(9)) { p9_ln1(a); }
    SEAM(9);
    if (IN(10)) { run_gemm(lds, RA + (size_t)2 * MT * 2048  , SW + (size_t)3 * D * D, MT, D, FStoreF32{(float*)(ws + WS_RB), D}); }
    SEAM(10);
    if (IN(11)) { for (int u = blockIdx.x; u < MT / 32; u += gridDim.x) peer_unit(a, u, lds); }
#undef IN
#undef SEAM
}

extern "C" void kernel_launch(void* const* d_in, const int* in_sizes, int n_in, void* d_out, int out_size, void* d_ws, size_t ws_size, hipStream_t stream) {
    static int grid = 0;
    if (grid == 0) {
        if (n_in != 31 || out_size != MT * D || ws_size < WS_END) { fprintf(stderr, "kernel_launch: unexpected problem shape / workspace (%d inputs, out %d, ws %zu)\n", n_in, out_size, ws_size); grid = -1; return; }
        int dev = 0, cus = 0, per_cu = 0;
        (void)hipGetDevice(&dev);
        (void)hipDeviceGetAttribute(&cus, hipDeviceAttributeMultiprocessorCount, dev);
        (void)hipFuncSetAttribute((const void*)fwd_mega, hipFuncAttributeMaxDynamicSharedMemorySize, LDS_BYTES);
        (void)hipOccupancyMaxActiveBlocksPerMultiprocessor(&per_cu, (const void*)fwd_mega, NT, LDS_BYTES);
        if (per_cu < 1) per_cu = 1;
        grid = cus * per_cu;
        (void)hipGetLastError();
    }
    if (grid < 0) return;
    Args a{};
    for (int i = 0; i < 31; ++i) a.in[i] = (const float*)d_in[i];
    a.out = (float*)d_out; a.ws = (unsigned char*)d_ws; a.ph_lo = 0; a.ph_hi = 12;
    void* args[] = {&a};
    hipError_t e = hipLaunchCooperativeKernel((const void*)fwd_mega, dim3(grid), dim3(NT), args, LDS_BYTES, stream);
    if (e != hipSuccess) fprintf(stderr, "cooperative launch failed: %s (grid %d)\n", hipGetErrorString(e), grid);
}
```

```cpp
#include <hip/hip_runtime.h>
#include <hip/hip_cooperative_groups.h>
#include <cstdio>
#include <cstdint>
namespace cg = cooperative_groups;

#ifndef DBG_MODE
#define DBG_MODE 0
#endif

__device__ __forceinline__ int tid_opaque() { int t = threadIdx.x; asm volatile("" : "+v"(t)); return t; }

namespace pg8 {
#define PG8_LAS __attribute__((address_space(3)))
typedef unsigned short bf16_t;
typedef short bf16x8 __attribute__((ext_vector_type(8)));
typedef float f32x4 __attribute__((ext_vector_type(4)));
typedef unsigned u32x4 __attribute__((ext_vector_type(4)));
constexpr int BM = 256, BK = 64, HALF = 128, HTB = HALF * BK * 2, STAGE_BYTES = 8 * HTB, NXCD = 8, WGM = 8;

__host__ __device__ __forceinline__ int lds_byte(int r, int c) { const int st = (r >> 4) * 2 + (c >> 5), rr = r & 15, cc = c & 31, ob = rr * 64 + cc * 2; return st * 1024 + (ob ^ (((ob >> 9) & 1) << 5)); }
__host__ __device__ __forceinline__ void stage_rc(int b, int& R, int& C) { const int st = b / 1024, sb = b % 1024, swz = sb ^ (((sb >> 9) & 1) << 5); R = (st >> 1) * 16 + swz / 64; C = (st & 1) * 32 + (swz % 64) / 2; }
__host__ __device__ __forceinline__ int perm32(int rho) { const int n = rho >> 4, i = rho & 15; return 8 * (i >> 2) + 4 * n + (i & 3); }

struct Unit { int pm, pn; };
struct Gemm { const bf16_t* A; const bf16_t* Bt; int M, N, K; };

struct StaticOrder {
    int nM, nN, nwg, G, c;
    __host__ __device__ void init(int M, int N, int G_, int c_) { nM = M / BM; nN = N / BM; nwg = nM * nN; G = G_; c = c_; }
    __host__ __device__ bool next(int i, Unit& u) const {
        const long L = (long)i * G + c; if (L >= nwg) return false;
        int wgid = (int)L; { const int q = nwg / NXCD, r = nwg % NXCD, xcd = wgid % NXCD, off = wgid / NXCD; wgid = (xcd < r ? xcd * (q + 1) : r * (q + 1) + (xcd - r) * q) + off; }
        const int nig = WGM * nN, gid = wgid / nig, fm = gid * WGM, gsz = (nM - fm) < WGM ? (nM - fm) : WGM;
        u.pm = fm + ((wgid % nig) % gsz); u.pn = (wgid % nig) / gsz; return true;
    }
    __device__ __forceinline__ void a_ready(const Unit&) const {}
    __device__ __forceinline__ void done(const Unit&) const {}
};

__device__ __forceinline__ unsigned cvt_pk_bf16(float lo, float hi) { unsigned r; asm volatile("v_cvt_pk_bf16_f32 %0, %1, %2" : "=v"(r) : "v"(lo), "v"(hi)); return r; }

template <class F> struct EpiGen {
    static constexpr bool PERM = true, AFTER_DRAIN = false;
    F f;
    __device__ __forceinline__ void operator()(const f32x4 (&acc)[2][2][4][2], const Unit& u, int wr, int wc, int fr, int fq) const {
        const int row0 = u.pm * BM + wr * 64 + fr, col0 = u.pn * BM + wc * 32 + 8 * fq;
#pragma unroll
        for (int ai = 0; ai < 2; ++ai)
#pragma unroll
            for (int m = 0; m < 4; ++m)
#pragma unroll
                for (int bj = 0; bj < 2; ++bj) f(row0 + ai * HALF + m * 16, col0 + bj * HALF, acc[ai][bj][m][0], acc[ai][bj][m][1]);
    }
};

template <class Epi, class Sched>
__device__ __forceinline__ void gemm_phase(PG8_LAS unsigned char* lds, const Gemm g, const Sched& S, const Epi& E) {
    const int tid = tid_opaque(), wid = __builtin_amdgcn_readfirstlane(tid >> 6), lane = tid & 63, wr = wid >> 2, wc = wid & 3, fr = lane & 15, fq = lane >> 4;
    const int K = g.K, nt = K / BK;
    unsigned voffA[2], voffB[2];
#pragma unroll
    for (int i = 0; i < 2; ++i) { int R, C; stage_rc(tid * 16 + i * 8192, R, C); const int Rb = Epi::PERM ? ((R & ~31) + perm32(R & 31)) : R;
        voffA[i] = (unsigned)(R * K + C) * 2u; voffB[i] = (unsigned)(Rb * K + C) * 2u; }
    const size_t kstep = (size_t)(BK * 2);
    const size_t hstep = (size_t)HALF * K * 2;
    const size_t tstep = 2 * hstep;
    const unsigned ldsw = (unsigned)wid * 1024u;
    const int aoff = lds_byte(wr * 64 + fr, fq * 8), boff = lds_byte(wc * 32 + fr, fq * 8);
#define PG8_SA(b, h) (((b) * 2 + (h)) * HTB)
#define PG8_SB(b, h) ((4 + (b) * 2 + (h)) * HTB)
#define PG8_STAGE(bufoff, gbase, voff) do { _Pragma("unroll") for (int _i = 0; _i < 2; ++_i) \
        __builtin_amdgcn_global_load_lds((const unsigned*)((const char*)(gbase) + (voff)[_i]), (PG8_LAS unsigned*)(lds + (bufoff) + ldsw + _i * 8192), 16, 0, 0); } while (0)
#define PG8_LDA(dst, b, h) do { _Pragma("unroll") for (int m = 0; m < 4; ++m) _Pragma("unroll") for (int k = 0; k < 2; ++k) dst[m][k] = *(const PG8_LAS bf16x8*)(lds + PG8_SA(b, h) + aoff + m * 2048 + k * 1024); } while (0)
#define PG8_LDB(dst, b, h) do { _Pragma("unroll") for (int n = 0; n < 2; ++n) _Pragma("unroll") for (int k = 0; k < 2; ++k) dst[n][k] = *(const PG8_LAS bf16x8*)(lds + PG8_SB(b, h) + boff + n * 2048 + k * 1024); } while (0)
#define PG8_MMA(ai, bj, At, Bt) do { __builtin_amdgcn_s_setprio(1); _Pragma("unroll") for (int m = 0; m < 4; ++m) _Pragma("unroll") for (int n = 0; n < 2; ++n) _Pragma("unroll") for (int k = 0; k < 2; ++k) \
        acc[ai][bj][m][n] = __builtin_amdgcn_mfma_f32_16x16x32_bf16(Bt[n][k], At[m][k], acc[ai][bj][m][n], 0, 0, 0); __builtin_amdgcn_s_setprio(0); } while (0)
#define PG8_WAIT_V(n) asm volatile("s_waitcnt vmcnt(" #n ")" ::: "memory")
#define PG8_WAIT_L(n) asm volatile("s_waitcnt lgkmcnt(" #n ")" ::: "memory")
#define PG8_BAR __builtin_amdgcn_s_barrier()
#define PG8_SCHED __builtin_amdgcn_sched_barrier(0)
    Unit cur, nxt; int ui = 0;
    if (!S.next(0, cur)) return;
    f32x4 acc[2][2][4][2];
#pragma unroll
    for (int a = 0; a < 2; ++a)
#pragma unroll
        for (int b = 0; b < 2; ++b)
#pragma unroll
            for (int m = 0; m < 4; ++m)
#pragma unroll
                for (int n = 0; n < 2; ++n) acc[a][b][m][n] = (f32x4){0.f, 0.f, 0.f, 0.f};
    bf16x8 At[4][2], B0[2][2], B1[2][2];
    const char* cA = (const char*)g.A + (size_t)cur.pm * tstep; const char* cB = (const char*)g.Bt + (size_t)cur.pn * tstep;
    S.a_ready(cur);
    PG8_STAGE(PG8_SB(0, 0), cB, voffB); PG8_STAGE(PG8_SA(0, 0), cA, voffA); PG8_STAGE(PG8_SB(0, 1), cB + hstep, voffB); PG8_STAGE(PG8_SA(0, 1), cA + hstep, voffA);
    if (wr == 1) PG8_BAR;
    PG8_WAIT_V(4); PG8_BAR;
    PG8_STAGE(PG8_SB(1, 0), cB + kstep, voffB); PG8_STAGE(PG8_SA(1, 0), cA + kstep, voffA); PG8_STAGE(PG8_SB(1, 1), cB + hstep + kstep, voffB);
    PG8_WAIT_V(6); PG8_BAR;
    for (;;) {
        const bool has_next = S.next(ui + 1, nxt);
        const char* nA = has_next ? (const char*)g.A + (size_t)nxt.pm * tstep : cA; const char* nB = has_next ? (const char*)g.Bt + (size_t)nxt.pn * tstep : cB;
        for (int t = 0; t < nt; t += 2) {
            const bool last = (t == nt - 2);
            const char* a1 = cA + (size_t)(t + 1) * kstep;
            const char* a2 = last ? nA : cA + (size_t)(t + 2) * kstep; const char* b2 = last ? nB : cB + (size_t)(t + 2) * kstep;
            const char* a3 = a2 + kstep; const char* b3 = b2 + kstep;
            if (last && has_next) S.a_ready(nxt);
            PG8_LDB(B0, 0, 0); PG8_SCHED; PG8_LDA(At, 0, 0); PG8_STAGE(PG8_SA(1, 1), a1 + hstep, voffA);
            PG8_WAIT_L(8); PG8_BAR; PG8_WAIT_L(0); PG8_MMA(0, 0, At, B0); PG8_BAR; PG8_SCHED;
            PG8_LDB(B1, 0, 1); PG8_STAGE(PG8_SB(0, 0), b2, voffB);
            PG8_BAR; PG8_WAIT_L(0); PG8_MMA(0, 1, At, B1); PG8_BAR;
            PG8_LDA(At, 0, 1); PG8_STAGE(PG8_SA(0, 0), a2, voffA);
            PG8_BAR; PG8_WAIT_L(0); PG8_MMA(1, 0, At, B0); PG8_BAR; PG8_SCHED;
            PG8_STAGE(PG8_SB(0, 1), b2 + hstep, voffB);
            PG8_WAIT_V(6); PG8_BAR; PG8_MMA(1, 1, At, B1); PG8_BAR;
            PG8_LDB(B0, 1, 0); PG8_SCHED; PG8_LDA(At, 1, 0); PG8_STAGE(PG8_SA(0, 1), a2 + hstep, voffA);
            PG8_WAIT_L(8); PG8_BAR; PG8_WAIT_L(0); PG8_MMA(0, 0, At, B0); PG8_BAR; PG8_SCHED;
            PG8_LDB(B1, 1, 1); PG8_STAGE(PG8_SB(1, 0), b3, voffB);
            PG8_BAR; PG8_WAIT_L(0); PG8_MMA(0, 1, At, B1); PG8_BAR;
            PG8_LDA(At, 1, 1); PG8_STAGE(PG8_SA(1, 0), a3, voffA);
            PG8_BAR; PG8_WAIT_L(0); PG8_MMA(1, 0, At, B0); PG8_BAR; PG8_SCHED;
            PG8_STAGE(PG8_SB(1, 1), b3 + hstep, voffB);
            PG8_WAIT_V(6); PG8_BAR; PG8_MMA(1, 1, At, B1); PG8_BAR;
        }
        E(acc, cur, wr, wc, fr, fq); S.done(cur);
        if (!has_next) break;
#pragma unroll
        for (int a = 0; a < 2; ++a)
#pragma unroll
            for (int b = 0; b < 2; ++b)
#pragma unroll
                for (int m = 0; m < 4; ++m)
#pragma unroll
                    for (int n = 0; n < 2; ++n) acc[a][b][m][n] = (f32x4){0.f, 0.f, 0.f, 0.f};
        cur = nxt; cA = nA; cB = nB; ++ui;
    }
    PG8_WAIT_V(0);
    if (wr == 0) PG8_BAR;
    PG8_BAR;
#undef PG8_SA
#undef PG8_SB
#undef PG8_STAGE
#undef PG8_LDA
#undef PG8_LDB
#undef PG8_MMA
#undef PG8_WAIT_V
#undef PG8_WAIT_L
#undef PG8_BAR
#undef PG8_SCHED
}
}

typedef unsigned short bf16_t;
typedef float f32x4 __attribute__((ext_vector_type(4)));
typedef unsigned u32x4 __attribute__((ext_vector_type(4)));
#define LAS __attribute__((address_space(3)))

constexpr int NT = 512;
constexpr int LDS_BYTES = 160 * 1024;
constexpr int D = 2048, NB = 4, SEQ = 4096, CTXL = 256;
constexpr int MT = NB * SEQ;
constexpr int MC = NB * CTXL;
constexpr int MA = MT + MC;
constexpr int NQKVP = 6400;
constexpr int PQ_LD = 6144;
constexpr int NHY = 6144, NZG = 6144;
constexpr int WT_ROWS = NQKVP + NHY + NZG;
constexpr int WT_HY0 = NQKVP, WT_ZG0 = NQKVP + NHY;
constexpr float ALPHA = 1.189207115002721f;

constexpr size_t MiB = (size_t)1 << 20;
constexpr size_t WS_MOD = 0, WS_HID2 = 1 * MiB, WS_SW = 2 * MiB, WS_HA = 34 * MiB, WS_WT = 102 * MiB, WS_RA = 175 * MiB, WS_RB = 367 * MiB, WS_AB = 580 * MiB, WS_END = 658 * MiB;

struct Args { const float* in[31]; float* out; unsigned char* ws; int ph_lo, ph_hi; };
typedef const __attribute__((address_space(4))) Args* KA;

__device__ __forceinline__ unsigned f2bf(float f) { unsigned u = __float_as_uint(f); return (u + 0x7fffu + ((u >> 16) & 1u)) >> 16; }
__device__ __forceinline__ unsigned pk2(float lo, float hi) { return f2bf(lo) | (f2bf(hi) << 16); }
__device__ __forceinline__ float bflo(unsigned w) { return __uint_as_float(w << 16); }
__device__ __forceinline__ float bfhi(unsigned w) { return __uint_as_float(w & 0xffff0000u); }
__device__ __forceinline__ float bf2f(bf16_t b) { return __uint_as_float(((unsigned)b) << 16); }
__device__ __forceinline__ void unpack8(const u32x4 w, float (&o)[8]) { o[0] = bflo(w.x); o[1] = bfhi(w.x); o[2] = bflo(w.y); o[3] = bfhi(w.y); o[4] = bflo(w.z); o[5] = bfhi(w.z); o[6] = bflo(w.w); o[7] = bfhi(w.w); }
__device__ __forceinline__ u32x4 pack8(const float (&v)[8]) { u32x4 w; w.x = pk2(v[0], v[1]); w.y = pk2(v[2], v[3]); w.z = pk2(v[4], v[5]); w.w = pk2(v[6], v[7]); return w; }
__device__ __forceinline__ float sigmoidf_(float x) { return 1.0f / (1.0f + expf(-x)); }
__device__ __forceinline__ float siluf_(float x) { return x / (1.0f + expf(-x)); }
__device__ __forceinline__ float rdlane(float v, const int l) { return __builtin_bit_cast(float, __builtin_amdgcn_readlane(__builtin_bit_cast(int, v), l)); }
__device__ __forceinline__ float wave_sum(float v) {
    v += __builtin_bit_cast(float, __builtin_amdgcn_update_dpp(0, __builtin_bit_cast(int, v), 0x128, 0xf, 0xf, false));
    v += __builtin_bit_cast(float, __builtin_amdgcn_update_dpp(0, __builtin_bit_cast(int, v), 0x124, 0xf, 0xf, false));
    v += __builtin_bit_cast(float, __builtin_amdgcn_update_dpp(0, __builtin_bit_cast(int, v), 0x122, 0xf, 0xf, false));
    v += __builtin_bit_cast(float, __builtin_amdgcn_update_dpp(0, __builtin_bit_cast(int, v), 0x121, 0xf, 0xf, false));
    return (rdlane(v, 0) + rdlane(v, 16)) + (rdlane(v, 32) + rdlane(v, 48));
}
__device__ __forceinline__ float wave_max(float v) {
    v = fmaxf(v, __builtin_bit_cast(float, __builtin_amdgcn_update_dpp(0, __builtin_bit_cast(int, v), 0x128, 0xf, 0xf, false)));
    v = fmaxf(v, __builtin_bit_cast(float, __builtin_amdgcn_update_dpp(0, __builtin_bit_cast(int, v), 0x124, 0xf, 0xf, false)));
    v = fmaxf(v, __builtin_bit_cast(float, __builtin_amdgcn_update_dpp(0, __builtin_bit_cast(int, v), 0x122, 0xf, 0xf, false)));
    v = fmaxf(v, __builtin_bit_cast(float, __builtin_amdgcn_update_dpp(0, __builtin_bit_cast(int, v), 0x121, 0xf, 0xf, false)));
    return fmaxf(fmaxf(rdlane(v, 0), rdlane(v, 16)), fmaxf(rdlane(v, 32), rdlane(v, 48)));
}

__device__ void p0_mod_hid2(KA a, float* lf) {
    const int tid = tid_opaque(), bid = blockIdx.x;
    if (bid < 192) {
        const float* c = a->in[1]; const float* cc = a->in[3]; const float* w_ada = a->in[4]; const float* b_ada = a->in[5];
        float* mod = (float*)(a->ws + WS_MOD);
        for (int i = tid; i < 5 * 2048; i += NT) { const int r = i >> 11, k = i & 2047; const float v = (r < 4) ? c[r * 2048 + k] : cc[k]; lf[i] = siluf_(v); }
        __syncthreads();
        const int cl = tid & 63, kg = tid >> 6, col = bid * 64 + cl;
        float a0 = 0.f, a1 = 0.f, a2 = 0.f, a3 = 0.f, a4 = 0.f;
#pragma unroll 8
        for (int k = kg * 256; k < kg * 256 + 256; ++k) {
            const float w = w_ada[(size_t)k * 12288 + col];
            a0 += lf[k] * w; a1 += lf[2048 + k] * w; a2 += lf[4096 + k] * w; a3 += lf[6144 + k] * w; a4 += lf[8192 + k] * w;
        }
        float* red = lf + 5 * 2048;
        red[(kg * 5 + 0) * 64 + cl] = a0; red[(kg * 5 + 1) * 64 + cl] = a1; red[(kg * 5 + 2) * 64 + cl] = a2; red[(kg * 5 + 3) * 64 + cl] = a3; red[(kg * 5 + 4) * 64 + cl] = a4;
        __syncthreads();
        if (tid < 320) { const int r = tid >> 6; float s = 0.f;
#pragma unroll
            for (int g = 0; g < 8; ++g) s += red[(g * 5 + r) * 64 + cl];
            mod[r * 12288 + col] = s + b_ada[col]; }
        __syncthreads();
    } else {
        const float* w1 = a->in[12]; const float* b1 = a->in[13]; const float* w2 = a->in[14]; const float* b2 = a->in[15]; const float* freq = a->in[18];
        float* hid2 = (float*)(a->ws + WS_HID2);
        const int pb = (bid - 192) * 64, j = tid & 63, pl = tid >> 6;
        const float fj = freq[j];
        for (int it = 0; it < 8; ++it) {
            const int pos = pb + it * 8 + pl;
            const float tt = (float)pos * (1.0f / 4095.0f);
            float s1 = tt * w1[j];
            const float base = (6.283185307179586f / 4096.0f) * (float)pos;
            for (int e = 0; e < 16; ++e) {
                const float band = 1e-4f + (float)e * ((15.0f - 1e-4f) / 15.0f);
                const float ang = base * band;
                s1 += cosf(ang) * w1[(1 + e) * 64 + j] - sinf(ang) * w1[(17 + e) * 64 + j];
            }
            lf[pl * 64 + j] = sinf(fj * (s1 + b1[j]));
            __syncthreads();
            float s2 = 0.f;
            for (int i = 0; i < 64; ++i) s2 += lf[pl * 64 + i] * w2[i * 64 + j];
            hid2[pos * 64 + j] = sinf(fj * (s2 + b2[j]));
            __syncthreads();
        }
    }
}

__device__ void transpose_unit(const float* src, int ldn, int n0src, bf16_t* dst, int nb, int kb, float* tile) {
    const int tid = tid_opaque(), r = tid >> 4, c4 = tid & 15;
#pragma unroll
    for (int i = 0; i < 4; ++i) {
        const int kk = i * 32 + r;
        f32x4 v = (f32x4){0.f, 0.f, 0.f, 0.f};
        if (n0src >= 0) v = *(const f32x4*)(src + (size_t)(kb * 128 + kk) * ldn + n0src + c4 * 4);
        float* t = tile + kk * 65 + c4 * 4; t[0] = v.x; t[1] = v.y; t[2] = v.z; t[3] = v.w;
    }
    __syncthreads();
#pragma unroll
    for (int i = 0; i < 2; ++i) {
        const int chunk = tid + i * NT, nr = chunk >> 4, kc = chunk & 15;
        const float* t = tile + (kc * 8) * 65 + nr;
        u32x4 w; w.x = pk2(t[0], t[65]); w.y = pk2(t[130], t[195]); w.z = pk2(t[260], t[325]); w.w = pk2(t[390], t[455]);
        *(u32x4*)(dst + (size_t)(nb * 64 + nr) * 2048 + kb * 128 + kc * 8) = w;
    }
    __syncthreads();
}
__device__ __forceinline__ int win_colmap(int np) {
    if (np < 6144) return np;
    if (np < 6208) return 8192 + (np - 6144);
    if (np < 6400) return -1;
    if (np < 12544) return 8256 + (np - 6400);
    if (np < 14592) return 6144 + (np - 12544);
    return 14400 + (np - 14592);
}
__device__ void p0_transposes(KA a, float* lf) {
    bf16_t* WT = (bf16_t*)(a->ws + WS_WT); bf16_t* SW = (bf16_t*)(a->ws + WS_SW);
    const int NU_WT = (WT_ROWS / 64) * 16, NU_SW = 4 * 32 * 16;
    for (int u = blockIdx.x; u < NU_WT + NU_SW; u += gridDim.x) {
        if (u < NU_WT) { const int nb = u >> 4, kb = u & 15; transpose_unit(a->in[6], 18496, win_colmap(nb * 64), WT, nb, kb, lf); }
        else { const int v = u - NU_WT, mtx = v >> 9, nb = (v >> 4) & 31, kb = v & 15;
            const float* src = (mtx == 0) ? a->in[20] : (mtx == 1) ? a->in[21] : (mtx == 2) ? a->in[22] : a->in[25];
            transpose_unit(src, 2048, nb * 64, SW + (size_t)mtx * 2048 * 2048, nb, kb, lf); }
    }
}

__device__ void p1_ha(KA a) {
    const float* mod = (const float*)(a->ws + WS_MOD); bf16_t* HA = (bf16_t*)(a->ws + WS_HA);
    const size_t nthr = (size_t)gridDim.x * NT;
    for (size_t i = (size_t)blockIdx.x * NT + tid_opaque(); i < (size_t)MA * 256; i += nthr) {
        const int row = (int)(i >> 8), k8 = (int)(i & 255) * 8;
        const float* sp; int mr;
        if (row < MT) { sp = a->in[0] + (size_t)row * 2048 + k8; mr = row >> 12; } else { sp = a->in[2] + (size_t)(row - MT) * 2048 + k8; mr = 4; }
        const f32x4 x0 = *(const f32x4*)sp, x1 = *(const f32x4*)(sp + 4);
        const float* mp = mod + mr * 12288 + k8;
        const f32x4 h0 = *(const f32x4*)mp, h1 = *(const f32x4*)(mp + 4), s0 = *(const f32x4*)(mp + 2048), s1 = *(const f32x4*)(mp + 2052);
        float v[8];
#pragma unroll
        for (int e = 0; e < 4; ++e) { v[e] = x0[e] * (1.0f + s0[e]) + h0[e]; v[4 + e] = x1[e] * (1.0f + s1[e]) + h1[e]; }
        *(u32x4*)(HA + (size_t)row * 2048 + k8) = pack8(v);
    }
}

struct FStoreBf16 { bf16_t* O; int ldc;
    __device__ __forceinline__ void operator()(int row, int col, const f32x4 v0, const f32x4 v1) const {
        u32x4 w; w.x = pg8::cvt_pk_bf16(v0[0], v0[1]); w.y = pg8::cvt_pk_bf16(v0[2], v0[3]); w.z = pg8::cvt_pk_bf16(v1[0], v1[1]); w.w = pg8::cvt_pk_bf16(v1[2], v1[3]);
        *(u32x4*)(O + (size_t)row * ldc + col) = w; } };
struct FStoreQKV { bf16_t* PQ; float* AB;
    __device__ __forceinline__ void operator()(int row, int col, const f32x4 v0, const f32x4 v1) const {
        if (col < 6144) { u32x4 w; w.x = pg8::cvt_pk_bf16(v0[0], v0[1]); w.y = pg8::cvt_pk_bf16(v0[2], v0[3]); w.z = pg8::cvt_pk_bf16(v1[0], v1[1]); w.w = pg8::cvt_pk_bf16(v1[2], v1[3]);
            *(u32x4*)(PQ + (size_t)row * PQ_LD + col) = w; }
        else if (col < 6208) { float* p = AB + (size_t)row * 64 + (col - 6144); *(f32x4*)p = v0; *(f32x4*)(p + 4) = v1; } } };
struct FStoreF32 { float* O; int ldc;
    __device__ __forceinline__ void operator()(int row, int col, const f32x4 v0, const f32x4 v1) const { float* p = O + (size_t)row * ldc + col; *(f32x4*)p = v0; *(f32x4*)(p + 4) = v1; } };
struct FGatePA { const bf16_t* ZG; bf16_t* MG;
    __device__ __forceinline__ void operator()(int row, int col, const f32x4 v0, const f32x4 v1) const {
        float g[8]; unpack8(*(const u32x4*)(ZG + (size_t)row * NZG + 2048 + col), g);
        float o[8];
#pragma unroll
        for (int e = 0; e < 4; ++e) { o[e] = sigmoidf_(g[e]) * v0[e]; o[4 + e] = sigmoidf_(g[4 + e]) * v1[e]; }
        *(u32x4*)(MG + (size_t)row * 2048 + col) = pack8(o); } };
struct FGatePH { const bf16_t* ZG; bf16_t* MG;
    __device__ __forceinline__ void operator()(int row, int col, const f32x4 v0, const f32x4 v1) const {
        float g[8], t[8]; unpack8(*(const u32x4*)(ZG + (size_t)row * NZG + 4096 + col), g); unpack8(*(const u32x4*)(MG + (size_t)row * 2048 + col), t);
        float o[8];
#pragma unroll
        for (int e = 0; e < 4; ++e) { o[e] = t[e] + sigmoidf_(g[e]) * v0[e]; o[4 + e] = t[4 + e] + sigmoidf_(g[4 + e]) * v1[e]; }
        *(u32x4*)(MG + (size_t)row * 2048 + col) = pack8(o); } };
struct FOut { const float* x; const float* mod; float* T3;
    __device__ __forceinline__ void operator()(int row, int col, const f32x4 v0, const f32x4 v1) const {
        const float* xp = x + (size_t)row * 2048 + col; const float* gp = mod + (row >> 12) * 12288 + 4096 + col;
        const f32x4 x0 = *(const f32x4*)xp, x1 = *(const f32x4*)(xp + 4), g0 = *(const f32x4*)gp, g1 = *(const f32x4*)(gp + 4);
        float* p = T3 + (size_t)row * 2048 + col;
#if DBG_MODE == 1
        *(f32x4*)p = ALPHA * x0; *(f32x4*)(p + 4) = ALPHA * x1;
#else
        *(f32x4*)p = ALPHA * x0 + g0 * v0; *(f32x4*)(p + 4) = ALPHA * x1 + g1 * v1;
#endif
    } };

template <class F> __device__ __forceinline__ void run_gemm(unsigned char* lds, const bf16_t* A, const bf16_t* Bt, int M, int N, const F& f) {
    pg8::Gemm g{A, Bt, M, N, 2048}; pg8::StaticOrder S; S.init(M, N, (int)gridDim.x, (int)blockIdx.x);
    pg8::EpiGen<F> E{f};
    pg8::gemm_phase<pg8::EpiGen<F>, pg8::StaticOrder>((PG8_LAS unsigned char*)lds, g, S, E);
}

typedef float f32x2 __attribute__((ext_vector_type(2)));
constexpr int HY_Z = 0, HY_F = 69632, HY_TW4 = 139264, HY_TW8 = 141312, HY_TW32 = 143360, HY_W3 = 143488;
__device__ __forceinline__ f32x2 cmul(const f32x2 a, const f32x2 b) { return (f32x2){a.x * b.x - a.y * b.y, a.x * b.y + a.y * b.x}; }
__device__ __forceinline__ f32x2 cmulc(const f32x2 a, const f32x2 b) { return (f32x2){a.x * b.x + a.y * b.y, a.y * b.x - a.x * b.y}; }
template <bool INV> __device__ __forceinline__ f32x2 ctw(const f32x2 v, const float wr, const float wi) {
    return INV ? (f32x2){v.x * wr + v.y * wi, v.y * wr - v.x * wi} : (f32x2){v.x * wr - v.y * wi, v.y * wr + v.x * wi};
}
template <bool INV> __device__ __forceinline__ void dft16(f32x2 (&x)[16]) {
    constexpr float C = 0.9238795325112867f, S = 0.3826834323650898f, R = 0.7071067811865476f;
    f32x2 A[4][4];
#pragma unroll
    for (int q0 = 0; q0 < 4; ++q0) {
        const f32x2 a = x[q0], b = x[4 + q0], c = x[8 + q0], d = x[12 + q0];
        const f32x2 t0 = a + c, t1 = a - c, t2 = b + d, t3 = b - d;
        const f32x2 m = (f32x2){t3.y, -t3.x};
        A[q0][0] = t0 + t2; A[q0][2] = t0 - t2;
        A[q0][1] = INV ? (t1 - m) : (t1 + m); A[q0][3] = INV ? (t1 + m) : (t1 - m);
    }
    A[1][1] = ctw<INV>(A[1][1], C, -S); A[1][2] = ctw<INV>(A[1][2], R, -R); A[1][3] = ctw<INV>(A[1][3], S, -C);
    A[2][1] = ctw<INV>(A[2][1], R, -R); A[2][2] = ctw<INV>(A[2][2], 0.f, -1.f); A[2][3] = ctw<INV>(A[2][3], -R, -R);
    A[3][1] = ctw<INV>(A[3][1], S, -C); A[3][2] = ctw<INV>(A[3][2], -R, -R); A[3][3] = ctw<INV>(A[3][3], -C, S);
#pragma unroll
    for (int s = 0; s < 4; ++s) {
        const f32x2 t0 = A[0][s] + A[2][s], t1 = A[0][s] - A[2][s], t2 = A[1][s] + A[3][s], t3 = A[1][s] - A[3][s];
        const f32x2 m = (f32x2){t3.y, -t3.x};
        x[s] = t0 + t2; x[s + 8] = t0 - t2;
        x[s + 4] = INV ? (t1 - m) : (t1 + m); x[s + 12] = INV ? (t1 + m) : (t1 - m);
    }
}
template <bool INV> __device__ __forceinline__ void apply_tw(f32x2 (&x)[16], const f32x2 w) {
    f32x2 wr = w;
#pragma unroll
    for (int r = 1; r < 16; ++r) { x[r] = INV ? cmulc(x[r], wr) : cmul(x[r], wr); if (r < 15) wr = cmul(wr, w); }
}
__device__ __forceinline__ void fft_pass2_fwd(f32x2* B, int t, const f32x2* TW4) {
    const int base = 272 * (t >> 4) + (t & 15); f32x2 x[16];
#pragma unroll
    for (int q = 0; q < 16; ++q) x[q] = B[base + 17 * q];
    dft16<false>(x); apply_tw<false>(x, TW4[16 * (t & 15)]);
#pragma unroll
    for (int q = 0; q < 16; ++q) B[base + 17 * q] = x[q];
}
__device__ __forceinline__ void fft_pass2_inv(f32x2* B, int t, const f32x2* TW4) {
    const int base = 272 * (t >> 4) + (t & 15); f32x2 x[16];
#pragma unroll
    for (int q = 0; q < 16; ++q) x[q] = B[base + 17 * q];
    apply_tw<true>(x, TW4[16 * (t & 15)]); dft16<true>(x);
#pragma unroll
    for (int q = 0; q < 16; ++q) B[base + 17 * q] = x[q];
}
__device__ __forceinline__ float conv3_lane(float c, int lane, float w0, float w1, float w2) {
    float up = __shfl_up(c, 1, 64), dn = __shfl_down(c, 1, 64);
    up = (lane == 0) ? 0.f : up; dn = (lane == 63) ? 0.f : dn;
    return w0 * up + w1 * c + w2 * dn;
}
__device__ void hyena_setup(unsigned char* lds) {
    const int tid = tid_opaque();
    f32x2* TW4 = (f32x2*)(lds + HY_TW4); f32x2* TW8 = (f32x2*)(lds + HY_TW8); f32x2* TW32 = (f32x2*)(lds + HY_TW32);
    if (tid < 256) { const float a4 = -6.283185307179586f * (float)tid * (1.0f / 4096.0f), a8 = -6.283185307179586f * (float)tid * (1.0f / 8192.0f);
        TW4[tid] = (f32x2){cosf(a4), sinf(a4)}; TW8[tid] = (f32x2){cosf(a8), sinf(a8)}; }
    if (tid < 16) { const float a = -6.283185307179586f * (float)tid * (1.0f / 32.0f); TW32[tid] = (f32x2){cosf(a), sinf(a)}; }
    __syncthreads();
}
struct HyCtx { f32x2* Z; f32x2* Fb0; const f32x2* TW4; const f32x2* TW32; const bf16_t* rv; const bf16_t* rx1; const bf16_t* rx2; bf16_t* YTc; float* Y1S;
    f32x2 w8t, w4t; float cv0, cv1, cv2, cx0, cx1, cx2, cy0, cy1, cy2, sk0, sk1; int tid, br, t, lane, p1; };
template <int ORDER> __device__ __forceinline__ void hyena_conv(const HyCtx& K, int pr) {
    f32x2* Z = K.Z; const f32x2* TW4 = K.TW4; const f32x2* TW32 = K.TW32;
    const bf16_t* rv = K.rv; const bf16_t* rx1 = K.rx1; const bf16_t* rx2 = K.rx2; float* Y1S = K.Y1S;
    int tid = K.tid; asm volatile("" : "+v"(tid));
    const f32x2 w8t = K.w8t, w4t = K.w4t; const int br = tid >> 8, t = tid & 255, lane = tid & 63, p1 = t + (t >> 4);
    f32x2* Zb = K.Z + br * 4352; f32x2* Fb = K.Fb0 + br * 4352;
    const float cv0 = K.cv0, cv1 = K.cv1, cv2 = K.cv2, cx0 = K.cx0, cx1 = K.cx1, cx2 = K.cx2, cy0 = K.cy0, cy1 = K.cy1, cy2 = K.cy2, sk0 = K.sk0, sk1 = K.sk1;
        const int ba = 2 * pr * 4096, bb = ba + 4096;
        {
            f32x2 x[16];
#pragma unroll
            for (int q = 0; q < 16; ++q) {
                const int n = t + 256 * q; float ua, ub;
                if (ORDER == 0) { ua = conv3_lane(bf2f(rv[ba + n]), lane, cv0, cv1, cv2); ub = conv3_lane(bf2f(rv[bb + n]), lane, cv0, cv1, cv2); }
                else { ua = Y1S[n]; ub = Y1S[4096 + n]; }
                const f32x2 z = (f32x2){ua, ub};
                x[q] = br ? cmul(z, cmul(w8t, TW32[q])) : z;
            }
            dft16<false>(x); apply_tw<false>(x, w4t);
#pragma unroll
            for (int q = 0; q < 16; ++q) Zb[p1 + 272 * q] = x[q];
        }
        __syncthreads();
        fft_pass2_fwd(Zb, t, TW4);
        __syncthreads();
        {
            f32x2 x[16];
#pragma unroll
            for (int q = 0; q < 16; ++q) x[q] = Zb[17 * t + q];
            dft16<false>(x);
#pragma unroll
            for (int r = 0; r < 16; ++r) {
                const int p = 16 * t + r; int pp;
                if (br) pp = 4095 - p;
                else { const int m = (r << 8) | ((t & 15) << 4) | (t >> 4); const int mp = (4096 - m) & 4095; pp = ((mp & 15) << 8) | (mp & 0xF0) | (mp >> 8); }
                const f32x2 fk = Fb[p + (p >> 4)], fc = Fb[pp + (pp >> 4)];
                f32x2 H;
                if (ORDER == 0) H = (f32x2){0.5f * (fk.x + fc.x), 0.5f * (fk.y - fc.y)};
                else H = (f32x2){0.5f * (fk.y + fc.y), -0.5f * (fk.x - fc.x)};
                x[r] = cmul(x[r], H);
            }
            dft16<true>(x);
#pragma unroll
            for (int q = 0; q < 16; ++q) Zb[17 * t + q] = x[q];
        }
        __syncthreads();
        fft_pass2_inv(Zb, t, TW4);
        __syncthreads();
        {
            f32x2 x[16];
#pragma unroll
            for (int q = 0; q < 16; ++q) x[q] = Zb[p1 + 272 * q];
            apply_tw<true>(x, w4t); dft16<true>(x);
            if (br) {
#pragma unroll
                for (int q = 0; q < 16; ++q) x[q] = cmulc(x[q], cmul(w8t, TW32[q]));
            }
#pragma unroll
            for (int q = 0; q < 16; ++q) Zb[p1 + 272 * q] = x[q];
        }
        __syncthreads();
#pragma unroll
        for (int i = 0; i < 8; ++i) {
            const int n = tid + i * NT, pn = n + (n >> 4);
            const f32x2 e0 = Z[pn], e1 = Z[4352 + pn];
            const float ca = (e0.x + e1.x) * (1.0f / 8192.0f), cb = (e0.y + e1.y) * (1.0f / 8192.0f);
            if (ORDER == 0) {
                const float va = conv3_lane(bf2f(rv[ba + n]), lane, cv0, cv1, cv2), vb = conv3_lane(bf2f(rv[bb + n]), lane, cv0, cv1, cv2);
                const float xa = conv3_lane(bf2f(rx1[ba + n]), lane, cx0, cx1, cx2), xb = conv3_lane(bf2f(rx1[bb + n]), lane, cx0, cx1, cx2);
                Y1S[n] = xa * (ca + sk0 * va); Y1S[4096 + n] = xb * (cb + sk0 * vb);
            } else {
                const float ya = Y1S[n], yb = Y1S[4096 + n];
                const float xa = conv3_lane(bf2f(rx2[ba + n]), lane, cy0, cy1, cy2), xb = conv3_lane(bf2f(rx2[bb + n]), lane, cy0, cy1, cy2);
                K.YTc[ba + n] = (bf16_t)f2bf(xa * (ca + sk1 * ya)); K.YTc[bb + n] = (bf16_t)f2bf(xb * (cb + sk1 * yb));
            }
        }
        __syncthreads();
}
__device__ void hyena_item(KA a, int c, unsigned char* lds) {
    f32x2* Z = (f32x2*)(lds + HY_Z); f32x2* F = (f32x2*)(lds + HY_F);
    const f32x2* TW4 = (const f32x2*)(lds + HY_TW4); const f32x2* TW8 = (const f32x2*)(lds + HY_TW8); const f32x2* TW32 = (const f32x2*)(lds + HY_TW32);
    float* W3 = (float*)(lds + HY_W3);
    int tid = tid_opaque(); asm volatile("" : "+v"(tid));
    const int br = tid >> 8, t = tid & 255, lane = tid & 63;
    f32x2* Zb = Z + br * 4352; f32x2* Fb = F + br * 4352;
    const float* hid2 = (const float*)(a->ws + WS_HID2);
    const float* w3 = a->in[16]; const float* b3 = a->in[17]; const float* cw = a->in[11]; const float* skip = a->in[19];
    const bf16_t* PHT = (const bf16_t*)(a->ws + WS_RA);
    bf16_t* YT = (bf16_t*)a->out;
    float* Y1S = a->out + (size_t)16 * 1024 * 1024 + (size_t)blockIdx.x * 16384;
    if (tid < 256) { const int q = tid >> 6, j = tid & 63; W3[q * 64 + j] = w3[(size_t)j * 8192 + (q >> 1) * 4096 + (q & 1) * 2048 + c]; }
    __syncthreads();
    {
        const float delta = 3.0701134573253944f + 12.280453829301578f * ((float)c * (1.0f / 2047.0f));
        float bq[4];
#pragma unroll
        for (int q = 0; q < 4; ++q) bq[q] = b3[(q >> 1) * 4096 + (q & 1) * 2048 + c];
#pragma unroll 1
        for (int i = 0; i < 8; ++i) {
            const int d = tid + i * NT;
            const f32x4* hp = (const f32x4*)(hid2 + d * 64);
            float f0 = 0.f, f1 = 0.f, f2 = 0.f, f3 = 0.f;
#pragma unroll 4
            for (int j4 = 0; j4 < 16; ++j4) {
                const f32x4 hv = hp[j4];
#pragma unroll
                for (int e = 0; e < 4; ++e) { const int j = j4 * 4 + e; f0 += hv[e] * W3[j]; f1 += hv[e] * W3[64 + j]; f2 += hv[e] * W3[128 + j]; f3 += hv[e] * W3[192 + j]; }
            }
            const float win = expf(-((float)d * (1.0f / 4095.0f)) * delta);
            Z[d] = (f32x2){(f0 + bq[0]) * win, (f1 + bq[1]) * win};
            Z[4096 + d] = (f32x2){(f2 + bq[2]) * win, (f3 + bq[3]) * win};
        }
    }
    __syncthreads();
    const f32x2 w8t = TW8[t], w4t = TW4[t];
    const int p1 = t + (t >> 4);
    {
        f32x2 x[16];
#pragma unroll
        for (int q = 0; q < 16; ++q) {
            const int n = t + 256 * q;
            const f32x2 av = Z[n]; f32x2 bv = Z[8192 - (n ? n : 1)]; if (n == 0) bv = (f32x2){0.f, 0.f};
            x[q] = br ? cmul(av - bv, cmul(w8t, TW32[q])) : (av + bv);
        }
        dft16<false>(x); apply_tw<false>(x, w4t);
#pragma unroll
        for (int q = 0; q < 16; ++q) Fb[p1 + 272 * q] = x[q];
    }
    __syncthreads();
    fft_pass2_fwd(Fb, t, TW4);
    __syncthreads();
    {   f32x2 x[16];
#pragma unroll
        for (int q = 0; q < 16; ++q) x[q] = Fb[17 * t + q];
        dft16<false>(x);
#pragma unroll
        for (int q = 0; q < 16; ++q) Fb[17 * t + q] = x[q];
    }
    __syncthreads();
    const float cv0 = cw[c], cv1 = cw[6144 + c], cv2 = cw[12288 + c];
    const float cx0 = cw[2048 + c], cx1 = cw[6144 + 2048 + c], cx2 = cw[12288 + 2048 + c];
    const float cy0 = cw[4096 + c], cy1 = cw[6144 + 4096 + c], cy2 = cw[12288 + 4096 + c];
    const float sk0 = skip[c], sk1 = skip[2048 + c];
    const bf16_t* rv = PHT + (size_t)c * MT; const bf16_t* rx1 = PHT + (size_t)(2048 + c) * MT; const bf16_t* rx2 = PHT + (size_t)(4096 + c) * MT;
    HyCtx K; K.Z = Z; K.Fb0 = F; K.TW4 = TW4; K.TW32 = TW32; K.rv = rv; K.rx1 = rx1; K.rx2 = rx2; K.YTc = YT + (size_t)c * MT; K.Y1S = Y1S;
    K.w8t = w8t; K.w4t = w4t; K.cv0 = cv0; K.cv1 = cv1; K.cv2 = cv2; K.cx0 = cx0; K.cx1 = cx1; K.cx2 = cx2; K.cy0 = cy0; K.cy1 = cy1; K.cy2 = cy2; K.sk0 = sk0; K.sk1 = sk1;
    K.tid = tid; K.br = br; K.t = t; K.lane = lane; K.p1 = p1;
#pragma unroll 1
    for (int pr = 0; pr < 2; ++pr) { hyena_conv<0>(K, pr); hyena_conv<1>(K, pr); }
}

__device__ void qkvpost_unit(KA a, int unit, unsigned char* lds) {
    const int tid = tid_opaque();
    int ntok, row0, wh;
    if (unit < 12288) { const int gr = unit / 48; wh = unit % 48; ntok = 64; row0 = gr * 64; }
    else { const int uu = unit - 12288; const int b = uu / 48; wh = uu % 48; ntok = 256; row0 = MT + b * 256; }
    const int which = wh >> 4, h = wh & 15, colbase = which * 2048 + h * 128;
    bf16_t* PQ = (bf16_t*)(a->ws + WS_RB);
    bf16_t* raw = (bf16_t*)lds; float* wl = (float*)(lds + 65536);
    const float* cwt = a->in[7];
    for (int i = tid; i < ntok * 16; i += NT) { const int r = i >> 4, c8 = i & 15; *(u32x4*)(raw + r * 128 + c8 * 8) = *(const u32x4*)(PQ + (size_t)(row0 + r) * PQ_LD + colbase + c8 * 8); }
    for (int i = tid; i < 640; i += NT) wl[i] = cwt[(i >> 7) * 6144 + colbase + (i & 127)];
    __syncthreads();
    const int r = tid >> 3, cg = tid & 7;
    for (int rb = 0; rb < ntok / 64; ++rb) {
        const int tok = rb * 64 + r;
        float v[16]; float ss = 0.f;
#pragma unroll
        for (int e = 0; e < 16; ++e) {
            const int ch = cg * 16 + e; float acc = 0.f;
#pragma unroll
            for (int j = 0; j < 5; ++j) { const int tt = tok + j - 2; if (tt >= 0 && tt < ntok) acc += wl[j * 128 + ch] * bf2f(raw[tt * 128 + ch]); }
            const float s = siluf_(acc); v[e] = s; ss += s * s;
        }
        if (which < 2) {
            ss += __shfl_xor(ss, 1, 64); ss += __shfl_xor(ss, 2, 64); ss += __shfl_xor(ss, 4, 64);
            const float sc = rsqrtf(ss + 1e-6f) * (which == 0 ? 0.08838834764831845f : 1.0f);
#pragma unroll
            for (int e = 0; e < 16; ++e) v[e] *= sc;
        }
        bf16_t* op = PQ + (size_t)(row0 + tok) * PQ_LD + colbase + cg * 16;
        u32x4 w0, w1;
        w0.x = pk2(v[0], v[1]); w0.y = pk2(v[2], v[3]); w0.z = pk2(v[4], v[5]); w0.w = pk2(v[6], v[7]);
        w1.x = pk2(v[8], v[9]); w1.y = pk2(v[10], v[11]); w1.z = pk2(v[12], v[13]); w1.w = pk2(v[14], v[15]);
        *(u32x4*)op = w0; *(u32x4*)(op + 8) = w1;
    }
    __syncthreads();
}

typedef short bf16x8 __attribute__((ext_vector_type(8)));
typedef unsigned u32x2 __attribute__((ext_vector_type(2)));
constexpr size_t WS_TS = 585 * MiB, WS_GCB = 653 * MiB;
#define MFMA16(a, b, c) __builtin_amdgcn_mfma_f32_16x16x32_bf16((a), (b), (c), 0, 0, 0)
__device__ __forceinline__ u32x2 pk4(float a, float b, float c, float d) { u32x2 w; w.x = pk2(a, b); w.y = pk2(c, d); return w; }

__device__ void tprep_wave(KA a, int pid, unsigned char* wl) {
    const int lane = tid_opaque() & 63, fr = lane & 15, fq = lane >> 4;
    const int sid = pid / 68, cidx = pid - sid * 68, dir = sid & 1, h = (sid >> 1) & 15, b = sid >> 5;
    bf16_t* kt = (bf16_t*)wl; float* Mf = (float*)wl; float* gcs = (float*)(wl + 17408); float* bes = gcs + 64;
    const bf16_t* PQ = (const bf16_t*)(a->ws + WS_RB); const float* AB = (const float*)(a->ws + WS_AB);
    bf16_t* TS = (bf16_t*)(a->ws + WS_TS) + (size_t)pid * 4096; float* GCB = (float*)(a->ws + WS_GCB) + (size_t)pid * 128;
    int rbase, Tn, p0;
    if (cidx < 4) { rbase = MT + b * CTXL; Tn = CTXL; p0 = cidx * 64; } else { rbase = b * SEQ; Tn = SEQ; p0 = (cidx - 4) * 64; }
#pragma unroll 4
    for (int it = 0; it < 16; ++it) {
        const int i = it * 4 + fq, p = p0 + i, tok = dir ? (Tn - 1 - p) : p;
        *(u32x4*)(kt + i * 136 + fr * 8) = *(const u32x4*)(PQ + (size_t)(rbase + tok) * PQ_LD + 2048 + h * 128 + fr * 8);
    }
    {
        const int p = p0 + lane, tok = dir ? (Tn - 1 - p) : p; const size_t row = (size_t)(rbase + tok);
        const float ab0 = AB[row * 64 + dir * 32 + h], ab1 = AB[row * 64 + dir * 32 + 16 + h];
        const float xx = ab0 + a->in[9][dir * 16 + h]; const float sp = (xx > 20.0f) ? xx : log1pf(expf(xx));
        float gc = -expf(a->in[8][dir * 16 + h]) * sp;
#pragma unroll
        for (int o = 1; o < 64; o <<= 1) { const float tt = __shfl_up(gc, o, 64); if (lane >= o) gc += tt; }
        const float be = sigmoidf_(ab1);
        gcs[lane] = gc; bes[lane] = be; GCB[lane] = gc; GCB[64 + lane] = be;
    }
    f32x4 acc[10];
#pragma unroll
    for (int i = 0; i < 10; ++i) acc[i] = (f32x4){0.f, 0.f, 0.f, 0.f};
#pragma unroll
    for (int kk = 0; kk < 4; ++kk) {
        bf16x8 fg[4];
#pragma unroll
        for (int ct = 0; ct < 4; ++ct) fg[ct] = *(const bf16x8*)(kt + (ct * 16 + fr) * 136 + kk * 32 + fq * 8);
#pragma unroll
        for (int ct = 0; ct < 4; ++ct)
#pragma unroll
            for (int mt = 0; mt <= ct; ++mt) acc[ct * (ct + 1) / 2 + mt] = MFMA16(fg[ct], fg[mt], acc[ct * (ct + 1) / 2 + mt]);
    }
    float gcr[4][4], ber[4][4];
#pragma unroll
    for (int ct = 0; ct < 4; ++ct)
#pragma unroll
        for (int r = 0; r < 4; ++r) { gcr[ct][r] = gcs[ct * 16 + 4 * fq + r]; ber[ct][r] = bes[ct * 16 + 4 * fq + r]; }
    float gcm[4];
#pragma unroll
    for (int mt = 0; mt < 4; ++mt) gcm[mt] = gcs[mt * 16 + fr];
    asm volatile("s_waitcnt lgkmcnt(0)" ::: "memory");
#pragma unroll
    for (int ct = 0; ct < 4; ++ct)
#pragma unroll
        for (int mt = 0; mt <= ct; ++mt)
#pragma unroll
            for (int r = 0; r < 4; ++r) {
                const int c = ct * 16 + 4 * fq + r, m = mt * 16 + fr;
                Mf[c * 68 + m] = (m < c) ? ber[ct][r] * acc[ct * (ct + 1) / 2 + mt][r] * expf(gcr[ct][r] - gcm[mt]) : 0.0f;
            }
    asm volatile("s_waitcnt lgkmcnt(0)" ::: "memory");
    Mf[lane] = (lane == 0) ? 1.0f : 0.0f;
    asm volatile("s_waitcnt lgkmcnt(0)" ::: "memory");
#pragma unroll 1
    for (int i = 1; i < 64; ++i) {
        const float* mr = Mf + i * 68;
        float s0 = 0.f, s1 = 0.f, s2 = 0.f, s3 = 0.f;
        int m = 0;
#pragma unroll 1
        for (; m + 4 <= i; m += 4) {
            const f32x4 mv = *(const f32x4*)(mr + m);
            s0 -= mv.x * Mf[m * 68 + lane]; s1 -= mv.y * Mf[(m + 1) * 68 + lane]; s2 -= mv.z * Mf[(m + 2) * 68 + lane]; s3 -= mv.w * Mf[(m + 3) * 68 + lane];
        }
#pragma unroll 1
        for (; m < i; ++m) s0 -= mr[m] * Mf[m * 68 + lane];
        const float tv = ((s0 + s1) + (s2 + s3)) + ((lane == i) ? 1.0f : 0.0f);
        asm volatile("s_waitcnt lgkmcnt(0)" ::: "memory");
        Mf[i * 68 + lane] = tv;
        asm volatile("s_waitcnt lgkmcnt(0)" ::: "memory");
    }
#pragma unroll
    for (int it = 0; it < 8; ++it) {
        const int row = it * 8 + (lane >> 3), c8 = (lane & 7) * 8;
        const f32x4 x0 = *(const f32x4*)(Mf + row * 68 + c8), x1 = *(const f32x4*)(Mf + row * 68 + c8 + 4);
        u32x4 wv; wv.x = pk2(x0[0], x0[1]); wv.y = pk2(x0[2], x0[3]); wv.z = pk2(x1[0], x1[1]); wv.w = pk2(x1[2], x1[3]);
        *(u32x4*)(TS + row * 64 + c8) = wv;
    }
    asm volatile("s_waitcnt lgkmcnt(0)" ::: "memory");
}

constexpr int DL_QN = 0, DL_KN = 17408, DL_WN = 34816, DL_ST = 52224, DL_KT = 69632, DL_VT = 88064, DL_T1 = 97280, DL_T2 = 106496, DL_AT = 115712, DL_VN = 124928, DL_VD = 134144, DL_GS = 143360;
struct DStage { u32x4 q0, q1, k0, k1, v, t; f32x4 g0, g1, b0, b1; float bi, gl, g63; };
__device__ __forceinline__ void dstage_load(DStage& R, const bf16_t* PQ, const bf16_t* TS, const float* GCB, int sid, int cidx, int dir, int h, int b, int dvh, int tid) {
    const int i = tid >> 3, part = tid & 7;
    int rbase, Tn, p0;
    if (cidx < 4) { rbase = MT + b * CTXL; Tn = CTXL; p0 = cidx * 64; } else { rbase = b * SEQ; Tn = SEQ; p0 = (cidx - 4) * 64; }
    const int p = p0 + i, tok = dir ? (Tn - 1 - p) : p;
    const bf16_t* rp = PQ + (size_t)(rbase + tok) * PQ_LD + h * 128;
    R.q0 = *(const u32x4*)(rp + part * 16); R.q1 = *(const u32x4*)(rp + part * 16 + 8);
    R.k0 = *(const u32x4*)(rp + 2048 + part * 16); R.k1 = *(const u32x4*)(rp + 2048 + part * 16 + 8);
    R.v = *(const u32x4*)(rp + 4096 + dvh * 64 + part * 8);
    const size_t pid = (size_t)sid * 68 + cidx;
    R.t = *(const u32x4*)(TS + pid * 4096 + i * 64 + part * 8);
    const float* gp = GCB + pid * 128;
    R.g0 = *(const f32x4*)(gp + part * 8); R.g1 = *(const f32x4*)(gp + part * 8 + 4);
    R.b0 = *(const f32x4*)(gp + 64 + part * 8); R.b1 = *(const f32x4*)(gp + 64 + part * 8 + 4);
    R.bi = gp[64 + i]; R.gl = gp[tid & 63]; R.g63 = gp[63];
}
__device__ __forceinline__ void dstage_store(const DStage& R, unsigned char* lds, int tid) {
    const int i = tid >> 3, part = tid & 7;
    bf16_t* QN = (bf16_t*)(lds + DL_QN); bf16_t* KN = (bf16_t*)(lds + DL_KN); bf16_t* KT = (bf16_t*)(lds + DL_KT); bf16_t* VT = (bf16_t*)(lds + DL_VT);
    bf16_t* T1 = (bf16_t*)(lds + DL_T1); bf16_t* T2 = (bf16_t*)(lds + DL_T2); float* GS = (float*)(lds + DL_GS);
    *(u32x4*)(QN + i * 136 + part * 16) = R.q0; *(u32x4*)(QN + i * 136 + part * 16 + 8) = R.q1;
    *(u32x4*)(KN + i * 136 + part * 16) = R.k0; *(u32x4*)(KN + i * 136 + part * 16 + 8) = R.k1;
    const unsigned kw[8] = {R.k0.x, R.k0.y, R.k0.z, R.k0.w, R.k1.x, R.k1.y, R.k1.z, R.k1.w};
#pragma unroll
    for (int e = 0; e < 8; ++e) { KT[(part * 16 + 2 * e) * 72 + i] = (bf16_t)(kw[e] & 0xffffu); KT[(part * 16 + 2 * e + 1) * 72 + i] = (bf16_t)(kw[e] >> 16); }
    float v8[8]; unpack8(R.v, v8);
#pragma unroll
    for (int e = 0; e < 8; ++e) VT[(part * 8 + e) * 72 + i] = (bf16_t)f2bf(v8[e]);
    float t8[8]; unpack8(R.t, t8);
    const float gm[8] = {R.g0.x, R.g0.y, R.g0.z, R.g0.w, R.g1.x, R.g1.y, R.g1.z, R.g1.w};
    const float bm[8] = {R.b0.x, R.b0.y, R.b0.z, R.b0.w, R.b1.x, R.b1.y, R.b1.z, R.b1.w};
    float a1[8], a2[8];
#pragma unroll
    for (int e = 0; e < 8; ++e) { a2[e] = t8[e] * bm[e]; a1[e] = a2[e] * expf(gm[e]); }
    *(u32x4*)(T1 + i * 72 + part * 8) = pack8(a1); *(u32x4*)(T2 + i * 72 + part * 8) = pack8(a2);
    if (tid < 64) { GS[tid] = R.gl; GS[64 + tid] = expf(R.gl); GS[128 + tid] = expf(R.g63 - R.gl); }
}
__device__ void delta_item(KA a, int item, unsigned char* lds) {
    const int tid = tid_opaque(), lane = tid & 63, w = tid >> 6, fr = lane & 15, fq = lane >> 4;
    const int dvh = item & 1, dir = (item >> 1) & 1, h = (item >> 2) & 15, b = item >> 6, sid = (b * 16 + h) * 2 + dir;
    const bf16_t* PQ = (const bf16_t*)(a->ws + WS_RB); const bf16_t* TS = (const bf16_t*)(a->ws + WS_TS); const float* GCB = (const float*)(a->ws + WS_GCB);
    bf16_t* O = (bf16_t*)(a->ws + WS_RA) + (size_t)dir * MT * 2048;
    const bf16_t* QN = (const bf16_t*)(lds + DL_QN); const bf16_t* KN = (const bf16_t*)(lds + DL_KN); bf16_t* WN = (bf16_t*)(lds + DL_WN); bf16_t* ST = (bf16_t*)(lds + DL_ST);
    const bf16_t* KT = (const bf16_t*)(lds + DL_KT); const bf16_t* VT = (const bf16_t*)(lds + DL_VT); const bf16_t* T1 = (const bf16_t*)(lds + DL_T1); const bf16_t* T2 = (const bf16_t*)(lds + DL_T2);
    bf16_t* AT = (bf16_t*)(lds + DL_AT); bf16_t* VN = (bf16_t*)(lds + DL_VN); bf16_t* VD = (bf16_t*)(lds + DL_VD); const float* GS = (const float*)(lds + DL_GS);
    __syncthreads();
    for (int i = tid; i < 64 * 136 / 2; i += NT) ((unsigned*)ST)[i] = 0u;
    f32x4 sacc[4];
#pragma unroll
    for (int i = 0; i < 4; ++i) sacc[i] = (f32x4){0.f, 0.f, 0.f, 0.f};
    DStage R;
    dstage_load(R, PQ, TS, GCB, sid, 0, dir, h, b, dvh, tid);
#pragma unroll 1
    for (int cidx = 0; cidx < 68; ++cidx) {
        dstage_store(R, lds, tid);
        __syncthreads();
        if (cidx + 1 < 68) dstage_load(R, PQ, TS, GCB, sid, cidx + 1, dir, h, b, dvh, tid);
#pragma unroll
        for (int ti = 0; ti < 2; ++ti) {
            const int idx = w * 2 + ti, mt = idx >> 2, ct = idx & 3;
            f32x4 acc = (f32x4){0.f, 0.f, 0.f, 0.f};
            if (mt <= ct) {
#pragma unroll
                for (int kk = 0; kk < 4; ++kk) {
                    const bf16x8 af = *(const bf16x8*)(KN + (mt * 16 + fr) * 136 + kk * 32 + fq * 8), bfg = *(const bf16x8*)(QN + (ct * 16 + fr) * 136 + kk * 32 + fq * 8);
                    acc = MFMA16(af, bfg, acc);
                }
            }
            const int c = ct * 16 + fr; const float gcc = GS[c];
            float o4[4];
#pragma unroll
            for (int r = 0; r < 4; ++r) { const int m = mt * 16 + 4 * fq + r; o4[r] = (m <= c) ? acc[r] * expf(gcc - GS[m]) : 0.0f; }
            *(u32x2*)(AT + c * 72 + mt * 16 + 4 * fq) = pk4(o4[0], o4[1], o4[2], o4[3]);
        }
        {
            bf16x8 af[2];
#pragma unroll
            for (int kk = 0; kk < 2; ++kk) af[kk] = *(const bf16x8*)(KT + (w * 16 + fr) * 72 + kk * 32 + fq * 8);
#pragma unroll
            for (int ct = 0; ct < 4; ++ct) {
                f32x4 acc = (f32x4){0.f, 0.f, 0.f, 0.f};
#pragma unroll
                for (int kk = 0; kk < 2; ++kk) acc = MFMA16(af[kk], *(const bf16x8*)(T1 + (ct * 16 + fr) * 72 + kk * 32 + fq * 8), acc);
                *(u32x2*)(WN + (ct * 16 + fr) * 136 + w * 16 + 4 * fq) = pk4(-acc[0], -acc[1], -acc[2], -acc[3]);
            }
        }
        const int ctu = w >> 1, dv0 = 2 * (w & 1);
        f32x4 uacc[2];
        {
            bf16x8 af[2];
#pragma unroll
            for (int kk = 0; kk < 2; ++kk) af[kk] = *(const bf16x8*)(T2 + (ctu * 16 + fr) * 72 + kk * 32 + fq * 8);
#pragma unroll
            for (int j = 0; j < 2; ++j) { uacc[j] = (f32x4){0.f, 0.f, 0.f, 0.f};
#pragma unroll
                for (int kk = 0; kk < 2; ++kk) uacc[j] = MFMA16(af[kk], *(const bf16x8*)(VT + ((dv0 + j) * 16 + fr) * 72 + kk * 32 + fq * 8), uacc[j]); }
        }
        __syncthreads();
        {
            bf16x8 af[4];
#pragma unroll
            for (int kk = 0; kk < 4; ++kk) af[kk] = *(const bf16x8*)(WN + (ctu * 16 + fr) * 136 + kk * 32 + fq * 8);
            float ed[4];
#pragma unroll
            for (int r = 0; r < 4; ++r) ed[r] = GS[128 + ctu * 16 + 4 * fq + r];
#pragma unroll
            for (int j = 0; j < 2; ++j) {
#pragma unroll
                for (int kk = 0; kk < 4; ++kk) uacc[j] = MFMA16(af[kk], *(const bf16x8*)(ST + ((dv0 + j) * 16 + fr) * 136 + kk * 32 + fq * 8), uacc[j]);
                const int dv = (dv0 + j) * 16 + fr;
                *(u32x2*)(VN + dv * 72 + ctu * 16 + 4 * fq) = pk4(uacc[j][0], uacc[j][1], uacc[j][2], uacc[j][3]);
                *(u32x2*)(VD + dv * 72 + ctu * 16 + 4 * fq) = pk4(uacc[j][0] * ed[0], uacc[j][1] * ed[1], uacc[j][2] * ed[2], uacc[j][3] * ed[3]);
            }
        }
        __syncthreads();
        {
            const int dvt = w >> 1, c0 = 2 * (w & 1);
            bf16x8 af[4], vf[2];
#pragma unroll
            for (int kk = 0; kk < 4; ++kk) af[kk] = *(const bf16x8*)(ST + (dvt * 16 + fr) * 136 + kk * 32 + fq * 8);
#pragma unroll
            for (int kk = 0; kk < 2; ++kk) vf[kk] = *(const bf16x8*)(VN + (dvt * 16 + fr) * 72 + kk * 32 + fq * 8);
#pragma unroll
            for (int j = 0; j < 2; ++j) {
                const int c = (c0 + j) * 16 + fr;
                f32x4 acc = (f32x4){0.f, 0.f, 0.f, 0.f};
#pragma unroll
                for (int kk = 0; kk < 4; ++kk) acc = MFMA16(af[kk], *(const bf16x8*)(QN + c * 136 + kk * 32 + fq * 8), acc);
                const float eg = GS[64 + c];
                acc = acc * eg;
#pragma unroll
                for (int kk = 0; kk < 2; ++kk) acc = MFMA16(vf[kk], *(const bf16x8*)(AT + c * 72 + kk * 32 + fq * 8), acc);
                if (cidx >= 4) {
                    const int p = (cidx - 4) * 64 + c, tok = dir ? (SEQ - 1 - p) : p;
                    *(u32x2*)(O + (size_t)(b * SEQ + tok) * 2048 + h * 128 + dvh * 64 + dvt * 16 + 4 * fq) = pk4(acc[0], acc[1], acc[2], acc[3]);
                }
            }
        }
        {
            const float eg63 = GS[64 + 63];
            bf16x8 af[2];
#pragma unroll
            for (int kk = 0; kk < 2; ++kk) af[kk] = *(const bf16x8*)(KT + (w * 16 + fr) * 72 + kk * 32 + fq * 8);
#pragma unroll
            for (int j = 0; j < 4; ++j) {
                sacc[j] = sacc[j] * eg63;
#pragma unroll
                for (int kk = 0; kk < 2; ++kk) sacc[j] = MFMA16(af[kk], *(const bf16x8*)(VD + (j * 16 + fr) * 72 + kk * 32 + fq * 8), sacc[j]);
            }
        }
        __syncthreads();
#pragma unroll
        for (int j = 0; j < 4; ++j) *(u32x2*)(ST + (j * 16 + fr) * 136 + w * 16 + 4 * fq) = pk4(sacc[j][0], sacc[j][1], sacc[j][2], sacc[j][3]);
    }
    __syncthreads();
}

__device__ void ytrans_unit(const bf16_t* YT, bf16_t* Y, int unit, bf16_t* tile) {
    const int tid = tid_opaque(), cb = unit & 31, tb = unit >> 5, r = tid >> 3, c8 = (tid & 7) * 8;
    *(u32x4*)(tile + r * 72 + c8) = *(const u32x4*)(YT + (size_t)(cb * 64 + r) * MT + tb * 64 + c8);
    __syncthreads();
    u32x4 w;
    w.x = (unsigned)tile[(c8 + 0) * 72 + r] | ((unsigned)tile[(c8 + 1) * 72 + r] << 16);
    w.y = (unsigned)tile[(c8 + 2) * 72 + r] | ((unsigned)tile[(c8 + 3) * 72 + r] << 16);
    w.z = (unsigned)tile[(c8 + 4) * 72 + r] | ((unsigned)tile[(c8 + 5) * 72 + r] << 16);
    w.w = (unsigned)tile[(c8 + 6) * 72 + r] | ((unsigned)tile[(c8 + 7) * 72 + r] << 16);
    *(u32x4*)(Y + (size_t)(tb * 64 + r) * 2048 + cb * 64 + c8) = w;
    __syncthreads();
}

__device__ void p6_on(KA a) {
    const bf16_t* OF = (const bf16_t*)(a->ws + WS_RA); const bf16_t* OB = OF + (size_t)MT * 2048;
    const bf16_t* ZG = (const bf16_t*)(a->ws + WS_RB); bf16_t* ON = (bf16_t*)(a->ws + WS_HA);
    const float* nw = a->in[10];
    const size_t nthr = (size_t)gridDim.x * NT;
    for (size_t i = (size_t)blockIdx.x * NT + tid_opaque(); i < (size_t)MT * 256; i += nthr) {
        const int row = (int)(i >> 8), c8 = (int)(i & 255) * 8;
        float f[8], g[8], z[8];
        unpack8(*(const u32x4*)(OF + (size_t)row * 2048 + c8), f); unpack8(*(const u32x4*)(OB + (size_t)row * 2048 + c8), g);
        unpack8(*(const u32x4*)(ZG + (size_t)row * NZG + c8), z);
        float ss = 0.f;
#pragma unroll
        for (int e = 0; e < 8; ++e) { f[e] += g[e]; ss += f[e] * f[e]; }
        ss += __shfl_xor(ss, 1, 64); ss += __shfl_xor(ss, 2, 64); ss += __shfl_xor(ss, 4, 64); ss += __shfl_xor(ss, 8, 64);
        const float rs = rsqrtf(ss * (1.0f / 128.0f) + 1e-6f);
        float o[8];
#pragma unroll
        for (int e = 0; e < 8; ++e) o[e] = f[e] * rs * nw[(c8 & 127) + e] * siluf_(z[e]);
        *(u32x4*)(ON + (size_t)row * 2048 + c8) = pack8(o);
    }
}

constexpr size_t PEER_U8 = 0, PEER_V8 = 32 * MiB, PEER_US = 64 * MiB, PEER_VS = 64 * MiB + 65536;
__device__ void p8_tables(KA a) {
    unsigned char* RAb = a->ws + WS_RA;
    const int lane = tid_opaque() & 63, wv = blockIdx.x * 8 + (tid_opaque() >> 6), nwv = gridDim.x * 8;
    for (int r = wv; r < 32768; r += nwv) {
        const int tab = r >> 14, row = r & 16383;
        const float* sp = (tab ? a->in[28] : a->in[27]) + (size_t)row * 2048;
        f32x4 x[8];
#pragma unroll
        for (int i = 0; i < 2; ++i)
#pragma unroll
            for (int j = 0; j < 4; ++j) x[i * 4 + j] = *(const f32x4*)(sp + i * 1024 + lane * 16 + j * 4);
        float mx = 0.f;
#pragma unroll
        for (int i = 0; i < 8; ++i) mx = fmaxf(mx, fmaxf(fmaxf(fabsf(x[i][0]), fabsf(x[i][1])), fmaxf(fabsf(x[i][2]), fabsf(x[i][3]))));
        mx = wave_max(mx);
        const float sc = (mx > 0.f) ? mx * (1.0f / 127.0f) : 1.0f, inv = 1.0f / sc;
        unsigned char* dp = RAb + (tab ? PEER_V8 : PEER_U8) + (size_t)row * 2048;
#pragma unroll
        for (int i = 0; i < 2; ++i) {
            u32x4 w;
#pragma unroll
            for (int j = 0; j < 4; ++j) {
                const f32x4 v = x[i * 4 + j];
                const unsigned b0 = (unsigned)(__float2int_rn(v[0] * inv) + 128), b1 = (unsigned)(__float2int_rn(v[1] * inv) + 128), b2 = (unsigned)(__float2int_rn(v[2] * inv) + 128), b3 = (unsigned)(__float2int_rn(v[3] * inv) + 128);
                w[j] = (b0 & 255u) | ((b1 & 255u) << 8) | ((b2 & 255u) << 16) | ((b3 & 255u) << 24);
            }
            *(u32x4*)(dp + i * 1024 + lane * 16) = w;
        }
        if (lane == 0) ((float*)(RAb + (tab ? PEER_VS : PEER_US)))[row] = sc;
    }
}

__device__ void p9_ln1(KA a) {
    const float* mod = (const float*)(a->ws + WS_MOD); bf16_t* H2 = (bf16_t*)(a->ws + WS_RA) + (size_t)2 * MT * 2048;
    const float* g = a->in[23]; const float* bb = a->in[24];
    const int lane = tid_opaque() & 63, wv = blockIdx.x * 8 + (tid_opaque() >> 6), nwv = gridDim.x * 8;
    for (int row = wv; row < MT; row += nwv) {
        float* rp = a->out + (size_t)row * 2048;
        float v[32]; float s = 0.f;
#pragma unroll
        for (int i = 0; i < 4; ++i) { const f32x4 x0 = *(const f32x4*)(rp + i * 512 + lane * 8), x1 = *(const f32x4*)(rp + i * 512 + lane * 8 + 4);
#pragma unroll
            for (int e = 0; e < 4; ++e) { v[i * 8 + e] = x0[e]; v[i * 8 + 4 + e] = x1[e]; s += x0[e] + x1[e]; } }
        const float mu = wave_sum(s) * (1.0f / 2048.0f);
        float q = 0.f;
#pragma unroll
        for (int e = 0; e < 32; ++e) { const float d = v[e] - mu; q += d * d; }
        const float rstd = rsqrtf(wave_sum(q) * (1.0f / 2048.0f) + 1e-5f);
        const float* mp = mod + (row >> 12) * 12288;
#pragma unroll
        for (int i = 0; i < 4; ++i) {
            const int col = i * 512 + lane * 8;
            float xn[8], h[8];
#pragma unroll
            for (int e = 0; e < 8; ++e) { xn[e] = (v[i * 8 + e] - mu) * rstd * g[col + e] + bb[col + e]; h[e] = xn[e] * (1.0f + mp[8192 + col + e]) + mp[6144 + col + e]; }
            *(f32x4*)(rp + col) = (f32x4){xn[0], xn[1], xn[2], xn[3]}; *(f32x4*)(rp + col + 4) = (f32x4){xn[4], xn[5], xn[6], xn[7]};
            *(u32x4*)(H2 + (size_t)row * 2048 + col) = pack8(h);
        }
    }
}

__device__ __forceinline__ void topk16_2(float v0, float v1, int lane, float& rs, int& ri) {
    rs = -INFINITY; ri = 0;
    for (int it = 0; it < 16; ++it) {
        const float wm = wave_max(fmaxf(v0, v1));
        const unsigned long long b0 = __ballot(v0 == wm), b1 = __ballot(v1 == wm);
        int key;
        if (b0) { const int l = __ffsll((long long)b0) - 1; key = l; if (lane == l) v0 = -INFINITY; }
        else { const int l = __ffsll((long long)b1) - 1; key = 64 + l; if (lane == l) v1 = -INFINITY; }
        if (lane == it) { rs = wm; ri = key; }
    }
}
__device__ __forceinline__ void topk16_4(float c0, float c1, float c2, float c3, int lane, float& rs, int& ri) {
    rs = -INFINITY; ri = 0;
    for (int it = 0; it < 16; ++it) {
        const float wm = wave_max(fmaxf(fmaxf(c0, c1), fmaxf(c2, c3)));
        const unsigned long long b0 = __ballot(c0 == wm), b1 = __ballot(c1 == wm), b2 = __ballot(c2 == wm), b3 = __ballot(c3 == wm);
        const unsigned long long ball = b0 | b1 | b2 | b3;
        const int l = __ffsll((long long)ball) - 1;
        const int r = ((b0 >> l) & 1ull) ? 0 : ((b1 >> l) & 1ull) ? 1 : ((b2 >> l) & 1ull) ? 2 : 3;
        if (lane == l) { if (r == 0) c0 = -INFINITY; else if (r == 1) c1 = -INFINITY; else if (r == 2) c2 = -INFINITY; else c3 = -INFINITY; }
        if (lane == it) { rs = wm; ri = l * 4 + r; }
    }
}
__device__ void peer_unit(KA a, int unit, unsigned char* lds) {
    const int tid = tid_opaque(), lane = tid & 63, wid = tid >> 6;
    float* SK = (float*)lds; float* QT = (float*)(lds + 66048); float* SC = (float*)(lds + 82432);
    int* IGI = (int*)(lds + 98816); float* IGG = (float*)(lds + 115200);
    const int tok0 = unit * 32;
    const float* Qp = (const float*)(a->ws + WS_RB); const float* subk = a->in[26];
    const bf16_t* H2 = (const bf16_t*)(a->ws + WS_RA) + (size_t)2 * MT * 2048;
    const float* mod = (const float*)(a->ws + WS_MOD);
    for (int h = 0; h < 8; ++h) {
        float tps[2][4]; int tpi[2][4];
#pragma unroll
        for (int p = 0; p < 2; ++p) {
            __syncthreads();
            for (int i = tid; i < 128 * 32; i += NT) { const int key = i >> 5, d4 = (i & 31) * 4; const f32x4 v = *(const f32x4*)(subk + (size_t)((h * 2 + p) * 128 + key) * 128 + d4);
                float* t = SK + key * 129 + d4; t[0] = v.x; t[1] = v.y; t[2] = v.z; t[3] = v.w; }
            for (int i = tid; i < 32 * 32; i += NT) { const int r = i >> 5, d4 = (i & 31) * 4; *(f32x4*)(QT + r * 128 + d4) = *(const f32x4*)(Qp + (size_t)(tok0 + r) * 2048 + h * 256 + p * 128 + d4); }
            __syncthreads();
            {
                const int key = tid & 127, tg = tid >> 7;
                float s[8];
#pragma unroll
                for (int e = 0; e < 8; ++e) s[e] = 0.f;
                for (int d4 = 0; d4 < 32; ++d4) {
                    const float* sp = SK + key * 129 + d4 * 4; const float k0 = sp[0], k1 = sp[1], k2 = sp[2], k3 = sp[3];
#pragma unroll
                    for (int e = 0; e < 8; ++e) { const f32x4 q = *(const f32x4*)(QT + (tg * 8 + e) * 128 + d4 * 4); s[e] += (k0 * q.x + k1 * q.y) + (k2 * q.z + k3 * q.w); }
                }
#pragma unroll
                for (int e = 0; e < 8; ++e) SC[(tg * 8 + e) * 128 + key] = s[e];
            }
            __syncthreads();
#pragma unroll
            for (int rr = 0; rr < 4; ++rr) { const int row = wid * 4 + rr; topk16_2(SC[row * 128 + lane], SC[row * 128 + 64 + lane], lane, tps[p][rr], tpi[p][rr]); }
        }
#pragma unroll
        for (int rr = 0; rr < 4; ++rr) {
            const int row = wid * 4 + rr;
            const float s0 = __shfl(tps[0][rr], lane >> 2, 64);
            const float c0 = s0 + __shfl(tps[1][rr], 4 * (lane & 3) + 0, 64), c1 = s0 + __shfl(tps[1][rr], 4 * (lane & 3) + 1, 64),
                        c2 = s0 + __shfl(tps[1][rr], 4 * (lane & 3) + 2, 64), c3 = s0 + __shfl(tps[1][rr], 4 * (lane & 3) + 3, 64);
            float bs; int bc; topk16_4(c0, c1, c2, c3, lane, bs, bc);
            const int e0 = __shfl(tpi[0][rr], (bc >> 4) & 15, 64), e1 = __shfl(tpi[1][rr], bc & 15, 64);
            const float mx = __shfl(bs, 0, 64);
            const float ex = (lane < 16) ? expf(bs - mx) : 0.f;
            const float sm = wave_sum(ex);
            if (lane < 16) { IGI[row * 128 + h * 16 + lane] = e0 * 128 + e1; IGG[row * 128 + h * 16 + lane] = ex / sm; }
        }
    }
    __syncthreads();
    const unsigned char* U8 = a->ws + WS_RA + PEER_U8; const unsigned char* V8 = a->ws + WS_RA + PEER_V8;
    const float* US = (const float*)(a->ws + WS_RA + PEER_US); const float* VS = (const float*)(a->ws + WS_RA + PEER_VS);
#pragma unroll 1
    for (int rr = 0; rr < 4; ++rr) {
        const int row = wid * 4 + rr, tok = tok0 + row;
        float hx[32], yq[32]; float hs = 0.f;
#pragma unroll
        for (int i = 0; i < 2; ++i) {
            float t8[8];
            unpack8(*(const u32x4*)(H2 + (size_t)tok * 2048 + i * 1024 + lane * 16), t8);
#pragma unroll
            for (int e = 0; e < 8; ++e) { hx[i * 16 + e] = t8[e]; hs += t8[e]; }
            unpack8(*(const u32x4*)(H2 + (size_t)tok * 2048 + i * 1024 + lane * 16 + 8), t8);
#pragma unroll
            for (int e = 0; e < 8; ++e) { hx[i * 16 + 8 + e] = t8[e]; hs += t8[e]; }
        }
#pragma unroll
        for (int e = 0; e < 32; ++e) yq[e] = 0.f;
        hs = wave_sum(hs);
        float csum = 0.f;
#if DBG_MODE != 2
        const int* ip = IGI + row * 128; const float* gp = IGG + row * 128;
        u32x4 nu[2][2], nv[2][2]; float nsu[2], nsv[2];
#pragma unroll
        for (int k = 0; k < 2; ++k) {
            const int idx = __builtin_amdgcn_readfirstlane(ip[k]);
            const unsigned char* up = U8 + (size_t)idx * 2048 + lane * 16; const unsigned char* vp = V8 + (size_t)idx * 2048 + lane * 16;
            nu[k][0] = *(const u32x4*)up; nu[k][1] = *(const u32x4*)(up + 1024); nv[k][0] = *(const u32x4*)vp; nv[k][1] = *(const u32x4*)(vp + 1024);
            nsu[k] = US[idx]; nsv[k] = VS[idx];
        }
#pragma unroll 1
        for (int e = 0; e < 128; e += 2) {
            u32x4 cu[2][2], cvv[2][2]; float csu[2], csv[2];
#pragma unroll
            for (int k = 0; k < 2; ++k) { cu[k][0] = nu[k][0]; cu[k][1] = nu[k][1]; cvv[k][0] = nv[k][0]; cvv[k][1] = nv[k][1]; csu[k] = nsu[k]; csv[k] = nsv[k]; }
            if (e + 2 < 128) {
#pragma unroll
                for (int k = 0; k < 2; ++k) {
                    const int idx = __builtin_amdgcn_readfirstlane(ip[e + 2 + k]);
                    const unsigned char* up = U8 + (size_t)idx * 2048 + lane * 16; const unsigned char* vp = V8 + (size_t)idx * 2048 + lane * 16;
                    nu[k][0] = *(const u32x4*)up; nu[k][1] = *(const u32x4*)(up + 1024); nv[k][0] = *(const u32x4*)vp; nv[k][1] = *(const u32x4*)(vp + 1024);
                    nsu[k] = US[idx]; nsv[k] = VS[idx];
                }
            }
#pragma unroll
            for (int k = 0; k < 2; ++k) {
                float acc = 0.f;
#pragma unroll
                for (int i = 0; i < 2; ++i)
#pragma unroll
                    for (int j = 0; j < 4; ++j) { const unsigned wd = cu[k][i][j]; const float* hp = hx + i * 16 + j * 4;
                        acc += (float)(wd & 255u) * hp[0]; acc += (float)((wd >> 8) & 255u) * hp[1]; acc += (float)((wd >> 16) & 255u) * hp[2]; acc += (float)(wd >> 24) * hp[3]; }
                const float dot = csu[k] * (wave_sum(acc) - 128.0f * hs);
                const float c1 = gp[e + k] * 0.5f * dot * (1.0f + erff(dot * 0.7071067811865476f)) * csv[k];
                csum += c1;
#pragma unroll
                for (int i = 0; i < 2; ++i)
#pragma unroll
                    for (int j = 0; j < 4; ++j) { const unsigned wd = cvv[k][i][j]; float* yp = yq + i * 16 + j * 4;
                        yp[0] += c1 * (float)(wd & 255u); yp[1] += c1 * (float)((wd >> 8) & 255u); yp[2] += c1 * (float)((wd >> 16) & 255u); yp[3] += c1 * (float)(wd >> 24); }
            }
        }
#endif
        float* rp = a->out + (size_t)tok * 2048; const float* mp = mod + (tok >> 12) * 12288 + 10240;
        float val[32]; float s = 0.f;
        const float yoff = 128.0f * csum;
#pragma unroll
        for (int i = 0; i < 2; ++i)
#pragma unroll
            for (int j = 0; j < 4; ++j) { const int col = i * 1024 + lane * 16 + j * 4; const f32x4 x0 = *(const f32x4*)(rp + col), g0 = *(const f32x4*)(mp + col);
#pragma unroll
                for (int e = 0; e < 4; ++e) { const float v = ALPHA * x0[e] + g0[e] * (yq[i * 16 + j * 4 + e] - yoff); val[i * 16 + j * 4 + e] = v; s += v; } }
        const float mu = wave_sum(s) * (1.0f / 2048.0f);
        float q = 0.f;
#pragma unroll
        for (int e = 0; e < 32; ++e) { const float d = val[e] - mu; q += d * d; }
        const float rstd = rsqrtf(wave_sum(q) * (1.0f / 2048.0f) + 1e-5f);
        const float* g = a->in[29]; const float* bb = a->in[30];
#pragma unroll
        for (int i = 0; i < 2; ++i)
#pragma unroll
            for (int j = 0; j < 4; ++j) { const int col = i * 1024 + lane * 16 + j * 4; const f32x4 gg = *(const f32x4*)(g + col), bv = *(const f32x4*)(bb + col); f32x4 o;
#pragma unroll
                for (int e = 0; e < 4; ++e) o[e] = (val[i * 16 + j * 4 + e] - mu) * rstd * gg[e] + bv[e];
                *(f32x4*)(rp + col) = o; }
    }
    __syncthreads();
}

__global__ void __launch_bounds__(NT, 2) fwd_mega(Args a_) {
    KA a = (KA)__builtin_amdgcn_kernarg_segment_ptr();
    extern __shared__ __attribute__((aligned(16))) unsigned char lds[];
    cg::grid_group grid = cg::this_grid();
    float* lf = (float*)lds;
    const int lo = a->ph_lo, hi = a->ph_hi;
#define IN(k) (lo <= (k) && (k) < hi)
#define SEAM(k) do { if (IN(k) && IN((k) + 1)) grid.sync(); asm volatile("" : "+s"(a)); } while (0)
    unsigned char* ws = a->ws;
    bf16_t* HA = (bf16_t*)(ws + WS_HA); bf16_t* WT = (bf16_t*)(ws + WS_WT); bf16_t* SW = (bf16_t*)(ws + WS_SW);
    bf16_t* RA = (bf16_t*)(ws + WS_RA); bf16_t* RB = (bf16_t*)(ws + WS_RB);
    const float* mod = (const float*)(ws + WS_MOD);

    if (IN(0)) { p0_mod_hid2(a, lf); p0_transposes(a, lf); }
    SEAM(0);
    if (IN(1)) { p1_ha(a); }
    SEAM(1);
    if (IN(2)) {
        run_gemm(lds, WT + (size_t)WT_HY0 * 2048, HA, NHY, MT, FStoreBf16{RA, MT});
        run_gemm(lds, HA, WT, MA, NQKVP, FStoreQKV{RB, (float*)(ws + WS_AB)});
    }
    SEAM(2);
    if (IN(3)) {
        hyena_setup(lds);
        for (int c = blockIdx.x; c < 2048; c += gridDim.x) hyena_item(a, c, lds);
        for (int u = blockIdx.x; u < 12288 + 192; u += gridDim.x) qkvpost_unit(a, u, lds);
    }
    SEAM(3);
    if (IN(4)) {
        { const int wv = tid_opaque() >> 6; for (int pid = blockIdx.x * 8 + wv; pid < 8704; pid += gridDim.x * 8) tprep_wave(a, pid, lds + wv * 17920); }
        grid.sync();
        for (int it = blockIdx.x; it < 256; it += gridDim.x) delta_item(a, it, lds);
    }
    SEAM(4);
    if (IN(5)) {
        run_gemm(lds, HA, WT + (size_t)WT_ZG0 * 2048, MT, NZG, FStoreBf16{RB, NZG});
        for (int u = blockIdx.x; u < 8192; u += gridDim.x) ytrans_unit((const bf16_t*)a->out, RA + (size_t)2 * MT * 2048, u, (bf16_t*)lds);
    }
    SEAM(5);
    if (IN(6)) { p6_on(a); }
    SEAM(6);
    if (IN(7)) {
        run_gemm(lds, HA  , SW, MT, D, FGatePA{RB, WT  });
        run_gemm(lds, RA + (size_t)2 * MT * 2048  , SW + (size_t)1 * D * D, MT, D, FGatePH{RB, WT  });
    }
    SEAM(7);
    if (IN(8)) {
        run_gemm(lds, WT  , SW + (size_t)2 * D * D, MT, D, FOut{a->in[0], mod, a->out});
        p8_tables(a);
    }
    SEAM(8);
    if (IN(9)) { p9_ln1(a); }
    SEAM(9);
    if (IN(10)) { run_gemm(lds, RA + (size_t)2 * MT * 2048  , SW + (size_t)3 * D * D, MT, D, FStoreF32{(float*)(ws + WS_RB), D}); }
    SEAM(10);
    if (IN(11)) { for (int u = blockIdx.x; u < MT / 32; u += gridDim.x) peer_unit(a, u, lds); }
#undef IN
#undef SEAM
}

extern "C" void kernel_launch(void* const* d_in, const int* in_sizes, int n_in, void* d_out, int out_size, void* d_ws, size_t ws_size, hipStream_t stream) {
    static int grid = 0;
    if (grid == 0) {
        if (n_in != 31 || out_size != MT * D || ws_size < WS_END) { fprintf(stderr, "kernel_launch: unexpected problem shape / workspace (%d inputs, out %d, ws %zu)\n", n_in, out_size, ws_size); grid = -1; return; }
        int dev = 0, cus = 0, per_cu = 0;
        (void)hipGetDevice(&dev);
        (void)hipDeviceGetAttribute(&cus, hipDeviceAttributeMultiprocessorCount, dev);
        (void)hipFuncSetAttribute((const void*)fwd_mega, hipFuncAttributeMaxDynamicSharedMemorySize, LDS_BYTES);
        (void)hipOccupancyMaxActiveBlocksPerMultiprocessor(&per_cu, (const void*)fwd_mega, NT, LDS_BYTES);
        if (per_cu < 1) per_cu = 1;
        grid = cus * per_cu;
        (void)hipGetLastError();
    }
    if (grid < 0) return;
    Args a{};
    for (int i = 0; i < 31; ++i) a.in[i] = (const float*)d_in[i];
    a.out = (float*)d_out; a.ws = (unsigned char*)d_ws; a.ph_lo = 0; a.ph_hi = 12;
    void* args[] = {&a};
    hipError_t e = hipLaunchCooperativeKernel((const void*)fwd_mega, dim3(grid), dim3(NT), args, LDS_BYTES, stream);
    if (e != hipSuccess) fprintf(stderr, "cooperative launch failed: %s (grid %d)\n", hipGetErrorString(e), grid);
}
```

```cpp
#include <hip/hip_runtime.h>
#include <hip/hip_cooperative_groups.h>
#include <cstdio>
#include <cstdint>
namespace cg = cooperative_groups;

#ifndef DBG_MODE
#define DBG_MODE 0
#endif
#define REP0 1
#define REP1 1
#define REP2 1
#define REP3 1

__device__ __forceinline__ int tid_opaque() { int t = threadIdx.x; asm volatile("" : "+v"(t)); return t; }

namespace pg8 {
#define PG8_LAS __attribute__((address_space(3)))
typedef unsigned short bf16_t;
typedef short bf16x8 __attribute__((ext_vector_type(8)));
typedef float f32x4 __attribute__((ext_vector_type(4)));
typedef unsigned u32x4 __attribute__((ext_vector_type(4)));
constexpr int BM = 256, BK = 64, HALF = 128, HTB = HALF * BK * 2, STAGE_BYTES = 8 * HTB, NXCD = 8, WGM = 8;

__host__ __device__ __forceinline__ int lds_byte(int r, int c) { const int st = (r >> 4) * 2 + (c >> 5), rr = r & 15, cc = c & 31, ob = rr * 64 + cc * 2; return st * 1024 + (ob ^ (((ob >> 9) & 1) << 5)); }
__host__ __device__ __forceinline__ void stage_rc(int b, int& R, int& C) { const int st = b / 1024, sb = b % 1024, swz = sb ^ (((sb >> 9) & 1) << 5); R = (st >> 1) * 16 + swz / 64; C = (st & 1) * 32 + (swz % 64) / 2; }
__host__ __device__ __forceinline__ int perm32(int rho) { const int n = rho >> 4, i = rho & 15; return 8 * (i >> 2) + 4 * n + (i & 3); }

struct Unit { int pm, pn; };
struct Gemm { const bf16_t* A; const bf16_t* Bt; int M, N, K; };

struct StaticOrder {
    int nM, nN, nwg, G, c;
    __host__ __device__ void init(int M, int N, int G_, int c_) { nM = M / BM; nN = N / BM; nwg = nM * nN; G = G_; c = c_; }
    __host__ __device__ bool next(int i, Unit& u) const {
        const long L = (long)i * G + c; if (L >= nwg) return false;
        int wgid = (int)L; { const int q = nwg / NXCD, r = nwg % NXCD, xcd = wgid % NXCD, off = wgid / NXCD; wgid = (xcd < r ? xcd * (q + 1) : r * (q + 1) + (xcd - r) * q) + off; }
        const int nig = WGM * nN, gid = wgid / nig, fm = gid * WGM, gsz = (nM - fm) < WGM ? (nM - fm) : WGM;
        u.pm = fm + ((wgid % nig) % gsz); u.pn = (wgid % nig) / gsz; return true;
    }
    __device__ __forceinline__ void a_ready(const Unit&) const {}
    __device__ __forceinline__ void done(const Unit&) const {}
};

__device__ __forceinline__ unsigned cvt_pk_bf16(float lo, float hi) { unsigned r; asm volatile("v_cvt_pk_bf16_f32 %0, %1, %2" : "=v"(r) : "v"(lo), "v"(hi)); return r; }

template <class F> struct EpiGen {
    static constexpr bool PERM = true, AFTER_DRAIN = false;
    F f;
    __device__ __forceinline__ void operator()(const f32x4 (&acc)[2][2][4][2], const Unit& u, int wr, int wc, int fr, int fq) const {
        const int row0 = u.pm * BM + wr * 64 + fr, col0 = u.pn * BM + wc * 32 + 8 * fq;
#pragma unroll
        for (int ai = 0; ai < 2; ++ai)
#pragma unroll
            for (int m = 0; m < 4; ++m)
#pragma unroll
                for (int bj = 0; bj < 2; ++bj) f(row0 + ai * HALF + m * 16, col0 + bj * HALF, acc[ai][bj][m][0], acc[ai][bj][m][1]);
    }
};

template <class Epi, class Sched>
__device__ __forceinline__ void gemm_phase(PG8_LAS unsigned char* lds, const Gemm g, const Sched& S, const Epi& E) {
    const int tid = tid_opaque(), wid = __builtin_amdgcn_readfirstlane(tid >> 6), lane = tid & 63, wr = wid >> 2, wc = wid & 3, fr = lane & 15, fq = lane >> 4;
    const int K = g.K, nt = K / BK;
    unsigned voffA[2], voffB[2];
#pragma unroll
    for (int i = 0; i < 2; ++i) { int R, C; stage_rc(tid * 16 + i * 8192, R, C); const int Rb = Epi::PERM ? ((R & ~31) + perm32(R & 31)) : R;
        voffA[i] = (unsigned)(R * K + C) * 2u; voffB[i] = (unsigned)(Rb * K + C) * 2u; }
    const size_t kstep = (size_t)(BK * 2);
    const size_t hstep = (size_t)HALF * K * 2;
    const size_t tstep = 2 * hstep;
    const unsigned ldsw = (unsigned)wid * 1024u;
    const int aoff = lds_byte(wr * 64 + fr, fq * 8), boff = lds_byte(wc * 32 + fr, fq * 8);
#define PG8_SA(b, h) (((b) * 2 + (h)) * HTB)
#define PG8_SB(b, h) ((4 + (b) * 2 + (h)) * HTB)
#define PG8_STAGE(bufoff, gbase, voff) do { _Pragma("unroll") for (int _i = 0; _i < 2; ++_i) \
        __builtin_amdgcn_global_load_lds((const unsigned*)((const char*)(gbase) + (voff)[_i]), (PG8_LAS unsigned*)(lds + (bufoff) + ldsw + _i * 8192), 16, 0, 0); } while (0)
#define PG8_LDA(dst, b, h) do { _Pragma("unroll") for (int m = 0; m < 4; ++m) _Pragma("unroll") for (int k = 0; k < 2; ++k) dst[m][k] = *(const PG8_LAS bf16x8*)(lds + PG8_SA(b, h) + aoff + m * 2048 + k * 1024); } while (0)
#define PG8_LDB(dst, b, h) do { _Pragma("unroll") for (int n = 0; n < 2; ++n) _Pragma("unroll") for (int k = 0; k < 2; ++k) dst[n][k] = *(const PG8_LAS bf16x8*)(lds + PG8_SB(b, h) + boff + n * 2048 + k * 1024); } while (0)
#define PG8_MMA(ai, bj, At, Bt) do { __builtin_amdgcn_s_setprio(1); _Pragma("unroll") for (int m = 0; m < 4; ++m) _Pragma("unroll") for (int n = 0; n < 2; ++n) _Pragma("unroll") for (int k = 0; k < 2; ++k) \
        acc[ai][bj][m][n] = __builtin_amdgcn_mfma_f32_16x16x32_bf16(Bt[n][k], At[m][k], acc[ai][bj][m][n], 0, 0, 0); __builtin_amdgcn_s_setprio(0); } while (0)
#define PG8_WAIT_V(n) asm volatile("s_waitcnt vmcnt(" #n ")" ::: "memory")
#define PG8_WAIT_L(n) asm volatile("s_waitcnt lgkmcnt(" #n ")" ::: "memory")
#define PG8_BAR __builtin_amdgcn_s_barrier()
#define PG8_SCHED __builtin_amdgcn_sched_barrier(0)
    Unit cur, nxt; int ui = 0;
    if (!S.next(0, cur)) return;
    f32x4 acc[2][2][4][2];
#pragma unroll
    for (int a = 0; a < 2; ++a)
#pragma unroll
        for (int b = 0; b < 2; ++b)
#pragma unroll
            for (int m = 0; m < 4; ++m)
#pragma unroll
                for (int n = 0; n < 2; ++n) acc[a][b][m][n] = (f32x4){0.f, 0.f, 0.f, 0.f};
    bf16x8 At[4][2], B0[2][2], B1[2][2];
    const char* cA = (const char*)g.A + (size_t)cur.pm * tstep; const char* cB = (const char*)g.Bt + (size_t)cur.pn * tstep;
    S.a_ready(cur);
    PG8_STAGE(PG8_SB(0, 0), cB, voffB); PG8_STAGE(PG8_SA(0, 0), cA, voffA); PG8_STAGE(PG8_SB(0, 1), cB + hstep, voffB); PG8_STAGE(PG8_SA(0, 1), cA + hstep, voffA);
    if (wr == 1) PG8_BAR;
    PG8_WAIT_V(4); PG8_BAR;
    PG8_STAGE(PG8_SB(1, 0), cB + kstep, voffB); PG8_STAGE(PG8_SA(1, 0), cA + kstep, voffA); PG8_STAGE(PG8_SB(1, 1), cB + hstep + kstep, voffB);
    PG8_WAIT_V(6); PG8_BAR;
    for (;;) {
        const bool has_next = S.next(ui + 1, nxt);
        const char* nA = has_next ? (const char*)g.A + (size_t)nxt.pm * tstep : cA; const char* nB = has_next ? (const char*)g.Bt + (size_t)nxt.pn * tstep : cB;
        for (int t = 0; t < nt; t += 2) {
            const bool last = (t == nt - 2);
            const char* a1 = cA + (size_t)(t + 1) * kstep;
            const char* a2 = last ? nA : cA + (size_t)(t + 2) * kstep; const char* b2 = last ? nB : cB + (size_t)(t + 2) * kstep;
            const char* a3 = a2 + kstep; const char* b3 = b2 + kstep;
            if (last && has_next) S.a_ready(nxt);
            PG8_LDB(B0, 0, 0); PG8_SCHED; PG8_LDA(At, 0, 0); PG8_STAGE(PG8_SA(1, 1), a1 + hstep, voffA);
            PG8_WAIT_L(8); PG8_BAR; PG8_WAIT_L(0); PG8_MMA(0, 0, At, B0); PG8_BAR; PG8_SCHED;
            PG8_LDB(B1, 0, 1); PG8_STAGE(PG8_SB(0, 0), b2, voffB);
            PG8_BAR; PG8_WAIT_L(0); PG8_MMA(0, 1, At, B1); PG8_BAR;
            PG8_LDA(At, 0, 1); PG8_STAGE(PG8_SA(0, 0), a2, voffA);
            PG8_BAR; PG8_WAIT_L(0); PG8_MMA(1, 0, At, B0); PG8_BAR; PG8_SCHED;
            PG8_STAGE(PG8_SB(0, 1), b2 + hstep, voffB);
            PG8_WAIT_V(6); PG8_BAR; PG8_MMA(1, 1, At, B1); PG8_BAR;
            PG8_LDB(B0, 1, 0); PG8_SCHED; PG8_LDA(At, 1, 0); PG8_STAGE(PG8_SA(0, 1), a2 + hstep, voffA);
            PG8_WAIT_L(8); PG8_BAR; PG8_WAIT_L(0); PG8_MMA(0, 0, At, B0); PG8_BAR; PG8_SCHED;
            PG8_LDB(B1, 1, 1); PG8_STAGE(PG8_SB(1, 0), b3, voffB);
            PG8_BAR; PG8_WAIT_L(0); PG8_MMA(0, 1, At, B1); PG8_BAR;
            PG8_LDA(At, 1, 1); PG8_STAGE(PG8_SA(1, 0), a3, voffA);
            PG8_BAR; PG8_WAIT_L(0); PG8_MMA(1, 0, At, B0); PG8_BAR; PG8_SCHED;
            PG8_STAGE(PG8_SB(1, 1), b3 + hstep, voffB);
            PG8_WAIT_V(6); PG8_BAR; PG8_MMA(1, 1, At, B1); PG8_BAR;
        }
        E(acc, cur, wr, wc, fr, fq); S.done(cur);
        if (!has_next) break;
#pragma unroll
        for (int a = 0; a < 2; ++a)
#pragma unroll
            for (int b = 0; b < 2; ++b)
#pragma unroll
                for (int m = 0; m < 4; ++m)
#pragma unroll
                    for (int n = 0; n < 2; ++n) acc[a][b][m][n] = (f32x4){0.f, 0.f, 0.f, 0.f};
        cur = nxt; cA = nA; cB = nB; ++ui;
    }
    PG8_WAIT_V(0);
    if (wr == 0) PG8_BAR;
    PG8_BAR;
#undef PG8_SA
#undef PG8_SB
#undef PG8_STAGE
#undef PG8_LDA
#undef PG8_LDB
#undef PG8_MMA
#undef PG8_WAIT_V
#undef PG8_WAIT_L
#undef PG8_BAR
#undef PG8_SCHED
}
}

typedef unsigned short bf16_t;
typedef float f32x4 __attribute__((ext_vector_type(4)));
typedef unsigned u32x4 __attribute__((ext_vector_type(4)));
#define LAS __attribute__((address_space(3)))

constexpr int NT = 512;
constexpr int LDS_BYTES = 160 * 1024;
constexpr int D = 2048, NB = 4, SEQ = 4096, CTXL = 256;
constexpr int MT = NB * SEQ;
constexpr int MC = NB * CTXL;
constexpr int MA = MT + MC;
constexpr int NQKVP = 6400;
constexpr int PQ_LD = 6144;
constexpr int NHY = 6144, NZG = 6144;
constexpr int WT_ROWS = NQKVP + NHY + NZG;
constexpr int WT_HY0 = NQKVP, WT_ZG0 = NQKVP + NHY;
constexpr float ALPHA = 1.189207115002721f;

constexpr size_t MiB = (size_t)1 << 20;
constexpr size_t WS_MOD = 0, WS_HID2 = 1 * MiB, WS_SW = 2 * MiB, WS_HA = 34 * MiB, WS_WT = 102 * MiB, WS_RA = 175 * MiB, WS_RB = 367 * MiB, WS_AB = 580 * MiB, WS_END = 658 * MiB;

struct Args { const float* in[31]; float* out; unsigned char* ws; int ph_lo, ph_hi; int reps[4]; };
typedef const __attribute__((address_space(4))) Args* KA;

__device__ __forceinline__ unsigned f2bf(float f) { unsigned u = __float_as_uint(f); return (u + 0x7fffu + ((u >> 16) & 1u)) >> 16; }
__device__ __forceinline__ unsigned pk2(float lo, float hi) { return f2bf(lo) | (f2bf(hi) << 16); }
__device__ __forceinline__ float bflo(unsigned w) { return __uint_as_float(w << 16); }
__device__ __forceinline__ float bfhi(unsigned w) { return __uint_as_float(w & 0xffff0000u); }
__device__ __forceinline__ float bf2f(bf16_t b) { return __uint_as_float(((unsigned)b) << 16); }
__device__ __forceinline__ void unpack8(const u32x4 w, float (&o)[8]) { o[0] = bflo(w.x); o[1] = bfhi(w.x); o[2] = bflo(w.y); o[3] = bfhi(w.y); o[4] = bflo(w.z); o[5] = bfhi(w.z); o[6] = bflo(w.w); o[7] = bfhi(w.w); }
__device__ __forceinline__ u32x4 pack8(const float (&v)[8]) { u32x4 w; w.x = pk2(v[0], v[1]); w.y = pk2(v[2], v[3]); w.z = pk2(v[4], v[5]); w.w = pk2(v[6], v[7]); return w; }
__device__ __forceinline__ float sigmoidf_(float x) { return 1.0f / (1.0f + expf(-x)); }
__device__ __forceinline__ float siluf_(float x) { return x / (1.0f + expf(-x)); }
__device__ __forceinline__ float rdlane(float v, const int l) { return __builtin_bit_cast(float, __builtin_amdgcn_readlane(__builtin_bit_cast(int, v), l)); }
__device__ __forceinline__ float wave_sum(float v) {
    v += __builtin_bit_cast(float, __builtin_amdgcn_update_dpp(0, __builtin_bit_cast(int, v), 0x128, 0xf, 0xf, false));
    v += __builtin_bit_cast(float, __builtin_amdgcn_update_dpp(0, __builtin_bit_cast(int, v), 0x124, 0xf, 0xf, false));
    v += __builtin_bit_cast(float, __builtin_amdgcn_update_dpp(0, __builtin_bit_cast(int, v), 0x122, 0xf, 0xf, false));
    v += __builtin_bit_cast(float, __builtin_amdgcn_update_dpp(0, __builtin_bit_cast(int, v), 0x121, 0xf, 0xf, false));
    return (rdlane(v, 0) + rdlane(v, 16)) + (rdlane(v, 32) + rdlane(v, 48));
}
__device__ __forceinline__ float wave_max(float v) {
    v = fmaxf(v, __builtin_bit_cast(float, __builtin_amdgcn_update_dpp(0, __builtin_bit_cast(int, v), 0x128, 0xf, 0xf, false)));
    v = fmaxf(v, __builtin_bit_cast(float, __builtin_amdgcn_update_dpp(0, __builtin_bit_cast(int, v), 0x124, 0xf, 0xf, false)));
    v = fmaxf(v, __builtin_bit_cast(float, __builtin_amdgcn_update_dpp(0, __builtin_bit_cast(int, v), 0x122, 0xf, 0xf, false)));
    v = fmaxf(v, __builtin_bit_cast(float, __builtin_amdgcn_update_dpp(0, __builtin_bit_cast(int, v), 0x121, 0xf, 0xf, false)));
    return fmaxf(fmaxf(rdlane(v, 0), rdlane(v, 16)), fmaxf(rdlane(v, 32), rdlane(v, 48)));
}

__device__ void p0_mod_hid2(KA a, float* lf) {
    const int tid = tid_opaque(), bid = blockIdx.x;
    if (bid < 192) {
        const float* c = a->in[1]; const float* cc = a->in[3]; const float* w_ada = a->in[4]; const float* b_ada = a->in[5];
        float* mod = (float*)(a->ws + WS_MOD);
        for (int i = tid; i < 5 * 2048; i += NT) { const int r = i >> 11, k = i & 2047; const float v = (r < 4) ? c[r * 2048 + k] : cc[k]; lf[i] = siluf_(v); }
        __syncthreads();
        const int cl = tid & 63, kg = tid >> 6, col = bid * 64 + cl;
        float a0 = 0.f, a1 = 0.f, a2 = 0.f, a3 = 0.f, a4 = 0.f;
#pragma unroll 8
        for (int k = kg * 256; k < kg * 256 + 256; ++k) {
            const float w = w_ada[(size_t)k * 12288 + col];
            a0 += lf[k] * w; a1 += lf[2048 + k] * w; a2 += lf[4096 + k] * w; a3 += lf[6144 + k] * w; a4 += lf[8192 + k] * w;
        }
        float* red = lf + 5 * 2048;
        red[(kg * 5 + 0) * 64 + cl] = a0; red[(kg * 5 + 1) * 64 + cl] = a1; red[(kg * 5 + 2) * 64 + cl] = a2; red[(kg * 5 + 3) * 64 + cl] = a3; red[(kg * 5 + 4) * 64 + cl] = a4;
        __syncthreads();
        if (tid < 320) { const int r = tid >> 6; float s = 0.f;
#pragma unroll
            for (int g = 0; g < 8; ++g) s += red[(g * 5 + r) * 64 + cl];
            mod[r * 12288 + col] = s + b_ada[col]; }
        __syncthreads();
    } else {
        const float* w1 = a->in[12]; const float* b1 = a->in[13]; const float* w2 = a->in[14]; const float* b2 = a->in[15]; const float* freq = a->in[18];
        float* hid2 = (float*)(a->ws + WS_HID2);
        const int pb = (bid - 192) * 64, j = tid & 63, pl = tid >> 6;
        const float fj = freq[j];
        for (int it = 0; it < 8; ++it) {
            const int pos = pb + it * 8 + pl;
            const float tt = (float)pos * (1.0f / 4095.0f);
            float s1 = tt * w1[j];
            const float base = (6.283185307179586f / 4096.0f) * (float)pos;
            for (int e = 0; e < 16; ++e) {
                const float band = 1e-4f + (float)e * ((15.0f - 1e-4f) / 15.0f);
                const float ang = base * band;
                s1 += cosf(ang) * w1[(1 + e) * 64 + j] - sinf(ang) * w1[(17 + e) * 64 + j];
            }
            lf[pl * 64 + j] = sinf(fj * (s1 + b1[j]));
            __syncthreads();
            float s2 = 0.f;
            for (int i = 0; i < 64; ++i) s2 += lf[pl * 64 + i] * w2[i * 64 + j];
            hid2[pos * 64 + j] = sinf(fj * (s2 + b2[j]));
            __syncthreads();
        }
    }
}

__device__ void transpose_unit(const float* src, int ldn, int n0src, bf16_t* dst, int nb, int kb, float* tile) {
    const int tid = tid_opaque(), r = tid >> 4, c4 = tid & 15;
#pragma unroll
    for (int i = 0; i < 4; ++i) {
        const int kk = i * 32 + r;
        f32x4 v = (f32x4){0.f, 0.f, 0.f, 0.f};
        if (n0src >= 0) v = *(const f32x4*)(src + (size_t)(kb * 128 + kk) * ldn + n0src + c4 * 4);
        float* t = tile + kk * 65 + c4 * 4; t[0] = v.x; t[1] = v.y; t[2] = v.z; t[3] = v.w;
    }
    __syncthreads();
#pragma unroll
    for (int i = 0; i < 2; ++i) {
        const int chunk = tid + i * NT, nr = chunk >> 4, kc = chunk & 15;
        const float* t = tile + (kc * 8) * 65 + nr;
        u32x4 w; w.x = pk2(t[0], t[65]); w.y = pk2(t[130], t[195]); w.z = pk2(t[260], t[325]); w.w = pk2(t[390], t[455]);
        *(u32x4*)(dst + (size_t)(nb * 64 + nr) * 2048 + kb * 128 + kc * 8) = w;
    }
    __syncthreads();
}
__device__ __forceinline__ int win_colmap(int np) {
    if (np < 6144) return np;
    if (np < 6208) return 8192 + (np - 6144);
    if (np < 6400) return -1;
    if (np < 12544) return 8256 + (np - 6400);
    if (np < 14592) return 6144 + (np - 12544);
    return 14400 + (np - 14592);
}
__device__ void p0_transposes(KA a, float* lf) {
    bf16_t* WT = (bf16_t*)(a->ws + WS_WT); bf16_t* SW = (bf16_t*)(a->ws + WS_SW);
    const int NU_WT = (WT_ROWS / 64) * 16, NU_SW = 4 * 32 * 16;
    for (int u = blockIdx.x; u < NU_WT + NU_SW; u += gridDim.x) {
        if (u < NU_WT) { const int nb = u >> 4, kb = u & 15; transpose_unit(a->in[6], 18496, win_colmap(nb * 64), WT, nb, kb, lf); }
        else { const int v = u - NU_WT, mtx = v >> 9, nb = (v >> 4) & 31, kb = v & 15;
            const float* src = (mtx == 0) ? a->in[20] : (mtx == 1) ? a->in[21] : (mtx == 2) ? a->in[22] : a->in[25];
            transpose_unit(src, 2048, nb * 64, SW + (size_t)mtx * 2048 * 2048, nb, kb, lf); }
    }
}

__device__ void p1_ha(KA a) {
    const float* mod = (const float*)(a->ws + WS_MOD); bf16_t* HA = (bf16_t*)(a->ws + WS_HA);
    const size_t nthr = (size_t)gridDim.x * NT;
    for (size_t i = (size_t)blockIdx.x * NT + tid_opaque(); i < (size_t)MA * 256; i += nthr) {
        const int row = (int)(i >> 8), k8 = (int)(i & 255) * 8;
        const float* sp; int mr;
        if (row < MT) { sp = a->in[0] + (size_t)row * 2048 + k8; mr = row >> 12; } else { sp = a->in[2] + (size_t)(row - MT) * 2048 + k8; mr = 4; }
        const f32x4 x0 = *(const f32x4*)sp, x1 = *(const f32x4*)(sp + 4);
        const float* mp = mod + mr * 12288 + k8;
        const f32x4 h0 = *(const f32x4*)mp, h1 = *(const f32x4*)(mp + 4), s0 = *(const f32x4*)(mp + 2048), s1 = *(const f32x4*)(mp + 2052);
        float v[8];
#pragma unroll
        for (int e = 0; e < 4; ++e) { v[e] = x0[e] * (1.0f + s0[e]) + h0[e]; v[4 + e] = x1[e] * (1.0f + s1[e]) + h1[e]; }
        *(u32x4*)(HA + (size_t)row * 2048 + k8) = pack8(v);
    }
}

struct FStoreBf16 { bf16_t* O; int ldc;
    __device__ __forceinline__ void operator()(int row, int col, const f32x4 v0, const f32x4 v1) const {
        u32x4 w; w.x = pg8::cvt_pk_bf16(v0[0], v0[1]); w.y = pg8::cvt_pk_bf16(v0[2], v0[3]); w.z = pg8::cvt_pk_bf16(v1[0], v1[1]); w.w = pg8::cvt_pk_bf16(v1[2], v1[3]);
        *(u32x4*)(O + (size_t)row * ldc + col) = w; } };
struct FStoreQKV { bf16_t* PQ; float* AB;
    __device__ __forceinline__ void operator()(int row, int col, const f32x4 v0, const f32x4 v1) const {
        if (col < 6144) { u32x4 w; w.x = pg8::cvt_pk_bf16(v0[0], v0[1]); w.y = pg8::cvt_pk_bf16(v0[2], v0[3]); w.z = pg8::cvt_pk_bf16(v1[0], v1[1]); w.w = pg8::cvt_pk_bf16(v1[2], v1[3]);
            *(u32x4*)(PQ + (size_t)row * PQ_LD + col) = w; }
        else if (col < 6208) { float* p = AB + (size_t)row * 64 + (col - 6144); *(f32x4*)p = v0; *(f32x4*)(p + 4) = v1; } } };
struct FStoreF32 { float* O; int ldc;
    __device__ __forceinline__ void operator()(int row, int col, const f32x4 v0, const f32x4 v1) const { float* p = O + (size_t)row * ldc + col; *(f32x4*)p = v0; *(f32x4*)(p + 4) = v1; } };
struct FGatePA { const bf16_t* ZG; bf16_t* MG;
    __device__ __forceinline__ void operator()(int row, int col, const f32x4 v0, const f32x4 v1) const {
        float g[8]; unpack8(*(const u32x4*)(ZG + (size_t)row * NZG + 2048 + col), g);
        float o[8];
#pragma unroll
        for (int e = 0; e < 4; ++e) { o[e] = sigmoidf_(g[e]) * v0[e]; o[4 + e] = sigmoidf_(g[4 + e]) * v1[e]; }
        *(u32x4*)(MG + (size_t)row * 2048 + col) = pack8(o); } };
struct FGatePH { const bf16_t* ZG; bf16_t* MG;
    __device__ __forceinline__ void operator()(int row, int col, const f32x4 v0, const f32x4 v1) const {
        float g[8], t[8]; unpack8(*(const u32x4*)(ZG + (size_t)row * NZG + 4096 + col), g); unpack8(*(const u32x4*)(MG + (size_t)row * 2048 + col), t);
        float o[8];
#pragma unroll
        for (int e = 0; e < 4; ++e) { o[e] = t[e] + sigmoidf_(g[e]) * v0[e]; o[4 + e] = t[4 + e] + sigmoidf_(g[4 + e]) * v1[e]; }
        *(u32x4*)(MG + (size_t)row * 2048 + col) = pack8(o); } };
struct FOut { const float* x; const float* mod; float* T3;
    __device__ __forceinline__ void operator()(int row, int col, const f32x4 v0, const f32x4 v1) const {
        const float* xp = x + (size_t)row * 2048 + col; const float* gp = mod + (row >> 12) * 12288 + 4096 + col;
        const f32x4 x0 = *(const f32x4*)xp, x1 = *(const f32x4*)(xp + 4), g0 = *(const f32x4*)gp, g1 = *(const f32x4*)(gp + 4);
        float* p = T3 + (size_t)row * 2048 + col;
#if DBG_MODE == 1
        *(f32x4*)p = ALPHA * x0; *(f32x4*)(p + 4) = ALPHA * x1;
#else
        *(f32x4*)p = ALPHA * x0 + g0 * v0; *(f32x4*)(p + 4) = ALPHA * x1 + g1 * v1;
#endif
    } };

template <class F> __device__ __forceinline__ void run_gemm(unsigned char* lds, const bf16_t* A, const bf16_t* Bt, int M, int N, const F& f) {
    pg8::Gemm g{A, Bt, M, N, 2048}; pg8::StaticOrder S; S.init(M, N, (int)gridDim.x, (int)blockIdx.x);
    pg8::EpiGen<F> E{f};
    pg8::gemm_phase<pg8::EpiGen<F>, pg8::StaticOrder>((PG8_LAS unsigned char*)lds, g, S, E);
}

typedef float f32x2 __attribute__((ext_vector_type(2)));
constexpr int HY_Z = 0, HY_F = 69632, HY_TW4 = 139264, HY_TW8 = 141312, HY_TW32 = 143360, HY_W3 = 143488;
__device__ __forceinline__ f32x2 cmul(const f32x2 a, const f32x2 b) { return (f32x2){a.x * b.x - a.y * b.y, a.x * b.y + a.y * b.x}; }
__device__ __forceinline__ f32x2 cmulc(const f32x2 a, const f32x2 b) { return (f32x2){a.x * b.x + a.y * b.y, a.y * b.x - a.x * b.y}; }
template <bool INV> __device__ __forceinline__ f32x2 ctw(const f32x2 v, const float wr, const float wi) {
    return INV ? (f32x2){v.x * wr + v.y * wi, v.y * wr - v.x * wi} : (f32x2){v.x * wr - v.y * wi, v.y * wr + v.x * wi};
}
template <bool INV> __device__ __forceinline__ void dft16(f32x2 (&x)[16]) {
    constexpr float C = 0.9238795325112867f, S = 0.3826834323650898f, R = 0.7071067811865476f;
    f32x2 A[4][4];
#pragma unroll
    for (int q0 = 0; q0 < 4; ++q0) {
        const f32x2 a = x[q0], b = x[4 + q0], c = x[8 + q0], d = x[12 + q0];
        const f32x2 t0 = a + c, t1 = a - c, t2 = b + d, t3 = b - d;
        const f32x2 m = (f32x2){t3.y, -t3.x};
        A[q0][0] = t0 + t2; A[q0][2] = t0 - t2;
        A[q0][1] = INV ? (t1 - m) : (t1 + m); A[q0][3] = INV ? (t1 + m) : (t1 - m);
    }
    A[1][1] = ctw<INV>(A[1][1], C, -S); A[1][2] = ctw<INV>(A[1][2], R, -R); A[1][3] = ctw<INV>(A[1][3], S, -C);
    A[2][1] = ctw<INV>(A[2][1], R, -R); A[2][2] = ctw<INV>(A[2][2], 0.f, -1.f); A[2][3] = ctw<INV>(A[2][3], -R, -R);
    A[3][1] = ctw<INV>(A[3][1], S, -C); A[3][2] = ctw<INV>(A[3][2], -R, -R); A[3][3] = ctw<INV>(A[3][3], -C, S);
#pragma unroll
    for (int s = 0; s < 4; ++s) {
        const f32x2 t0 = A[0][s] + A[2][s], t1 = A[0][s] - A[2][s], t2 = A[1][s] + A[3][s], t3 = A[1][s] - A[3][s];
        const f32x2 m = (f32x2){t3.y, -t3.x};
        x[s] = t0 + t2; x[s + 8] = t0 - t2;
        x[s + 4] = INV ? (t1 - m) : (t1 + m); x[s + 12] = INV ? (t1 + m) : (t1 - m);
    }
}
template <bool INV> __device__ __forceinline__ void apply_tw(f32x2 (&x)[16], const f32x2 w) {
    f32x2 wr = w;
#pragma unroll
    for (int r = 1; r < 16; ++r) { x[r] = INV ? cmulc(x[r], wr) : cmul(x[r], wr); if (r < 15) wr = cmul(wr, w); }
}
__device__ __forceinline__ void fft_pass2_fwd(f32x2* B, int t, const f32x2* TW4) {
    const int base = 272 * (t >> 4) + (t & 15); f32x2 x[16];
#pragma unroll
    for (int q = 0; q < 16; ++q) x[q] = B[base + 17 * q];
    dft16<false>(x); apply_tw<false>(x, TW4[16 * (t & 15)]);
#pragma unroll
    for (int q = 0; q < 16; ++q) B[base + 17 * q] = x[q];
}
__device__ __forceinline__ void fft_pass2_inv(f32x2* B, int t, const f32x2* TW4) {
    const int base = 272 * (t >> 4) + (t & 15); f32x2 x[16];
#pragma unroll
    for (int q = 0; q < 16; ++q) x[q] = B[base + 17 * q];
    apply_tw<true>(x, TW4[16 * (t & 15)]); dft16<true>(x);
#pragma unroll
    for (int q = 0; q < 16; ++q) B[base + 17 * q] = x[q];
}
__device__ __forceinline__ float conv3_lane(float c, int lane, float w0, float w1, float w2) {
    float up = __shfl_up(c, 1, 64), dn = __shfl_down(c, 1, 64);
    up = (lane == 0) ? 0.f : up; dn = (lane == 63) ? 0.f : dn;
    return w0 * up + w1 * c + w2 * dn;
}
__device__ void hyena_setup(unsigned char* lds) {
    const int tid = tid_opaque();
    f32x2* TW4 = (f32x2*)(lds + HY_TW4); f32x2* TW8 = (f32x2*)(lds + HY_TW8); f32x2* TW32 = (f32x2*)(lds + HY_TW32);
    if (tid < 256) { const float a4 = -6.283185307179586f * (float)tid * (1.0f / 4096.0f), a8 = -6.283185307179586f * (float)tid * (1.0f / 8192.0f);
        TW4[tid] = (f32x2){cosf(a4), sinf(a4)}; TW8[tid] = (f32x2){cosf(a8), sinf(a8)}; }
    if (tid < 16) { const float a = -6.283185307179586f * (float)tid * (1.0f / 32.0f); TW32[tid] = (f32x2){cosf(a), sinf(a)}; }
    __syncthreads();
}
struct HyCtx { f32x2* Z; f32x2* Fb0; const f32x2* TW4; const f32x2* TW32; const bf16_t* rv; const bf16_t* rx1; const bf16_t* rx2; bf16_t* YTc; float* Y1S;
    f32x2 w8t, w4t; float cv0, cv1, cv2, cx0, cx1, cx2, cy0, cy1, cy2, sk0, sk1; int tid, br, t, lane, p1; };
template <int ORDER> __device__ __forceinline__ void hyena_conv(const HyCtx& K, int pr) {
    f32x2* Z = K.Z; const f32x2* TW4 = K.TW4; const f32x2* TW32 = K.TW32;
    const bf16_t* rv = K.rv; const bf16_t* rx1 = K.rx1; const bf16_t* rx2 = K.rx2; float* Y1S = K.Y1S;
    int tid = K.tid; asm volatile("" : "+v"(tid));
    const f32x2 w8t = K.w8t, w4t = K.w4t; const int br = tid >> 8, t = tid & 255, lane = tid & 63, p1 = t + (t >> 4);
    f32x2* Zb = K.Z + br * 4352; f32x2* Fb = K.Fb0 + br * 4352;
    const float cv0 = K.cv0, cv1 = K.cv1, cv2 = K.cv2, cx0 = K.cx0, cx1 = K.cx1, cx2 = K.cx2, cy0 = K.cy0, cy1 = K.cy1, cy2 = K.cy2, sk0 = K.sk0, sk1 = K.sk1;
        const int ba = 2 * pr * 4096, bb = ba + 4096;
        {
            f32x2 x[16];
#pragma unroll
            for (int q = 0; q < 16; ++q) {
                const int n = t + 256 * q; float ua, ub;
                if (ORDER == 0) { ua = conv3_lane(bf2f(rv[ba + n]), lane, cv0, cv1, cv2); ub = conv3_lane(bf2f(rv[bb + n]), lane, cv0, cv1, cv2); }
                else { ua = Y1S[n]; ub = Y1S[4096 + n]; }
                const f32x2 z = (f32x2){ua, ub};
                x[q] = br ? cmul(z, cmul(w8t, TW32[q])) : z;
            }
            dft16<false>(x); apply_tw<false>(x, w4t);
#pragma unroll
            for (int q = 0; q < 16; ++q) Zb[p1 + 272 * q] = x[q];
        }
        __syncthreads();
        fft_pass2_fwd(Zb, t, TW4);
        __syncthreads();
        {
            f32x2 x[16];
#pragma unroll
            for (int q = 0; q < 16; ++q) x[q] = Zb[17 * t + q];
            dft16<false>(x);
#pragma unroll
            for (int r = 0; r < 16; ++r) {
                const int p = 16 * t + r; int pp;
                if (br) pp = 4095 - p;
                else { const int m = (r << 8) | ((t & 15) << 4) | (t >> 4); const int mp = (4096 - m) & 4095; pp = ((mp & 15) << 8) | (mp & 0xF0) | (mp >> 8); }
                const f32x2 fk = Fb[p + (p >> 4)], fc = Fb[pp + (pp >> 4)];
                f32x2 H;
                if (ORDER == 0) H = (f32x2){0.5f * (fk.x + fc.x), 0.5f * (fk.y - fc.y)};
                else H = (f32x2){0.5f * (fk.y + fc.y), -0.5f * (fk.x - fc.x)};
                x[r] = cmul(x[r], H);
            }
            dft16<true>(x);
#pragma unroll
            for (int q = 0; q < 16; ++q) Zb[17 * t + q] = x[q];
        }
        __syncthreads();
        fft_pass2_inv(Zb, t, TW4);
        __syncthreads();
        {
            f32x2 x[16];
#pragma unroll
            for (int q = 0; q < 16; ++q) x[q] = Zb[p1 + 272 * q];
            apply_tw<true>(x, w4t); dft16<true>(x);
            if (br) {
#pragma unroll
                for (int q = 0; q < 16; ++q) x[q] = cmulc(x[q], cmul(w8t, TW32[q]));
            }
#pragma unroll
            for (int q = 0; q < 16; ++q) Zb[p1 + 272 * q] = x[q];
        }
        __syncthreads();
#pragma unroll
        for (int i = 0; i < 8; ++i) {
            const int n = tid + i * NT, pn = n + (n >> 4);
            const f32x2 e0 = Z[pn], e1 = Z[4352 + pn];
            const float ca = (e0.x + e1.x) * (1.0f / 8192.0f), cb = (e0.y + e1.y) * (1.0f / 8192.0f);
            if (ORDER == 0) {
                const float va = conv3_lane(bf2f(rv[ba + n]), lane, cv0, cv1, cv2), vb = conv3_lane(bf2f(rv[bb + n]), lane, cv0, cv1, cv2);
                const float xa = conv3_lane(bf2f(rx1[ba + n]), lane, cx0, cx1, cx2), xb = conv3_lane(bf2f(rx1[bb + n]), lane, cx0, cx1, cx2);
                Y1S[n] = xa * (ca + sk0 * va); Y1S[4096 + n] = xb * (cb + sk0 * vb);
            } else {
                const float ya = Y1S[n], yb = Y1S[4096 + n];
                const float xa = conv3_lane(bf2f(rx2[ba + n]), lane, cy0, cy1, cy2), xb = conv3_lane(bf2f(rx2[bb + n]), lane, cy0, cy1, cy2);
                K.YTc[ba + n] = (bf16_t)f2bf(xa * (ca + sk1 * ya)); K.YTc[bb + n] = (bf16_t)f2bf(xb * (cb + sk1 * yb));
            }
        }
        __syncthreads();
}
__device__ void hyena_item(KA a, int c, unsigned char* lds) {
    f32x2* Z = (f32x2*)(lds + HY_Z); f32x2* F = (f32x2*)(lds + HY_F);
    const f32x2* TW4 = (const f32x2*)(lds + HY_TW4); const f32x2* TW8 = (const f32x2*)(lds + HY_TW8); const f32x2* TW32 = (const f32x2*)(lds + HY_TW32);
    float* W3 = (float*)(lds + HY_W3);
    int tid = tid_opaque(); asm volatile("" : "+v"(tid));
    const int br = tid >> 8, t = tid & 255, lane = tid & 63;
    f32x2* Zb = Z + br * 4352; f32x2* Fb = F + br * 4352;
    const float* hid2 = (const float*)(a->ws + WS_HID2);
    const float* w3 = a->in[16]; const float* b3 = a->in[17]; const float* cw = a->in[11]; const float* skip = a->in[19];
    const bf16_t* PHT = (const bf16_t*)(a->ws + WS_RA);
    bf16_t* YT = (bf16_t*)a->out;
    float* Y1S = a->out + (size_t)16 * 1024 * 1024 + (size_t)blockIdx.x * 16384;
    if (tid < 256) { const int q = tid >> 6, j = tid & 63; W3[q * 64 + j] = w3[(size_t)j * 8192 + (q >> 1) * 4096 + (q & 1) * 2048 + c]; }
    __syncthreads();
    {
        const float delta = 3.0701134573253944f + 12.280453829301578f * ((float)c * (1.0f / 2047.0f));
        float bq[4];
#pragma unroll
        for (int q = 0; q < 4; ++q) bq[q] = b3[(q >> 1) * 4096 + (q & 1) * 2048 + c];
#pragma unroll 1
        for (int i = 0; i < 8; ++i) {
            const int d = tid + i * NT;
            const f32x4* hp = (const f32x4*)(hid2 + d * 64);
            float f0 = 0.f, f1 = 0.f, f2 = 0.f, f3 = 0.f;
#pragma unroll 4
            for (int j4 = 0; j4 < 16; ++j4) {
                const f32x4 hv = hp[j4];
#pragma unroll
                for (int e = 0; e < 4; ++e) { const int j = j4 * 4 + e; f0 += hv[e] * W3[j]; f1 += hv[e] * W3[64 + j]; f2 += hv[e] * W3[128 + j]; f3 += hv[e] * W3[192 + j]; }
            }
            const float win = expf(-((float)d * (1.0f / 4095.0f)) * delta);
            Z[d] = (f32x2){(f0 + bq[0]) * win, (f1 + bq[1]) * win};
            Z[4096 + d] = (f32x2){(f2 + bq[2]) * win, (f3 + bq[3]) * win};
        }
    }
    __syncthreads();
    const f32x2 w8t = TW8[t], w4t = TW4[t];
    const int p1 = t + (t >> 4);
    {
        f32x2 x[16];
#pragma unroll
        for (int q = 0; q < 16; ++q) {
            const int n = t + 256 * q;
            const f32x2 av = Z[n]; f32x2 bv = Z[8192 - (n ? n : 1)]; if (n == 0) bv = (f32x2){0.f, 0.f};
            x[q] = br ? cmul(av - bv, cmul(w8t, TW32[q])) : (av + bv);
        }
        dft16<false>(x); apply_tw<false>(x, w4t);
#pragma unroll
        for (int q = 0; q < 16; ++q) Fb[p1 + 272 * q] = x[q];
    }
    __syncthreads();
    fft_pass2_fwd(Fb, t, TW4);
    __syncthreads();
    {   f32x2 x[16];
#pragma unroll
        for (int q = 0; q < 16; ++q) x[q] = Fb[17 * t + q];
        dft16<false>(x);
#pragma unroll
        for (int q = 0; q < 16; ++q) Fb[17 * t + q] = x[q];
    }
    __syncthreads();
    const float cv0 = cw[c], cv1 = cw[6144 + c], cv2 = cw[12288 + c];
    const float cx0 = cw[2048 + c], cx1 = cw[6144 + 2048 + c], cx2 = cw[12288 + 2048 + c];
    const float cy0 = cw[4096 + c], cy1 = cw[6144 + 4096 + c], cy2 = cw[12288 + 4096 + c];
    const float sk0 = skip[c], sk1 = skip[2048 + c];
    const bf16_t* rv = PHT + (size_t)c * MT; const bf16_t* rx1 = PHT + (size_t)(2048 + c) * MT; const bf16_t* rx2 = PHT + (size_t)(4096 + c) * MT;
    HyCtx K; K.Z = Z; K.Fb0 = F; K.TW4 = TW4; K.TW32 = TW32; K.rv = rv; K.rx1 = rx1; K.rx2 = rx2; K.YTc = YT + (size_t)c * MT; K.Y1S = Y1S;
    K.w8t = w8t; K.w4t = w4t; K.cv0 = cv0; K.cv1 = cv1; K.cv2 = cv2; K.cx0 = cx0; K.cx1 = cx1; K.cx2 = cx2; K.cy0 = cy0; K.cy1 = cy1; K.cy2 = cy2; K.sk0 = sk0; K.sk1 = sk1;
    K.tid = tid; K.br = br; K.t = t; K.lane = lane; K.p1 = p1;
#pragma unroll 1
    for (int pr = 0; pr < 2; ++pr) { hyena_conv<0>(K, pr); hyena_conv<1>(K, pr); }
}

__device__ void qkvpost_unit(KA a, int unit, unsigned char* lds) {
    const int tid = tid_opaque();
    int ntok, row0, wh;
    if (unit < 12288) { const int gr = unit / 48; wh = unit % 48; ntok = 64; row0 = gr * 64; }
    else { const int uu = unit - 12288; const int b = uu / 48; wh = uu % 48; ntok = 256; row0 = MT + b * 256; }
    const int which = wh >> 4, h = wh & 15, colbase = which * 2048 + h * 128;
    bf16_t* PQ = (bf16_t*)(a->ws + WS_RB);
    bf16_t* raw = (bf16_t*)lds; float* wl = (float*)(lds + 65536);
    const float* cwt = a->in[7];
    for (int i = tid; i < ntok * 16; i += NT) { const int r = i >> 4, c8 = i & 15; *(u32x4*)(raw + r * 128 + c8 * 8) = *(const u32x4*)(PQ + (size_t)(row0 + r) * PQ_LD + colbase + c8 * 8); }
    for (int i = tid; i < 640; i += NT) wl[i] = cwt[(i >> 7) * 6144 + colbase + (i & 127)];
    __syncthreads();
    const int r = tid >> 3, cg = tid & 7;
    for (int rb = 0; rb < ntok / 64; ++rb) {
        const int tok = rb * 64 + r;
        float v[16]; float ss = 0.f;
#pragma unroll
        for (int e = 0; e < 16; ++e) {
            const int ch = cg * 16 + e; float acc = 0.f;
#pragma unroll
            for (int j = 0; j < 5; ++j) { const int tt = tok + j - 2; if (tt >= 0 && tt < ntok) acc += wl[j * 128 + ch] * bf2f(raw[tt * 128 + ch]); }
            const float s = siluf_(acc); v[e] = s; ss += s * s;
        }
        if (which < 2) {
            ss += __shfl_xor(ss, 1, 64); ss += __shfl_xor(ss, 2, 64); ss += __shfl_xor(ss, 4, 64);
            const float sc = rsqrtf(ss + 1e-6f) * (which == 0 ? 0.08838834764831845f : 1.0f);
#pragma unroll
            for (int e = 0; e < 16; ++e) v[e] *= sc;
        }
        bf16_t* op = PQ + (size_t)(row0 + tok) * PQ_LD + colbase + cg * 16;
        u32x4 w0, w1;
        w0.x = pk2(v[0], v[1]); w0.y = pk2(v[2], v[3]); w0.z = pk2(v[4], v[5]); w0.w = pk2(v[6], v[7]);
        w1.x = pk2(v[8], v[9]); w1.y = pk2(v[10], v[11]); w1.z = pk2(v[12], v[13]); w1.w = pk2(v[14], v[15]);
        *(u32x4*)op = w0; *(u32x4*)(op + 8) = w1;
    }
    __syncthreads();
}

typedef short bf16x8 __attribute__((ext_vector_type(8)));
typedef unsigned u32x2 __attribute__((ext_vector_type(2)));
constexpr size_t WS_TS = 585 * MiB, WS_GCB = 653 * MiB;
#define MFMA16(a, b, c) __builtin_amdgcn_mfma_f32_16x16x32_bf16((a), (b), (c), 0, 0, 0)
__device__ __forceinline__ u32x2 pk4(float a, float b, float c, float d) { u32x2 w; w.x = pk2(a, b); w.y = pk2(c, d); return w; }

__device__ void tprep_wave(KA a, int pid, unsigned char* wl) {
    const int lane = tid_opaque() & 63, fr = lane & 15, fq = lane >> 4;
    const int sid = pid / 68, cidx = pid - sid * 68, dir = sid & 1, h = (sid >> 1) & 15, b = sid >> 5;
    bf16_t* kt = (bf16_t*)wl; float* Mf = (float*)wl; float* gcs = (float*)(wl + 17408); float* bes = gcs + 64;
    const bf16_t* PQ = (const bf16_t*)(a->ws + WS_RB); const float* AB = (const float*)(a->ws + WS_AB);
    bf16_t* TS = (bf16_t*)(a->ws + WS_TS) + (size_t)pid * 4096; float* GCB = (float*)(a->ws + WS_GCB) + (size_t)pid * 128;
    int rbase, Tn, p0;
    if (cidx < 4) { rbase = MT + b * CTXL; Tn = CTXL; p0 = cidx * 64; } else { rbase = b * SEQ; Tn = SEQ; p0 = (cidx - 4) * 64; }
#pragma unroll 4
    for (int it = 0; it < 16; ++it) {
        const int i = it * 4 + fq, p = p0 + i, tok = dir ? (Tn - 1 - p) : p;
        *(u32x4*)(kt + i * 136 + fr * 8) = *(const u32x4*)(PQ + (size_t)(rbase + tok) * PQ_LD + 2048 + h * 128 + fr * 8);
    }
    {
        const int p = p0 + lane, tok = dir ? (Tn - 1 - p) : p; const size_t row = (size_t)(rbase + tok);
        const float ab0 = AB[row * 64 + dir * 32 + h], ab1 = AB[row * 64 + dir * 32 + 16 + h];
        const float xx = ab0 + a->in[9][dir * 16 + h]; const float sp = (xx > 20.0f) ? xx : log1pf(expf(xx));
        float gc = -expf(a->in[8][dir * 16 + h]) * sp;
#pragma unroll
        for (int o = 1; o < 64; o <<= 1) { const float tt = __shfl_up(gc, o, 64); if (lane >= o) gc += tt; }
        const float be = sigmoidf_(ab1);
        gcs[lane] = gc; bes[lane] = be; GCB[lane] = gc; GCB[64 + lane] = be;
    }
    f32x4 acc[10];
#pragma unroll
    for (int i = 0; i < 10; ++i) acc[i] = (f32x4){0.f, 0.f, 0.f, 0.f};
#pragma unroll
    for (int kk = 0; kk < 4; ++kk) {
        bf16x8 fg[4];
#pragma unroll
        for (int ct = 0; ct < 4; ++ct) fg[ct] = *(const bf16x8*)(kt + (ct * 16 + fr) * 136 + kk * 32 + fq * 8);
#pragma unroll
        for (int ct = 0; ct < 4; ++ct)
#pragma unroll
            for (int mt = 0; mt <= ct; ++mt) acc[ct * (ct + 1) / 2 + mt] = MFMA16(fg[ct], fg[mt], acc[ct * (ct + 1) / 2 + mt]);
    }
    float gcr[4][4], ber[4][4];
#pragma unroll
    for (int ct = 0; ct < 4; ++ct)
#pragma unroll
        for (int r = 0; r < 4; ++r) { gcr[ct][r] = gcs[ct * 16 + 4 * fq + r]; ber[ct][r] = bes[ct * 16 + 4 * fq + r]; }
    float gcm[4];
#pragma unroll
    for (int mt = 0; mt < 4; ++mt) gcm[mt] = gcs[mt * 16 + fr];
    asm volatile("s_waitcnt lgkmcnt(0)" ::: "memory");
#pragma unroll
    for (int ct = 0; ct < 4; ++ct)
#pragma unroll
        for (int mt = 0; mt <= ct; ++mt)
#pragma unroll
            for (int r = 0; r < 4; ++r) {
                const int c = ct * 16 + 4 * fq + r, m = mt * 16 + fr;
                Mf[c * 68 + m] = (m < c) ? ber[ct][r] * acc[ct * (ct + 1) / 2 + mt][r] * expf(gcr[ct][r] - gcm[mt]) : 0.0f;
            }
    asm volatile("s_waitcnt lgkmcnt(0)" ::: "memory");
    Mf[lane] = (lane == 0) ? 1.0f : 0.0f;
    asm volatile("s_waitcnt lgkmcnt(0)" ::: "memory");
#pragma unroll 1
    for (int i = 1; i < 64; ++i) {
        const float* mr = Mf + i * 68;
        float s0 = 0.f, s1 = 0.f, s2 = 0.f, s3 = 0.f;
        int m = 0;
#pragma unroll 1
        for (; m + 4 <= i; m += 4) {
            const f32x4 mv = *(const f32x4*)(mr + m);
            s0 -= mv.x * Mf[m * 68 + lane]; s1 -= mv.y * Mf[(m + 1) * 68 + lane]; s2 -= mv.z * Mf[(m + 2) * 68 + lane]; s3 -= mv.w * Mf[(m + 3) * 68 + lane];
        }
#pragma unroll 1
        for (; m < i; ++m) s0 -= mr[m] * Mf[m * 68 + lane];
        const float tv = ((s0 + s1) + (s2 + s3)) + ((lane == i) ? 1.0f : 0.0f);
        asm volatile("s_waitcnt lgkmcnt(0)" ::: "memory");
        Mf[i * 68 + lane] = tv;
        asm volatile("s_waitcnt lgkmcnt(0)" ::: "memory");
    }
#pragma unroll
    for (int it = 0; it < 8; ++it) {
        const int row = it * 8 + (lane >> 3), c8 = (lane & 7) * 8;
        const f32x4 x0 = *(const f32x4*)(Mf + row * 68 + c8), x1 = *(const f32x4*)(Mf + row * 68 + c8 + 4);
        u32x4 wv; wv.x = pk2(x0[0], x0[1]); wv.y = pk2(x0[2], x0[3]); wv.z = pk2(x1[0], x1[1]); wv.w = pk2(x1[2], x1[3]);
        *(u32x4*)(TS + row * 64 + c8) = wv;
    }
    asm volatile("s_waitcnt lgkmcnt(0)" ::: "memory");
}

constexpr int DL_QN = 0, DL_KN = 17408, DL_WN = 34816, DL_ST = 52224, DL_KT = 69632, DL_VT = 88064, DL_T1 = 97280, DL_T2 = 106496, DL_AT = 115712, DL_VN = 124928, DL_VD = 134144, DL_GS = 143360;
struct DStage { u32x4 q0, q1, k0, k1, v, t; f32x4 g0, g1, b0, b1; float bi, gl, g63; };
__device__ __forceinline__ void dstage_load(DStage& R, const bf16_t* PQ, const bf16_t* TS, const float* GCB, int sid, int cidx, int dir, int h, int b, int dvh, int tid) {
    const int i = tid >> 3, part = tid & 7;
    int rbase, Tn, p0;
    if (cidx < 4) { rbase = MT + b * CTXL; Tn = CTXL; p0 = cidx * 64; } else { rbase = b * SEQ; Tn = SEQ; p0 = (cidx - 4) * 64; }
    const int p = p0 + i, tok = dir ? (Tn - 1 - p) : p;
    const bf16_t* rp = PQ + (size_t)(rbase + tok) * PQ_LD + h * 128;
    R.q0 = *(const u32x4*)(rp + part * 16); R.q1 = *(const u32x4*)(rp + part * 16 + 8);
    R.k0 = *(const u32x4*)(rp + 2048 + part * 16); R.k1 = *(const u32x4*)(rp + 2048 + part * 16 + 8);
    R.v = *(const u32x4*)(rp + 4096 + dvh * 64 + part * 8);
    const size_t pid = (size_t)sid * 68 + cidx;
    R.t = *(const u32x4*)(TS + pid * 4096 + i * 64 + part * 8);
    const float* gp = GCB + pid * 128;
    R.g0 = *(const f32x4*)(gp + part * 8); R.g1 = *(const f32x4*)(gp + part * 8 + 4);
    R.b0 = *(const f32x4*)(gp + 64 + part * 8); R.b1 = *(const f32x4*)(gp + 64 + part * 8 + 4);
    R.bi = gp[64 + i]; R.gl = gp[tid & 63]; R.g63 = gp[63];
}
__device__ __forceinline__ void dstage_store(const DStage& R, unsigned char* lds, int tid) {
    const int i = tid >> 3, part = tid & 7;
    bf16_t* QN = (bf16_t*)(lds + DL_QN); bf16_t* KN = (bf16_t*)(lds + DL_KN); bf16_t* KT = (bf16_t*)(lds + DL_KT); bf16_t* VT = (bf16_t*)(lds + DL_VT);
    bf16_t* T1 = (bf16_t*)(lds + DL_T1); bf16_t* T2 = (bf16_t*)(lds + DL_T2); float* GS = (float*)(lds + DL_GS);
    *(u32x4*)(QN + i * 136 + part * 16) = R.q0; *(u32x4*)(QN + i * 136 + part * 16 + 8) = R.q1;
    *(u32x4*)(KN + i * 136 + part * 16) = R.k0; *(u32x4*)(KN + i * 136 + part * 16 + 8) = R.k1;
    const unsigned kw[8] = {R.k0.x, R.k0.y, R.k0.z, R.k0.w, R.k1.x, R.k1.y, R.k1.z, R.k1.w};
#pragma unroll
    for (int e = 0; e < 8; ++e) { KT[(part * 16 + 2 * e) * 72 + i] = (bf16_t)(kw[e] & 0xffffu); KT[(part * 16 + 2 * e + 1) * 72 + i] = (bf16_t)(kw[e] >> 16); }
    float v8[8]; unpack8(R.v, v8);
#pragma unroll
    for (int e = 0; e < 8; ++e) VT[(part * 8 + e) * 72 + i] = (bf16_t)f2bf(v8[e]);
    float t8[8]; unpack8(R.t, t8);
    const float gm[8] = {R.g0.x, R.g0.y, R.g0.z, R.g0.w, R.g1.x, R.g1.y, R.g1.z, R.g1.w};
    const float bm[8] = {R.b0.x, R.b0.y, R.b0.z, R.b0.w, R.b1.x, R.b1.y, R.b1.z, R.b1.w};
    float a1[8], a2[8];
#pragma unroll
    for (int e = 0; e < 8; ++e) { a2[e] = t8[e] * bm[e]; a1[e] = a2[e] * expf(gm[e]); }
    *(u32x4*)(T1 + i * 72 + part * 8) = pack8(a1); *(u32x4*)(T2 + i * 72 + part * 8) = pack8(a2);
    if (tid < 64) { GS[tid] = R.gl; GS[64 + tid] = expf(R.gl); GS[128 + tid] = expf(R.g63 - R.gl); }
}
__device__ void delta_item(KA a, int item, unsigned char* lds) {
    const int tid = tid_opaque(), lane = tid & 63, w = tid >> 6, fr = lane & 15, fq = lane >> 4;
    const int dvh = item & 1, dir = (item >> 1) & 1, h = (item >> 2) & 15, b = item >> 6, sid = (b * 16 + h) * 2 + dir;
    const bf16_t* PQ = (const bf16_t*)(a->ws + WS_RB); const bf16_t* TS = (const bf16_t*)(a->ws + WS_TS); const float* GCB = (const float*)(a->ws + WS_GCB);
    bf16_t* O = (bf16_t*)(a->ws + WS_RA) + (size_t)dir * MT * 2048;
    const bf16_t* QN = (const bf16_t*)(lds + DL_QN); const bf16_t* KN = (const bf16_t*)(lds + DL_KN); bf16_t* WN = (bf16_t*)(lds + DL_WN); bf16_t* ST = (bf16_t*)(lds + DL_ST);
    const bf16_t* KT = (const bf16_t*)(lds + DL_KT); const bf16_t* VT = (const bf16_t*)(lds + DL_VT); const bf16_t* T1 = (const bf16_t*)(lds + DL_T1); const bf16_t* T2 = (const bf16_t*)(lds + DL_T2);
    bf16_t* AT = (bf16_t*)(lds + DL_AT); bf16_t* VN = (bf16_t*)(lds + DL_VN); bf16_t* VD = (bf16_t*)(lds + DL_VD); const float* GS = (const float*)(lds + DL_GS);
    __syncthreads();
    for (int i = tid; i < 64 * 136 / 2; i += NT) ((unsigned*)ST)[i] = 0u;
    f32x4 sacc[4];
#pragma unroll
    for (int i = 0; i < 4; ++i) sacc[i] = (f32x4){0.f, 0.f, 0.f, 0.f};
    DStage R;
    dstage_load(R, PQ, TS, GCB, sid, 0, dir, h, b, dvh, tid);
#pragma unroll 1
    for (int cidx = 0; cidx < 68; ++cidx) {
        dstage_store(R, lds, tid);
        __syncthreads();
        if (cidx + 1 < 68) dstage_load(R, PQ, TS, GCB, sid, cidx + 1, dir, h, b, dvh, tid);
#pragma unroll
        for (int ti = 0; ti < 2; ++ti) {
            const int idx = w * 2 + ti, mt = idx >> 2, ct = idx & 3;
            f32x4 acc = (f32x4){0.f, 0.f, 0.f, 0.f};
            if (mt <= ct) {
#pragma unroll
                for (int kk = 0; kk < 4; ++kk) {
                    const bf16x8 af = *(const bf16x8*)(KN + (mt * 16 + fr) * 136 + kk * 32 + fq * 8), bfg = *(const bf16x8*)(QN + (ct * 16 + fr) * 136 + kk * 32 + fq * 8);
                    acc = MFMA16(af, bfg, acc);
                }
            }
            const int c = ct * 16 + fr; const float gcc = GS[c];
            float o4[4];
#pragma unroll
            for (int r = 0; r < 4; ++r) { const int m = mt * 16 + 4 * fq + r; o4[r] = (m <= c) ? acc[r] * expf(gcc - GS[m]) : 0.0f; }
            *(u32x2*)(AT + c * 72 + mt * 16 + 4 * fq) = pk4(o4[0], o4[1], o4[2], o4[3]);
        }
        {
            bf16x8 af[2];
#pragma unroll
            for (int kk = 0; kk < 2; ++kk) af[kk] = *(const bf16x8*)(KT + (w * 16 + fr) * 72 + kk * 32 + fq * 8);
#pragma unroll
            for (int ct = 0; ct < 4; ++ct) {
                f32x4 acc = (f32x4){0.f, 0.f, 0.f, 0.f};
#pragma unroll
                for (int kk = 0; kk < 2; ++kk) acc = MFMA16(af[kk], *(const bf16x8*)(T1 + (ct * 16 + fr) * 72 + kk * 32 + fq * 8), acc);
                *(u32x2*)(WN + (ct * 16 + fr) * 136 + w * 16 + 4 * fq) = pk4(-acc[0], -acc[1], -acc[2], -acc[3]);
            }
        }
        const int ctu = w >> 1, dv0 = 2 * (w & 1);
        f32x4 uacc[2];
        {
            bf16x8 af[2];
#pragma unroll
            for (int kk = 0; kk < 2; ++kk) af[kk] = *(const bf16x8*)(T2 + (ctu * 16 + fr) * 72 + kk * 32 + fq * 8);
#pragma unroll
            for (int j = 0; j < 2; ++j) { uacc[j] = (f32x4){0.f, 0.f, 0.f, 0.f};
#pragma unroll
                for (int kk = 0; kk < 2; ++kk) uacc[j] = MFMA16(af[kk], *(const bf16x8*)(VT + ((dv0 + j) * 16 + fr) * 72 + kk * 32 + fq * 8), uacc[j]); }
        }
        __syncthreads();
        {
            bf16x8 af[4];
#pragma unroll
            for (int kk = 0; kk < 4; ++kk) af[kk] = *(const bf16x8*)(WN + (ctu * 16 + fr) * 136 + kk * 32 + fq * 8);
            float ed[4];
#pragma unroll
            for (int r = 0; r < 4; ++r) ed[r] = GS[128 + ctu * 16 + 4 * fq + r];
#pragma unroll
            for (int j = 0; j < 2; ++j) {
#pragma unroll
                for (int kk = 0; kk < 4; ++kk) uacc[j] = MFMA16(af[kk], *(const bf16x8*)(ST + ((dv0 + j) * 16 + fr) * 136 + kk * 32 + fq * 8), uacc[j]);
                const int dv = (dv0 + j) * 16 + fr;
                *(u32x2*)(VN + dv * 72 + ctu * 16 + 4 * fq) = pk4(uacc[j][0], uacc[j][1], uacc[j][2], uacc[j][3]);
                *(u32x2*)(VD + dv * 72 + ctu * 16 + 4 * fq) = pk4(uacc[j][0] * ed[0], uacc[j][1] * ed[1], uacc[j][2] * ed[2], uacc[j][3] * ed[3]);
            }
        }
        __syncthreads();
        {
            const int dvt = w >> 1, c0 = 2 * (w & 1);
            bf16x8 af[4], vf[2];
#pragma unroll
            for (int kk = 0; kk < 4; ++kk) af[kk] = *(const bf16x8*)(ST + (dvt * 16 + fr) * 136 + kk * 32 + fq * 8);
#pragma unroll
            for (int kk = 0; kk < 2; ++kk) vf[kk] = *(const bf16x8*)(VN + (dvt * 16 + fr) * 72 + kk * 32 + fq * 8);
#pragma unroll
            for (int j = 0; j < 2; ++j) {
                const int c = (c0 + j) * 16 + fr;
                f32x4 acc = (f32x4){0.f, 0.f, 0.f, 0.f};
#pragma unroll
                for (int kk = 0; kk < 4; ++kk) acc = MFMA16(af[kk], *(const bf16x8*)(QN + c * 136 + kk * 32 + fq * 8), acc);
                const float eg = GS[64 + c];
                acc = acc * eg;
#pragma unroll
                for (int kk = 0; kk < 2; ++kk) acc = MFMA16(vf[kk], *(const bf16x8*)(AT + c * 72 + kk * 32 + fq * 8), acc);
                if (cidx >= 4) {
                    const int p = (cidx - 4) * 64 + c, tok = dir ? (SEQ - 1 - p) : p;
                    *(u32x2*)(O + (size_t)(b * SEQ + tok) * 2048 + h * 128 + dvh * 64 + dvt * 16 + 4 * fq) = pk4(acc[0], acc[1], acc[2], acc[3]);
                }
            }
        }
        {
            const float eg63 = GS[64 + 63];
            bf16x8 af[2];
#pragma unroll
            for (int kk = 0; kk < 2; ++kk) af[kk] = *(const bf16x8*)(KT + (w * 16 + fr) * 72 + kk * 32 + fq * 8);
#pragma unroll
            for (int j = 0; j < 4; ++j) {
                sacc[j] = sacc[j] * eg63;
#pragma unroll
                for (int kk = 0; kk < 2; ++kk) sacc[j] = MFMA16(af[kk], *(const bf16x8*)(VD + (j * 16 + fr) * 72 + kk * 32 + fq * 8), sacc[j]);
            }
        }
        __syncthreads();
#pragma unroll
        for (int j = 0; j < 4; ++j) *(u32x2*)(ST + (j * 16 + fr) * 136 + w * 16 + 4 * fq) = pk4(sacc[j][0], sacc[j][1], sacc[j][2], sacc[j][3]);
    }
    __syncthreads();
}

__device__ void ytrans_unit(const bf16_t* YT, bf16_t* Y, int unit, bf16_t* tile) {
    const int tid = tid_opaque(), cb = unit & 31, tb = unit >> 5, r = tid >> 3, c8 = (tid & 7) * 8;
    *(u32x4*)(tile + r * 72 + c8) = *(const u32x4*)(YT + (size_t)(cb * 64 + r) * MT + tb * 64 + c8);
    __syncthreads();
    u32x4 w;
    w.x = (unsigned)tile[(c8 + 0) * 72 + r] | ((unsigned)tile[(c8 + 1) * 72 + r] << 16);
    w.y = (unsigned)tile[(c8 + 2) * 72 + r] | ((unsigned)tile[(c8 + 3) * 72 + r] << 16);
    w.z = (unsigned)tile[(c8 + 4) * 72 + r] | ((unsigned)tile[(c8 + 5) * 72 + r] << 16);
    w.w = (unsigned)tile[(c8 + 6) * 72 + r] | ((unsigned)tile[(c8 + 7) * 72 + r] << 16);
    *(u32x4*)(Y + (size_t)(tb * 64 + r) * 2048 + cb * 64 + c8) = w;
    __syncthreads();
}

__device__ void p6_on(KA a) {
    const bf16_t* OF = (const bf16_t*)(a->ws + WS_RA); const bf16_t* OB = OF + (size_t)MT * 2048;
    const bf16_t* ZG = (const bf16_t*)(a->ws + WS_RB); bf16_t* ON = (bf16_t*)(a->ws + WS_HA);
    const float* nw = a->in[10];
    const size_t nthr = (size_t)gridDim.x * NT;
    for (size_t i = (size_t)blockIdx.x * NT + tid_opaque(); i < (size_t)MT * 256; i += nthr) {
        const int row = (int)(i >> 8), c8 = (int)(i & 255) * 8;
        float f[8], g[8], z[8];
        unpack8(*(const u32x4*)(OF + (size_t)row * 2048 + c8), f); unpack8(*(const u32x4*)(OB + (size_t)row * 2048 + c8), g);
        unpack8(*(const u32x4*)(ZG + (size_t)row * NZG + c8), z);
        float ss = 0.f;
#pragma unroll
        for (int e = 0; e < 8; ++e) { f[e] += g[e]; ss += f[e] * f[e]; }
        ss += __shfl_xor(ss, 1, 64); ss += __shfl_xor(ss, 2, 64); ss += __shfl_xor(ss, 4, 64); ss += __shfl_xor(ss, 8, 64);
        const float rs = rsqrtf(ss * (1.0f / 128.0f) + 1e-6f);
        float o[8];
#pragma unroll
        for (int e = 0; e < 8; ++e) o[e] = f[e] * rs * nw[(c8 & 127) + e] * siluf_(z[e]);
        *(u32x4*)(ON + (size_t)row * 2048 + c8) = pack8(o);
    }
}

constexpr size_t PEER_U8 = 0, PEER_V8 = 32 * MiB, PEER_US = 64 * MiB, PEER_VS = 64 * MiB + 65536;
__device__ void p8_tables(KA a) {
    unsigned char* RAb = a->ws + WS_RA;
    const int lane = tid_opaque() & 63, wv = blockIdx.x * 8 + (tid_opaque() >> 6), nwv = gridDim.x * 8;
    for (int r = wv; r < 32768; r += nwv) {
        const int tab = r >> 14, row = r & 16383;
        const float* sp = (tab ? a->in[28] : a->in[27]) + (size_t)row * 2048;
        f32x4 x[8];
#pragma unroll
        for (int i = 0; i < 2; ++i)
#pragma unroll
            for (int j = 0; j < 4; ++j) x[i * 4 + j] = *(const f32x4*)(sp + i * 1024 + lane * 16 + j * 4);
        float mx = 0.f;
#pragma unroll
        for (int i = 0; i < 8; ++i) mx = fmaxf(mx, fmaxf(fmaxf(fabsf(x[i][0]), fabsf(x[i][1])), fmaxf(fabsf(x[i][2]), fabsf(x[i][3]))));
        mx = wave_max(mx);
        const float sc = (mx > 0.f) ? mx * (1.0f / 127.0f) : 1.0f, inv = 1.0f / sc;
        unsigned char* dp = RAb + (tab ? PEER_V8 : PEER_U8) + (size_t)row * 2048;
#pragma unroll
        for (int i = 0; i < 2; ++i) {
            u32x4 w;
#pragma unroll
            for (int j = 0; j < 4; ++j) {
                const f32x4 v = x[i * 4 + j];
                const unsigned b0 = (unsigned)(__float2int_rn(v[0] * inv) + 128), b1 = (unsigned)(__float2int_rn(v[1] * inv) + 128), b2 = (unsigned)(__float2int_rn(v[2] * inv) + 128), b3 = (unsigned)(__float2int_rn(v[3] * inv) + 128);
                w[j] = (b0 & 255u) | ((b1 & 255u) << 8) | ((b2 & 255u) << 16) | ((b3 & 255u) << 24);
            }
            *(u32x4*)(dp + i * 1024 + lane * 16) = w;
        }
        if (lane == 0) ((float*)(RAb + (tab ? PEER_VS : PEER_US)))[row] = sc;
    }
}

__device__ void p9_ln1(KA a) {
    const float* mod = (const float*)(a->ws + WS_MOD); bf16_t* H2 = (bf16_t*)(a->ws + WS_RA) + (size_t)2 * MT * 2048;
    const float* g = a->in[23]; const float* bb = a->in[24];
    const int lane = tid_opaque() & 63, wv = blockIdx.x * 8 + (tid_opaque() >> 6), nwv = gridDim.x * 8;
    for (int row = wv; row < MT; row += nwv) {
        float* rp = a->out + (size_t)row * 2048;
        float v[32]; float s = 0.f;
#pragma unroll
        for (int i = 0; i < 4; ++i) { const f32x4 x0 = *(const f32x4*)(rp + i * 512 + lane * 8), x1 = *(const f32x4*)(rp + i * 512 + lane * 8 + 4);
#pragma unroll
            for (int e = 0; e < 4; ++e) { v[i * 8 + e] = x0[e]; v[i * 8 + 4 + e] = x1[e]; s += x0[e] + x1[e]; } }
        const float mu = wave_sum(s) * (1.0f / 2048.0f);
        float q = 0.f;
#pragma unroll
        for (int e = 0; e < 32; ++e) { const float d = v[e] - mu; q += d * d; }
        const float rstd = rsqrtf(wave_sum(q) * (1.0f / 2048.0f) + 1e-5f);
        const float* mp = mod + (row >> 12) * 12288;
#pragma unroll
        for (int i = 0; i < 4; ++i) {
            const int col = i * 512 + lane * 8;
            float xn[8], h[8];
#pragma unroll
            for (int e = 0; e < 8; ++e) { xn[e] = (v[i * 8 + e] - mu) * rstd * g[col + e] + bb[col + e]; h[e] = xn[e] * (1.0f + mp[8192 + col + e]) + mp[6144 + col + e]; }
            *(f32x4*)(rp + col) = (f32x4){xn[0], xn[1], xn[2], xn[3]}; *(f32x4*)(rp + col + 4) = (f32x4){xn[4], xn[5], xn[6], xn[7]};
            *(u32x4*)(H2 + (size_t)row * 2048 + col) = pack8(h);
        }
    }
}

__device__ __forceinline__ float row_max16(float v) {
    v = fmaxf(v, __builtin_bit_cast(float, __builtin_amdgcn_update_dpp(0, __builtin_bit_cast(int, v), 0x128, 0xf, 0xf, false)));
    v = fmaxf(v, __builtin_bit_cast(float, __builtin_amdgcn_update_dpp(0, __builtin_bit_cast(int, v), 0x124, 0xf, 0xf, false)));
    v = fmaxf(v, __builtin_bit_cast(float, __builtin_amdgcn_update_dpp(0, __builtin_bit_cast(int, v), 0x122, 0xf, 0xf, false)));
    v = fmaxf(v, __builtin_bit_cast(float, __builtin_amdgcn_update_dpp(0, __builtin_bit_cast(int, v), 0x121, 0xf, 0xf, false)));
    return v;
}
__device__ __forceinline__ float row_sum16(float v) {
    v += __builtin_bit_cast(float, __builtin_amdgcn_update_dpp(0, __builtin_bit_cast(int, v), 0x128, 0xf, 0xf, false));
    v += __builtin_bit_cast(float, __builtin_amdgcn_update_dpp(0, __builtin_bit_cast(int, v), 0x124, 0xf, 0xf, false));
    v += __builtin_bit_cast(float, __builtin_amdgcn_update_dpp(0, __builtin_bit_cast(int, v), 0x122, 0xf, 0xf, false));
    v += __builtin_bit_cast(float, __builtin_amdgcn_update_dpp(0, __builtin_bit_cast(int, v), 0x121, 0xf, 0xf, false));
    return v;
}
__device__ __forceinline__ int row_sum16i(int v) {
    v += __builtin_amdgcn_update_dpp(0, v, 0x128, 0xf, 0xf, false);
    v += __builtin_amdgcn_update_dpp(0, v, 0x124, 0xf, 0xf, false);
    v += __builtin_amdgcn_update_dpp(0, v, 0x122, 0xf, 0xf, false);
    v += __builtin_amdgcn_update_dpp(0, v, 0x121, 0xf, 0xf, false);
    return v;
}
template <int NCH, int NV> __device__ __forceinline__ void topk16_row16(float (&x)[NCH][NV], int s, int g, float (&rs)[NCH], int (&ri)[NCH]) {
#pragma unroll
    for (int c = 0; c < NCH; ++c) { rs[c] = -INFINITY; ri[c] = 0; }
#pragma unroll 1
    for (int it = 0; it < 16; ++it) {
#pragma unroll
        for (int c = 0; c < NCH; ++c) {
            float m = x[c][0];
#pragma unroll
            for (int j = 1; j < NV; ++j) m = fmaxf(m, x[c][j]);
            const float wm = row_max16(m);
            const unsigned long long bal = __ballot(m == wm);
            const unsigned seg = (unsigned)(bal >> (16 * g)) & 0xffffu;
            const bool iswin = (s == (__ffs((int)seg) - 1));
            int jsel = 0;
#pragma unroll
            for (int j = NV - 1; j >= 0; --j) { const bool e = (x[c][j] == wm); jsel = e ? j : jsel; x[c][j] = (e && iswin) ? -INFINITY : x[c][j]; }
            const int key = row_sum16i(iswin ? (s * NV + jsel) : 0);
            if (s == it) { rs[c] = wm; ri[c] = key; }
        }
    }
}
__device__ void peer_unit(KA a, int unit, unsigned char* lds) {
    const int tid = tid_opaque(), lane = tid & 63, wid = tid >> 6, fr = lane & 15, fq = lane >> 4;
    float* SC = (float*)lds;
    int* IGI = (int*)(lds + 32768); float* IGG = (float*)(lds + 49152);
    float* TL = (float*)(lds + 65536); int* TI = (int*)(lds + 69632);
    const int tok0 = unit * 32;
    const float* Qp = (const float*)(a->ws + WS_RB); const float* subk = a->in[26];
    const bf16_t* H2 = (const bf16_t*)(a->ws + WS_RA) + (size_t)2 * MT * 2048;
    const float* mod = (const float*)(a->ws + WS_MOD);
    int sti[4], stj[4];
#pragma unroll
    for (int q = 0; q < 4; ++q) {
        const int t = fr * 4 + q; int acc = 0, ii = -1, jj = 0;
#pragma unroll
        for (int i = 0; i < 16; ++i) { const int cnt = 16 / (i + 1); if (ii < 0 && t < acc + cnt) { ii = i; jj = t - acc; } acc += cnt; }
        sti[q] = ii; stj[q] = jj;
    }
#pragma unroll 1
    for (int hh = 0; hh < 8 * a->reps[2]; ++hh) { const int h = hh & 7;
#pragma unroll 1
        for (int p = 0; p < 2; ++p) {
            f32x4 bq[8], aq[2][8];
            const float* bp = subk + (size_t)((h * 2 + p) * 128 + wid * 16 + fr) * 128 + fq * 32;
#pragma unroll
            for (int j = 0; j < 8; ++j) bq[j] = *(const f32x4*)(bp + j * 4);
#pragma unroll
            for (int mt = 0; mt < 2; ++mt) { const float* ap = Qp + (size_t)(tok0 + mt * 16 + fr) * 2048 + h * 256 + p * 128 + fq * 32;
#pragma unroll
                for (int j = 0; j < 8; ++j) aq[mt][j] = *(const f32x4*)(ap + j * 4); }
            f32x4 acc[2] = {(f32x4){0.f, 0.f, 0.f, 0.f}, (f32x4){0.f, 0.f, 0.f, 0.f}};
#pragma unroll
            for (int j = 0; j < 8; ++j)
#pragma unroll
                for (int e = 0; e < 4; ++e) {
                    acc[0] = __builtin_amdgcn_mfma_f32_16x16x4f32(aq[0][j][e], bq[j][e], acc[0], 0, 0, 0);
                    acc[1] = __builtin_amdgcn_mfma_f32_16x16x4f32(aq[1][j][e], bq[j][e], acc[1], 0, 0, 0);
                }
#pragma unroll
            for (int mt = 0; mt < 2; ++mt)
#pragma unroll
                for (int r = 0; r < 4; ++r) SC[(p * 32 + mt * 16 + 4 * fq + r) * 128 + wid * 16 + fr] = acc[mt][r];
        }
        __syncthreads();
        {
            const int tk = wid * 4 + fq;
            float x[2][8]; float ts[2]; int tix[2];
#pragma unroll
            for (int p = 0; p < 2; ++p) { const f32x4 y0 = *(const f32x4*)(SC + (p * 32 + tk) * 128 + fr * 8), y1 = *(const f32x4*)(SC + (p * 32 + tk) * 128 + fr * 8 + 4);
                x[p][0] = y0.x; x[p][1] = y0.y; x[p][2] = y0.z; x[p][3] = y0.w; x[p][4] = y1.x; x[p][5] = y1.y; x[p][6] = y1.z; x[p][7] = y1.w; }
            topk16_row16<2, 8>(x, fr, fq, ts, tix);
            TL[(tk * 2 + 0) * 16 + fr] = ts[0]; TL[(tk * 2 + 1) * 16 + fr] = ts[1]; TI[(tk * 2 + 0) * 16 + fr] = tix[0]; TI[(tk * 2 + 1) * 16 + fr] = tix[1];
            asm volatile("s_waitcnt lgkmcnt(0)" ::: "memory");
            float cnd[1][4]; float bs[1]; int bc[1];
#pragma unroll
            for (int q = 0; q < 4; ++q) cnd[0][q] = (sti[q] >= 0) ? TL[(tk * 2 + 0) * 16 + (sti[q] & 15)] + TL[(tk * 2 + 1) * 16 + stj[q]] : -INFINITY;
            topk16_row16<1, 4>(cnd, fr, fq, bs, bc);
            const int src = (lane & 48) + (bc[0] >> 2), qq = bc[0] & 3;
            const int i0 = __shfl(sti[0], src, 64), i1 = __shfl(sti[1], src, 64), i2 = __shfl(sti[2], src, 64), i3 = __shfl(sti[3], src, 64);
            const int j0 = __shfl(stj[0], src, 64), j1 = __shfl(stj[1], src, 64), j2 = __shfl(stj[2], src, 64), j3 = __shfl(stj[3], src, 64);
            const int pi = (qq == 0) ? i0 : (qq == 1) ? i1 : (qq == 2) ? i2 : i3, pj = (qq == 0) ? j0 : (qq == 1) ? j1 : (qq == 2) ? j2 : j3;
            const int e0 = TI[(tk * 2 + 0) * 16 + (pi & 15)], e1 = TI[(tk * 2 + 1) * 16 + (pj & 15)];
            const float mx = row_max16(bs[0]);
            const float ex = expf(bs[0] - mx);
            const float sm = row_sum16(ex);
            IGI[tk * 128 + h * 16 + fr] = e0 * 128 + e1; IGG[tk * 128 + h * 16 + fr] = ex / sm;
        }
        __syncthreads();
    }
    __syncthreads();
    const unsigned char* U8 = a->ws + WS_RA + PEER_U8; const unsigned char* V8 = a->ws + WS_RA + PEER_V8;
    const float* US = (const float*)(a->ws + WS_RA + PEER_US); const float* VS = (const float*)(a->ws + WS_RA + PEER_VS);
#pragma unroll 1
    for (int rr = 0; rr < 4; ++rr) {
        const int row = wid * 4 + rr, tok = tok0 + row;
        float hx[32], yq[32]; float hs = 0.f;
#pragma unroll
        for (int i = 0; i < 2; ++i) {
            float t8[8];
            unpack8(*(const u32x4*)(H2 + (size_t)tok * 2048 + i * 1024 + lane * 16), t8);
#pragma unroll
            for (int e = 0; e < 8; ++e) { hx[i * 16 + e] = t8[e]; hs += t8[e]; }
            unpack8(*(const u32x4*)(H2 + (size_t)tok * 2048 + i * 1024 + lane * 16 + 8), t8);
#pragma unroll
            for (int e = 0; e < 8; ++e) { hx[i * 16 + 8 + e] = t8[e]; hs += t8[e]; }
        }
#pragma unroll
        for (int e = 0; e < 32; ++e) yq[e] = 0.f;
        hs = wave_sum(hs);
        float csum = 0.f;
#if DBG_MODE != 2
        const int* ip = IGI + row * 128; const float* gp = IGG + row * 128;
        u32x4 nu[2][2], nv[2][2]; float nsu[2], nsv[2];
#pragma unroll
        for (int k = 0; k < 2; ++k) {
            const int idx = __builtin_amdgcn_readfirstlane(ip[k]);
            const unsigned char* up = U8 + (size_t)idx * 2048 + lane * 16; const unsigned char* vp = V8 + (size_t)idx * 2048 + lane * 16;
            nu[k][0] = *(const u32x4*)up; nu[k][1] = *(const u32x4*)(up + 1024); nv[k][0] = *(const u32x4*)vp; nv[k][1] = *(const u32x4*)(vp + 1024);
            nsu[k] = US[idx]; nsv[k] = VS[idx];
        }
#pragma unroll 1
        for (int e = 0; e < 128; e += 2) {
            u32x4 cu[2][2], cvv[2][2]; float csu[2], csv[2];
#pragma unroll
            for (int k = 0; k < 2; ++k) { cu[k][0] = nu[k][0]; cu[k][1] = nu[k][1]; cvv[k][0] = nv[k][0]; cvv[k][1] = nv[k][1]; csu[k] = nsu[k]; csv[k] = nsv[k]; }
            if (e + 2 < 128) {
#pragma unroll
                for (int k = 0; k < 2; ++k) {
                    const int idx = __builtin_amdgcn_readfirstlane(ip[e + 2 + k]);
                    const unsigned char* up = U8 + (size_t)idx * 2048 + lane * 16; const unsigned char* vp = V8 + (size_t)idx * 2048 + lane * 16;
                    nu[k][0] = *(const u32x4*)up; nu[k][1] = *(const u32x4*)(up + 1024); nv[k][0] = *(const u32x4*)vp; nv[k][1] = *(const u32x4*)(vp + 1024);
                    nsu[k] = US[idx]; nsv[k] = VS[idx];
                }
            }
#pragma unroll
            for (int k = 0; k < 2; ++k) {
                float acc = 0.f;
#pragma unroll
                for (int i = 0; i < 2; ++i)
#pragma unroll
                    for (int j = 0; j < 4; ++j) { const unsigned wd = cu[k][i][j]; const float* hp = hx + i * 16 + j * 4;
                        acc += (float)(wd & 255u) * hp[0]; acc += (float)((wd >> 8) & 255u) * hp[1]; acc += (float)((wd >> 16) & 255u) * hp[2]; acc += (float)(wd >> 24) * hp[3]; }
                const float dot = csu[k] * (wave_sum(acc) - 128.0f * hs);
                const float c1 = gp[e + k] * 0.5f * dot * (1.0f + erff(dot * 0.7071067811865476f)) * csv[k];
                csum += c1;
#pragma unroll
                for (int i = 0; i < 2; ++i)
#pragma unroll
                    for (int j = 0; j < 4; ++j) { const unsigned wd = cvv[k][i][j]; float* yp = yq + i * 16 + j * 4;
                        yp[0] += c1 * (float)(wd & 255u); yp[1] += c1 * (float)((wd >> 8) & 255u); yp[2] += c1 * (float)((wd >> 16) & 255u); yp[3] += c1 * (float)(wd >> 24); }
            }
        }
#endif
        float* rp = a->out + (size_t)tok * 2048; const float* mp = mod + (tok >> 12) * 12288 + 10240;
        float val[32]; float s = 0.f;
        const float yoff = 128.0f * csum;
#pragma unroll
        for (int i = 0; i < 2; ++i)
#pragma unroll
            for (int j = 0; j < 4; ++j) { const int col = i * 1024 + lane * 16 + j * 4; const f32x4 x0 = *(const f32x4*)(rp + col), g0 = *(const f32x4*)(mp + col);
#pragma unroll
                for (int e = 0; e < 4; ++e) { const float v = ALPHA * x0[e] + g0[e] * (yq[i * 16 + j * 4 + e] - yoff); val[i * 16 + j * 4 + e] = v; s += v; } }
        const float mu = wave_sum(s) * (1.0f / 2048.0f);
        float q = 0.f;
#pragma unroll
        for (int e = 0; e < 32; ++e) { const float d = val[e] - mu; q += d * d; }
        const float rstd = rsqrtf(wave_sum(q) * (1.0f / 2048.0f) + 1e-5f);
        const float* g = a->in[29]; const float* bb = a->in[30];
#pragma unroll
        for (int i = 0; i < 2; ++i)
#pragma unroll
            for (int j = 0; j < 4; ++j) { const int col = i * 1024 + lane * 16 + j * 4; const f32x4 gg = *(const f32x4*)(g + col), bv = *(const f32x4*)(bb + col); f32x4 o;
#pragma unroll
                for (int e = 0; e < 4; ++e) o[e] = (val[i * 16 + j * 4 + e] - mu) * rstd * gg[e] + bv[e];
                *(f32x4*)(rp + col) = o; }
    }
    __syncthreads();
}

__global__ void __launch_bounds__(NT, 2) fwd_mega(Args a_) {
    KA a = (KA)__builtin_amdgcn_kernarg_segment_ptr();
    extern __shared__ __attribute__((aligned(16))) unsigned char lds[];
    cg::grid_group grid = cg::this_grid();
    float* lf = (float*)lds;
    const int lo = a->ph_lo, hi = a->ph_hi;
#define IN(k) (lo <= (k) && (k) < hi)
#define SEAM(k) do { if (IN(k) && IN((k) + 1)) grid.sync(); asm volatile("" : "+s"(a)); } while (0)
    unsigned char* ws = a->ws;
    bf16_t* HA = (bf16_t*)(ws + WS_HA); bf16_t* WT = (bf16_t*)(ws + WS_WT); bf16_t* SW = (bf16_t*)(ws + WS_SW);
    bf16_t* RA = (bf16_t*)(ws + WS_RA); bf16_t* RB = (bf16_t*)(ws + WS_RB);
    const float* mod = (const float*)(ws + WS_MOD);

    if (IN(0)) {
#pragma unroll 1
        for (int rep = 0; rep < a->reps[0]; ++rep) { p0_mod_hid2(a, lf); p0_transposes(a, lf); }
    }
    SEAM(0);
    if (IN(1)) {
#pragma unroll 1
        for (int rep = 0; rep < a->reps[0]; ++rep) p1_ha(a);
    }
    SEAM(1);
    if (IN(2)) {
#pragma unroll 1
        for (int rep = 0; rep < a->reps[1]; ++rep) {
        run_gemm(lds, WT + (size_t)WT_HY0 * 2048, HA, NHY, MT, FStoreBf16{RA, MT});
        run_gemm(lds, HA, WT, MA, NQKVP, FStoreQKV{RB, (float*)(ws + WS_AB)});
        }
    }
    SEAM(2);
    if (IN(3)) {
        hyena_setup(lds);
#pragma unroll 1
        for (int rep = 0; rep < a->reps[3]; ++rep)
        for (int c = blockIdx.x; c < 2048; c += gridDim.x) hyena_item(a, c, lds);
        for (int u = blockIdx.x; u < 12288 + 192; u += gridDim.x) qkvpost_unit(a, u, lds);
    }
    SEAM(3);
    if (IN(4)) {
        { const int wv = tid_opaque() >> 6; for (int pid = blockIdx.x * 8 + wv; pid < 8704; pid += gridDim.x * 8) tprep_wave(a, pid, lds + wv * 17920); }
        grid.sync();
        for (int it = blockIdx.x; it < 256; it += gridDim.x) delta_item(a, it, lds);
    }
    SEAM(4);
    if (IN(5)) {
        run_gemm(lds, HA, WT + (size_t)WT_ZG0 * 2048, MT, NZG, FStoreBf16{RB, NZG});
        for (int u = blockIdx.x; u < 8192; u += gridDim.x) ytrans_unit((const bf16_t*)a->out, RA + (size_t)2 * MT * 2048, u, (bf16_t*)lds);
    }
    SEAM(5);
    if (IN(6)) { p6_on(a); }
    SEAM(6);
    if (IN(7)) {
        run_gemm(lds, HA  , SW, MT, D, FGatePA{RB, WT  });
        run_gemm(lds, RA + (size_t)2 * MT * 2048  , SW + (size_t)1 * D * D, MT, D, FGatePH{RB, WT  });
    }
    SEAM(7);
    if (IN(8)) {
        run_gemm(lds, WT  , SW + (size_t)2 * D * D, MT, D, FOut{a->in[0], mod, a->out});
        p8_tables(a);
    }
    SEAM(8);
    if (IN(9)) { p9_ln1(a); }
    SEAM(9);
    if (IN(10)) { run_gemm(lds, RA + (size_t)2 * MT * 2048  , SW + (size_t)3 * D * D, MT, D, FStoreF32{(float*)(ws + WS_RB), D}); }
    SEAM(10);
    if (IN(11)) { for (int u = blockIdx.x; u < MT / 32; u += gridDim.x) peer_unit(a, u, lds); }
#undef IN
#undef SEAM
}

extern "C" void kernel_launch(void* const* d_in, const int* in_sizes, int n_in, void* d_out, int out_size, void* d_ws, size_t ws_size, hipStream_t stream) {
    static int grid = 0;
    if (grid == 0) {
        if (n_in != 31 || out_size != MT * D || ws_size < WS_END) { fprintf(stderr, "kernel_launch: unexpected problem shape / workspace (%d inputs, out %d, ws %zu)\n", n_in, out_size, ws_size); grid = -1; return; }
        int dev = 0, cus = 0, per_cu = 0;
        (void)hipGetDevice(&dev);
        (void)hipDeviceGetAttribute(&cus, hipDeviceAttributeMultiprocessorCount, dev);
        (void)hipFuncSetAttribute((const void*)fwd_mega, hipFuncAttributeMaxDynamicSharedMemorySize, LDS_BYTES);
        (void)hipOccupancyMaxActiveBlocksPerMultiprocessor(&per_cu, (const void*)fwd_mega, NT, LDS_BYTES);
        if (per_cu < 1) per_cu = 1;
        grid = cus * per_cu;
        (void)hipGetLastError();
    }
    if (grid < 0) return;
    Args a{};
    for (int i = 0; i < 31; ++i) a.in[i] = (const float*)d_in[i];
    a.out = (float*)d_out; a.ws = (unsigned char*)d_ws; a.ph_lo = 0; a.ph_hi = 12; a.reps[0] = REP0; a.reps[1] = REP1; a.reps[2] = REP2; a.reps[3] = REP3;
    void* args[] = {&a};
    hipError_t e = hipLaunchCooperativeKernel((const void*)fwd_mega, dim3(grid), dim3(NT), args, LDS_BYTES, stream);
    if (e != hipSuccess) fprintf(stderr, "cooperative launch failed: %s (grid %d)\n", hipGetErrorString(e), grid);
}
```

```cpp
#include <hip/hip_runtime.h>
#include <hip/hip_cooperative_groups.h>
#include <cstdio>
#include <cstdint>
namespace cg = cooperative_groups;

#ifndef DBG_MODE
#define DBG_MODE 0
#endif
#define REP0 1
#define REP1 1
#define REP2 1
#define REP3 1
#define REP4 1
#define REP5 1
#define REP6 1
#define REP7 1

__device__ __forceinline__ int tid_opaque() { int t = threadIdx.x; asm volatile("" : "+v"(t)); return t; }

namespace pg8 {
#define PG8_LAS __attribute__((address_space(3)))
typedef unsigned short bf16_t;
typedef short bf16x8 __attribute__((ext_vector_type(8)));
typedef float f32x4 __attribute__((ext_vector_type(4)));
typedef unsigned u32x4 __attribute__((ext_vector_type(4)));
constexpr int BM = 256, BK = 64, HALF = 128, HTB = HALF * BK * 2, STAGE_BYTES = 8 * HTB, NXCD = 8, WGM = 8;

__host__ __device__ __forceinline__ int lds_byte(int r, int c) { const int st = (r >> 4) * 2 + (c >> 5), rr = r & 15, cc = c & 31, ob = rr * 64 + cc * 2; return st * 1024 + (ob ^ (((ob >> 9) & 1) << 5)); }
__host__ __device__ __forceinline__ void stage_rc(int b, int& R, int& C) { const int st = b / 1024, sb = b % 1024, swz = sb ^ (((sb >> 9) & 1) << 5); R = (st >> 1) * 16 + swz / 64; C = (st & 1) * 32 + (swz % 64) / 2; }
__host__ __device__ __forceinline__ int perm32(int rho) { const int n = rho >> 4, i = rho & 15; return 8 * (i >> 2) + 4 * n + (i & 3); }

struct Unit { int pm, pn; };
struct Gemm { const bf16_t* A; const bf16_t* Bt; int M, N, K; };

struct StaticOrder {
    int nM, nN, nwg, G, c;
    __host__ __device__ void init(int M, int N, int G_, int c_) { nM = M / BM; nN = N / BM; nwg = nM * nN; G = G_; c = c_; }
    __host__ __device__ bool next(int i, Unit& u) const {
        const long L = (long)i * G + c; if (L >= nwg) return false;
        int wgid = (int)L; { const int q = nwg / NXCD, r = nwg % NXCD, xcd = wgid % NXCD, off = wgid / NXCD; wgid = (xcd < r ? xcd * (q + 1) : r * (q + 1) + (xcd - r) * q) + off; }
        const int nig = WGM * nN, gid = wgid / nig, fm = gid * WGM, gsz = (nM - fm) < WGM ? (nM - fm) : WGM;
        u.pm = fm + ((wgid % nig) % gsz); u.pn = (wgid % nig) / gsz; return true;
    }
    __device__ __forceinline__ void a_ready(const Unit&) const {}
    __device__ __forceinline__ void done(const Unit&) const {}
};

__device__ __forceinline__ unsigned cvt_pk_bf16(float lo, float hi) { unsigned r; asm volatile("v_cvt_pk_bf16_f32 %0, %1, %2" : "=v"(r) : "v"(lo), "v"(hi)); return r; }

template <class F> struct EpiGen {
    static constexpr bool PERM = true, AFTER_DRAIN = false;
    F f;
    __device__ __forceinline__ void operator()(const f32x4 (&acc)[2][2][4][2], const Unit& u, int wr, int wc, int fr, int fq) const {
        const int row0 = u.pm * BM + wr * 64 + fr, col0 = u.pn * BM + wc * 32 + 8 * fq;
#pragma unroll
        for (int ai = 0; ai < 2; ++ai)
#pragma unroll
            for (int m = 0; m < 4; ++m)
#pragma unroll
                for (int bj = 0; bj < 2; ++bj) f(row0 + ai * HALF + m * 16, col0 + bj * HALF, acc[ai][bj][m][0], acc[ai][bj][m][1]);
    }
};

template <class Epi, class Sched, bool ALIGN_EPI = false, bool SP2 = false>
__device__ __forceinline__ void gemm_phase(PG8_LAS unsigned char* lds, const Gemm g, const Sched& S, const Epi& E) {
    const int tid = tid_opaque(), wid = __builtin_amdgcn_readfirstlane(tid >> 6), lane = tid & 63, wr = wid >> 2, wc = wid & 3, fr = lane & 15, fq = lane >> 4;
    const int K = g.K, nt = K / BK;
    unsigned voffA[2], voffB[2];
#pragma unroll
    for (int i = 0; i < 2; ++i) { int R, C; stage_rc(tid * 16 + i * 8192, R, C); const int Rb = Epi::PERM ? ((R & ~31) + perm32(R & 31)) : R;
        voffA[i] = (unsigned)(R * K + C) * 2u; voffB[i] = (unsigned)(Rb * K + C) * 2u; }
    const size_t kstep = (size_t)(BK * 2);
    const size_t hstep = (size_t)HALF * K * 2;
    const size_t tstep = 2 * hstep;
    const unsigned ldsw = (unsigned)wid * 1024u;
    const int aoff = lds_byte(wr * 64 + fr, fq * 8), boff = lds_byte(wc * 32 + fr, fq * 8);
#define PG8_SA(b, h) (((b) * 2 + (h)) * HTB)
#define PG8_SB(b, h) ((4 + (b) * 2 + (h)) * HTB)
#define PG8_STAGE(bufoff, gbase, voff) do { _Pragma("unroll") for (int _i = 0; _i < 2; ++_i) \
        __builtin_amdgcn_global_load_lds((const unsigned*)((const char*)(gbase) + (voff)[_i]), (PG8_LAS unsigned*)(lds + (bufoff) + ldsw + _i * 8192), 16, 0, 0); } while (0)
#define PG8_LDA(dst, b, h) do { _Pragma("unroll") for (int m = 0; m < 4; ++m) _Pragma("unroll") for (int k = 0; k < 2; ++k) dst[m][k] = *(const PG8_LAS bf16x8*)(lds + PG8_SA(b, h) + aoff + m * 2048 + k * 1024); } while (0)
#define PG8_LDB(dst, b, h) do { _Pragma("unroll") for (int n = 0; n < 2; ++n) _Pragma("unroll") for (int k = 0; k < 2; ++k) dst[n][k] = *(const PG8_LAS bf16x8*)(lds + PG8_SB(b, h) + boff + n * 2048 + k * 1024); } while (0)
#define PG8_MMA(ai, bj, At, Bt) do { __builtin_amdgcn_s_setprio(1); _Pragma("unroll") for (int m = 0; m < 4; ++m) _Pragma("unroll") for (int n = 0; n < 2; ++n) _Pragma("unroll") for (int k = 0; k < 2; ++k) \
        acc[ai][bj][m][n] = __builtin_amdgcn_mfma_f32_16x16x32_bf16(Bt[n][k], At[m][k], acc[ai][bj][m][n], 0, 0, 0); __builtin_amdgcn_s_setprio(0); } while (0)
#define PG8_WAIT_V(n) asm volatile("s_waitcnt vmcnt(" #n ")" ::: "memory")
#define PG8_WAIT_L(n) asm volatile("s_waitcnt lgkmcnt(" #n ")" ::: "memory")
#define PG8_BAR __builtin_amdgcn_s_barrier()
#define PG8_SCHED __builtin_amdgcn_sched_barrier(0)
    Unit cur, nxt; int ui = 0;
    if (!S.next(0, cur)) return;
    f32x4 acc[2][2][4][2];
#pragma unroll
    for (int a = 0; a < 2; ++a)
#pragma unroll
        for (int b = 0; b < 2; ++b)
#pragma unroll
            for (int m = 0; m < 4; ++m)
#pragma unroll
                for (int n = 0; n < 2; ++n) acc[a][b][m][n] = (f32x4){0.f, 0.f, 0.f, 0.f};
    bf16x8 At[4][2], B0[2][2], B1[2][2];
    const char* cA = (const char*)g.A + (size_t)cur.pm * tstep; const char* cB = (const char*)g.Bt + (size_t)cur.pn * tstep;
    S.a_ready(cur);
    if constexpr (SP2) {
        PG8_STAGE(PG8_SB(0, 0), cB, voffB); PG8_STAGE(PG8_SB(0, 1), cB + hstep, voffB); PG8_STAGE(PG8_SA(0, 0), cA, voffA); PG8_STAGE(PG8_SA(0, 1), cA + hstep, voffA);
        if (wr == 1) PG8_BAR;
        PG8_WAIT_V(2); PG8_BAR;
        PG8_STAGE(PG8_SB(1, 0), cB + kstep, voffB); PG8_STAGE(PG8_SA(1, 0), cA + kstep, voffA); PG8_STAGE(PG8_SB(1, 1), cB + hstep + kstep, voffB);
        PG8_WAIT_V(6); PG8_BAR;
    } else {
        PG8_STAGE(PG8_SB(0, 0), cB, voffB); PG8_STAGE(PG8_SA(0, 0), cA, voffA); PG8_STAGE(PG8_SB(0, 1), cB + hstep, voffB); PG8_STAGE(PG8_SA(0, 1), cA + hstep, voffA);
        if (wr == 1) PG8_BAR;
        PG8_WAIT_V(4); PG8_BAR;
        PG8_STAGE(PG8_SB(1, 0), cB + kstep, voffB); PG8_STAGE(PG8_SA(1, 0), cA + kstep, voffA); PG8_STAGE(PG8_SB(1, 1), cB + hstep + kstep, voffB);
        PG8_WAIT_V(6); PG8_BAR;
    }
    for (;;) {
        const bool has_next = S.next(ui + 1, nxt);
        const char* nA = has_next ? (const char*)g.A + (size_t)nxt.pm * tstep : cA; const char* nB = has_next ? (const char*)g.Bt + (size_t)nxt.pn * tstep : cB;
        for (int t = 0; t < nt; t += 2) {
            const bool last = (t == nt - 2);
            const char* a1 = cA + (size_t)(t + 1) * kstep;
            const char* a2 = last ? nA : cA + (size_t)(t + 2) * kstep; const char* b2 = last ? nB : cB + (size_t)(t + 2) * kstep;
            const char* a3 = a2 + kstep; const char* b3 = b2 + kstep;
            if (last && has_next) S.a_ready(nxt);
            if constexpr (SP2) {
            PG8_LDB(B0, 0, 0); PG8_LDB(B1, 0, 1); PG8_SCHED; PG8_LDA(At, 0, 0); PG8_STAGE(PG8_SA(1, 1), a1 + hstep, voffA);
            PG8_WAIT_V(8); PG8_WAIT_L(0); PG8_BAR; PG8_MMA(0, 0, At, B0); PG8_MMA(0, 1, At, B1); PG8_BAR; PG8_SCHED;
            PG8_LDA(At, 0, 1); PG8_STAGE(PG8_SB(0, 0), b2, voffB); PG8_STAGE(PG8_SB(0, 1), b2 + hstep, voffB); PG8_STAGE(PG8_SA(0, 0), a2, voffA);
            PG8_WAIT_V(8); PG8_WAIT_L(0); PG8_BAR; PG8_MMA(1, 0, At, B0); PG8_MMA(1, 1, At, B1); PG8_BAR; PG8_SCHED;
            PG8_LDB(B0, 1, 0); PG8_LDB(B1, 1, 1); PG8_SCHED; PG8_LDA(At, 1, 0); PG8_STAGE(PG8_SA(0, 1), a2 + hstep, voffA);
            PG8_WAIT_V(8); PG8_WAIT_L(0); PG8_BAR; PG8_MMA(0, 0, At, B0); PG8_MMA(0, 1, At, B1); PG8_BAR; PG8_SCHED;
            PG8_LDA(At, 1, 1); PG8_STAGE(PG8_SB(1, 0), b3, voffB); PG8_STAGE(PG8_SB(1, 1), b3 + hstep, voffB); PG8_STAGE(PG8_SA(1, 0), a3, voffA);
            PG8_WAIT_V(8); PG8_WAIT_L(0); PG8_BAR; PG8_MMA(1, 0, At, B0); PG8_MMA(1, 1, At, B1); PG8_BAR; PG8_SCHED;
            } else {
            PG8_LDB(B0, 0, 0); PG8_SCHED; PG8_LDA(At, 0, 0); PG8_STAGE(PG8_SA(1, 1), a1 + hstep, voffA);
            PG8_WAIT_L(8); PG8_BAR; PG8_WAIT_L(0); PG8_MMA(0, 0, At, B0); PG8_BAR; PG8_SCHED;
            PG8_LDB(B1, 0, 1); PG8_STAGE(PG8_SB(0, 0), b2, voffB);
            PG8_BAR; PG8_WAIT_L(0); PG8_MMA(0, 1, At, B1); PG8_BAR;
            PG8_LDA(At, 0, 1); PG8_STAGE(PG8_SA(0, 0), a2, voffA);
            PG8_BAR; PG8_WAIT_L(0); PG8_MMA(1, 0, At, B0); PG8_BAR; PG8_SCHED;
            PG8_STAGE(PG8_SB(0, 1), b2 + hstep, voffB);
            PG8_WAIT_V(6); PG8_BAR; PG8_MMA(1, 1, At, B1); PG8_BAR;
            PG8_LDB(B0, 1, 0); PG8_SCHED; PG8_LDA(At, 1, 0); PG8_STAGE(PG8_SA(0, 1), a2 + hstep, voffA);
            PG8_WAIT_L(8); PG8_BAR; PG8_WAIT_L(0); PG8_MMA(0, 0, At, B0); PG8_BAR; PG8_SCHED;
            PG8_LDB(B1, 1, 1); PG8_STAGE(PG8_SB(1, 0), b3, voffB);
            PG8_BAR; PG8_WAIT_L(0); PG8_MMA(0, 1, At, B1); PG8_BAR;
            PG8_LDA(At, 1, 1); PG8_STAGE(PG8_SA(1, 0), a3, voffA);
            PG8_BAR; PG8_WAIT_L(0); PG8_MMA(1, 0, At, B0); PG8_BAR; PG8_SCHED;
            PG8_STAGE(PG8_SB(1, 1), b3 + hstep, voffB);
            PG8_WAIT_V(6); PG8_BAR; PG8_MMA(1, 1, At, B1); PG8_BAR;
            }
        }
        if constexpr (ALIGN_EPI) { if (wr == 0) PG8_BAR; }
        if constexpr (!Epi::AFTER_DRAIN) { E(acc, cur, wr, wc, fr, fq); S.done(cur); }
        if (!has_next) break;
#pragma unroll
        for (int a = 0; a < 2; ++a)
#pragma unroll
            for (int b = 0; b < 2; ++b)
#pragma unroll
                for (int m = 0; m < 4; ++m)
#pragma unroll
                    for (int n = 0; n < 2; ++n) acc[a][b][m][n] = (f32x4){0.f, 0.f, 0.f, 0.f};
        cur = nxt; cA = nA; cB = nB; ++ui;
        if constexpr (ALIGN_EPI) { if (wr == 1) PG8_BAR; }
    }
    PG8_WAIT_V(0);
    if constexpr (!ALIGN_EPI) { if (wr == 0) PG8_BAR; }
    PG8_BAR;
    if constexpr (Epi::AFTER_DRAIN) { E.fused(acc, cur, wr, wc, fr, fq, lds, wid, lane); S.done(cur); }
#undef PG8_SA
#undef PG8_SB
#undef PG8_STAGE
#undef PG8_LDA
#undef PG8_LDB
#undef PG8_MMA
#undef PG8_WAIT_V
#undef PG8_WAIT_L
#undef PG8_BAR
#undef PG8_SCHED
}
}

typedef unsigned short bf16_t;
typedef float f32x4 __attribute__((ext_vector_type(4)));
typedef unsigned u32x4 __attribute__((ext_vector_type(4)));
#define LAS __attribute__((address_space(3)))

constexpr int NT = 512;
constexpr int LDS_BYTES = 160 * 1024;
constexpr int D = 2048, NB = 4, SEQ = 4096, CTXL = 256;
constexpr int MT = NB * SEQ;
constexpr int MC = NB * CTXL;
constexpr int MA = MT + MC;
constexpr int NQKVP = 6400;
constexpr int PQ_LD = 6144;
constexpr int NHY = 6144, NZG = 6144;
constexpr int WT_ROWS = NQKVP + NHY + NZG;
constexpr int WT_HY0 = NQKVP, WT_ZG0 = NQKVP + NHY;
constexpr float ALPHA = 1.189207115002721f;

constexpr size_t MiB = (size_t)1 << 20;
constexpr size_t WS_MOD = 0, WS_HID2 = 1 * MiB, WS_SW = 2 * MiB, WS_HA = 34 * MiB, WS_WT = 102 * MiB, WS_RA = 175 * MiB, WS_RB = 367 * MiB, WS_AB = 580 * MiB, WS_END = 658 * MiB;

struct Args { const float* in[31]; float* out; unsigned char* ws; int ph_lo, ph_hi; int reps[8]; int pad2[2]; };
typedef const __attribute__((address_space(4))) Args* KA;

__device__ __forceinline__ unsigned f2bf(float f) { unsigned u = __float_as_uint(f); return (u + 0x7fffu + ((u >> 16) & 1u)) >> 16; }
__device__ __forceinline__ unsigned pk2(float lo, float hi) { return f2bf(lo) | (f2bf(hi) << 16); }
__device__ __forceinline__ float bflo(unsigned w) { return __uint_as_float(w << 16); }
__device__ __forceinline__ float bfhi(unsigned w) { return __uint_as_float(w & 0xffff0000u); }
__device__ __forceinline__ float bf2f(bf16_t b) { return __uint_as_float(((unsigned)b) << 16); }
__device__ __forceinline__ void unpack8(const u32x4 w, float (&o)[8]) { o[0] = bflo(w.x); o[1] = bfhi(w.x); o[2] = bflo(w.y); o[3] = bfhi(w.y); o[4] = bflo(w.z); o[5] = bfhi(w.z); o[6] = bflo(w.w); o[7] = bfhi(w.w); }
__device__ __forceinline__ u32x4 pack8(const float (&v)[8]) { u32x4 w; w.x = pk2(v[0], v[1]); w.y = pk2(v[2], v[3]); w.z = pk2(v[4], v[5]); w.w = pk2(v[6], v[7]); return w; }
typedef short bf16x8 __attribute__((ext_vector_type(8)));
typedef unsigned u32x2 __attribute__((ext_vector_type(2)));
#define MFMA16(a, b, c) __builtin_amdgcn_mfma_f32_16x16x32_bf16((a), (b), (c), 0, 0, 0)
__device__ __forceinline__ u32x2 pk4(float a, float b, float c, float d) { u32x2 w; w.x = pk2(a, b); w.y = pk2(c, d); return w; }
__device__ __forceinline__ float sigmoidf_(float x) { return 1.0f / (1.0f + expf(-x)); }
__device__ __forceinline__ float siluf_(float x) { return x / (1.0f + expf(-x)); }
__device__ __forceinline__ float rdlane(float v, const int l) { return __builtin_bit_cast(float, __builtin_amdgcn_readlane(__builtin_bit_cast(int, v), l)); }
__device__ __forceinline__ float wave_sum(float v) {
    v += __builtin_bit_cast(float, __builtin_amdgcn_update_dpp(0, __builtin_bit_cast(int, v), 0x128, 0xf, 0xf, false));
    v += __builtin_bit_cast(float, __builtin_amdgcn_update_dpp(0, __builtin_bit_cast(int, v), 0x124, 0xf, 0xf, false));
    v += __builtin_bit_cast(float, __builtin_amdgcn_update_dpp(0, __builtin_bit_cast(int, v), 0x122, 0xf, 0xf, false));
    v += __builtin_bit_cast(float, __builtin_amdgcn_update_dpp(0, __builtin_bit_cast(int, v), 0x121, 0xf, 0xf, false));
    return (rdlane(v, 0) + rdlane(v, 16)) + (rdlane(v, 32) + rdlane(v, 48));
}
__device__ __forceinline__ float wave_max(float v) {
    v = fmaxf(v, __builtin_bit_cast(float, __builtin_amdgcn_update_dpp(0, __builtin_bit_cast(int, v), 0x128, 0xf, 0xf, false)));
    v = fmaxf(v, __builtin_bit_cast(float, __builtin_amdgcn_update_dpp(0, __builtin_bit_cast(int, v), 0x124, 0xf, 0xf, false)));
    v = fmaxf(v, __builtin_bit_cast(float, __builtin_amdgcn_update_dpp(0, __builtin_bit_cast(int, v), 0x122, 0xf, 0xf, false)));
    v = fmaxf(v, __builtin_bit_cast(float, __builtin_amdgcn_update_dpp(0, __builtin_bit_cast(int, v), 0x121, 0xf, 0xf, false)));
    return fmaxf(fmaxf(rdlane(v, 0), rdlane(v, 16)), fmaxf(rdlane(v, 32), rdlane(v, 48)));
}

__device__ void p0_mod_hid2(KA a, float* lf) {
    const int tid = tid_opaque(), bid = blockIdx.x;
    if (bid < 192) {
        const float* c = a->in[1]; const float* cc = a->in[3]; const float* w_ada = a->in[4]; const float* b_ada = a->in[5];
        float* mod = (float*)(a->ws + WS_MOD);
        for (int i = tid; i < 5 * 2048; i += NT) { const int r = i >> 11, k = i & 2047; const float v = (r < 4) ? c[r * 2048 + k] : cc[k]; lf[i] = siluf_(v); }
        __syncthreads();
        const int cl = tid & 63, kg = tid >> 6, col = bid * 64 + cl;
        float a0 = 0.f, a1 = 0.f, a2 = 0.f, a3 = 0.f, a4 = 0.f;
#pragma unroll 8
        for (int k = kg * 256; k < kg * 256 + 256; ++k) {
            const float w = w_ada[(size_t)k * 12288 + col];
            a0 += lf[k] * w; a1 += lf[2048 + k] * w; a2 += lf[4096 + k] * w; a3 += lf[6144 + k] * w; a4 += lf[8192 + k] * w;
        }
        float* red = lf + 5 * 2048;
        red[(kg * 5 + 0) * 64 + cl] = a0; red[(kg * 5 + 1) * 64 + cl] = a1; red[(kg * 5 + 2) * 64 + cl] = a2; red[(kg * 5 + 3) * 64 + cl] = a3; red[(kg * 5 + 4) * 64 + cl] = a4;
        __syncthreads();
        if (tid < 320) { const int r = tid >> 6; float s = 0.f;
#pragma unroll
            for (int g = 0; g < 8; ++g) s += red[(g * 5 + r) * 64 + cl];
            mod[r * 12288 + col] = s + b_ada[col]; }
        __syncthreads();
    } else {
        const float* w1 = a->in[12]; const float* b1 = a->in[13]; const float* w2 = a->in[14]; const float* b2 = a->in[15]; const float* freq = a->in[18];
        float* hid2 = (float*)(a->ws + WS_HID2);
        const int pb = (bid - 192) * 64, j = tid & 63, pl = tid >> 6;
        const float fj = freq[j];
        for (int it = 0; it < 8; ++it) {
            const int pos = pb + it * 8 + pl;
            const float tt = (float)pos * (1.0f / 4095.0f);
            float s1 = tt * w1[j];
            const float base = (6.283185307179586f / 4096.0f) * (float)pos;
            for (int e = 0; e < 16; ++e) {
                const float band = 1e-4f + (float)e * ((15.0f - 1e-4f) / 15.0f);
                const float ang = base * band;
                s1 += cosf(ang) * w1[(1 + e) * 64 + j] - sinf(ang) * w1[(17 + e) * 64 + j];
            }
            lf[pl * 64 + j] = sinf(fj * (s1 + b1[j]));
            __syncthreads();
            float s2 = 0.f;
            for (int i = 0; i < 64; ++i) s2 += lf[pl * 64 + i] * w2[i * 64 + j];
            hid2[pos * 64 + j] = sinf(fj * (s2 + b2[j]));
            __syncthreads();
        }
    }
}

__device__ void transpose_unit(const float* src, int ldn, int n0src, bf16_t* dst, int nb, int kb, float* tile) {
    const int tid = tid_opaque(), r = tid >> 4, c4 = tid & 15;
#pragma unroll
    for (int i = 0; i < 4; ++i) {
        const int kk = i * 32 + r;
        f32x4 v = (f32x4){0.f, 0.f, 0.f, 0.f};
        if (n0src >= 0) v = *(const f32x4*)(src + (size_t)(kb * 128 + kk) * ldn + n0src + c4 * 4);
        float* t = tile + kk * 65 + c4 * 4; t[0] = v.x; t[1] = v.y; t[2] = v.z; t[3] = v.w;
    }
    __syncthreads();
#pragma unroll
    for (int i = 0; i < 2; ++i) {
        const int chunk = tid + i * NT, nr = chunk >> 4, kc = chunk & 15;
        const float* t = tile + (kc * 8) * 65 + nr;
        u32x4 w; w.x = pk2(t[0], t[65]); w.y = pk2(t[130], t[195]); w.z = pk2(t[260], t[325]); w.w = pk2(t[390], t[455]);
        *(u32x4*)(dst + (size_t)(nb * 64 + nr) * 2048 + kb * 128 + kc * 8) = w;
    }
    __syncthreads();
}
__device__ __forceinline__ int win_colmap(int np) {
    if (np < 6144) return np;
    if (np < 6208) return 8192 + (np - 6144);
    if (np < 6400) return -1;
    if (np < 12544) return 8256 + (np - 6400);
    if (np < 14592) return 6144 + (np - 12544);
    return 14400 + (np - 14592);
}
__device__ void p0_transposes(KA a, float* lf) {
    bf16_t* WT = (bf16_t*)(a->ws + WS_WT); bf16_t* SW = (bf16_t*)(a->ws + WS_SW);
    const int NU_WT = (WT_ROWS / 64) * 16, NU_SW = 4 * 32 * 16;
    for (int u = blockIdx.x; u < NU_WT + NU_SW; u += gridDim.x) {
        if (u < NU_WT) { const int nb = u >> 4, kb = u & 15; transpose_unit(a->in[6], 18496, win_colmap(nb * 64), WT, nb, kb, lf); }
        else { const int v = u - NU_WT, mtx = v >> 9, nb = (v >> 4) & 31, kb = v & 15;
            const float* src = (mtx == 0) ? a->in[20] : (mtx == 1) ? a->in[21] : (mtx == 2) ? a->in[22] : a->in[25];
            transpose_unit(src, 2048, nb * 64, SW + (size_t)mtx * 2048 * 2048, nb, kb, lf); }
    }
}

__device__ void p1_ha(KA a) {
    const float* mod = (const float*)(a->ws + WS_MOD); bf16_t* HA = (bf16_t*)(a->ws + WS_HA);
    const size_t nthr = (size_t)gridDim.x * NT;
    for (size_t i = (size_t)blockIdx.x * NT + tid_opaque(); i < (size_t)MA * 256; i += nthr) {
        const int row = (int)(i >> 8), k8 = (int)(i & 255) * 8;
        const float* sp; int mr;
        if (row < MT) { sp = a->in[0] + (size_t)row * 2048 + k8; mr = row >> 12; } else { sp = a->in[2] + (size_t)(row - MT) * 2048 + k8; mr = 4; }
        const f32x4 x0 = *(const f32x4*)sp, x1 = *(const f32x4*)(sp + 4);
        const float* mp = mod + mr * 12288 + k8;
        const f32x4 h0 = *(const f32x4*)mp, h1 = *(const f32x4*)(mp + 4), s0 = *(const f32x4*)(mp + 2048), s1 = *(const f32x4*)(mp + 2052);
        float v[8];
#pragma unroll
        for (int e = 0; e < 4; ++e) { v[e] = x0[e] * (1.0f + s0[e]) + h0[e]; v[4 + e] = x1[e] * (1.0f + s1[e]) + h1[e]; }
        *(u32x4*)(HA + (size_t)row * 2048 + k8) = pack8(v);
    }
}

struct FStoreBf16 { bf16_t* O; int ldc;
    __device__ __forceinline__ void operator()(int row, int col, const f32x4 v0, const f32x4 v1) const {
        u32x4 w; w.x = pg8::cvt_pk_bf16(v0[0], v0[1]); w.y = pg8::cvt_pk_bf16(v0[2], v0[3]); w.z = pg8::cvt_pk_bf16(v1[0], v1[1]); w.w = pg8::cvt_pk_bf16(v1[2], v1[3]);
        *(u32x4*)(O + (size_t)row * ldc + col) = w; } };
struct FStoreQKV { bf16_t* PQ; float* AB;
    __device__ __forceinline__ void operator()(int row, int col, const f32x4 v0, const f32x4 v1) const {
        if (col < 6144) { u32x4 w; w.x = pg8::cvt_pk_bf16(v0[0], v0[1]); w.y = pg8::cvt_pk_bf16(v0[2], v0[3]); w.z = pg8::cvt_pk_bf16(v1[0], v1[1]); w.w = pg8::cvt_pk_bf16(v1[2], v1[3]);
            *(u32x4*)(PQ + (size_t)row * PQ_LD + col) = w; }
        else if (col < 6208) { float* p = AB + (size_t)row * 64 + (col - 6144); *(f32x4*)p = v0; *(f32x4*)(p + 4) = v1; } } };
struct FStoreF32 { float* O; int ldc;
    __device__ __forceinline__ void operator()(int row, int col, const f32x4 v0, const f32x4 v1) const { float* p = O + (size_t)row * ldc + col; *(f32x4*)p = v0; *(f32x4*)(p + 4) = v1; } };
struct FGatePA { const bf16_t* ZG; bf16_t* MG;
    __device__ __forceinline__ void operator()(int row, int col, const f32x4 v0, const f32x4 v1) const {
        float g[8]; unpack8(*(const u32x4*)(ZG + (size_t)row * NZG + 2048 + col), g);
        float o[8];
#pragma unroll
        for (int e = 0; e < 4; ++e) { o[e] = sigmoidf_(g[e]) * v0[e]; o[4 + e] = sigmoidf_(g[4 + e]) * v1[e]; }
        *(u32x4*)(MG + (size_t)row * 2048 + col) = pack8(o); } };
struct FGatePH { const bf16_t* ZG; bf16_t* MG;
    __device__ __forceinline__ void operator()(int row, int col, const f32x4 v0, const f32x4 v1) const {
        float g[8], t[8]; unpack8(*(const u32x4*)(ZG + (size_t)row * NZG + 4096 + col), g); unpack8(*(const u32x4*)(MG + (size_t)row * 2048 + col), t);
        float o[8];
#pragma unroll
        for (int e = 0; e < 4; ++e) { o[e] = t[e] + sigmoidf_(g[e]) * v0[e]; o[4 + e] = t[4 + e] + sigmoidf_(g[4 + e]) * v1[e]; }
        *(u32x4*)(MG + (size_t)row * 2048 + col) = pack8(o); } };
struct FOut { const float* x; const float* mod; float* T3;
    __device__ __forceinline__ void operator()(int row, int col, const f32x4 v0, const f32x4 v1) const {
        const float* xp = x + (size_t)row * 2048 + col; const float* gp = mod + (row >> 12) * 12288 + 4096 + col;
        const f32x4 x0 = *(const f32x4*)xp, x1 = *(const f32x4*)(xp + 4), g0 = *(const f32x4*)gp, g1 = *(const f32x4*)(gp + 4);
        float* p = T3 + (size_t)row * 2048 + col;
#if DBG_MODE == 1
        *(f32x4*)p = ALPHA * x0; *(f32x4*)(p + 4) = ALPHA * x1;
#else
        *(f32x4*)p = ALPHA * x0 + g0 * v0; *(f32x4*)(p + 4) = ALPHA * x1 + g1 * v1;
#endif
    } };

template <class F> __device__ __forceinline__ void run_gemm(unsigned char* lds, const bf16_t* A, const bf16_t* Bt, int M, int N, const F& f) {
    pg8::Gemm g{A, Bt, M, N, 2048}; pg8::StaticOrder S; S.init(M, N, (int)gridDim.x, (int)blockIdx.x);
    pg8::EpiGen<F> E{f};
    pg8::gemm_phase<pg8::EpiGen<F>, pg8::StaticOrder, true, true>((PG8_LAS unsigned char*)lds, g, S, E);
}

typedef float f32x2 __attribute__((ext_vector_type(2)));
constexpr int HY_Z = 0, HY_F = 69632, HY_TW4 = 139264, HY_TW8 = 141312, HY_TW32 = 143360, HY_W3 = 143488;
__device__ __forceinline__ f32x2 cmul(const f32x2 a, const f32x2 b) { return (f32x2){a.x * b.x - a.y * b.y, a.x * b.y + a.y * b.x}; }
__device__ __forceinline__ f32x2 cmulc(const f32x2 a, const f32x2 b) { return (f32x2){a.x * b.x + a.y * b.y, a.y * b.x - a.x * b.y}; }
template <bool INV> __device__ __forceinline__ f32x2 ctw(const f32x2 v, const float wr, const float wi) {
    return INV ? (f32x2){v.x * wr + v.y * wi, v.y * wr - v.x * wi} : (f32x2){v.x * wr - v.y * wi, v.y * wr + v.x * wi};
}
template <bool INV> __device__ __forceinline__ void dft16(f32x2 (&x)[16]) {
    constexpr float C = 0.9238795325112867f, S = 0.3826834323650898f, R = 0.7071067811865476f;
    f32x2 A[4][4];
#pragma unroll
    for (int q0 = 0; q0 < 4; ++q0) {
        const f32x2 a = x[q0], b = x[4 + q0], c = x[8 + q0], d = x[12 + q0];
        const f32x2 t0 = a + c, t1 = a - c, t2 = b + d, t3 = b - d;
        const f32x2 m = (f32x2){t3.y, -t3.x};
        A[q0][0] = t0 + t2; A[q0][2] = t0 - t2;
        A[q0][1] = INV ? (t1 - m) : (t1 + m); A[q0][3] = INV ? (t1 + m) : (t1 - m);
    }
    A[1][1] = ctw<INV>(A[1][1], C, -S); A[1][2] = ctw<INV>(A[1][2], R, -R); A[1][3] = ctw<INV>(A[1][3], S, -C);
    A[2][1] = ctw<INV>(A[2][1], R, -R); A[2][2] = ctw<INV>(A[2][2], 0.f, -1.f); A[2][3] = ctw<INV>(A[2][3], -R, -R);
    A[3][1] = ctw<INV>(A[3][1], S, -C); A[3][2] = ctw<INV>(A[3][2], -R, -R); A[3][3] = ctw<INV>(A[3][3], -C, S);
#pragma unroll
    for (int s = 0; s < 4; ++s) {
        const f32x2 t0 = A[0][s] + A[2][s], t1 = A[0][s] - A[2][s], t2 = A[1][s] + A[3][s], t3 = A[1][s] - A[3][s];
        const f32x2 m = (f32x2){t3.y, -t3.x};
        x[s] = t0 + t2; x[s + 8] = t0 - t2;
        x[s + 4] = INV ? (t1 - m) : (t1 + m); x[s + 12] = INV ? (t1 + m) : (t1 - m);
    }
}
template <bool INV> __device__ __forceinline__ void apply_tw(f32x2 (&x)[16], const f32x2 w) {
    f32x2 wr = w;
#pragma unroll
    for (int r = 1; r < 16; ++r) { x[r] = INV ? cmulc(x[r], wr) : cmul(x[r], wr); if (r < 15) wr = cmul(wr, w); }
}
__device__ __forceinline__ void fft_pass2_fwd(f32x2* B, int t, const f32x2* TW4) {
    const int base = 272 * (t >> 4) + (t & 15); f32x2 x[16];
#pragma unroll
    for (int q = 0; q < 16; ++q) x[q] = B[base + 17 * q];
    dft16<false>(x); apply_tw<false>(x, TW4[16 * (t & 15)]);
#pragma unroll
    for (int q = 0; q < 16; ++q) B[base + 17 * q] = x[q];
}
__device__ __forceinline__ void fft_pass2_inv(f32x2* B, int t, const f32x2* TW4) {
    const int base = 272 * (t >> 4) + (t & 15); f32x2 x[16];
#pragma unroll
    for (int q = 0; q < 16; ++q) x[q] = B[base + 17 * q];
    apply_tw<true>(x, TW4[16 * (t & 15)]); dft16<true>(x);
#pragma unroll
    for (int q = 0; q < 16; ++q) B[base + 17 * q] = x[q];
}
__device__ __forceinline__ float conv3_lane(float c, int lane, float w0, float w1, float w2) {
    (void)lane;
    const float up = __builtin_bit_cast(float, __builtin_amdgcn_update_dpp(0, __builtin_bit_cast(int, c), 0x138, 0xf, 0xf, true));
    const float dn = __builtin_bit_cast(float, __builtin_amdgcn_update_dpp(0, __builtin_bit_cast(int, c), 0x130, 0xf, 0xf, true));
    return w0 * up + w1 * c + w2 * dn;
}
constexpr size_t WS_FILT = 585 * MiB;
__device__ void filt_unit(KA a, int unit, unsigned char* lds) {
    const int tid = tid_opaque(), lane = tid & 63, w = tid >> 6, fr = lane & 15, fq = lane >> 4;
    const int c0 = (unit >> 3) * 64, pc = (unit & 7) * 512;
    bf16_t* Bt = (bf16_t*)lds;
    const float* w3 = a->in[16]; const float* b3 = a->in[17]; const float* hid2 = (const float*)(a->ws + WS_HID2);
    bf16_t* FILT = (bf16_t*)(a->ws + WS_FILT);
    __syncthreads();
#pragma unroll
    for (int i = 0; i < 8; ++i) {
        const int idx = tid + i * NT, k = idx >> 6, q = (idx >> 4) & 3, c4 = idx & 15;
        const f32x4 v = *(const f32x4*)(w3 + (size_t)k * 8192 + (q >> 1) * 4096 + (q & 1) * 2048 + c0 + c4 * 4);
        bf16_t* bp = Bt + (q * 64 + c4 * 4) * 72 + k;
        bp[0] = (bf16_t)f2bf(v.x); bp[72] = (bf16_t)f2bf(v.y); bp[144] = (bf16_t)f2bf(v.z); bp[216] = (bf16_t)f2bf(v.w);
    }
    __syncthreads();
#pragma unroll 1
    for (int it = 0; it < 4; ++it) {
        const int p0 = pc + (it * 8 + w) * 16;
        bf16x8 af[2];
#pragma unroll
        for (int kk = 0; kk < 2; ++kk) { const float* hp = hid2 + (size_t)(p0 + fr) * 64 + kk * 32 + fq * 8; const f32x4 x0 = *(const f32x4*)hp, x1 = *(const f32x4*)(hp + 4);
            u32x4 wv; wv.x = pk2(x0[0], x0[1]); wv.y = pk2(x0[2], x0[3]); wv.z = pk2(x1[0], x1[1]); wv.w = pk2(x1[2], x1[3]); af[kk] = __builtin_bit_cast(bf16x8, wv); }
#pragma unroll 4
        for (int n = 0; n < 16; ++n) {
            f32x4 acc = (f32x4){0.f, 0.f, 0.f, 0.f};
#pragma unroll
            for (int kk = 0; kk < 2; ++kk) acc = MFMA16(af[kk], *(const bf16x8*)(Bt + (n * 16 + fr) * 72 + kk * 32 + fq * 8), acc);
            const int q = n >> 2, c = c0 + (n & 3) * 16 + fr;
            const float bias = b3[(q >> 1) * 4096 + (q & 1) * 2048 + c];
            const float dl = (3.0701134573253944f + 12.280453829301578f * ((float)c * (1.0f / 2047.0f))) * (1.0f / 4095.0f);
            const int pos = p0 + 4 * fq;
            const float e0 = expf(-(float)pos * dl), e1 = expf(-(float)(pos + 1) * dl), e2 = expf(-(float)(pos + 2) * dl), e3 = expf(-(float)(pos + 3) * dl);
            *(u32x2*)(FILT + ((size_t)c * 4 + q) * 4096 + pos) = pk4((acc[0] + bias) * e0, (acc[1] + bias) * e1, (acc[2] + bias) * e2, (acc[3] + bias) * e3);
        }
    }
}
__device__ void hyena_setup(unsigned char* lds) {
    const int tid = tid_opaque();
    f32x2* TW4 = (f32x2*)(lds + HY_TW4); f32x2* TW8 = (f32x2*)(lds + HY_TW8); f32x2* TW32 = (f32x2*)(lds + HY_TW32);
    if (tid < 256) { const float a4 = -6.283185307179586f * (float)tid * (1.0f / 4096.0f), a8 = -6.283185307179586f * (float)tid * (1.0f / 8192.0f);
        TW4[tid] = (f32x2){cosf(a4), sinf(a4)}; TW8[tid] = (f32x2){cosf(a8), sinf(a8)}; }
    if (tid < 16) { const float a = -6.283185307179586f * (float)tid * (1.0f / 32.0f); TW32[tid] = (f32x2){cosf(a), sinf(a)}; }
    __syncthreads();
}
struct HyCtx { f32x2* Z; f32x2* Fb0; const f32x2* TW4; const f32x2* TW32; const bf16_t* rv; const bf16_t* rx1; const bf16_t* rx2; bf16_t* YTc; float* Y1S;
    f32x2 w8t, w4t; float cv0, cv1, cv2, cx0, cx1, cx2, cy0, cy1, cy2, sk0, sk1; int tid, br, t, lane, p1; };
template <int ORDER> __device__ __forceinline__ void hyena_conv(const HyCtx& K, int pr) {
    f32x2* Z = K.Z; const f32x2* TW4 = K.TW4; const f32x2* TW32 = K.TW32;
    const bf16_t* rv = K.rv; const bf16_t* rx1 = K.rx1; const bf16_t* rx2 = K.rx2; float* Y1S = K.Y1S;
    int tid = K.tid; asm volatile("" : "+v"(tid));
    const f32x2 w8t = K.w8t, w4t = K.w4t; const int br = tid >> 8, t = tid & 255, lane = tid & 63, p1 = t + (t >> 4);
    f32x2* Zb = K.Z + br * 4352; f32x2* Fb = K.Fb0 + br * 4352;
    const float cv0 = K.cv0, cv1 = K.cv1, cv2 = K.cv2, cx0 = K.cx0, cx1 = K.cx1, cx2 = K.cx2, cy0 = K.cy0, cy1 = K.cy1, cy2 = K.cy2, sk0 = K.sk0, sk1 = K.sk1;
        const int ba = 2 * pr * 4096, bb = ba + 4096;
        {
            f32x2 x[16];
#pragma unroll
            for (int q = 0; q < 16; ++q) {
                const int n = t + 256 * q; float ua, ub;
                if (ORDER == 0) { ua = conv3_lane(bf2f(rv[ba + n]), lane, cv0, cv1, cv2); ub = conv3_lane(bf2f(rv[bb + n]), lane, cv0, cv1, cv2); }
                else { ua = Y1S[n]; ub = Y1S[4096 + n]; }
                const f32x2 z = (f32x2){ua, ub};
                x[q] = br ? cmul(z, cmul(w8t, TW32[q])) : z;
            }
            dft16<false>(x); apply_tw<false>(x, w4t);
#pragma unroll
            for (int q = 0; q < 16; ++q) Zb[p1 + 272 * q] = x[q];
        }
        __syncthreads();
        fft_pass2_fwd(Zb, t, TW4);
        __syncthreads();
        {
            f32x2 x[16];
#pragma unroll
            for (int q = 0; q < 16; ++q) x[q] = Zb[17 * t + q];
            dft16<false>(x);
#pragma unroll
            for (int r = 0; r < 16; ++r) {
                const int p = 16 * t + r; int pp;
                if (br) pp = 4095 - p;
                else { const int m = (r << 8) | ((t & 15) << 4) | (t >> 4); const int mp = (4096 - m) & 4095; pp = ((mp & 15) << 8) | (mp & 0xF0) | (mp >> 8); }
                const f32x2 fk = Fb[p + (p >> 4)], fc = Fb[pp + (pp >> 4)];
                f32x2 H;
                if (ORDER == 0) H = (f32x2){0.5f * (fk.x + fc.x), 0.5f * (fk.y - fc.y)};
                else H = (f32x2){0.5f * (fk.y + fc.y), -0.5f * (fk.x - fc.x)};
                x[r] = cmul(x[r], H);
            }
            dft16<true>(x);
#pragma unroll
            for (int q = 0; q < 16; ++q) Zb[17 * t + q] = x[q];
        }
        __syncthreads();
        fft_pass2_inv(Zb, t, TW4);
        __syncthreads();
        {
            f32x2 x[16];
#pragma unroll
            for (int q = 0; q < 16; ++q) x[q] = Zb[p1 + 272 * q];
            apply_tw<true>(x, w4t); dft16<true>(x);
            if (br) {
#pragma unroll
                for (int q = 0; q < 16; ++q) x[q] = cmulc(x[q], cmul(w8t, TW32[q]));
            }
#pragma unroll
            for (int q = 0; q < 16; ++q) Zb[p1 + 272 * q] = x[q];
        }
        __syncthreads();
#pragma unroll
        for (int i = 0; i < 8; ++i) {
            const int n = tid + i * NT, pn = n + (n >> 4);
            const f32x2 e0 = Z[pn], e1 = Z[4352 + pn];
            const float ca = (e0.x + e1.x) * (1.0f / 8192.0f), cb = (e0.y + e1.y) * (1.0f / 8192.0f);
            if (ORDER == 0) {
                const float va = conv3_lane(bf2f(rv[ba + n]), lane, cv0, cv1, cv2), vb = conv3_lane(bf2f(rv[bb + n]), lane, cv0, cv1, cv2);
                const float xa = conv3_lane(bf2f(rx1[ba + n]), lane, cx0, cx1, cx2), xb = conv3_lane(bf2f(rx1[bb + n]), lane, cx0, cx1, cx2);
                Y1S[n] = xa * (ca + sk0 * va); Y1S[4096 + n] = xb * (cb + sk0 * vb);
            } else {
                const float ya = Y1S[n], yb = Y1S[4096 + n];
                const float xa = conv3_lane(bf2f(rx2[ba + n]), lane, cy0, cy1, cy2), xb = conv3_lane(bf2f(rx2[bb + n]), lane, cy0, cy1, cy2);
                K.YTc[ba + n] = (bf16_t)f2bf(xa * (ca + sk1 * ya)); K.YTc[bb + n] = (bf16_t)f2bf(xb * (cb + sk1 * yb));
            }
        }
        __syncthreads();
}
__device__ void hyena_item(KA a, int c, unsigned char* lds) {
    f32x2* Z = (f32x2*)(lds + HY_Z); f32x2* F = (f32x2*)(lds + HY_F);
    const f32x2* TW4 = (const f32x2*)(lds + HY_TW4); const f32x2* TW8 = (const f32x2*)(lds + HY_TW8); const f32x2* TW32 = (const f32x2*)(lds + HY_TW32);
    float* W3 = (float*)(lds + HY_W3);
    int tid = tid_opaque(); asm volatile("" : "+v"(tid));
    const int br = tid >> 8, t = tid & 255, lane = tid & 63;
    f32x2* Zb = Z + br * 4352; f32x2* Fb = F + br * 4352;
    const float* hid2 = (const float*)(a->ws + WS_HID2);
    const float* w3 = a->in[16]; const float* b3 = a->in[17]; const float* cw = a->in[11]; const float* skip = a->in[19];
    const bf16_t* PHT = (const bf16_t*)(a->ws + WS_RA);
    bf16_t* YT = (bf16_t*)a->out;
    float* Y1S = a->out + (size_t)16 * 1024 * 1024 + (size_t)blockIdx.x * 16384;
    {
        const bf16_t* fp = (const bf16_t*)(a->ws + WS_FILT) + (size_t)c * 4 * 4096 + tid * 8;
        float f0[8], f1[8], f2[8], f3[8];
        unpack8(*(const u32x4*)fp, f0); unpack8(*(const u32x4*)(fp + 4096), f1); unpack8(*(const u32x4*)(fp + 8192), f2); unpack8(*(const u32x4*)(fp + 12288), f3);
#pragma unroll
        for (int e = 0; e < 8; ++e) { Z[tid * 8 + e] = (f32x2){f0[e], f1[e]}; Z[4096 + tid * 8 + e] = (f32x2){f2[e], f3[e]}; }
    }
    __syncthreads();
    const f32x2 w8t = TW8[t], w4t = TW4[t];
    const int p1 = t + (t >> 4);
    {
        f32x2 x[16];
#pragma unroll
        for (int q = 0; q < 16; ++q) {
            const int n = t + 256 * q;
            const f32x2 av = Z[n]; f32x2 bv = Z[8192 - (n ? n : 1)]; if (n == 0) bv = (f32x2){0.f, 0.f};
            x[q] = br ? cmul(av - bv, cmul(w8t, TW32[q])) : (av + bv);
        }
        dft16<false>(x); apply_tw<false>(x, w4t);
#pragma unroll
        for (int q = 0; q < 16; ++q) Fb[p1 + 272 * q] = x[q];
    }
    __syncthreads();
    fft_pass2_fwd(Fb, t, TW4);
    __syncthreads();
    {   f32x2 x[16];
#pragma unroll
        for (int q = 0; q < 16; ++q) x[q] = Fb[17 * t + q];
        dft16<false>(x);
#pragma unroll
        for (int q = 0; q < 16; ++q) Fb[17 * t + q] = x[q];
    }
    __syncthreads();
    const float cv0 = cw[c], cv1 = cw[6144 + c], cv2 = cw[12288 + c];
    const float cx0 = cw[2048 + c], cx1 = cw[6144 + 2048 + c], cx2 = cw[12288 + 2048 + c];
    const float cy0 = cw[4096 + c], cy1 = cw[6144 + 4096 + c], cy2 = cw[12288 + 4096 + c];
    const float sk0 = skip[c], sk1 = skip[2048 + c];
    const bf16_t* rv = PHT + (size_t)c * MT; const bf16_t* rx1 = PHT + (size_t)(2048 + c) * MT; const bf16_t* rx2 = PHT + (size_t)(4096 + c) * MT;
    HyCtx K; K.Z = Z; K.Fb0 = F; K.TW4 = TW4; K.TW32 = TW32; K.rv = rv; K.rx1 = rx1; K.rx2 = rx2; K.YTc = YT + (size_t)c * MT; K.Y1S = Y1S;
    K.w8t = w8t; K.w4t = w4t; K.cv0 = cv0; K.cv1 = cv1; K.cv2 = cv2; K.cx0 = cx0; K.cx1 = cx1; K.cx2 = cx2; K.cy0 = cy0; K.cy1 = cy1; K.cy2 = cy2; K.sk0 = sk0; K.sk1 = sk1;
    K.tid = tid; K.br = br; K.t = t; K.lane = lane; K.p1 = p1;
#pragma unroll 1
    for (int pr = 0; pr < 2; ++pr) { hyena_conv<0>(K, pr); hyena_conv<1>(K, pr); }
}

__device__ void qkvpost_unit(KA a, int unit, unsigned char* lds) {
    const int tid = tid_opaque();
    int ntok, row0, wh;
    if (unit < 12288) { const int gr = unit / 48; wh = unit % 48; ntok = 64; row0 = gr * 64; }
    else { const int uu = unit - 12288; const int b = uu / 48; wh = uu % 48; ntok = 256; row0 = MT + b * 256; }
    const int which = wh >> 4, h = wh & 15, colbase = which * 2048 + h * 128;
    bf16_t* PQ = (bf16_t*)(a->ws + WS_RB);
    bf16_t* raw = (bf16_t*)lds; float* wl = (float*)(lds + 65536);
    const float* cwt = a->in[7];
    for (int i = tid; i < ntok * 16; i += NT) { const int r = i >> 4, c8 = i & 15; *(u32x4*)(raw + r * 128 + c8 * 8) = *(const u32x4*)(PQ + (size_t)(row0 + r) * PQ_LD + colbase + c8 * 8); }
    for (int i = tid; i < 640; i += NT) wl[i] = cwt[(i >> 7) * 6144 + colbase + (i & 127)];
    __syncthreads();
    const int r = tid >> 3, cg = tid & 7;
    for (int rb = 0; rb < ntok / 64; ++rb) {
        const int tok = rb * 64 + r;
        float v[16]; float ss = 0.f;
#pragma unroll
        for (int e = 0; e < 16; ++e) {
            const int ch = cg * 16 + e; float acc = 0.f;
#pragma unroll
            for (int j = 0; j < 5; ++j) { const int tt = tok + j - 2; if (tt >= 0 && tt < ntok) acc += wl[j * 128 + ch] * bf2f(raw[tt * 128 + ch]); }
            const float s = siluf_(acc); v[e] = s; ss += s * s;
        }
        if (which < 2) {
            ss += __shfl_xor(ss, 1, 64); ss += __shfl_xor(ss, 2, 64); ss += __shfl_xor(ss, 4, 64);
            const float sc = rsqrtf(ss + 1e-6f) * (which == 0 ? 0.08838834764831845f : 1.0f);
#pragma unroll
            for (int e = 0; e < 16; ++e) v[e] *= sc;
        }
        bf16_t* op = PQ + (size_t)(row0 + tok) * PQ_LD + colbase + cg * 16;
        u32x4 w0, w1;
        w0.x = pk2(v[0], v[1]); w0.y = pk2(v[2], v[3]); w0.z = pk2(v[4], v[5]); w0.w = pk2(v[6], v[7]);
        w1.x = pk2(v[8], v[9]); w1.y = pk2(v[10], v[11]); w1.z = pk2(v[12], v[13]); w1.w = pk2(v[14], v[15]);
        *(u32x4*)op = w0; *(u32x4*)(op + 8) = w1;
    }
    __syncthreads();
}

typedef short bf16x8 __attribute__((ext_vector_type(8)));
constexpr size_t WS_TS = 585 * MiB, WS_GCB = 653 * MiB;

__device__ void tprep_wave(KA a, int pid, unsigned char* wl) {
    const int lane = tid_opaque() & 63, fr = lane & 15, fq = lane >> 4;
    const int sid = pid / 68, cidx = pid - sid * 68, dir = sid & 1, h = (sid >> 1) & 15, b = sid >> 5;
    bf16_t* kt = (bf16_t*)wl; float* Mf = (float*)wl; float* gcs = (float*)(wl + 17408); float* bes = gcs + 64;
    const bf16_t* PQ = (const bf16_t*)(a->ws + WS_RB); const float* AB = (const float*)(a->ws + WS_AB);
    bf16_t* TS = (bf16_t*)(a->ws + WS_TS) + (size_t)pid * 4096; float* GCB = (float*)(a->ws + WS_GCB) + (size_t)pid * 128;
    int rbase, Tn, p0;
    if (cidx < 4) { rbase = MT + b * CTXL; Tn = CTXL; p0 = cidx * 64; } else { rbase = b * SEQ; Tn = SEQ; p0 = (cidx - 4) * 64; }
    {
        u32x4 kv[16];
#pragma unroll
        for (int it = 0; it < 16; ++it) {
            const int i = it * 4 + fq, p = p0 + i, tok = dir ? (Tn - 1 - p) : p;
            kv[it] = *(const u32x4*)(PQ + (size_t)(rbase + tok) * PQ_LD + 2048 + h * 128 + fr * 8);
        }
#pragma unroll
        for (int it = 0; it < 16; ++it) *(u32x4*)(kt + (it * 4 + fq) * 136 + fr * 8) = kv[it];
    }
    {
        const int p = p0 + lane, tok = dir ? (Tn - 1 - p) : p; const size_t row = (size_t)(rbase + tok);
        const float ab0 = AB[row * 64 + dir * 32 + h], ab1 = AB[row * 64 + dir * 32 + 16 + h];
        const float xx = ab0 + a->in[9][dir * 16 + h]; const float sp = (xx > 20.0f) ? xx : log1pf(expf(xx));
        float gc = -expf(a->in[8][dir * 16 + h]) * sp;
#pragma unroll
        for (int o = 1; o < 64; o <<= 1) { const float tt = __shfl_up(gc, o, 64); if (lane >= o) gc += tt; }
        const float be = sigmoidf_(ab1);
        gcs[lane] = gc; bes[lane] = be; GCB[lane] = gc; GCB[64 + lane] = be;
    }
    f32x4 acc[10];
#pragma unroll
    for (int i = 0; i < 10; ++i) acc[i] = (f32x4){0.f, 0.f, 0.f, 0.f};
#pragma unroll
    for (int kk = 0; kk < 4; ++kk) {
        bf16x8 fg[4];
#pragma unroll
        for (int ct = 0; ct < 4; ++ct) fg[ct] = *(const bf16x8*)(kt + (ct * 16 + fr) * 136 + kk * 32 + fq * 8);
#pragma unroll
        for (int ct = 0; ct < 4; ++ct)
#pragma unroll
            for (int mt = 0; mt <= ct; ++mt) acc[ct * (ct + 1) / 2 + mt] = MFMA16(fg[ct], fg[mt], acc[ct * (ct + 1) / 2 + mt]);
    }
    float gcr[4][4], ber[4][4];
#pragma unroll
    for (int ct = 0; ct < 4; ++ct)
#pragma unroll
        for (int r = 0; r < 4; ++r) { gcr[ct][r] = gcs[ct * 16 + 4 * fq + r]; ber[ct][r] = bes[ct * 16 + 4 * fq + r]; }
    float gcm[4];
#pragma unroll
    for (int mt = 0; mt < 4; ++mt) gcm[mt] = gcs[mt * 16 + fr];
    asm volatile("s_waitcnt lgkmcnt(0)" ::: "memory");
#pragma unroll
    for (int ct = 0; ct < 4; ++ct)
#pragma unroll
        for (int mt = 0; mt < 4; ++mt)
#pragma unroll
            for (int r = 0; r < 4; ++r) {
                const int c = ct * 16 + 4 * fq + r, m = mt * 16 + fr;
                float val = 0.0f;
                if (mt <= ct) val = (m < c) ? ber[ct][r] * acc[(mt <= ct) ? (ct * (ct + 1) / 2 + mt) : 0][r] * expf(gcr[ct][r] - gcm[mt]) : 0.0f;
                Mf[c * 68 + m] = val;
            }
    asm volatile("s_waitcnt lgkmcnt(0)" ::: "memory");
    Mf[lane] = (lane == 0) ? 1.0f : 0.0f;
    asm volatile("s_waitcnt lgkmcnt(0)" ::: "memory");
#define TSUB_ROWS(NCH, I0, I1) \
    _Pragma("unroll 1") for (int i = (I0); i < (I1); ++i) { \
        const float* mr = Mf + i * 68; float s0 = 0.f, s1 = 0.f, s2 = 0.f, s3 = 0.f; \
        _Pragma("unroll") for (int ch = 0; ch < (NCH); ++ch) { \
            const f32x4 ma = *(const f32x4*)(mr + ch * 16), mb = *(const f32x4*)(mr + ch * 16 + 4), mc = *(const f32x4*)(mr + ch * 16 + 8), md = *(const f32x4*)(mr + ch * 16 + 12); \
            const float* tp = Mf + ch * 16 * 68 + lane; \
            s0 -= ma.x * tp[0]; s1 -= ma.y * tp[68]; s2 -= ma.z * tp[136]; s3 -= ma.w * tp[204]; s0 -= mb.x * tp[272]; s1 -= mb.y * tp[340]; s2 -= mb.z * tp[408]; s3 -= mb.w * tp[476]; \
            s0 -= mc.x * tp[544]; s1 -= mc.y * tp[612]; s2 -= mc.z * tp[680]; s3 -= mc.w * tp[748]; s0 -= md.x * tp[816]; s1 -= md.y * tp[884]; s2 -= md.z * tp[952]; s3 -= md.w * tp[1020]; } \
        const float tv = ((s0 + s1) + (s2 + s3)) + ((lane == i) ? 1.0f : 0.0f); \
        asm volatile("s_waitcnt lgkmcnt(0)" ::: "memory"); \
        Mf[i * 68 + lane] = tv; \
        asm volatile("s_waitcnt lgkmcnt(0)" ::: "memory"); }
    TSUB_ROWS(1, 1, 16)
    TSUB_ROWS(2, 16, 32)
    TSUB_ROWS(3, 32, 48)
    TSUB_ROWS(4, 48, 64)
#undef TSUB_ROWS
#pragma unroll
    for (int it = 0; it < 8; ++it) {
        const int row = it * 8 + (lane >> 3), c8 = (lane & 7) * 8;
        const f32x4 x0 = *(const f32x4*)(Mf + row * 68 + c8), x1 = *(const f32x4*)(Mf + row * 68 + c8 + 4);
        u32x4 wv; wv.x = pk2(x0[0], x0[1]); wv.y = pk2(x0[2], x0[3]); wv.z = pk2(x1[0], x1[1]); wv.w = pk2(x1[2], x1[3]);
        *(u32x4*)(TS + row * 64 + c8) = wv;
    }
    asm volatile("s_waitcnt lgkmcnt(0)" ::: "memory");
}

constexpr int DL_QN = 0, DL_KN = 17408, DL_WN = 34816, DL_ST = 52224, DL_KT = 69632, DL_VT = 88064, DL_T1 = 97280, DL_T2 = 106496, DL_AT = 115712, DL_VN = 124928, DL_VD = 134144, DL_GS = 143360;
struct DStage { u32x4 q0, q1, k0, k1, v, t; f32x4 g0, g1, b0, b1; float bi, gl, g63; };
__device__ __forceinline__ void dstage_load(DStage& R, const bf16_t* PQ, const bf16_t* TS, const float* GCB, int sid, int cidx, int dir, int h, int b, int dvh, int tid) {
    const int i = tid >> 3, part = tid & 7;
    int rbase, Tn, p0;
    if (cidx < 4) { rbase = MT + b * CTXL; Tn = CTXL; p0 = cidx * 64; } else { rbase = b * SEQ; Tn = SEQ; p0 = (cidx - 4) * 64; }
    const int p = p0 + i, tok = dir ? (Tn - 1 - p) : p;
    const bf16_t* rp = PQ + (size_t)(rbase + tok) * PQ_LD + h * 128;
    R.q0 = *(const u32x4*)(rp + part * 16); R.q1 = *(const u32x4*)(rp + part * 16 + 8);
    R.k0 = *(const u32x4*)(rp + 2048 + part * 16); R.k1 = *(const u32x4*)(rp + 2048 + part * 16 + 8);
    R.v = *(const u32x4*)(rp + 4096 + dvh * 64 + part * 8);
    const size_t pid = (size_t)sid * 68 + cidx;
    R.t = *(const u32x4*)(TS + pid * 4096 + i * 64 + part * 8);
    const float* gp = GCB + pid * 128;
    R.g0 = *(const f32x4*)(gp + part * 8); R.g1 = *(const f32x4*)(gp + part * 8 + 4);
    R.b0 = *(const f32x4*)(gp + 64 + part * 8); R.b1 = *(const f32x4*)(gp + 64 + part * 8 + 4);
    R.bi = gp[64 + i]; R.gl = gp[tid & 63]; R.g63 = gp[63];
}
__device__ __forceinline__ void dstage_store(const DStage& R, unsigned char* lds, int tid) {
    const int i = tid >> 3, part = tid & 7;
    bf16_t* QN = (bf16_t*)(lds + DL_QN); bf16_t* KN = (bf16_t*)(lds + DL_KN); bf16_t* KT = (bf16_t*)(lds + DL_KT); bf16_t* VT = (bf16_t*)(lds + DL_VT);
    bf16_t* T1 = (bf16_t*)(lds + DL_T1); bf16_t* T2 = (bf16_t*)(lds + DL_T2); float* GS = (float*)(lds + DL_GS);
    *(u32x4*)(QN + i * 136 + part * 16) = R.q0; *(u32x4*)(QN + i * 136 + part * 16 + 8) = R.q1;
    *(u32x4*)(KN + i * 136 + part * 16) = R.k0; *(u32x4*)(KN + i * 136 + part * 16 + 8) = R.k1;
    const unsigned kw[8] = {R.k0.x, R.k0.y, R.k0.z, R.k0.w, R.k1.x, R.k1.y, R.k1.z, R.k1.w};
#pragma unroll
    for (int e = 0; e < 8; ++e) { KT[(part * 16 + 2 * e) * 72 + i] = (bf16_t)(kw[e] & 0xffffu); KT[(part * 16 + 2 * e + 1) * 72 + i] = (bf16_t)(kw[e] >> 16); }
    float v8[8]; unpack8(R.v, v8);
#pragma unroll
    for (int e = 0; e < 8; ++e) VT[(part * 8 + e) * 72 + i] = (bf16_t)f2bf(v8[e]);
    float t8[8]; unpack8(R.t, t8);
    const float gm[8] = {R.g0.x, R.g0.y, R.g0.z, R.g0.w, R.g1.x, R.g1.y, R.g1.z, R.g1.w};
    const float bm[8] = {R.b0.x, R.b0.y, R.b0.z, R.b0.w, R.b1.x, R.b1.y, R.b1.z, R.b1.w};
    float a1[8], a2[8];
#pragma unroll
    for (int e = 0; e < 8; ++e) { a2[e] = t8[e] * bm[e]; a1[e] = a2[e] * expf(gm[e]); }
    *(u32x4*)(T1 + i * 72 + part * 8) = pack8(a1); *(u32x4*)(T2 + i * 72 + part * 8) = pack8(a2);
    if (tid < 64) { GS[tid] = R.gl; GS[64 + tid] = expf(R.gl); GS[128 + tid] = expf(R.g63 - R.gl); }
}
#define LBAR() do { asm volatile("s_waitcnt lgkmcnt(0)" ::: "memory"); __builtin_amdgcn_s_barrier(); asm volatile("" ::: "memory"); } while (0)
__device__ void delta_item(KA a, int item, unsigned char* lds) {
    const int tid = tid_opaque(), lane = tid & 63, w = tid >> 6, fr = lane & 15, fq = lane >> 4;
    const int dvh = item & 1, dir = (item >> 1) & 1, h = (item >> 2) & 15, b = item >> 6, sid = (b * 16 + h) * 2 + dir;
    const bf16_t* PQ = (const bf16_t*)(a->ws + WS_RB); const bf16_t* TS = (const bf16_t*)(a->ws + WS_TS); const float* GCB = (const float*)(a->ws + WS_GCB);
    bf16_t* O = (bf16_t*)(a->ws + WS_RA) + (size_t)dir * MT * 2048;
    const bf16_t* QN = (const bf16_t*)(lds + DL_QN); const bf16_t* KN = (const bf16_t*)(lds + DL_KN); bf16_t* WN = (bf16_t*)(lds + DL_WN); bf16_t* ST = (bf16_t*)(lds + DL_ST);
    const bf16_t* KT = (const bf16_t*)(lds + DL_KT); const bf16_t* VT = (const bf16_t*)(lds + DL_VT); const bf16_t* T1 = (const bf16_t*)(lds + DL_T1); const bf16_t* T2 = (const bf16_t*)(lds + DL_T2);
    bf16_t* AT = (bf16_t*)(lds + DL_AT); bf16_t* VN = (bf16_t*)(lds + DL_VN); bf16_t* VD = (bf16_t*)(lds + DL_VD); const float* GS = (const float*)(lds + DL_GS);
    __syncthreads();
    for (int i = tid; i < 64 * 136 / 2; i += NT) ((unsigned*)ST)[i] = 0u;
    f32x4 sacc[4];
#pragma unroll
    for (int i = 0; i < 4; ++i) sacc[i] = (f32x4){0.f, 0.f, 0.f, 0.f};
    DStage R;
    dstage_load(R, PQ, TS, GCB, sid, 0, dir, h, b, dvh, tid);
#pragma unroll 1
    for (int cidx = 0; cidx < 68; ++cidx) {
        dstage_store(R, lds, tid);
        LBAR();
        if (cidx + 1 < 68) dstage_load(R, PQ, TS, GCB, sid, cidx + 1, dir, h, b, dvh, tid);
#pragma unroll
        for (int ti = 0; ti < 2; ++ti) {
            const int idx = w * 2 + ti, mt = idx >> 2, ct = idx & 3;
            f32x4 acc = (f32x4){0.f, 0.f, 0.f, 0.f};
            if (mt <= ct) {
#pragma unroll
                for (int kk = 0; kk < 4; ++kk) {
                    const bf16x8 af = *(const bf16x8*)(KN + (mt * 16 + fr) * 136 + kk * 32 + fq * 8), bfg = *(const bf16x8*)(QN + (ct * 16 + fr) * 136 + kk * 32 + fq * 8);
                    acc = MFMA16(af, bfg, acc);
                }
            }
            const int c = ct * 16 + fr; const float gcc = GS[c];
            float o4[4];
#pragma unroll
            for (int r = 0; r < 4; ++r) { const int m = mt * 16 + 4 * fq + r; o4[r] = (m <= c) ? acc[r] * expf(gcc - GS[m]) : 0.0f; }
            *(u32x2*)(AT + c * 72 + mt * 16 + 4 * fq) = pk4(o4[0], o4[1], o4[2], o4[3]);
        }
        {
            bf16x8 af[2];
#pragma unroll
            for (int kk = 0; kk < 2; ++kk) af[kk] = *(const bf16x8*)(KT + (w * 16 + fr) * 72 + kk * 32 + fq * 8);
#pragma unroll
            for (int ct = 0; ct < 4; ++ct) {
                f32x4 acc = (f32x4){0.f, 0.f, 0.f, 0.f};
#pragma unroll
                for (int kk = 0; kk < 2; ++kk) acc = MFMA16(af[kk], *(const bf16x8*)(T1 + (ct * 16 + fr) * 72 + kk * 32 + fq * 8), acc);
                *(u32x2*)(WN + (ct * 16 + fr) * 136 + w * 16 + 4 * fq) = pk4(-acc[0], -acc[1], -acc[2], -acc[3]);
            }
        }
        const int ctu = w >> 1, dv0 = 2 * (w & 1);
        f32x4 uacc[2];
        {
            bf16x8 af[2];
#pragma unroll
            for (int kk = 0; kk < 2; ++kk) af[kk] = *(const bf16x8*)(T2 + (ctu * 16 + fr) * 72 + kk * 32 + fq * 8);
#pragma unroll
            for (int j = 0; j < 2; ++j) { uacc[j] = (f32x4){0.f, 0.f, 0.f, 0.f};
#pragma unroll
                for (int kk = 0; kk < 2; ++kk) uacc[j] = MFMA16(af[kk], *(const bf16x8*)(VT + ((dv0 + j) * 16 + fr) * 72 + kk * 32 + fq * 8), uacc[j]); }
        }
        LBAR();
        {
            bf16x8 af[4];
#pragma unroll
            for (int kk = 0; kk < 4; ++kk) af[kk] = *(const bf16x8*)(WN + (ctu * 16 + fr) * 136 + kk * 32 + fq * 8);
            float ed[4];
#pragma unroll
            for (int r = 0; r < 4; ++r) ed[r] = GS[128 + ctu * 16 + 4 * fq + r];
#pragma unroll
            for (int j = 0; j < 2; ++j) {
#pragma unroll
                for (int kk = 0; kk < 4; ++kk) uacc[j] = MFMA16(af[kk], *(const bf16x8*)(ST + ((dv0 + j) * 16 + fr) * 136 + kk * 32 + fq * 8), uacc[j]);
                const int dv = (dv0 + j) * 16 + fr;
                *(u32x2*)(VN + dv * 72 + ctu * 16 + 4 * fq) = pk4(uacc[j][0], uacc[j][1], uacc[j][2], uacc[j][3]);
                *(u32x2*)(VD + dv * 72 + ctu * 16 + 4 * fq) = pk4(uacc[j][0] * ed[0], uacc[j][1] * ed[1], uacc[j][2] * ed[2], uacc[j][3] * ed[3]);
            }
        }
        LBAR();
        {
            const int dvt = w >> 1, c0 = 2 * (w & 1);
            bf16x8 af[4], vf[2];
#pragma unroll
            for (int kk = 0; kk < 4; ++kk) af[kk] = *(const bf16x8*)(ST + (dvt * 16 + fr) * 136 + kk * 32 + fq * 8);
#pragma unroll
            for (int kk = 0; kk < 2; ++kk) vf[kk] = *(const bf16x8*)(VN + (dvt * 16 + fr) * 72 + kk * 32 + fq * 8);
#pragma unroll
            for (int j = 0; j < 2; ++j) {
                const int c = (c0 + j) * 16 + fr;
                f32x4 acc = (f32x4){0.f, 0.f, 0.f, 0.f};
#pragma unroll
                for (int kk = 0; kk < 4; ++kk) acc = MFMA16(af[kk], *(const bf16x8*)(QN + c * 136 + kk * 32 + fq * 8), acc);
                const float eg = GS[64 + c];
                acc = acc * eg;
#pragma unroll
                for (int kk = 0; kk < 2; ++kk) acc = MFMA16(vf[kk], *(const bf16x8*)(AT + c * 72 + kk * 32 + fq * 8), acc);
                if (cidx >= 4) {
                    const int p = (cidx - 4) * 64 + c, tok = dir ? (SEQ - 1 - p) : p;
                    *(u32x2*)(O + (size_t)(b * SEQ + tok) * 2048 + h * 128 + dvh * 64 + dvt * 16 + 4 * fq) = pk4(acc[0], acc[1], acc[2], acc[3]);
                }
            }
        }
        {
            const float eg63 = GS[64 + 63];
            bf16x8 af[2];
#pragma unroll
            for (int kk = 0; kk < 2; ++kk) af[kk] = *(const bf16x8*)(KT + (w * 16 + fr) * 72 + kk * 32 + fq * 8);
#pragma unroll
            for (int j = 0; j < 4; ++j) {
                sacc[j] = sacc[j] * eg63;
#pragma unroll
                for (int kk = 0; kk < 2; ++kk) sacc[j] = MFMA16(af[kk], *(const bf16x8*)(VD + (j * 16 + fr) * 72 + kk * 32 + fq * 8), sacc[j]);
            }
        }
        LBAR();
#pragma unroll
        for (int j = 0; j < 4; ++j) *(u32x2*)(ST + (j * 16 + fr) * 136 + w * 16 + 4 * fq) = pk4(sacc[j][0], sacc[j][1], sacc[j][2], sacc[j][3]);
    }
    __syncthreads();
}

__device__ void ytrans_unit(const bf16_t* YT, bf16_t* Y, int unit, bf16_t* tile) {
    const int tid = tid_opaque(), cb = unit & 31, tb = unit >> 5, r = tid >> 3, c8 = (tid & 7) * 8;
    *(u32x4*)(tile + r * 72 + c8) = *(const u32x4*)(YT + (size_t)(cb * 64 + r) * MT + tb * 64 + c8);
    __syncthreads();
    u32x4 w;
    w.x = (unsigned)tile[(c8 + 0) * 72 + r] | ((unsigned)tile[(c8 + 1) * 72 + r] << 16);
    w.y = (unsigned)tile[(c8 + 2) * 72 + r] | ((unsigned)tile[(c8 + 3) * 72 + r] << 16);
    w.z = (unsigned)tile[(c8 + 4) * 72 + r] | ((unsigned)tile[(c8 + 5) * 72 + r] << 16);
    w.w = (unsigned)tile[(c8 + 6) * 72 + r] | ((unsigned)tile[(c8 + 7) * 72 + r] << 16);
    *(u32x4*)(Y + (size_t)(tb * 64 + r) * 2048 + cb * 64 + c8) = w;
    __syncthreads();
}

__device__ void p6_on(KA a) {
    const bf16_t* OF = (const bf16_t*)(a->ws + WS_RA); const bf16_t* OB = OF + (size_t)MT * 2048;
    const bf16_t* ZG = (const bf16_t*)(a->ws + WS_RB); bf16_t* ON = (bf16_t*)(a->ws + WS_HA);
    const float* nw = a->in[10];
    const size_t nthr = (size_t)gridDim.x * NT;
    for (size_t i = (size_t)blockIdx.x * NT + tid_opaque(); i < (size_t)MT * 256; i += nthr) {
        const int row = (int)(i >> 8), c8 = (int)(i & 255) * 8;
        float f[8], g[8], z[8];
        unpack8(*(const u32x4*)(OF + (size_t)row * 2048 + c8), f); unpack8(*(const u32x4*)(OB + (size_t)row * 2048 + c8), g);
        unpack8(*(const u32x4*)(ZG + (size_t)row * NZG + c8), z);
        float ss = 0.f;
#pragma unroll
        for (int e = 0; e < 8; ++e) { f[e] += g[e]; ss += f[e] * f[e]; }
        ss += __shfl_xor(ss, 1, 64); ss += __shfl_xor(ss, 2, 64); ss += __shfl_xor(ss, 4, 64); ss += __shfl_xor(ss, 8, 64);
        const float rs = rsqrtf(ss * (1.0f / 128.0f) + 1e-6f);
        float o[8];
#pragma unroll
        for (int e = 0; e < 8; ++e) o[e] = f[e] * rs * nw[(c8 & 127) + e] * siluf_(z[e]);
        *(u32x4*)(ON + (size_t)row * 2048 + c8) = pack8(o);
    }
}

constexpr size_t PEER_U8 = 0, PEER_V8 = 32 * MiB, PEER_US = 64 * MiB, PEER_VS = 64 * MiB + 65536;
__device__ void p8_tables(KA a) {
    unsigned char* RAb = a->ws + WS_RA;
    const int lane = tid_opaque() & 63, wv = blockIdx.x * 8 + (tid_opaque() >> 6), nwv = gridDim.x * 8;
    for (int r = wv; r < 32768; r += nwv) {
        const int tab = r >> 14, row = r & 16383;
        const float* sp = (tab ? a->in[28] : a->in[27]) + (size_t)row * 2048;
        f32x4 x[8];
#pragma unroll
        for (int i = 0; i < 2; ++i)
#pragma unroll
            for (int j = 0; j < 4; ++j) x[i * 4 + j] = *(const f32x4*)(sp + i * 1024 + lane * 16 + j * 4);
        float mx = 0.f;
#pragma unroll
        for (int i = 0; i < 8; ++i) mx = fmaxf(mx, fmaxf(fmaxf(fabsf(x[i][0]), fabsf(x[i][1])), fmaxf(fabsf(x[i][2]), fabsf(x[i][3]))));
        mx = wave_max(mx);
        const float sc = (mx > 0.f) ? mx * (1.0f / 127.0f) : 1.0f, inv = 1.0f / sc;
        unsigned char* dp = RAb + (tab ? PEER_V8 : PEER_U8) + (size_t)row * 2048;
#pragma unroll
        for (int i = 0; i < 2; ++i) {
            u32x4 w;
#pragma unroll
            for (int j = 0; j < 4; ++j) {
                const f32x4 v = x[i * 4 + j];
                const unsigned b0 = (unsigned)(__float2int_rn(v[0] * inv) + 128), b1 = (unsigned)(__float2int_rn(v[1] * inv) + 128), b2 = (unsigned)(__float2int_rn(v[2] * inv) + 128), b3 = (unsigned)(__float2int_rn(v[3] * inv) + 128);
                w[j] = (b0 & 255u) | ((b1 & 255u) << 8) | ((b2 & 255u) << 16) | ((b3 & 255u) << 24);
            }
            *(u32x4*)(dp + i * 1024 + lane * 16) = w;
        }
        if (lane == 0) ((float*)(RAb + (tab ? PEER_VS : PEER_US)))[row] = sc;
    }
}

__device__ void p9_ln1(KA a) {
    const float* mod = (const float*)(a->ws + WS_MOD); bf16_t* H2 = (bf16_t*)(a->ws + WS_RA) + (size_t)2 * MT * 2048;
    const float* g = a->in[23]; const float* bb = a->in[24];
    const int lane = tid_opaque() & 63, wv = blockIdx.x * 8 + (tid_opaque() >> 6), nwv = gridDim.x * 8;
    for (int row = wv; row < MT; row += nwv) {
        float* rp = a->out + (size_t)row * 2048;
        float v[32]; float s = 0.f;
#pragma unroll
        for (int i = 0; i < 4; ++i) { const f32x4 x0 = *(const f32x4*)(rp + i * 512 + lane * 8), x1 = *(const f32x4*)(rp + i * 512 + lane * 8 + 4);
#pragma unroll
            for (int e = 0; e < 4; ++e) { v[i * 8 + e] = x0[e]; v[i * 8 + 4 + e] = x1[e]; s += x0[e] + x1[e]; } }
        const float mu = wave_sum(s) * (1.0f / 2048.0f);
        float q = 0.f;
#pragma unroll
        for (int e = 0; e < 32; ++e) { const float d = v[e] - mu; q += d * d; }
        const float rstd = rsqrtf(wave_sum(q) * (1.0f / 2048.0f) + 1e-5f);
        const float* mp = mod + (row >> 12) * 12288;
#pragma unroll
        for (int i = 0; i < 4; ++i) {
            const int col = i * 512 + lane * 8;
            float xn[8], h[8];
#pragma unroll
            for (int e = 0; e < 8; ++e) { xn[e] = (v[i * 8 + e] - mu) * rstd * g[col + e] + bb[col + e]; h[e] = xn[e] * (1.0f + mp[8192 + col + e]) + mp[6144 + col + e]; }
            *(f32x4*)(rp + col) = (f32x4){xn[0], xn[1], xn[2], xn[3]}; *(f32x4*)(rp + col + 4) = (f32x4){xn[4], xn[5], xn[6], xn[7]};
            *(u32x4*)(H2 + (size_t)row * 2048 + col) = pack8(h);
        }
    }
}

__device__ __forceinline__ float row_max16(float v) {
    v = fmaxf(v, __builtin_bit_cast(float, __builtin_amdgcn_update_dpp(0, __builtin_bit_cast(int, v), 0x128, 0xf, 0xf, false)));
    v = fmaxf(v, __builtin_bit_cast(float, __builtin_amdgcn_update_dpp(0, __builtin_bit_cast(int, v), 0x124, 0xf, 0xf, false)));
    v = fmaxf(v, __builtin_bit_cast(float, __builtin_amdgcn_update_dpp(0, __builtin_bit_cast(int, v), 0x122, 0xf, 0xf, false)));
    v = fmaxf(v, __builtin_bit_cast(float, __builtin_amdgcn_update_dpp(0, __builtin_bit_cast(int, v), 0x121, 0xf, 0xf, false)));
    return v;
}
__device__ __forceinline__ float row_sum16(float v) {
    v += __builtin_bit_cast(float, __builtin_amdgcn_update_dpp(0, __builtin_bit_cast(int, v), 0x128, 0xf, 0xf, false));
    v += __builtin_bit_cast(float, __builtin_amdgcn_update_dpp(0, __builtin_bit_cast(int, v), 0x124, 0xf, 0xf, false));
    v += __builtin_bit_cast(float, __builtin_amdgcn_update_dpp(0, __builtin_bit_cast(int, v), 0x122, 0xf, 0xf, false));
    v += __builtin_bit_cast(float, __builtin_amdgcn_update_dpp(0, __builtin_bit_cast(int, v), 0x121, 0xf, 0xf, false));
    return v;
}
__device__ __forceinline__ int row_sum16i(int v) {
    v += __builtin_amdgcn_update_dpp(0, v, 0x128, 0xf, 0xf, false);
    v += __builtin_amdgcn_update_dpp(0, v, 0x124, 0xf, 0xf, false);
    v += __builtin_amdgcn_update_dpp(0, v, 0x122, 0xf, 0xf, false);
    v += __builtin_amdgcn_update_dpp(0, v, 0x121, 0xf, 0xf, false);
    return v;
}
template <int NCH, int NV> __device__ __forceinline__ void topk16_row16(float (&x)[NCH][NV], int s, int g, float (&rs)[NCH], int (&ri)[NCH]) {
#pragma unroll
    for (int c = 0; c < NCH; ++c) { rs[c] = -INFINITY; ri[c] = 0; }
#pragma unroll 1
    for (int it = 0; it < 16; ++it) {
#pragma unroll
        for (int c = 0; c < NCH; ++c) {
            float m = x[c][0];
#pragma unroll
            for (int j = 1; j < NV; ++j) m = fmaxf(m, x[c][j]);
            const float wm = row_max16(m);
            const unsigned long long bal = __ballot(m == wm);
            const unsigned seg = (unsigned)(bal >> (16 * g)) & 0xffffu;
            const bool iswin = (s == (__ffs((int)seg) - 1));
            int jsel = 0;
#pragma unroll
            for (int j = NV - 1; j >= 0; --j) { const bool e = (x[c][j] == wm); jsel = e ? j : jsel; x[c][j] = (e && iswin) ? -INFINITY : x[c][j]; }
            const int key = row_sum16i(iswin ? (s * NV + jsel) : 0);
            if (s == it) { rs[c] = wm; ri[c] = key; }
        }
    }
}
__device__ void peer_unit(KA a, int unit, unsigned char* lds) {
    const int tid = tid_opaque(), lane = tid & 63, wid = tid >> 6, fr = lane & 15, fq = lane >> 4;
    float* SC = (float*)lds;
    int* IGI = (int*)(lds + 32768); float* IGG = (float*)(lds + 49152);
    float* TL = (float*)(lds + 65536); int* TI = (int*)(lds + 69632);
    const int tok0 = unit * 32;
    const float* Qp = (const float*)(a->ws + WS_RB); const float* subk = a->in[26];
    const bf16_t* H2 = (const bf16_t*)(a->ws + WS_RA) + (size_t)2 * MT * 2048;
    const float* mod = (const float*)(a->ws + WS_MOD);
    int sti[4], stj[4];
#pragma unroll
    for (int q = 0; q < 4; ++q) {
        const int t = fr * 4 + q; int acc = 0, ii = -1, jj = 0;
#pragma unroll
        for (int i = 0; i < 16; ++i) { const int cnt = 16 / (i + 1); if (ii < 0 && t < acc + cnt) { ii = i; jj = t - acc; } acc += cnt; }
        sti[q] = ii; stj[q] = jj;
    }
#pragma unroll 1
    for (int hh = 0; hh < 8 * a->reps[2]; ++hh) { const int h = hh & 7;
#pragma unroll 1
        for (int p = 0; p < 2; ++p) {
            f32x4 bq[8], aq[2][8];
            const float* bp = subk + (size_t)((h * 2 + p) * 128 + wid * 16 + fr) * 128 + fq * 32;
#pragma unroll
            for (int j = 0; j < 8; ++j) bq[j] = *(const f32x4*)(bp + j * 4);
#pragma unroll
            for (int mt = 0; mt < 2; ++mt) { const float* ap = Qp + (size_t)(tok0 + mt * 16 + fr) * 2048 + h * 256 + p * 128 + fq * 32;
#pragma unroll
                for (int j = 0; j < 8; ++j) aq[mt][j] = *(const f32x4*)(ap + j * 4); }
            f32x4 acc[2] = {(f32x4){0.f, 0.f, 0.f, 0.f}, (f32x4){0.f, 0.f, 0.f, 0.f}};
#pragma unroll
            for (int j = 0; j < 8; ++j)
#pragma unroll
                for (int e = 0; e < 4; ++e) {
                    acc[0] = __builtin_amdgcn_mfma_f32_16x16x4f32(aq[0][j][e], bq[j][e], acc[0], 0, 0, 0);
                    acc[1] = __builtin_amdgcn_mfma_f32_16x16x4f32(aq[1][j][e], bq[j][e], acc[1], 0, 0, 0);
                }
#pragma unroll
            for (int mt = 0; mt < 2; ++mt)
#pragma unroll
                for (int r = 0; r < 4; ++r) SC[(p * 32 + mt * 16 + 4 * fq + r) * 128 + wid * 16 + fr] = acc[mt][r];
        }
        __syncthreads();
        {
            const int tk = wid * 4 + fq;
            float x[2][8]; float ts[2]; int tix[2];
#pragma unroll
            for (int p = 0; p < 2; ++p) { const f32x4 y0 = *(const f32x4*)(SC + (p * 32 + tk) * 128 + fr * 8), y1 = *(const f32x4*)(SC + (p * 32 + tk) * 128 + fr * 8 + 4);
                x[p][0] = y0.x; x[p][1] = y0.y; x[p][2] = y0.z; x[p][3] = y0.w; x[p][4] = y1.x; x[p][5] = y1.y; x[p][6] = y1.z; x[p][7] = y1.w; }
            topk16_row16<2, 8>(x, fr, fq, ts, tix);
            TL[(tk * 2 + 0) * 16 + fr] = ts[0]; TL[(tk * 2 + 1) * 16 + fr] = ts[1]; TI[(tk * 2 + 0) * 16 + fr] = tix[0]; TI[(tk * 2 + 1) * 16 + fr] = tix[1];
            asm volatile("s_waitcnt lgkmcnt(0)" ::: "memory");
            float cnd[1][4]; float bs[1]; int bc[1];
#pragma unroll
            for (int q = 0; q < 4; ++q) cnd[0][q] = (sti[q] >= 0) ? TL[(tk * 2 + 0) * 16 + (sti[q] & 15)] + TL[(tk * 2 + 1) * 16 + stj[q]] : -INFINITY;
            topk16_row16<1, 4>(cnd, fr, fq, bs, bc);
            const int src = (lane & 48) + (bc[0] >> 2), qq = bc[0] & 3;
            const int i0 = __shfl(sti[0], src, 64), i1 = __shfl(sti[1], src, 64), i2 = __shfl(sti[2], src, 64), i3 = __shfl(sti[3], src, 64);
            const int j0 = __shfl(stj[0], src, 64), j1 = __shfl(stj[1], src, 64), j2 = __shfl(stj[2], src, 64), j3 = __shfl(stj[3], src, 64);
            const int pi = (qq == 0) ? i0 : (qq == 1) ? i1 : (qq == 2) ? i2 : i3, pj = (qq == 0) ? j0 : (qq == 1) ? j1 : (qq == 2) ? j2 : j3;
            const int e0 = TI[(tk * 2 + 0) * 16 + (pi & 15)], e1 = TI[(tk * 2 + 1) * 16 + (pj & 15)];
            const float mx = row_max16(bs[0]);
            const float ex = expf(bs[0] - mx);
            const float sm = row_sum16(ex);
            IGI[tk * 128 + h * 16 + fr] = e0 * 128 + e1; IGG[tk * 128 + h * 16 + fr] = ex / sm;
        }
        __syncthreads();
    }
    __syncthreads();
    const unsigned char* U8 = a->ws + WS_RA + PEER_U8; const unsigned char* V8 = a->ws + WS_RA + PEER_V8;
    const float* US = (const float*)(a->ws + WS_RA + PEER_US); const float* VS = (const float*)(a->ws + WS_RA + PEER_VS);
#pragma unroll 1
    for (int rr = 0; rr < 4; ++rr) {
        const int row = wid * 4 + rr, tok = tok0 + row;
        float hx[32], yq[32]; float hs = 0.f;
#pragma unroll
        for (int i = 0; i < 2; ++i) {
            float t8[8];
            unpack8(*(const u32x4*)(H2 + (size_t)tok * 2048 + i * 1024 + lane * 16), t8);
#pragma unroll
            for (int e = 0; e < 8; ++e) { hx[i * 16 + e] = t8[e]; hs += t8[e]; }
            unpack8(*(const u32x4*)(H2 + (size_t)tok * 2048 + i * 1024 + lane * 16 + 8), t8);
#pragma unroll
            for (int e = 0; e < 8; ++e) { hx[i * 16 + 8 + e] = t8[e]; hs += t8[e]; }
        }
#pragma unroll
        for (int e = 0; e < 32; ++e) yq[e] = 0.f;
        hs = wave_sum(hs);
        float csum = 0.f;
#if DBG_MODE != 2
        const int* ip = IGI + row * 128; const float* gp = IGG + row * 128;
        u32x4 nu[2][2], nv[2][2]; float nsu[2], nsv[2];
#pragma unroll
        for (int k = 0; k < 2; ++k) {
            const int idx = __builtin_amdgcn_readfirstlane(ip[k]);
            const unsigned char* up = U8 + (size_t)idx * 2048 + lane * 16; const unsigned char* vp = V8 + (size_t)idx * 2048 + lane * 16;
            nu[k][0] = *(const u32x4*)up; nu[k][1] = *(const u32x4*)(up + 1024); nv[k][0] = *(const u32x4*)vp; nv[k][1] = *(const u32x4*)(vp + 1024);
            nsu[k] = US[idx]; nsv[k] = VS[idx];
        }
#pragma unroll 1
        for (int e = 0; e < 128; e += 2) {
            u32x4 cu[2][2], cvv[2][2]; float csu[2], csv[2];
#pragma unroll
            for (int k = 0; k < 2; ++k) { cu[k][0] = nu[k][0]; cu[k][1] = nu[k][1]; cvv[k][0] = nv[k][0]; cvv[k][1] = nv[k][1]; csu[k] = nsu[k]; csv[k] = nsv[k]; }
            if (e + 2 < 128) {
#pragma unroll
                for (int k = 0; k < 2; ++k) {
                    const int idx = __builtin_amdgcn_readfirstlane(ip[e + 2 + k]);
                    const unsigned char* up = U8 + (size_t)idx * 2048 + lane * 16; const unsigned char* vp = V8 + (size_t)idx * 2048 + lane * 16;
                    nu[k][0] = *(const u32x4*)up; nu[k][1] = *(const u32x4*)(up + 1024); nv[k][0] = *(const u32x4*)vp; nv[k][1] = *(const u32x4*)(vp + 1024);
                    nsu[k] = US[idx]; nsv[k] = VS[idx];
                }
            }
#pragma unroll
            for (int k = 0; k < 2; ++k) {
                float acc = 0.f;
#pragma unroll
                for (int i = 0; i < 2; ++i)
#pragma unroll
                    for (int j = 0; j < 4; ++j) { const unsigned wd = cu[k][i][j]; const float* hp = hx + i * 16 + j * 4;
                        acc += (float)(wd & 255u) * hp[0]; acc += (float)((wd >> 8) & 255u) * hp[1]; acc += (float)((wd >> 16) & 255u) * hp[2]; acc += (float)(wd >> 24) * hp[3]; }
                const float dot = csu[k] * (wave_sum(acc) - 128.0f * hs);
                const float c1 = gp[e + k] * 0.5f * dot * (1.0f + erff(dot * 0.7071067811865476f)) * csv[k];
                csum += c1;
#pragma unroll
                for (int i = 0; i < 2; ++i)
#pragma unroll
                    for (int j = 0; j < 4; ++j) { const unsigned wd = cvv[k][i][j]; float* yp = yq + i * 16 + j * 4;
                        yp[0] += c1 * (float)(wd & 255u); yp[1] += c1 * (float)((wd >> 8) & 255u); yp[2] += c1 * (float)((wd >> 16) & 255u); yp[3] += c1 * (float)(wd >> 24); }
            }
        }
#endif
        float* rp = a->out + (size_t)tok * 2048; const float* mp = mod + (tok >> 12) * 12288 + 10240;
        float val[32]; float s = 0.f;
        const float yoff = 128.0f * csum;
#pragma unroll
        for (int i = 0; i < 2; ++i)
#pragma unroll
            for (int j = 0; j < 4; ++j) { const int col = i * 1024 + lane * 16 + j * 4; const f32x4 x0 = *(const f32x4*)(rp + col), g0 = *(const f32x4*)(mp + col);
#pragma unroll
                for (int e = 0; e < 4; ++e) { const float v = ALPHA * x0[e] + g0[e] * (yq[i * 16 + j * 4 + e] - yoff); val[i * 16 + j * 4 + e] = v; s += v; } }
        const float mu = wave_sum(s) * (1.0f / 2048.0f);
        float q = 0.f;
#pragma unroll
        for (int e = 0; e < 32; ++e) { const float d = val[e] - mu; q += d * d; }
        const float rstd = rsqrtf(wave_sum(q) * (1.0f / 2048.0f) + 1e-5f);
        const float* g = a->in[29]; const float* bb = a->in[30];
#pragma unroll
        for (int i = 0; i < 2; ++i)
#pragma unroll
            for (int j = 0; j < 4; ++j) { const int col = i * 1024 + lane * 16 + j * 4; const f32x4 gg = *(const f32x4*)(g + col), bv = *(const f32x4*)(bb + col); f32x4 o;
#pragma unroll
                for (int e = 0; e < 4; ++e) o[e] = (val[i * 16 + j * 4 + e] - mu) * rstd * gg[e] + bv[e];
                *(f32x4*)(rp + col) = o; }
    }
    __syncthreads();
}

constexpr size_t WS_BAR = 690 * MiB;
__device__ __forceinline__ void grid_bar(unsigned* ctr, unsigned target) {
    asm volatile("s_waitcnt vmcnt(0)" ::: "memory");
    __syncthreads();
    if (tid_opaque() == 0) {
        __builtin_amdgcn_fence(__ATOMIC_RELEASE, "agent");
        asm volatile("s_waitcnt vmcnt(0)" ::: "memory");
        __hip_atomic_fetch_add(ctr, 1u, __ATOMIC_RELAXED, __HIP_MEMORY_SCOPE_AGENT);
        while (__hip_atomic_load(ctr, __ATOMIC_RELAXED, __HIP_MEMORY_SCOPE_AGENT) < target) __builtin_amdgcn_s_sleep(2);
        __builtin_amdgcn_fence(__ATOMIC_ACQUIRE, "agent");
        asm volatile("s_waitcnt vmcnt(0)" ::: "memory");
    }
    __syncthreads();
}

__global__ void __launch_bounds__(NT, 2) fwd_mega(Args a_) {
    KA a = (KA)__builtin_amdgcn_kernarg_segment_ptr();
    extern __shared__ __attribute__((aligned(16))) unsigned char lds[];
    cg::grid_group grid = cg::this_grid();
    float* lf = (float*)lds;
    const int lo = a->ph_lo, hi = a->ph_hi;
#define IN(k) (lo <= (k) && (k) < hi)
    unsigned* barctr = (unsigned*)(a->ws + WS_BAR); unsigned nbar = 0;
    if (blockIdx.x == 0 && tid_opaque() == 0) __hip_atomic_store(barctr, 0u, __ATOMIC_RELAXED, __HIP_MEMORY_SCOPE_AGENT);
#define GBAR() do { ++nbar; grid_bar(barctr, nbar * gridDim.x); } while (0)
#define SEAM(k) do { if (IN(k) && IN((k) + 1)) { if ((k) == 0) grid.sync(); else GBAR(); } asm volatile("" : "+s"(a)); } while (0)
    unsigned char* ws = a->ws;
    bf16_t* HA = (bf16_t*)(ws + WS_HA); bf16_t* WT = (bf16_t*)(ws + WS_WT); bf16_t* SW = (bf16_t*)(ws + WS_SW);
    bf16_t* RA = (bf16_t*)(ws + WS_RA); bf16_t* RB = (bf16_t*)(ws + WS_RB);
    const float* mod = (const float*)(ws + WS_MOD);

    if (IN(0)) {
#pragma unroll 1
        for (int rep = 0; rep < a->reps[0]; ++rep) { p0_mod_hid2(a, lf); p0_transposes(a, lf); }
    }
    SEAM(0);
    if (IN(1)) {
#pragma unroll 1
        for (int rep = 0; rep < a->reps[0]; ++rep) { p1_ha(a); for (int u = blockIdx.x; u < 256; u += gridDim.x) filt_unit(a, u, lds); }
    }
    SEAM(1);
    if (IN(2)) {
#pragma unroll 1
        for (int rep = 0; rep < a->reps[1]; ++rep) {
        run_gemm(lds, WT + (size_t)WT_HY0 * 2048, HA, NHY, MT, FStoreBf16{RA, MT});
        run_gemm(lds, HA, WT, MA, NQKVP, FStoreQKV{RB, (float*)(ws + WS_AB)});
        }
    }
    SEAM(2);
    if (IN(3)) {
        hyena_setup(lds);
#pragma unroll 1
        for (int rep = 0; rep < a->reps[3]; ++rep)
        for (int c = blockIdx.x; c < 2048; c += gridDim.x) hyena_item(a, c, lds);
        for (int u = blockIdx.x; u < 12288 + 192; u += gridDim.x) qkvpost_unit(a, u, lds);
    }
    SEAM(3);
    if (IN(4)) {
#pragma unroll 1
        for (int rep = 0; rep < a->reps[4]; ++rep)
        { const int wv = tid_opaque() >> 6; for (int pid = blockIdx.x * 8 + wv; pid < 8704; pid += gridDim.x * 8) tprep_wave(a, pid, lds + wv * 17920); }
        GBAR();
#pragma unroll 1
        for (int rep = 0; rep < a->reps[5]; ++rep)
        for (int it = blockIdx.x; it < 256; it += gridDim.x) delta_item(a, it, lds);
    }
    SEAM(4);
    if (IN(5)) {
        run_gemm(lds, HA, WT + (size_t)WT_ZG0 * 2048, MT, NZG, FStoreBf16{RB, NZG});
#pragma unroll 1
        for (int rep = 0; rep < a->reps[6]; ++rep)
        for (int u = blockIdx.x; u < 8192; u += gridDim.x) ytrans_unit((const bf16_t*)a->out, RA + (size_t)2 * MT * 2048, u, (bf16_t*)lds);
    }
    SEAM(5);
    if (IN(6)) {
#pragma unroll 1
        for (int rep = 0; rep < a->reps[6]; ++rep) p6_on(a); }
    SEAM(6);
    if (IN(7)) {
        run_gemm(lds, HA  , SW, MT, D, FGatePA{RB, WT  });
        run_gemm(lds, RA + (size_t)2 * MT * 2048  , SW + (size_t)1 * D * D, MT, D, FGatePH{RB, WT  });
    }
    SEAM(7);
    if (IN(8)) {
        run_gemm(lds, WT  , SW + (size_t)2 * D * D, MT, D, FOut{a->in[0], mod, a->out});
#pragma unroll 1
        for (int rep = 0; rep < a->reps[7]; ++rep) p8_tables(a);
    }
    SEAM(8);
    if (IN(9)) { p9_ln1(a); }
    SEAM(9);
    if (IN(10)) { run_gemm(lds, RA + (size_t)2 * MT * 2048  , SW + (size_t)3 * D * D, MT, D, FStoreF32{(float*)(ws + WS_RB), D}); }
    SEAM(10);
    if (IN(11)) { for (int u = blockIdx.x; u < MT / 32; u += gridDim.x) peer_unit(a, u, lds); }
#undef IN
#undef SEAM
}

extern "C" void kernel_launch(void* const* d_in, const int* in_sizes, int n_in, void* d_out, int out_size, void* d_ws, size_t ws_size, hipStream_t stream) {
    static int grid = 0;
    if (grid == 0) {
        if (n_in != 31 || out_size != MT * D || ws_size < WS_BAR + 4096) { fprintf(stderr, "kernel_launch: unexpected problem shape / workspace (%d inputs, out %d, ws %zu)\n", n_in, out_size, ws_size); grid = -1; return; }
        int dev = 0, cus = 0, per_cu = 0;
        (void)hipGetDevice(&dev);
        (void)hipDeviceGetAttribute(&cus, hipDeviceAttributeMultiprocessorCount, dev);
        (void)hipFuncSetAttribute((const void*)fwd_mega, hipFuncAttributeMaxDynamicSharedMemorySize, LDS_BYTES);
        (void)hipOccupancyMaxActiveBlocksPerMultiprocessor(&per_cu, (const void*)fwd_mega, NT, LDS_BYTES);
        if (per_cu < 1) per_cu = 1;
        grid = cus * per_cu;
        (void)hipGetLastError();
    }
    if (grid < 0) return;
    Args a{};
    for (int i = 0; i < 31; ++i) a.in[i] = (const float*)d_in[i];
    a.out = (float*)d_out; a.ws = (unsigned char*)d_ws; a.ph_lo = 0; a.ph_hi = 12; a.reps[0] = REP0; a.reps[1] = REP1; a.reps[2] = REP2; a.reps[3] = REP3; a.reps[4] = REP4; a.reps[5] = REP5; a.reps[6] = REP6; a.reps[7] = REP7;
    void* args[] = {&a};
    hipError_t e = hipLaunchCooperativeKernel((const void*)fwd_mega, dim3(grid), dim3(NT), args, LDS_BYTES, stream);
    if (e != hipSuccess) fprintf(stderr, "cooperative launch failed: %s (grid %d)\n", hipGetErrorString(e), grid);
}
```

```cpp
#include <hip/hip_runtime.h>
#include <hip/hip_cooperative_groups.h>
#include <cstdio>
#include <cstdint>
namespace cg = cooperative_groups;

#ifndef DBG_MODE
#define DBG_MODE 0
#endif
#define REP0 1
#define REP1 1
#define REP2 1
#define REP3 1
#define REP4 1
#define REP5 1
#define REP6 1
#define REP7 1

extern __shared__ __attribute__((aligned(16))) unsigned char g_lds[];
constexpr int TIDTAB_OFF = 160 * 1024 - 256;
__device__ __forceinline__ int tid_opaque() {
    const int slot = __builtin_amdgcn_s_getreg(0x2804) & 63;
    int wv = __builtin_amdgcn_readfirstlane(((const int*)(g_lds + TIDTAB_OFF))[slot]);
    int t = wv * 64 + (int)__builtin_amdgcn_mbcnt_hi(~0u, __builtin_amdgcn_mbcnt_lo(~0u, 0u));
    asm volatile("" : "+v"(t));
    return t;
}
__device__ __forceinline__ void tid_table_init() {
    const int t = threadIdx.x;
    if ((t & 63) == 0) ((int*)(g_lds + TIDTAB_OFF))[__builtin_amdgcn_s_getreg(0x2804) & 63] = t >> 6;
    __syncthreads();
}

namespace pg8 {
#define PG8_LAS __attribute__((address_space(3)))
typedef unsigned short bf16_t;
typedef short bf16x8 __attribute__((ext_vector_type(8)));
typedef float f32x4 __attribute__((ext_vector_type(4)));
typedef unsigned u32x4 __attribute__((ext_vector_type(4)));
constexpr int BM = 256, BK = 64, HALF = 128, HTB = HALF * BK * 2, STAGE_BYTES = 8 * HTB, NXCD = 8, WGM = 8;

__host__ __device__ __forceinline__ int lds_byte(int r, int c) { const int st = (r >> 4) * 2 + (c >> 5), rr = r & 15, cc = c & 31, ob = rr * 64 + cc * 2; return st * 1024 + (ob ^ (((ob >> 9) & 1) << 5)); }
__host__ __device__ __forceinline__ void stage_rc(int b, int& R, int& C) { const int st = b / 1024, sb = b % 1024, swz = sb ^ (((sb >> 9) & 1) << 5); R = (st >> 1) * 16 + swz / 64; C = (st & 1) * 32 + (swz % 64) / 2; }
__host__ __device__ __forceinline__ int perm32(int rho) { const int n = rho >> 4, i = rho & 15; return 8 * (i >> 2) + 4 * n + (i & 3); }

struct Unit { int pm, pn; };
struct Gemm { const bf16_t* A; const bf16_t* Bt; int M, N, K; };

struct StaticOrder {
    int nM, nN, nwg, G, c;
    __host__ __device__ void init(int M, int N, int G_, int c_) { nM = M / BM; nN = N / BM; nwg = nM * nN; G = G_; c = c_; }
    __host__ __device__ bool next(int i, Unit& u) const {
        const long L = (long)i * G + c; if (L >= nwg) return false;
        int wgid = (int)L; { const int q = nwg / NXCD, r = nwg % NXCD, xcd = wgid % NXCD, off = wgid / NXCD; wgid = (xcd < r ? xcd * (q + 1) : r * (q + 1) + (xcd - r) * q) + off; }
        const int nig = WGM * nN, gid = wgid / nig, fm = gid * WGM, gsz = (nM - fm) < WGM ? (nM - fm) : WGM;
        u.pm = fm + ((wgid % nig) % gsz); u.pn = (wgid % nig) / gsz; return true;
    }
    __device__ __forceinline__ void a_ready(const Unit&) const {}
    __device__ __forceinline__ void done(const Unit&) const {}
};

__device__ __forceinline__ unsigned cvt_pk_bf16(float lo, float hi) { unsigned r; asm volatile("v_cvt_pk_bf16_f32 %0, %1, %2" : "=v"(r) : "v"(lo), "v"(hi)); return r; }

template <class F> struct EpiGen {
    static constexpr bool PERM = true, AFTER_DRAIN = false;
    F f;
    __device__ __forceinline__ void operator()(const f32x4 (&acc)[2][2][4][2], const Unit& u, int wr, int wc, int, int) const {
        int ln = (int)__builtin_amdgcn_mbcnt_hi(~0u, __builtin_amdgcn_mbcnt_lo(~0u, 0u)); asm volatile("" : "+v"(ln));
        const int fr = ln & 15, fq = ln >> 4;
        const int row0 = u.pm * BM + wr * 64 + fr, col0 = u.pn * BM + wc * 32 + 8 * fq;
#pragma unroll
        for (int ai = 0; ai < 2; ++ai)
#pragma unroll
            for (int m = 0; m < 4; ++m)
#pragma unroll
                for (int bj = 0; bj < 2; ++bj) f(row0 + ai * HALF + m * 16, col0 + bj * HALF, acc[ai][bj][m][0], acc[ai][bj][m][1]);
    }
};

template <class Epi, class Sched, bool ALIGN_EPI = false, bool SP2 = false>
__device__ __forceinline__ void gemm_phase(PG8_LAS unsigned char* lds, const Gemm g, const Sched& S, const Epi& E) {
    const int tid = tid_opaque(), wid = __builtin_amdgcn_readfirstlane(tid >> 6), lane = tid & 63, wr = wid >> 2, wc = wid & 3, fr = lane & 15, fq = lane >> 4;
    const int K = g.K, nt = K / BK;
    unsigned voffA[2], voffB[2];
#pragma unroll
    for (int i = 0; i < 2; ++i) { int R, C; stage_rc(tid * 16 + i * 8192, R, C); const int Rb = Epi::PERM ? ((R & ~31) + perm32(R & 31)) : R;
        voffA[i] = (unsigned)(R * K + C) * 2u; voffB[i] = (unsigned)(Rb * K + C) * 2u; }
    const size_t kstep = (size_t)(BK * 2);
    const size_t hstep = (size_t)HALF * K * 2;
    const size_t tstep = 2 * hstep;
    const unsigned ldsw = (unsigned)wid * 1024u;
    const int aoff = lds_byte(wr * 64 + fr, fq * 8), boff = lds_byte(wc * 32 + fr, fq * 8);
#define PG8_SA(b, h) (((b) * 2 + (h)) * HTB)
#define PG8_SB(b, h) ((4 + (b) * 2 + (h)) * HTB)
#define PG8_STAGE(bufoff, gbase, voff) do { _Pragma("unroll") for (int _i = 0; _i < 2; ++_i) \
        __builtin_amdgcn_global_load_lds((const unsigned*)((const char*)(gbase) + (voff)[_i]), (PG8_LAS unsigned*)(lds + (bufoff) + ldsw + _i * 8192), 16, 0, 0); } while (0)
#define PG8_LDA(dst, b, h) do { _Pragma("unroll") for (int m = 0; m < 4; ++m) _Pragma("unroll") for (int k = 0; k < 2; ++k) dst[m][k] = *(const PG8_LAS bf16x8*)(lds + PG8_SA(b, h) + aoff + m * 2048 + k * 1024); } while (0)
#define PG8_LDB(dst, b, h) do { _Pragma("unroll") for (int n = 0; n < 2; ++n) _Pragma("unroll") for (int k = 0; k < 2; ++k) dst[n][k] = *(const PG8_LAS bf16x8*)(lds + PG8_SB(b, h) + boff + n * 2048 + k * 1024); } while (0)
#define PG8_MMA(ai, bj, At, Bt) do { __builtin_amdgcn_s_setprio(1); _Pragma("unroll") for (int m = 0; m < 4; ++m) _Pragma("unroll") for (int n = 0; n < 2; ++n) _Pragma("unroll") for (int k = 0; k < 2; ++k) \
        acc[ai][bj][m][n] = __builtin_amdgcn_mfma_f32_16x16x32_bf16(Bt[n][k], At[m][k], acc[ai][bj][m][n], 0, 0, 0); __builtin_amdgcn_s_setprio(0); } while (0)
#define PG8_WAIT_V(n) asm volatile("s_waitcnt vmcnt(" #n ")" ::: "memory")
#define PG8_WAIT_L(n) asm volatile("s_waitcnt lgkmcnt(" #n ")" ::: "memory")
#define PG8_BAR __builtin_amdgcn_s_barrier()
#define PG8_SCHED __builtin_amdgcn_sched_barrier(0)
    Unit cur, nxt; int ui = 0;
    if (!S.next(0, cur)) return;
    f32x4 acc[2][2][4][2];
#pragma unroll
    for (int a = 0; a < 2; ++a)
#pragma unroll
        for (int b = 0; b < 2; ++b)
#pragma unroll
            for (int m = 0; m < 4; ++m)
#pragma unroll
                for (int n = 0; n < 2; ++n) acc[a][b][m][n] = (f32x4){0.f, 0.f, 0.f, 0.f};
    bf16x8 At[4][2], B0[2][2], B1[2][2];
    const char* cA = (const char*)g.A + (size_t)cur.pm * tstep; const char* cB = (const char*)g.Bt + (size_t)cur.pn * tstep;
    S.a_ready(cur);
    if constexpr (SP2) {
        PG8_STAGE(PG8_SB(0, 0), cB, voffB); PG8_STAGE(PG8_SB(0, 1), cB + hstep, voffB); PG8_STAGE(PG8_SA(0, 0), cA, voffA); PG8_STAGE(PG8_SA(0, 1), cA + hstep, voffA);
        if (wr == 1) PG8_BAR;
        PG8_WAIT_V(2); PG8_BAR;
        PG8_STAGE(PG8_SB(1, 0), cB + kstep, voffB); PG8_STAGE(PG8_SA(1, 0), cA + kstep, voffA); PG8_STAGE(PG8_SB(1, 1), cB + hstep + kstep, voffB);
        PG8_WAIT_V(6); PG8_BAR;
    } else {
        PG8_STAGE(PG8_SB(0, 0), cB, voffB); PG8_STAGE(PG8_SA(0, 0), cA, voffA); PG8_STAGE(PG8_SB(0, 1), cB + hstep, voffB); PG8_STAGE(PG8_SA(0, 1), cA + hstep, voffA);
        if (wr == 1) PG8_BAR;
        PG8_WAIT_V(4); PG8_BAR;
        PG8_STAGE(PG8_SB(1, 0), cB + kstep, voffB); PG8_STAGE(PG8_SA(1, 0), cA + kstep, voffA); PG8_STAGE(PG8_SB(1, 1), cB + hstep + kstep, voffB);
        PG8_WAIT_V(6); PG8_BAR;
    }
    for (;;) {
        const bool has_next = S.next(ui + 1, nxt);
        const char* nA = has_next ? (const char*)g.A + (size_t)nxt.pm * tstep : cA; const char* nB = has_next ? (const char*)g.Bt + (size_t)nxt.pn * tstep : cB;
        for (int t = 0; t < nt; t += 2) {
            const bool last = (t == nt - 2);
            const char* a1 = cA + (size_t)(t + 1) * kstep;
            const char* a2 = last ? nA : cA + (size_t)(t + 2) * kstep; const char* b2 = last ? nB : cB + (size_t)(t + 2) * kstep;
            const char* a3 = a2 + kstep; const char* b3 = b2 + kstep;
            if (last && has_next) S.a_ready(nxt);
            if constexpr (SP2) {
            PG8_LDB(B0, 0, 0); PG8_LDB(B1, 0, 1); PG8_SCHED; PG8_LDA(At, 0, 0); PG8_STAGE(PG8_SA(1, 1), a1 + hstep, voffA);
            PG8_WAIT_V(8); PG8_WAIT_L(0); PG8_BAR; PG8_MMA(0, 0, At, B0); PG8_MMA(0, 1, At, B1); PG8_BAR; PG8_SCHED;
            PG8_LDA(At, 0, 1); PG8_STAGE(PG8_SB(0, 0), b2, voffB); PG8_STAGE(PG8_SB(0, 1), b2 + hstep, voffB); PG8_STAGE(PG8_SA(0, 0), a2, voffA);
            PG8_WAIT_V(8); PG8_WAIT_L(0); PG8_BAR; PG8_MMA(1, 0, At, B0); PG8_MMA(1, 1, At, B1); PG8_BAR; PG8_SCHED;
            PG8_LDB(B0, 1, 0); PG8_LDB(B1, 1, 1); PG8_SCHED; PG8_LDA(At, 1, 0); PG8_STAGE(PG8_SA(0, 1), a2 + hstep, voffA);
            PG8_WAIT_V(8); PG8_WAIT_L(0); PG8_BAR; PG8_MMA(0, 0, At, B0); PG8_MMA(0, 1, At, B1); PG8_BAR; PG8_SCHED;
            PG8_LDA(At, 1, 1); PG8_STAGE(PG8_SB(1, 0), b3, voffB); PG8_STAGE(PG8_SB(1, 1), b3 + hstep, voffB); PG8_STAGE(PG8_SA(1, 0), a3, voffA);
            PG8_WAIT_V(8); PG8_WAIT_L(0); PG8_BAR; PG8_MMA(1, 0, At, B0); PG8_MMA(1, 1, At, B1); PG8_BAR; PG8_SCHED;
            } else {
            PG8_LDB(B0, 0, 0); PG8_SCHED; PG8_LDA(At, 0, 0); PG8_STAGE(PG8_SA(1, 1), a1 + hstep, voffA);
            PG8_WAIT_L(8); PG8_BAR; PG8_WAIT_L(0); PG8_MMA(0, 0, At, B0); PG8_BAR; PG8_SCHED;
            PG8_LDB(B1, 0, 1); PG8_STAGE(PG8_SB(0, 0), b2, voffB);
            PG8_BAR; PG8_WAIT_L(0); PG8_MMA(0, 1, At, B1); PG8_BAR;
            PG8_LDA(At, 0, 1); PG8_STAGE(PG8_SA(0, 0), a2, voffA);
            PG8_BAR; PG8_WAIT_L(0); PG8_MMA(1, 0, At, B0); PG8_BAR; PG8_SCHED;
            PG8_STAGE(PG8_SB(0, 1), b2 + hstep, voffB);
            PG8_WAIT_V(6); PG8_BAR; PG8_MMA(1, 1, At, B1); PG8_BAR;
            PG8_LDB(B0, 1, 0); PG8_SCHED; PG8_LDA(At, 1, 0); PG8_STAGE(PG8_SA(0, 1), a2 + hstep, voffA);
            PG8_WAIT_L(8); PG8_BAR; PG8_WAIT_L(0); PG8_MMA(0, 0, At, B0); PG8_BAR; PG8_SCHED;
            PG8_LDB(B1, 1, 1); PG8_STAGE(PG8_SB(1, 0), b3, voffB);
            PG8_BAR; PG8_WAIT_L(0); PG8_MMA(0, 1, At, B1); PG8_BAR;
            PG8_LDA(At, 1, 1); PG8_STAGE(PG8_SA(1, 0), a3, voffA);
            PG8_BAR; PG8_WAIT_L(0); PG8_MMA(1, 0, At, B0); PG8_BAR; PG8_SCHED;
            PG8_STAGE(PG8_SB(1, 1), b3 + hstep, voffB);
            PG8_WAIT_V(6); PG8_BAR; PG8_MMA(1, 1, At, B1); PG8_BAR;
            }
        }
        if constexpr (ALIGN_EPI) { if (wr == 0) PG8_BAR; }
        if constexpr (!Epi::AFTER_DRAIN) { E(acc, cur, wr, wc, fr, fq); S.done(cur); }
        if (!has_next) break;
#pragma unroll
        for (int a = 0; a < 2; ++a)
#pragma unroll
            for (int b = 0; b < 2; ++b)
#pragma unroll
                for (int m = 0; m < 4; ++m)
#pragma unroll
                    for (int n = 0; n < 2; ++n) acc[a][b][m][n] = (f32x4){0.f, 0.f, 0.f, 0.f};
        cur = nxt; cA = nA; cB = nB; ++ui;
        if constexpr (ALIGN_EPI) { if (wr == 1) PG8_BAR; }
    }
    PG8_WAIT_V(0);
    if constexpr (!ALIGN_EPI) { if (wr == 0) PG8_BAR; }
    PG8_BAR;
    if constexpr (Epi::AFTER_DRAIN) { E.fused(acc, cur, wr, wc, fr, fq, lds, wid, lane); S.done(cur); }
#undef PG8_SA
#undef PG8_SB
#undef PG8_STAGE
#undef PG8_LDA
#undef PG8_LDB
#undef PG8_MMA
#undef PG8_WAIT_V
#undef PG8_WAIT_L
#undef PG8_BAR
#undef PG8_SCHED
}
typedef int i32x4 __attribute__((ext_vector_type(4)));
typedef int i32x8 __attribute__((ext_vector_type(8)));
template <class Epi, class Sched, bool ALIGN_EPI = false, bool SP2 = false>
__device__ __forceinline__ void gemm_phase8(PG8_LAS unsigned char* lds, const Gemm g, const Sched& S, const Epi& E) {
    const int tid = tid_opaque(), wid = __builtin_amdgcn_readfirstlane(tid >> 6), lane = tid & 63, wr = wid >> 2, wc = wid & 3, fr = lane & 15, fq = lane >> 4;
    const int K = g.K, nt = K / BK;
    unsigned voffA[2], voffB[2];
#pragma unroll
    for (int i = 0; i < 2; ++i) { int R, C; stage_rc(tid * 16 + i * 8192, R, C); const int Rb = Epi::PERM ? ((R & ~31) + perm32(R & 31)) : R;
        voffA[i] = (unsigned)(R * K + C) * 2u; voffB[i] = (unsigned)(Rb * K + C) * 2u; }
    const size_t rstep64 = (size_t)64 * K * 2;
    const size_t kstep = (size_t)(BK * 2);
    const size_t hstep = (size_t)HALF * K * 2;
    const size_t tstep = 2 * hstep;
    const unsigned ldsw = (unsigned)wid * 1024u;
    const int aoff = lds_byte(wr * 64 + fr, fq * 8), boff = lds_byte(wc * 32 + fr, fq * 8);
#define PG8_SA(b, h) (((b) * 2 + (h)) * HTB)
#define PG8_SB(b, h) ((4 + (b) * 2 + (h)) * HTB)
#define PG8_STAGE(bufoff, gbase, voff) do { _Pragma("unroll") for (int _i = 0; _i < 2; ++_i) \
        __builtin_amdgcn_global_load_lds((const unsigned*)((const char*)(gbase) + (size_t)_i * rstep64 + (voff)[0]), (PG8_LAS unsigned*)(lds + (bufoff) + ldsw + _i * 8192), 16, 0, 0); } while (0)
#define PG8_LD32(p) __builtin_shufflevector(*(const PG8_LAS i32x4*)(p), *(const PG8_LAS i32x4*)((p) + 1024), 0, 1, 2, 3, 4, 5, 6, 7)
#define PG8_LDA(dst, b, h) do { _Pragma("unroll") for (int m = 0; m < 4; ++m) dst[m] = PG8_LD32(lds + PG8_SA(b, h) + aoff + m * 2048); } while (0)
#define PG8_LDB(dst, b, h) do { _Pragma("unroll") for (int n = 0; n < 2; ++n) dst[n] = PG8_LD32(lds + PG8_SB(b, h) + boff + n * 2048); } while (0)
#define PG8_MMA(ai, bj, At, Bt) do { __builtin_amdgcn_s_setprio(1); _Pragma("unroll") for (int m = 0; m < 4; ++m) _Pragma("unroll") for (int n = 0; n < 2; ++n) \
        acc[ai][bj][m][n] = __builtin_amdgcn_mfma_scale_f32_16x16x128_f8f6f4(Bt[n], At[m], acc[ai][bj][m][n], 0, 0, 0, 0, 0, 0);     __builtin_amdgcn_s_setprio(0); } while (0)
#define PG8_WAIT_V(n) asm volatile("s_waitcnt vmcnt(" #n ")" ::: "memory")
#define PG8_WAIT_L(n) asm volatile("s_waitcnt lgkmcnt(" #n ")" ::: "memory")
#define PG8_BAR __builtin_amdgcn_s_barrier()
#define PG8_SCHED __builtin_amdgcn_sched_barrier(0)
    Unit cur, nxt; int ui = 0;
    if (!S.next(0, cur)) return;
    f32x4 acc[2][2][4][2];
#pragma unroll
    for (int a = 0; a < 2; ++a)
#pragma unroll
        for (int b = 0; b < 2; ++b)
#pragma unroll
            for (int m = 0; m < 4; ++m)
#pragma unroll
                for (int n = 0; n < 2; ++n) acc[a][b][m][n] = (f32x4){0.f, 0.f, 0.f, 0.f};
    i32x8 At[4], B0[2], B1[2];
    const char* cA = (const char*)g.A + (size_t)cur.pm * tstep; const char* cB = (const char*)g.Bt + (size_t)cur.pn * tstep;
    S.a_ready(cur);
    if constexpr (SP2) {
        PG8_STAGE(PG8_SB(0, 0), cB, voffB); PG8_STAGE(PG8_SB(0, 1), cB + hstep, voffB); PG8_STAGE(PG8_SA(0, 0), cA, voffA); PG8_STAGE(PG8_SA(0, 1), cA + hstep, voffA);
        if (wr == 1) PG8_BAR;
        PG8_WAIT_V(2); PG8_BAR;
        PG8_STAGE(PG8_SB(1, 0), cB + kstep, voffB); PG8_STAGE(PG8_SA(1, 0), cA + kstep, voffA); PG8_STAGE(PG8_SB(1, 1), cB + hstep + kstep, voffB);
        PG8_WAIT_V(6); PG8_BAR;
    } else {
        PG8_STAGE(PG8_SB(0, 0), cB, voffB); PG8_STAGE(PG8_SA(0, 0), cA, voffA); PG8_STAGE(PG8_SB(0, 1), cB + hstep, voffB); PG8_STAGE(PG8_SA(0, 1), cA + hstep, voffA);
        if (wr == 1) PG8_BAR;
        PG8_WAIT_V(4); PG8_BAR;
        PG8_STAGE(PG8_SB(1, 0), cB + kstep, voffB); PG8_STAGE(PG8_SA(1, 0), cA + kstep, voffA); PG8_STAGE(PG8_SB(1, 1), cB + hstep + kstep, voffB);
        PG8_WAIT_V(6); PG8_BAR;
    }
    for (;;) {
        const bool has_next = S.next(ui + 1, nxt);
        const char* nA = has_next ? (const char*)g.A + (size_t)nxt.pm * tstep : cA; const char* nB = has_next ? (const char*)g.Bt + (size_t)nxt.pn * tstep : cB;
        for (int t = 0; t < nt; t += 2) {
            const bool last = (t == nt - 2);
            const char* a1 = cA + (size_t)(t + 1) * kstep;
            const char* a2 = last ? nA : cA + (size_t)(t + 2) * kstep; const char* b2 = last ? nB : cB + (size_t)(t + 2) * kstep;
            const char* a3 = a2 + kstep; const char* b3 = b2 + kstep;
            if (last && has_next) S.a_ready(nxt);
            if constexpr (SP2) {
            PG8_LDB(B0, 0, 0); PG8_LDB(B1, 0, 1); PG8_SCHED; PG8_LDA(At, 0, 0); PG8_STAGE(PG8_SA(1, 1), a1 + hstep, voffA);
            PG8_WAIT_V(8); PG8_WAIT_L(0); PG8_BAR; PG8_MMA(0, 0, At, B0); PG8_MMA(0, 1, At, B1); PG8_BAR; PG8_SCHED;
            PG8_LDA(At, 0, 1); PG8_STAGE(PG8_SB(0, 0), b2, voffB); PG8_STAGE(PG8_SB(0, 1), b2 + hstep, voffB); PG8_STAGE(PG8_SA(0, 0), a2, voffA);
            PG8_WAIT_V(8); PG8_WAIT_L(0); PG8_BAR; PG8_MMA(1, 0, At, B0); PG8_MMA(1, 1, At, B1); PG8_BAR; PG8_SCHED;
            PG8_LDB(B0, 1, 0); PG8_LDB(B1, 1, 1); PG8_SCHED; PG8_LDA(At, 1, 0); PG8_STAGE(PG8_SA(0, 1), a2 + hstep, voffA);
            PG8_WAIT_V(8); PG8_WAIT_L(0); PG8_BAR; PG8_MMA(0, 0, At, B0); PG8_MMA(0, 1, At, B1); PG8_BAR; PG8_SCHED;
            PG8_LDA(At, 1, 1); PG8_STAGE(PG8_SB(1, 0), b3, voffB); PG8_STAGE(PG8_SB(1, 1), b3 + hstep, voffB); PG8_STAGE(PG8_SA(1, 0), a3, voffA);
            PG8_WAIT_V(8); PG8_WAIT_L(0); PG8_BAR; PG8_MMA(1, 0, At, B0); PG8_MMA(1, 1, At, B1); PG8_BAR; PG8_SCHED;
            } else {
            PG8_LDB(B0, 0, 0); PG8_SCHED; PG8_LDA(At, 0, 0); PG8_STAGE(PG8_SA(1, 1), a1 + hstep, voffA);
            PG8_WAIT_L(8); PG8_BAR; PG8_WAIT_L(0); PG8_MMA(0, 0, At, B0); PG8_BAR; PG8_SCHED;
            PG8_LDB(B1, 0, 1); PG8_STAGE(PG8_SB(0, 0), b2, voffB);
            PG8_BAR; PG8_WAIT_L(0); PG8_MMA(0, 1, At, B1); PG8_BAR;
            PG8_LDA(At, 0, 1); PG8_STAGE(PG8_SA(0, 0), a2, voffA);
            PG8_BAR; PG8_WAIT_L(0); PG8_MMA(1, 0, At, B0); PG8_BAR; PG8_SCHED;
            PG8_STAGE(PG8_SB(0, 1), b2 + hstep, voffB);
            PG8_WAIT_V(6); PG8_BAR; PG8_MMA(1, 1, At, B1); PG8_BAR;
            PG8_LDB(B0, 1, 0); PG8_SCHED; PG8_LDA(At, 1, 0); PG8_STAGE(PG8_SA(0, 1), a2 + hstep, voffA);
            PG8_WAIT_L(8); PG8_BAR; PG8_WAIT_L(0); PG8_MMA(0, 0, At, B0); PG8_BAR; PG8_SCHED;
            PG8_LDB(B1, 1, 1); PG8_STAGE(PG8_SB(1, 0), b3, voffB);
            PG8_BAR; PG8_WAIT_L(0); PG8_MMA(0, 1, At, B1); PG8_BAR;
            PG8_LDA(At, 1, 1); PG8_STAGE(PG8_SA(1, 0), a3, voffA);
            PG8_BAR; PG8_WAIT_L(0); PG8_MMA(1, 0, At, B0); PG8_BAR; PG8_SCHED;
            PG8_STAGE(PG8_SB(1, 1), b3 + hstep, voffB);
            PG8_WAIT_V(6); PG8_BAR; PG8_MMA(1, 1, At, B1); PG8_BAR;
            }
        }
        if constexpr (ALIGN_EPI) { if (wr == 0) PG8_BAR; }
        if constexpr (!Epi::AFTER_DRAIN) { E(acc, cur, wr, wc, fr, fq); S.done(cur); }
        if (!has_next) break;
#pragma unroll
        for (int a = 0; a < 2; ++a)
#pragma unroll
            for (int b = 0; b < 2; ++b)
#pragma unroll
                for (int m = 0; m < 4; ++m)
#pragma unroll
                    for (int n = 0; n < 2; ++n) acc[a][b][m][n] = (f32x4){0.f, 0.f, 0.f, 0.f};
        cur = nxt; cA = nA; cB = nB; ++ui;
        if constexpr (ALIGN_EPI) { if (wr == 1) PG8_BAR; }
    }
    PG8_WAIT_V(0);
    if constexpr (!ALIGN_EPI) { if (wr == 0) PG8_BAR; }
    PG8_BAR;
    if constexpr (Epi::AFTER_DRAIN) { E.fused(acc, cur, wr, wc, fr, fq, lds, wid, lane); S.done(cur); }
#undef PG8_SA
#undef PG8_SB
#undef PG8_STAGE
#undef PG8_LDA
#undef PG8_LDB
#undef PG8_MMA
#undef PG8_LD32
#undef PG8_WAIT_V
#undef PG8_WAIT_L
#undef PG8_BAR
#undef PG8_SCHED
}
}

typedef unsigned short bf16_t;
typedef float f32x4 __attribute__((ext_vector_type(4)));
typedef unsigned u32x4 __attribute__((ext_vector_type(4)));
#define LAS __attribute__((address_space(3)))

constexpr int NT = 512;
constexpr int LDS_BYTES = 160 * 1024;
constexpr int D = 2048, NB = 4, SEQ = 4096, CTXL = 256;
constexpr int MT = NB * SEQ;
constexpr int MC = NB * CTXL;
constexpr int MA = MT + MC;
constexpr int NQKVP = 6400;
constexpr int PQ_LD = 6144;
constexpr int NHY = 6144, NZG = 6144;
constexpr int WT_ROWS = NQKVP + NHY + NZG;
constexpr int WT_HY0 = NQKVP, WT_ZG0 = NQKVP + NHY;
constexpr float ALPHA = 1.189207115002721f;

constexpr size_t MiB = (size_t)1 << 20;
constexpr size_t WS_MOD = 0, WS_HID2 = 1 * MiB, WS_SW = 2 * MiB, WS_HA = 34 * MiB, WS_WT = 102 * MiB, WS_RA = 175 * MiB, WS_RB = 367 * MiB, WS_AB = 580 * MiB, WS_END = 658 * MiB;
constexpr size_t WS_HA8 = 658 * MiB;
constexpr size_t WT8_OFF = (size_t)6144 * 2048 * 2;

struct Args { const float* in[31]; float* out; unsigned char* ws; int ph_lo, ph_hi; int reps[8]; int pad2[2]; };
typedef const __attribute__((address_space(4))) Args* KA;

__device__ __forceinline__ unsigned f2bf(float f) { unsigned u = __float_as_uint(f); return (u + 0x7fffu + ((u >> 16) & 1u)) >> 16; }
__device__ __forceinline__ unsigned pk2(float lo, float hi) { return f2bf(lo) | (f2bf(hi) << 16); }
__device__ __forceinline__ float bflo(unsigned w) { return __uint_as_float(w << 16); }
__device__ __forceinline__ float bfhi(unsigned w) { return __uint_as_float(w & 0xffff0000u); }
__device__ __forceinline__ float bf2f(bf16_t b) { return __uint_as_float(((unsigned)b) << 16); }
__device__ __forceinline__ void unpack8(const u32x4 w, float (&o)[8]) { o[0] = bflo(w.x); o[1] = bfhi(w.x); o[2] = bflo(w.y); o[3] = bfhi(w.y); o[4] = bflo(w.z); o[5] = bfhi(w.z); o[6] = bflo(w.w); o[7] = bfhi(w.w); }
__device__ __forceinline__ u32x4 pack8(const float (&v)[8]) { u32x4 w; w.x = pk2(v[0], v[1]); w.y = pk2(v[2], v[3]); w.z = pk2(v[4], v[5]); w.w = pk2(v[6], v[7]); return w; }
typedef short bf16x8 __attribute__((ext_vector_type(8)));
typedef unsigned u32x2 __attribute__((ext_vector_type(2)));
#define MFMA16(a, b, c) __builtin_amdgcn_mfma_f32_16x16x32_bf16((a), (b), (c), 0, 0, 0)
__device__ __forceinline__ u32x2 pk4(float a, float b, float c, float d) { u32x2 w; w.x = pk2(a, b); w.y = pk2(c, d); return w; }
__device__ __forceinline__ float sigmoidf_(float x) { return 1.0f / (1.0f + expf(-x)); }
__device__ __forceinline__ float siluf_(float x) { return x / (1.0f + expf(-x)); }
__device__ __forceinline__ float rdlane(float v, const int l) { return __builtin_bit_cast(float, __builtin_amdgcn_readlane(__builtin_bit_cast(int, v), l)); }
__device__ __forceinline__ float wave_sum(float v) {
    v += __builtin_bit_cast(float, __builtin_amdgcn_update_dpp(0, __builtin_bit_cast(int, v), 0x128, 0xf, 0xf, false));
    v += __builtin_bit_cast(float, __builtin_amdgcn_update_dpp(0, __builtin_bit_cast(int, v), 0x124, 0xf, 0xf, false));
    v += __builtin_bit_cast(float, __builtin_amdgcn_update_dpp(0, __builtin_bit_cast(int, v), 0x122, 0xf, 0xf, false));
    v += __builtin_bit_cast(float, __builtin_amdgcn_update_dpp(0, __builtin_bit_cast(int, v), 0x121, 0xf, 0xf, false));
    return (rdlane(v, 0) + rdlane(v, 16)) + (rdlane(v, 32) + rdlane(v, 48));
}
__device__ __forceinline__ float wave_max(float v) {
    v = fmaxf(v, __builtin_bit_cast(float, __builtin_amdgcn_update_dpp(0, __builtin_bit_cast(int, v), 0x128, 0xf, 0xf, false)));
    v = fmaxf(v, __builtin_bit_cast(float, __builtin_amdgcn_update_dpp(0, __builtin_bit_cast(int, v), 0x124, 0xf, 0xf, false)));
    v = fmaxf(v, __builtin_bit_cast(float, __builtin_amdgcn_update_dpp(0, __builtin_bit_cast(int, v), 0x122, 0xf, 0xf, false)));
    v = fmaxf(v, __builtin_bit_cast(float, __builtin_amdgcn_update_dpp(0, __builtin_bit_cast(int, v), 0x121, 0xf, 0xf, false)));
    return fmaxf(fmaxf(rdlane(v, 0), rdlane(v, 16)), fmaxf(rdlane(v, 32), rdlane(v, 48)));
}

__device__ void p0_mod_hid2(KA a, float* lf) {
    const int tid = tid_opaque(), bid = blockIdx.x;
    if (bid < 192) {
        const float* c = a->in[1]; const float* cc = a->in[3]; const float* w_ada = a->in[4]; const float* b_ada = a->in[5];
        float* mod = (float*)(a->ws + WS_MOD);
        for (int i = tid; i < 5 * 2048; i += NT) { const int r = i >> 11, k = i & 2047; const float v = (r < 4) ? c[r * 2048 + k] : cc[k]; lf[i] = siluf_(v); }
        __syncthreads();
        const int cl = tid & 63, kg = tid >> 6, col = bid * 64 + cl;
        float a0 = 0.f, a1 = 0.f, a2 = 0.f, a3 = 0.f, a4 = 0.f;
#pragma unroll 8
        for (int k = kg * 256; k < kg * 256 + 256; ++k) {
            const float w = w_ada[(size_t)k * 12288 + col];
            a0 += lf[k] * w; a1 += lf[2048 + k] * w; a2 += lf[4096 + k] * w; a3 += lf[6144 + k] * w; a4 += lf[8192 + k] * w;
        }
        float* red = lf + 5 * 2048;
        red[(kg * 5 + 0) * 64 + cl] = a0; red[(kg * 5 + 1) * 64 + cl] = a1; red[(kg * 5 + 2) * 64 + cl] = a2; red[(kg * 5 + 3) * 64 + cl] = a3; red[(kg * 5 + 4) * 64 + cl] = a4;
        __syncthreads();
        if (tid < 320) { const int r = tid >> 6; float s = 0.f;
#pragma unroll
            for (int g = 0; g < 8; ++g) s += red[(g * 5 + r) * 64 + cl];
            mod[r * 12288 + col] = s + b_ada[col]; }
        __syncthreads();
    } else {
        const float* w1 = a->in[12]; const float* b1 = a->in[13]; const float* w2 = a->in[14]; const float* b2 = a->in[15]; const float* freq = a->in[18];
        float* hid2 = (float*)(a->ws + WS_HID2);
        const int pb = (bid - 192) * 64, j = tid & 63, pl = tid >> 6;
        const float fj = freq[j];
        for (int it = 0; it < 8; ++it) {
            const int pos = pb + it * 8 + pl;
            const float tt = (float)pos * (1.0f / 4095.0f);
            float s1 = tt * w1[j];
            const float base = (6.283185307179586f / 4096.0f) * (float)pos;
            for (int e = 0; e < 16; ++e) {
                const float band = 1e-4f + (float)e * ((15.0f - 1e-4f) / 15.0f);
                const float ang = base * band;
                s1 += cosf(ang) * w1[(1 + e) * 64 + j] - sinf(ang) * w1[(17 + e) * 64 + j];
            }
            lf[pl * 64 + j] = sinf(fj * (s1 + b1[j]));
            __syncthreads();
            float s2 = 0.f;
            for (int i = 0; i < 64; ++i) s2 += lf[pl * 64 + i] * w2[i * 64 + j];
            hid2[pos * 64 + j] = sinf(fj * (s2 + b2[j]));
            __syncthreads();
        }
    }
}

__device__ void transpose_unit(const float* src, int ldn, int n0src, bf16_t* dst, int nb, int kb, float* tile) {
    const int tid = tid_opaque(), r = tid >> 4, c4 = tid & 15;
#pragma unroll
    for (int i = 0; i < 4; ++i) {
        const int kk = i * 32 + r;
        f32x4 v = (f32x4){0.f, 0.f, 0.f, 0.f};
        if (n0src >= 0) v = *(const f32x4*)(src + (size_t)(kb * 128 + kk) * ldn + n0src + c4 * 4);
        float* t = tile + kk * 65 + c4 * 4; t[0] = v.x; t[1] = v.y; t[2] = v.z; t[3] = v.w;
    }
    __syncthreads();
#pragma unroll
    for (int i = 0; i < 2; ++i) {
        const int chunk = tid + i * NT, nr = chunk >> 4, kc = chunk & 15;
        const float* t = tile + (kc * 8) * 65 + nr;
        u32x4 w; w.x = pk2(t[0], t[65]); w.y = pk2(t[130], t[195]); w.z = pk2(t[260], t[325]); w.w = pk2(t[390], t[455]);
        *(u32x4*)(dst + (size_t)(nb * 64 + nr) * 2048 + kb * 128 + kc * 8) = w;
    }
    __syncthreads();
}
__device__ __forceinline__ unsigned pk4_fp8(float a, float b, float c, float d) { int w = __builtin_amdgcn_cvt_pk_fp8_f32(a, b, 0, false); w = __builtin_amdgcn_cvt_pk_fp8_f32(c, d, w, true); return (unsigned)w; }
__device__ void transpose_unit8(const float* src, int ldn, int n0src, unsigned char* dst, int nb, int kb, float* tile) {
    const int tid = tid_opaque(), r = tid >> 4, c4 = tid & 15;
#pragma unroll
    for (int i = 0; i < 4; ++i) {
        const int kk = i * 32 + r;
        f32x4 v = (f32x4){0.f, 0.f, 0.f, 0.f};
        if (n0src >= 0) v = *(const f32x4*)(src + (size_t)(kb * 128 + kk) * ldn + n0src + c4 * 4);
        float* t = tile + kk * 65 + c4 * 4; t[0] = v.x * 64.0f; t[1] = v.y * 64.0f; t[2] = v.z * 64.0f; t[3] = v.w * 64.0f;
    }
    __syncthreads();
    {
        const int nr = tid >> 3, kc = tid & 7;
        const float* t = tile + (kc * 16) * 65 + nr;
        u32x4 w;
        w.x = pk4_fp8(t[0], t[65], t[130], t[195]); w.y = pk4_fp8(t[260], t[325], t[390], t[455]);
        w.z = pk4_fp8(t[520], t[585], t[650], t[715]); w.w = pk4_fp8(t[780], t[845], t[910], t[975]);
        *(u32x4*)(dst + (size_t)(nb * 64 + nr) * 2048 + kb * 128 + kc * 16) = w;
    }
    __syncthreads();
}
__device__ __forceinline__ int win_colmap(int np) {
    if (np < 6144) return np;
    if (np < 6208) return 8192 + (np - 6144);
    if (np < 6400) return -1;
    if (np < 12544) return 8256 + (np - 6400);
    if (np < 14592) return 6144 + (np - 12544);
    return 14400 + (np - 14592);
}
__device__ void p0_transposes(KA a, float* lf) {
    bf16_t* WT = (bf16_t*)(a->ws + WS_WT); bf16_t* SW = (bf16_t*)(a->ws + WS_SW);
    const int NU_WT = (WT_ROWS / 64) * 16, NU_SW = 4 * 32 * 16;
    for (int u = blockIdx.x; u < NU_WT + NU_SW; u += gridDim.x) {
        if (u < NU_WT) { const int nb = u >> 4, kb = u & 15;
            if (nb >= 100 && nb < 196) transpose_unit(a->in[6], 18496, win_colmap(nb * 64), WT, nb - 100, kb, lf);
            else transpose_unit8(a->in[6], 18496, win_colmap(nb * 64), (unsigned char*)WT + WT8_OFF, nb < 100 ? nb : nb - 96, kb, lf); }
        else { const int v = u - NU_WT, mtx = v >> 9, nb = (v >> 4) & 31, kb = v & 15;
            const float* src = (mtx == 0) ? a->in[20] : (mtx == 1) ? a->in[21] : (mtx == 2) ? a->in[22] : a->in[25];
            transpose_unit(src, 2048, nb * 64, SW + (size_t)mtx * 2048 * 2048, nb, kb, lf); }
    }
}

__device__ void p1_ha(KA a) {
    const float* mod = (const float*)(a->ws + WS_MOD); bf16_t* HA = (bf16_t*)(a->ws + WS_HA); unsigned char* HA8 = a->ws + WS_HA8;
    const size_t nthr = (size_t)gridDim.x * NT;
    for (size_t i = (size_t)blockIdx.x * NT + tid_opaque(); i < (size_t)MA * 128; i += nthr) {
        const int row = (int)(i >> 7), k16 = (int)(i & 127) * 16;
        const float* sp; int mr;
        if (row < MT) { sp = a->in[0] + (size_t)row * 2048 + k16; mr = row >> 12; } else { sp = a->in[2] + (size_t)(row - MT) * 2048 + k16; mr = 4; }
        const float* mp = mod + mr * 12288 + k16;
        u32x4 w8, wlo, whi;
#pragma unroll
        for (int j = 0; j < 4; ++j) {
            const f32x4 x = *(const f32x4*)(sp + j * 4), hh = *(const f32x4*)(mp + j * 4), ss = *(const f32x4*)(mp + 2048 + j * 4);
            const float v0 = x[0] * (1.0f + ss[0]) + hh[0], v1 = x[1] * (1.0f + ss[1]) + hh[1], v2 = x[2] * (1.0f + ss[2]) + hh[2], v3 = x[3] * (1.0f + ss[3]) + hh[3];
            w8[j] = pk4_fp8(v0, v1, v2, v3);
            if (j < 2) { wlo[2 * j] = pk2(v0, v1); wlo[2 * j + 1] = pk2(v2, v3); } else { whi[2 * (j - 2)] = pk2(v0, v1); whi[2 * (j - 2) + 1] = pk2(v2, v3); }
        }
        if (row < MT) { *(u32x4*)(HA + (size_t)row * 2048 + k16) = wlo; *(u32x4*)(HA + (size_t)row * 2048 + k16 + 8) = whi; }
        *(u32x4*)(HA8 + (size_t)row * 2048 + k16) = w8;
    }
}

struct FStoreBf16 { bf16_t* O; int ldc; float sc;
    __device__ __forceinline__ void operator()(int row, int col, const f32x4 a0, const f32x4 a1) const {
        const f32x4 v0 = a0 * sc, v1 = a1 * sc;
        u32x4 w; w.x = pg8::cvt_pk_bf16(v0[0], v0[1]); w.y = pg8::cvt_pk_bf16(v0[2], v0[3]); w.z = pg8::cvt_pk_bf16(v1[0], v1[1]); w.w = pg8::cvt_pk_bf16(v1[2], v1[3]);
        *(u32x4*)(O + (size_t)row * ldc + col) = w; } };
struct FStoreQKV { bf16_t* PQ; float* AB; float sc;
    __device__ __forceinline__ void operator()(int row, int col, const f32x4 a0, const f32x4 a1) const {
        const f32x4 v0 = a0 * sc, v1 = a1 * sc;
        if (col < 6144) { u32x4 w; w.x = pg8::cvt_pk_bf16(v0[0], v0[1]); w.y = pg8::cvt_pk_bf16(v0[2], v0[3]); w.z = pg8::cvt_pk_bf16(v1[0], v1[1]); w.w = pg8::cvt_pk_bf16(v1[2], v1[3]);
            *(u32x4*)(PQ + (size_t)row * PQ_LD + col) = w; }
        else if (col < 6208) { float* p = AB + (size_t)row * 64 + (col - 6144); *(f32x4*)p = v0; *(f32x4*)(p + 4) = v1; } } };
struct FStoreF32 { float* O; int ldc;
    __device__ __forceinline__ void operator()(int row, int col, const f32x4 v0, const f32x4 v1) const { float* p = O + (size_t)row * ldc + col; *(f32x4*)p = v0; *(f32x4*)(p + 4) = v1; } };
struct FGatePA { const bf16_t* ZG; bf16_t* MG;
    __device__ __forceinline__ void operator()(int row, int col, const f32x4 v0, const f32x4 v1) const {
        float g[8]; unpack8(*(const u32x4*)(ZG + (size_t)row * NZG + 2048 + col), g);
        float o[8];
#pragma unroll
        for (int e = 0; e < 4; ++e) { o[e] = sigmoidf_(g[e]) * v0[e]; o[4 + e] = sigmoidf_(g[4 + e]) * v1[e]; }
        *(u32x4*)(MG + (size_t)row * 2048 + col) = pack8(o); } };
struct FGatePH { const bf16_t* ZG; bf16_t* MG;
    __device__ __forceinline__ void operator()(int row, int col, const f32x4 v0, const f32x4 v1) const {
        float g[8], t[8]; unpack8(*(const u32x4*)(ZG + (size_t)row * NZG + 4096 + col), g); unpack8(*(const u32x4*)(MG + (size_t)row * 2048 + col), t);
        float o[8];
#pragma unroll
        for (int e = 0; e < 4; ++e) { o[e] = t[e] + sigmoidf_(g[e]) * v0[e]; o[4 + e] = t[4 + e] + sigmoidf_(g[4 + e]) * v1[e]; }
        *(u32x4*)(MG + (size_t)row * 2048 + col) = pack8(o); } };
struct FOut { const float* x; const float* mod; float* T3;
    __device__ __forceinline__ void operator()(int row, int col, const f32x4 v0, const f32x4 v1) const {
        const float* xp = x + (size_t)row * 2048 + col; const float* gp = mod + (row >> 12) * 12288 + 4096 + col;
        const f32x4 x0 = *(const f32x4*)xp, x1 = *(const f32x4*)(xp + 4), g0 = *(const f32x4*)gp, g1 = *(const f32x4*)(gp + 4);
        float* p = T3 + (size_t)row * 2048 + col;
#if DBG_MODE == 1
        *(f32x4*)p = ALPHA * x0; *(f32x4*)(p + 4) = ALPHA * x1;
#else
        *(f32x4*)p = ALPHA * x0 + g0 * v0; *(f32x4*)(p + 4) = ALPHA * x1 + g1 * v1;
#endif
    } };

template <class F> __device__ __forceinline__ void run_gemm8(unsigned char* lds, const unsigned char* A8, const unsigned char* Bt8, int M, int N, const F& f) {
    pg8::Gemm g{(const bf16_t*)A8, (const bf16_t*)Bt8, M, N, 1024}; pg8::StaticOrder S; S.init(M, N, (int)gridDim.x, (int)blockIdx.x);
    pg8::EpiGen<F> E{f};
    pg8::gemm_phase8<pg8::EpiGen<F>, pg8::StaticOrder, true, true>((PG8_LAS unsigned char*)lds, g, S, E);
}
template <class F> __device__ __forceinline__ void run_gemm(unsigned char* lds, const bf16_t* A, const bf16_t* Bt, int M, int N, const F& f) {
    pg8::Gemm g{A, Bt, M, N, 2048}; pg8::StaticOrder S; S.init(M, N, (int)gridDim.x, (int)blockIdx.x);
    pg8::EpiGen<F> E{f};
    pg8::gemm_phase<pg8::EpiGen<F>, pg8::StaticOrder, true, true>((PG8_LAS unsigned char*)lds, g, S, E);
}

typedef float f32x2 __attribute__((ext_vector_type(2)));
constexpr int HY_Z = 0, HY_F = 69632, HY_TW4 = 139264, HY_TW8 = 141312, HY_TW32 = 143360, HY_W3 = 143488;
__device__ __forceinline__ f32x2 cmul(const f32x2 a, const f32x2 b) { return (f32x2){a.x * b.x - a.y * b.y, a.x * b.y + a.y * b.x}; }
__device__ __forceinline__ f32x2 cmulc(const f32x2 a, const f32x2 b) { return (f32x2){a.x * b.x + a.y * b.y, a.y * b.x - a.x * b.y}; }
template <bool INV> __device__ __forceinline__ f32x2 ctw(const f32x2 v, const float wr, const float wi) {
    return INV ? (f32x2){v.x * wr + v.y * wi, v.y * wr - v.x * wi} : (f32x2){v.x * wr - v.y * wi, v.y * wr + v.x * wi};
}
template <bool INV> __device__ __forceinline__ void dft16(f32x2 (&x)[16]) {
    constexpr float C = 0.9238795325112867f, S = 0.3826834323650898f, R = 0.7071067811865476f;
    f32x2 A[4][4];
#pragma unroll
    for (int q0 = 0; q0 < 4; ++q0) {
        const f32x2 a = x[q0], b = x[4 + q0], c = x[8 + q0], d = x[12 + q0];
        const f32x2 t0 = a + c, t1 = a - c, t2 = b + d, t3 = b - d;
        const f32x2 m = (f32x2){t3.y, -t3.x};
        A[q0][0] = t0 + t2; A[q0][2] = t0 - t2;
        A[q0][1] = INV ? (t1 - m) : (t1 + m); A[q0][3] = INV ? (t1 + m) : (t1 - m);
    }
    A[1][1] = ctw<INV>(A[1][1], C, -S); A[1][2] = ctw<INV>(A[1][2], R, -R); A[1][3] = ctw<INV>(A[1][3], S, -C);
    A[2][1] = ctw<INV>(A[2][1], R, -R); A[2][2] = ctw<INV>(A[2][2], 0.f, -1.f); A[2][3] = ctw<INV>(A[2][3], -R, -R);
    A[3][1] = ctw<INV>(A[3][1], S, -C); A[3][2] = ctw<INV>(A[3][2], -R, -R); A[3][3] = ctw<INV>(A[3][3], -C, S);
#pragma unroll
    for (int s = 0; s < 4; ++s) {
        const f32x2 t0 = A[0][s] + A[2][s], t1 = A[0][s] - A[2][s], t2 = A[1][s] + A[3][s], t3 = A[1][s] - A[3][s];
        const f32x2 m = (f32x2){t3.y, -t3.x};
        x[s] = t0 + t2; x[s + 8] = t0 - t2;
        x[s + 4] = INV ? (t1 - m) : (t1 + m); x[s + 12] = INV ? (t1 + m) : (t1 - m);
    }
}
template <bool INV> __device__ __forceinline__ void apply_tw(f32x2 (&x)[16], const f32x2 w) {
    f32x2 wr = w;
#pragma unroll
    for (int r = 1; r < 16; ++r) { x[r] = INV ? cmulc(x[r], wr) : cmul(x[r], wr); if (r < 15) wr = cmul(wr, w); }
}
__device__ __forceinline__ void fft_pass2_fwd(f32x2* B, int t, const f32x2* TW4) {
    const int base = 272 * (t >> 4) + (t & 15); f32x2 x[16];
#pragma unroll
    for (int q = 0; q < 16; ++q) x[q] = B[base + 17 * q];
    dft16<false>(x); apply_tw<false>(x, TW4[16 * (t & 15)]);
#pragma unroll
    for (int q = 0; q < 16; ++q) B[base + 17 * q] = x[q];
}
__device__ __forceinline__ void fft_pass2_inv(f32x2* B, int t, const f32x2* TW4) {
    const int base = 272 * (t >> 4) + (t & 15); f32x2 x[16];
#pragma unroll
    for (int q = 0; q < 16; ++q) x[q] = B[base + 17 * q];
    apply_tw<true>(x, TW4[16 * (t & 15)]); dft16<true>(x);
#pragma unroll
    for (int q = 0; q < 16; ++q) B[base + 17 * q] = x[q];
}
__device__ __forceinline__ float conv3_lane(float c, int lane, float w0, float w1, float w2) {
    (void)lane;
    const float up = __builtin_bit_cast(float, __builtin_amdgcn_update_dpp(0, __builtin_bit_cast(int, c), 0x138, 0xf, 0xf, true));
    const float dn = __builtin_bit_cast(float, __builtin_amdgcn_update_dpp(0, __builtin_bit_cast(int, c), 0x130, 0xf, 0xf, true));
    return w0 * up + w1 * c + w2 * dn;
}
constexpr size_t WS_FILT = 585 * MiB;
__device__ void filt_unit(KA a, int unit, unsigned char* lds) {
    const int tid = tid_opaque(), lane = tid & 63, w = tid >> 6, fr = lane & 15, fq = lane >> 4;
    const int c0 = (unit >> 3) * 64, pc = (unit & 7) * 512;
    bf16_t* Bt = (bf16_t*)lds;
    const float* w3 = a->in[16]; const float* b3 = a->in[17]; const float* hid2 = (const float*)(a->ws + WS_HID2);
    bf16_t* FILT = (bf16_t*)(a->ws + WS_FILT);
    __syncthreads();
#pragma unroll
    for (int i = 0; i < 8; ++i) {
        const int idx = tid + i * NT, k = idx >> 6, q = (idx >> 4) & 3, c4 = idx & 15;
        const f32x4 v = *(const f32x4*)(w3 + (size_t)k * 8192 + (q >> 1) * 4096 + (q & 1) * 2048 + c0 + c4 * 4);
        bf16_t* bp = Bt + (q * 64 + c4 * 4) * 72 + k;
        bp[0] = (bf16_t)f2bf(v.x); bp[72] = (bf16_t)f2bf(v.y); bp[144] = (bf16_t)f2bf(v.z); bp[216] = (bf16_t)f2bf(v.w);
    }
    __syncthreads();
#pragma unroll 1
    for (int it = 0; it < 4; ++it) {
        const int p0 = pc + (it * 8 + w) * 16;
        bf16x8 af[2];
#pragma unroll
        for (int kk = 0; kk < 2; ++kk) { const float* hp = hid2 + (size_t)(p0 + fr) * 64 + kk * 32 + fq * 8; const f32x4 x0 = *(const f32x4*)hp, x1 = *(const f32x4*)(hp + 4);
            u32x4 wv; wv.x = pk2(x0[0], x0[1]); wv.y = pk2(x0[2], x0[3]); wv.z = pk2(x1[0], x1[1]); wv.w = pk2(x1[2], x1[3]); af[kk] = __builtin_bit_cast(bf16x8, wv); }
#pragma unroll 4
        for (int n = 0; n < 16; ++n) {
            f32x4 acc = (f32x4){0.f, 0.f, 0.f, 0.f};
#pragma unroll
            for (int kk = 0; kk < 2; ++kk) acc = MFMA16(af[kk], *(const bf16x8*)(Bt + (n * 16 + fr) * 72 + kk * 32 + fq * 8), acc);
            const int q = n >> 2, c = c0 + (n & 3) * 16 + fr;
            const float bias = b3[(q >> 1) * 4096 + (q & 1) * 2048 + c];
            const float dl = (3.0701134573253944f + 12.280453829301578f * ((float)c * (1.0f / 2047.0f))) * (1.0f / 4095.0f);
            const int pos = p0 + 4 * fq;
            const float e0 = expf(-(float)pos * dl), e1 = expf(-(float)(pos + 1) * dl), e2 = expf(-(float)(pos + 2) * dl), e3 = expf(-(float)(pos + 3) * dl);
            *(u32x2*)(FILT + ((size_t)c * 4 + q) * 4096 + pos) = pk4((acc[0] + bias) * e0, (acc[1] + bias) * e1, (acc[2] + bias) * e2, (acc[3] + bias) * e3);
        }
    }
}
__device__ void hyena_setup(unsigned char* lds) {
    const int tid = tid_opaque();
    f32x2* TW4 = (f32x2*)(lds + HY_TW4); f32x2* TW8 = (f32x2*)(lds + HY_TW8); f32x2* TW32 = (f32x2*)(lds + HY_TW32);
    if (tid < 256) { const float a4 = -6.283185307179586f * (float)tid * (1.0f / 4096.0f), a8 = -6.283185307179586f * (float)tid * (1.0f / 8192.0f);
        TW4[tid] = (f32x2){cosf(a4), sinf(a4)}; TW8[tid] = (f32x2){cosf(a8), sinf(a8)}; }
    if (tid < 16) { const float a = -6.283185307179586f * (float)tid * (1.0f / 32.0f); TW32[tid] = (f32x2){cosf(a), sinf(a)}; }
    __syncthreads();
}
struct HyCtx { f32x2* Z; f32x2* Fb0; const f32x2* TW4; const f32x2* TW32; const bf16_t* rv; const bf16_t* rx1; const bf16_t* rx2; bf16_t* YTc; float* Y1S;
    f32x2 w8t, w4t; float cv0, cv1, cv2, cx0, cx1, cx2, cy0, cy1, cy2, sk0, sk1; int tid, br, t, lane, p1; };
template <int ORDER> __device__ __forceinline__ void hyena_conv(const HyCtx& K, int pr) {
    f32x2* Z = K.Z; const f32x2* TW4 = K.TW4; const f32x2* TW32 = K.TW32;
    const bf16_t* rv = K.rv; const bf16_t* rx1 = K.rx1; const bf16_t* rx2 = K.rx2; float* Y1S = K.Y1S;
    int tid = K.tid; asm volatile("" : "+v"(tid));
    const f32x2 w8t = K.w8t, w4t = K.w4t; const int br = tid >> 8, t = tid & 255, lane = tid & 63, p1 = t + (t >> 4);
    f32x2* Zb = K.Z + br * 4352; f32x2* Fb = K.Fb0 + br * 4352;
    const float cv0 = K.cv0, cv1 = K.cv1, cv2 = K.cv2, cx0 = K.cx0, cx1 = K.cx1, cx2 = K.cx2, cy0 = K.cy0, cy1 = K.cy1, cy2 = K.cy2, sk0 = K.sk0, sk1 = K.sk1;
        const int ba = 2 * pr * 4096, bb = ba + 4096;
        {
            f32x2 x[16];
#pragma unroll
            for (int q = 0; q < 16; ++q) {
                const int n = t + 256 * q; float ua, ub;
                if (ORDER == 0) { ua = conv3_lane(bf2f(rv[ba + n]), lane, cv0, cv1, cv2); ub = conv3_lane(bf2f(rv[bb + n]), lane, cv0, cv1, cv2); }
                else { ua = Y1S[n]; ub = Y1S[4096 + n]; }
                const f32x2 z = (f32x2){ua, ub};
                x[q] = br ? cmul(z, cmul(w8t, TW32[q])) : z;
            }
            dft16<false>(x); apply_tw<false>(x, w4t);
#pragma unroll
            for (int q = 0; q < 16; ++q) Zb[p1 + 272 * q] = x[q];
        }
        __syncthreads();
        fft_pass2_fwd(Zb, t, TW4);
        __syncthreads();
        {
            f32x2 x[16];
#pragma unroll
            for (int q = 0; q < 16; ++q) x[q] = Zb[17 * t + q];
            dft16<false>(x);
#pragma unroll
            for (int r = 0; r < 16; ++r) {
                const int p = 16 * t + r; int pp;
                if (br) pp = 4095 - p;
                else { const int m = (r << 8) | ((t & 15) << 4) | (t >> 4); const int mp = (4096 - m) & 4095; pp = ((mp & 15) << 8) | (mp & 0xF0) | (mp >> 8); }
                const f32x2 fk = Fb[p + (p >> 4)], fc = Fb[pp + (pp >> 4)];
                f32x2 H;
                if (ORDER == 0) H = (f32x2){0.5f * (fk.x + fc.x), 0.5f * (fk.y - fc.y)};
                else H = (f32x2){0.5f * (fk.y + fc.y), -0.5f * (fk.x - fc.x)};
                x[r] = cmul(x[r], H);
            }
            dft16<true>(x);
#pragma unroll
            for (int q = 0; q < 16; ++q) Zb[17 * t + q] = x[q];
        }
        __syncthreads();
        fft_pass2_inv(Zb, t, TW4);
        __syncthreads();
        {
            f32x2 x[16];
#pragma unroll
            for (int q = 0; q < 16; ++q) x[q] = Zb[p1 + 272 * q];
            apply_tw<true>(x, w4t); dft16<true>(x);
            if (br) {
#pragma unroll
                for (int q = 0; q < 16; ++q) x[q] = cmulc(x[q], cmul(w8t, TW32[q]));
            }
#pragma unroll
            for (int q = 0; q < 16; ++q) Zb[p1 + 272 * q] = x[q];
        }
        __syncthreads();
#pragma unroll
        for (int i = 0; i < 8; ++i) {
            const int n = tid + i * NT, pn = n + (n >> 4);
            const f32x2 e0 = Z[pn], e1 = Z[4352 + pn];
            const float ca = (e0.x + e1.x) * (1.0f / 8192.0f), cb = (e0.y + e1.y) * (1.0f / 8192.0f);
            if (ORDER == 0) {
                const float va = conv3_lane(bf2f(rv[ba + n]), lane, cv0, cv1, cv2), vb = conv3_lane(bf2f(rv[bb + n]), lane, cv0, cv1, cv2);
                const float xa = conv3_lane(bf2f(rx1[ba + n]), lane, cx0, cx1, cx2), xb = conv3_lane(bf2f(rx1[bb + n]), lane, cx0, cx1, cx2);
                Y1S[n] = xa * (ca + sk0 * va); Y1S[4096 + n] = xb * (cb + sk0 * vb);
            } else {
                const float ya = Y1S[n], yb = Y1S[4096 + n];
                const float xa = conv3_lane(bf2f(rx2[ba + n]), lane, cy0, cy1, cy2), xb = conv3_lane(bf2f(rx2[bb + n]), lane, cy0, cy1, cy2);
                K.YTc[ba + n] = (bf16_t)f2bf(xa * (ca + sk1 * ya)); K.YTc[bb + n] = (bf16_t)f2bf(xb * (cb + sk1 * yb));
            }
        }
        __syncthreads();
}
__device__ void hyena_item(KA a, int c, unsigned char* lds) {
    f32x2* Z = (f32x2*)(lds + HY_Z); f32x2* F = (f32x2*)(lds + HY_F);
    const f32x2* TW4 = (const f32x2*)(lds + HY_TW4); const f32x2* TW8 = (const f32x2*)(lds + HY_TW8); const f32x2* TW32 = (const f32x2*)(lds + HY_TW32);
    float* W3 = (float*)(lds + HY_W3);
    int tid = tid_opaque(); asm volatile("" : "+v"(tid));
    const int br = tid >> 8, t = tid & 255, lane = tid & 63;
    f32x2* Zb = Z + br * 4352; f32x2* Fb = F + br * 4352;
    const float* hid2 = (const float*)(a->ws + WS_HID2);
    const float* w3 = a->in[16]; const float* b3 = a->in[17]; const float* cw = a->in[11]; const float* skip = a->in[19];
    const bf16_t* PHT = (const bf16_t*)(a->ws + WS_RA);
    bf16_t* YT = (bf16_t*)a->out;
    float* Y1S = a->out + (size_t)16 * 1024 * 1024 + (size_t)blockIdx.x * 16384;
    {
        const bf16_t* fp = (const bf16_t*)(a->ws + WS_FILT) + (size_t)c * 4 * 4096 + tid * 8;
        float f0[8], f1[8], f2[8], f3[8];
        unpack8(*(const u32x4*)fp, f0); unpack8(*(const u32x4*)(fp + 4096), f1); unpack8(*(const u32x4*)(fp + 8192), f2); unpack8(*(const u32x4*)(fp + 12288), f3);
#pragma unroll
        for (int e = 0; e < 8; ++e) { Z[tid * 8 + e] = (f32x2){f0[e], f1[e]}; Z[4096 + tid * 8 + e] = (f32x2){f2[e], f3[e]}; }
    }
    __syncthreads();
    const f32x2 w8t = TW8[t], w4t = TW4[t];
    const int p1 = t + (t >> 4);
    {
        f32x2 x[16];
#pragma unroll
        for (int q = 0; q < 16; ++q) {
            const int n = t + 256 * q;
            const f32x2 av = Z[n]; f32x2 bv = Z[8192 - (n ? n : 1)]; if (n == 0) bv = (f32x2){0.f, 0.f};
            x[q] = br ? cmul(av - bv, cmul(w8t, TW32[q])) : (av + bv);
        }
        dft16<false>(x); apply_tw<false>(x, w4t);
#pragma unroll
        for (int q = 0; q < 16; ++q) Fb[p1 + 272 * q] = x[q];
    }
    __syncthreads();
    fft_pass2_fwd(Fb, t, TW4);
    __syncthreads();
    {   f32x2 x[16];
#pragma unroll
        for (int q = 0; q < 16; ++q) x[q] = Fb[17 * t + q];
        dft16<false>(x);
#pragma unroll
        for (int q = 0; q < 16; ++q) Fb[17 * t + q] = x[q];
    }
    __syncthreads();
    const float cv0 = cw[c], cv1 = cw[6144 + c], cv2 = cw[12288 + c];
    const float cx0 = cw[2048 + c], cx1 = cw[6144 + 2048 + c], cx2 = cw[12288 + 2048 + c];
    const float cy0 = cw[4096 + c], cy1 = cw[6144 + 4096 + c], cy2 = cw[12288 + 4096 + c];
    const float sk0 = skip[c], sk1 = skip[2048 + c];
    const bf16_t* rv = PHT + (size_t)c * MT; const bf16_t* rx1 = PHT + (size_t)(2048 + c) * MT; const bf16_t* rx2 = PHT + (size_t)(4096 + c) * MT;
    HyCtx K; K.Z = Z; K.Fb0 = F; K.TW4 = TW4; K.TW32 = TW32; K.rv = rv; K.rx1 = rx1; K.rx2 = rx2; K.YTc = YT + (size_t)c * MT; K.Y1S = Y1S;
    K.w8t = w8t; K.w4t = w4t; K.cv0 = cv0; K.cv1 = cv1; K.cv2 = cv2; K.cx0 = cx0; K.cx1 = cx1; K.cx2 = cx2; K.cy0 = cy0; K.cy1 = cy1; K.cy2 = cy2; K.sk0 = sk0; K.sk1 = sk1;
    K.tid = tid; K.br = br; K.t = t; K.lane = lane; K.p1 = p1;
#pragma unroll 1
    for (int pr = 0; pr < 2; ++pr) { hyena_conv<0>(K, pr); hyena_conv<1>(K, pr); }
}

__device__ void qkvpost_unit(KA a, int unit, unsigned char* lds) {
    const int tid = tid_opaque();
    int ntok, row0, wh;
    if (unit < 12288) { const int gr = unit / 48; wh = unit % 48; ntok = 64; row0 = gr * 64; }
    else { const int uu = unit - 12288; const int b = uu / 48; wh = uu % 48; ntok = 256; row0 = MT + b * 256; }
    const int which = wh >> 4, h = wh & 15, colbase = which * 2048 + h * 128;
    bf16_t* PQ = (bf16_t*)(a->ws + WS_RB);
    bf16_t* raw = (bf16_t*)lds; float* wl = (float*)(lds + 65536);
    const float* cwt = a->in[7];
    for (int i = tid; i < ntok * 16; i += NT) { const int r = i >> 4, c8 = i & 15; *(u32x4*)(raw + r * 128 + c8 * 8) = *(const u32x4*)(PQ + (size_t)(row0 + r) * PQ_LD + colbase + c8 * 8); }
    for (int i = tid; i < 640; i += NT) wl[i] = cwt[(i >> 7) * 6144 + colbase + (i & 127)];
    __syncthreads();
    const int r = tid >> 3, cg = tid & 7;
    for (int rb = 0; rb < ntok / 64; ++rb) {
        const int tok = rb * 64 + r;
        float v[16]; float ss = 0.f;
#pragma unroll
        for (int e = 0; e < 16; ++e) {
            const int ch = cg * 16 + e; float acc = 0.f;
#pragma unroll
            for (int j = 0; j < 5; ++j) { const int tt = tok + j - 2; if (tt >= 0 && tt < ntok) acc += wl[j * 128 + ch] * bf2f(raw[tt * 128 + ch]); }
            const float s = siluf_(acc); v[e] = s; ss += s * s;
        }
        if (which < 2) {
            ss += __shfl_xor(ss, 1, 64); ss += __shfl_xor(ss, 2, 64); ss += __shfl_xor(ss, 4, 64);
            const float sc = rsqrtf(ss + 1e-6f) * (which == 0 ? 0.08838834764831845f : 1.0f);
#pragma unroll
            for (int e = 0; e < 16; ++e) v[e] *= sc;
        }
        bf16_t* op = PQ + (size_t)(row0 + tok) * PQ_LD + colbase + cg * 16;
        u32x4 w0, w1;
        w0.x = pk2(v[0], v[1]); w0.y = pk2(v[2], v[3]); w0.z = pk2(v[4], v[5]); w0.w = pk2(v[6], v[7]);
        w1.x = pk2(v[8], v[9]); w1.y = pk2(v[10], v[11]); w1.z = pk2(v[12], v[13]); w1.w = pk2(v[14], v[15]);
        *(u32x4*)op = w0; *(u32x4*)(op + 8) = w1;
    }
    __syncthreads();
}

typedef short bf16x8 __attribute__((ext_vector_type(8)));
constexpr size_t WS_TS = 585 * MiB, WS_GCB = 653 * MiB;

__device__ void tprep_wave(KA a, int pid, unsigned char* wl) {
    const int lane = tid_opaque() & 63, fr = lane & 15, fq = lane >> 4;
    const int sid = pid / 68, cidx = pid - sid * 68, dir = sid & 1, h = (sid >> 1) & 15, b = sid >> 5;
    bf16_t* kt = (bf16_t*)wl; float* Mf = (float*)wl; float* gcs = (float*)(wl + 17408); float* bes = gcs + 64;
    const bf16_t* PQ = (const bf16_t*)(a->ws + WS_RB); const float* AB = (const float*)(a->ws + WS_AB);
    bf16_t* TS = (bf16_t*)(a->ws + WS_TS) + (size_t)pid * 4096; float* GCB = (float*)(a->ws + WS_GCB) + (size_t)pid * 128;
    int rbase, Tn, p0;
    if (cidx < 4) { rbase = MT + b * CTXL; Tn = CTXL; p0 = cidx * 64; } else { rbase = b * SEQ; Tn = SEQ; p0 = (cidx - 4) * 64; }
    {
        u32x4 kv[16];
#pragma unroll
        for (int it = 0; it < 16; ++it) {
            const int i = it * 4 + fq, p = p0 + i, tok = dir ? (Tn - 1 - p) : p;
            kv[it] = *(const u32x4*)(PQ + (size_t)(rbase + tok) * PQ_LD + 2048 + h * 128 + fr * 8);
        }
#pragma unroll
        for (int it = 0; it < 16; ++it) *(u32x4*)(kt + (it * 4 + fq) * 136 + fr * 8) = kv[it];
    }
    {
        const int p = p0 + lane, tok = dir ? (Tn - 1 - p) : p; const size_t row = (size_t)(rbase + tok);
        const float ab0 = AB[row * 64 + dir * 32 + h], ab1 = AB[row * 64 + dir * 32 + 16 + h];
        const float xx = ab0 + a->in[9][dir * 16 + h]; const float sp = (xx > 20.0f) ? xx : log1pf(expf(xx));
        float gc = -expf(a->in[8][dir * 16 + h]) * sp;
#pragma unroll
        for (int o = 1; o < 64; o <<= 1) { const float tt = __shfl_up(gc, o, 64); if (lane >= o) gc += tt; }
        const float be = sigmoidf_(ab1);
        gcs[lane] = gc; bes[lane] = be; GCB[lane] = gc; GCB[64 + lane] = be;
    }
    f32x4 acc[10];
#pragma unroll
    for (int i = 0; i < 10; ++i) acc[i] = (f32x4){0.f, 0.f, 0.f, 0.f};
#pragma unroll
    for (int kk = 0; kk < 4; ++kk) {
        bf16x8 fg[4];
#pragma unroll
        for (int ct = 0; ct < 4; ++ct) fg[ct] = *(const bf16x8*)(kt + (ct * 16 + fr) * 136 + kk * 32 + fq * 8);
#pragma unroll
        for (int ct = 0; ct < 4; ++ct)
#pragma unroll
            for (int mt = 0; mt <= ct; ++mt) acc[ct * (ct + 1) / 2 + mt] = MFMA16(fg[ct], fg[mt], acc[ct * (ct + 1) / 2 + mt]);
    }
    float gcr[4][4], ber[4][4];
#pragma unroll
    for (int ct = 0; ct < 4; ++ct)
#pragma unroll
        for (int r = 0; r < 4; ++r) { gcr[ct][r] = gcs[ct * 16 + 4 * fq + r]; ber[ct][r] = bes[ct * 16 + 4 * fq + r]; }
    float gcm[4];
#pragma unroll
    for (int mt = 0; mt < 4; ++mt) gcm[mt] = gcs[mt * 16 + fr];
    asm volatile("s_waitcnt lgkmcnt(0)" ::: "memory");
#pragma unroll
    for (int ct = 0; ct < 4; ++ct)
#pragma unroll
        for (int mt = 0; mt < 4; ++mt)
#pragma unroll
            for (int r = 0; r < 4; ++r) {
                const int c = ct * 16 + 4 * fq + r, m = mt * 16 + fr;
                float val = 0.0f;
                if (mt <= ct) val = (m < c) ? ber[ct][r] * acc[(mt <= ct) ? (ct * (ct + 1) / 2 + mt) : 0][r] * expf(gcr[ct][r] - gcm[mt]) : 0.0f;
                Mf[c * 68 + m] = val;
            }
    asm volatile("s_waitcnt lgkmcnt(0)" ::: "memory");
    Mf[lane] = (lane == 0) ? 1.0f : 0.0f;
    asm volatile("s_waitcnt lgkmcnt(0)" ::: "memory");
#define TSUB_ROWS(NCH, I0, I1) \
    _Pragma("unroll 1") for (int i = (I0); i < (I1); ++i) { \
        const float* mr = Mf + i * 68; float s0 = 0.f, s1 = 0.f, s2 = 0.f, s3 = 0.f; \
        _Pragma("unroll") for (int ch = 0; ch < (NCH); ++ch) { \
            const f32x4 ma = *(const f32x4*)(mr + ch * 16), mb = *(const f32x4*)(mr + ch * 16 + 4), mc = *(const f32x4*)(mr + ch * 16 + 8), md = *(const f32x4*)(mr + ch * 16 + 12); \
            const float* tp = Mf + ch * 16 * 68 + lane; \
            s0 -= ma.x * tp[0]; s1 -= ma.y * tp[68]; s2 -= ma.z * tp[136]; s3 -= ma.w * tp[204]; s0 -= mb.x * tp[272]; s1 -= mb.y * tp[340]; s2 -= mb.z * tp[408]; s3 -= mb.w * tp[476]; \
            s0 -= mc.x * tp[544]; s1 -= mc.y * tp[612]; s2 -= mc.z * tp[680]; s3 -= mc.w * tp[748]; s0 -= md.x * tp[816]; s1 -= md.y * tp[884]; s2 -= md.z * tp[952]; s3 -= md.w * tp[1020]; } \
        const float tv = ((s0 + s1) + (s2 + s3)) + ((lane == i) ? 1.0f : 0.0f); \
        asm volatile("s_waitcnt lgkmcnt(0)" ::: "memory"); \
        Mf[i * 68 + lane] = tv; \
        asm volatile("s_waitcnt lgkmcnt(0)" ::: "memory"); }
    TSUB_ROWS(1, 1, 16)
    TSUB_ROWS(2, 16, 32)
    TSUB_ROWS(3, 32, 48)
    TSUB_ROWS(4, 48, 64)
#undef TSUB_ROWS
#pragma unroll
    for (int it = 0; it < 8; ++it) {
        const int row = it * 8 + (lane >> 3), c8 = (lane & 7) * 8;
        const f32x4 x0 = *(const f32x4*)(Mf + row * 68 + c8), x1 = *(const f32x4*)(Mf + row * 68 + c8 + 4);
        u32x4 wv; wv.x = pk2(x0[0], x0[1]); wv.y = pk2(x0[2], x0[3]); wv.z = pk2(x1[0], x1[1]); wv.w = pk2(x1[2], x1[3]);
        *(u32x4*)(TS + row * 64 + c8) = wv;
    }
    asm volatile("s_waitcnt lgkmcnt(0)" ::: "memory");
}

constexpr int DL_QN = 0, DL_KN = 17408, DL_WN = 34816, DL_ST = 52224, DL_KT = 69632, DL_VT = 88064, DL_T1 = 97280, DL_T2 = 106496, DL_AT = 115712, DL_VN = 124928, DL_VD = 134144, DL_GS = 143360;
struct DStage { u32x4 q0, q1, k0, k1, v, t; f32x4 g0, g1, b0, b1; float bi, gl, g63; };
__device__ __forceinline__ void dstage_load(DStage& R, const bf16_t* PQ, const bf16_t* TS, const float* GCB, int sid, int cidx, int dir, int h, int b, int dvh, int tid) {
    const int i = tid >> 3, part = tid & 7;
    int rbase, Tn, p0;
    if (cidx < 4) { rbase = MT + b * CTXL; Tn = CTXL; p0 = cidx * 64; } else { rbase = b * SEQ; Tn = SEQ; p0 = (cidx - 4) * 64; }
    const int p = p0 + i, tok = dir ? (Tn - 1 - p) : p;
    const bf16_t* rp = PQ + (size_t)(rbase + tok) * PQ_LD + h * 128;
    R.q0 = *(const u32x4*)(rp + part * 16); R.q1 = *(const u32x4*)(rp + part * 16 + 8);
    R.k0 = *(const u32x4*)(rp + 2048 + part * 16); R.k1 = *(const u32x4*)(rp + 2048 + part * 16 + 8);
    R.v = *(const u32x4*)(rp + 4096 + dvh * 64 + part * 8);
    const size_t pid = (size_t)sid * 68 + cidx;
    R.t = *(const u32x4*)(TS + pid * 4096 + i * 64 + part * 8);
    const float* gp = GCB + pid * 128;
    R.g0 = *(const f32x4*)(gp + part * 8); R.g1 = *(const f32x4*)(gp + part * 8 + 4);
    R.b0 = *(const f32x4*)(gp + 64 + part * 8); R.b1 = *(const f32x4*)(gp + 64 + part * 8 + 4);
    R.bi = gp[64 + i]; R.gl = gp[tid & 63]; R.g63 = gp[63];
}
__device__ __forceinline__ void dstage_store(const DStage& R, unsigned char* lds, int tid) {
    const int i = tid >> 3, part = tid & 7;
    bf16_t* QN = (bf16_t*)(lds + DL_QN); bf16_t* KN = (bf16_t*)(lds + DL_KN); bf16_t* KT = (bf16_t*)(lds + DL_KT); bf16_t* VT = (bf16_t*)(lds + DL_VT);
    bf16_t* T1 = (bf16_t*)(lds + DL_T1); bf16_t* T2 = (bf16_t*)(lds + DL_T2); float* GS = (float*)(lds + DL_GS);
    *(u32x4*)(QN + i * 136 + part * 16) = R.q0; *(u32x4*)(QN + i * 136 + part * 16 + 8) = R.q1;
    *(u32x4*)(KN + i * 136 + part * 16) = R.k0; *(u32x4*)(KN + i * 136 + part * 16 + 8) = R.k1;
    const unsigned kw[8] = {R.k0.x, R.k0.y, R.k0.z, R.k0.w, R.k1.x, R.k1.y, R.k1.z, R.k1.w};
#pragma unroll
    for (int e = 0; e < 8; ++e) { KT[(part * 16 + 2 * e) * 72 + i] = (bf16_t)(kw[e] & 0xffffu); KT[(part * 16 + 2 * e + 1) * 72 + i] = (bf16_t)(kw[e] >> 16); }
    float v8[8]; unpack8(R.v, v8);
#pragma unroll
    for (int e = 0; e < 8; ++e) VT[(part * 8 + e) * 72 + i] = (bf16_t)f2bf(v8[e]);
    float t8[8]; unpack8(R.t, t8);
    const float gm[8] = {R.g0.x, R.g0.y, R.g0.z, R.g0.w, R.g1.x, R.g1.y, R.g1.z, R.g1.w};
    const float bm[8] = {R.b0.x, R.b0.y, R.b0.z, R.b0.w, R.b1.x, R.b1.y, R.b1.z, R.b1.w};
    float a1[8], a2[8];
#pragma unroll
    for (int e = 0; e < 8; ++e) { a2[e] = t8[e] * bm[e]; a1[e] = a2[e] * expf(gm[e]); }
    *(u32x4*)(T1 + i * 72 + part * 8) = pack8(a1); *(u32x4*)(T2 + i * 72 + part * 8) = pack8(a2);
    if (tid < 64) { GS[tid] = R.gl; GS[64 + tid] = expf(R.gl); GS[128 + tid] = expf(R.g63 - R.gl); }
}
#define LBAR() do { asm volatile("s_waitcnt lgkmcnt(0)" ::: "memory"); __builtin_amdgcn_s_barrier(); asm volatile("" ::: "memory"); } while (0)
__device__ void delta_item(KA a, int item, unsigned char* lds) {
    const int tid = tid_opaque(), lane = tid & 63, w = tid >> 6, fr = lane & 15, fq = lane >> 4;
    const int dvh = item & 1, dir = (item >> 1) & 1, h = (item >> 2) & 15, b = item >> 6, sid = (b * 16 + h) * 2 + dir;
    const bf16_t* PQ = (const bf16_t*)(a->ws + WS_RB); const bf16_t* TS = (const bf16_t*)(a->ws + WS_TS); const float* GCB = (const float*)(a->ws + WS_GCB);
    bf16_t* O = (bf16_t*)(a->ws + WS_RA) + (size_t)dir * MT * 2048;
    const bf16_t* QN = (const bf16_t*)(lds + DL_QN); const bf16_t* KN = (const bf16_t*)(lds + DL_KN); bf16_t* WN = (bf16_t*)(lds + DL_WN); bf16_t* ST = (bf16_t*)(lds + DL_ST);
    const bf16_t* KT = (const bf16_t*)(lds + DL_KT); const bf16_t* VT = (const bf16_t*)(lds + DL_VT); const bf16_t* T1 = (const bf16_t*)(lds + DL_T1); const bf16_t* T2 = (const bf16_t*)(lds + DL_T2);
    bf16_t* AT = (bf16_t*)(lds + DL_AT); bf16_t* VN = (bf16_t*)(lds + DL_VN); bf16_t* VD = (bf16_t*)(lds + DL_VD); const float* GS = (const float*)(lds + DL_GS);
    __syncthreads();
    for (int i = tid; i < 64 * 136 / 2; i += NT) ((unsigned*)ST)[i] = 0u;
    f32x4 sacc[4];
#pragma unroll
    for (int i = 0; i < 4; ++i) sacc[i] = (f32x4){0.f, 0.f, 0.f, 0.f};
    DStage R;
    dstage_load(R, PQ, TS, GCB, sid, 0, dir, h, b, dvh, tid);
#pragma unroll 1
    for (int cidx = 0; cidx < 68; ++cidx) {
        dstage_store(R, lds, tid);
        LBAR();
        if (cidx + 1 < 68) dstage_load(R, PQ, TS, GCB, sid, cidx + 1, dir, h, b, dvh, tid);
#pragma unroll
        for (int ti = 0; ti < 2; ++ti) {
            const int idx = w * 2 + ti, mt = idx >> 2, ct = idx & 3;
            f32x4 acc = (f32x4){0.f, 0.f, 0.f, 0.f};
            if (mt <= ct) {
#pragma unroll
                for (int kk = 0; kk < 4; ++kk) {
                    const bf16x8 af = *(const bf16x8*)(KN + (mt * 16 + fr) * 136 + kk * 32 + fq * 8), bfg = *(const bf16x8*)(QN + (ct * 16 + fr) * 136 + kk * 32 + fq * 8);
                    acc = MFMA16(af, bfg, acc);
                }
            }
            const int c = ct * 16 + fr; const float gcc = GS[c];
            float o4[4];
#pragma unroll
            for (int r = 0; r < 4; ++r) { const int m = mt * 16 + 4 * fq + r; o4[r] = (m <= c) ? acc[r] * expf(gcc - GS[m]) : 0.0f; }
            *(u32x2*)(AT + c * 72 + mt * 16 + 4 * fq) = pk4(o4[0], o4[1], o4[2], o4[3]);
        }
        {
            bf16x8 af[2];
#pragma unroll
            for (int kk = 0; kk < 2; ++kk) af[kk] = *(const bf16x8*)(KT + (w * 16 + fr) * 72 + kk * 32 + fq * 8);
#pragma unroll
            for (int ct = 0; ct < 4; ++ct) {
                f32x4 acc = (f32x4){0.f, 0.f, 0.f, 0.f};
#pragma unroll
                for (int kk = 0; kk < 2; ++kk) acc = MFMA16(af[kk], *(const bf16x8*)(T1 + (ct * 16 + fr) * 72 + kk * 32 + fq * 8), acc);
                *(u32x2*)(WN + (ct * 16 + fr) * 136 + w * 16 + 4 * fq) = pk4(-acc[0], -acc[1], -acc[2], -acc[3]);
            }
        }
        const int ctu = w >> 1, dv0 = 2 * (w & 1);
        f32x4 uacc[2];
        {
            bf16x8 af[2];
#pragma unroll
            for (int kk = 0; kk < 2; ++kk) af[kk] = *(const bf16x8*)(T2 + (ctu * 16 + fr) * 72 + kk * 32 + fq * 8);
#pragma unroll
            for (int j = 0; j < 2; ++j) { uacc[j] = (f32x4){0.f, 0.f, 0.f, 0.f};
#pragma unroll
                for (int kk = 0; kk < 2; ++kk) uacc[j] = MFMA16(af[kk], *(const bf16x8*)(VT + ((dv0 + j) * 16 + fr) * 72 + kk * 32 + fq * 8), uacc[j]); }
        }
        LBAR();
        {
            bf16x8 af[4];
#pragma unroll
            for (int kk = 0; kk < 4; ++kk) af[kk] = *(const bf16x8*)(WN + (ctu * 16 + fr) * 136 + kk * 32 + fq * 8);
            float ed[4];
#pragma unroll
            for (int r = 0; r < 4; ++r) ed[r] = GS[128 + ctu * 16 + 4 * fq + r];
#pragma unroll
            for (int j = 0; j < 2; ++j) {
#pragma unroll
                for (int kk = 0; kk < 4; ++kk) uacc[j] = MFMA16(af[kk], *(const bf16x8*)(ST + ((dv0 + j) * 16 + fr) * 136 + kk * 32 + fq * 8), uacc[j]);
                const int dv = (dv0 + j) * 16 + fr;
                *(u32x2*)(VN + dv * 72 + ctu * 16 + 4 * fq) = pk4(uacc[j][0], uacc[j][1], uacc[j][2], uacc[j][3]);
                *(u32x2*)(VD + dv * 72 + ctu * 16 + 4 * fq) = pk4(uacc[j][0] * ed[0], uacc[j][1] * ed[1], uacc[j][2] * ed[2], uacc[j][3] * ed[3]);
            }
        }
        LBAR();
        {
            const int dvt = w >> 1, c0 = 2 * (w & 1);
            bf16x8 af[4], vf[2];
#pragma unroll
            for (int kk = 0; kk < 4; ++kk) af[kk] = *(const bf16x8*)(ST + (dvt * 16 + fr) * 136 + kk * 32 + fq * 8);
#pragma unroll
            for (int kk = 0; kk < 2; ++kk) vf[kk] = *(const bf16x8*)(VN + (dvt * 16 + fr) * 72 + kk * 32 + fq * 8);
#pragma unroll
            for (int j = 0; j < 2; ++j) {
                const int c = (c0 + j) * 16 + fr;
                f32x4 acc = (f32x4){0.f, 0.f, 0.f, 0.f};
#pragma unroll
                for (int kk = 0; kk < 4; ++kk) acc = MFMA16(af[kk], *(const bf16x8*)(QN + c * 136 + kk * 32 + fq * 8), acc);
                const float eg = GS[64 + c];
                acc = acc * eg;
#pragma unroll
                for (int kk = 0; kk < 2; ++kk) acc = MFMA16(vf[kk], *(const bf16x8*)(AT + c * 72 + kk * 32 + fq * 8), acc);
                if (cidx >= 4) {
                    const int p = (cidx - 4) * 64 + c, tok = dir ? (SEQ - 1 - p) : p;
                    *(u32x2*)(O + (size_t)(b * SEQ + tok) * 2048 + h * 128 + dvh * 64 + dvt * 16 + 4 * fq) = pk4(acc[0], acc[1], acc[2], acc[3]);
                }
            }
        }
        {
            const float eg63 = GS[64 + 63];
            bf16x8 af[2];
#pragma unroll
            for (int kk = 0; kk < 2; ++kk) af[kk] = *(const bf16x8*)(KT + (w * 16 + fr) * 72 + kk * 32 + fq * 8);
#pragma unroll
            for (int j = 0; j < 4; ++j) {
                sacc[j] = sacc[j] * eg63;
#pragma unroll
                for (int kk = 0; kk < 2; ++kk) sacc[j] = MFMA16(af[kk], *(const bf16x8*)(VD + (j * 16 + fr) * 72 + kk * 32 + fq * 8), sacc[j]);
            }
        }
        LBAR();
#pragma unroll
        for (int j = 0; j < 4; ++j) *(u32x2*)(ST + (j * 16 + fr) * 136 + w * 16 + 4 * fq) = pk4(sacc[j][0], sacc[j][1], sacc[j][2], sacc[j][3]);
    }
    __syncthreads();
}

__device__ void ytrans_unit(const bf16_t* YT, bf16_t* Y, int unit, bf16_t* tile) {
    const int tid = tid_opaque(), cb = unit & 31, tb = unit >> 5, r = tid >> 3, c8 = (tid & 7) * 8;
    *(u32x4*)(tile + r * 72 + c8) = *(const u32x4*)(YT + (size_t)(cb * 64 + r) * MT + tb * 64 + c8);
    __syncthreads();
    u32x4 w;
    w.x = (unsigned)tile[(c8 + 0) * 72 + r] | ((unsigned)tile[(c8 + 1) * 72 + r] << 16);
    w.y = (unsigned)tile[(c8 + 2) * 72 + r] | ((unsigned)tile[(c8 + 3) * 72 + r] << 16);
    w.z = (unsigned)tile[(c8 + 4) * 72 + r] | ((unsigned)tile[(c8 + 5) * 72 + r] << 16);
    w.w = (unsigned)tile[(c8 + 6) * 72 + r] | ((unsigned)tile[(c8 + 7) * 72 + r] << 16);
    *(u32x4*)(Y + (size_t)(tb * 64 + r) * 2048 + cb * 64 + c8) = w;
    __syncthreads();
}

__device__ void p6_on(KA a) {
    const bf16_t* OF = (const bf16_t*)(a->ws + WS_RA); const bf16_t* OB = OF + (size_t)MT * 2048;
    const bf16_t* ZG = (const bf16_t*)(a->ws + WS_RB); bf16_t* ON = (bf16_t*)(a->ws + WS_HA);
    const float* nw = a->in[10];
    const size_t nthr = (size_t)gridDim.x * NT;
    for (size_t i = (size_t)blockIdx.x * NT + tid_opaque(); i < (size_t)MT * 256; i += nthr) {
        const int row = (int)(i >> 8), c8 = (int)(i & 255) * 8;
        float f[8], g[8], z[8];
        unpack8(*(const u32x4*)(OF + (size_t)row * 2048 + c8), f); unpack8(*(const u32x4*)(OB + (size_t)row * 2048 + c8), g);
        unpack8(*(const u32x4*)(ZG + (size_t)row * NZG + c8), z);
        float ss = 0.f;
#pragma unroll
        for (int e = 0; e < 8; ++e) { f[e] += g[e]; ss += f[e] * f[e]; }
        ss += __shfl_xor(ss, 1, 64); ss += __shfl_xor(ss, 2, 64); ss += __shfl_xor(ss, 4, 64); ss += __shfl_xor(ss, 8, 64);
        const float rs = rsqrtf(ss * (1.0f / 128.0f) + 1e-6f);
        float o[8];
#pragma unroll
        for (int e = 0; e < 8; ++e) o[e] = f[e] * rs * nw[(c8 & 127) + e] * siluf_(z[e]);
        *(u32x4*)(ON + (size_t)row * 2048 + c8) = pack8(o);
    }
}

constexpr size_t PEER_U8 = 0, PEER_V8 = 32 * MiB, PEER_US = 64 * MiB, PEER_VS = 64 * MiB + 65536;
__device__ void p8_tables(KA a) {
    unsigned char* RAb = a->ws + WS_RA;
    const int lane = tid_opaque() & 63, wv = blockIdx.x * 8 + (tid_opaque() >> 6), nwv = gridDim.x * 8;
    for (int r = wv; r < 32768; r += nwv) {
        const int tab = r >> 14, row = r & 16383;
        const float* sp = (tab ? a->in[28] : a->in[27]) + (size_t)row * 2048;
        f32x4 x[8];
#pragma unroll
        for (int i = 0; i < 2; ++i)
#pragma unroll
            for (int j = 0; j < 4; ++j) x[i * 4 + j] = *(const f32x4*)(sp + i * 1024 + lane * 16 + j * 4);
        float mx = 0.f;
#pragma unroll
        for (int i = 0; i < 8; ++i) mx = fmaxf(mx, fmaxf(fmaxf(fabsf(x[i][0]), fabsf(x[i][1])), fmaxf(fabsf(x[i][2]), fabsf(x[i][3]))));
        mx = wave_max(mx);
        const float sc = (mx > 0.f) ? mx * (1.0f / 127.0f) : 1.0f, inv = 1.0f / sc;
        unsigned char* dp = RAb + (tab ? PEER_V8 : PEER_U8) + (size_t)row * 2048;
#pragma unroll
        for (int i = 0; i < 2; ++i) {
            u32x4 w;
#pragma unroll
            for (int j = 0; j < 4; ++j) {
                const f32x4 v = x[i * 4 + j];
                const unsigned b0 = (unsigned)(__float2int_rn(v[0] * inv) + 128), b1 = (unsigned)(__float2int_rn(v[1] * inv) + 128), b2 = (unsigned)(__float2int_rn(v[2] * inv) + 128), b3 = (unsigned)(__float2int_rn(v[3] * inv) + 128);
                w[j] = (b0 & 255u) | ((b1 & 255u) << 8) | ((b2 & 255u) << 16) | ((b3 & 255u) << 24);
            }
            *(u32x4*)(dp + i * 1024 + lane * 16) = w;
        }
        if (lane == 0) ((float*)(RAb + (tab ? PEER_VS : PEER_US)))[row] = sc;
    }
}

__device__ void p9_ln1(KA a) {
    const float* mod = (const float*)(a->ws + WS_MOD); bf16_t* H2 = (bf16_t*)(a->ws + WS_RA) + (size_t)2 * MT * 2048;
    const float* g = a->in[23]; const float* bb = a->in[24];
    const int lane = tid_opaque() & 63, wv = blockIdx.x * 8 + (tid_opaque() >> 6), nwv = gridDim.x * 8;
    for (int row = wv; row < MT; row += nwv) {
        float* rp = a->out + (size_t)row * 2048;
        float v[32]; float s = 0.f;
#pragma unroll
        for (int i = 0; i < 4; ++i) { const f32x4 x0 = *(const f32x4*)(rp + i * 512 + lane * 8), x1 = *(const f32x4*)(rp + i * 512 + lane * 8 + 4);
#pragma unroll
            for (int e = 0; e < 4; ++e) { v[i * 8 + e] = x0[e]; v[i * 8 + 4 + e] = x1[e]; s += x0[e] + x1[e]; } }
        const float mu = wave_sum(s) * (1.0f / 2048.0f);
        float q = 0.f;
#pragma unroll
        for (int e = 0; e < 32; ++e) { const float d = v[e] - mu; q += d * d; }
        const float rstd = rsqrtf(wave_sum(q) * (1.0f / 2048.0f) + 1e-5f);
        const float* mp = mod + (row >> 12) * 12288;
#pragma unroll
        for (int i = 0; i < 4; ++i) {
            const int col = i * 512 + lane * 8;
            float xn[8], h[8];
#pragma unroll
            for (int e = 0; e < 8; ++e) { xn[e] = (v[i * 8 + e] - mu) * rstd * g[col + e] + bb[col + e]; h[e] = xn[e] * (1.0f + mp[8192 + col + e]) + mp[6144 + col + e]; }
            *(f32x4*)(rp + col) = (f32x4){xn[0], xn[1], xn[2], xn[3]}; *(f32x4*)(rp + col + 4) = (f32x4){xn[4], xn[5], xn[6], xn[7]};
            *(u32x4*)(H2 + (size_t)row * 2048 + col) = pack8(h);
        }
    }
}

__device__ __forceinline__ float row_max16(float v) {
    v = fmaxf(v, __builtin_bit_cast(float, __builtin_amdgcn_update_dpp(0, __builtin_bit_cast(int, v), 0x128, 0xf, 0xf, false)));
    v = fmaxf(v, __builtin_bit_cast(float, __builtin_amdgcn_update_dpp(0, __builtin_bit_cast(int, v), 0x124, 0xf, 0xf, false)));
    v = fmaxf(v, __builtin_bit_cast(float, __builtin_amdgcn_update_dpp(0, __builtin_bit_cast(int, v), 0x122, 0xf, 0xf, false)));
    v = fmaxf(v, __builtin_bit_cast(float, __builtin_amdgcn_update_dpp(0, __builtin_bit_cast(int, v), 0x121, 0xf, 0xf, false)));
    return v;
}
__device__ __forceinline__ float row_sum16(float v) {
    v += __builtin_bit_cast(float, __builtin_amdgcn_update_dpp(0, __builtin_bit_cast(int, v), 0x128, 0xf, 0xf, false));
    v += __builtin_bit_cast(float, __builtin_amdgcn_update_dpp(0, __builtin_bit_cast(int, v), 0x124, 0xf, 0xf, false));
    v += __builtin_bit_cast(float, __builtin_amdgcn_update_dpp(0, __builtin_bit_cast(int, v), 0x122, 0xf, 0xf, false));
    v += __builtin_bit_cast(float, __builtin_amdgcn_update_dpp(0, __builtin_bit_cast(int, v), 0x121, 0xf, 0xf, false));
    return v;
}
__device__ __forceinline__ int row_sum16i(int v) {
    v += __builtin_amdgcn_update_dpp(0, v, 0x128, 0xf, 0xf, false);
    v += __builtin_amdgcn_update_dpp(0, v, 0x124, 0xf, 0xf, false);
    v += __builtin_amdgcn_update_dpp(0, v, 0x122, 0xf, 0xf, false);
    v += __builtin_amdgcn_update_dpp(0, v, 0x121, 0xf, 0xf, false);
    return v;
}
template <int NCH, int NV> __device__ __forceinline__ void topk16_row16(float (&x)[NCH][NV], int s, int g, float (&rs)[NCH], int (&ri)[NCH]) {
#pragma unroll
    for (int c = 0; c < NCH; ++c) { rs[c] = -INFINITY; ri[c] = 0; }
#pragma unroll 1
    for (int it = 0; it < 16; ++it) {
#pragma unroll
        for (int c = 0; c < NCH; ++c) {
            float m = x[c][0];
#pragma unroll
            for (int j = 1; j < NV; ++j) m = fmaxf(m, x[c][j]);
            const float wm = row_max16(m);
            const unsigned long long bal = __ballot(m == wm);
            const unsigned seg = (unsigned)(bal >> (16 * g)) & 0xffffu;
            const bool iswin = (s == (__ffs((int)seg) - 1));
            int jsel = 0;
#pragma unroll
            for (int j = NV - 1; j >= 0; --j) { const bool e = (x[c][j] == wm); jsel = e ? j : jsel; x[c][j] = (e && iswin) ? -INFINITY : x[c][j]; }
            const int key = row_sum16i(iswin ? (s * NV + jsel) : 0);
            if (s == it) { rs[c] = wm; ri[c] = key; }
        }
    }
}
__device__ void peer_unit(KA a, int unit, unsigned char* lds) {
    const int tid = tid_opaque(), lane = tid & 63, wid = tid >> 6, fr = lane & 15, fq = lane >> 4;
    float* SC = (float*)lds;
    int* IGI = (int*)(lds + 32768); float* IGG = (float*)(lds + 49152);
    float* TL = (float*)(lds + 65536); int* TI = (int*)(lds + 69632);
    const int tok0 = unit * 32;
    const float* Qp = (const float*)(a->ws + WS_RB); const float* subk = a->in[26];
    const bf16_t* H2 = (const bf16_t*)(a->ws + WS_RA) + (size_t)2 * MT * 2048;
    const float* mod = (const float*)(a->ws + WS_MOD);
    int sti[4], stj[4];
#pragma unroll
    for (int q = 0; q < 4; ++q) {
        const int t = fr * 4 + q; int acc = 0, ii = -1, jj = 0;
#pragma unroll
        for (int i = 0; i < 16; ++i) { const int cnt = 16 / (i + 1); if (ii < 0 && t < acc + cnt) { ii = i; jj = t - acc; } acc += cnt; }
        sti[q] = ii; stj[q] = jj;
    }
#pragma unroll 1
    for (int hh = 0; hh < 8 * a->reps[2]; ++hh) { const int h = hh & 7;
#pragma unroll 1
        for (int p = 0; p < 2; ++p) {
            f32x4 bq[8], aq[2][8];
            const float* bp = subk + (size_t)((h * 2 + p) * 128 + wid * 16 + fr) * 128 + fq * 32;
#pragma unroll
            for (int j = 0; j < 8; ++j) bq[j] = *(const f32x4*)(bp + j * 4);
#pragma unroll
            for (int mt = 0; mt < 2; ++mt) { const float* ap = Qp + (size_t)(tok0 + mt * 16 + fr) * 2048 + h * 256 + p * 128 + fq * 32;
#pragma unroll
                for (int j = 0; j < 8; ++j) aq[mt][j] = *(const f32x4*)(ap + j * 4); }
            f32x4 acc[2] = {(f32x4){0.f, 0.f, 0.f, 0.f}, (f32x4){0.f, 0.f, 0.f, 0.f}};
#pragma unroll
            for (int j = 0; j < 8; ++j)
#pragma unroll
                for (int e = 0; e < 4; ++e) {
                    acc[0] = __builtin_amdgcn_mfma_f32_16x16x4f32(aq[0][j][e], bq[j][e], acc[0], 0, 0, 0);
                    acc[1] = __builtin_amdgcn_mfma_f32_16x16x4f32(aq[1][j][e], bq[j][e], acc[1], 0, 0, 0);
                }
#pragma unroll
            for (int mt = 0; mt < 2; ++mt)
#pragma unroll
                for (int r = 0; r < 4; ++r) SC[(p * 32 + mt * 16 + 4 * fq + r) * 128 + wid * 16 + fr] = acc[mt][r];
        }
        __syncthreads();
        {
            const int tk = wid * 4 + fq;
            float x[2][8]; float ts[2]; int tix[2];
#pragma unroll
            for (int p = 0; p < 2; ++p) { const f32x4 y0 = *(const f32x4*)(SC + (p * 32 + tk) * 128 + fr * 8), y1 = *(const f32x4*)(SC + (p * 32 + tk) * 128 + fr * 8 + 4);
                x[p][0] = y0.x; x[p][1] = y0.y; x[p][2] = y0.z; x[p][3] = y0.w; x[p][4] = y1.x; x[p][5] = y1.y; x[p][6] = y1.z; x[p][7] = y1.w; }
            topk16_row16<2, 8>(x, fr, fq, ts, tix);
            TL[(tk * 2 + 0) * 16 + fr] = ts[0]; TL[(tk * 2 + 1) * 16 + fr] = ts[1]; TI[(tk * 2 + 0) * 16 + fr] = tix[0]; TI[(tk * 2 + 1) * 16 + fr] = tix[1];
            asm volatile("s_waitcnt lgkmcnt(0)" ::: "memory");
            float cnd[1][4]; float bs[1]; int bc[1];
#pragma unroll
            for (int q = 0; q < 4; ++q) cnd[0][q] = (sti[q] >= 0) ? TL[(tk * 2 + 0) * 16 + (sti[q] & 15)] + TL[(tk * 2 + 1) * 16 + stj[q]] : -INFINITY;
            topk16_row16<1, 4>(cnd, fr, fq, bs, bc);
            const int src = (lane & 48) + (bc[0] >> 2), qq = bc[0] & 3;
            const int i0 = __shfl(sti[0], src, 64), i1 = __shfl(sti[1], src, 64), i2 = __shfl(sti[2], src, 64), i3 = __shfl(sti[3], src, 64);
            const int j0 = __shfl(stj[0], src, 64), j1 = __shfl(stj[1], src, 64), j2 = __shfl(stj[2], src, 64), j3 = __shfl(stj[3], src, 64);
            const int pi = (qq == 0) ? i0 : (qq == 1) ? i1 : (qq == 2) ? i2 : i3, pj = (qq == 0) ? j0 : (qq == 1) ? j1 : (qq == 2) ? j2 : j3;
            const int e0 = TI[(tk * 2 + 0) * 16 + (pi & 15)], e1 = TI[(tk * 2 + 1) * 16 + (pj & 15)];
            const float mx = row_max16(bs[0]);
            const float ex = expf(bs[0] - mx);
            const float sm = row_sum16(ex);
            IGI[tk * 128 + h * 16 + fr] = e0 * 128 + e1; IGG[tk * 128 + h * 16 + fr] = ex / sm;
        }
        __syncthreads();
    }
    __syncthreads();
    const unsigned char* U8 = a->ws + WS_RA + PEER_U8; const unsigned char* V8 = a->ws + WS_RA + PEER_V8;
    const float* US = (const float*)(a->ws + WS_RA + PEER_US); const float* VS = (const float*)(a->ws + WS_RA + PEER_VS);
#pragma unroll 1
    for (int rr = 0; rr < 4; ++rr) {
        const int row = wid * 4 + rr, tok = tok0 + row;
        float hx[32], yq[32]; float hs = 0.f;
#pragma unroll
        for (int i = 0; i < 2; ++i) {
            float t8[8];
            unpack8(*(const u32x4*)(H2 + (size_t)tok * 2048 + i * 1024 + lane * 16), t8);
#pragma unroll
            for (int e = 0; e < 8; ++e) { hx[i * 16 + e] = t8[e]; hs += t8[e]; }
            unpack8(*(const u32x4*)(H2 + (size_t)tok * 2048 + i * 1024 + lane * 16 + 8), t8);
#pragma unroll
            for (int e = 0; e < 8; ++e) { hx[i * 16 + 8 + e] = t8[e]; hs += t8[e]; }
        }
#pragma unroll
        for (int e = 0; e < 32; ++e) yq[e] = 0.f;
        hs = wave_sum(hs);
        float csum = 0.f;
#if DBG_MODE != 2
        const int* ip = IGI + row * 128; const float* gp = IGG + row * 128;
        u32x4 nu[2][2], nv[2][2]; float nsu[2], nsv[2];
#pragma unroll
        for (int k = 0; k < 2; ++k) {
            const int idx = __builtin_amdgcn_readfirstlane(ip[k]);
            const unsigned char* up = U8 + (size_t)idx * 2048 + lane * 16; const unsigned char* vp = V8 + (size_t)idx * 2048 + lane * 16;
            nu[k][0] = *(const u32x4*)up; nu[k][1] = *(const u32x4*)(up + 1024); nv[k][0] = *(const u32x4*)vp; nv[k][1] = *(const u32x4*)(vp + 1024);
            nsu[k] = US[idx]; nsv[k] = VS[idx];
        }
#pragma unroll 1
        for (int e = 0; e < 128; e += 2) {
            u32x4 cu[2][2], cvv[2][2]; float csu[2], csv[2];
#pragma unroll
            for (int k = 0; k < 2; ++k) { cu[k][0] = nu[k][0]; cu[k][1] = nu[k][1]; cvv[k][0] = nv[k][0]; cvv[k][1] = nv[k][1]; csu[k] = nsu[k]; csv[k] = nsv[k]; }
            if (e + 2 < 128) {
#pragma unroll
                for (int k = 0; k < 2; ++k) {
                    const int idx = __builtin_amdgcn_readfirstlane(ip[e + 2 + k]);
                    const unsigned char* up = U8 + (size_t)idx * 2048 + lane * 16; const unsigned char* vp = V8 + (size_t)idx * 2048 + lane * 16;
                    nu[k][0] = *(const u32x4*)up; nu[k][1] = *(const u32x4*)(up + 1024); nv[k][0] = *(const u32x4*)vp; nv[k][1] = *(const u32x4*)(vp + 1024);
                    nsu[k] = US[idx]; nsv[k] = VS[idx];
                }
            }
#pragma unroll
            for (int k = 0; k < 2; ++k) {
                float acc = 0.f;
#pragma unroll
                for (int i = 0; i < 2; ++i)
#pragma unroll
                    for (int j = 0; j < 4; ++j) { const unsigned wd = cu[k][i][j]; const float* hp = hx + i * 16 + j * 4;
                        acc += (float)(wd & 255u) * hp[0]; acc += (float)((wd >> 8) & 255u) * hp[1]; acc += (float)((wd >> 16) & 255u) * hp[2]; acc += (float)(wd >> 24) * hp[3]; }
                const float dot = csu[k] * (wave_sum(acc) - 128.0f * hs);
                const float c1 = gp[e + k] * 0.5f * dot * (1.0f + erff(dot * 0.7071067811865476f)) * csv[k];
                csum += c1;
#pragma unroll
                for (int i = 0; i < 2; ++i)
#pragma unroll
                    for (int j = 0; j < 4; ++j) { const unsigned wd = cvv[k][i][j]; float* yp = yq + i * 16 + j * 4;
                        yp[0] += c1 * (float)(wd & 255u); yp[1] += c1 * (float)((wd >> 8) & 255u); yp[2] += c1 * (float)((wd >> 16) & 255u); yp[3] += c1 * (float)(wd >> 24); }
            }
        }
#endif
        float* rp = a->out + (size_t)tok * 2048; const float* mp = mod + (tok >> 12) * 12288 + 10240;
        float val[32]; float s = 0.f;
        const float yoff = 128.0f * csum;
#pragma unroll
        for (int i = 0; i < 2; ++i)
#pragma unroll
            for (int j = 0; j < 4; ++j) { const int col = i * 1024 + lane * 16 + j * 4; const f32x4 x0 = *(const f32x4*)(rp + col), g0 = *(const f32x4*)(mp + col);
#pragma unroll
                for (int e = 0; e < 4; ++e) { const float v = ALPHA * x0[e] + g0[e] * (yq[i * 16 + j * 4 + e] - yoff); val[i * 16 + j * 4 + e] = v; s += v; } }
        const float mu = wave_sum(s) * (1.0f / 2048.0f);
        float q = 0.f;
#pragma unroll
        for (int e = 0; e < 32; ++e) { const float d = val[e] - mu; q += d * d; }
        const float rstd = rsqrtf(wave_sum(q) * (1.0f / 2048.0f) + 1e-5f);
        const float* g = a->in[29]; const float* bb = a->in[30];
#pragma unroll
        for (int i = 0; i < 2; ++i)
#pragma unroll
            for (int j = 0; j < 4; ++j) { const int col = i * 1024 + lane * 16 + j * 4; const f32x4 gg = *(const f32x4*)(g + col), bv = *(const f32x4*)(bb + col); f32x4 o;
#pragma unroll
                for (int e = 0; e < 4; ++e) o[e] = (val[i * 16 + j * 4 + e] - mu) * rstd * gg[e] + bv[e];
                *(f32x4*)(rp + col) = o; }
    }
    __syncthreads();
}

constexpr size_t WS_BAR = 699 * MiB;

__device__ __forceinline__ void grid_bar(unsigned* ctr, unsigned target) {
    asm volatile("s_waitcnt vmcnt(0)" ::: "memory");
    __syncthreads();
    if (tid_opaque() == 0) {
        __builtin_amdgcn_fence(__ATOMIC_RELEASE, "agent");
        asm volatile("s_waitcnt vmcnt(0)" ::: "memory");
        __hip_atomic_fetch_add(ctr, 1u, __ATOMIC_RELAXED, __HIP_MEMORY_SCOPE_AGENT);
        while (__hip_atomic_load(ctr, __ATOMIC_RELAXED, __HIP_MEMORY_SCOPE_AGENT) < target) __builtin_amdgcn_s_sleep(2);
        __builtin_amdgcn_fence(__ATOMIC_ACQUIRE, "agent");
        asm volatile("s_waitcnt vmcnt(0)" ::: "memory");
    }
    __syncthreads();
}

__global__ void __launch_bounds__(NT, 2) fwd_mega(Args a_) {
    KA a = (KA)__builtin_amdgcn_kernarg_segment_ptr();
    unsigned char* lds = g_lds;
    tid_table_init();
    cg::grid_group grid = cg::this_grid();
    float* lf = (float*)lds;
    const int lo = a->ph_lo, hi = a->ph_hi;
#define IN(k) (lo <= (k) && (k) < hi)
    unsigned* barctr = (unsigned*)(a->ws + WS_BAR); unsigned nbar = 0;
    if (blockIdx.x == 0 && tid_opaque() == 0) __hip_atomic_store(barctr, 0u, __ATOMIC_RELAXED, __HIP_MEMORY_SCOPE_AGENT);
#define GBAR() do { ++nbar; grid_bar(barctr, nbar * gridDim.x); } while (0)
#define SEAM(k) do { if (IN(k) && IN((k) + 1)) { if ((k) == 0) grid.sync(); else GBAR(); } asm volatile("" : "+s"(a)); } while (0)
    unsigned char* ws = a->ws;
    bf16_t* HA = (bf16_t*)(ws + WS_HA); bf16_t* WT = (bf16_t*)(ws + WS_WT); bf16_t* SW = (bf16_t*)(ws + WS_SW);
    bf16_t* RA = (bf16_t*)(ws + WS_RA); bf16_t* RB = (bf16_t*)(ws + WS_RB);
    const float* mod = (const float*)(ws + WS_MOD);

    if (IN(0)) {
#pragma unroll 1
        for (int rep = 0; rep < a->reps[0]; ++rep) { p0_mod_hid2(a, lf); p0_transposes(a, lf); }
    }
    SEAM(0);
    if (IN(1)) {
#pragma unroll 1
        for (int rep = 0; rep < a->reps[0]; ++rep) { p1_ha(a); for (int u = blockIdx.x; u < 256; u += gridDim.x) filt_unit(a, u, lds); }
    }
    SEAM(1);
    if (IN(2)) {
#pragma unroll 1
        for (int rep = 0; rep < a->reps[1]; ++rep) {
        run_gemm(lds, WT, HA, NHY, MT, FStoreBf16{RA, MT, 1.0f});
        run_gemm8(lds, ws + WS_HA8, (const unsigned char*)WT + WT8_OFF, MA, NQKVP, FStoreQKV{RB, (float*)(ws + WS_AB), 1.0f / 64.0f});
        }
    }
    SEAM(2);
    if (IN(3)) {
        hyena_setup(lds);
#pragma unroll 1
        for (int rep = 0; rep < a->reps[3]; ++rep)
        for (int c = blockIdx.x; c < 2048; c += gridDim.x) hyena_item(a, c, lds);
        for (int u = blockIdx.x; u < 12288 + 192; u += gridDim.x) qkvpost_unit(a, u, lds);
    }
    SEAM(3);
    if (IN(4)) {
#pragma unroll 1
        for (int rep = 0; rep < a->reps[4]; ++rep)
        { const int wv = tid_opaque() >> 6; for (int pid = blockIdx.x * 8 + wv; pid < 8704; pid += gridDim.x * 8) tprep_wave(a, pid, lds + wv * 17920); }
        GBAR();
#pragma unroll 1
        for (int rep = 0; rep < a->reps[5]; ++rep)
        for (int it = blockIdx.x; it < 256; it += gridDim.x) delta_item(a, it, lds);
    }
    SEAM(4);
    if (IN(5)) {
        run_gemm8(lds, ws + WS_HA8, (const unsigned char*)WT + WT8_OFF + (size_t)NQKVP * 2048, MT, NZG, FStoreBf16{RB, NZG, 1.0f / 64.0f});
#pragma unroll 1
        for (int rep = 0; rep < a->reps[6]; ++rep)
        for (int u = blockIdx.x; u < 8192; u += gridDim.x) ytrans_unit((const bf16_t*)a->out, RA + (size_t)2 * MT * 2048, u, (bf16_t*)lds);
    }
    SEAM(5);
    if (IN(6)) {
#pragma unroll 1
        for (int rep = 0; rep < a->reps[6]; ++rep) p6_on(a); }
    SEAM(6);
    if (IN(7)) {
        run_gemm(lds, HA  , SW, MT, D, FGatePA{RB, WT  });
        run_gemm(lds, RA + (size_t)2 * MT * 2048  , SW + (size_t)1 * D * D, MT, D, FGatePH{RB, WT  });
    }
    SEAM(7);
    if (IN(8)) {
        run_gemm(lds, WT  , SW + (size_t)2 * D * D, MT, D, FOut{a->in[0], mod, a->out});
#pragma unroll 1
        for (int rep = 0; rep < a->reps[7]; ++rep) p8_tables(a);
    }
    SEAM(8);
    if (IN(9)) { p9_ln1(a); }
    SEAM(9);
    if (IN(10)) { run_gemm(lds, RA + (size_t)2 * MT * 2048  , SW + (size_t)3 * D * D, MT, D, FStoreF32{(float*)(ws + WS_RB), D}); }
    SEAM(10);
    if (IN(11)) { for (int u = blockIdx.x; u < MT / 32; u += gridDim.x) peer_unit(a, u, lds); }
#undef IN
#undef SEAM
}

extern "C" void kernel_launch(void* const* d_in, const int* in_sizes, int n_in, void* d_out, int out_size, void* d_ws, size_t ws_size, hipStream_t stream) {
    static int grid = 0;
    if (grid == 0) {
        if (n_in != 31 || out_size != MT * D || ws_size < WS_BAR + 4096) { fprintf(stderr, "kernel_launch: unexpected problem shape / workspace (%d inputs, out %d, ws %zu)\n", n_in, out_size, ws_size); grid = -1; return; }
        int dev = 0, cus = 0, per_cu = 0;
        (void)hipGetDevice(&dev);
        (void)hipDeviceGetAttribute(&cus, hipDeviceAttributeMultiprocessorCount, dev);
        (void)hipFuncSetAttribute((const void*)fwd_mega, hipFuncAttributeMaxDynamicSharedMemorySize, LDS_BYTES);
        (void)hipOccupancyMaxActiveBlocksPerMultiprocessor(&per_cu, (const void*)fwd_mega, NT, LDS_BYTES);
        if (per_cu < 1) per_cu = 1;
        grid = cus * per_cu;
        (void)hipGetLastError();
    }
    if (grid < 0) return;
    Args a{};
    for (int i = 0; i < 31; ++i) a.in[i] = (const float*)d_in[i];
    a.out = (float*)d_out; a.ws = (unsigned char*)d_ws; a.ph_lo = 0; a.ph_hi = 12; a.reps[0] = REP0; a.reps[1] = REP1; a.reps[2] = REP2; a.reps[3] = REP3; a.reps[4] = REP4; a.reps[5] = REP5; a.reps[6] = REP6; a.reps[7] = REP7;
    void* args[] = {&a};
    hipError_t e = hipLaunchCooperativeKernel((const void*)fwd_mega, dim3(grid), dim3(NT), args, LDS_BYTES, stream);
    if (e != hipSuccess) fprintf(stderr, "cooperative launch failed: %s (grid %d)\n", hipGetErrorString(e), grid);
}
```

```cpp
#include <hip/hip_runtime.h>
#include <hip/hip_cooperative_groups.h>
#include <cstdio>
#include <cstdint>
namespace cg = cooperative_groups;

#ifndef DBG_MODE
#define DBG_MODE 0
#endif
#define PD 2
#define REP0 1
#define REP1 1
#define REP2 1
#define REP3 1
#define REP4 1
#define REP5 1
#define REP6 1
#define REP7 1
#define REPG 1

extern __shared__ __attribute__((aligned(16))) unsigned char g_lds[];
constexpr int TIDTAB_OFF = 160 * 1024 - 256;
__device__ __forceinline__ int tid_opaque() {
    const int slot = __builtin_amdgcn_s_getreg(0x2804) & 63;
    int wv = __builtin_amdgcn_readfirstlane(((const int*)(g_lds + TIDTAB_OFF))[slot]);
    int t = wv * 64 + (int)__builtin_amdgcn_mbcnt_hi(~0u, __builtin_amdgcn_mbcnt_lo(~0u, 0u));
    asm volatile("" : "+v"(t));
    return t;
}
__device__ __forceinline__ void tid_table_init() {
    const int t = threadIdx.x;
    if ((t & 63) == 0) ((int*)(g_lds + TIDTAB_OFF))[__builtin_amdgcn_s_getreg(0x2804) & 63] = t >> 6;
    __syncthreads();
}

namespace pg8 {
#define PG8_LAS __attribute__((address_space(3)))
typedef unsigned short bf16_t;
typedef short bf16x8 __attribute__((ext_vector_type(8)));
typedef float f32x4 __attribute__((ext_vector_type(4)));
typedef unsigned u32x4 __attribute__((ext_vector_type(4)));
constexpr int BM = 256, BK = 64, HALF = 128, HTB = HALF * BK * 2, STAGE_BYTES = 8 * HTB, NXCD = 8, WGM = 8;

__host__ __device__ __forceinline__ int lds_byte(int r, int c) { const int st = (r >> 4) * 2 + (c >> 5), rr = r & 15, cc = c & 31, ob = rr * 64 + cc * 2; return st * 1024 + (ob ^ (((ob >> 9) & 1) << 5)); }
__host__ __device__ __forceinline__ void stage_rc(int b, int& R, int& C) { const int st = b / 1024, sb = b % 1024, swz = sb ^ (((sb >> 9) & 1) << 5); R = (st >> 1) * 16 + swz / 64; C = (st & 1) * 32 + (swz % 64) / 2; }
__host__ __device__ __forceinline__ int perm32(int rho) { const int n = rho >> 4, i = rho & 15; return 8 * (i >> 2) + 4 * n + (i & 3); }

struct Unit { int pm, pn; };
struct Gemm { const bf16_t* A; const bf16_t* Bt; int M, N, K; };

struct StaticOrder {
    int nM, nN, nwg, G, c;
    __host__ __device__ void init(int M, int N, int G_, int c_) { nM = M / BM; nN = N / BM; nwg = nM * nN; G = G_; c = c_; }
    __host__ __device__ bool next(int i, Unit& u) const {
        const long L = (long)i * G + c; if (L >= nwg) return false;
        int wgid = (int)L; { const int q = nwg / NXCD, r = nwg % NXCD, xcd = wgid % NXCD, off = wgid / NXCD; wgid = (xcd < r ? xcd * (q + 1) : r * (q + 1) + (xcd - r) * q) + off; }
        const int nig = WGM * nN, gid = wgid / nig, fm = gid * WGM, gsz = (nM - fm) < WGM ? (nM - fm) : WGM;
        u.pm = fm + ((wgid % nig) % gsz); u.pn = (wgid % nig) / gsz; return true;
    }
    __device__ __forceinline__ void a_ready(const Unit&) const {}
    __device__ __forceinline__ void done(const Unit&) const {}
};

__device__ __forceinline__ unsigned cvt_pk_bf16(float lo, float hi) { unsigned r; asm volatile("v_cvt_pk_bf16_f32 %0, %1, %2" : "=v"(r) : "v"(lo), "v"(hi)); return r; }

template <class F> struct EpiGen {
    static constexpr bool PERM = true, AFTER_DRAIN = false;
    F f;
    __device__ __forceinline__ void operator()(const f32x4 (&acc)[2][2][4][2], const Unit& u, int wr, int wc, int, int) const {
        int ln = (int)__builtin_amdgcn_mbcnt_hi(~0u, __builtin_amdgcn_mbcnt_lo(~0u, 0u)); asm volatile("" : "+v"(ln));
        const int fr = ln & 15, fq = ln >> 4;
        const int row0 = u.pm * BM + wr * 64 + fr, col0 = u.pn * BM + wc * 32 + 8 * fq;
#pragma unroll
        for (int ai = 0; ai < 2; ++ai)
#pragma unroll
            for (int m = 0; m < 4; ++m)
#pragma unroll
                for (int bj = 0; bj < 2; ++bj) f(row0 + ai * HALF + m * 16, col0 + bj * HALF, acc[ai][bj][m][0], acc[ai][bj][m][1]);
    }
};

template <class Epi, class Sched, bool ALIGN_EPI = false, bool SP2 = false>
__device__ __forceinline__ void gemm_phase(PG8_LAS unsigned char* lds, const Gemm g, const Sched& S, const Epi& E) {
    const int tid = tid_opaque(), wid = __builtin_amdgcn_readfirstlane(tid >> 6), lane = tid & 63, wr = wid >> 2, wc = wid & 3, fr = lane & 15, fq = lane >> 4;
    const int K = g.K, nt = K / BK;
    unsigned voffA[2], voffB[2];
#pragma unroll
    for (int i = 0; i < 2; ++i) { int R, C; stage_rc(tid * 16 + i * 8192, R, C); const int Rb = Epi::PERM ? ((R & ~31) + perm32(R & 31)) : R;
        voffA[i] = (unsigned)(R * K + C) * 2u; voffB[i] = (unsigned)(Rb * K + C) * 2u; }
    const size_t kstep = (size_t)(BK * 2);
    const size_t hstep = (size_t)HALF * K * 2;
    const size_t tstep = 2 * hstep;
    const unsigned ldsw = (unsigned)wid * 1024u;
    const int aoff = lds_byte(wr * 64 + fr, fq * 8), boff = lds_byte(wc * 32 + fr, fq * 8);
#define PG8_SA(b, h) (((b) * 2 + (h)) * HTB)
#define PG8_SB(b, h) ((4 + (b) * 2 + (h)) * HTB)
#define PG8_STAGE(bufoff, gbase, voff) do { _Pragma("unroll") for (int _i = 0; _i < 2; ++_i) \
        __builtin_amdgcn_global_load_lds((const unsigned*)((const char*)(gbase) + (voff)[_i]), (PG8_LAS unsigned*)(lds + (bufoff) + ldsw + _i * 8192), 16, 0, 0); } while (0)
#define PG8_LDA(dst, b, h) do { _Pragma("unroll") for (int m = 0; m < 4; ++m) _Pragma("unroll") for (int k = 0; k < 2; ++k) dst[m][k] = *(const PG8_LAS bf16x8*)(lds + PG8_SA(b, h) + aoff + m * 2048 + k * 1024); } while (0)
#define PG8_LDB(dst, b, h) do { _Pragma("unroll") for (int n = 0; n < 2; ++n) _Pragma("unroll") for (int k = 0; k < 2; ++k) dst[n][k] = *(const PG8_LAS bf16x8*)(lds + PG8_SB(b, h) + boff + n * 2048 + k * 1024); } while (0)
#define PG8_MMA(ai, bj, At, Bt) do { __builtin_amdgcn_s_setprio(1); _Pragma("unroll") for (int m = 0; m < 4; ++m) _Pragma("unroll") for (int n = 0; n < 2; ++n) _Pragma("unroll") for (int k = 0; k < 2; ++k) \
        acc[ai][bj][m][n] = __builtin_amdgcn_mfma_f32_16x16x32_bf16(Bt[n][k], At[m][k], acc[ai][bj][m][n], 0, 0, 0); __builtin_amdgcn_s_setprio(0); } while (0)
#define PG8_WAIT_V(n) asm volatile("s_waitcnt vmcnt(" #n ")" ::: "memory")
#define PG8_WAIT_L(n) asm volatile("s_waitcnt lgkmcnt(" #n ")" ::: "memory")
#define PG8_BAR __builtin_amdgcn_s_barrier()
#define PG8_SCHED __builtin_amdgcn_sched_barrier(0)
    Unit cur, nxt; int ui = 0;
    if (!S.next(0, cur)) return;
    f32x4 acc[2][2][4][2];
#pragma unroll
    for (int a = 0; a < 2; ++a)
#pragma unroll
        for (int b = 0; b < 2; ++b)
#pragma unroll
            for (int m = 0; m < 4; ++m)
#pragma unroll
                for (int n = 0; n < 2; ++n) acc[a][b][m][n] = (f32x4){0.f, 0.f, 0.f, 0.f};
    bf16x8 At[4][2], B0[2][2], B1[2][2];
    const char* cA = (const char*)g.A + (size_t)cur.pm * tstep; const char* cB = (const char*)g.Bt + (size_t)cur.pn * tstep;
    S.a_ready(cur);
    if constexpr (SP2) {
        PG8_STAGE(PG8_SB(0, 0), cB, voffB); PG8_STAGE(PG8_SB(0, 1), cB + hstep, voffB); PG8_STAGE(PG8_SA(0, 0), cA, voffA); PG8_STAGE(PG8_SA(0, 1), cA + hstep, voffA);
        if (wr == 1) PG8_BAR;
        PG8_WAIT_V(2); PG8_BAR;
        PG8_STAGE(PG8_SB(1, 0), cB + kstep, voffB); PG8_STAGE(PG8_SA(1, 0), cA + kstep, voffA); PG8_STAGE(PG8_SB(1, 1), cB + hstep + kstep, voffB);
        PG8_WAIT_V(6); PG8_BAR;
    } else {
        PG8_STAGE(PG8_SB(0, 0), cB, voffB); PG8_STAGE(PG8_SA(0, 0), cA, voffA); PG8_STAGE(PG8_SB(0, 1), cB + hstep, voffB); PG8_STAGE(PG8_SA(0, 1), cA + hstep, voffA);
        if (wr == 1) PG8_BAR;
        PG8_WAIT_V(4); PG8_BAR;
        PG8_STAGE(PG8_SB(1, 0), cB + kstep, voffB); PG8_STAGE(PG8_SA(1, 0), cA + kstep, voffA); PG8_STAGE(PG8_SB(1, 1), cB + hstep + kstep, voffB);
        PG8_WAIT_V(6); PG8_BAR;
    }
    for (;;) {
        const bool has_next = S.next(ui + 1, nxt);
        const char* nA = has_next ? (const char*)g.A + (size_t)nxt.pm * tstep : cA; const char* nB = has_next ? (const char*)g.Bt + (size_t)nxt.pn * tstep : cB;
        for (int t = 0; t < nt; t += 2) {
            const bool last = (t == nt - 2);
            const char* a1 = cA + (size_t)(t + 1) * kstep;
            const char* a2 = last ? nA : cA + (size_t)(t + 2) * kstep; const char* b2 = last ? nB : cB + (size_t)(t + 2) * kstep;
            const char* a3 = a2 + kstep; const char* b3 = b2 + kstep;
            if (last && has_next) S.a_ready(nxt);
            if constexpr (SP2) {
            PG8_LDB(B0, 0, 0); PG8_LDB(B1, 0, 1); PG8_SCHED; PG8_LDA(At, 0, 0); PG8_STAGE(PG8_SA(1, 1), a1 + hstep, voffA);
            PG8_WAIT_V(8); PG8_WAIT_L(0); PG8_BAR; PG8_MMA(0, 0, At, B0); PG8_MMA(0, 1, At, B1); PG8_BAR; PG8_SCHED;
            PG8_LDA(At, 0, 1); PG8_STAGE(PG8_SB(0, 0), b2, voffB); PG8_STAGE(PG8_SB(0, 1), b2 + hstep, voffB); PG8_STAGE(PG8_SA(0, 0), a2, voffA);
            PG8_WAIT_V(8); PG8_WAIT_L(0); PG8_BAR; PG8_MMA(1, 0, At, B0); PG8_MMA(1, 1, At, B1); PG8_BAR; PG8_SCHED;
            PG8_LDB(B0, 1, 0); PG8_LDB(B1, 1, 1); PG8_SCHED; PG8_LDA(At, 1, 0); PG8_STAGE(PG8_SA(0, 1), a2 + hstep, voffA);
            PG8_WAIT_V(8); PG8_WAIT_L(0); PG8_BAR; PG8_MMA(0, 0, At, B0); PG8_MMA(0, 1, At, B1); PG8_BAR; PG8_SCHED;
            PG8_LDA(At, 1, 1); PG8_STAGE(PG8_SB(1, 0), b3, voffB); PG8_STAGE(PG8_SB(1, 1), b3 + hstep, voffB); PG8_STAGE(PG8_SA(1, 0), a3, voffA);
            PG8_WAIT_V(8); PG8_WAIT_L(0); PG8_BAR; PG8_MMA(1, 0, At, B0); PG8_MMA(1, 1, At, B1); PG8_BAR; PG8_SCHED;
            } else {
            PG8_LDB(B0, 0, 0); PG8_SCHED; PG8_LDA(At, 0, 0); PG8_STAGE(PG8_SA(1, 1), a1 + hstep, voffA);
            PG8_WAIT_L(8); PG8_BAR; PG8_WAIT_L(0); PG8_MMA(0, 0, At, B0); PG8_BAR; PG8_SCHED;
            PG8_LDB(B1, 0, 1); PG8_STAGE(PG8_SB(0, 0), b2, voffB);
            PG8_BAR; PG8_WAIT_L(0); PG8_MMA(0, 1, At, B1); PG8_BAR;
            PG8_LDA(At, 0, 1); PG8_STAGE(PG8_SA(0, 0), a2, voffA);
            PG8_BAR; PG8_WAIT_L(0); PG8_MMA(1, 0, At, B0); PG8_BAR; PG8_SCHED;
            PG8_STAGE(PG8_SB(0, 1), b2 + hstep, voffB);
            PG8_WAIT_V(6); PG8_BAR; PG8_MMA(1, 1, At, B1); PG8_BAR;
            PG8_LDB(B0, 1, 0); PG8_SCHED; PG8_LDA(At, 1, 0); PG8_STAGE(PG8_SA(0, 1), a2 + hstep, voffA);
            PG8_WAIT_L(8); PG8_BAR; PG8_WAIT_L(0); PG8_MMA(0, 0, At, B0); PG8_BAR; PG8_SCHED;
            PG8_LDB(B1, 1, 1); PG8_STAGE(PG8_SB(1, 0), b3, voffB);
            PG8_BAR; PG8_WAIT_L(0); PG8_MMA(0, 1, At, B1); PG8_BAR;
            PG8_LDA(At, 1, 1); PG8_STAGE(PG8_SA(1, 0), a3, voffA);
            PG8_BAR; PG8_WAIT_L(0); PG8_MMA(1, 0, At, B0); PG8_BAR; PG8_SCHED;
            PG8_STAGE(PG8_SB(1, 1), b3 + hstep, voffB);
            PG8_WAIT_V(6); PG8_BAR; PG8_MMA(1, 1, At, B1); PG8_BAR;
            }
        }
        if constexpr (ALIGN_EPI) { if (wr == 0) PG8_BAR; }
        if constexpr (!Epi::AFTER_DRAIN) { E(acc, cur, wr, wc, fr, fq); S.done(cur); }
        if (!has_next) break;
#pragma unroll
        for (int a = 0; a < 2; ++a)
#pragma unroll
            for (int b = 0; b < 2; ++b)
#pragma unroll
                for (int m = 0; m < 4; ++m)
#pragma unroll
                    for (int n = 0; n < 2; ++n) acc[a][b][m][n] = (f32x4){0.f, 0.f, 0.f, 0.f};
        cur = nxt; cA = nA; cB = nB; ++ui;
        if constexpr (ALIGN_EPI) { if (wr == 1) PG8_BAR; }
    }
    PG8_WAIT_V(0);
    if constexpr (!ALIGN_EPI) { if (wr == 0) PG8_BAR; }
    PG8_BAR;
    if constexpr (Epi::AFTER_DRAIN) { E.fused(acc, cur, wr, wc, fr, fq, lds, wid, lane); S.done(cur); }
#undef PG8_SA
#undef PG8_SB
#undef PG8_STAGE
#undef PG8_LDA
#undef PG8_LDB
#undef PG8_MMA
#undef PG8_WAIT_V
#undef PG8_WAIT_L
#undef PG8_BAR
#undef PG8_SCHED
}
typedef int i32x4 __attribute__((ext_vector_type(4)));
typedef int i32x8 __attribute__((ext_vector_type(8)));
template <class Epi, class Sched, bool ALIGN_EPI = false, bool SP2 = false>
__device__ __forceinline__ void gemm_phase8(PG8_LAS unsigned char* lds, const Gemm g, const Sched& S, const Epi& E) {
    const int tid = tid_opaque(), wid = __builtin_amdgcn_readfirstlane(tid >> 6), lane = tid & 63, wr = wid >> 2, wc = wid & 3, fr = lane & 15, fq = lane >> 4;
    const int K = g.K, nt = K / BK;
    unsigned voffA[2], voffB[2];
#pragma unroll
    for (int i = 0; i < 2; ++i) { int R, C; stage_rc(tid * 16 + i * 8192, R, C); const int Rb = Epi::PERM ? ((R & ~31) + perm32(R & 31)) : R;
        voffA[i] = (unsigned)(R * K + C) * 2u; voffB[i] = (unsigned)(Rb * K + C) * 2u; }
    const size_t rstep64 = (size_t)64 * K * 2;
    const size_t kstep = (size_t)(BK * 2);
    const size_t hstep = (size_t)HALF * K * 2;
    const size_t tstep = 2 * hstep;
    const unsigned ldsw = (unsigned)wid * 1024u;
    const int aoff = lds_byte(wr * 64 + fr, fq * 8), boff = lds_byte(wc * 32 + fr, fq * 8);
#define PG8_SA(b, h) (((b) * 2 + (h)) * HTB)
#define PG8_SB(b, h) ((4 + (b) * 2 + (h)) * HTB)
#define PG8_STAGE(bufoff, gbase, voff) do { _Pragma("unroll") for (int _i = 0; _i < 2; ++_i) \
        __builtin_amdgcn_global_load_lds((const unsigned*)((const char*)(gbase) + (size_t)_i * rstep64 + (voff)[0]), (PG8_LAS unsigned*)(lds + (bufoff) + ldsw + _i * 8192), 16, 0, 0); } while (0)
#define PG8_LD32(p) __builtin_shufflevector(*(const PG8_LAS i32x4*)(p), *(const PG8_LAS i32x4*)((p) + 1024), 0, 1, 2, 3, 4, 5, 6, 7)
#define PG8_LDA(dst, b, h) do { _Pragma("unroll") for (int m = 0; m < 4; ++m) dst[m] = PG8_LD32(lds + PG8_SA(b, h) + aoff + m * 2048); } while (0)
#define PG8_LDB(dst, b, h) do { _Pragma("unroll") for (int n = 0; n < 2; ++n) dst[n] = PG8_LD32(lds + PG8_SB(b, h) + boff + n * 2048); } while (0)
#define PG8_MMA(ai, bj, At, Bt) do { __builtin_amdgcn_s_setprio(1); _Pragma("unroll") for (int m = 0; m < 4; ++m) _Pragma("unroll") for (int n = 0; n < 2; ++n) \
        acc[ai][bj][m][n] = __builtin_amdgcn_mfma_scale_f32_16x16x128_f8f6f4(Bt[n], At[m], acc[ai][bj][m][n], 0, 0, 0, 0, 0, 0);     __builtin_amdgcn_s_setprio(0); } while (0)
#define PG8_WAIT_V(n) asm volatile("s_waitcnt vmcnt(" #n ")" ::: "memory")
#define PG8_WAIT_L(n) asm volatile("s_waitcnt lgkmcnt(" #n ")" ::: "memory")
#define PG8_BAR __builtin_amdgcn_s_barrier()
#define PG8_SCHED __builtin_amdgcn_sched_barrier(0)
    Unit cur, nxt; int ui = 0;
    if (!S.next(0, cur)) return;
    f32x4 acc[2][2][4][2];
#pragma unroll
    for (int a = 0; a < 2; ++a)
#pragma unroll
        for (int b = 0; b < 2; ++b)
#pragma unroll
            for (int m = 0; m < 4; ++m)
#pragma unroll
                for (int n = 0; n < 2; ++n) acc[a][b][m][n] = (f32x4){0.f, 0.f, 0.f, 0.f};
    i32x8 At[4], B0[2], B1[2];
    const char* cA = (const char*)g.A + (size_t)cur.pm * tstep; const char* cB = (const char*)g.Bt + (size_t)cur.pn * tstep;
    S.a_ready(cur);
    if constexpr (SP2) {
        PG8_STAGE(PG8_SB(0, 0), cB, voffB); PG8_STAGE(PG8_SB(0, 1), cB + hstep, voffB); PG8_STAGE(PG8_SA(0, 0), cA, voffA); PG8_STAGE(PG8_SA(0, 1), cA + hstep, voffA);
        if (wr == 1) PG8_BAR;
        PG8_WAIT_V(2); PG8_BAR;
        PG8_STAGE(PG8_SB(1, 0), cB + kstep, voffB); PG8_STAGE(PG8_SA(1, 0), cA + kstep, voffA); PG8_STAGE(PG8_SB(1, 1), cB + hstep + kstep, voffB);
        PG8_WAIT_V(6); PG8_BAR;
    } else {
        PG8_STAGE(PG8_SB(0, 0), cB, voffB); PG8_STAGE(PG8_SA(0, 0), cA, voffA); PG8_STAGE(PG8_SB(0, 1), cB + hstep, voffB); PG8_STAGE(PG8_SA(0, 1), cA + hstep, voffA);
        if (wr == 1) PG8_BAR;
        PG8_WAIT_V(4); PG8_BAR;
        PG8_STAGE(PG8_SB(1, 0), cB + kstep, voffB); PG8_STAGE(PG8_SA(1, 0), cA + kstep, voffA); PG8_STAGE(PG8_SB(1, 1), cB + hstep + kstep, voffB);
        PG8_WAIT_V(6); PG8_BAR;
    }
    for (;;) {
        const bool has_next = S.next(ui + 1, nxt);
        const char* nA = has_next ? (const char*)g.A + (size_t)nxt.pm * tstep : cA; const char* nB = has_next ? (const char*)g.Bt + (size_t)nxt.pn * tstep : cB;
        for (int t = 0; t < nt; t += 2) {
            const bool last = (t == nt - 2);
            const char* a1 = cA + (size_t)(t + 1) * kstep;
            const char* a2 = last ? nA : cA + (size_t)(t + 2) * kstep; const char* b2 = last ? nB : cB + (size_t)(t + 2) * kstep;
            const char* a3 = a2 + kstep; const char* b3 = b2 + kstep;
            if (last && has_next) S.a_ready(nxt);
            if constexpr (SP2) {
            PG8_LDB(B0, 0, 0); PG8_LDB(B1, 0, 1); PG8_SCHED; PG8_LDA(At, 0, 0); PG8_STAGE(PG8_SA(1, 1), a1 + hstep, voffA);
            PG8_WAIT_V(8); PG8_WAIT_L(0); PG8_BAR; PG8_MMA(0, 0, At, B0); PG8_MMA(0, 1, At, B1); PG8_BAR; PG8_SCHED;
            PG8_LDA(At, 0, 1); PG8_STAGE(PG8_SB(0, 0), b2, voffB); PG8_STAGE(PG8_SB(0, 1), b2 + hstep, voffB); PG8_STAGE(PG8_SA(0, 0), a2, voffA);
            PG8_WAIT_V(8); PG8_WAIT_L(0); PG8_BAR; PG8_MMA(1, 0, At, B0); PG8_MMA(1, 1, At, B1); PG8_BAR; PG8_SCHED;
            PG8_LDB(B0, 1, 0); PG8_LDB(B1, 1, 1); PG8_SCHED; PG8_LDA(At, 1, 0); PG8_STAGE(PG8_SA(0, 1), a2 + hstep, voffA);
            PG8_WAIT_V(8); PG8_WAIT_L(0); PG8_BAR; PG8_MMA(0, 0, At, B0); PG8_MMA(0, 1, At, B1); PG8_BAR; PG8_SCHED;
            PG8_LDA(At, 1, 1); PG8_STAGE(PG8_SB(1, 0), b3, voffB); PG8_STAGE(PG8_SB(1, 1), b3 + hstep, voffB); PG8_STAGE(PG8_SA(1, 0), a3, voffA);
            PG8_WAIT_V(8); PG8_WAIT_L(0); PG8_BAR; PG8_MMA(1, 0, At, B0); PG8_MMA(1, 1, At, B1); PG8_BAR; PG8_SCHED;
            } else {
            PG8_LDB(B0, 0, 0); PG8_SCHED; PG8_LDA(At, 0, 0); PG8_STAGE(PG8_SA(1, 1), a1 + hstep, voffA);
            PG8_WAIT_L(8); PG8_BAR; PG8_WAIT_L(0); PG8_MMA(0, 0, At, B0); PG8_BAR; PG8_SCHED;
            PG8_LDB(B1, 0, 1); PG8_STAGE(PG8_SB(0, 0), b2, voffB);
            PG8_BAR; PG8_WAIT_L(0); PG8_MMA(0, 1, At, B1); PG8_BAR;
            PG8_LDA(At, 0, 1); PG8_STAGE(PG8_SA(0, 0), a2, voffA);
            PG8_BAR; PG8_WAIT_L(0); PG8_MMA(1, 0, At, B0); PG8_BAR; PG8_SCHED;
            PG8_STAGE(PG8_SB(0, 1), b2 + hstep, voffB);
            PG8_WAIT_V(6); PG8_BAR; PG8_MMA(1, 1, At, B1); PG8_BAR;
            PG8_LDB(B0, 1, 0); PG8_SCHED; PG8_LDA(At, 1, 0); PG8_STAGE(PG8_SA(0, 1), a2 + hstep, voffA);
            PG8_WAIT_L(8); PG8_BAR; PG8_WAIT_L(0); PG8_MMA(0, 0, At, B0); PG8_BAR; PG8_SCHED;
            PG8_LDB(B1, 1, 1); PG8_STAGE(PG8_SB(1, 0), b3, voffB);
            PG8_BAR; PG8_WAIT_L(0); PG8_MMA(0, 1, At, B1); PG8_BAR;
            PG8_LDA(At, 1, 1); PG8_STAGE(PG8_SA(1, 0), a3, voffA);
            PG8_BAR; PG8_WAIT_L(0); PG8_MMA(1, 0, At, B0); PG8_BAR; PG8_SCHED;
            PG8_STAGE(PG8_SB(1, 1), b3 + hstep, voffB);
            PG8_WAIT_V(6); PG8_BAR; PG8_MMA(1, 1, At, B1); PG8_BAR;
            }
        }
        if constexpr (ALIGN_EPI) { if (wr == 0) PG8_BAR; }
        if constexpr (!Epi::AFTER_DRAIN) { E(acc, cur, wr, wc, fr, fq); S.done(cur); }
        if (!has_next) break;
#pragma unroll
        for (int a = 0; a < 2; ++a)
#pragma unroll
            for (int b = 0; b < 2; ++b)
#pragma unroll
                for (int m = 0; m < 4; ++m)
#pragma unroll
                    for (int n = 0; n < 2; ++n) acc[a][b][m][n] = (f32x4){0.f, 0.f, 0.f, 0.f};
        cur = nxt; cA = nA; cB = nB; ++ui;
        if constexpr (ALIGN_EPI) { if (wr == 1) PG8_BAR; }
    }
    PG8_WAIT_V(0);
    if constexpr (!ALIGN_EPI) { if (wr == 0) PG8_BAR; }
    PG8_BAR;
    if constexpr (Epi::AFTER_DRAIN) { E.fused(acc, cur, wr, wc, fr, fq, lds, wid, lane); S.done(cur); }
#undef PG8_SA
#undef PG8_SB
#undef PG8_STAGE
#undef PG8_LDA
#undef PG8_LDB
#undef PG8_MMA
#undef PG8_LD32
#undef PG8_WAIT_V
#undef PG8_WAIT_L
#undef PG8_BAR
#undef PG8_SCHED
}
}

typedef unsigned short bf16_t;
typedef float f32x4 __attribute__((ext_vector_type(4)));
typedef unsigned u32x4 __attribute__((ext_vector_type(4)));
#define LAS __attribute__((address_space(3)))

constexpr int NT = 512;
constexpr int LDS_BYTES = 160 * 1024;
constexpr int D = 2048, NB = 4, SEQ = 4096, CTXL = 256;
constexpr int MT = NB * SEQ;
constexpr int MC = NB * CTXL;
constexpr int MA = MT + MC;
constexpr int NQKVP = 6400;
constexpr int PQ_LD = 6144;
constexpr int NHY = 6144, NZG = 6144;
constexpr int WT_ROWS = NQKVP + NHY + NZG;
constexpr int WT_HY0 = NQKVP, WT_ZG0 = NQKVP + NHY;
constexpr float ALPHA = 1.189207115002721f;

constexpr size_t MiB = (size_t)1 << 20;
constexpr size_t WS_MOD = 0, WS_HID2 = 1 * MiB, WS_SW = 2 * MiB, WS_HA = 34 * MiB, WS_WT = 102 * MiB, WS_RA = 175 * MiB, WS_RB = 367 * MiB, WS_AB = 580 * MiB, WS_END = 658 * MiB;
constexpr size_t WS_HA8 = 658 * MiB;
constexpr size_t WT8_OFF = (size_t)6144 * 2048 * 2;

struct Args { const float* in[31]; float* out; unsigned char* ws; int ph_lo, ph_hi; int reps[8]; int pad2[2]; };
typedef const __attribute__((address_space(4))) Args* KA;

__device__ __forceinline__ unsigned f2bf(float f) { unsigned u = __float_as_uint(f); return (u + 0x7fffu + ((u >> 16) & 1u)) >> 16; }
__device__ __forceinline__ unsigned pk2(float lo, float hi) { return f2bf(lo) | (f2bf(hi) << 16); }
__device__ __forceinline__ float bflo(unsigned w) { return __uint_as_float(w << 16); }
__device__ __forceinline__ float bfhi(unsigned w) { return __uint_as_float(w & 0xffff0000u); }
__device__ __forceinline__ float bf2f(bf16_t b) { return __uint_as_float(((unsigned)b) << 16); }
__device__ __forceinline__ void unpack8(const u32x4 w, float (&o)[8]) { o[0] = bflo(w.x); o[1] = bfhi(w.x); o[2] = bflo(w.y); o[3] = bfhi(w.y); o[4] = bflo(w.z); o[5] = bfhi(w.z); o[6] = bflo(w.w); o[7] = bfhi(w.w); }
__device__ __forceinline__ u32x4 pack8(const float (&v)[8]) { u32x4 w; w.x = pk2(v[0], v[1]); w.y = pk2(v[2], v[3]); w.z = pk2(v[4], v[5]); w.w = pk2(v[6], v[7]); return w; }
typedef short bf16x8 __attribute__((ext_vector_type(8)));
typedef unsigned u32x2 __attribute__((ext_vector_type(2)));
#define MFMA16(a, b, c) __builtin_amdgcn_mfma_f32_16x16x32_bf16((a), (b), (c), 0, 0, 0)
__device__ __forceinline__ u32x2 pk4(float a, float b, float c, float d) { u32x2 w; w.x = pk2(a, b); w.y = pk2(c, d); return w; }
__device__ __forceinline__ float sigmoidf_(float x) { return 1.0f / (1.0f + expf(-x)); }
__device__ __forceinline__ float siluf_(float x) { return x / (1.0f + expf(-x)); }
__device__ __forceinline__ float rdlane(float v, const int l) { return __builtin_bit_cast(float, __builtin_amdgcn_readlane(__builtin_bit_cast(int, v), l)); }
__device__ __forceinline__ float wave_sum(float v) {
    v += __builtin_bit_cast(float, __builtin_amdgcn_update_dpp(0, __builtin_bit_cast(int, v), 0x128, 0xf, 0xf, false));
    v += __builtin_bit_cast(float, __builtin_amdgcn_update_dpp(0, __builtin_bit_cast(int, v), 0x124, 0xf, 0xf, false));
    v += __builtin_bit_cast(float, __builtin_amdgcn_update_dpp(0, __builtin_bit_cast(int, v), 0x122, 0xf, 0xf, false));
    v += __builtin_bit_cast(float, __builtin_amdgcn_update_dpp(0, __builtin_bit_cast(int, v), 0x121, 0xf, 0xf, false));
    return (rdlane(v, 0) + rdlane(v, 16)) + (rdlane(v, 32) + rdlane(v, 48));
}
__device__ __forceinline__ float wave_max(float v) {
    v = fmaxf(v, __builtin_bit_cast(float, __builtin_amdgcn_update_dpp(0, __builtin_bit_cast(int, v), 0x128, 0xf, 0xf, false)));
    v = fmaxf(v, __builtin_bit_cast(float, __builtin_amdgcn_update_dpp(0, __builtin_bit_cast(int, v), 0x124, 0xf, 0xf, false)));
    v = fmaxf(v, __builtin_bit_cast(float, __builtin_amdgcn_update_dpp(0, __builtin_bit_cast(int, v), 0x122, 0xf, 0xf, false)));
    v = fmaxf(v, __builtin_bit_cast(float, __builtin_amdgcn_update_dpp(0, __builtin_bit_cast(int, v), 0x121, 0xf, 0xf, false)));
    return fmaxf(fmaxf(rdlane(v, 0), rdlane(v, 16)), fmaxf(rdlane(v, 32), rdlane(v, 48)));
}

__device__ void p0_mod_hid2(KA a, float* lf) {
    const int tid = tid_opaque(), bid = blockIdx.x;
    if (bid < 192) {
        const float* c = a->in[1]; const float* cc = a->in[3]; const float* w_ada = a->in[4]; const float* b_ada = a->in[5];
        float* mod = (float*)(a->ws + WS_MOD);
        for (int i = tid; i < 5 * 2048; i += NT) { const int r = i >> 11, k = i & 2047; const float v = (r < 4) ? c[r * 2048 + k] : cc[k]; lf[i] = siluf_(v); }
        __syncthreads();
        const int cl = tid & 63, kg = tid >> 6, col = bid * 64 + cl;
        float a0 = 0.f, a1 = 0.f, a2 = 0.f, a3 = 0.f, a4 = 0.f;
#pragma unroll 8
        for (int k = kg * 256; k < kg * 256 + 256; ++k) {
            const float w = w_ada[(size_t)k * 12288 + col];
            a0 += lf[k] * w; a1 += lf[2048 + k] * w; a2 += lf[4096 + k] * w; a3 += lf[6144 + k] * w; a4 += lf[8192 + k] * w;
        }
        float* red = lf + 5 * 2048;
        red[(kg * 5 + 0) * 64 + cl] = a0; red[(kg * 5 + 1) * 64 + cl] = a1; red[(kg * 5 + 2) * 64 + cl] = a2; red[(kg * 5 + 3) * 64 + cl] = a3; red[(kg * 5 + 4) * 64 + cl] = a4;
        __syncthreads();
        if (tid < 320) { const int r = tid >> 6; float s = 0.f;
#pragma unroll
            for (int g = 0; g < 8; ++g) s += red[(g * 5 + r) * 64 + cl];
            mod[r * 12288 + col] = s + b_ada[col]; }
        __syncthreads();
    } else {
        const float* w1 = a->in[12]; const float* b1 = a->in[13]; const float* w2 = a->in[14]; const float* b2 = a->in[15]; const float* freq = a->in[18];
        float* hid2 = (float*)(a->ws + WS_HID2);
        const int pb = (bid - 192) * 64, j = tid & 63, pl = tid >> 6;
        const float fj = freq[j];
        for (int it = 0; it < 8; ++it) {
            const int pos = pb + it * 8 + pl;
            const float tt = (float)pos * (1.0f / 4095.0f);
            float s1 = tt * w1[j];
            const float base = (6.283185307179586f / 4096.0f) * (float)pos;
            for (int e = 0; e < 16; ++e) {
                const float band = 1e-4f + (float)e * ((15.0f - 1e-4f) / 15.0f);
                const float ang = base * band;
                s1 += cosf(ang) * w1[(1 + e) * 64 + j] - sinf(ang) * w1[(17 + e) * 64 + j];
            }
            lf[pl * 64 + j] = sinf(fj * (s1 + b1[j]));
            __syncthreads();
            float s2 = 0.f;
            for (int i = 0; i < 64; ++i) s2 += lf[pl * 64 + i] * w2[i * 64 + j];
            hid2[pos * 64 + j] = sinf(fj * (s2 + b2[j]));
            __syncthreads();
        }
    }
}

__device__ void transpose_unit(const float* src, int ldn, int n0src, bf16_t* dst, int nb, int kb, float* tile) {
    const int tid = tid_opaque(), r = tid >> 4, c4 = tid & 15;
#pragma unroll
    for (int i = 0; i < 4; ++i) {
        const int kk = i * 32 + r;
        f32x4 v = (f32x4){0.f, 0.f, 0.f, 0.f};
        if (n0src >= 0) v = *(const f32x4*)(src + (size_t)(kb * 128 + kk) * ldn + n0src + c4 * 4);
        float* t = tile + kk * 65 + c4 * 4; t[0] = v.x; t[1] = v.y; t[2] = v.z; t[3] = v.w;
    }
    __syncthreads();
#pragma unroll
    for (int i = 0; i < 2; ++i) {
        const int chunk = tid + i * NT, nr = chunk >> 4, kc = chunk & 15;
        const float* t = tile + (kc * 8) * 65 + nr;
        u32x4 w; w.x = pk2(t[0], t[65]); w.y = pk2(t[130], t[195]); w.z = pk2(t[260], t[325]); w.w = pk2(t[390], t[455]);
        *(u32x4*)(dst + (size_t)(nb * 64 + nr) * 2048 + kb * 128 + kc * 8) = w;
    }
    __syncthreads();
}
__device__ __forceinline__ unsigned pk4_fp8(float a, float b, float c, float d) { int w = __builtin_amdgcn_cvt_pk_fp8_f32(a, b, 0, false); w = __builtin_amdgcn_cvt_pk_fp8_f32(c, d, w, true); return (unsigned)w; }
__device__ void transpose_unit8(const float* src, int ldn, int n0src, unsigned char* dst, int nb, int kb, float* tile) {
    const int tid = tid_opaque(), r = tid >> 4, c4 = tid & 15;
#pragma unroll
    for (int i = 0; i < 4; ++i) {
        const int kk = i * 32 + r;
        f32x4 v = (f32x4){0.f, 0.f, 0.f, 0.f};
        if (n0src >= 0) v = *(const f32x4*)(src + (size_t)(kb * 128 + kk) * ldn + n0src + c4 * 4);
        float* t = tile + kk * 65 + c4 * 4; t[0] = v.x * 64.0f; t[1] = v.y * 64.0f; t[2] = v.z * 64.0f; t[3] = v.w * 64.0f;
    }
    __syncthreads();
    {
        const int nr = tid >> 3, kc = tid & 7;
        const float* t = tile + (kc * 16) * 65 + nr;
        u32x4 w;
        w.x = pk4_fp8(t[0], t[65], t[130], t[195]); w.y = pk4_fp8(t[260], t[325], t[390], t[455]);
        w.z = pk4_fp8(t[520], t[585], t[650], t[715]); w.w = pk4_fp8(t[780], t[845], t[910], t[975]);
        *(u32x4*)(dst + (size_t)(nb * 64 + nr) * 2048 + kb * 128 + kc * 16) = w;
    }
    __syncthreads();
}
__device__ __forceinline__ int win_colmap(int np) {
    if (np < 6144) return np;
    if (np < 6208) return 8192 + (np - 6144);
    if (np < 6400) return -1;
    if (np < 12544) return 8256 + (np - 6400);
    if (np < 14592) return 6144 + (np - 12544);
    return 14400 + (np - 14592);
}
__device__ void p0_transposes(KA a, float* lf) {
    bf16_t* WT = (bf16_t*)(a->ws + WS_WT); bf16_t* SW = (bf16_t*)(a->ws + WS_SW);
    const int NU_WT = (WT_ROWS / 64) * 16, NU_SW = 4 * 32 * 16;
    for (int u = blockIdx.x; u < NU_WT + NU_SW; u += gridDim.x) {
        if (u < NU_WT) { const int nb = u >> 4, kb = u & 15;
            if (nb >= 100 && nb < 196) transpose_unit(a->in[6], 18496, win_colmap(nb * 64), WT, nb - 100, kb, lf);
            else transpose_unit8(a->in[6], 18496, win_colmap(nb * 64), (unsigned char*)WT + WT8_OFF, nb < 100 ? nb : nb - 96, kb, lf); }
        else { const int v = u - NU_WT, mtx = v >> 9, nb = (v >> 4) & 31, kb = v & 15;
            const float* src = (mtx == 0) ? a->in[20] : (mtx == 1) ? a->in[21] : (mtx == 2) ? a->in[22] : a->in[25];
            transpose_unit(src, 2048, nb * 64, SW + (size_t)mtx * 2048 * 2048, nb, kb, lf); }
    }
}

__device__ void p1_ha(KA a) {
    const float* mod = (const float*)(a->ws + WS_MOD); bf16_t* HA = (bf16_t*)(a->ws + WS_HA); unsigned char* HA8 = a->ws + WS_HA8;
    const size_t nthr = (size_t)gridDim.x * NT;
    for (size_t i = (size_t)blockIdx.x * NT + tid_opaque(); i < (size_t)MA * 128; i += nthr) {
        const int row = (int)(i >> 7), k16 = (int)(i & 127) * 16;
        const float* sp; int mr;
        if (row < MT) { sp = a->in[0] + (size_t)row * 2048 + k16; mr = row >> 12; } else { sp = a->in[2] + (size_t)(row - MT) * 2048 + k16; mr = 4; }
        const float* mp = mod + mr * 12288 + k16;
        u32x4 w8, wlo, whi;
#pragma unroll
        for (int j = 0; j < 4; ++j) {
            const f32x4 x = *(const f32x4*)(sp + j * 4), hh = *(const f32x4*)(mp + j * 4), ss = *(const f32x4*)(mp + 2048 + j * 4);
            const float v0 = x[0] * (1.0f + ss[0]) + hh[0], v1 = x[1] * (1.0f + ss[1]) + hh[1], v2 = x[2] * (1.0f + ss[2]) + hh[2], v3 = x[3] * (1.0f + ss[3]) + hh[3];
            w8[j] = pk4_fp8(v0, v1, v2, v3);
            if (j < 2) { wlo[2 * j] = pk2(v0, v1); wlo[2 * j + 1] = pk2(v2, v3); } else { whi[2 * (j - 2)] = pk2(v0, v1); whi[2 * (j - 2) + 1] = pk2(v2, v3); }
        }
        if (row < MT) { *(u32x4*)(HA + (size_t)row * 2048 + k16) = wlo; *(u32x4*)(HA + (size_t)row * 2048 + k16 + 8) = whi; }
        *(u32x4*)(HA8 + (size_t)row * 2048 + k16) = w8;
    }
}

struct FStoreBf16 { bf16_t* O; int ldc; float sc;
    __device__ __forceinline__ void operator()(int row, int col, const f32x4 a0, const f32x4 a1) const {
        const f32x4 v0 = a0 * sc, v1 = a1 * sc;
        u32x4 w; w.x = pg8::cvt_pk_bf16(v0[0], v0[1]); w.y = pg8::cvt_pk_bf16(v0[2], v0[3]); w.z = pg8::cvt_pk_bf16(v1[0], v1[1]); w.w = pg8::cvt_pk_bf16(v1[2], v1[3]);
        *(u32x4*)(O + (size_t)row * ldc + col) = w; } };
struct FStoreQKV { bf16_t* PQ; float* AB; float sc;
    __device__ __forceinline__ void operator()(int row, int col, const f32x4 a0, const f32x4 a1) const {
        const f32x4 v0 = a0 * sc, v1 = a1 * sc;
        if (col < 6144) { u32x4 w; w.x = pg8::cvt_pk_bf16(v0[0], v0[1]); w.y = pg8::cvt_pk_bf16(v0[2], v0[3]); w.z = pg8::cvt_pk_bf16(v1[0], v1[1]); w.w = pg8::cvt_pk_bf16(v1[2], v1[3]);
            *(u32x4*)(PQ + (size_t)row * PQ_LD + col) = w; }
        else if (col < 6208) { float* p = AB + (size_t)row * 64 + (col - 6144); *(f32x4*)p = v0; *(f32x4*)(p + 4) = v1; } } };
struct FStoreF32 { float* O; int ldc;
    __device__ __forceinline__ void operator()(int row, int col, const f32x4 v0, const f32x4 v1) const { float* p = O + (size_t)row * ldc + col; *(f32x4*)p = v0; *(f32x4*)(p + 4) = v1; } };
struct FGatePA { const bf16_t* ZG; bf16_t* MG;
    __device__ __forceinline__ void operator()(int row, int col, const f32x4 v0, const f32x4 v1) const {
        float g[8]; unpack8(*(const u32x4*)(ZG + (size_t)row * NZG + 2048 + col), g);
        float o[8];
#pragma unroll
        for (int e = 0; e < 4; ++e) { o[e] = sigmoidf_(g[e]) * v0[e]; o[4 + e] = sigmoidf_(g[4 + e]) * v1[e]; }
        *(u32x4*)(MG + (size_t)row * 2048 + col) = pack8(o); } };
struct FGatePH { const bf16_t* ZG; bf16_t* MG;
    __device__ __forceinline__ void operator()(int row, int col, const f32x4 v0, const f32x4 v1) const {
        float g[8], t[8]; unpack8(*(const u32x4*)(ZG + (size_t)row * NZG + 4096 + col), g); unpack8(*(const u32x4*)(MG + (size_t)row * 2048 + col), t);
        float o[8];
#pragma unroll
        for (int e = 0; e < 4; ++e) { o[e] = t[e] + sigmoidf_(g[e]) * v0[e]; o[4 + e] = t[4 + e] + sigmoidf_(g[4 + e]) * v1[e]; }
        *(u32x4*)(MG + (size_t)row * 2048 + col) = pack8(o); } };
struct FOut { const float* x; const float* mod; float* T3;
    __device__ __forceinline__ void operator()(int row, int col, const f32x4 v0, const f32x4 v1) const {
        const float* xp = x + (size_t)row * 2048 + col; const float* gp = mod + (row >> 12) * 12288 + 4096 + col;
        const f32x4 x0 = *(const f32x4*)xp, x1 = *(const f32x4*)(xp + 4), g0 = *(const f32x4*)gp, g1 = *(const f32x4*)(gp + 4);
        float* p = T3 + (size_t)row * 2048 + col;
#if DBG_MODE == 1
        *(f32x4*)p = ALPHA * x0; *(f32x4*)(p + 4) = ALPHA * x1;
#else
        *(f32x4*)p = ALPHA * x0 + g0 * v0; *(f32x4*)(p + 4) = ALPHA * x1 + g1 * v1;
#endif
    } };

template <class F> __device__ __forceinline__ void run_gemm8(unsigned char* lds, const unsigned char* A8, const unsigned char* Bt8, int M, int N, const F& f) {
    pg8::Gemm g{(const bf16_t*)A8, (const bf16_t*)Bt8, M, N, 1024}; pg8::StaticOrder S; S.init(M, N, (int)gridDim.x, (int)blockIdx.x);
    pg8::EpiGen<F> E{f};
    pg8::gemm_phase8<pg8::EpiGen<F>, pg8::StaticOrder, true, true>((PG8_LAS unsigned char*)lds, g, S, E);
}
template <class F> __device__ __forceinline__ void run_gemm(unsigned char* lds, const bf16_t* A, const bf16_t* Bt, int M, int N, const F& f) {
    pg8::Gemm g{A, Bt, M, N, 2048}; pg8::StaticOrder S; S.init(M, N, (int)gridDim.x, (int)blockIdx.x);
    pg8::EpiGen<F> E{f};
    pg8::gemm_phase<pg8::EpiGen<F>, pg8::StaticOrder, true, true>((PG8_LAS unsigned char*)lds, g, S, E);
}

typedef float f32x2 __attribute__((ext_vector_type(2)));
constexpr int HY_Z = 0, HY_F = 69632, HY_TW4 = 139264, HY_TW8 = 141312, HY_TW32 = 143360, HY_W3 = 143488;
__device__ __forceinline__ f32x2 cmul(const f32x2 a, const f32x2 b) { return (f32x2){a.x * b.x - a.y * b.y, a.x * b.y + a.y * b.x}; }
__device__ __forceinline__ f32x2 cmulc(const f32x2 a, const f32x2 b) { return (f32x2){a.x * b.x + a.y * b.y, a.y * b.x - a.x * b.y}; }
template <bool INV> __device__ __forceinline__ f32x2 ctw(const f32x2 v, const float wr, const float wi) {
    return INV ? (f32x2){v.x * wr + v.y * wi, v.y * wr - v.x * wi} : (f32x2){v.x * wr - v.y * wi, v.y * wr + v.x * wi};
}
template <bool INV> __device__ __forceinline__ void dft16(f32x2 (&x)[16]) {
    constexpr float C = 0.9238795325112867f, S = 0.3826834323650898f, R = 0.7071067811865476f;
    f32x2 A[4][4];
#pragma unroll
    for (int q0 = 0; q0 < 4; ++q0) {
        const f32x2 a = x[q0], b = x[4 + q0], c = x[8 + q0], d = x[12 + q0];
        const f32x2 t0 = a + c, t1 = a - c, t2 = b + d, t3 = b - d;
        const f32x2 m = (f32x2){t3.y, -t3.x};
        A[q0][0] = t0 + t2; A[q0][2] = t0 - t2;
        A[q0][1] = INV ? (t1 - m) : (t1 + m); A[q0][3] = INV ? (t1 + m) : (t1 - m);
    }
    A[1][1] = ctw<INV>(A[1][1], C, -S); A[1][2] = ctw<INV>(A[1][2], R, -R); A[1][3] = ctw<INV>(A[1][3], S, -C);
    A[2][1] = ctw<INV>(A[2][1], R, -R); A[2][2] = ctw<INV>(A[2][2], 0.f, -1.f); A[2][3] = ctw<INV>(A[2][3], -R, -R);
    A[3][1] = ctw<INV>(A[3][1], S, -C); A[3][2] = ctw<INV>(A[3][2], -R, -R); A[3][3] = ctw<INV>(A[3][3], -C, S);
#pragma unroll
    for (int s = 0; s < 4; ++s) {
        const f32x2 t0 = A[0][s] + A[2][s], t1 = A[0][s] - A[2][s], t2 = A[1][s] + A[3][s], t3 = A[1][s] - A[3][s];
        const f32x2 m = (f32x2){t3.y, -t3.x};
        x[s] = t0 + t2; x[s + 8] = t0 - t2;
        x[s + 4] = INV ? (t1 - m) : (t1 + m); x[s + 12] = INV ? (t1 + m) : (t1 - m);
    }
}
template <bool INV> __device__ __forceinline__ void apply_tw(f32x2 (&x)[16], const f32x2 w) {
    f32x2 wr = w;
#pragma unroll
    for (int r = 1; r < 16; ++r) { x[r] = INV ? cmulc(x[r], wr) : cmul(x[r], wr); if (r < 15) wr = cmul(wr, w); }
}
__device__ __forceinline__ void fft_pass2_fwd(f32x2* B, int t, const f32x2* TW4) {
    const int base = 272 * (t >> 4) + (t & 15); f32x2 x[16];
#pragma unroll
    for (int q = 0; q < 16; ++q) x[q] = B[base + 17 * q];
    dft16<false>(x); apply_tw<false>(x, TW4[16 * (t & 15)]);
#pragma unroll
    for (int q = 0; q < 16; ++q) B[base + 17 * q] = x[q];
}
__device__ __forceinline__ void fft_pass2_inv(f32x2* B, int t, const f32x2* TW4) {
    const int base = 272 * (t >> 4) + (t & 15); f32x2 x[16];
#pragma unroll
    for (int q = 0; q < 16; ++q) x[q] = B[base + 17 * q];
    apply_tw<true>(x, TW4[16 * (t & 15)]); dft16<true>(x);
#pragma unroll
    for (int q = 0; q < 16; ++q) B[base + 17 * q] = x[q];
}
__device__ __forceinline__ float conv3_lane(float c, int lane, float w0, float w1, float w2) {
    (void)lane;
    const float up = __builtin_bit_cast(float, __builtin_amdgcn_update_dpp(0, __builtin_bit_cast(int, c), 0x138, 0xf, 0xf, true));
    const float dn = __builtin_bit_cast(float, __builtin_amdgcn_update_dpp(0, __builtin_bit_cast(int, c), 0x130, 0xf, 0xf, true));
    return w0 * up + w1 * c + w2 * dn;
}
constexpr size_t WS_FILT = 585 * MiB;
__device__ void filt_unit(KA a, int unit, unsigned char* lds) {
    const int tid = tid_opaque(), lane = tid & 63, w = tid >> 6, fr = lane & 15, fq = lane >> 4;
    const int c0 = (unit >> 3) * 64, pc = (unit & 7) * 512;
    bf16_t* Bt = (bf16_t*)lds;
    const float* w3 = a->in[16]; const float* b3 = a->in[17]; const float* hid2 = (const float*)(a->ws + WS_HID2);
    bf16_t* FILT = (bf16_t*)(a->ws + WS_FILT);
    __syncthreads();
#pragma unroll
    for (int i = 0; i < 8; ++i) {
        const int idx = tid + i * NT, k = idx >> 6, q = (idx >> 4) & 3, c4 = idx & 15;
        const f32x4 v = *(const f32x4*)(w3 + (size_t)k * 8192 + (q >> 1) * 4096 + (q & 1) * 2048 + c0 + c4 * 4);
        bf16_t* bp = Bt + (q * 64 + c4 * 4) * 72 + k;
        bp[0] = (bf16_t)f2bf(v.x); bp[72] = (bf16_t)f2bf(v.y); bp[144] = (bf16_t)f2bf(v.z); bp[216] = (bf16_t)f2bf(v.w);
    }
    __syncthreads();
#pragma unroll 1
    for (int it = 0; it < 4; ++it) {
        const int p0 = pc + (it * 8 + w) * 16;
        bf16x8 af[2];
#pragma unroll
        for (int kk = 0; kk < 2; ++kk) { const float* hp = hid2 + (size_t)(p0 + fr) * 64 + kk * 32 + fq * 8; const f32x4 x0 = *(const f32x4*)hp, x1 = *(const f32x4*)(hp + 4);
            u32x4 wv; wv.x = pk2(x0[0], x0[1]); wv.y = pk2(x0[2], x0[3]); wv.z = pk2(x1[0], x1[1]); wv.w = pk2(x1[2], x1[3]); af[kk] = __builtin_bit_cast(bf16x8, wv); }
#pragma unroll 4
        for (int n = 0; n < 16; ++n) {
            f32x4 acc = (f32x4){0.f, 0.f, 0.f, 0.f};
#pragma unroll
            for (int kk = 0; kk < 2; ++kk) acc = MFMA16(af[kk], *(const bf16x8*)(Bt + (n * 16 + fr) * 72 + kk * 32 + fq * 8), acc);
            const int q = n >> 2, c = c0 + (n & 3) * 16 + fr;
            const float bias = b3[(q >> 1) * 4096 + (q & 1) * 2048 + c];
            const float dl = (3.0701134573253944f + 12.280453829301578f * ((float)c * (1.0f / 2047.0f))) * (1.0f / 4095.0f);
            const int pos = p0 + 4 * fq;
            const float e0 = expf(-(float)pos * dl), e1 = expf(-(float)(pos + 1) * dl), e2 = expf(-(float)(pos + 2) * dl), e3 = expf(-(float)(pos + 3) * dl);
            *(u32x2*)(FILT + ((size_t)c * 4 + q) * 4096 + pos) = pk4((acc[0] + bias) * e0, (acc[1] + bias) * e1, (acc[2] + bias) * e2, (acc[3] + bias) * e3);
        }
    }
}
__device__ void hyena_setup(unsigned char* lds) {
    const int tid = tid_opaque();
    f32x2* TW4 = (f32x2*)(lds + HY_TW4); f32x2* TW8 = (f32x2*)(lds + HY_TW8); f32x2* TW32 = (f32x2*)(lds + HY_TW32);
    if (tid < 256) { const float a4 = -6.283185307179586f * (float)tid * (1.0f / 4096.0f), a8 = -6.283185307179586f * (float)tid * (1.0f / 8192.0f);
        TW4[tid] = (f32x2){cosf(a4), sinf(a4)}; TW8[tid] = (f32x2){cosf(a8), sinf(a8)}; }
    if (tid < 16) { const float a = -6.283185307179586f * (float)tid * (1.0f / 32.0f); TW32[tid] = (f32x2){cosf(a), sinf(a)}; }
    __syncthreads();
}
struct HyCtx { f32x2* Z; f32x2* Fb0; const f32x2* TW4; const f32x2* TW32; const bf16_t* rv; const bf16_t* rx1; const bf16_t* rx2; bf16_t* YTc; float* Y1S;
    f32x2 w8t, w4t; float cv0, cv1, cv2, cx0, cx1, cx2, cy0, cy1, cy2, sk0, sk1; int tid, br, t, lane, p1; };
template <int ORDER> __device__ __forceinline__ void hyena_conv(const HyCtx& K, int pr) {
    f32x2* Z = K.Z; const f32x2* TW4 = K.TW4; const f32x2* TW32 = K.TW32;
    const bf16_t* rv = K.rv; const bf16_t* rx1 = K.rx1; const bf16_t* rx2 = K.rx2; float* Y1S = K.Y1S;
    int tid = K.tid; asm volatile("" : "+v"(tid));
    const f32x2 w8t = K.w8t, w4t = K.w4t; const int br = tid >> 8, t = tid & 255, lane = tid & 63, p1 = t + (t >> 4);
    f32x2* Zb = K.Z + br * 4352; f32x2* Fb = K.Fb0 + br * 4352;
    const float cv0 = K.cv0, cv1 = K.cv1, cv2 = K.cv2, cx0 = K.cx0, cx1 = K.cx1, cx2 = K.cx2, cy0 = K.cy0, cy1 = K.cy1, cy2 = K.cy2, sk0 = K.sk0, sk1 = K.sk1;
        const int ba = 2 * pr * 4096, bb = ba + 4096;
        {
            f32x2 x[16];
#pragma unroll
            for (int q = 0; q < 16; ++q) {
                const int n = t + 256 * q; float ua, ub;
                if (ORDER == 0) { ua = conv3_lane(bf2f(rv[ba + n]), lane, cv0, cv1, cv2); ub = conv3_lane(bf2f(rv[bb + n]), lane, cv0, cv1, cv2); }
                else { ua = Y1S[n]; ub = Y1S[4096 + n]; }
                const f32x2 z = (f32x2){ua, ub};
                x[q] = br ? cmul(z, cmul(w8t, TW32[q])) : z;
            }
            dft16<false>(x); apply_tw<false>(x, w4t);
#pragma unroll
            for (int q = 0; q < 16; ++q) Zb[p1 + 272 * q] = x[q];
        }
        __syncthreads();
        fft_pass2_fwd(Zb, t, TW4);
        __syncthreads();
        {
            f32x2 x[16];
#pragma unroll
            for (int q = 0; q < 16; ++q) x[q] = Zb[17 * t + q];
            dft16<false>(x);
#pragma unroll
            for (int r = 0; r < 16; ++r) {
                const int p = 16 * t + r; int pp;
                if (br) pp = 4095 - p;
                else { const int m = (r << 8) | ((t & 15) << 4) | (t >> 4); const int mp = (4096 - m) & 4095; pp = ((mp & 15) << 8) | (mp & 0xF0) | (mp >> 8); }
                const f32x2 fk = Fb[p + (p >> 4)], fc = Fb[pp + (pp >> 4)];
                f32x2 H;
                if (ORDER == 0) H = (f32x2){0.5f * (fk.x + fc.x), 0.5f * (fk.y - fc.y)};
                else H = (f32x2){0.5f * (fk.y + fc.y), -0.5f * (fk.x - fc.x)};
                x[r] = cmul(x[r], H);
            }
            dft16<true>(x);
#pragma unroll
            for (int q = 0; q < 16; ++q) Zb[17 * t + q] = x[q];
        }
        __syncthreads();
        fft_pass2_inv(Zb, t, TW4);
        __syncthreads();
        {
            f32x2 x[16];
#pragma unroll
            for (int q = 0; q < 16; ++q) x[q] = Zb[p1 + 272 * q];
            apply_tw<true>(x, w4t); dft16<true>(x);
            if (br) {
#pragma unroll
                for (int q = 0; q < 16; ++q) x[q] = cmulc(x[q], cmul(w8t, TW32[q]));
            }
#pragma unroll
            for (int q = 0; q < 16; ++q) Zb[p1 + 272 * q] = x[q];
        }
        __syncthreads();
        {
            float in0[8], in1[8], in2[8], in3[8];
#pragma unroll
            for (int i = 0; i < 8; ++i) {
                const int n = tid + i * NT;
                if (ORDER == 0) { in0[i] = bf2f(rv[ba + n]); in1[i] = bf2f(rv[bb + n]); in2[i] = bf2f(rx1[ba + n]); in3[i] = bf2f(rx1[bb + n]); }
                else { in0[i] = Y1S[n]; in1[i] = Y1S[4096 + n]; in2[i] = bf2f(rx2[ba + n]); in3[i] = bf2f(rx2[bb + n]); }
            }
#pragma unroll
            for (int i = 0; i < 8; ++i) {
                const int n = tid + i * NT, pn = n + (n >> 4);
                const f32x2 e0 = Z[pn], e1 = Z[4352 + pn];
                const float ca = (e0.x + e1.x) * (1.0f / 8192.0f), cb = (e0.y + e1.y) * (1.0f / 8192.0f);
                if (ORDER == 0) {
                    const float va = conv3_lane(in0[i], lane, cv0, cv1, cv2), vb = conv3_lane(in1[i], lane, cv0, cv1, cv2);
                    const float xa = conv3_lane(in2[i], lane, cx0, cx1, cx2), xb = conv3_lane(in3[i], lane, cx0, cx1, cx2);
                    Y1S[n] = xa * (ca + sk0 * va); Y1S[4096 + n] = xb * (cb + sk0 * vb);
                } else {
                    const float xa = conv3_lane(in2[i], lane, cy0, cy1, cy2), xb = conv3_lane(in3[i], lane, cy0, cy1, cy2);
                    K.YTc[ba + n] = (bf16_t)f2bf(xa * (ca + sk1 * in0[i])); K.YTc[bb + n] = (bf16_t)f2bf(xb * (cb + sk1 * in1[i]));
                }
            }
        }
        __syncthreads();
}
__device__ void hyena_item(KA a, int c, unsigned char* lds) {
    f32x2* Z = (f32x2*)(lds + HY_Z); f32x2* F = (f32x2*)(lds + HY_F);
    const f32x2* TW4 = (const f32x2*)(lds + HY_TW4); const f32x2* TW8 = (const f32x2*)(lds + HY_TW8); const f32x2* TW32 = (const f32x2*)(lds + HY_TW32);
    float* W3 = (float*)(lds + HY_W3);
    int tid = tid_opaque(); asm volatile("" : "+v"(tid));
    const int br = tid >> 8, t = tid & 255, lane = tid & 63;
    f32x2* Zb = Z + br * 4352; f32x2* Fb = F + br * 4352;
    const float* hid2 = (const float*)(a->ws + WS_HID2);
    const float* w3 = a->in[16]; const float* b3 = a->in[17]; const float* cw = a->in[11]; const float* skip = a->in[19];
    const bf16_t* PHT = (const bf16_t*)(a->ws + WS_RA);
    bf16_t* YT = (bf16_t*)a->out;
    float* Y1S = a->out + (size_t)16 * 1024 * 1024 + (size_t)blockIdx.x * 16384;
    {
        const bf16_t* fp = (const bf16_t*)(a->ws + WS_FILT) + (size_t)c * 4 * 4096 + tid * 8;
        float f0[8], f1[8], f2[8], f3[8];
        unpack8(*(const u32x4*)fp, f0); unpack8(*(const u32x4*)(fp + 4096), f1); unpack8(*(const u32x4*)(fp + 8192), f2); unpack8(*(const u32x4*)(fp + 12288), f3);
#pragma unroll
        for (int e = 0; e < 8; ++e) { Z[tid * 8 + e] = (f32x2){f0[e], f1[e]}; Z[4096 + tid * 8 + e] = (f32x2){f2[e], f3[e]}; }
    }
    __syncthreads();
    const f32x2 w8t = TW8[t], w4t = TW4[t];
    const int p1 = t + (t >> 4);
    {
        f32x2 x[16];
#pragma unroll
        for (int q = 0; q < 16; ++q) {
            const int n = t + 256 * q;
            const f32x2 av = Z[n]; f32x2 bv = Z[8192 - (n ? n : 1)]; if (n == 0) bv = (f32x2){0.f, 0.f};
            x[q] = br ? cmul(av - bv, cmul(w8t, TW32[q])) : (av + bv);
        }
        dft16<false>(x); apply_tw<false>(x, w4t);
#pragma unroll
        for (int q = 0; q < 16; ++q) Fb[p1 + 272 * q] = x[q];
    }
    __syncthreads();
    fft_pass2_fwd(Fb, t, TW4);
    __syncthreads();
    {   f32x2 x[16];
#pragma unroll
        for (int q = 0; q < 16; ++q) x[q] = Fb[17 * t + q];
        dft16<false>(x);
#pragma unroll
        for (int q = 0; q < 16; ++q) Fb[17 * t + q] = x[q];
    }
    __syncthreads();
    const float cv0 = cw[c], cv1 = cw[6144 + c], cv2 = cw[12288 + c];
    const float cx0 = cw[2048 + c], cx1 = cw[6144 + 2048 + c], cx2 = cw[12288 + 2048 + c];
    const float cy0 = cw[4096 + c], cy1 = cw[6144 + 4096 + c], cy2 = cw[12288 + 4096 + c];
    const float sk0 = skip[c], sk1 = skip[2048 + c];
    const bf16_t* rv = PHT + (size_t)c * MT; const bf16_t* rx1 = PHT + (size_t)(2048 + c) * MT; const bf16_t* rx2 = PHT + (size_t)(4096 + c) * MT;
    HyCtx K; K.Z = Z; K.Fb0 = F; K.TW4 = TW4; K.TW32 = TW32; K.rv = rv; K.rx1 = rx1; K.rx2 = rx2; K.YTc = YT + (size_t)c * MT; K.Y1S = Y1S;
    K.w8t = w8t; K.w4t = w4t; K.cv0 = cv0; K.cv1 = cv1; K.cv2 = cv2; K.cx0 = cx0; K.cx1 = cx1; K.cx2 = cx2; K.cy0 = cy0; K.cy1 = cy1; K.cy2 = cy2; K.sk0 = sk0; K.sk1 = sk1;
    K.tid = tid; K.br = br; K.t = t; K.lane = lane; K.p1 = p1;
#pragma unroll 1
    for (int pr = 0; pr < 2; ++pr) { hyena_conv<0>(K, pr); hyena_conv<1>(K, pr); }
}

__device__ void qkvpost_unit(KA a, int unit, unsigned char* lds) {
    const int tid = tid_opaque();
    int ntok, row0, wh;
    if (unit < 12288) { const int gr = unit / 48; wh = unit % 48; ntok = 64; row0 = gr * 64; }
    else { const int uu = unit - 12288; const int b = uu / 48; wh = uu % 48; ntok = 256; row0 = MT + b * 256; }
    const int which = wh >> 4, h = wh & 15, colbase = which * 2048 + h * 128;
    bf16_t* PQ = (bf16_t*)(a->ws + WS_RB);
    bf16_t* raw = (bf16_t*)lds; float* wl = (float*)(lds + 65536);
    const float* cwt = a->in[7];
    for (int i = tid; i < ntok * 16; i += NT) { const int r = i >> 4, c8 = i & 15; *(u32x4*)(raw + r * 128 + c8 * 8) = *(const u32x4*)(PQ + (size_t)(row0 + r) * PQ_LD + colbase + c8 * 8); }
    for (int i = tid; i < 640; i += NT) wl[i] = cwt[(i >> 7) * 6144 + colbase + (i & 127)];
    __syncthreads();
    const int r = tid >> 3, cg = tid & 7;
    for (int rb = 0; rb < ntok / 64; ++rb) {
        const int tok = rb * 64 + r;
        float v[16]; float ss = 0.f;
#pragma unroll
        for (int e = 0; e < 16; ++e) v[e] = 0.f;
#pragma unroll
        for (int j = 0; j < 5; ++j) {
            const int tt = tok + j - 2;
            if (tt >= 0 && tt < ntok) {
                float p0[8], p1[8]; unpack8(*(const u32x4*)(raw + tt * 128 + cg * 16), p0); unpack8(*(const u32x4*)(raw + tt * 128 + cg * 16 + 8), p1);
                const float* wp = wl + j * 128 + cg * 16;
#pragma unroll
                for (int e = 0; e < 8; ++e) { v[e] += wp[e] * p0[e]; v[8 + e] += wp[8 + e] * p1[e]; }
            }
        }
#pragma unroll
        for (int e = 0; e < 16; ++e) { const float s = siluf_(v[e]); v[e] = s; ss += s * s; }
        if (which < 2) {
            ss += __shfl_xor(ss, 1, 64); ss += __shfl_xor(ss, 2, 64); ss += __shfl_xor(ss, 4, 64);
            const float sc = rsqrtf(ss + 1e-6f) * (which == 0 ? 0.08838834764831845f : 1.0f);
#pragma unroll
            for (int e = 0; e < 16; ++e) v[e] *= sc;
        }
        bf16_t* op = PQ + (size_t)(row0 + tok) * PQ_LD + colbase + cg * 16;
        u32x4 w0, w1;
        w0.x = pk2(v[0], v[1]); w0.y = pk2(v[2], v[3]); w0.z = pk2(v[4], v[5]); w0.w = pk2(v[6], v[7]);
        w1.x = pk2(v[8], v[9]); w1.y = pk2(v[10], v[11]); w1.z = pk2(v[12], v[13]); w1.w = pk2(v[14], v[15]);
        *(u32x4*)op = w0; *(u32x4*)(op + 8) = w1;
    }
    __syncthreads();
}

__device__ void qkvpost_latent(KA a, unsigned char* lds) {
    const int tid = tid_opaque(), r = tid >> 3, cg = tid & 7;
    bf16_t* PQ = (bf16_t*)(a->ws + WS_RB); const float* cwt = a->in[7];
    u32x4 pre0, pre1; float pw0, pw1 = 0.f;
    int u = blockIdx.x;
    {
        const int gr = u / 48, wh = u % 48, colbase = (wh >> 4) * 2048 + (wh & 15) * 128, row0 = gr * 64;
        pre0 = *(const u32x4*)(PQ + (size_t)(row0 + (tid >> 4)) * PQ_LD + colbase + (tid & 15) * 8);
        pre1 = *(const u32x4*)(PQ + (size_t)(row0 + 32 + (tid >> 4)) * PQ_LD + colbase + (tid & 15) * 8);
        pw0 = cwt[(tid >> 7) * 6144 + colbase + (tid & 127)]; if (tid < 128) pw1 = cwt[4 * 6144 + colbase + tid];
    }
#pragma unroll 1
    for (int k = 0; u < 12288; ++k, u += gridDim.x) {
        bf16_t* raw = (bf16_t*)(lds + (k & 1) * 16384); float* wl = (float*)(lds + 32768 + (k & 1) * 2560);
        *(u32x4*)(raw + (tid >> 4) * 128 + (tid & 15) * 8) = pre0; *(u32x4*)(raw + (32 + (tid >> 4)) * 128 + (tid & 15) * 8) = pre1;
        wl[tid] = pw0; if (tid < 128) wl[512 + tid] = pw1;
        __syncthreads();
        const int gr = u / 48, wh = u % 48, which = wh >> 4, colbase = which * 2048 + (wh & 15) * 128, row0 = gr * 64;
        const int un = u + gridDim.x;
        if (un < 12288) {
            const int grn = un / 48, whn = un % 48, cbn = (whn >> 4) * 2048 + (whn & 15) * 128, r0n = grn * 64;
            pre0 = *(const u32x4*)(PQ + (size_t)(r0n + (tid >> 4)) * PQ_LD + cbn + (tid & 15) * 8);
            pre1 = *(const u32x4*)(PQ + (size_t)(r0n + 32 + (tid >> 4)) * PQ_LD + cbn + (tid & 15) * 8);
            pw0 = cwt[(tid >> 7) * 6144 + cbn + (tid & 127)]; if (tid < 128) pw1 = cwt[4 * 6144 + cbn + tid];
        }
        float v[16]; float ss = 0.f;
#pragma unroll
        for (int e = 0; e < 16; ++e) v[e] = 0.f;
#pragma unroll
        for (int j = 0; j < 5; ++j) {
            const int tt = r + j - 2;
            if (tt >= 0 && tt < 64) {
                float p0[8], p1[8]; unpack8(*(const u32x4*)(raw + tt * 128 + cg * 16), p0); unpack8(*(const u32x4*)(raw + tt * 128 + cg * 16 + 8), p1);
                const float* wp = wl + j * 128 + cg * 16;
#pragma unroll
                for (int e = 0; e < 8; ++e) { v[e] += wp[e] * p0[e]; v[8 + e] += wp[8 + e] * p1[e]; }
            }
        }
#pragma unroll
        for (int e = 0; e < 16; ++e) { const float s = siluf_(v[e]); v[e] = s; ss += s * s; }
        if (which < 2) {
            ss += __shfl_xor(ss, 1, 64); ss += __shfl_xor(ss, 2, 64); ss += __shfl_xor(ss, 4, 64);
            const float sc = rsqrtf(ss + 1e-6f) * (which == 0 ? 0.08838834764831845f : 1.0f);
#pragma unroll
            for (int e = 0; e < 16; ++e) v[e] *= sc;
        }
        bf16_t* op = PQ + (size_t)(row0 + r) * PQ_LD + colbase + cg * 16;
        u32x4 w0, w1;
        w0.x = pk2(v[0], v[1]); w0.y = pk2(v[2], v[3]); w0.z = pk2(v[4], v[5]); w0.w = pk2(v[6], v[7]);
        w1.x = pk2(v[8], v[9]); w1.y = pk2(v[10], v[11]); w1.z = pk2(v[12], v[13]); w1.w = pk2(v[14], v[15]);
        *(u32x4*)op = w0; *(u32x4*)(op + 8) = w1;
    }
    __syncthreads();
}

typedef short bf16x8 __attribute__((ext_vector_type(8)));
constexpr size_t WS_TS = 585 * MiB, WS_GCB = 653 * MiB;

__device__ void tprep_wave(KA a, int pid, unsigned char* wl) {
    const int lane = tid_opaque() & 63, fr = lane & 15, fq = lane >> 4;
    const int sid = pid / 68, cidx = pid - sid * 68, dir = sid & 1, h = (sid >> 1) & 15, b = sid >> 5;
    bf16_t* kt = (bf16_t*)wl; float* Mf = (float*)wl; float* gcs = (float*)(wl + 17408); float* bes = gcs + 64;
    const bf16_t* PQ = (const bf16_t*)(a->ws + WS_RB); const float* AB = (const float*)(a->ws + WS_AB);
    bf16_t* TS = (bf16_t*)(a->ws + WS_TS) + (size_t)pid * 4096; float* GCB = (float*)(a->ws + WS_GCB) + (size_t)pid * 128;
    int rbase, Tn, p0;
    if (cidx < 4) { rbase = MT + b * CTXL; Tn = CTXL; p0 = cidx * 64; } else { rbase = b * SEQ; Tn = SEQ; p0 = (cidx - 4) * 64; }
    {
        u32x4 kv[16];
#pragma unroll
        for (int it = 0; it < 16; ++it) {
            const int i = it * 4 + fq, p = p0 + i, tok = dir ? (Tn - 1 - p) : p;
            kv[it] = *(const u32x4*)(PQ + (size_t)(rbase + tok) * PQ_LD + 2048 + h * 128 + fr * 8);
        }
#pragma unroll
        for (int it = 0; it < 16; ++it) *(u32x4*)(kt + (it * 4 + fq) * 136 + fr * 8) = kv[it];
    }
    {
        const int p = p0 + lane, tok = dir ? (Tn - 1 - p) : p; const size_t row = (size_t)(rbase + tok);
        const float ab0 = AB[row * 64 + dir * 32 + h], ab1 = AB[row * 64 + dir * 32 + 16 + h];
        const float xx = ab0 + a->in[9][dir * 16 + h]; const float sp = (xx > 20.0f) ? xx : log1pf(expf(xx));
        float gc = -expf(a->in[8][dir * 16 + h]) * sp;
#pragma unroll
        for (int o = 1; o < 64; o <<= 1) { const float tt = __shfl_up(gc, o, 64); if (lane >= o) gc += tt; }
        const float be = sigmoidf_(ab1);
        gcs[lane] = gc; bes[lane] = be; GCB[lane] = gc; GCB[64 + lane] = expf(gc);
    }
    f32x4 acc[10];
#pragma unroll
    for (int i = 0; i < 10; ++i) acc[i] = (f32x4){0.f, 0.f, 0.f, 0.f};
#pragma unroll
    for (int kk = 0; kk < 4; ++kk) {
        bf16x8 fg[4];
#pragma unroll
        for (int ct = 0; ct < 4; ++ct) fg[ct] = *(const bf16x8*)(kt + (ct * 16 + fr) * 136 + kk * 32 + fq * 8);
#pragma unroll
        for (int ct = 0; ct < 4; ++ct)
#pragma unroll
            for (int mt = 0; mt <= ct; ++mt) acc[ct * (ct + 1) / 2 + mt] = MFMA16(fg[ct], fg[mt], acc[ct * (ct + 1) / 2 + mt]);
    }
    float gcr[4][4], ber[4][4];
#pragma unroll
    for (int ct = 0; ct < 4; ++ct)
#pragma unroll
        for (int r = 0; r < 4; ++r) { gcr[ct][r] = gcs[ct * 16 + 4 * fq + r]; ber[ct][r] = bes[ct * 16 + 4 * fq + r]; }
    float gcm[4];
#pragma unroll
    for (int mt = 0; mt < 4; ++mt) gcm[mt] = gcs[mt * 16 + fr];
    asm volatile("s_waitcnt lgkmcnt(0)" ::: "memory");
#pragma unroll
    for (int ct = 0; ct < 4; ++ct)
#pragma unroll
        for (int mt = 0; mt < 4; ++mt)
#pragma unroll
            for (int r = 0; r < 4; ++r) {
                const int c = ct * 16 + 4 * fq + r, m = mt * 16 + fr;
                float val = 0.0f;
                if (mt <= ct) val = (m < c) ? ber[ct][r] * acc[(mt <= ct) ? (ct * (ct + 1) / 2 + mt) : 0][r] * expf(gcr[ct][r] - gcm[mt]) : 0.0f;
                Mf[c * 68 + m] = val;
            }
    asm volatile("s_waitcnt lgkmcnt(0)" ::: "memory");
    {
        float* blk = Mf + (fq * 16) * 68 + fq * 16;
        float t[16];
#pragma unroll
        for (int i = 0; i < 16; ++i) {
            float s = (fr == i) ? 1.0f : 0.0f;
#pragma unroll
            for (int m4 = 0; m4 < i; m4 += 4) {
                const f32x4 mv = *(const f32x4*)(blk + i * 68 + m4);
                s -= mv.x * t[m4];
                if (m4 + 1 < i) s -= mv.y * t[m4 + 1];
                if (m4 + 2 < i) s -= mv.z * t[m4 + 2];
                if (m4 + 3 < i) s -= mv.w * t[m4 + 3];
            }
            t[i] = s;
        }
        asm volatile("s_waitcnt lgkmcnt(0)" ::: "memory");
#pragma unroll
        for (int i = 0; i < 16; ++i) blk[i * 68 + fr] = t[i];
        asm volatile("s_waitcnt lgkmcnt(0)" ::: "memory");
    }
    float* Ysc = (float*)(wl + 17920);
#pragma unroll
    for (int I = 1; I < 4; ++I)
#pragma unroll
        for (int J = 0; J < I; ++J) {
            f32x4 ya = (f32x4){0.f, 0.f, 0.f, 0.f};
#pragma unroll
            for (int K = J; K < I; ++K)
#pragma unroll
                for (int s = 0; s < 4; ++s) ya = __builtin_amdgcn_mfma_f32_16x16x4f32(Mf[(16 * I + fr) * 68 + 16 * K + 4 * s + fq], Mf[(16 * K + 4 * s + fq) * 68 + 16 * J + fr], ya, 0, 0, 0);
#pragma unroll
            for (int r = 0; r < 4; ++r) Ysc[(4 * fq + r) * 16 + fr] = ya[r];
            asm volatile("s_waitcnt lgkmcnt(0)" ::: "memory");
            f32x4 za = (f32x4){0.f, 0.f, 0.f, 0.f};
#pragma unroll
            for (int s = 0; s < 4; ++s) za = __builtin_amdgcn_mfma_f32_16x16x4f32(Mf[(16 * I + fr) * 68 + 16 * I + 4 * s + fq], Ysc[(4 * s + fq) * 16 + fr], za, 0, 0, 0);
#pragma unroll
            for (int r = 0; r < 4; ++r) Mf[(16 * I + 4 * fq + r) * 68 + 16 * J + fr] = -za[r];
            asm volatile("s_waitcnt lgkmcnt(0)" ::: "memory");
        }
#pragma unroll
    for (int it = 0; it < 8; ++it) {
        const int row = it * 8 + (lane >> 3), c8 = (lane & 7) * 8;
        const f32x4 x0 = *(const f32x4*)(Mf + row * 68 + c8) * *(const f32x4*)(bes + c8), x1 = *(const f32x4*)(Mf + row * 68 + c8 + 4) * *(const f32x4*)(bes + c8 + 4);
        u32x4 wv; wv.x = pk2(x0[0], x0[1]); wv.y = pk2(x0[2], x0[3]); wv.z = pk2(x1[0], x1[1]); wv.w = pk2(x1[2], x1[3]);
        *(u32x4*)(TS + row * 64 + c8) = wv;
    }
    asm volatile("s_waitcnt lgkmcnt(0)" ::: "memory");
}

constexpr int DL_QN = 0, DL_KN = 17408, DL_WN = 34816, DL_ST = 52224, DL_KT = 69632, DL_VT = 88064, DL_T1 = 97280, DL_T2 = 106496, DL_AT = 115712, DL_VN = 124928, DL_VD = 134144, DL_GS = 143360;
struct DStage { u32x4 q0, q1, k0, k1, v, t; f32x4 g0, g1, b0, b1; float bi, gl, g63; };
__device__ __forceinline__ void dstage_load(DStage& R, const bf16_t* PQ, const bf16_t* TS, const float* GCB, int sid, int cidx, int dir, int h, int b, int dvh, int tid) {
    const int i = tid >> 3, part = tid & 7;
    int rbase, Tn, p0;
    if (cidx < 4) { rbase = MT + b * CTXL; Tn = CTXL; p0 = cidx * 64; } else { rbase = b * SEQ; Tn = SEQ; p0 = (cidx - 4) * 64; }
    const int p = p0 + i, tok = dir ? (Tn - 1 - p) : p;
    const bf16_t* rp = PQ + (size_t)(rbase + tok) * PQ_LD + h * 128;
    R.q0 = *(const u32x4*)(rp + part * 16); R.q1 = *(const u32x4*)(rp + part * 16 + 8);
    R.k0 = *(const u32x4*)(rp + 2048 + part * 16); R.k1 = *(const u32x4*)(rp + 2048 + part * 16 + 8);
    R.v = *(const u32x4*)(rp + 4096 + dvh * 64 + part * 8);
    const size_t pid = (size_t)sid * 68 + cidx;
    R.t = *(const u32x4*)(TS + pid * 4096 + i * 64 + part * 8);
    const float* gp = GCB + pid * 128;
    R.b0 = *(const f32x4*)(gp + 64 + part * 8); R.b1 = *(const f32x4*)(gp + 64 + part * 8 + 4);
    R.gl = gp[tid & 63]; R.bi = gp[64 + (tid & 63)]; R.g63 = gp[63];
}
__device__ __forceinline__ void dstage_store(const DStage& R, unsigned char* lds, int tid) {
    const int i = tid >> 3, part = tid & 7;
    bf16_t* QN = (bf16_t*)(lds + DL_QN); bf16_t* KN = (bf16_t*)(lds + DL_KN); bf16_t* VNAT = (bf16_t*)(lds + DL_VT);
    bf16_t* T1 = (bf16_t*)(lds + DL_T1); bf16_t* T2 = (bf16_t*)(lds + DL_T2); float* GS = (float*)(lds + DL_GS);
    *(u32x4*)(QN + i * 136 + part * 16) = R.q0; *(u32x4*)(QN + i * 136 + part * 16 + 8) = R.q1;
    *(u32x4*)(KN + i * 136 + part * 16) = R.k0; *(u32x4*)(KN + i * 136 + part * 16 + 8) = R.k1;
    *(u32x4*)(VNAT + i * 72 + part * 8) = R.v;
    float t8[8]; unpack8(R.t, t8);
    const float em[8] = {R.b0.x, R.b0.y, R.b0.z, R.b0.w, R.b1.x, R.b1.y, R.b1.z, R.b1.w};
    float a1[8];
#pragma unroll
    for (int e = 0; e < 8; ++e) a1[e] = t8[e] * em[e];
    *(u32x4*)(T1 + i * 72 + part * 8) = pack8(a1); *(u32x4*)(T2 + i * 72 + part * 8) = R.t;
    if (tid < 64) { GS[tid] = R.gl; GS[64 + tid] = R.bi; GS[128 + tid] = expf(R.g63 - R.gl); }
}
typedef short s16x4 __attribute__((ext_vector_type(4)));
__device__ __forceinline__ void tr_frags2(unsigned a0, unsigned a1, bf16x8& f0, bf16x8& f1) {
    (void)a0; (void)a1; (void)f0; (void)f1;
}
#define TR_READ4(r0, r1, r2, r3, ad0, ad1, ad2, ad3) asm volatile("ds_read_b64_tr_b16 %0, %4\n\tds_read_b64_tr_b16 %1, %5\n\tds_read_b64_tr_b16 %2, %6\n\tds_read_b64_tr_b16 %3, %7\n\ts_waitcnt lgkmcnt(0)" \
    : "=&v"(r0), "=&v"(r1), "=&v"(r2), "=&v"(r3) : "v"(ad0), "v"(ad1), "v"(ad2), "v"(ad3) : "memory")
#define TR_CAT(lo, hi) __builtin_shufflevector((lo), (hi), 0, 1, 2, 3, 4, 5, 6, 7)
#define LBAR() do { asm volatile("s_waitcnt lgkmcnt(0)" ::: "memory"); __builtin_amdgcn_s_barrier(); asm volatile("" ::: "memory"); } while (0)
__device__ void delta_item(KA a, int item, unsigned char* lds) {
    const int tid = tid_opaque(), lane = tid & 63, w = tid >> 6, fr = lane & 15, fq = lane >> 4;
    const int dvh = item & 1, dir = (item >> 1) & 1, h = (item >> 2) & 15, b = item >> 6, sid = (b * 16 + h) * 2 + dir;
    const bf16_t* PQ = (const bf16_t*)(a->ws + WS_RB); const bf16_t* TS = (const bf16_t*)(a->ws + WS_TS); const float* GCB = (const float*)(a->ws + WS_GCB);
    bf16_t* O = (bf16_t*)(a->ws + WS_RA) + (size_t)dir * MT * 2048;
    const bf16_t* QN = (const bf16_t*)(lds + DL_QN); const bf16_t* KN = (const bf16_t*)(lds + DL_KN); bf16_t* WN = (bf16_t*)(lds + DL_WN); bf16_t* ST = (bf16_t*)(lds + DL_ST);
    const bf16_t* KT = (const bf16_t*)(lds + DL_KT); const bf16_t* VT = (const bf16_t*)(lds + DL_VT); const bf16_t* T1 = (const bf16_t*)(lds + DL_T1); const bf16_t* T2 = (const bf16_t*)(lds + DL_T2);
    bf16_t* AT = (bf16_t*)(lds + DL_AT); bf16_t* VN = (bf16_t*)(lds + DL_VN); bf16_t* VD = (bf16_t*)(lds + DL_VD); const float* GS = (const float*)(lds + DL_GS);
    const unsigned lds_base = (unsigned)(size_t)lds;
    __syncthreads();
    for (int i = tid; i < 64 * 136 / 2; i += NT) ((unsigned*)ST)[i] = 0u;
    f32x4 sacc[4];
#pragma unroll
    for (int i = 0; i < 4; ++i) sacc[i] = (f32x4){0.f, 0.f, 0.f, 0.f};
    DStage R;
    dstage_load(R, PQ, TS, GCB, sid, 0, dir, h, b, dvh, tid);
#pragma unroll 1
    for (int cidx = 0; cidx < 68; ++cidx) {
#pragma unroll 1
        for (int rep = 0; rep < a->reps[6]; ++rep) dstage_store(R, lds, tid);
        LBAR();
        if (cidx + 1 < 68) dstage_load(R, PQ, TS, GCB, sid, cidx + 1, dir, h, b, dvh, tid);
        bf16x8 ktf[2];
        {
            const unsigned kb = lds_base + DL_KN + (unsigned)((8 * fq + (fr >> 2)) * 272 + (w * 16 + 4 * (fr & 3)) * 2);
            s16x4 r0, r1, r2, r3;
            TR_READ4(r0, r1, r2, r3, kb, kb + 4 * 272, kb + 32 * 272, kb + 36 * 272);
            __builtin_amdgcn_sched_barrier(0);
            ktf[0] = TR_CAT(r0, r1); ktf[1] = TR_CAT(r2, r3);
        }
#pragma unroll 1
        for (int rep = 0; rep < a->reps[7]; ++rep) {
#pragma unroll
        for (int ti = 0; ti < 2; ++ti) {
            const int idx = w * 2 + ti, mt = idx >> 2, ct = idx & 3;
            f32x4 acc = (f32x4){0.f, 0.f, 0.f, 0.f};
            if (mt <= ct) {
#pragma unroll
                for (int kk = 0; kk < 4; ++kk) {
                    const bf16x8 af = *(const bf16x8*)(KN + (mt * 16 + fr) * 136 + kk * 32 + fq * 8), bfg = *(const bf16x8*)(QN + (ct * 16 + fr) * 136 + kk * 32 + fq * 8);
                    acc = MFMA16(af, bfg, acc);
                }
            }
            const int c = ct * 16 + fr; const float gcc = GS[c];
            float o4[4];
#pragma unroll
            for (int r = 0; r < 4; ++r) { const int m = mt * 16 + 4 * fq + r; o4[r] = (m <= c) ? acc[r] * expf(gcc - GS[m]) : 0.0f; }
            *(u32x2*)(AT + c * 72 + mt * 16 + 4 * fq) = pk4(o4[0], o4[1], o4[2], o4[3]);
        }
        {
            bf16x8 af[2];
            af[0] = ktf[0]; af[1] = ktf[1];
#pragma unroll
            for (int ct = 0; ct < 4; ++ct) {
                f32x4 acc = (f32x4){0.f, 0.f, 0.f, 0.f};
#pragma unroll
                for (int kk = 0; kk < 2; ++kk) acc = MFMA16(af[kk], *(const bf16x8*)(T1 + (ct * 16 + fr) * 72 + kk * 32 + fq * 8), acc);
                *(u32x2*)(WN + (ct * 16 + fr) * 136 + w * 16 + 4 * fq) = pk4(-acc[0], -acc[1], -acc[2], -acc[3]);
            }
        }
        }
        const int ctu = w >> 1, dv0 = 2 * (w & 1);
        f32x4 uacc[2];
        {
            bf16x8 af[2];
#pragma unroll
            for (int kk = 0; kk < 2; ++kk) af[kk] = *(const bf16x8*)(T2 + (ctu * 16 + fr) * 72 + kk * 32 + fq * 8);
#pragma unroll
            for (int j = 0; j < 2; ++j) { uacc[j] = (f32x4){0.f, 0.f, 0.f, 0.f};
                const unsigned vb = lds_base + DL_VT + (unsigned)((8 * fq + (fr >> 2)) * 144 + ((dv0 + j) * 16 + 4 * (fr & 3)) * 2);
                s16x4 r0, r1, r2, r3;
                TR_READ4(r0, r1, r2, r3, vb, vb + 4 * 144, vb + 32 * 144, vb + 36 * 144);
                __builtin_amdgcn_sched_barrier(0);
                uacc[j] = MFMA16(af[0], TR_CAT(r0, r1), uacc[j]); uacc[j] = MFMA16(af[1], TR_CAT(r2, r3), uacc[j]); }
        }
        LBAR();
        {
            bf16x8 af[4];
#pragma unroll
            for (int kk = 0; kk < 4; ++kk) af[kk] = *(const bf16x8*)(WN + (ctu * 16 + fr) * 136 + kk * 32 + fq * 8);
            float ed[4];
#pragma unroll
            for (int r = 0; r < 4; ++r) ed[r] = GS[128 + ctu * 16 + 4 * fq + r];
#pragma unroll
            for (int j = 0; j < 2; ++j) {
#pragma unroll
                for (int kk = 0; kk < 4; ++kk) uacc[j] = MFMA16(af[kk], *(const bf16x8*)(ST + ((dv0 + j) * 16 + fr) * 136 + kk * 32 + fq * 8), uacc[j]);
                const int dv = (dv0 + j) * 16 + fr;
                *(u32x2*)(VN + dv * 72 + ctu * 16 + 4 * fq) = pk4(uacc[j][0], uacc[j][1], uacc[j][2], uacc[j][3]);
                *(u32x2*)(VD + dv * 72 + ctu * 16 + 4 * fq) = pk4(uacc[j][0] * ed[0], uacc[j][1] * ed[1], uacc[j][2] * ed[2], uacc[j][3] * ed[3]);
            }
        }
        LBAR();
        {
            const int dvt = w >> 1, c0 = 2 * (w & 1);
            bf16x8 af[4], vf[2];
#pragma unroll
            for (int kk = 0; kk < 4; ++kk) af[kk] = *(const bf16x8*)(ST + (dvt * 16 + fr) * 136 + kk * 32 + fq * 8);
#pragma unroll
            for (int kk = 0; kk < 2; ++kk) vf[kk] = *(const bf16x8*)(VN + (dvt * 16 + fr) * 72 + kk * 32 + fq * 8);
#pragma unroll
            for (int j = 0; j < 2; ++j) {
                const int c = (c0 + j) * 16 + fr;
                f32x4 acc = (f32x4){0.f, 0.f, 0.f, 0.f};
#pragma unroll
                for (int kk = 0; kk < 4; ++kk) acc = MFMA16(af[kk], *(const bf16x8*)(QN + c * 136 + kk * 32 + fq * 8), acc);
                const float eg = GS[64 + c];
                acc = acc * eg;
#pragma unroll
                for (int kk = 0; kk < 2; ++kk) acc = MFMA16(vf[kk], *(const bf16x8*)(AT + c * 72 + kk * 32 + fq * 8), acc);
                if (cidx >= 4) {
                    const int p = (cidx - 4) * 64 + c, tok = dir ? (SEQ - 1 - p) : p;
                    *(u32x2*)(O + (size_t)(b * SEQ + tok) * 2048 + h * 128 + dvh * 64 + dvt * 16 + 4 * fq) = pk4(acc[0], acc[1], acc[2], acc[3]);
                }
            }
        }
        {
            const float eg63 = GS[64 + 63];
            bf16x8 af[2];
            af[0] = ktf[0]; af[1] = ktf[1];
#pragma unroll
            for (int j = 0; j < 4; ++j) {
                sacc[j] = sacc[j] * eg63;
#pragma unroll
                for (int kk = 0; kk < 2; ++kk) sacc[j] = MFMA16(af[kk], *(const bf16x8*)(VD + (j * 16 + fr) * 72 + kk * 32 + fq * 8), sacc[j]);
            }
        }
        LBAR();
#pragma unroll
        for (int j = 0; j < 4; ++j) *(u32x2*)(ST + (j * 16 + fr) * 136 + w * 16 + 4 * fq) = pk4(sacc[j][0], sacc[j][1], sacc[j][2], sacc[j][3]);
    }
    __syncthreads();
}

__device__ void ytrans_unit(const bf16_t* YT, bf16_t* Y, int unit, bf16_t* tile) {
    const int tid = tid_opaque(), cb = unit & 31, tb = unit >> 5, r = tid >> 3, c8 = (tid & 7) * 8;
    *(u32x4*)(tile + r * 72 + c8) = *(const u32x4*)(YT + (size_t)(cb * 64 + r) * MT + tb * 64 + c8);
    __syncthreads();
    u32x4 w;
    w.x = (unsigned)tile[(c8 + 0) * 72 + r] | ((unsigned)tile[(c8 + 1) * 72 + r] << 16);
    w.y = (unsigned)tile[(c8 + 2) * 72 + r] | ((unsigned)tile[(c8 + 3) * 72 + r] << 16);
    w.z = (unsigned)tile[(c8 + 4) * 72 + r] | ((unsigned)tile[(c8 + 5) * 72 + r] << 16);
    w.w = (unsigned)tile[(c8 + 6) * 72 + r] | ((unsigned)tile[(c8 + 7) * 72 + r] << 16);
    *(u32x4*)(Y + (size_t)(tb * 64 + r) * 2048 + cb * 64 + c8) = w;
    __syncthreads();
}

__device__ void p6_on(KA a) {
    const bf16_t* OF = (const bf16_t*)(a->ws + WS_RA); const bf16_t* OB = OF + (size_t)MT * 2048;
    const bf16_t* ZG = (const bf16_t*)(a->ws + WS_RB); bf16_t* ON = (bf16_t*)(a->ws + WS_HA);
    const float* nw = a->in[10];
    const size_t nthr = (size_t)gridDim.x * NT;
    for (size_t i = (size_t)blockIdx.x * NT + tid_opaque(); i < (size_t)MT * 256; i += nthr) {
        const int row = (int)(i >> 8), c8 = (int)(i & 255) * 8;
        float f[8], g[8], z[8];
        unpack8(*(const u32x4*)(OF + (size_t)row * 2048 + c8), f); unpack8(*(const u32x4*)(OB + (size_t)row * 2048 + c8), g);
        unpack8(*(const u32x4*)(ZG + (size_t)row * NZG + c8), z);
        float ss = 0.f;
#pragma unroll
        for (int e = 0; e < 8; ++e) { f[e] += g[e]; ss += f[e] * f[e]; }
        ss += __shfl_xor(ss, 1, 64); ss += __shfl_xor(ss, 2, 64); ss += __shfl_xor(ss, 4, 64); ss += __shfl_xor(ss, 8, 64);
        const float rs = rsqrtf(ss * (1.0f / 128.0f) + 1e-6f);
        float o[8];
#pragma unroll
        for (int e = 0; e < 8; ++e) o[e] = f[e] * rs * nw[(c8 & 127) + e] * siluf_(z[e]);
        *(u32x4*)(ON + (size_t)row * 2048 + c8) = pack8(o);
    }
}

constexpr size_t PEER_U8 = 0, PEER_V4 = 32 * MiB, PEER_VG = 48 * MiB, PEER_US = 64 * MiB, PEER_VS = 64 * MiB + 65536;
__device__ void p8_tables(KA a) {
    unsigned char* RAb = a->ws + WS_RA;
    const int lane = tid_opaque() & 63, wv = blockIdx.x * 8 + (tid_opaque() >> 6), nwv = gridDim.x * 8;
    for (int r = wv; r < 32768; r += nwv) {
        const int tab = r >> 14, row = r & 16383;
        const float* sp = (tab ? a->in[28] : a->in[27]) + (size_t)row * 2048;
        f32x4 x[8];
#pragma unroll
        for (int i = 0; i < 2; ++i)
#pragma unroll
            for (int j = 0; j < 4; ++j) x[i * 4 + j] = *(const f32x4*)(sp + i * 1024 + lane * 16 + j * 4);
        float gmx[2];
#pragma unroll
        for (int i = 0; i < 2; ++i) { float m = 0.f;
#pragma unroll
            for (int j = 0; j < 4; ++j) m = fmaxf(m, fmaxf(fmaxf(fabsf(x[i * 4 + j][0]), fabsf(x[i * 4 + j][1])), fmaxf(fabsf(x[i * 4 + j][2]), fabsf(x[i * 4 + j][3]))));
            gmx[i] = m; }
        const float mx = wave_max(fmaxf(gmx[0], gmx[1]));
        if (tab == 0) {
            const float sc = (mx > 0.f) ? mx * (1.0f / 127.0f) : 1.0f, inv = 1.0f / sc;
            unsigned char* dp = RAb + PEER_U8 + (size_t)row * 2048;
#pragma unroll
            for (int i = 0; i < 2; ++i) {
                u32x4 w;
#pragma unroll
                for (int j = 0; j < 4; ++j) {
                    const f32x4 v = x[i * 4 + j];
                    const unsigned b0 = (unsigned)__float2int_rn(v[0] * inv), b1 = (unsigned)__float2int_rn(v[1] * inv), b2 = (unsigned)__float2int_rn(v[2] * inv), b3 = (unsigned)__float2int_rn(v[3] * inv);
                    w[j] = (b0 & 255u) | ((b1 & 255u) << 8) | ((b2 & 255u) << 16) | ((b3 & 255u) << 24);
                }
                *(u32x4*)(dp + i * 1024 + lane * 16) = w;
            }
            if (lane == 0) ((float*)(RAb + PEER_US))[row] = sc;
        } else {
            const float rmx = (mx > 0.f) ? mx : 1.0f;
#pragma unroll
            for (int i = 0; i < 2; ++i) {
                int m = (int)ceilf(gmx[i] * (255.0f / rmx)); m = m < 1 ? 1 : (m > 255 ? 255 : m);
                const float inv = (7.0f * 255.0f) / (rmx * (float)m);
                unsigned q[16];
#pragma unroll
                for (int j = 0; j < 4; ++j)
#pragma unroll
                    for (int e = 0; e < 4; ++e) { int c = __float2int_rn(x[i * 4 + j][e] * inv); c = c < -7 ? -7 : (c > 7 ? 7 : c); q[j * 4 + e] = (unsigned)(c + 8); }
                u32x2 w;
                w.x = (q[0] | (q[4] << 4)) | ((q[1] | (q[5] << 4)) << 8) | ((q[2] | (q[6] << 4)) << 16) | ((q[3] | (q[7] << 4)) << 24);
                w.y = (q[8] | (q[12] << 4)) | ((q[9] | (q[13] << 4)) << 8) | ((q[10] | (q[14] << 4)) << 16) | ((q[11] | (q[15] << 4)) << 24);
                *(u32x2*)(RAb + PEER_V4 + (size_t)row * 1024 + i * 512 + lane * 8) = w;
                (RAb + PEER_VG)[(size_t)row * 128 + lane * 2 + i] = (unsigned char)m;
            }
            if (lane == 0) ((float*)(RAb + PEER_VS))[row] = rmx * (1.0f / (7.0f * 255.0f));
        }
    }
}

__device__ void p9_ln1(KA a) {
    const float* mod = (const float*)(a->ws + WS_MOD); bf16_t* H2 = (bf16_t*)(a->ws + WS_RA) + (size_t)2 * MT * 2048;
    const float* g = a->in[23]; const float* bb = a->in[24];
    const int lane = tid_opaque() & 63, wv = blockIdx.x * 8 + (tid_opaque() >> 6), nwv = gridDim.x * 8;
    for (int row = wv; row < MT; row += nwv) {
        float* rp = a->out + (size_t)row * 2048;
        float v[32]; float s = 0.f;
#pragma unroll
        for (int i = 0; i < 4; ++i) { const f32x4 x0 = *(const f32x4*)(rp + i * 512 + lane * 8), x1 = *(const f32x4*)(rp + i * 512 + lane * 8 + 4);
#pragma unroll
            for (int e = 0; e < 4; ++e) { v[i * 8 + e] = x0[e]; v[i * 8 + 4 + e] = x1[e]; s += x0[e] + x1[e]; } }
        const float mu = wave_sum(s) * (1.0f / 2048.0f);
        float q = 0.f;
#pragma unroll
        for (int e = 0; e < 32; ++e) { const float d = v[e] - mu; q += d * d; }
        const float rstd = rsqrtf(wave_sum(q) * (1.0f / 2048.0f) + 1e-5f);
        const float* mp = mod + (row >> 12) * 12288;
#pragma unroll
        for (int i = 0; i < 4; ++i) {
            const int col = i * 512 + lane * 8;
            float xn[8], h[8];
#pragma unroll
            for (int e = 0; e < 8; ++e) { xn[e] = (v[i * 8 + e] - mu) * rstd * g[col + e] + bb[col + e]; h[e] = xn[e] * (1.0f + mp[8192 + col + e]) + mp[6144 + col + e]; }
            *(f32x4*)(rp + col) = (f32x4){xn[0], xn[1], xn[2], xn[3]}; *(f32x4*)(rp + col + 4) = (f32x4){xn[4], xn[5], xn[6], xn[7]};
            *(u32x4*)(H2 + (size_t)row * 2048 + col) = pack8(h);
        }
    }
}

__device__ __forceinline__ float row_max16(float v) {
    v = fmaxf(v, __builtin_bit_cast(float, __builtin_amdgcn_update_dpp(0, __builtin_bit_cast(int, v), 0x128, 0xf, 0xf, false)));
    v = fmaxf(v, __builtin_bit_cast(float, __builtin_amdgcn_update_dpp(0, __builtin_bit_cast(int, v), 0x124, 0xf, 0xf, false)));
    v = fmaxf(v, __builtin_bit_cast(float, __builtin_amdgcn_update_dpp(0, __builtin_bit_cast(int, v), 0x122, 0xf, 0xf, false)));
    v = fmaxf(v, __builtin_bit_cast(float, __builtin_amdgcn_update_dpp(0, __builtin_bit_cast(int, v), 0x121, 0xf, 0xf, false)));
    return v;
}
__device__ __forceinline__ float row_sum16(float v) {
    v += __builtin_bit_cast(float, __builtin_amdgcn_update_dpp(0, __builtin_bit_cast(int, v), 0x128, 0xf, 0xf, false));
    v += __builtin_bit_cast(float, __builtin_amdgcn_update_dpp(0, __builtin_bit_cast(int, v), 0x124, 0xf, 0xf, false));
    v += __builtin_bit_cast(float, __builtin_amdgcn_update_dpp(0, __builtin_bit_cast(int, v), 0x122, 0xf, 0xf, false));
    v += __builtin_bit_cast(float, __builtin_amdgcn_update_dpp(0, __builtin_bit_cast(int, v), 0x121, 0xf, 0xf, false));
    return v;
}
__device__ __forceinline__ int row_sum16i(int v) {
    v += __builtin_amdgcn_update_dpp(0, v, 0x128, 0xf, 0xf, false);
    v += __builtin_amdgcn_update_dpp(0, v, 0x124, 0xf, 0xf, false);
    v += __builtin_amdgcn_update_dpp(0, v, 0x122, 0xf, 0xf, false);
    v += __builtin_amdgcn_update_dpp(0, v, 0x121, 0xf, 0xf, false);
    return v;
}
template <int NCH, int NV> __device__ __forceinline__ void topk16_row16(float (&x)[NCH][NV], int s, int g, float (&rs)[NCH], int (&ri)[NCH]) {
#pragma unroll
    for (int c = 0; c < NCH; ++c) { rs[c] = -INFINITY; ri[c] = 0; }
#pragma unroll 1
    for (int it = 0; it < 16; ++it) {
#pragma unroll
        for (int c = 0; c < NCH; ++c) {
            float m = x[c][0];
#pragma unroll
            for (int j = 1; j < NV; ++j) m = fmaxf(m, x[c][j]);
            const float wm = row_max16(m);
            const unsigned long long bal = __ballot(m == wm);
            const unsigned seg = (unsigned)(bal >> (16 * g)) & 0xffffu;
            const bool iswin = (s == (__ffs((int)seg) - 1));
            int jsel = 0;
#pragma unroll
            for (int j = NV - 1; j >= 0; --j) { const bool e = (x[c][j] == wm); jsel = e ? j : jsel; x[c][j] = (e && iswin) ? -INFINITY : x[c][j]; }
            const int key = row_sum16i(iswin ? (s * NV + jsel) : 0);
            if (s == it) { rs[c] = wm; ri[c] = key; }
        }
    }
}
__device__ void peer_unit(KA a, int unit, unsigned char* lds) {
    const int tid = tid_opaque(), lane = tid & 63, wid = tid >> 6, fr = lane & 15, fq = lane >> 4;
    float* SC = (float*)lds;
    int* IGI = (int*)(lds + 32768); float* IGG = (float*)(lds + 49152);
    float* TL = (float*)(lds + 65536); int* TI = (int*)(lds + 69632);
    const int tok0 = unit * 32;
    const float* Qp = (const float*)(a->ws + WS_RB); const float* subk = a->in[26];
    const bf16_t* H2 = (const bf16_t*)(a->ws + WS_RA) + (size_t)2 * MT * 2048;
    const float* mod = (const float*)(a->ws + WS_MOD);
    int sti[4], stj[4];
#pragma unroll
    for (int q = 0; q < 4; ++q) {
        const int t = fr * 4 + q; int acc = 0, ii = -1, jj = 0;
#pragma unroll
        for (int i = 0; i < 16; ++i) { const int cnt = 16 / (i + 1); if (ii < 0 && t < acc + cnt) { ii = i; jj = t - acc; } acc += cnt; }
        sti[q] = ii; stj[q] = jj;
    }
#pragma unroll 1
    for (int hh = 0; hh < 8 * a->reps[2]; ++hh) { const int h = hh & 7;
#pragma unroll 1
        for (int p = 0; p < 2; ++p) {
            f32x4 bq[8], aq[2][8];
            const float* bp = subk + (size_t)((h * 2 + p) * 128 + wid * 16 + fr) * 128 + fq * 32;
#pragma unroll
            for (int j = 0; j < 8; ++j) bq[j] = *(const f32x4*)(bp + j * 4);
#pragma unroll
            for (int mt = 0; mt < 2; ++mt) { const float* ap = Qp + (size_t)(tok0 + mt * 16 + fr) * 2048 + h * 256 + p * 128 + fq * 32;
#pragma unroll
                for (int j = 0; j < 8; ++j) aq[mt][j] = *(const f32x4*)(ap + j * 4); }
            f32x4 acc[2] = {(f32x4){0.f, 0.f, 0.f, 0.f}, (f32x4){0.f, 0.f, 0.f, 0.f}};
#pragma unroll
            for (int j = 0; j < 8; ++j)
#pragma unroll
                for (int e = 0; e < 4; ++e) {
                    acc[0] = __builtin_amdgcn_mfma_f32_16x16x4f32(aq[0][j][e], bq[j][e], acc[0], 0, 0, 0);
                    acc[1] = __builtin_amdgcn_mfma_f32_16x16x4f32(aq[1][j][e], bq[j][e], acc[1], 0, 0, 0);
                }
#pragma unroll
            for (int mt = 0; mt < 2; ++mt)
#pragma unroll
                for (int r = 0; r < 4; ++r) SC[(p * 32 + mt * 16 + 4 * fq + r) * 128 + wid * 16 + fr] = acc[mt][r];
        }
        __syncthreads();
        {
            const int tk = wid * 4 + fq;
            float x[2][8]; float ts[2]; int tix[2];
#pragma unroll
            for (int p = 0; p < 2; ++p) { const f32x4 y0 = *(const f32x4*)(SC + (p * 32 + tk) * 128 + fr * 8), y1 = *(const f32x4*)(SC + (p * 32 + tk) * 128 + fr * 8 + 4);
                x[p][0] = y0.x; x[p][1] = y0.y; x[p][2] = y0.z; x[p][3] = y0.w; x[p][4] = y1.x; x[p][5] = y1.y; x[p][6] = y1.z; x[p][7] = y1.w; }
            topk16_row16<2, 8>(x, fr, fq, ts, tix);
            TL[(tk * 2 + 0) * 16 + fr] = ts[0]; TL[(tk * 2 + 1) * 16 + fr] = ts[1]; TI[(tk * 2 + 0) * 16 + fr] = tix[0]; TI[(tk * 2 + 1) * 16 + fr] = tix[1];
            asm volatile("s_waitcnt lgkmcnt(0)" ::: "memory");
            float cnd[1][4]; float bs[1]; int bc[1];
#pragma unroll
            for (int q = 0; q < 4; ++q) cnd[0][q] = (sti[q] >= 0) ? TL[(tk * 2 + 0) * 16 + (sti[q] & 15)] + TL[(tk * 2 + 1) * 16 + stj[q]] : -INFINITY;
            topk16_row16<1, 4>(cnd, fr, fq, bs, bc);
            const int src = (lane & 48) + (bc[0] >> 2), qq = bc[0] & 3;
            const int i0 = __shfl(sti[0], src, 64), i1 = __shfl(sti[1], src, 64), i2 = __shfl(sti[2], src, 64), i3 = __shfl(sti[3], src, 64);
            const int j0 = __shfl(stj[0], src, 64), j1 = __shfl(stj[1], src, 64), j2 = __shfl(stj[2], src, 64), j3 = __shfl(stj[3], src, 64);
            const int pi = (qq == 0) ? i0 : (qq == 1) ? i1 : (qq == 2) ? i2 : i3, pj = (qq == 0) ? j0 : (qq == 1) ? j1 : (qq == 2) ? j2 : j3;
            const int e0 = TI[(tk * 2 + 0) * 16 + (pi & 15)], e1 = TI[(tk * 2 + 1) * 16 + (pj & 15)];
            const float mx = row_max16(bs[0]);
            const float ex = expf(bs[0] - mx);
            const float sm = row_sum16(ex);
            IGI[tk * 128 + h * 16 + fr] = e0 * 128 + e1; IGG[tk * 128 + h * 16 + fr] = ex / sm;
        }
        __syncthreads();
    }
    __syncthreads();
    const unsigned char* U8 = a->ws + WS_RA + PEER_U8; const unsigned char* V4 = a->ws + WS_RA + PEER_V4; const unsigned short* VG = (const unsigned short*)(a->ws + WS_RA + PEER_VG);
    const float* US = (const float*)(a->ws + WS_RA + PEER_US); const float* VS = (const float*)(a->ws + WS_RA + PEER_VS);
#pragma unroll 1
    for (int rr = 0; rr < 4; ++rr) {
        const int row = wid * 4 + rr, tok = tok0 + row;
        float hx[32], yq[32]; float hs = 0.f;
#pragma unroll
        for (int i = 0; i < 2; ++i) {
            float t8[8];
            unpack8(*(const u32x4*)(H2 + (size_t)tok * 2048 + i * 1024 + lane * 16), t8);
#pragma unroll
            for (int e = 0; e < 8; ++e) { hx[i * 16 + e] = t8[e]; hs += t8[e]; }
            unpack8(*(const u32x4*)(H2 + (size_t)tok * 2048 + i * 1024 + lane * 16 + 8), t8);
#pragma unroll
            for (int e = 0; e < 8; ++e) { hx[i * 16 + 8 + e] = t8[e]; hs += t8[e]; }
        }
#pragma unroll
        for (int e = 0; e < 32; ++e) yq[e] = 0.f;
        float hmx = 0.f;
#pragma unroll
        for (int e = 0; e < 32; ++e) hmx = fmaxf(hmx, fabsf(hx[e]));
        hmx = wave_max(hmx);
        const float shq = (hmx > 0.f) ? hmx * (1.0f / 127.0f) : 1.0f, ihq = 1.0f / shq;
        int hq[8];
#pragma unroll
        for (int w4 = 0; w4 < 8; ++w4) {
            const unsigned b0 = (unsigned)__float2int_rn(hx[w4 * 4 + 0] * ihq) & 255u, b1 = (unsigned)__float2int_rn(hx[w4 * 4 + 1] * ihq) & 255u, b2 = (unsigned)__float2int_rn(hx[w4 * 4 + 2] * ihq) & 255u, b3 = (unsigned)__float2int_rn(hx[w4 * 4 + 3] * ihq) & 255u;
            hq[w4] = (int)(b0 | (b1 << 8) | (b2 << 16) | (b3 << 24));
        }
        (void)hs;
        float csum2[2] = {0.f, 0.f};
#if DBG_MODE != 2
        const int* ip = IGI + row * 128; const float* gp = IGG + row * 128;
        u32x4 nu[PD][2]; u32x2 nv[PD][2]; unsigned ng[PD]; float nsu[PD], nsv[PD];
#pragma unroll
        for (int k = 0; k < PD; ++k) {
            const int idx = __builtin_amdgcn_readfirstlane(ip[k]);
            const unsigned char* up = U8 + (size_t)idx * 2048 + lane * 16; const unsigned char* vp = V4 + (size_t)idx * 1024 + lane * 8;
            nu[k][0] = *(const u32x4*)up; nu[k][1] = *(const u32x4*)(up + 1024); nv[k][0] = *(const u32x2*)vp; nv[k][1] = *(const u32x2*)(vp + 512);
            ng[k] = VG[(size_t)idx * 64 + lane]; nsu[k] = US[idx]; nsv[k] = VS[idx];
        }
#pragma unroll 1
        for (int grep = 0; grep < a->pad2[0]; ++grep) {
        const float gmul = (grep == 0) ? 1.0f : 0.0f;
#pragma unroll 1
        for (int e = 0; e < 128; e += PD) {
            u32x4 cu[PD][2]; u32x2 cvv[PD][2]; unsigned cg[PD]; float csu[PD], csv[PD];
#pragma unroll
            for (int k = 0; k < PD; ++k) { cu[k][0] = nu[k][0]; cu[k][1] = nu[k][1]; cvv[k][0] = nv[k][0]; cvv[k][1] = nv[k][1]; cg[k] = ng[k]; csu[k] = nsu[k]; csv[k] = nsv[k]; }
            if (e + PD < 128) {
#pragma unroll
                for (int k = 0; k < PD; ++k) {
                    const int idx = __builtin_amdgcn_readfirstlane(ip[e + PD + k]);
                    const unsigned char* up = U8 + (size_t)idx * 2048 + lane * 16; const unsigned char* vp = V4 + (size_t)idx * 1024 + lane * 8;
                    nu[k][0] = *(const u32x4*)up; nu[k][1] = *(const u32x4*)(up + 1024); nv[k][0] = *(const u32x2*)vp; nv[k][1] = *(const u32x2*)(vp + 512);
                    ng[k] = VG[(size_t)idx * 64 + lane]; nsu[k] = US[idx]; nsv[k] = VS[idx];
                }
            }
#pragma unroll
            for (int k = 0; k < PD; ++k) {
                int iacc = 0;
#pragma unroll
                for (int i = 0; i < 2; ++i)
#pragma unroll
                    for (int j = 0; j < 4; ++j) iacc = __builtin_amdgcn_sdot4((int)cu[k][i][j], hq[i * 4 + j], iacc, false);
                const float dot = csu[k] * shq * wave_sum((float)iacc);
                const float c1 = gmul * gp[e + k] * 0.5f * dot * (1.0f + erff(dot * 0.7071067811865476f)) * csv[k];
#pragma unroll
                for (int i = 0; i < 2; ++i) {
                    const float ci = c1 * (float)((cg[k] >> (8 * i)) & 255u);
                    csum2[i] += ci;
#pragma unroll
                    for (int j = 0; j < 2; ++j) { const unsigned wd = cvv[k][i][j]; const unsigned lo = wd & 0x0f0f0f0fu, hi = (wd >> 4) & 0x0f0f0f0fu; float* yp = yq + i * 16 + j * 8;
                        yp[0] += ci * (float)(lo & 255u); yp[1] += ci * (float)((lo >> 8) & 255u); yp[2] += ci * (float)((lo >> 16) & 255u); yp[3] += ci * (float)(lo >> 24);
                        yp[4] += ci * (float)(hi & 255u); yp[5] += ci * (float)((hi >> 8) & 255u); yp[6] += ci * (float)((hi >> 16) & 255u); yp[7] += ci * (float)(hi >> 24); }
                }
            }
        }
        }
#endif
        float* rp = a->out + (size_t)tok * 2048; const float* mp = mod + (tok >> 12) * 12288 + 10240;
        float val[32]; float s = 0.f;
#pragma unroll
        for (int i = 0; i < 2; ++i)
#pragma unroll
            for (int j = 0; j < 4; ++j) { const int col = i * 1024 + lane * 16 + j * 4; const f32x4 x0 = *(const f32x4*)(rp + col), g0 = *(const f32x4*)(mp + col);
#pragma unroll
                for (int e = 0; e < 4; ++e) { const float v = ALPHA * x0[e] + g0[e] * (yq[i * 16 + j * 4 + e] - 8.0f * csum2[i]); val[i * 16 + j * 4 + e] = v; s += v; } }
        const float mu = wave_sum(s) * (1.0f / 2048.0f);
        float q = 0.f;
#pragma unroll
        for (int e = 0; e < 32; ++e) { const float d = val[e] - mu; q += d * d; }
        const float rstd = rsqrtf(wave_sum(q) * (1.0f / 2048.0f) + 1e-5f);
        const float* g = a->in[29]; const float* bb = a->in[30];
#pragma unroll
        for (int i = 0; i < 2; ++i)
#pragma unroll
            for (int j = 0; j < 4; ++j) { const int col = i * 1024 + lane * 16 + j * 4; const f32x4 gg = *(const f32x4*)(g + col), bv = *(const f32x4*)(bb + col); f32x4 o;
#pragma unroll
                for (int e = 0; e < 4; ++e) o[e] = (val[i * 16 + j * 4 + e] - mu) * rstd * gg[e] + bv[e];
                *(f32x4*)(rp + col) = o; }
    }
    __syncthreads();
}

constexpr size_t WS_BAR = 699 * MiB;

__device__ __forceinline__ void grid_bar(unsigned* ctr, unsigned target) {
    asm volatile("s_waitcnt vmcnt(0)" ::: "memory");
    __syncthreads();
    if (tid_opaque() == 0) {
        __builtin_amdgcn_fence(__ATOMIC_RELEASE, "agent");
        asm volatile("s_waitcnt vmcnt(0)" ::: "memory");
        __hip_atomic_fetch_add(ctr, 1u, __ATOMIC_RELAXED, __HIP_MEMORY_SCOPE_AGENT);
        while (__hip_atomic_load(ctr, __ATOMIC_RELAXED, __HIP_MEMORY_SCOPE_AGENT) < target) __builtin_amdgcn_s_sleep(2);
        __builtin_amdgcn_fence(__ATOMIC_ACQUIRE, "agent");
        asm volatile("s_waitcnt vmcnt(0)" ::: "memory");
    }
    __syncthreads();
}

__global__ void __launch_bounds__(NT, 2) fwd_mega(Args a_) {
    KA a = (KA)__builtin_amdgcn_kernarg_segment_ptr();
    unsigned char* lds = g_lds;
    tid_table_init();
    cg::grid_group grid = cg::this_grid();
    float* lf = (float*)lds;
    const int lo = a->ph_lo, hi = a->ph_hi;
#define IN(k) (lo <= (k) && (k) < hi)
    unsigned* barctr = (unsigned*)(a->ws + WS_BAR); unsigned nbar = 0;
    if (blockIdx.x == 0 && tid_opaque() == 0) __hip_atomic_store(barctr, 0u, __ATOMIC_RELAXED, __HIP_MEMORY_SCOPE_AGENT);
#define GBAR() do { ++nbar; grid_bar(barctr, nbar * gridDim.x); } while (0)
#define SEAM(k) do { if (IN(k) && IN((k) + 1)) { if ((k) == 0) grid.sync(); else GBAR(); } asm volatile("" : "+s"(a)); } while (0)
    unsigned char* ws = a->ws;
    bf16_t* HA = (bf16_t*)(ws + WS_HA); bf16_t* WT = (bf16_t*)(ws + WS_WT); bf16_t* SW = (bf16_t*)(ws + WS_SW);
    bf16_t* RA = (bf16_t*)(ws + WS_RA); bf16_t* RB = (bf16_t*)(ws + WS_RB);
    const float* mod = (const float*)(ws + WS_MOD);

    if (IN(0)) {
#pragma unroll 1
        for (int rep = 0; rep < a->reps[0]; ++rep) { p0_mod_hid2(a, lf); p0_transposes(a, lf); }
    }
    SEAM(0);
    if (IN(1)) {
#pragma unroll 1
        for (int rep = 0; rep < a->reps[0]; ++rep) { p1_ha(a); for (int u = blockIdx.x; u < 256; u += gridDim.x) filt_unit(a, u, lds); }
    }
    SEAM(1);
    if (IN(2)) {
#pragma unroll 1
        for (int rep = 0; rep < a->reps[1]; ++rep) {
        run_gemm(lds, WT, HA, NHY, MT, FStoreBf16{RA, MT, 1.0f});
        run_gemm8(lds, ws + WS_HA8, (const unsigned char*)WT + WT8_OFF, MA, NQKVP, FStoreQKV{RB, (float*)(ws + WS_AB), 1.0f / 64.0f});
        }
    }
    SEAM(2);
    if (IN(3)) {
        hyena_setup(lds);
#pragma unroll 1
        for (int rep = 0; rep < a->reps[3]; ++rep)
        for (int c = blockIdx.x; c < 2048; c += gridDim.x) hyena_item(a, c, lds);
        qkvpost_latent(a, lds);
        for (int u = 12288 + blockIdx.x; u < 12288 + 192; u += gridDim.x) qkvpost_unit(a, u, lds);
    }
    SEAM(3);
    if (IN(4)) {
#pragma unroll 1
        for (int rep = 0; rep < a->reps[4]; ++rep)
        { const int wv = tid_opaque() >> 6; for (int pid = blockIdx.x * 8 + wv; pid < 8704; pid += gridDim.x * 8) tprep_wave(a, pid, lds + wv * 18944); }
        GBAR();
#pragma unroll 1
        for (int rep = 0; rep < a->reps[5]; ++rep)
        for (int it = blockIdx.x; it < 256; it += gridDim.x) delta_item(a, it, lds);
    }
    SEAM(4);
    if (IN(5)) {
        run_gemm8(lds, ws + WS_HA8, (const unsigned char*)WT + WT8_OFF + (size_t)NQKVP * 2048, MT, NZG, FStoreBf16{RB, NZG, 1.0f / 64.0f});
#pragma unroll 1
        for (int rep = 0; rep < a->reps[6]; ++rep)
        for (int u = blockIdx.x; u < 8192; u += gridDim.x) ytrans_unit((const bf16_t*)a->out, RA + (size_t)2 * MT * 2048, u, (bf16_t*)lds);
    }
    SEAM(5);
    if (IN(6)) {
#pragma unroll 1
        for (int rep = 0; rep < a->reps[6]; ++rep) p6_on(a); }
    SEAM(6);
    if (IN(7)) {
        run_gemm(lds, HA  , SW, MT, D, FGatePA{RB, WT  });
        run_gemm(lds, RA + (size_t)2 * MT * 2048  , SW + (size_t)1 * D * D, MT, D, FGatePH{RB, WT  });
    }
    SEAM(7);
    if (IN(8)) {
        run_gemm(lds, WT  , SW + (size_t)2 * D * D, MT, D, FOut{a->in[0], mod, a->out});
#pragma unroll 1
        for (int rep = 0; rep < a->reps[7]; ++rep) p8_tables(a);
    }
    SEAM(8);
    if (IN(9)) { p9_ln1(a); }
    SEAM(9);
    if (IN(10)) { run_gemm(lds, RA + (size_t)2 * MT * 2048  , SW + (size_t)3 * D * D, MT, D, FStoreF32{(float*)(ws + WS_RB), D}); }
    SEAM(10);
    if (IN(11)) { for (int u = blockIdx.x; u < MT / 32; u += gridDim.x) peer_unit(a, u, lds); }
#undef IN
#undef SEAM
}

extern "C" void kernel_launch(void* const* d_in, const int* in_sizes, int n_in, void* d_out, int out_size, void* d_ws, size_t ws_size, hipStream_t stream) {
    static int grid = 0;
    if (grid == 0) {
        if (n_in != 31 || out_size != MT * D || ws_size < WS_BAR + 4096) { fprintf(stderr, "kernel_launch: unexpected problem shape / workspace (%d inputs, out %d, ws %zu)\n", n_in, out_size, ws_size); grid = -1; return; }
        int dev = 0, cus = 0, per_cu = 0;
        (void)hipGetDevice(&dev);
        (void)hipDeviceGetAttribute(&cus, hipDeviceAttributeMultiprocessorCount, dev);
        (void)hipFuncSetAttribute((const void*)fwd_mega, hipFuncAttributeMaxDynamicSharedMemorySize, LDS_BYTES);
        (void)hipOccupancyMaxActiveBlocksPerMultiprocessor(&per_cu, (const void*)fwd_mega, NT, LDS_BYTES);
        if (per_cu < 1) per_cu = 1;
        grid = cus * per_cu;
        (void)hipGetLastError();
    }
    if (grid < 0) return;
    Args a{};
    for (int i = 0; i < 31; ++i) a.in[i] = (const float*)d_in[i];
    a.out = (float*)d_out; a.ws = (unsigned char*)d_ws; a.ph_lo = 0; a.ph_hi = 12; a.reps[0] = REP0; a.reps[1] = REP1; a.reps[2] = REP2; a.reps[3] = REP3; a.reps[4] = REP4; a.reps[5] = REP5; a.reps[6] = REP6; a.reps[7] = REP7; a.pad2[0] = REPG;
    void* args[] = {&a};
    hipError_t e = hipLaunchCooperativeKernel((const void*)fwd_mega, dim3(grid), dim3(NT), args, LDS_BYTES, stream);
    if (e != hipSuccess) fprintf(stderr, "cooperative launch failed: %s (grid %d)\n", hipGetErrorString(e), grid);
}
```

```cpp
#include <hip/hip_runtime.h>
#include <hip/hip_cooperative_groups.h>
#include <cstdio>
#include <cstdint>
namespace cg = cooperative_groups;

#ifndef DBG_MODE
#define DBG_MODE 0
#endif
#define PA 4
#define PB 8
#define REP0 1
#define REP1 1
#define REP2 1
#define REP3 1
#define REP4 1
#define REP5 1
#define REP6 1
#define REP7 1
#define REPG 1

extern __shared__ __attribute__((aligned(16))) unsigned char g_lds[];
constexpr int TIDTAB_OFF = 160 * 1024 - 256;
__device__ __forceinline__ int tid_opaque() {
    const int slot = __builtin_amdgcn_s_getreg(0x2804) & 63;
    int wv = __builtin_amdgcn_readfirstlane(((const int*)(g_lds + TIDTAB_OFF))[slot]);
    int t = wv * 64 + (int)__builtin_amdgcn_mbcnt_hi(~0u, __builtin_amdgcn_mbcnt_lo(~0u, 0u));
    asm volatile("" : "+v"(t));
    return t;
}
__device__ __forceinline__ void tid_table_init() {
    const int t = threadIdx.x;
    if ((t & 63) == 0) ((int*)(g_lds + TIDTAB_OFF))[__builtin_amdgcn_s_getreg(0x2804) & 63] = t >> 6;
    __syncthreads();
}

namespace pg8 {
#define PG8_LAS __attribute__((address_space(3)))
typedef unsigned short bf16_t;
typedef short bf16x8 __attribute__((ext_vector_type(8)));
typedef float f32x4 __attribute__((ext_vector_type(4)));
typedef unsigned u32x4 __attribute__((ext_vector_type(4)));
constexpr int BM = 256, BK = 64, HALF = 128, HTB = HALF * BK * 2, STAGE_BYTES = 8 * HTB, NXCD = 8, WGM = 8;

__host__ __device__ __forceinline__ int lds_byte(int r, int c) { const int st = (r >> 4) * 2 + (c >> 5), rr = r & 15, cc = c & 31, ob = rr * 64 + cc * 2; return st * 1024 + (ob ^ (((ob >> 9) & 1) << 5)); }
__host__ __device__ __forceinline__ void stage_rc(int b, int& R, int& C) { const int st = b / 1024, sb = b % 1024, swz = sb ^ (((sb >> 9) & 1) << 5); R = (st >> 1) * 16 + swz / 64; C = (st & 1) * 32 + (swz % 64) / 2; }
__host__ __device__ __forceinline__ int perm32(int rho) { const int n = rho >> 4, i = rho & 15; return 8 * (i >> 2) + 4 * n + (i & 3); }

struct Unit { int pm, pn; };
struct Gemm { const bf16_t* A; const bf16_t* Bt; int M, N, K; };

struct StaticOrder {
    int nM, nN, nwg, G, c;
    __host__ __device__ void init(int M, int N, int G_, int c_) { nM = M / BM; nN = N / BM; nwg = nM * nN; G = G_; c = c_; }
    __host__ __device__ bool next(int i, Unit& u) const {
        const long L = (long)i * G + c; if (L >= nwg) return false;
        int wgid = (int)L; { const int q = nwg / NXCD, r = nwg % NXCD, xcd = wgid % NXCD, off = wgid / NXCD; wgid = (xcd < r ? xcd * (q + 1) : r * (q + 1) + (xcd - r) * q) + off; }
        const int nig = WGM * nN, gid = wgid / nig, fm = gid * WGM, gsz = (nM - fm) < WGM ? (nM - fm) : WGM;
        u.pm = fm + ((wgid % nig) % gsz); u.pn = (wgid % nig) / gsz; return true;
    }
    __device__ __forceinline__ void a_ready(const Unit&) const {}
    __device__ __forceinline__ void done(const Unit&) const {}
};

__device__ __forceinline__ unsigned cvt_pk_bf16(float lo, float hi) { unsigned r; asm volatile("v_cvt_pk_bf16_f32 %0, %1, %2" : "=v"(r) : "v"(lo), "v"(hi)); return r; }

template <class F> struct EpiGen {
    static constexpr bool PERM = true, AFTER_DRAIN = false;
    F f;
    __device__ __forceinline__ void operator()(const f32x4 (&acc)[2][2][4][2], const Unit& u, int wr, int wc, int, int) const {
        int ln = (int)__builtin_amdgcn_mbcnt_hi(~0u, __builtin_amdgcn_mbcnt_lo(~0u, 0u)); asm volatile("" : "+v"(ln));
        const int fr = ln & 15, fq = ln >> 4;
        const int row0 = u.pm * BM + wr * 64 + fr, col0 = u.pn * BM + wc * 32 + 8 * fq;
#pragma unroll
        for (int ai = 0; ai < 2; ++ai)
#pragma unroll
            for (int m = 0; m < 4; ++m)
#pragma unroll
                for (int bj = 0; bj < 2; ++bj) f(row0 + ai * HALF + m * 16, col0 + bj * HALF, acc[ai][bj][m][0], acc[ai][bj][m][1]);
    }
};

template <class Epi, class Sched, bool ALIGN_EPI = false, bool SP2 = false>
__device__ __forceinline__ void gemm_phase(PG8_LAS unsigned char* lds, const Gemm g, const Sched& S, const Epi& E) {
    const int tid = tid_opaque(), wid = __builtin_amdgcn_readfirstlane(tid >> 6), lane = tid & 63, wr = wid >> 2, wc = wid & 3, fr = lane & 15, fq = lane >> 4;
    const int K = g.K, nt = K / BK;
    unsigned voffA[2], voffB[2];
#pragma unroll
    for (int i = 0; i < 2; ++i) { int R, C; stage_rc(tid * 16 + i * 8192, R, C); const int Rb = Epi::PERM ? ((R & ~31) + perm32(R & 31)) : R;
        voffA[i] = (unsigned)(R * K + C) * 2u; voffB[i] = (unsigned)(Rb * K + C) * 2u; }
    const size_t kstep = (size_t)(BK * 2);
    const size_t hstep = (size_t)HALF * K * 2;
    const size_t tstep = 2 * hstep;
    const unsigned ldsw = (unsigned)wid * 1024u;
    const int aoff = lds_byte(wr * 64 + fr, fq * 8), boff = lds_byte(wc * 32 + fr, fq * 8);
#define PG8_SA(b, h) (((b) * 2 + (h)) * HTB)
#define PG8_SB(b, h) ((4 + (b) * 2 + (h)) * HTB)
#define PG8_STAGE(bufoff, gbase, voff) do { _Pragma("unroll") for (int _i = 0; _i < 2; ++_i) \
        __builtin_amdgcn_global_load_lds((const unsigned*)((const char*)(gbase) + (voff)[_i]), (PG8_LAS unsigned*)(lds + (bufoff) + ldsw + _i * 8192), 16, 0, 0); } while (0)
#define PG8_LDA(dst, b, h) do { _Pragma("unroll") for (int m = 0; m < 4; ++m) _Pragma("unroll") for (int k = 0; k < 2; ++k) dst[m][k] = *(const PG8_LAS bf16x8*)(lds + PG8_SA(b, h) + aoff + m * 2048 + k * 1024); } while (0)
#define PG8_LDB(dst, b, h) do { _Pragma("unroll") for (int n = 0; n < 2; ++n) _Pragma("unroll") for (int k = 0; k < 2; ++k) dst[n][k] = *(const PG8_LAS bf16x8*)(lds + PG8_SB(b, h) + boff + n * 2048 + k * 1024); } while (0)
#define PG8_MMA(ai, bj, At, Bt) do { __builtin_amdgcn_s_setprio(1); _Pragma("unroll") for (int m = 0; m < 4; ++m) _Pragma("unroll") for (int n = 0; n < 2; ++n) _Pragma("unroll") for (int k = 0; k < 2; ++k) \
        acc[ai][bj][m][n] = __builtin_amdgcn_mfma_f32_16x16x32_bf16(Bt[n][k], At[m][k], acc[ai][bj][m][n], 0, 0, 0); __builtin_amdgcn_s_setprio(0); } while (0)
#define PG8_WAIT_V(n) asm volatile("s_waitcnt vmcnt(" #n ")" ::: "memory")
#define PG8_WAIT_L(n) asm volatile("s_waitcnt lgkmcnt(" #n ")" ::: "memory")
#define PG8_BAR __builtin_amdgcn_s_barrier()
#define PG8_SCHED __builtin_amdgcn_sched_barrier(0)
    Unit cur, nxt; int ui = 0;
    if (!S.next(0, cur)) return;
    f32x4 acc[2][2][4][2];
#pragma unroll
    for (int a = 0; a < 2; ++a)
#pragma unroll
        for (int b = 0; b < 2; ++b)
#pragma unroll
            for (int m = 0; m < 4; ++m)
#pragma unroll
                for (int n = 0; n < 2; ++n) acc[a][b][m][n] = (f32x4){0.f, 0.f, 0.f, 0.f};
    bf16x8 At[4][2], B0[2][2], B1[2][2];
    const char* cA = (const char*)g.A + (size_t)cur.pm * tstep; const char* cB = (const char*)g.Bt + (size_t)cur.pn * tstep;
    S.a_ready(cur);
    if constexpr (SP2) {
        PG8_STAGE(PG8_SB(0, 0), cB, voffB); PG8_STAGE(PG8_SB(0, 1), cB + hstep, voffB); PG8_STAGE(PG8_SA(0, 0), cA, voffA); PG8_STAGE(PG8_SA(0, 1), cA + hstep, voffA);
        if (wr == 1) PG8_BAR;
        PG8_WAIT_V(2); PG8_BAR;
        PG8_STAGE(PG8_SB(1, 0), cB + kstep, voffB); PG8_STAGE(PG8_SA(1, 0), cA + kstep, voffA); PG8_STAGE(PG8_SB(1, 1), cB + hstep + kstep, voffB);
        PG8_WAIT_V(6); PG8_BAR;
    } else {
        PG8_STAGE(PG8_SB(0, 0), cB, voffB); PG8_STAGE(PG8_SA(0, 0), cA, voffA); PG8_STAGE(PG8_SB(0, 1), cB + hstep, voffB); PG8_STAGE(PG8_SA(0, 1), cA + hstep, voffA);
        if (wr == 1) PG8_BAR;
        PG8_WAIT_V(4); PG8_BAR;
        PG8_STAGE(PG8_SB(1, 0), cB + kstep, voffB); PG8_STAGE(PG8_SA(1, 0), cA + kstep, voffA); PG8_STAGE(PG8_SB(1, 1), cB + hstep + kstep, voffB);
        PG8_WAIT_V(6); PG8_BAR;
    }
    for (;;) {
        const bool has_next = S.next(ui + 1, nxt);
        const char* nA = has_next ? (const char*)g.A + (size_t)nxt.pm * tstep : cA; const char* nB = has_next ? (const char*)g.Bt + (size_t)nxt.pn * tstep : cB;
        for (int t = 0; t < nt; t += 2) {
            const bool last = (t == nt - 2);
            const char* a1 = cA + (size_t)(t + 1) * kstep;
            const char* a2 = last ? nA : cA + (size_t)(t + 2) * kstep; const char* b2 = last ? nB : cB + (size_t)(t + 2) * kstep;
            const char* a3 = a2 + kstep; const char* b3 = b2 + kstep;
            if (last && has_next) S.a_ready(nxt);
            if constexpr (SP2) {
            PG8_LDB(B0, 0, 0); PG8_LDB(B1, 0, 1); PG8_SCHED; PG8_LDA(At, 0, 0); PG8_STAGE(PG8_SA(1, 1), a1 + hstep, voffA);
            PG8_WAIT_V(8); PG8_WAIT_L(0); PG8_BAR; PG8_MMA(0, 0, At, B0); PG8_MMA(0, 1, At, B1); PG8_BAR; PG8_SCHED;
            PG8_LDA(At, 0, 1); PG8_STAGE(PG8_SB(0, 0), b2, voffB); PG8_STAGE(PG8_SB(0, 1), b2 + hstep, voffB); PG8_STAGE(PG8_SA(0, 0), a2, voffA);
            PG8_WAIT_V(8); PG8_WAIT_L(0); PG8_BAR; PG8_MMA(1, 0, At, B0); PG8_MMA(1, 1, At, B1); PG8_BAR; PG8_SCHED;
            PG8_LDB(B0, 1, 0); PG8_LDB(B1, 1, 1); PG8_SCHED; PG8_LDA(At, 1, 0); PG8_STAGE(PG8_SA(0, 1), a2 + hstep, voffA);
            PG8_WAIT_V(8); PG8_WAIT_L(0); PG8_BAR; PG8_MMA(0, 0, At, B0); PG8_MMA(0, 1, At, B1); PG8_BAR; PG8_SCHED;
            PG8_LDA(At, 1, 1); PG8_STAGE(PG8_SB(1, 0), b3, voffB); PG8_STAGE(PG8_SB(1, 1), b3 + hstep, voffB); PG8_STAGE(PG8_SA(1, 0), a3, voffA);
            PG8_WAIT_V(8); PG8_WAIT_L(0); PG8_BAR; PG8_MMA(1, 0, At, B0); PG8_MMA(1, 1, At, B1); PG8_BAR; PG8_SCHED;
            } else {
            PG8_LDB(B0, 0, 0); PG8_SCHED; PG8_LDA(At, 0, 0); PG8_STAGE(PG8_SA(1, 1), a1 + hstep, voffA);
            PG8_WAIT_L(8); PG8_BAR; PG8_WAIT_L(0); PG8_MMA(0, 0, At, B0); PG8_BAR; PG8_SCHED;
            PG8_LDB(B1, 0, 1); PG8_STAGE(PG8_SB(0, 0), b2, voffB);
            PG8_BAR; PG8_WAIT_L(0); PG8_MMA(0, 1, At, B1); PG8_BAR;
            PG8_LDA(At, 0, 1); PG8_STAGE(PG8_SA(0, 0), a2, voffA);
            PG8_BAR; PG8_WAIT_L(0); PG8_MMA(1, 0, At, B0); PG8_BAR; PG8_SCHED;
            PG8_STAGE(PG8_SB(0, 1), b2 + hstep, voffB);
            PG8_WAIT_V(6); PG8_BAR; PG8_MMA(1, 1, At, B1); PG8_BAR;
            PG8_LDB(B0, 1, 0); PG8_SCHED; PG8_LDA(At, 1, 0); PG8_STAGE(PG8_SA(0, 1), a2 + hstep, voffA);
            PG8_WAIT_L(8); PG8_BAR; PG8_WAIT_L(0); PG8_MMA(0, 0, At, B0); PG8_BAR; PG8_SCHED;
            PG8_LDB(B1, 1, 1); PG8_STAGE(PG8_SB(1, 0), b3, voffB);
            PG8_BAR; PG8_WAIT_L(0); PG8_MMA(0, 1, At, B1); PG8_BAR;
            PG8_LDA(At, 1, 1); PG8_STAGE(PG8_SA(1, 0), a3, voffA);
            PG8_BAR; PG8_WAIT_L(0); PG8_MMA(1, 0, At, B0); PG8_BAR; PG8_SCHED;
            PG8_STAGE(PG8_SB(1, 1), b3 + hstep, voffB);
            PG8_WAIT_V(6); PG8_BAR; PG8_MMA(1, 1, At, B1); PG8_BAR;
            }
        }
        if constexpr (ALIGN_EPI) { if (wr == 0) PG8_BAR; }
        if constexpr (!Epi::AFTER_DRAIN) { E(acc, cur, wr, wc, fr, fq); S.done(cur); }
        if (!has_next) break;
#pragma unroll
        for (int a = 0; a < 2; ++a)
#pragma unroll
            for (int b = 0; b < 2; ++b)
#pragma unroll
                for (int m = 0; m < 4; ++m)
#pragma unroll
                    for (int n = 0; n < 2; ++n) acc[a][b][m][n] = (f32x4){0.f, 0.f, 0.f, 0.f};
        cur = nxt; cA = nA; cB = nB; ++ui;
        if constexpr (ALIGN_EPI) { if (wr == 1) PG8_BAR; }
    }
    PG8_WAIT_V(0);
    if constexpr (!ALIGN_EPI) { if (wr == 0) PG8_BAR; }
    PG8_BAR;
    if constexpr (Epi::AFTER_DRAIN) { E.fused(acc, cur, wr, wc, fr, fq, lds, wid, lane); S.done(cur); }
#undef PG8_SA
#undef PG8_SB
#undef PG8_STAGE
#undef PG8_LDA
#undef PG8_LDB
#undef PG8_MMA
#undef PG8_WAIT_V
#undef PG8_WAIT_L
#undef PG8_BAR
#undef PG8_SCHED
}
typedef int i32x4 __attribute__((ext_vector_type(4)));
typedef int i32x8 __attribute__((ext_vector_type(8)));
template <class Epi, class Sched, bool ALIGN_EPI = false, bool SP2 = false>
__device__ __forceinline__ void gemm_phase8(PG8_LAS unsigned char* lds, const Gemm g, const Sched& S, const Epi& E) {
    const int tid = tid_opaque(), wid = __builtin_amdgcn_readfirstlane(tid >> 6), lane = tid & 63, wr = wid >> 2, wc = wid & 3, fr = lane & 15, fq = lane >> 4;
    const int K = g.K, nt = K / BK;
    unsigned voffA[2], voffB[2];
#pragma unroll
    for (int i = 0; i < 2; ++i) { int R, C; stage_rc(tid * 16 + i * 8192, R, C); const int Rb = Epi::PERM ? ((R & ~31) + perm32(R & 31)) : R;
        voffA[i] = (unsigned)(R * K + C) * 2u; voffB[i] = (unsigned)(Rb * K + C) * 2u; }
    const size_t rstep64 = (size_t)64 * K * 2;
    const size_t kstep = (size_t)(BK * 2);
    const size_t hstep = (size_t)HALF * K * 2;
    const size_t tstep = 2 * hstep;
    const unsigned ldsw = (unsigned)wid * 1024u;
    const int aoff = lds_byte(wr * 64 + fr, fq * 8), boff = lds_byte(wc * 32 + fr, fq * 8);
#define PG8_SA(b, h) (((b) * 2 + (h)) * HTB)
#define PG8_SB(b, h) ((4 + (b) * 2 + (h)) * HTB)
#define PG8_STAGE(bufoff, gbase, voff) do { _Pragma("unroll") for (int _i = 0; _i < 2; ++_i) \
        __builtin_amdgcn_global_load_lds((const unsigned*)((const char*)(gbase) + (size_t)_i * rstep64 + (voff)[0]), (PG8_LAS unsigned*)(lds + (bufoff) + ldsw + _i * 8192), 16, 0, 0); } while (0)
#define PG8_LD32(p) __builtin_shufflevector(*(const PG8_LAS i32x4*)(p), *(const PG8_LAS i32x4*)((p) + 1024), 0, 1, 2, 3, 4, 5, 6, 7)
#define PG8_LDA(dst, b, h) do { _Pragma("unroll") for (int m = 0; m < 4; ++m) dst[m] = PG8_LD32(lds + PG8_SA(b, h) + aoff + m * 2048); } while (0)
#define PG8_LDB(dst, b, h) do { _Pragma("unroll") for (int n = 0; n < 2; ++n) dst[n] = PG8_LD32(lds + PG8_SB(b, h) + boff + n * 2048); } while (0)
#define PG8_MMA(ai, bj, At, Bt) do { __builtin_amdgcn_s_setprio(1); _Pragma("unroll") for (int m = 0; m < 4; ++m) _Pragma("unroll") for (int n = 0; n < 2; ++n) \
        acc[ai][bj][m][n] = __builtin_amdgcn_mfma_scale_f32_16x16x128_f8f6f4(Bt[n], At[m], acc[ai][bj][m][n], 0, 0, 0, 0, 0, 0);     __builtin_amdgcn_s_setprio(0); } while (0)
#define PG8_WAIT_V(n) asm volatile("s_waitcnt vmcnt(" #n ")" ::: "memory")
#define PG8_WAIT_L(n) asm volatile("s_waitcnt lgkmcnt(" #n ")" ::: "memory")
#define PG8_BAR __builtin_amdgcn_s_barrier()
#define PG8_SCHED __builtin_amdgcn_sched_barrier(0)
    Unit cur, nxt; int ui = 0;
    if (!S.next(0, cur)) return;
    f32x4 acc[2][2][4][2];
#pragma unroll
    for (int a = 0; a < 2; ++a)
#pragma unroll
        for (int b = 0; b < 2; ++b)
#pragma unroll
            for (int m = 0; m < 4; ++m)
#pragma unroll
                for (int n = 0; n < 2; ++n) acc[a][b][m][n] = (f32x4){0.f, 0.f, 0.f, 0.f};
    i32x8 At[4], B0[2], B1[2];
    const char* cA = (const char*)g.A + (size_t)cur.pm * tstep; const char* cB = (const char*)g.Bt + (size_t)cur.pn * tstep;
    S.a_ready(cur);
    if constexpr (SP2) {
        PG8_STAGE(PG8_SB(0, 0), cB, voffB); PG8_STAGE(PG8_SB(0, 1), cB + hstep, voffB); PG8_STAGE(PG8_SA(0, 0), cA, voffA); PG8_STAGE(PG8_SA(0, 1), cA + hstep, voffA);
        if (wr == 1) PG8_BAR;
        PG8_WAIT_V(2); PG8_BAR;
        PG8_STAGE(PG8_SB(1, 0), cB + kstep, voffB); PG8_STAGE(PG8_SA(1, 0), cA + kstep, voffA); PG8_STAGE(PG8_SB(1, 1), cB + hstep + kstep, voffB);
        PG8_WAIT_V(6); PG8_BAR;
    } else {
        PG8_STAGE(PG8_SB(0, 0), cB, voffB); PG8_STAGE(PG8_SA(0, 0), cA, voffA); PG8_STAGE(PG8_SB(0, 1), cB + hstep, voffB); PG8_STAGE(PG8_SA(0, 1), cA + hstep, voffA);
        if (wr == 1) PG8_BAR;
        PG8_WAIT_V(4); PG8_BAR;
        PG8_STAGE(PG8_SB(1, 0), cB + kstep, voffB); PG8_STAGE(PG8_SA(1, 0), cA + kstep, voffA); PG8_STAGE(PG8_SB(1, 1), cB + hstep + kstep, voffB);
        PG8_WAIT_V(6); PG8_BAR;
    }
    for (;;) {
        const bool has_next = S.next(ui + 1, nxt);
        const char* nA = has_next ? (const char*)g.A + (size_t)nxt.pm * tstep : cA; const char* nB = has_next ? (const char*)g.Bt + (size_t)nxt.pn * tstep : cB;
        for (int t = 0; t < nt; t += 2) {
            const bool last = (t == nt - 2);
            const char* a1 = cA + (size_t)(t + 1) * kstep;
            const char* a2 = last ? nA : cA + (size_t)(t + 2) * kstep; const char* b2 = last ? nB : cB + (size_t)(t + 2) * kstep;
            const char* a3 = a2 + kstep; const char* b3 = b2 + kstep;
            if (last && has_next) S.a_ready(nxt);
            if constexpr (SP2) {
            PG8_LDB(B0, 0, 0); PG8_LDB(B1, 0, 1); PG8_SCHED; PG8_LDA(At, 0, 0); PG8_STAGE(PG8_SA(1, 1), a1 + hstep, voffA);
            PG8_WAIT_V(8); PG8_WAIT_L(0); PG8_BAR; PG8_MMA(0, 0, At, B0); PG8_MMA(0, 1, At, B1); PG8_BAR; PG8_SCHED;
            PG8_LDA(At, 0, 1); PG8_STAGE(PG8_SB(0, 0), b2, voffB); PG8_STAGE(PG8_SB(0, 1), b2 + hstep, voffB); PG8_STAGE(PG8_SA(0, 0), a2, voffA);
            PG8_WAIT_V(8); PG8_WAIT_L(0); PG8_BAR; PG8_MMA(1, 0, At, B0); PG8_MMA(1, 1, At, B1); PG8_BAR; PG8_SCHED;
            PG8_LDB(B0, 1, 0); PG8_LDB(B1, 1, 1); PG8_SCHED; PG8_LDA(At, 1, 0); PG8_STAGE(PG8_SA(0, 1), a2 + hstep, voffA);
            PG8_WAIT_V(8); PG8_WAIT_L(0); PG8_BAR; PG8_MMA(0, 0, At, B0); PG8_MMA(0, 1, At, B1); PG8_BAR; PG8_SCHED;
            PG8_LDA(At, 1, 1); PG8_STAGE(PG8_SB(1, 0), b3, voffB); PG8_STAGE(PG8_SB(1, 1), b3 + hstep, voffB); PG8_STAGE(PG8_SA(1, 0), a3, voffA);
            PG8_WAIT_V(8); PG8_WAIT_L(0); PG8_BAR; PG8_MMA(1, 0, At, B0); PG8_MMA(1, 1, At, B1); PG8_BAR; PG8_SCHED;
            } else {
            PG8_LDB(B0, 0, 0); PG8_SCHED; PG8_LDA(At, 0, 0); PG8_STAGE(PG8_SA(1, 1), a1 + hstep, voffA);
            PG8_WAIT_L(8); PG8_BAR; PG8_WAIT_L(0); PG8_MMA(0, 0, At, B0); PG8_BAR; PG8_SCHED;
            PG8_LDB(B1, 0, 1); PG8_STAGE(PG8_SB(0, 0), b2, voffB);
            PG8_BAR; PG8_WAIT_L(0); PG8_MMA(0, 1, At, B1); PG8_BAR;
            PG8_LDA(At, 0, 1); PG8_STAGE(PG8_SA(0, 0), a2, voffA);
            PG8_BAR; PG8_WAIT_L(0); PG8_MMA(1, 0, At, B0); PG8_BAR; PG8_SCHED;
            PG8_STAGE(PG8_SB(0, 1), b2 + hstep, voffB);
            PG8_WAIT_V(6); PG8_BAR; PG8_MMA(1, 1, At, B1); PG8_BAR;
            PG8_LDB(B0, 1, 0); PG8_SCHED; PG8_LDA(At, 1, 0); PG8_STAGE(PG8_SA(0, 1), a2 + hstep, voffA);
            PG8_WAIT_L(8); PG8_BAR; PG8_WAIT_L(0); PG8_MMA(0, 0, At, B0); PG8_BAR; PG8_SCHED;
            PG8_LDB(B1, 1, 1); PG8_STAGE(PG8_SB(1, 0), b3, voffB);
            PG8_BAR; PG8_WAIT_L(0); PG8_MMA(0, 1, At, B1); PG8_BAR;
            PG8_LDA(At, 1, 1); PG8_STAGE(PG8_SA(1, 0), a3, voffA);
            PG8_BAR; PG8_WAIT_L(0); PG8_MMA(1, 0, At, B0); PG8_BAR; PG8_SCHED;
            PG8_STAGE(PG8_SB(1, 1), b3 + hstep, voffB);
            PG8_WAIT_V(6); PG8_BAR; PG8_MMA(1, 1, At, B1); PG8_BAR;
            }
        }
        if constexpr (ALIGN_EPI) { if (wr == 0) PG8_BAR; }
        if constexpr (!Epi::AFTER_DRAIN) { E(acc, cur, wr, wc, fr, fq); S.done(cur); }
        if (!has_next) break;
#pragma unroll
        for (int a = 0; a < 2; ++a)
#pragma unroll
            for (int b = 0; b < 2; ++b)
#pragma unroll
                for (int m = 0; m < 4; ++m)
#pragma unroll
                    for (int n = 0; n < 2; ++n) acc[a][b][m][n] = (f32x4){0.f, 0.f, 0.f, 0.f};
        cur = nxt; cA = nA; cB = nB; ++ui;
        if constexpr (ALIGN_EPI) { if (wr == 1) PG8_BAR; }
    }
    PG8_WAIT_V(0);
    if constexpr (!ALIGN_EPI) { if (wr == 0) PG8_BAR; }
    PG8_BAR;
    if constexpr (Epi::AFTER_DRAIN) { E.fused(acc, cur, wr, wc, fr, fq, lds, wid, lane); S.done(cur); }
#undef PG8_SA
#undef PG8_SB
#undef PG8_STAGE
#undef PG8_LDA
#undef PG8_LDB
#undef PG8_MMA
#undef PG8_LD32
#undef PG8_WAIT_V
#undef PG8_WAIT_L
#undef PG8_BAR
#undef PG8_SCHED
}
}

typedef unsigned short bf16_t;
typedef float f32x4 __attribute__((ext_vector_type(4)));
typedef unsigned u32x4 __attribute__((ext_vector_type(4)));
#define LAS __attribute__((address_space(3)))

constexpr int NT = 512;
constexpr int LDS_BYTES = 160 * 1024;
constexpr int D = 2048, NB = 4, SEQ = 4096, CTXL = 256;
constexpr int MT = NB * SEQ;
constexpr int MC = NB * CTXL;
constexpr int MA = MT + MC;
constexpr int NQKVP = 6400;
constexpr int PQ_LD = 6144;
constexpr int NHY = 6144, NZG = 6144;
constexpr int WT_ROWS = NQKVP + NHY + NZG;
constexpr int WT_HY0 = NQKVP, WT_ZG0 = NQKVP + NHY;
constexpr float ALPHA = 1.189207115002721f;

constexpr size_t MiB = (size_t)1 << 20;
constexpr size_t WS_MOD = 0, WS_HID2 = 1 * MiB, WS_SW = 2 * MiB, WS_HA = 34 * MiB, WS_WT = 102 * MiB, WS_RA = 175 * MiB, WS_RB = 367 * MiB, WS_AB = 580 * MiB, WS_END = 658 * MiB;
constexpr size_t WS_HA8 = 658 * MiB;
constexpr size_t WT8_OFF = (size_t)6144 * 2048 * 2;

struct Args { const float* in[31]; float* out; unsigned char* ws; int ph_lo, ph_hi; int reps[8]; int pad2[2]; };
typedef const __attribute__((address_space(4))) Args* KA;

__device__ __forceinline__ unsigned f2bf(float f) { unsigned u = __float_as_uint(f); return (u + 0x7fffu + ((u >> 16) & 1u)) >> 16; }
__device__ __forceinline__ unsigned pk2(float lo, float hi) { return f2bf(lo) | (f2bf(hi) << 16); }
__device__ __forceinline__ float bflo(unsigned w) { return __uint_as_float(w << 16); }
__device__ __forceinline__ float bfhi(unsigned w) { return __uint_as_float(w & 0xffff0000u); }
__device__ __forceinline__ float bf2f(bf16_t b) { return __uint_as_float(((unsigned)b) << 16); }
__device__ __forceinline__ void unpack8(const u32x4 w, float (&o)[8]) { o[0] = bflo(w.x); o[1] = bfhi(w.x); o[2] = bflo(w.y); o[3] = bfhi(w.y); o[4] = bflo(w.z); o[5] = bfhi(w.z); o[6] = bflo(w.w); o[7] = bfhi(w.w); }
__device__ __forceinline__ u32x4 pack8(const float (&v)[8]) { u32x4 w; w.x = pk2(v[0], v[1]); w.y = pk2(v[2], v[3]); w.z = pk2(v[4], v[5]); w.w = pk2(v[6], v[7]); return w; }
typedef short bf16x8 __attribute__((ext_vector_type(8)));
typedef unsigned u32x2 __attribute__((ext_vector_type(2)));
#define MFMA16(a, b, c) __builtin_amdgcn_mfma_f32_16x16x32_bf16((a), (b), (c), 0, 0, 0)
__device__ __forceinline__ u32x2 pk4(float a, float b, float c, float d) { u32x2 w; w.x = pk2(a, b); w.y = pk2(c, d); return w; }
__device__ __forceinline__ float sigmoidf_(float x) { return 1.0f / (1.0f + expf(-x)); }
__device__ __forceinline__ float siluf_(float x) { return x / (1.0f + expf(-x)); }
__device__ __forceinline__ float rdlane(float v, const int l) { return __builtin_bit_cast(float, __builtin_amdgcn_readlane(__builtin_bit_cast(int, v), l)); }
__device__ __forceinline__ float wave_sum(float v) {
    v += __builtin_bit_cast(float, __builtin_amdgcn_update_dpp(0, __builtin_bit_cast(int, v), 0x128, 0xf, 0xf, false));
    v += __builtin_bit_cast(float, __builtin_amdgcn_update_dpp(0, __builtin_bit_cast(int, v), 0x124, 0xf, 0xf, false));
    v += __builtin_bit_cast(float, __builtin_amdgcn_update_dpp(0, __builtin_bit_cast(int, v), 0x122, 0xf, 0xf, false));
    v += __builtin_bit_cast(float, __builtin_amdgcn_update_dpp(0, __builtin_bit_cast(int, v), 0x121, 0xf, 0xf, false));
    return (rdlane(v, 0) + rdlane(v, 16)) + (rdlane(v, 32) + rdlane(v, 48));
}
__device__ __forceinline__ float wave_max(float v) {
    v = fmaxf(v, __builtin_bit_cast(float, __builtin_amdgcn_update_dpp(0, __builtin_bit_cast(int, v), 0x128, 0xf, 0xf, false)));
    v = fmaxf(v, __builtin_bit_cast(float, __builtin_amdgcn_update_dpp(0, __builtin_bit_cast(int, v), 0x124, 0xf, 0xf, false)));
    v = fmaxf(v, __builtin_bit_cast(float, __builtin_amdgcn_update_dpp(0, __builtin_bit_cast(int, v), 0x122, 0xf, 0xf, false)));
    v = fmaxf(v, __builtin_bit_cast(float, __builtin_amdgcn_update_dpp(0, __builtin_bit_cast(int, v), 0x121, 0xf, 0xf, false)));
    return fmaxf(fmaxf(rdlane(v, 0), rdlane(v, 16)), fmaxf(rdlane(v, 32), rdlane(v, 48)));
}

__device__ void p0_mod_hid2(KA a, float* lf) {
    const int tid = tid_opaque(), bid = blockIdx.x;
    if (bid < 192) {
        const float* c = a->in[1]; const float* cc = a->in[3]; const float* w_ada = a->in[4]; const float* b_ada = a->in[5];
        float* mod = (float*)(a->ws + WS_MOD);
        for (int i = tid; i < 5 * 2048; i += NT) { const int r = i >> 11, k = i & 2047; const float v = (r < 4) ? c[r * 2048 + k] : cc[k]; lf[i] = siluf_(v); }
        __syncthreads();
        const int cl = tid & 63, kg = tid >> 6, col = bid * 64 + cl;
        float a0 = 0.f, a1 = 0.f, a2 = 0.f, a3 = 0.f, a4 = 0.f;
#pragma unroll 32
        for (int k = kg * 256; k < kg * 256 + 256; ++k) {
            const float w = w_ada[(size_t)k * 12288 + col];
            a0 += lf[k] * w; a1 += lf[2048 + k] * w; a2 += lf[4096 + k] * w; a3 += lf[6144 + k] * w; a4 += lf[8192 + k] * w;
        }
        float* red = lf + 5 * 2048;
        red[(kg * 5 + 0) * 64 + cl] = a0; red[(kg * 5 + 1) * 64 + cl] = a1; red[(kg * 5 + 2) * 64 + cl] = a2; red[(kg * 5 + 3) * 64 + cl] = a3; red[(kg * 5 + 4) * 64 + cl] = a4;
        __syncthreads();
        if (tid < 320) { const int r = tid >> 6; float s = 0.f;
#pragma unroll
            for (int g = 0; g < 8; ++g) s += red[(g * 5 + r) * 64 + cl];
            mod[r * 12288 + col] = s + b_ada[col]; }
        __syncthreads();
    } else {
        const float* w1 = a->in[12]; const float* b1 = a->in[13]; const float* w2 = a->in[14]; const float* b2 = a->in[15]; const float* freq = a->in[18];
        float* hid2 = (float*)(a->ws + WS_HID2);
        const int pb = (bid - 192) * 64, j = tid & 63, pl = tid >> 6;
        const float fj = freq[j];
        for (int it = 0; it < 8; ++it) {
            const int pos = pb + it * 8 + pl;
            const float tt = (float)pos * (1.0f / 4095.0f);
            float s1 = tt * w1[j];
            const float base = (6.283185307179586f / 4096.0f) * (float)pos;
            for (int e = 0; e < 16; ++e) {
                const float band = 1e-4f + (float)e * ((15.0f - 1e-4f) / 15.0f);
                const float ang = base * band;
                s1 += cosf(ang) * w1[(1 + e) * 64 + j] - sinf(ang) * w1[(17 + e) * 64 + j];
            }
            lf[pl * 64 + j] = sinf(fj * (s1 + b1[j]));
            __syncthreads();
            float s2 = 0.f;
            for (int i = 0; i < 64; ++i) s2 += lf[pl * 64 + i] * w2[i * 64 + j];
            hid2[pos * 64 + j] = sinf(fj * (s2 + b2[j]));
            __syncthreads();
        }
    }
}

__device__ void transpose_unit(const float* src, int ldn, int n0src, bf16_t* dst, int nb, int kb, float* tile) {
    const int tid = tid_opaque(), r = tid >> 4, c4 = tid & 15;
#pragma unroll
    for (int i = 0; i < 4; ++i) {
        const int kk = i * 32 + r;
        f32x4 v = (f32x4){0.f, 0.f, 0.f, 0.f};
        if (n0src >= 0) v = *(const f32x4*)(src + (size_t)(kb * 128 + kk) * ldn + n0src + c4 * 4);
        float* t = tile + kk * 65 + c4 * 4; t[0] = v.x; t[1] = v.y; t[2] = v.z; t[3] = v.w;
    }
    __syncthreads();
#pragma unroll
    for (int i = 0; i < 2; ++i) {
        const int chunk = tid + i * NT, nr = chunk >> 4, kc = chunk & 15;
        const float* t = tile + (kc * 8) * 65 + nr;
        u32x4 w; w.x = pk2(t[0], t[65]); w.y = pk2(t[130], t[195]); w.z = pk2(t[260], t[325]); w.w = pk2(t[390], t[455]);
        *(u32x4*)(dst + (size_t)(nb * 64 + nr) * 2048 + kb * 128 + kc * 8) = w;
    }
    __syncthreads();
}
__device__ __forceinline__ unsigned pk4_fp8(float a, float b, float c, float d) { int w = __builtin_amdgcn_cvt_pk_fp8_f32(a, b, 0, false); w = __builtin_amdgcn_cvt_pk_fp8_f32(c, d, w, true); return (unsigned)w; }
__device__ void transpose_unit8(const float* src, int ldn, int n0src, unsigned char* dst, int nb, int kb, float* tile) {
    const int tid = tid_opaque(), r = tid >> 4, c4 = tid & 15;
#pragma unroll
    for (int i = 0; i < 4; ++i) {
        const int kk = i * 32 + r;
        f32x4 v = (f32x4){0.f, 0.f, 0.f, 0.f};
        if (n0src >= 0) v = *(const f32x4*)(src + (size_t)(kb * 128 + kk) * ldn + n0src + c4 * 4);
        float* t = tile + kk * 65 + c4 * 4; t[0] = v.x * 64.0f; t[1] = v.y * 64.0f; t[2] = v.z * 64.0f; t[3] = v.w * 64.0f;
    }
    __syncthreads();
    {
        const int nr = tid >> 3, kc = tid & 7;
        const float* t = tile + (kc * 16) * 65 + nr;
        u32x4 w;
        w.x = pk4_fp8(t[0], t[65], t[130], t[195]); w.y = pk4_fp8(t[260], t[325], t[390], t[455]);
        w.z = pk4_fp8(t[520], t[585], t[650], t[715]); w.w = pk4_fp8(t[780], t[845], t[910], t[975]);
        *(u32x4*)(dst + (size_t)(nb * 64 + nr) * 2048 + kb * 128 + kc * 16) = w;
    }
    __syncthreads();
}
__device__ __forceinline__ int win_colmap(int np) {
    if (np < 6144) return np;
    if (np < 6208) return 8192 + (np - 6144);
    if (np < 6400) return -1;
    if (np < 12544) return 8256 + (np - 6400);
    if (np < 14592) return 6144 + (np - 12544);
    return 14400 + (np - 14592);
}
struct TrUnit { const float* src; int ldn, n0src, nb, kb, fp8; unsigned char* dst; };
__device__ __forceinline__ TrUnit tr_unit_of(KA a, int u) {
    bf16_t* WT = (bf16_t*)(a->ws + WS_WT); bf16_t* SW = (bf16_t*)(a->ws + WS_SW);
    const int NU_WT = (WT_ROWS / 64) * 16;
    TrUnit t;
    if (u < NU_WT) { const int nb = u >> 4; t.kb = u & 15; t.src = a->in[6]; t.ldn = 18496; t.n0src = win_colmap(nb * 64);
        if (nb >= 100 && nb < 196) { t.fp8 = 0; t.dst = (unsigned char*)WT; t.nb = nb - 100; }
        else { t.fp8 = 1; t.dst = (unsigned char*)WT + WT8_OFF; t.nb = nb < 100 ? nb : nb - 96; } }
    else { const int v = u - NU_WT, mtx = v >> 9; t.nb = (v >> 4) & 31; t.kb = v & 15; t.fp8 = 0; t.ldn = 2048; t.n0src = t.nb * 64;
        t.src = (mtx == 0) ? a->in[20] : (mtx == 1) ? a->in[21] : (mtx == 2) ? a->in[22] : a->in[25]; t.dst = (unsigned char*)(SW + (size_t)mtx * 2048 * 2048); }
    return t;
}
__device__ void p0_transposes(KA a, float* lf) {
    const int NU = (WT_ROWS / 64) * 16 + 4 * 32 * 16;
    const int tid = tid_opaque(), r = tid >> 4, c4 = tid & 15;
    int u = blockIdx.x;
    f32x4 pre[4];
    if (u < NU) { const TrUnit t = tr_unit_of(a, u);
#pragma unroll
        for (int i = 0; i < 4; ++i) pre[i] = (t.n0src >= 0) ? *(const f32x4*)(t.src + (size_t)(t.kb * 128 + i * 32 + r) * t.ldn + t.n0src + c4 * 4) : (f32x4){0.f, 0.f, 0.f, 0.f}; }
    __syncthreads();
#pragma unroll 1
    for (int k = 0; u < NU; ++k, u += gridDim.x) {
        const TrUnit t = tr_unit_of(a, u);
        float* tile = lf + (k & 1) * (128 * 65);
        const float sc = t.fp8 ? 64.0f : 1.0f;
#pragma unroll
        for (int i = 0; i < 4; ++i) { float* tp = tile + (i * 32 + r) * 65 + c4 * 4; tp[0] = pre[i].x * sc; tp[1] = pre[i].y * sc; tp[2] = pre[i].z * sc; tp[3] = pre[i].w * sc; }
        __syncthreads();
        const int un = u + gridDim.x;
        if (un < NU) { const TrUnit tn = tr_unit_of(a, un);
#pragma unroll
            for (int i = 0; i < 4; ++i) pre[i] = (tn.n0src >= 0) ? *(const f32x4*)(tn.src + (size_t)(tn.kb * 128 + i * 32 + r) * tn.ldn + tn.n0src + c4 * 4) : (f32x4){0.f, 0.f, 0.f, 0.f}; }
        if (t.fp8) {
            const int nr = tid >> 3, kc = tid & 7;
            const float* tp = tile + (kc * 16) * 65 + nr;
            u32x4 w;
            w.x = pk4_fp8(tp[0], tp[65], tp[130], tp[195]); w.y = pk4_fp8(tp[260], tp[325], tp[390], tp[455]);
            w.z = pk4_fp8(tp[520], tp[585], tp[650], tp[715]); w.w = pk4_fp8(tp[780], tp[845], tp[910], tp[975]);
            *(u32x4*)(t.dst + (size_t)(t.nb * 64 + nr) * 2048 + t.kb * 128 + kc * 16) = w;
        } else {
#pragma unroll
            for (int i = 0; i < 2; ++i) {
                const int chunk = tid + i * NT, nr = chunk >> 4, kc = chunk & 15;
                const float* tp = tile + (kc * 8) * 65 + nr;
                u32x4 w; w.x = pk2(tp[0], tp[65]); w.y = pk2(tp[130], tp[195]); w.z = pk2(tp[260], tp[325]); w.w = pk2(tp[390], tp[455]);
                *(u32x4*)((bf16_t*)t.dst + (size_t)(t.nb * 64 + nr) * 2048 + t.kb * 128 + kc * 8) = w;
            }
        }
    }
    __syncthreads();
}

__device__ void p1_ha(KA a) {
    const float* mod = (const float*)(a->ws + WS_MOD); bf16_t* HA = (bf16_t*)(a->ws + WS_HA); unsigned char* HA8 = a->ws + WS_HA8;
    const size_t nthr = (size_t)gridDim.x * NT;
    for (size_t i = (size_t)blockIdx.x * NT + tid_opaque(); i < (size_t)MA * 128; i += nthr) {
        const int row = (int)(i >> 7), k16 = (int)(i & 127) * 16;
        const float* sp; int mr;
        if (row < MT) { sp = a->in[0] + (size_t)row * 2048 + k16; mr = row >> 12; } else { sp = a->in[2] + (size_t)(row - MT) * 2048 + k16; mr = 4; }
        const float* mp = mod + mr * 12288 + k16;
        u32x4 w8, wlo, whi;
#pragma unroll
        for (int j = 0; j < 4; ++j) {
            const f32x4 x = *(const f32x4*)(sp + j * 4), hh = *(const f32x4*)(mp + j * 4), ss = *(const f32x4*)(mp + 2048 + j * 4);
            const float v0 = x[0] * (1.0f + ss[0]) + hh[0], v1 = x[1] * (1.0f + ss[1]) + hh[1], v2 = x[2] * (1.0f + ss[2]) + hh[2], v3 = x[3] * (1.0f + ss[3]) + hh[3];
            w8[j] = pk4_fp8(v0, v1, v2, v3);
            if (j < 2) { wlo[2 * j] = pk2(v0, v1); wlo[2 * j + 1] = pk2(v2, v3); } else { whi[2 * (j - 2)] = pk2(v0, v1); whi[2 * (j - 2) + 1] = pk2(v2, v3); }
        }
        if (row < MT) { *(u32x4*)(HA + (size_t)row * 2048 + k16) = wlo; *(u32x4*)(HA + (size_t)row * 2048 + k16 + 8) = whi; }
        *(u32x4*)(HA8 + (size_t)row * 2048 + k16) = w8;
    }
}

struct FStoreBf16 { bf16_t* O; int ldc; float sc;
    __device__ __forceinline__ void operator()(int row, int col, const f32x4 a0, const f32x4 a1) const {
        const f32x4 v0 = a0 * sc, v1 = a1 * sc;
        u32x4 w; w.x = pg8::cvt_pk_bf16(v0[0], v0[1]); w.y = pg8::cvt_pk_bf16(v0[2], v0[3]); w.z = pg8::cvt_pk_bf16(v1[0], v1[1]); w.w = pg8::cvt_pk_bf16(v1[2], v1[3]);
        *(u32x4*)(O + (size_t)row * ldc + col) = w; } };
struct FStoreQKV { bf16_t* PQ; float* AB; float sc;
    __device__ __forceinline__ void operator()(int row, int col, const f32x4 a0, const f32x4 a1) const {
        const f32x4 v0 = a0 * sc, v1 = a1 * sc;
        if (col < 6144) { u32x4 w; w.x = pg8::cvt_pk_bf16(v0[0], v0[1]); w.y = pg8::cvt_pk_bf16(v0[2], v0[3]); w.z = pg8::cvt_pk_bf16(v1[0], v1[1]); w.w = pg8::cvt_pk_bf16(v1[2], v1[3]);
            *(u32x4*)(PQ + (size_t)row * PQ_LD + col) = w; }
        else if (col < 6208) { float* p = AB + (size_t)row * 64 + (col - 6144); *(f32x4*)p = v0; *(f32x4*)(p + 4) = v1; } } };
struct FStoreF32 { float* O; int ldc;
    __device__ __forceinline__ void operator()(int row, int col, const f32x4 v0, const f32x4 v1) const { float* p = O + (size_t)row * ldc + col; *(f32x4*)p = v0; *(f32x4*)(p + 4) = v1; } };
struct FGatePA { const bf16_t* ZG; bf16_t* MG;
    __device__ __forceinline__ void operator()(int row, int col, const f32x4 v0, const f32x4 v1) const {
        float g[8]; unpack8(*(const u32x4*)(ZG + (size_t)row * NZG + 2048 + col), g);
        float o[8];
#pragma unroll
        for (int e = 0; e < 4; ++e) { o[e] = sigmoidf_(g[e]) * v0[e]; o[4 + e] = sigmoidf_(g[4 + e]) * v1[e]; }
        *(u32x4*)(MG + (size_t)row * 2048 + col) = pack8(o); } };
struct FGatePH { const bf16_t* ZG; bf16_t* MG;
    __device__ __forceinline__ void operator()(int row, int col, const f32x4 v0, const f32x4 v1) const {
        float g[8], t[8]; unpack8(*(const u32x4*)(ZG + (size_t)row * NZG + 4096 + col), g); unpack8(*(const u32x4*)(MG + (size_t)row * 2048 + col), t);
        float o[8];
#pragma unroll
        for (int e = 0; e < 4; ++e) { o[e] = t[e] + sigmoidf_(g[e]) * v0[e]; o[4 + e] = t[4 + e] + sigmoidf_(g[4 + e]) * v1[e]; }
        *(u32x4*)(MG + (size_t)row * 2048 + col) = pack8(o); } };
struct FOut { const float* x; const float* mod; float* T3;
    __device__ __forceinline__ void operator()(int row, int col, const f32x4 v0, const f32x4 v1) const {
        const float* xp = x + (size_t)row * 2048 + col; const float* gp = mod + (row >> 12) * 12288 + 4096 + col;
        const f32x4 x0 = *(const f32x4*)xp, x1 = *(const f32x4*)(xp + 4), g0 = *(const f32x4*)gp, g1 = *(const f32x4*)(gp + 4);
        float* p = T3 + (size_t)row * 2048 + col;
#if DBG_MODE == 1
        *(f32x4*)p = ALPHA * x0; *(f32x4*)(p + 4) = ALPHA * x1;
#else
        *(f32x4*)p = ALPHA * x0 + g0 * v0; *(f32x4*)(p + 4) = ALPHA * x1 + g1 * v1;
#endif
    } };

template <class F> __device__ __forceinline__ void run_gemm8(unsigned char* lds, const unsigned char* A8, const unsigned char* Bt8, int M, int N, const F& f) {
    pg8::Gemm g{(const bf16_t*)A8, (const bf16_t*)Bt8, M, N, 1024}; pg8::StaticOrder S; S.init(M, N, (int)gridDim.x, (int)blockIdx.x);
    pg8::EpiGen<F> E{f};
    pg8::gemm_phase8<pg8::EpiGen<F>, pg8::StaticOrder, true, true>((PG8_LAS unsigned char*)lds, g, S, E);
}
template <class F> __device__ __forceinline__ void run_gemm(unsigned char* lds, const bf16_t* A, const bf16_t* Bt, int M, int N, const F& f) {
    pg8::Gemm g{A, Bt, M, N, 2048}; pg8::StaticOrder S; S.init(M, N, (int)gridDim.x, (int)blockIdx.x);
    pg8::EpiGen<F> E{f};
    pg8::gemm_phase<pg8::EpiGen<F>, pg8::StaticOrder, true, true>((PG8_LAS unsigned char*)lds, g, S, E);
}

typedef float f32x2 __attribute__((ext_vector_type(2)));
constexpr int HY_Z = 0, HY_F = 69632, HY_TW4 = 139264, HY_TW8 = 141312, HY_TW32 = 143360, HY_W3 = 143488;
__device__ __forceinline__ f32x2 cmul(const f32x2 a, const f32x2 b) { return (f32x2){a.x * b.x - a.y * b.y, a.x * b.y + a.y * b.x}; }
__device__ __forceinline__ f32x2 cmulc(const f32x2 a, const f32x2 b) { return (f32x2){a.x * b.x + a.y * b.y, a.y * b.x - a.x * b.y}; }
template <bool INV> __device__ __forceinline__ f32x2 ctw(const f32x2 v, const float wr, const float wi) {
    return INV ? (f32x2){v.x * wr + v.y * wi, v.y * wr - v.x * wi} : (f32x2){v.x * wr - v.y * wi, v.y * wr + v.x * wi};
}
template <bool INV> __device__ __forceinline__ void dft16(f32x2 (&x)[16]) {
    constexpr float C = 0.9238795325112867f, S = 0.3826834323650898f, R = 0.7071067811865476f;
    f32x2 A[4][4];
#pragma unroll
    for (int q0 = 0; q0 < 4; ++q0) {
        const f32x2 a = x[q0], b = x[4 + q0], c = x[8 + q0], d = x[12 + q0];
        const f32x2 t0 = a + c, t1 = a - c, t2 = b + d, t3 = b - d;
        const f32x2 m = (f32x2){t3.y, -t3.x};
        A[q0][0] = t0 + t2; A[q0][2] = t0 - t2;
        A[q0][1] = INV ? (t1 - m) : (t1 + m); A[q0][3] = INV ? (t1 + m) : (t1 - m);
    }
    A[1][1] = ctw<INV>(A[1][1], C, -S); A[1][2] = ctw<INV>(A[1][2], R, -R); A[1][3] = ctw<INV>(A[1][3], S, -C);
    A[2][1] = ctw<INV>(A[2][1], R, -R); A[2][2] = ctw<INV>(A[2][2], 0.f, -1.f); A[2][3] = ctw<INV>(A[2][3], -R, -R);
    A[3][1] = ctw<INV>(A[3][1], S, -C); A[3][2] = ctw<INV>(A[3][2], -R, -R); A[3][3] = ctw<INV>(A[3][3], -C, S);
#pragma unroll
    for (int s = 0; s < 4; ++s) {
        const f32x2 t0 = A[0][s] + A[2][s], t1 = A[0][s] - A[2][s], t2 = A[1][s] + A[3][s], t3 = A[1][s] - A[3][s];
        const f32x2 m = (f32x2){t3.y, -t3.x};
        x[s] = t0 + t2; x[s + 8] = t0 - t2;
        x[s + 4] = INV ? (t1 - m) : (t1 + m); x[s + 12] = INV ? (t1 + m) : (t1 - m);
    }
}
template <bool INV> __device__ __forceinline__ void apply_tw(f32x2 (&x)[16], const f32x2 w) {
    f32x2 wr = w;
#pragma unroll
    for (int r = 1; r < 16; ++r) { x[r] = INV ? cmulc(x[r], wr) : cmul(x[r], wr); if (r < 15) wr = cmul(wr, w); }
}
__device__ __forceinline__ void fft_pass2_fwd(f32x2* B, int t, const f32x2* TW4) {
    const int base = 272 * (t >> 4) + (t & 15); f32x2 x[16];
#pragma unroll
    for (int q = 0; q < 16; ++q) x[q] = B[base + 17 * q];
    dft16<false>(x); apply_tw<false>(x, TW4[16 * (t & 15)]);
#pragma unroll
    for (int q = 0; q < 16; ++q) B[base + 17 * q] = x[q];
}
__device__ __forceinline__ void fft_pass2_inv(f32x2* B, int t, const f32x2* TW4) {
    const int base = 272 * (t >> 4) + (t & 15); f32x2 x[16];
#pragma unroll
    for (int q = 0; q < 16; ++q) x[q] = B[base + 17 * q];
    apply_tw<true>(x, TW4[16 * (t & 15)]); dft16<true>(x);
#pragma unroll
    for (int q = 0; q < 16; ++q) B[base + 17 * q] = x[q];
}
__device__ __forceinline__ float conv3_lane(float c, int lane, float w0, float w1, float w2) {
    (void)lane;
    const float up = __builtin_bit_cast(float, __builtin_amdgcn_update_dpp(0, __builtin_bit_cast(int, c), 0x138, 0xf, 0xf, true));
    const float dn = __builtin_bit_cast(float, __builtin_amdgcn_update_dpp(0, __builtin_bit_cast(int, c), 0x130, 0xf, 0xf, true));
    return w0 * up + w1 * c + w2 * dn;
}
constexpr size_t WS_FILT = 585 * MiB;
__device__ void filt_unit(KA a, int unit, unsigned char* lds) {
    const int tid = tid_opaque(), lane = tid & 63, w = tid >> 6, fr = lane & 15, fq = lane >> 4;
    const int c0 = (unit >> 3) * 64, pc = (unit & 7) * 512;
    bf16_t* Bt = (bf16_t*)lds;
    const float* w3 = a->in[16]; const float* b3 = a->in[17]; const float* hid2 = (const float*)(a->ws + WS_HID2);
    bf16_t* FILT = (bf16_t*)(a->ws + WS_FILT);
    __syncthreads();
#pragma unroll
    for (int i = 0; i < 8; ++i) {
        const int idx = tid + i * NT, k = idx >> 6, q = (idx >> 4) & 3, c4 = idx & 15;
        const f32x4 v = *(const f32x4*)(w3 + (size_t)k * 8192 + (q >> 1) * 4096 + (q & 1) * 2048 + c0 + c4 * 4);
        bf16_t* bp = Bt + (q * 64 + c4 * 4) * 72 + k;
        bp[0] = (bf16_t)f2bf(v.x); bp[72] = (bf16_t)f2bf(v.y); bp[144] = (bf16_t)f2bf(v.z); bp[216] = (bf16_t)f2bf(v.w);
    }
    __syncthreads();
#pragma unroll 1
    for (int it = 0; it < 4; ++it) {
        const int p0 = pc + (it * 8 + w) * 16;
        bf16x8 af[2];
#pragma unroll
        for (int kk = 0; kk < 2; ++kk) { const float* hp = hid2 + (size_t)(p0 + fr) * 64 + kk * 32 + fq * 8; const f32x4 x0 = *(const f32x4*)hp, x1 = *(const f32x4*)(hp + 4);
            u32x4 wv; wv.x = pk2(x0[0], x0[1]); wv.y = pk2(x0[2], x0[3]); wv.z = pk2(x1[0], x1[1]); wv.w = pk2(x1[2], x1[3]); af[kk] = __builtin_bit_cast(bf16x8, wv); }
#pragma unroll 4
        for (int n = 0; n < 16; ++n) {
            f32x4 acc = (f32x4){0.f, 0.f, 0.f, 0.f};
#pragma unroll
            for (int kk = 0; kk < 2; ++kk) acc = MFMA16(af[kk], *(const bf16x8*)(Bt + (n * 16 + fr) * 72 + kk * 32 + fq * 8), acc);
            const int q = n >> 2, c = c0 + (n & 3) * 16 + fr;
            const float bias = b3[(q >> 1) * 4096 + (q & 1) * 2048 + c];
            const float dl = (3.0701134573253944f + 12.280453829301578f * ((float)c * (1.0f / 2047.0f))) * (1.0f / 4095.0f);
            const int pos = p0 + 4 * fq;
            const float e0 = expf(-(float)pos * dl), e1 = expf(-(float)(pos + 1) * dl), e2 = expf(-(float)(pos + 2) * dl), e3 = expf(-(float)(pos + 3) * dl);
            *(u32x2*)(FILT + ((size_t)c * 4 + q) * 4096 + pos) = pk4((acc[0] + bias) * e0, (acc[1] + bias) * e1, (acc[2] + bias) * e2, (acc[3] + bias) * e3);
        }
    }
}
__device__ void hyena_setup(unsigned char* lds) {
    const int tid = tid_opaque();
    f32x2* TW4 = (f32x2*)(lds + HY_TW4); f32x2* TW8 = (f32x2*)(lds + HY_TW8); f32x2* TW32 = (f32x2*)(lds + HY_TW32);
    if (tid < 256) { const float a4 = -6.283185307179586f * (float)tid * (1.0f / 4096.0f), a8 = -6.283185307179586f * (float)tid * (1.0f / 8192.0f);
        TW4[tid] = (f32x2){cosf(a4), sinf(a4)}; TW8[tid] = (f32x2){cosf(a8), sinf(a8)}; }
    if (tid < 16) { const float a = -6.283185307179586f * (float)tid * (1.0f / 32.0f); TW32[tid] = (f32x2){cosf(a), sinf(a)}; }
    __syncthreads();
}
struct HyCtx { f32x2* Z; f32x2* Fb0; const f32x2* TW4; const f32x2* TW32; const bf16_t* rv; const bf16_t* rx1; const bf16_t* rx2; bf16_t* YTc; float* Y1S;
    f32x2 w8t, w4t; float cv0, cv1, cv2, cx0, cx1, cx2, cy0, cy1, cy2, sk0, sk1; int tid, br, t, lane, p1; };
template <int ORDER> __device__ __forceinline__ void hyena_conv(const HyCtx& K, int pr) {
    f32x2* Z = K.Z; const f32x2* TW4 = K.TW4; const f32x2* TW32 = K.TW32;
    const bf16_t* rv = K.rv; const bf16_t* rx1 = K.rx1; const bf16_t* rx2 = K.rx2; float* Y1S = K.Y1S;
    int tid = K.tid; asm volatile("" : "+v"(tid));
    const f32x2 w8t = K.w8t, w4t = K.w4t; const int br = tid >> 8, t = tid & 255, lane = tid & 63, p1 = t + (t >> 4);
    f32x2* Zb = K.Z + br * 4352; f32x2* Fb = K.Fb0 + br * 4352;
    const float cv0 = K.cv0, cv1 = K.cv1, cv2 = K.cv2, cx0 = K.cx0, cx1 = K.cx1, cx2 = K.cx2, cy0 = K.cy0, cy1 = K.cy1, cy2 = K.cy2, sk0 = K.sk0, sk1 = K.sk1;
        const int ba = 2 * pr * 4096, bb = ba + 4096;
        {
            f32x2 x[16];
#pragma unroll
            for (int q = 0; q < 16; ++q) {
                const int n = t + 256 * q; float ua, ub;
                if (ORDER == 0) { ua = conv3_lane(bf2f(rv[ba + n]), lane, cv0, cv1, cv2); ub = conv3_lane(bf2f(rv[bb + n]), lane, cv0, cv1, cv2); }
                else { ua = Y1S[n]; ub = Y1S[4096 + n]; }
                const f32x2 z = (f32x2){ua, ub};
                x[q] = br ? cmul(z, cmul(w8t, TW32[q])) : z;
            }
            dft16<false>(x); apply_tw<false>(x, w4t);
#pragma unroll
            for (int q = 0; q < 16; ++q) Zb[p1 + 272 * q] = x[q];
        }
        __syncthreads();
        fft_pass2_fwd(Zb, t, TW4);
        __syncthreads();
        {
            f32x2 x[16];
#pragma unroll
            for (int q = 0; q < 16; ++q) x[q] = Zb[17 * t + q];
            dft16<false>(x);
#pragma unroll
            for (int r = 0; r < 16; ++r) {
                const int p = 16 * t + r; int pp;
                if (br) pp = 4095 - p;
                else { const int m = (r << 8) | ((t & 15) << 4) | (t >> 4); const int mp = (4096 - m) & 4095; pp = ((mp & 15) << 8) | (mp & 0xF0) | (mp >> 8); }
                const f32x2 fk = Fb[p + (p >> 4)], fc = Fb[pp + (pp >> 4)];
                f32x2 H;
                if (ORDER == 0) H = (f32x2){0.5f * (fk.x + fc.x), 0.5f * (fk.y - fc.y)};
                else H = (f32x2){0.5f * (fk.y + fc.y), -0.5f * (fk.x - fc.x)};
                x[r] = cmul(x[r], H);
            }
            dft16<true>(x);
#pragma unroll
            for (int q = 0; q < 16; ++q) Zb[17 * t + q] = x[q];
        }
        __syncthreads();
        fft_pass2_inv(Zb, t, TW4);
        __syncthreads();
        {
            f32x2 x[16];
#pragma unroll
            for (int q = 0; q < 16; ++q) x[q] = Zb[p1 + 272 * q];
            apply_tw<true>(x, w4t); dft16<true>(x);
            if (br) {
#pragma unroll
                for (int q = 0; q < 16; ++q) x[q] = cmulc(x[q], cmul(w8t, TW32[q]));
            }
#pragma unroll
            for (int q = 0; q < 16; ++q) Zb[p1 + 272 * q] = x[q];
        }
        __syncthreads();
        {
            float in0[8], in1[8], in2[8], in3[8];
#pragma unroll
            for (int i = 0; i < 8; ++i) {
                const int n = tid + i * NT;
                if (ORDER == 0) { in0[i] = bf2f(rv[ba + n]); in1[i] = bf2f(rv[bb + n]); in2[i] = bf2f(rx1[ba + n]); in3[i] = bf2f(rx1[bb + n]); }
                else { in0[i] = Y1S[n]; in1[i] = Y1S[4096 + n]; in2[i] = bf2f(rx2[ba + n]); in3[i] = bf2f(rx2[bb + n]); }
            }
#pragma unroll
            for (int i = 0; i < 8; ++i) {
                const int n = tid + i * NT, pn = n + (n >> 4);
                const f32x2 e0 = Z[pn], e1 = Z[4352 + pn];
                const float ca = (e0.x + e1.x) * (1.0f / 8192.0f), cb = (e0.y + e1.y) * (1.0f / 8192.0f);
                if (ORDER == 0) {
                    const float va = conv3_lane(in0[i], lane, cv0, cv1, cv2), vb = conv3_lane(in1[i], lane, cv0, cv1, cv2);
                    const float xa = conv3_lane(in2[i], lane, cx0, cx1, cx2), xb = conv3_lane(in3[i], lane, cx0, cx1, cx2);
                    Y1S[n] = xa * (ca + sk0 * va); Y1S[4096 + n] = xb * (cb + sk0 * vb);
                } else {
                    const float xa = conv3_lane(in2[i], lane, cy0, cy1, cy2), xb = conv3_lane(in3[i], lane, cy0, cy1, cy2);
                    K.YTc[ba + n] = (bf16_t)f2bf(xa * (ca + sk1 * in0[i])); K.YTc[bb + n] = (bf16_t)f2bf(xb * (cb + sk1 * in1[i]));
                }
            }
        }
        __syncthreads();
}
__device__ void hyena_item(KA a, int c, unsigned char* lds) {
    f32x2* Z = (f32x2*)(lds + HY_Z); f32x2* F = (f32x2*)(lds + HY_F);
    const f32x2* TW4 = (const f32x2*)(lds + HY_TW4); const f32x2* TW8 = (const f32x2*)(lds + HY_TW8); const f32x2* TW32 = (const f32x2*)(lds + HY_TW32);
    float* W3 = (float*)(lds + HY_W3);
    int tid = tid_opaque(); asm volatile("" : "+v"(tid));
    const int br = tid >> 8, t = tid & 255, lane = tid & 63;
    f32x2* Zb = Z + br * 4352; f32x2* Fb = F + br * 4352;
    const float* hid2 = (const float*)(a->ws + WS_HID2);
    const float* w3 = a->in[16]; const float* b3 = a->in[17]; const float* cw = a->in[11]; const float* skip = a->in[19];
    const bf16_t* PHT = (const bf16_t*)(a->ws + WS_RA);
    bf16_t* YT = (bf16_t*)a->out;
    float* Y1S = a->out + (size_t)16 * 1024 * 1024 + (size_t)blockIdx.x * 16384;
    {
        const bf16_t* fp = (const bf16_t*)(a->ws + WS_FILT) + (size_t)c * 4 * 4096 + tid * 8;
        float f0[8], f1[8], f2[8], f3[8];
        unpack8(*(const u32x4*)fp, f0); unpack8(*(const u32x4*)(fp + 4096), f1); unpack8(*(const u32x4*)(fp + 8192), f2); unpack8(*(const u32x4*)(fp + 12288), f3);
#pragma unroll
        for (int e = 0; e < 8; ++e) { Z[tid * 8 + e] = (f32x2){f0[e], f1[e]}; Z[4096 + tid * 8 + e] = (f32x2){f2[e], f3[e]}; }
    }
    __syncthreads();
    const f32x2 w8t = TW8[t], w4t = TW4[t];
    const int p1 = t + (t >> 4);
    {
        f32x2 x[16];
#pragma unroll
        for (int q = 0; q < 16; ++q) {
            const int n = t + 256 * q;
            const f32x2 av = Z[n]; f32x2 bv = Z[8192 - (n ? n : 1)]; if (n == 0) bv = (f32x2){0.f, 0.f};
            x[q] = br ? cmul(av - bv, cmul(w8t, TW32[q])) : (av + bv);
        }
        dft16<false>(x); apply_tw<false>(x, w4t);
#pragma unroll
        for (int q = 0; q < 16; ++q) Fb[p1 + 272 * q] = x[q];
    }
    __syncthreads();
    fft_pass2_fwd(Fb, t, TW4);
    __syncthreads();
    {   f32x2 x[16];
#pragma unroll
        for (int q = 0; q < 16; ++q) x[q] = Fb[17 * t + q];
        dft16<false>(x);
#pragma unroll
        for (int q = 0; q < 16; ++q) Fb[17 * t + q] = x[q];
    }
    __syncthreads();
    const float cv0 = cw[c], cv1 = cw[6144 + c], cv2 = cw[12288 + c];
    const float cx0 = cw[2048 + c], cx1 = cw[6144 + 2048 + c], cx2 = cw[12288 + 2048 + c];
    const float cy0 = cw[4096 + c], cy1 = cw[6144 + 4096 + c], cy2 = cw[12288 + 4096 + c];
    const float sk0 = skip[c], sk1 = skip[2048 + c];
    const bf16_t* rv = PHT + (size_t)c * MT; const bf16_t* rx1 = PHT + (size_t)(2048 + c) * MT; const bf16_t* rx2 = PHT + (size_t)(4096 + c) * MT;
    HyCtx K; K.Z = Z; K.Fb0 = F; K.TW4 = TW4; K.TW32 = TW32; K.rv = rv; K.rx1 = rx1; K.rx2 = rx2; K.YTc = YT + (size_t)c * MT; K.Y1S = Y1S;
    K.w8t = w8t; K.w4t = w4t; K.cv0 = cv0; K.cv1 = cv1; K.cv2 = cv2; K.cx0 = cx0; K.cx1 = cx1; K.cx2 = cx2; K.cy0 = cy0; K.cy1 = cy1; K.cy2 = cy2; K.sk0 = sk0; K.sk1 = sk1;
    K.tid = tid; K.br = br; K.t = t; K.lane = lane; K.p1 = p1;
#pragma unroll 1
    for (int pr = 0; pr < 2; ++pr) { hyena_conv<0>(K, pr); hyena_conv<1>(K, pr); }
}

constexpr int H2_ZT = 0, H2_YS = 36864, H2_F = 110592, H2_TW8 = 143360, H2_TW32 = 145408;
struct Hy2W { bf16x8 wr[2], wi[2], wn[2]; };
__device__ __forceinline__ bf16x8 h2frag(const bf16_t* plane, int row, int kk, int fq) { return *(const bf16x8*)(plane + row * 72 + kk * 32 + fq * 8); }
template <int WROLE, int CONJ> __device__ __forceinline__ void h2tile(const bf16_t* Pr, const bf16_t* Pi, int row0, const Hy2W& W, int fr, int fq, f32x4& ar, f32x4& ai) {
    ar = (f32x4){0.f, 0.f, 0.f, 0.f}; ai = (f32x4){0.f, 0.f, 0.f, 0.f};
#pragma unroll
    for (int kk = 0; kk < 2; ++kk) {
        const bf16x8 dr = h2frag(Pr, row0 + fr, kk, fq), di = h2frag(Pi, row0 + fr, kk, fq);
        if (WROLE == 0) { ar = MFMA16(dr, W.wr[kk], ar); ar = MFMA16(di, CONJ ? W.wi[kk] : W.wn[kk], ar); ai = MFMA16(dr, CONJ ? W.wn[kk] : W.wi[kk], ai); ai = MFMA16(di, W.wr[kk], ai); }
        else { ar = MFMA16(W.wr[kk], dr, ar); ar = MFMA16(CONJ ? W.wi[kk] : W.wn[kk], di, ar); ai = MFMA16(CONJ ? W.wn[kk] : W.wi[kk], dr, ai); ai = MFMA16(W.wr[kk], di, ai); }
    }
}
struct Hy2T { f32x2 t[4][4]; };
__device__ void hyena2_setup(unsigned char* lds, Hy2W& W, Hy2T& T) {
    const int tid = tid_opaque(), lane = tid & 63, fr = lane & 15, fq = lane >> 4, wt = (tid >> 6) & 3;
    f32x2* TW8 = (f32x2*)(lds + H2_TW8); f32x2* TW32 = (f32x2*)(lds + H2_TW32);
    if (tid < 256) { const float a8 = -6.283185307179586f * (float)tid * (1.0f / 8192.0f); TW8[tid] = (f32x2){cosf(a8), sinf(a8)}; }
    if (tid < 16) { const float a = -6.283185307179586f * (float)tid * (1.0f / 32.0f); TW32[tid] = (f32x2){cosf(a), sinf(a)}; }
#pragma unroll
    for (int kk = 0; kk < 2; ++kk)
#pragma unroll
        for (int j = 0; j < 8; ++j) {
            const int m = ((16 * wt + fr) * (kk * 32 + fq * 8 + j)) & 63;
            const float ang = -6.283185307179586f * (float)m * (1.0f / 64.0f), c = cosf(ang), s = sinf(ang);
            W.wr[kk][j] = (short)f2bf(c); W.wi[kk][j] = (short)f2bf(s); W.wn[kk][j] = (short)f2bf(-s);
        }
#pragma unroll
    for (int mt = 0; mt < 4; ++mt)
#pragma unroll
        for (int r = 0; r < 4; ++r) { const float ang = (float)((16 * wt + fr) * (mt * 16 + 4 * fq + r)) * (6.283185307179586f / 4096.0f); T.t[mt][r] = (f32x2){cosf(ang), sinf(ang)}; }
    __syncthreads();
}
struct Hy2Ctx { unsigned char* lds; const bf16_t* rv; const bf16_t* rx1; const bf16_t* rx2; bf16_t* YTc; float cv0, cv1, cv2, cx0, cx1, cx2, cy0, cy1, cy2, sk0, sk1; };
#define H2BAR() do { asm volatile("s_waitcnt lgkmcnt(0)" ::: "memory"); __builtin_amdgcn_s_barrier(); asm volatile("" ::: "memory"); } while (0)
template <int FMODE> __device__ __forceinline__ void h2_forward(unsigned char* lds, const Hy2W& W, const Hy2T& T, int tid) {
    const int lane = tid & 63, w = tid >> 6, br = w >> 2, wt = w & 3, fr = lane & 15, fq = lane >> 4;
    bf16_t* ZTr = (bf16_t*)(lds + H2_ZT + br * 18432); bf16_t* ZTi = ZTr + 4608;
    bf16_t* Yr = (bf16_t*)(lds + H2_YS + br * 36864); bf16_t* Yi = Yr + 4608; bf16_t* Sr = Yi + 4608; bf16_t* Si = Sr + 4608;
    unsigned* Fq = (unsigned*)(lds + H2_F) + br * 4096;
#pragma unroll
    for (int mt = 0; mt < 4; ++mt) {
        f32x4 ar, ai; h2tile<0, 0>(ZTr, ZTi, mt * 16, W, fr, fq, ar, ai);
        const int k1 = 16 * wt + fr;
        float vr[4], vi[4];
#pragma unroll
        for (int r = 0; r < 4; ++r) { const float c = T.t[mt][r].x, s = T.t[mt][r].y; vr[r] = ar[r] * c + ai[r] * s; vi[r] = ai[r] * c - ar[r] * s; }
        *(u32x2*)(Yr + k1 * 72 + mt * 16 + 4 * fq) = pk4(vr[0], vr[1], vr[2], vr[3]); *(u32x2*)(Yi + k1 * 72 + mt * 16 + 4 * fq) = pk4(vi[0], vi[1], vi[2], vi[3]);
    }
    H2BAR();
#pragma unroll
    for (int nt = 0; nt < 4; ++nt) {
        f32x4 ar, ai; h2tile<1, 0>(Yr, Yi, nt * 16, W, fr, fq, ar, ai);
        const int k1 = nt * 16 + fr;
        if (FMODE == 0) {
#pragma unroll
            for (int r = 0; r < 4; ++r) Fq[k1 + 64 * (16 * wt + 4 * fq + r)] = pk2(ar[r], ai[r]);
        } else {
            float vr[4], vi[4];
#pragma unroll
            for (int r = 0; r < 4; ++r) {
                const int k = k1 + 64 * (16 * wt + 4 * fq + r), kp = br ? (4095 - k) : ((4096 - k) & 4095);
                const unsigned fa = Fq[k], fb = Fq[kp];
                const float fkr = bflo(fa), fki = bfhi(fa), fcr = bflo(fb), fci = bfhi(fb);
                float hr, hi;
                if (FMODE == 1) { hr = 0.5f * (fkr + fcr); hi = 0.5f * (fki - fci); } else { hr = 0.5f * (fki + fci); hi = -0.5f * (fkr - fcr); }
                vr[r] = ar[r] * hr - ai[r] * hi; vi[r] = ar[r] * hi + ai[r] * hr;
            }
            *(u32x2*)(Sr + k1 * 72 + 16 * wt + 4 * fq) = pk4(vr[0], vr[1], vr[2], vr[3]); *(u32x2*)(Si + k1 * 72 + 16 * wt + 4 * fq) = pk4(vi[0], vi[1], vi[2], vi[3]);
        }
    }
    H2BAR();
}
__device__ __forceinline__ void h2_inverse(unsigned char* lds, const Hy2W& W, const Hy2T& T, int tid) {
    const int lane = tid & 63, w = tid >> 6, br = w >> 2, wt = w & 3, fr = lane & 15, fq = lane >> 4;
    const f32x2* TW8 = (const f32x2*)(lds + H2_TW8); const f32x2* TW32 = (const f32x2*)(lds + H2_TW32);
    bf16_t* ZTr = (bf16_t*)(lds + H2_ZT + br * 18432); bf16_t* ZTi = ZTr + 4608;
    bf16_t* Sr = (bf16_t*)(lds + H2_YS + br * 36864) + 9216; bf16_t* Si = Sr + 4608;
#pragma unroll
    for (int mt = 0; mt < 4; ++mt) {
        f32x4 ar, ai; h2tile<0, 1>(Sr, Si, mt * 16, W, fr, fq, ar, ai);
        const int n2 = 16 * wt + fr;
        float vr[4], vi[4];
#pragma unroll
        for (int r = 0; r < 4; ++r) { const float c = T.t[mt][r].x, s = T.t[mt][r].y; vr[r] = ar[r] * c - ai[r] * s; vi[r] = ai[r] * c + ar[r] * s; }
        *(u32x2*)(ZTr + n2 * 72 + mt * 16 + 4 * fq) = pk4(vr[0], vr[1], vr[2], vr[3]); *(u32x2*)(ZTi + n2 * 72 + mt * 16 + 4 * fq) = pk4(vi[0], vi[1], vi[2], vi[3]);
    }
    H2BAR();
    f32x2* E = (f32x2*)(lds + H2_YS);
#pragma unroll
    for (int nt = 0; nt < 4; ++nt) {
        f32x4 ar, ai; h2tile<1, 1>(ZTr, ZTi, nt * 16, W, fr, fq, ar, ai);
#pragma unroll
        for (int r = 0; r < 4; ++r) {
            const int n = 64 * (16 * wt + 4 * fq + r) + nt * 16 + fr;
            f32x2 e = (f32x2){ar[r], ai[r]};
            if (br) e = cmulc(e, cmul(TW8[n & 255], TW32[n >> 8]));
            E[br * 4096 + n] = e;
        }
    }
    H2BAR();
}
__device__ __forceinline__ void h2_pass0(unsigned char* lds, const float (&ua)[8], const float (&ub)[8], int w, int lane) {
    const f32x2* TW8 = (const f32x2*)(lds + H2_TW8); const f32x2* TW32 = (const f32x2*)(lds + H2_TW32);
    bf16_t* ZT = (bf16_t*)(lds + H2_ZT) + lane * 72 + 8 * w;
    float o0[8], o1[8];
#pragma unroll
    for (int i = 0; i < 8; ++i) { const int n = 64 * (8 * w + i) + lane; const f32x2 wv = cmul(TW8[n & 255], TW32[n >> 8]); o0[i] = ua[i] * wv.x - ub[i] * wv.y; o1[i] = ua[i] * wv.y + ub[i] * wv.x; }
    *(u32x4*)ZT = pack8(ua); *(u32x4*)(ZT + 4608) = pack8(ub); *(u32x4*)(ZT + 9216) = pack8(o0); *(u32x4*)(ZT + 13824) = pack8(o1);
}
__device__ __forceinline__ void hyena2_pair(const Hy2Ctx& K, const Hy2W& W, const Hy2T& T, int pr) {
    unsigned char* lds = K.lds;
    int tid = tid_opaque();
    const int lane = tid & 63, w = tid >> 6;
    const int ba = 2 * pr * 4096, bb = ba + 4096;
    const f32x2* E = (const f32x2*)(lds + H2_YS);
    float va[8], vb[8], xa[8], xb[8];
#pragma unroll
    for (int i = 0; i < 8; ++i) { const int n = 64 * (8 * w + i) + lane; va[i] = bf2f(K.rv[ba + n]); vb[i] = bf2f(K.rv[bb + n]); }
#pragma unroll
    for (int i = 0; i < 8; ++i) { va[i] = conv3_lane(va[i], lane, K.cv0, K.cv1, K.cv2); vb[i] = conv3_lane(vb[i], lane, K.cv0, K.cv1, K.cv2); }
    h2_pass0(lds, va, vb, w, lane);
    H2BAR();
#pragma unroll
    for (int i = 0; i < 8; ++i) { const int n = 64 * (8 * w + i) + lane; xa[i] = bf2f(K.rx1[ba + n]); xb[i] = bf2f(K.rx1[bb + n]); }
    h2_forward<1>(lds, W, T, tid);
    h2_inverse(lds, W, T, tid);
    float ya[8], yb[8];
#pragma unroll
    for (int i = 0; i < 8; ++i) {
        const int n = 64 * (8 * w + i) + lane;
        const f32x2 e0 = E[n], e1 = E[4096 + n];
        const float ca = (e0.x + e1.x) * (1.0f / 8192.0f), cb = (e0.y + e1.y) * (1.0f / 8192.0f);
        ya[i] = conv3_lane(xa[i], lane, K.cx0, K.cx1, K.cx2) * (ca + K.sk0 * va[i]); yb[i] = conv3_lane(xb[i], lane, K.cx0, K.cx1, K.cx2) * (cb + K.sk0 * vb[i]);
    }
    h2_pass0(lds, ya, yb, w, lane);
    H2BAR();
    float za[8], zb[8];
#pragma unroll
    for (int i = 0; i < 8; ++i) { const int n = 64 * (8 * w + i) + lane; za[i] = bf2f(K.rx2[ba + n]); zb[i] = bf2f(K.rx2[bb + n]); }
    h2_forward<2>(lds, W, T, tid);
    h2_inverse(lds, W, T, tid);
#pragma unroll
    for (int i = 0; i < 8; ++i) {
        const int n = 64 * (8 * w + i) + lane;
        const f32x2 e0 = E[n], e1 = E[4096 + n];
        const float ca = (e0.x + e1.x) * (1.0f / 8192.0f), cb = (e0.y + e1.y) * (1.0f / 8192.0f);
        K.YTc[ba + n] = (bf16_t)f2bf(conv3_lane(za[i], lane, K.cy0, K.cy1, K.cy2) * (ca + K.sk1 * ya[i]));
        K.YTc[bb + n] = (bf16_t)f2bf(conv3_lane(zb[i], lane, K.cy0, K.cy1, K.cy2) * (cb + K.sk1 * yb[i]));
    }
    H2BAR();
}
__device__ void hyena2_item(KA a, int c, unsigned char* lds, const Hy2W& W, const Hy2T& T) {
    int tid = tid_opaque();
    const int lane = tid & 63, w = tid >> 6;
    const float* cw = a->in[11]; const float* skip = a->in[19];
    const bf16_t* PHT = (const bf16_t*)(a->ws + WS_RA);
    {
        const bf16_t* fp = (const bf16_t*)(a->ws + WS_FILT) + (size_t)c * 4 * 4096;
        float sr[8], si[8], dr[8], di[8];
#pragma unroll
        for (int i = 0; i < 8; ++i) { const int n = 64 * (8 * w + i) + lane, m = n ? (4096 - n) : 0;
            const float a0 = bf2f(fp[n]), a1 = bf2f(fp[4096 + n]); float b0 = bf2f(fp[8192 + m]), b1 = bf2f(fp[12288 + m]);
            if (n == 0) { b0 = 0.f; b1 = 0.f; }
            sr[i] = a0 + b0; si[i] = a1 + b1; dr[i] = a0 - b0; di[i] = a1 - b1; }
        const f32x2* TW8 = (const f32x2*)(lds + H2_TW8); const f32x2* TW32 = (const f32x2*)(lds + H2_TW32);
        bf16_t* ZT = (bf16_t*)(lds + H2_ZT) + lane * 72 + 8 * w;
        float o0[8], o1[8];
#pragma unroll
        for (int i = 0; i < 8; ++i) { const int n = 64 * (8 * w + i) + lane; const f32x2 wv = cmul(TW8[n & 255], TW32[n >> 8]); o0[i] = dr[i] * wv.x - di[i] * wv.y; o1[i] = dr[i] * wv.y + di[i] * wv.x; }
        *(u32x4*)ZT = pack8(sr); *(u32x4*)(ZT + 4608) = pack8(si); *(u32x4*)(ZT + 9216) = pack8(o0); *(u32x4*)(ZT + 13824) = pack8(o1);
    }
    H2BAR();
    h2_forward<0>(lds, W, T, tid);
    Hy2Ctx K; K.lds = lds; K.rv = PHT + (size_t)c * MT; K.rx1 = PHT + (size_t)(2048 + c) * MT; K.rx2 = PHT + (size_t)(4096 + c) * MT;
    K.YTc = (bf16_t*)a->out + (size_t)c * MT;
    K.cv0 = cw[c]; K.cv1 = cw[6144 + c]; K.cv2 = cw[12288 + c]; K.cx0 = cw[2048 + c]; K.cx1 = cw[6144 + 2048 + c]; K.cx2 = cw[12288 + 2048 + c];
    K.cy0 = cw[4096 + c]; K.cy1 = cw[6144 + 4096 + c]; K.cy2 = cw[12288 + 4096 + c]; K.sk0 = skip[c]; K.sk1 = skip[2048 + c];
#pragma unroll 1
    for (int pr = 0; pr < 2; ++pr) hyena2_pair(K, W, T, pr);
}

__device__ void qkvpost_unit(KA a, int unit, unsigned char* lds) {
    const int tid = tid_opaque();
    int ntok, row0, wh;
    if (unit < 12288) { const int gr = unit / 48; wh = unit % 48; ntok = 64; row0 = gr * 64; }
    else { const int uu = unit - 12288; const int b = uu / 48; wh = uu % 48; ntok = 256; row0 = MT + b * 256; }
    const int which = wh >> 4, h = wh & 15, colbase = which * 2048 + h * 128;
    bf16_t* PQ = (bf16_t*)(a->ws + WS_RB);
    bf16_t* raw = (bf16_t*)lds; float* wl = (float*)(lds + 65536);
    const float* cwt = a->in[7];
    for (int i = tid; i < ntok * 16; i += NT) { const int r = i >> 4, c8 = i & 15; *(u32x4*)(raw + r * 128 + c8 * 8) = *(const u32x4*)(PQ + (size_t)(row0 + r) * PQ_LD + colbase + c8 * 8); }
    for (int i = tid; i < 640; i += NT) wl[i] = cwt[(i >> 7) * 6144 + colbase + (i & 127)];
    __syncthreads();
    const int r = tid >> 3, cg = tid & 7;
    for (int rb = 0; rb < ntok / 64; ++rb) {
        const int tok = rb * 64 + r;
        float v[16]; float ss = 0.f;
#pragma unroll
        for (int e = 0; e < 16; ++e) v[e] = 0.f;
#pragma unroll
        for (int j = 0; j < 5; ++j) {
            const int tt = tok + j - 2;
            if (tt >= 0 && tt < ntok) {
                float p0[8], p1[8]; unpack8(*(const u32x4*)(raw + tt * 128 + cg * 16), p0); unpack8(*(const u32x4*)(raw + tt * 128 + cg * 16 + 8), p1);
                const float* wp = wl + j * 128 + cg * 16;
#pragma unroll
                for (int e = 0; e < 8; ++e) { v[e] += wp[e] * p0[e]; v[8 + e] += wp[8 + e] * p1[e]; }
            }
        }
#pragma unroll
        for (int e = 0; e < 16; ++e) { const float s = siluf_(v[e]); v[e] = s; ss += s * s; }
        if (which < 2) {
            ss += __shfl_xor(ss, 1, 64); ss += __shfl_xor(ss, 2, 64); ss += __shfl_xor(ss, 4, 64);
            const float sc = rsqrtf(ss + 1e-6f) * (which == 0 ? 0.08838834764831845f : 1.0f);
#pragma unroll
            for (int e = 0; e < 16; ++e) v[e] *= sc;
        }
        bf16_t* op = PQ + (size_t)(row0 + tok) * PQ_LD + colbase + cg * 16;
        u32x4 w0, w1;
        w0.x = pk2(v[0], v[1]); w0.y = pk2(v[2], v[3]); w0.z = pk2(v[4], v[5]); w0.w = pk2(v[6], v[7]);
        w1.x = pk2(v[8], v[9]); w1.y = pk2(v[10], v[11]); w1.z = pk2(v[12], v[13]); w1.w = pk2(v[14], v[15]);
        *(u32x4*)op = w0; *(u32x4*)(op + 8) = w1;
    }
    __syncthreads();
}

__device__ void qkvpost_latent(KA a, unsigned char* lds) {
    const int tid = tid_opaque(), r = tid >> 3, cg = tid & 7;
    bf16_t* PQ = (bf16_t*)(a->ws + WS_RB); const float* cwt = a->in[7];
    u32x4 pre0, pre1; float pw0, pw1 = 0.f;
    int u = blockIdx.x;
    {
        const int gr = u / 48, wh = u % 48, colbase = (wh >> 4) * 2048 + (wh & 15) * 128, row0 = gr * 64;
        pre0 = *(const u32x4*)(PQ + (size_t)(row0 + (tid >> 4)) * PQ_LD + colbase + (tid & 15) * 8);
        pre1 = *(const u32x4*)(PQ + (size_t)(row0 + 32 + (tid >> 4)) * PQ_LD + colbase + (tid & 15) * 8);
        pw0 = cwt[(tid >> 7) * 6144 + colbase + (tid & 127)]; if (tid < 128) pw1 = cwt[4 * 6144 + colbase + tid];
    }
#pragma unroll 1
    for (int k = 0; u < 12288; ++k, u += gridDim.x) {
        bf16_t* raw = (bf16_t*)(lds + (k & 1) * 16384); float* wl = (float*)(lds + 32768 + (k & 1) * 2560);
        *(u32x4*)(raw + (tid >> 4) * 128 + (tid & 15) * 8) = pre0; *(u32x4*)(raw + (32 + (tid >> 4)) * 128 + (tid & 15) * 8) = pre1;
        wl[tid] = pw0; if (tid < 128) wl[512 + tid] = pw1;
        __syncthreads();
        const int gr = u / 48, wh = u % 48, which = wh >> 4, colbase = which * 2048 + (wh & 15) * 128, row0 = gr * 64;
        const int un = u + gridDim.x;
        if (un < 12288) {
            const int grn = un / 48, whn = un % 48, cbn = (whn >> 4) * 2048 + (whn & 15) * 128, r0n = grn * 64;
            pre0 = *(const u32x4*)(PQ + (size_t)(r0n + (tid >> 4)) * PQ_LD + cbn + (tid & 15) * 8);
            pre1 = *(const u32x4*)(PQ + (size_t)(r0n + 32 + (tid >> 4)) * PQ_LD + cbn + (tid & 15) * 8);
            pw0 = cwt[(tid >> 7) * 6144 + cbn + (tid & 127)]; if (tid < 128) pw1 = cwt[4 * 6144 + cbn + tid];
        }
        float v[16]; float ss = 0.f;
#pragma unroll
        for (int e = 0; e < 16; ++e) v[e] = 0.f;
#pragma unroll
        for (int j = 0; j < 5; ++j) {
            const int tt = r + j - 2;
            if (tt >= 0 && tt < 64) {
                float p0[8], p1[8]; unpack8(*(const u32x4*)(raw + tt * 128 + cg * 16), p0); unpack8(*(const u32x4*)(raw + tt * 128 + cg * 16 + 8), p1);
                const float* wp = wl + j * 128 + cg * 16;
#pragma unroll
                for (int e = 0; e < 8; ++e) { v[e] += wp[e] * p0[e]; v[8 + e] += wp[8 + e] * p1[e]; }
            }
        }
#pragma unroll
        for (int e = 0; e < 16; ++e) { const float s = siluf_(v[e]); v[e] = s; ss += s * s; }
        if (which < 2) {
            ss += __shfl_xor(ss, 1, 64); ss += __shfl_xor(ss, 2, 64); ss += __shfl_xor(ss, 4, 64);
            const float sc = rsqrtf(ss + 1e-6f) * (which == 0 ? 0.08838834764831845f : 1.0f);
#pragma unroll
            for (int e = 0; e < 16; ++e) v[e] *= sc;
        }
        bf16_t* op = PQ + (size_t)(row0 + r) * PQ_LD + colbase + cg * 16;
        u32x4 w0, w1;
        w0.x = pk2(v[0], v[1]); w0.y = pk2(v[2], v[3]); w0.z = pk2(v[4], v[5]); w0.w = pk2(v[6], v[7]);
        w1.x = pk2(v[8], v[9]); w1.y = pk2(v[10], v[11]); w1.z = pk2(v[12], v[13]); w1.w = pk2(v[14], v[15]);
        *(u32x4*)op = w0; *(u32x4*)(op + 8) = w1;
    }
    __syncthreads();
}

typedef short bf16x8 __attribute__((ext_vector_type(8)));
constexpr size_t WS_TS = 585 * MiB, WS_GCB = 653 * MiB;

__device__ void tprep_wave(KA a, int pid, unsigned char* wl) {
    const int lane = tid_opaque() & 63, fr = lane & 15, fq = lane >> 4;
    const int sid = pid / 68, cidx = pid - sid * 68, dir = sid & 1, h = (sid >> 1) & 15, b = sid >> 5;
    bf16_t* kt = (bf16_t*)wl; float* Mf = (float*)wl; float* gcs = (float*)(wl + 17408); float* bes = gcs + 64;
    const bf16_t* PQ = (const bf16_t*)(a->ws + WS_RB); const float* AB = (const float*)(a->ws + WS_AB);
    bf16_t* TS = (bf16_t*)(a->ws + WS_TS) + (size_t)pid * 4096; float* GCB = (float*)(a->ws + WS_GCB) + (size_t)pid * 128;
    int rbase, Tn, p0;
    if (cidx < 4) { rbase = MT + b * CTXL; Tn = CTXL; p0 = cidx * 64; } else { rbase = b * SEQ; Tn = SEQ; p0 = (cidx - 4) * 64; }
    {
        u32x4 kv[16];
#pragma unroll
        for (int it = 0; it < 16; ++it) {
            const int i = it * 4 + fq, p = p0 + i, tok = dir ? (Tn - 1 - p) : p;
            kv[it] = *(const u32x4*)(PQ + (size_t)(rbase + tok) * PQ_LD + 2048 + h * 128 + fr * 8);
        }
#pragma unroll
        for (int it = 0; it < 16; ++it) *(u32x4*)(kt + (it * 4 + fq) * 136 + fr * 8) = kv[it];
    }
    {
        const int p = p0 + lane, tok = dir ? (Tn - 1 - p) : p; const size_t row = (size_t)(rbase + tok);
        const float ab0 = AB[row * 64 + dir * 32 + h], ab1 = AB[row * 64 + dir * 32 + 16 + h];
        const float xx = ab0 + a->in[9][dir * 16 + h]; const float sp = (xx > 20.0f) ? xx : log1pf(expf(xx));
        float gc = -expf(a->in[8][dir * 16 + h]) * sp;
#pragma unroll
        for (int o = 1; o < 64; o <<= 1) { const float tt = __shfl_up(gc, o, 64); if (lane >= o) gc += tt; }
        const float be = sigmoidf_(ab1);
        gcs[lane] = gc; bes[lane] = be; GCB[lane] = gc; GCB[64 + lane] = expf(gc);
    }
    f32x4 acc[10];
#pragma unroll
    for (int i = 0; i < 10; ++i) acc[i] = (f32x4){0.f, 0.f, 0.f, 0.f};
#pragma unroll
    for (int kk = 0; kk < 4; ++kk) {
        bf16x8 fg[4];
#pragma unroll
        for (int ct = 0; ct < 4; ++ct) fg[ct] = *(const bf16x8*)(kt + (ct * 16 + fr) * 136 + kk * 32 + fq * 8);
#pragma unroll
        for (int ct = 0; ct < 4; ++ct)
#pragma unroll
            for (int mt = 0; mt <= ct; ++mt) acc[ct * (ct + 1) / 2 + mt] = MFMA16(fg[ct], fg[mt], acc[ct * (ct + 1) / 2 + mt]);
    }
    float gcr[4][4], ber[4][4];
#pragma unroll
    for (int ct = 0; ct < 4; ++ct)
#pragma unroll
        for (int r = 0; r < 4; ++r) { gcr[ct][r] = gcs[ct * 16 + 4 * fq + r]; ber[ct][r] = bes[ct * 16 + 4 * fq + r]; }
    float gcm[4];
#pragma unroll
    for (int mt = 0; mt < 4; ++mt) gcm[mt] = gcs[mt * 16 + fr];
    asm volatile("s_waitcnt lgkmcnt(0)" ::: "memory");
#pragma unroll
    for (int ct = 0; ct < 4; ++ct)
#pragma unroll
        for (int mt = 0; mt < 4; ++mt)
#pragma unroll
            for (int r = 0; r < 4; ++r) {
                const int c = ct * 16 + 4 * fq + r, m = mt * 16 + fr;
                float val = 0.0f;
                if (mt <= ct) val = (m < c) ? ber[ct][r] * acc[(mt <= ct) ? (ct * (ct + 1) / 2 + mt) : 0][r] * expf(gcr[ct][r] - gcm[mt]) : 0.0f;
                Mf[c * 68 + m] = val;
            }
    asm volatile("s_waitcnt lgkmcnt(0)" ::: "memory");
    {
        float* blk = Mf + (fq * 16) * 68 + fq * 16;
        float t[16];
#pragma unroll
        for (int i = 0; i < 16; ++i) {
            float s = (fr == i) ? 1.0f : 0.0f;
#pragma unroll
            for (int m4 = 0; m4 < i; m4 += 4) {
                const f32x4 mv = *(const f32x4*)(blk + i * 68 + m4);
                s -= mv.x * t[m4];
                if (m4 + 1 < i) s -= mv.y * t[m4 + 1];
                if (m4 + 2 < i) s -= mv.z * t[m4 + 2];
                if (m4 + 3 < i) s -= mv.w * t[m4 + 3];
            }
            t[i] = s;
        }
        asm volatile("s_waitcnt lgkmcnt(0)" ::: "memory");
#pragma unroll
        for (int i = 0; i < 16; ++i) blk[i * 68 + fr] = t[i];
        asm volatile("s_waitcnt lgkmcnt(0)" ::: "memory");
    }
    float* Ysc = (float*)(wl + 17920);
#pragma unroll
    for (int I = 1; I < 4; ++I)
#pragma unroll
        for (int J = 0; J < I; ++J) {
            f32x4 ya = (f32x4){0.f, 0.f, 0.f, 0.f};
#pragma unroll
            for (int K = J; K < I; ++K)
#pragma unroll
                for (int s = 0; s < 4; ++s) ya = __builtin_amdgcn_mfma_f32_16x16x4f32(Mf[(16 * I + fr) * 68 + 16 * K + 4 * s + fq], Mf[(16 * K + 4 * s + fq) * 68 + 16 * J + fr], ya, 0, 0, 0);
#pragma unroll
            for (int r = 0; r < 4; ++r) Ysc[(4 * fq + r) * 16 + fr] = ya[r];
            asm volatile("s_waitcnt lgkmcnt(0)" ::: "memory");
            f32x4 za = (f32x4){0.f, 0.f, 0.f, 0.f};
#pragma unroll
            for (int s = 0; s < 4; ++s) za = __builtin_amdgcn_mfma_f32_16x16x4f32(Mf[(16 * I + fr) * 68 + 16 * I + 4 * s + fq], Ysc[(4 * s + fq) * 16 + fr], za, 0, 0, 0);
#pragma unroll
            for (int r = 0; r < 4; ++r) Mf[(16 * I + 4 * fq + r) * 68 + 16 * J + fr] = -za[r];
            asm volatile("s_waitcnt lgkmcnt(0)" ::: "memory");
        }
#pragma unroll
    for (int it = 0; it < 8; ++it) {
        const int row = it * 8 + (lane >> 3), c8 = (lane & 7) * 8;
        const f32x4 x0 = *(const f32x4*)(Mf + row * 68 + c8) * *(const f32x4*)(bes + c8), x1 = *(const f32x4*)(Mf + row * 68 + c8 + 4) * *(const f32x4*)(bes + c8 + 4);
        u32x4 wv; wv.x = pk2(x0[0], x0[1]); wv.y = pk2(x0[2], x0[3]); wv.z = pk2(x1[0], x1[1]); wv.w = pk2(x1[2], x1[3]);
        *(u32x4*)(TS + row * 64 + c8) = wv;
    }
    asm volatile("s_waitcnt lgkmcnt(0)" ::: "memory");
}

constexpr int DL_QN = 0, DL_KN = 17408, DL_WN = 34816, DL_ST = 52224, DL_KT = 69632, DL_VT = 88064, DL_T1 = 97280, DL_T2 = 106496, DL_AT = 115712, DL_VN = 124928, DL_VD = 134144, DL_GS = 143360;
struct DStage { u32x4 q0, q1, k0, k1, v, t; f32x4 g0, g1, b0, b1; float bi, gl, g63; };
__device__ __forceinline__ void dstage_load(DStage& R, const bf16_t* PQ, const bf16_t* TS, const float* GCB, int sid, int cidx, int dir, int h, int b, int dvh, int tid) {
    const int i = tid >> 3, part = tid & 7;
    int rbase, Tn, p0;
    if (cidx < 4) { rbase = MT + b * CTXL; Tn = CTXL; p0 = cidx * 64; } else { rbase = b * SEQ; Tn = SEQ; p0 = (cidx - 4) * 64; }
    const int p = p0 + i, tok = dir ? (Tn - 1 - p) : p;
    const bf16_t* rp = PQ + (size_t)(rbase + tok) * PQ_LD + h * 128;
    R.q0 = *(const u32x4*)(rp + part * 16); R.q1 = *(const u32x4*)(rp + part * 16 + 8);
    R.k0 = *(const u32x4*)(rp + 2048 + part * 16); R.k1 = *(const u32x4*)(rp + 2048 + part * 16 + 8);
    R.v = *(const u32x4*)(rp + 4096 + dvh * 64 + part * 8);
    const size_t pid = (size_t)sid * 68 + cidx;
    R.t = *(const u32x4*)(TS + pid * 4096 + i * 64 + part * 8);
    const float* gp = GCB + pid * 128;
    R.b0 = *(const f32x4*)(gp + 64 + part * 8); R.b1 = *(const f32x4*)(gp + 64 + part * 8 + 4);
    R.gl = gp[tid & 63]; R.bi = gp[64 + (tid & 63)]; R.g63 = gp[63];
}
__device__ __forceinline__ void dstage_store(const DStage& R, unsigned char* lds, int tid) {
    const int i = tid >> 3, part = tid & 7;
    bf16_t* QN = (bf16_t*)(lds + DL_QN); bf16_t* KN = (bf16_t*)(lds + DL_KN); bf16_t* VNAT = (bf16_t*)(lds + DL_VT);
    bf16_t* T1 = (bf16_t*)(lds + DL_T1); bf16_t* T2 = (bf16_t*)(lds + DL_T2); float* GS = (float*)(lds + DL_GS);
    *(u32x4*)(QN + i * 136 + part * 16) = R.q0; *(u32x4*)(QN + i * 136 + part * 16 + 8) = R.q1;
    *(u32x4*)(KN + i * 136 + part * 16) = R.k0; *(u32x4*)(KN + i * 136 + part * 16 + 8) = R.k1;
    *(u32x4*)(VNAT + i * 72 + part * 8) = R.v;
    float t8[8]; unpack8(R.t, t8);
    const float em[8] = {R.b0.x, R.b0.y, R.b0.z, R.b0.w, R.b1.x, R.b1.y, R.b1.z, R.b1.w};
    float a1[8];
#pragma unroll
    for (int e = 0; e < 8; ++e) a1[e] = t8[e] * em[e];
    *(u32x4*)(T1 + i * 72 + part * 8) = pack8(a1); *(u32x4*)(T2 + i * 72 + part * 8) = R.t;
    if (tid < 64) { GS[tid] = R.gl; GS[64 + tid] = R.bi; GS[128 + tid] = expf(R.g63 - R.gl); }
}
typedef short s16x4 __attribute__((ext_vector_type(4)));
__device__ __forceinline__ void tr_frags2(unsigned a0, unsigned a1, bf16x8& f0, bf16x8& f1) {
    (void)a0; (void)a1; (void)f0; (void)f1;
}
#define TR_READ4(r0, r1, r2, r3, ad0, ad1, ad2, ad3) asm volatile("ds_read_b64_tr_b16 %0, %4\n\tds_read_b64_tr_b16 %1, %5\n\tds_read_b64_tr_b16 %2, %6\n\tds_read_b64_tr_b16 %3, %7\n\ts_waitcnt lgkmcnt(0)" \
    : "=&v"(r0), "=&v"(r1), "=&v"(r2), "=&v"(r3) : "v"(ad0), "v"(ad1), "v"(ad2), "v"(ad3) : "memory")
#define TR_CAT(lo, hi) __builtin_shufflevector((lo), (hi), 0, 1, 2, 3, 4, 5, 6, 7)
#define LBAR() do { asm volatile("s_waitcnt lgkmcnt(0)" ::: "memory"); __builtin_amdgcn_s_barrier(); asm volatile("" ::: "memory"); } while (0)
__device__ void delta_item(KA a, int item, unsigned char* lds) {
    const int tid = tid_opaque(), lane = tid & 63, w = tid >> 6, fr = lane & 15, fq = lane >> 4;
    const int dvh = item & 1, dir = (item >> 1) & 1, h = (item >> 2) & 15, b = item >> 6, sid = (b * 16 + h) * 2 + dir;
    const bf16_t* PQ = (const bf16_t*)(a->ws + WS_RB); const bf16_t* TS = (const bf16_t*)(a->ws + WS_TS); const float* GCB = (const float*)(a->ws + WS_GCB);
    bf16_t* O = (bf16_t*)(a->ws + WS_RA) + (size_t)dir * MT * 2048;
    const bf16_t* QN = (const bf16_t*)(lds + DL_QN); const bf16_t* KN = (const bf16_t*)(lds + DL_KN); bf16_t* WN = (bf16_t*)(lds + DL_WN); bf16_t* ST = (bf16_t*)(lds + DL_ST);
    const bf16_t* KT = (const bf16_t*)(lds + DL_KT); const bf16_t* VT = (const bf16_t*)(lds + DL_VT); const bf16_t* T1 = (const bf16_t*)(lds + DL_T1); const bf16_t* T2 = (const bf16_t*)(lds + DL_T2);
    bf16_t* AT = (bf16_t*)(lds + DL_AT); bf16_t* VN = (bf16_t*)(lds + DL_VN); bf16_t* VD = (bf16_t*)(lds + DL_VD); const float* GS = (const float*)(lds + DL_GS);
    const unsigned lds_base = (unsigned)(size_t)lds;
    __syncthreads();
    for (int i = tid; i < 64 * 136 / 2; i += NT) ((unsigned*)ST)[i] = 0u;
    f32x4 sacc[4];
#pragma unroll
    for (int i = 0; i < 4; ++i) sacc[i] = (f32x4){0.f, 0.f, 0.f, 0.f};
    DStage R;
    dstage_load(R, PQ, TS, GCB, sid, 0, dir, h, b, dvh, tid);
#pragma unroll 1
    for (int cidx = 0; cidx < 68; ++cidx) {
#pragma unroll 1
        for (int rep = 0; rep < a->reps[6]; ++rep) dstage_store(R, lds, tid);
        LBAR();
        if (cidx + 1 < 68) dstage_load(R, PQ, TS, GCB, sid, cidx + 1, dir, h, b, dvh, tid);
        bf16x8 ktf[2];
        {
            const unsigned kb = lds_base + DL_KN + (unsigned)((8 * fq + (fr >> 2)) * 272 + (w * 16 + 4 * (fr & 3)) * 2);
            s16x4 r0, r1, r2, r3;
            TR_READ4(r0, r1, r2, r3, kb, kb + 4 * 272, kb + 32 * 272, kb + 36 * 272);
            __builtin_amdgcn_sched_barrier(0);
            ktf[0] = TR_CAT(r0, r1); ktf[1] = TR_CAT(r2, r3);
        }
#pragma unroll 1
        for (int rep = 0; rep < a->reps[7]; ++rep) {
#pragma unroll
        for (int ti = 0; ti < 2; ++ti) {
            const int idx = w * 2 + ti, mt = idx >> 2, ct = idx & 3;
            f32x4 acc = (f32x4){0.f, 0.f, 0.f, 0.f};
            if (mt <= ct) {
#pragma unroll
                for (int kk = 0; kk < 4; ++kk) {
                    const bf16x8 af = *(const bf16x8*)(KN + (mt * 16 + fr) * 136 + kk * 32 + fq * 8), bfg = *(const bf16x8*)(QN + (ct * 16 + fr) * 136 + kk * 32 + fq * 8);
                    acc = MFMA16(af, bfg, acc);
                }
            }
            const int c = ct * 16 + fr; const float gcc = GS[c];
            float o4[4];
#pragma unroll
            for (int r = 0; r < 4; ++r) { const int m = mt * 16 + 4 * fq + r; o4[r] = (m <= c) ? acc[r] * expf(gcc - GS[m]) : 0.0f; }
            *(u32x2*)(AT + c * 72 + mt * 16 + 4 * fq) = pk4(o4[0], o4[1], o4[2], o4[3]);
        }
        {
            bf16x8 af[2];
            af[0] = ktf[0]; af[1] = ktf[1];
#pragma unroll
            for (int ct = 0; ct < 4; ++ct) {
                f32x4 acc = (f32x4){0.f, 0.f, 0.f, 0.f};
#pragma unroll
                for (int kk = 0; kk < 2; ++kk) acc = MFMA16(af[kk], *(const bf16x8*)(T1 + (ct * 16 + fr) * 72 + kk * 32 + fq * 8), acc);
                *(u32x2*)(WN + (ct * 16 + fr) * 136 + w * 16 + 4 * fq) = pk4(-acc[0], -acc[1], -acc[2], -acc[3]);
            }
        }
        }
        const int ctu = w >> 1, dv0 = 2 * (w & 1);
        f32x4 uacc[2];
        {
            bf16x8 af[2];
#pragma unroll
            for (int kk = 0; kk < 2; ++kk) af[kk] = *(const bf16x8*)(T2 + (ctu * 16 + fr) * 72 + kk * 32 + fq * 8);
#pragma unroll
            for (int j = 0; j < 2; ++j) { uacc[j] = (f32x4){0.f, 0.f, 0.f, 0.f};
                const unsigned vb = lds_base + DL_VT + (unsigned)((8 * fq + (fr >> 2)) * 144 + ((dv0 + j) * 16 + 4 * (fr & 3)) * 2);
                s16x4 r0, r1, r2, r3;
                TR_READ4(r0, r1, r2, r3, vb, vb + 4 * 144, vb + 32 * 144, vb + 36 * 144);
                __builtin_amdgcn_sched_barrier(0);
                uacc[j] = MFMA16(af[0], TR_CAT(r0, r1), uacc[j]); uacc[j] = MFMA16(af[1], TR_CAT(r2, r3), uacc[j]); }
        }
        LBAR();
        {
            bf16x8 af[4];
#pragma unroll
            for (int kk = 0; kk < 4; ++kk) af[kk] = *(const bf16x8*)(WN + (ctu * 16 + fr) * 136 + kk * 32 + fq * 8);
            float ed[4];
#pragma unroll
            for (int r = 0; r < 4; ++r) ed[r] = GS[128 + ctu * 16 + 4 * fq + r];
#pragma unroll
            for (int j = 0; j < 2; ++j) {
#pragma unroll
                for (int kk = 0; kk < 4; ++kk) uacc[j] = MFMA16(af[kk], *(const bf16x8*)(ST + ((dv0 + j) * 16 + fr) * 136 + kk * 32 + fq * 8), uacc[j]);
                const int dv = (dv0 + j) * 16 + fr;
                *(u32x2*)(VN + dv * 72 + ctu * 16 + 4 * fq) = pk4(uacc[j][0], uacc[j][1], uacc[j][2], uacc[j][3]);
                *(u32x2*)(VD + dv * 72 + ctu * 16 + 4 * fq) = pk4(uacc[j][0] * ed[0], uacc[j][1] * ed[1], uacc[j][2] * ed[2], uacc[j][3] * ed[3]);
            }
        }
        LBAR();
        {
            const int dvt = w >> 1, c0 = 2 * (w & 1);
            bf16x8 af[4], vf[2];
#pragma unroll
            for (int kk = 0; kk < 4; ++kk) af[kk] = *(const bf16x8*)(ST + (dvt * 16 + fr) * 136 + kk * 32 + fq * 8);
#pragma unroll
            for (int kk = 0; kk < 2; ++kk) vf[kk] = *(const bf16x8*)(VN + (dvt * 16 + fr) * 72 + kk * 32 + fq * 8);
#pragma unroll
            for (int j = 0; j < 2; ++j) {
                const int c = (c0 + j) * 16 + fr;
                f32x4 acc = (f32x4){0.f, 0.f, 0.f, 0.f};
#pragma unroll
                for (int kk = 0; kk < 4; ++kk) acc = MFMA16(af[kk], *(const bf16x8*)(QN + c * 136 + kk * 32 + fq * 8), acc);
                const float eg = GS[64 + c];
                acc = acc * eg;
#pragma unroll
                for (int kk = 0; kk < 2; ++kk) acc = MFMA16(vf[kk], *(const bf16x8*)(AT + c * 72 + kk * 32 + fq * 8), acc);
                if (cidx >= 4) {
                    const int p = (cidx - 4) * 64 + c, tok = dir ? (SEQ - 1 - p) : p;
                    *(u32x2*)(O + (size_t)(b * SEQ + tok) * 2048 + h * 128 + dvh * 64 + dvt * 16 + 4 * fq) = pk4(acc[0], acc[1], acc[2], acc[3]);
                }
            }
        }
        {
            const float eg63 = GS[64 + 63];
            bf16x8 af[2];
            af[0] = ktf[0]; af[1] = ktf[1];
#pragma unroll
            for (int j = 0; j < 4; ++j) {
                sacc[j] = sacc[j] * eg63;
#pragma unroll
                for (int kk = 0; kk < 2; ++kk) sacc[j] = MFMA16(af[kk], *(const bf16x8*)(VD + (j * 16 + fr) * 72 + kk * 32 + fq * 8), sacc[j]);
            }
        }
        LBAR();
#pragma unroll
        for (int j = 0; j < 4; ++j) *(u32x2*)(ST + (j * 16 + fr) * 136 + w * 16 + 4 * fq) = pk4(sacc[j][0], sacc[j][1], sacc[j][2], sacc[j][3]);
    }
    __syncthreads();
}

__device__ void ytrans_unit(const bf16_t* YT, bf16_t* Y, int unit, bf16_t* tile) {
    const int tid = tid_opaque(), cb = unit & 31, tb = unit >> 5, r = tid >> 3, c8 = (tid & 7) * 8;
    *(u32x4*)(tile + r * 72 + c8) = *(const u32x4*)(YT + (size_t)(cb * 64 + r) * MT + tb * 64 + c8);
    __syncthreads();
    u32x4 w;
    w.x = (unsigned)tile[(c8 + 0) * 72 + r] | ((unsigned)tile[(c8 + 1) * 72 + r] << 16);
    w.y = (unsigned)tile[(c8 + 2) * 72 + r] | ((unsigned)tile[(c8 + 3) * 72 + r] << 16);
    w.z = (unsigned)tile[(c8 + 4) * 72 + r] | ((unsigned)tile[(c8 + 5) * 72 + r] << 16);
    w.w = (unsigned)tile[(c8 + 6) * 72 + r] | ((unsigned)tile[(c8 + 7) * 72 + r] << 16);
    *(u32x4*)(Y + (size_t)(tb * 64 + r) * 2048 + cb * 64 + c8) = w;
    __syncthreads();
}

__device__ void p6_on(KA a) {
    const bf16_t* OF = (const bf16_t*)(a->ws + WS_RA); const bf16_t* OB = OF + (size_t)MT * 2048;
    const bf16_t* ZG = (const bf16_t*)(a->ws + WS_RB); bf16_t* ON = (bf16_t*)(a->ws + WS_HA);
    const float* nw = a->in[10];
    const size_t nthr = (size_t)gridDim.x * NT;
    for (size_t i = (size_t)blockIdx.x * NT + tid_opaque(); i < (size_t)MT * 256; i += nthr) {
        const int row = (int)(i >> 8), c8 = (int)(i & 255) * 8;
        float f[8], g[8], z[8];
        unpack8(*(const u32x4*)(OF + (size_t)row * 2048 + c8), f); unpack8(*(const u32x4*)(OB + (size_t)row * 2048 + c8), g);
        unpack8(*(const u32x4*)(ZG + (size_t)row * NZG + c8), z);
        float ss = 0.f;
#pragma unroll
        for (int e = 0; e < 8; ++e) { f[e] += g[e]; ss += f[e] * f[e]; }
        ss += __shfl_xor(ss, 1, 64); ss += __shfl_xor(ss, 2, 64); ss += __shfl_xor(ss, 4, 64); ss += __shfl_xor(ss, 8, 64);
        const float rs = rsqrtf(ss * (1.0f / 128.0f) + 1e-6f);
        float o[8];
#pragma unroll
        for (int e = 0; e < 8; ++e) o[e] = f[e] * rs * nw[(c8 & 127) + e] * siluf_(z[e]);
        *(u32x4*)(ON + (size_t)row * 2048 + c8) = pack8(o);
    }
}

constexpr size_t PEER_U8 = 0, PEER_V4 = 32 * MiB, PEER_VG = 48 * MiB, PEER_US = 64 * MiB, PEER_VS = 64 * MiB + 65536;
__device__ void p8_tables(KA a) {
    unsigned char* RAb = a->ws + WS_RA;
    const int lane = tid_opaque() & 63, wv = blockIdx.x * 8 + (tid_opaque() >> 6), nwv = gridDim.x * 8;
    for (int r = wv; r < 32768; r += nwv) {
        const int tab = r >> 14, row = r & 16383;
        const float* sp = (tab ? a->in[28] : a->in[27]) + (size_t)row * 2048;
        f32x4 x[8];
#pragma unroll
        for (int i = 0; i < 2; ++i)
#pragma unroll
            for (int j = 0; j < 4; ++j) x[i * 4 + j] = *(const f32x4*)(sp + i * 1024 + lane * 16 + j * 4);
        float gmx[2];
#pragma unroll
        for (int i = 0; i < 2; ++i) { float m = 0.f;
#pragma unroll
            for (int j = 0; j < 4; ++j) m = fmaxf(m, fmaxf(fmaxf(fabsf(x[i * 4 + j][0]), fabsf(x[i * 4 + j][1])), fmaxf(fabsf(x[i * 4 + j][2]), fabsf(x[i * 4 + j][3]))));
            gmx[i] = m; }
        const float mx = wave_max(fmaxf(gmx[0], gmx[1]));
        if (tab == 0) {
            const float sc = (mx > 0.f) ? mx * (1.0f / 127.0f) : 1.0f, inv = 1.0f / sc;
            unsigned char* dp = RAb + PEER_U8 + (size_t)row * 2048;
#pragma unroll
            for (int i = 0; i < 2; ++i) {
                u32x4 w;
#pragma unroll
                for (int j = 0; j < 4; ++j) {
                    const f32x4 v = x[i * 4 + j];
                    const unsigned b0 = (unsigned)__float2int_rn(v[0] * inv), b1 = (unsigned)__float2int_rn(v[1] * inv), b2 = (unsigned)__float2int_rn(v[2] * inv), b3 = (unsigned)__float2int_rn(v[3] * inv);
                    w[j] = (b0 & 255u) | ((b1 & 255u) << 8) | ((b2 & 255u) << 16) | ((b3 & 255u) << 24);
                }
                *(u32x4*)(dp + i * 1024 + lane * 16) = w;
            }
            if (lane == 0) ((float*)(RAb + PEER_US))[row] = sc;
        } else {
            const float rmx = (mx > 0.f) ? mx : 1.0f;
#pragma unroll
            for (int i = 0; i < 2; ++i) {
                int m = (int)ceilf(gmx[i] * (255.0f / rmx)); m = m < 1 ? 1 : (m > 255 ? 255 : m);
                const float inv = (7.0f * 255.0f) / (rmx * (float)m);
                unsigned q[16];
#pragma unroll
                for (int j = 0; j < 4; ++j)
#pragma unroll
                    for (int e = 0; e < 4; ++e) { int c = __float2int_rn(x[i * 4 + j][e] * inv); c = c < -7 ? -7 : (c > 7 ? 7 : c); q[j * 4 + e] = (unsigned)(c + 8); }
                u32x2 w;
                w.x = (q[0] | (q[4] << 4)) | ((q[1] | (q[5] << 4)) << 8) | ((q[2] | (q[6] << 4)) << 16) | ((q[3] | (q[7] << 4)) << 24);
                w.y = (q[8] | (q[12] << 4)) | ((q[9] | (q[13] << 4)) << 8) | ((q[10] | (q[14] << 4)) << 16) | ((q[11] | (q[15] << 4)) << 24);
                *(u32x2*)(RAb + PEER_V4 + (size_t)row * 1024 + i * 512 + lane * 8) = w;
                (RAb + PEER_VG)[(size_t)row * 128 + lane * 2 + i] = (unsigned char)m;
            }
            if (lane == 0) ((float*)(RAb + PEER_VS))[row] = rmx * (1.0f / (7.0f * 255.0f));
        }
    }
}

__device__ void p9_ln1(KA a) {
    const float* mod = (const float*)(a->ws + WS_MOD); bf16_t* H2 = (bf16_t*)(a->ws + WS_RA) + (size_t)2 * MT * 2048;
    const float* g = a->in[23]; const float* bb = a->in[24];
    const int lane = tid_opaque() & 63, wv = blockIdx.x * 8 + (tid_opaque() >> 6), nwv = gridDim.x * 8;
    for (int row = wv; row < MT; row += nwv) {
        float* rp = a->out + (size_t)row * 2048;
        float v[32]; float s = 0.f;
#pragma unroll
        for (int i = 0; i < 4; ++i) { const f32x4 x0 = *(const f32x4*)(rp + i * 512 + lane * 8), x1 = *(const f32x4*)(rp + i * 512 + lane * 8 + 4);
#pragma unroll
            for (int e = 0; e < 4; ++e) { v[i * 8 + e] = x0[e]; v[i * 8 + 4 + e] = x1[e]; s += x0[e] + x1[e]; } }
        const float mu = wave_sum(s) * (1.0f / 2048.0f);
        float q = 0.f;
#pragma unroll
        for (int e = 0; e < 32; ++e) { const float d = v[e] - mu; q += d * d; }
        const float rstd = rsqrtf(wave_sum(q) * (1.0f / 2048.0f) + 1e-5f);
        const float* mp = mod + (row >> 12) * 12288;
#pragma unroll
        for (int i = 0; i < 4; ++i) {
            const int col = i * 512 + lane * 8;
            float xn[8], h[8];
#pragma unroll
            for (int e = 0; e < 8; ++e) { xn[e] = (v[i * 8 + e] - mu) * rstd * g[col + e] + bb[col + e]; h[e] = xn[e] * (1.0f + mp[8192 + col + e]) + mp[6144 + col + e]; }
            *(f32x4*)(rp + col) = (f32x4){xn[0], xn[1], xn[2], xn[3]}; *(f32x4*)(rp + col + 4) = (f32x4){xn[4], xn[5], xn[6], xn[7]};
            *(u32x4*)(H2 + (size_t)row * 2048 + col) = pack8(h);
        }
    }
}

__device__ __forceinline__ float row_max16(float v) {
    v = fmaxf(v, __builtin_bit_cast(float, __builtin_amdgcn_update_dpp(0, __builtin_bit_cast(int, v), 0x128, 0xf, 0xf, false)));
    v = fmaxf(v, __builtin_bit_cast(float, __builtin_amdgcn_update_dpp(0, __builtin_bit_cast(int, v), 0x124, 0xf, 0xf, false)));
    v = fmaxf(v, __builtin_bit_cast(float, __builtin_amdgcn_update_dpp(0, __builtin_bit_cast(int, v), 0x122, 0xf, 0xf, false)));
    v = fmaxf(v, __builtin_bit_cast(float, __builtin_amdgcn_update_dpp(0, __builtin_bit_cast(int, v), 0x121, 0xf, 0xf, false)));
    return v;
}
__device__ __forceinline__ float row_sum16(float v) {
    v += __builtin_bit_cast(float, __builtin_amdgcn_update_dpp(0, __builtin_bit_cast(int, v), 0x128, 0xf, 0xf, false));
    v += __builtin_bit_cast(float, __builtin_amdgcn_update_dpp(0, __builtin_bit_cast(int, v), 0x124, 0xf, 0xf, false));
    v += __builtin_bit_cast(float, __builtin_amdgcn_update_dpp(0, __builtin_bit_cast(int, v), 0x122, 0xf, 0xf, false));
    v += __builtin_bit_cast(float, __builtin_amdgcn_update_dpp(0, __builtin_bit_cast(int, v), 0x121, 0xf, 0xf, false));
    return v;
}
__device__ __forceinline__ int row_sum16i(int v) {
    v += __builtin_amdgcn_update_dpp(0, v, 0x128, 0xf, 0xf, false);
    v += __builtin_amdgcn_update_dpp(0, v, 0x124, 0xf, 0xf, false);
    v += __builtin_amdgcn_update_dpp(0, v, 0x122, 0xf, 0xf, false);
    v += __builtin_amdgcn_update_dpp(0, v, 0x121, 0xf, 0xf, false);
    return v;
}
template <int NCH, int NV> __device__ __forceinline__ void topk16_row16(float (&x)[NCH][NV], int s, int g, float (&rs)[NCH], int (&ri)[NCH]) {
#pragma unroll
    for (int c = 0; c < NCH; ++c) { rs[c] = -INFINITY; ri[c] = 0; }
#pragma unroll 1
    for (int it = 0; it < 16; ++it) {
#pragma unroll
        for (int c = 0; c < NCH; ++c) {
            float m = x[c][0];
#pragma unroll
            for (int j = 1; j < NV; ++j) m = fmaxf(m, x[c][j]);
            const float wm = row_max16(m);
            const unsigned long long bal = __ballot(m == wm);
            const unsigned seg = (unsigned)(bal >> (16 * g)) & 0xffffu;
            const bool iswin = (s == (__ffs((int)seg) - 1));
            int jsel = 0;
#pragma unroll
            for (int j = NV - 1; j >= 0; --j) { const bool e = (x[c][j] == wm); jsel = e ? j : jsel; x[c][j] = (e && iswin) ? -INFINITY : x[c][j]; }
            const int key = row_sum16i(iswin ? (s * NV + jsel) : 0);
            if (s == it) { rs[c] = wm; ri[c] = key; }
        }
    }
}
__device__ void peer_unit(KA a, int unit, unsigned char* lds) {
    const int tid = tid_opaque(), lane = tid & 63, wid = tid >> 6, fr = lane & 15, fq = lane >> 4;
    float* SC = (float*)lds;
    int* IGI = (int*)(lds + 32768); float* IGG = (float*)(lds + 49152);
    float* TL = (float*)(lds + 65536); int* TI = (int*)(lds + 69632);
    const int tok0 = unit * 32;
    const float* Qp = (const float*)(a->ws + WS_RB); const float* subk = a->in[26];
    const bf16_t* H2 = (const bf16_t*)(a->ws + WS_RA) + (size_t)2 * MT * 2048;
    const float* mod = (const float*)(a->ws + WS_MOD);
    int sti[4], stj[4];
#pragma unroll
    for (int q = 0; q < 4; ++q) {
        const int t = fr * 4 + q; int acc = 0, ii = -1, jj = 0;
#pragma unroll
        for (int i = 0; i < 16; ++i) { const int cnt = 16 / (i + 1); if (ii < 0 && t < acc + cnt) { ii = i; jj = t - acc; } acc += cnt; }
        sti[q] = ii; stj[q] = jj;
    }
#pragma unroll 1
    for (int hh = 0; hh < 8 * a->reps[2]; ++hh) { const int h = hh & 7;
#pragma unroll 1
        for (int p = 0; p < 2; ++p) {
            f32x4 bq[8], aq[2][8];
            const float* bp = subk + (size_t)((h * 2 + p) * 128 + wid * 16 + fr) * 128 + fq * 32;
#pragma unroll
            for (int j = 0; j < 8; ++j) bq[j] = *(const f32x4*)(bp + j * 4);
#pragma unroll
            for (int mt = 0; mt < 2; ++mt) { const float* ap = Qp + (size_t)(tok0 + mt * 16 + fr) * 2048 + h * 256 + p * 128 + fq * 32;
#pragma unroll
                for (int j = 0; j < 8; ++j) aq[mt][j] = *(const f32x4*)(ap + j * 4); }
            f32x4 acc[2] = {(f32x4){0.f, 0.f, 0.f, 0.f}, (f32x4){0.f, 0.f, 0.f, 0.f}};
#pragma unroll
            for (int j = 0; j < 8; ++j)
#pragma unroll
                for (int e = 0; e < 4; ++e) {
                    acc[0] = __builtin_amdgcn_mfma_f32_16x16x4f32(aq[0][j][e], bq[j][e], acc[0], 0, 0, 0);
                    acc[1] = __builtin_amdgcn_mfma_f32_16x16x4f32(aq[1][j][e], bq[j][e], acc[1], 0, 0, 0);
                }
#pragma unroll
            for (int mt = 0; mt < 2; ++mt)
#pragma unroll
                for (int r = 0; r < 4; ++r) SC[(p * 32 + mt * 16 + 4 * fq + r) * 128 + wid * 16 + fr] = acc[mt][r];
        }
        __syncthreads();
        {
            const int tk = wid * 4 + fq;
            float x[2][8]; float ts[2]; int tix[2];
#pragma unroll
            for (int p = 0; p < 2; ++p) { const f32x4 y0 = *(const f32x4*)(SC + (p * 32 + tk) * 128 + fr * 8), y1 = *(const f32x4*)(SC + (p * 32 + tk) * 128 + fr * 8 + 4);
                x[p][0] = y0.x; x[p][1] = y0.y; x[p][2] = y0.z; x[p][3] = y0.w; x[p][4] = y1.x; x[p][5] = y1.y; x[p][6] = y1.z; x[p][7] = y1.w; }
            topk16_row16<2, 8>(x, fr, fq, ts, tix);
            TL[(tk * 2 + 0) * 16 + fr] = ts[0]; TL[(tk * 2 + 1) * 16 + fr] = ts[1]; TI[(tk * 2 + 0) * 16 + fr] = tix[0]; TI[(tk * 2 + 1) * 16 + fr] = tix[1];
            asm volatile("s_waitcnt lgkmcnt(0)" ::: "memory");
            float cnd[1][4]; float bs[1]; int bc[1];
#pragma unroll
            for (int q = 0; q < 4; ++q) cnd[0][q] = (sti[q] >= 0) ? TL[(tk * 2 + 0) * 16 + (sti[q] & 15)] + TL[(tk * 2 + 1) * 16 + stj[q]] : -INFINITY;
            topk16_row16<1, 4>(cnd, fr, fq, bs, bc);
            const int src = (lane & 48) + (bc[0] >> 2), qq = bc[0] & 3;
            const int i0 = __shfl(sti[0], src, 64), i1 = __shfl(sti[1], src, 64), i2 = __shfl(sti[2], src, 64), i3 = __shfl(sti[3], src, 64);
            const int j0 = __shfl(stj[0], src, 64), j1 = __shfl(stj[1], src, 64), j2 = __shfl(stj[2], src, 64), j3 = __shfl(stj[3], src, 64);
            const int pi = (qq == 0) ? i0 : (qq == 1) ? i1 : (qq == 2) ? i2 : i3, pj = (qq == 0) ? j0 : (qq == 1) ? j1 : (qq == 2) ? j2 : j3;
            const int e0 = TI[(tk * 2 + 0) * 16 + (pi & 15)], e1 = TI[(tk * 2 + 1) * 16 + (pj & 15)];
            const float mx = row_max16(bs[0]);
            const float ex = expf(bs[0] - mx);
            const float sm = row_sum16(ex);
            IGI[tk * 128 + h * 16 + fr] = e0 * 128 + e1; IGG[tk * 128 + h * 16 + fr] = ex / sm;
        }
        __syncthreads();
    }
    __syncthreads();
    const unsigned char* U8 = a->ws + WS_RA + PEER_U8; const unsigned char* V4 = a->ws + WS_RA + PEER_V4; const unsigned short* VG = (const unsigned short*)(a->ws + WS_RA + PEER_VG);
    const float* US = (const float*)(a->ws + WS_RA + PEER_US); const float* VS = (const float*)(a->ws + WS_RA + PEER_VS);
#pragma unroll 1
    for (int rr = 0; rr < 4; ++rr) {
        const int row = wid * 4 + rr, tok = tok0 + row;
        float hx[32]; float hs = 0.f;
#pragma unroll
        for (int i = 0; i < 2; ++i) {
            float t8[8];
            unpack8(*(const u32x4*)(H2 + (size_t)tok * 2048 + i * 1024 + lane * 16), t8);
#pragma unroll
            for (int e = 0; e < 8; ++e) { hx[i * 16 + e] = t8[e]; hs += t8[e]; }
            unpack8(*(const u32x4*)(H2 + (size_t)tok * 2048 + i * 1024 + lane * 16 + 8), t8);
#pragma unroll
            for (int e = 0; e < 8; ++e) { hx[i * 16 + 8 + e] = t8[e]; hs += t8[e]; }
        }
        float hmx = 0.f;
#pragma unroll
        for (int e = 0; e < 32; ++e) hmx = fmaxf(hmx, fabsf(hx[e]));
        hmx = wave_max(hmx);
        const float shq = (hmx > 0.f) ? hmx * (1.0f / 127.0f) : 1.0f, ihq = 1.0f / shq;
        int hq[8];
#pragma unroll
        for (int w4 = 0; w4 < 8; ++w4) {
            const unsigned b0 = (unsigned)__float2int_rn(hx[w4 * 4 + 0] * ihq) & 255u, b1 = (unsigned)__float2int_rn(hx[w4 * 4 + 1] * ihq) & 255u, b2 = (unsigned)__float2int_rn(hx[w4 * 4 + 2] * ihq) & 255u, b3 = (unsigned)__float2int_rn(hx[w4 * 4 + 3] * ihq) & 255u;
            hq[w4] = (int)(b0 | (b1 << 8) | (b2 << 16) | (b3 << 24));
        }
        (void)hs;
        int yi[32];
#pragma unroll
        for (int e = 0; e < 32; ++e) yi[e] = 0;
        int cs0 = 0, cs1 = 0; float qscale = 0.f;
#if DBG_MODE != 2
        const int* ip = IGI + row * 128; float* gp = IGG + row * 128;
        float cmax = 0.f;
#define TMERGE(a_, b_, k_) ({ const int _s = (lane & (k_)) ? (a_) : (b_); const int _k = (lane & (k_)) ? (b_) : (a_); _k + __shfl_xor(_s, (k_), 64); })
#pragma unroll 1
        for (int half = 0; half < 2; ++half) {
            const int* iph = ip + half * 64;
            u32x4 nu[PA][2];
#pragma unroll
            for (int k = 0; k < PA; ++k) { const int idx = __builtin_amdgcn_readfirstlane(iph[k]); const unsigned char* up = U8 + (size_t)idx * 2048 + lane * 16;
                nu[k][0] = *(const u32x4*)up; nu[k][1] = *(const u32x4*)(up + 1024); }
            int L2 = 0, L3 = 0, L4 = 0, L5 = 0, FIN = 0;
#pragma unroll 1
            for (int it = 0; it < 16; ++it) {
                u32x4 cu[PA][2];
#pragma unroll
                for (int k = 0; k < PA; ++k) { cu[k][0] = nu[k][0]; cu[k][1] = nu[k][1]; }
                if (it + 1 < 16) {
#pragma unroll
                    for (int k = 0; k < PA; ++k) { const int idx = __builtin_amdgcn_readfirstlane(iph[(it + 1) * PA + k]); const unsigned char* up = U8 + (size_t)idx * 2048 + lane * 16;
                        nu[k][0] = *(const u32x4*)up; nu[k][1] = *(const u32x4*)(up + 1024); }
                }
                int ia[PA];
#pragma unroll
                for (int k = 0; k < PA; ++k) { int iacc = 0;
#pragma unroll
                    for (int i = 0; i < 2; ++i)
#pragma unroll
                        for (int j = 0; j < 4; ++j) iacc = __builtin_amdgcn_sdot4((int)cu[k][i][j], hq[i * 4 + j], iacc, false);
                    ia[k] = iacc; }
                const int m01 = TMERGE(ia[0], ia[1], 32), m23 = TMERGE(ia[2], ia[3], 32);
                const int X2 = TMERGE(m01, m23, 16);
                if ((it & 1) == 0) L2 = X2; else { const int X3 = TMERGE(L2, X2, 8);
                    if ((it & 2) == 0) L3 = X3; else { const int X4 = TMERGE(L3, X3, 4);
                        if ((it & 4) == 0) L4 = X4; else { const int X5 = TMERGE(L4, X4, 2);
                            if ((it & 8) == 0) L5 = X5; else FIN = TMERGE(L5, X5, 1); } } }
            }
            {
                const int el = half * 64 + (int)(__builtin_bitreverse32((unsigned)lane) >> 26);
                const int idx = ip[el];
                const float dot = US[idx] * shq * (float)FIN;
                const float c1 = gp[el] * 0.5f * dot * (1.0f + erff(dot * 0.7071067811865476f)) * VS[idx];
                cmax = fmaxf(cmax, wave_max(fabsf(c1)));
                asm volatile("s_waitcnt lgkmcnt(0)" ::: "memory");
                gp[el] = c1;
            }
        }
#undef TMERGE
        asm volatile("s_waitcnt lgkmcnt(0)" ::: "memory");
        qscale = (cmax > 0.f) ? (524287.0f / (cmax * 255.0f)) : 0.f;
        {
            u32x2 nv[PB][2]; unsigned ng[PB];
#pragma unroll
            for (int k = 0; k < PB; ++k) { const int idx = __builtin_amdgcn_readfirstlane(ip[k]); const unsigned char* vp = V4 + (size_t)idx * 1024 + lane * 8;
                nv[k][0] = *(const u32x2*)vp; nv[k][1] = *(const u32x2*)(vp + 512); ng[k] = VG[(size_t)idx * 64 + lane]; }
#pragma unroll 1
            for (int e = 0; e < 128; e += PB) {
                u32x2 cvv[PB][2]; unsigned cg[PB];
#pragma unroll
                for (int k = 0; k < PB; ++k) { cvv[k][0] = nv[k][0]; cvv[k][1] = nv[k][1]; cg[k] = ng[k]; }
                if (e + PB < 128) {
#pragma unroll
                    for (int k = 0; k < PB; ++k) { const int idx = __builtin_amdgcn_readfirstlane(ip[e + PB + k]); const unsigned char* vp = V4 + (size_t)idx * 1024 + lane * 8;
                        nv[k][0] = *(const u32x2*)vp; nv[k][1] = *(const u32x2*)(vp + 512); ng[k] = VG[(size_t)idx * 64 + lane]; }
                }
#pragma unroll
                for (int k = 0; k < PB; ++k) {
                    const float c1s = gp[e + k] * qscale;
#pragma unroll
                    for (int i = 0; i < 2; ++i) {
                        const int cq = __float2int_rn(c1s * (float)((cg[k] >> (8 * i)) & 255u));
                        if (i == 0) cs0 += cq; else cs1 += cq;
#pragma unroll
                        for (int j = 0; j < 2; ++j) { const unsigned wd = cvv[k][i][j]; int* yp = yi + i * 16 + j * 8;
                            yp[0] = __mul24(cq, (int)(wd & 15u)) + yp[0]; yp[4] = __mul24(cq, (int)((wd >> 4) & 15u)) + yp[4];
                            yp[1] = __mul24(cq, (int)((wd >> 8) & 15u)) + yp[1]; yp[5] = __mul24(cq, (int)((wd >> 12) & 15u)) + yp[5];
                            yp[2] = __mul24(cq, (int)((wd >> 16) & 15u)) + yp[2]; yp[6] = __mul24(cq, (int)((wd >> 20) & 15u)) + yp[6];
                            yp[3] = __mul24(cq, (int)((wd >> 24) & 15u)) + yp[3]; yp[7] = __mul24(cq, (int)(wd >> 28)) + yp[7]; }
                    }
                }
            }
        }
#endif
        float yq[32];
        {
            const float inv = (qscale > 0.f) ? (1.0f / qscale) : 0.f;
#pragma unroll
            for (int e = 0; e < 16; ++e) { yq[e] = (float)(yi[e] - 8 * cs0) * inv; yq[16 + e] = (float)(yi[16 + e] - 8 * cs1) * inv; }
        }
        const float csum2[2] = {0.f, 0.f};
        float* rp = a->out + (size_t)tok * 2048; const float* mp = mod + (tok >> 12) * 12288 + 10240;
        float val[32]; float s = 0.f;
#pragma unroll
        for (int i = 0; i < 2; ++i)
#pragma unroll
            for (int j = 0; j < 4; ++j) { const int col = i * 1024 + lane * 16 + j * 4; const f32x4 x0 = *(const f32x4*)(rp + col), g0 = *(const f32x4*)(mp + col);
#pragma unroll
                for (int e = 0; e < 4; ++e) { const float v = ALPHA * x0[e] + g0[e] * (yq[i * 16 + j * 4 + e] - 8.0f * csum2[i]); val[i * 16 + j * 4 + e] = v; s += v; } }
        const float mu = wave_sum(s) * (1.0f / 2048.0f);
        float q = 0.f;
#pragma unroll
        for (int e = 0; e < 32; ++e) { const float d = val[e] - mu; q += d * d; }
        const float rstd = rsqrtf(wave_sum(q) * (1.0f / 2048.0f) + 1e-5f);
        const float* g = a->in[29]; const float* bb = a->in[30];
#pragma unroll
        for (int i = 0; i < 2; ++i)
#pragma unroll
            for (int j = 0; j < 4; ++j) { const int col = i * 1024 + lane * 16 + j * 4; const f32x4 gg = *(const f32x4*)(g + col), bv = *(const f32x4*)(bb + col); f32x4 o;
#pragma unroll
                for (int e = 0; e < 4; ++e) o[e] = (val[i * 16 + j * 4 + e] - mu) * rstd * gg[e] + bv[e];
                *(f32x4*)(rp + col) = o; }
    }
    __syncthreads();
}

constexpr size_t WS_BAR = 699 * MiB;

__device__ __forceinline__ void grid_bar(unsigned* ctr, unsigned target) {
    asm volatile("s_waitcnt vmcnt(0)" ::: "memory");
    __syncthreads();
    if (tid_opaque() == 0) {
        __builtin_amdgcn_fence(__ATOMIC_RELEASE, "agent");
        asm volatile("s_waitcnt vmcnt(0)" ::: "memory");
        __hip_atomic_fetch_add(ctr, 1u, __ATOMIC_RELAXED, __HIP_MEMORY_SCOPE_AGENT);
        while (__hip_atomic_load(ctr, __ATOMIC_RELAXED, __HIP_MEMORY_SCOPE_AGENT) < target) __builtin_amdgcn_s_sleep(2);
        __builtin_amdgcn_fence(__ATOMIC_ACQUIRE, "agent");
        asm volatile("s_waitcnt vmcnt(0)" ::: "memory");
    }
    __syncthreads();
}

__global__ void __launch_bounds__(NT, 2) fwd_mega(Args a_) {
    KA a = (KA)__builtin_amdgcn_kernarg_segment_ptr();
    unsigned char* lds = g_lds;
    tid_table_init();
    cg::grid_group grid = cg::this_grid();
    float* lf = (float*)lds;
    const int lo = a->ph_lo, hi = a->ph_hi;
#define IN(k) (lo <= (k) && (k) < hi)
    unsigned* barctr = (unsigned*)(a->ws + WS_BAR); unsigned nbar = 0;
    if (blockIdx.x == 0 && tid_opaque() == 0) __hip_atomic_store(barctr, 0u, __ATOMIC_RELAXED, __HIP_MEMORY_SCOPE_AGENT);
#define GBAR() do { ++nbar; grid_bar(barctr, nbar * gridDim.x); } while (0)
#define SEAM(k) do { if (IN(k) && IN((k) + 1)) { if ((k) == 0) grid.sync(); else GBAR(); } asm volatile("" : "+s"(a)); } while (0)
    unsigned char* ws = a->ws;
    bf16_t* HA = (bf16_t*)(ws + WS_HA); bf16_t* WT = (bf16_t*)(ws + WS_WT); bf16_t* SW = (bf16_t*)(ws + WS_SW);
    bf16_t* RA = (bf16_t*)(ws + WS_RA); bf16_t* RB = (bf16_t*)(ws + WS_RB);
    const float* mod = (const float*)(ws + WS_MOD);

    if (IN(0)) {
#pragma unroll 1
        for (int rep = 0; rep < a->reps[0]; ++rep) { p0_mod_hid2(a, lf); p0_transposes(a, lf); }
    }
    SEAM(0);
    if (IN(1)) {
#pragma unroll 1
        for (int rep = 0; rep < a->reps[0]; ++rep) { p1_ha(a); for (int u = blockIdx.x; u < 256; u += gridDim.x) filt_unit(a, u, lds); }
    }
    SEAM(1);
    if (IN(2)) {
#pragma unroll 1
        for (int rep = 0; rep < a->reps[1]; ++rep) {
        run_gemm(lds, WT, HA, NHY, MT, FStoreBf16{RA, MT, 1.0f});
        run_gemm8(lds, ws + WS_HA8, (const unsigned char*)WT + WT8_OFF, MA, NQKVP, FStoreQKV{RB, (float*)(ws + WS_AB), 1.0f / 64.0f});
        }
    }
    SEAM(2);
    if (IN(3)) {
        { Hy2W HW; Hy2T HT; hyena2_setup(lds, HW, HT);
#pragma unroll 1
        for (int rep = 0; rep < a->reps[3]; ++rep)
        for (int c = blockIdx.x; c < 2048; c += gridDim.x) hyena2_item(a, c, lds, HW, HT);
        __syncthreads(); }
        qkvpost_latent(a, lds);
        for (int u = 12288 + blockIdx.x; u < 12288 + 192; u += gridDim.x) qkvpost_unit(a, u, lds);
    }
    SEAM(3);
    if (IN(4)) {
#pragma unroll 1
        for (int rep = 0; rep < a->reps[4]; ++rep)
        { const int wv = tid_opaque() >> 6; for (int pid = blockIdx.x * 8 + wv; pid < 8704; pid += gridDim.x * 8) tprep_wave(a, pid, lds + wv * 18944); }
        GBAR();
#pragma unroll 1
        for (int rep = 0; rep < a->reps[5]; ++rep)
        for (int it = blockIdx.x; it < 256; it += gridDim.x) delta_item(a, it, lds);
    }
    SEAM(4);
    if (IN(5)) {
        run_gemm8(lds, ws + WS_HA8, (const unsigned char*)WT + WT8_OFF + (size_t)NQKVP * 2048, MT, NZG, FStoreBf16{RB, NZG, 1.0f / 64.0f});
#pragma unroll 1
        for (int rep = 0; rep < a->reps[6]; ++rep)
        for (int u = blockIdx.x; u < 8192; u += gridDim.x) ytrans_unit((const bf16_t*)a->out, RA + (size_t)2 * MT * 2048, u, (bf16_t*)lds);
    }
    SEAM(5);
    if (IN(6)) {
#pragma unroll 1
        for (int rep = 0; rep < a->reps[6]; ++rep) p6_on(a); }
    SEAM(6);
    if (IN(7)) {
        run_gemm(lds, HA  , SW, MT, D, FGatePA{RB, WT  });
        run_gemm(lds, RA + (size_t)2 * MT * 2048  , SW + (size_t)1 * D * D, MT, D, FGatePH{RB, WT  });
    }
    SEAM(7);
    if (IN(8)) {
        run_gemm(lds, WT  , SW + (size_t)2 * D * D, MT, D, FOut{a->in[0], mod, a->out});
#pragma unroll 1
        for (int rep = 0; rep < a->reps[7]; ++rep) p8_tables(a);
    }
    SEAM(8);
    if (IN(9)) { p9_ln1(a); }
    SEAM(9);
    if (IN(10)) { run_gemm(lds, RA + (size_t)2 * MT * 2048  , SW + (size_t)3 * D * D, MT, D, FStoreF32{(float*)(ws + WS_RB), D}); }
    SEAM(10);
    if (IN(11)) { for (int u = blockIdx.x; u < MT / 32; u += gridDim.x) peer_unit(a, u, lds); }
#undef IN
#undef SEAM
}

extern "C" void kernel_launch(void* const* d_in, const int* in_sizes, int n_in, void* d_out, int out_size, void* d_ws, size_t ws_size, hipStream_t stream) {
    static int grid = 0;
    if (grid == 0) {
        if (n_in != 31 || out_size != MT * D || ws_size < WS_BAR + 4096) { fprintf(stderr, "kernel_launch: unexpected problem shape / workspace (%d inputs, out %d, ws %zu)\n", n_in, out_size, ws_size); grid = -1; return; }
        int dev = 0, cus = 0, per_cu = 0;
        (void)hipGetDevice(&dev);
        (void)hipDeviceGetAttribute(&cus, hipDeviceAttributeMultiprocessorCount, dev);
        (void)hipFuncSetAttribute((const void*)fwd_mega, hipFuncAttributeMaxDynamicSharedMemorySize, LDS_BYTES);
        (void)hipOccupancyMaxActiveBlocksPerMultiprocessor(&per_cu, (const void*)fwd_mega, NT, LDS_BYTES);
        if (per_cu < 1) per_cu = 1;
        grid = cus * per_cu;
        (void)hipGetLastError();
    }
    if (grid < 0) return;
    Args a{};
    for (int i = 0; i < 31; ++i) a.in[i] = (const float*)d_in[i];
    a.out = (float*)d_out; a.ws = (unsigned char*)d_ws; a.ph_lo = 0; a.ph_hi = 12; a.reps[0] = REP0; a.reps[1] = REP1; a.reps[2] = REP2; a.reps[3] = REP3; a.reps[4] = REP4; a.reps[5] = REP5; a.reps[6] = REP6; a.reps[7] = REP7; a.pad2[0] = REPG;
    void* args[] = {&a};
    hipError_t e = hipLaunchCooperativeKernel((const void*)fwd_mega, dim3(grid), dim3(NT), args, LDS_BYTES, stream);
    if (e != hipSuccess) fprintf(stderr, "cooperative launch failed: %s (grid %d)\n", hipGetErrorString(e), grid);
}
```

```cpp
#include <hip/hip_runtime.h>
#include <hip/hip_cooperative_groups.h>
#include <cstdio>
#include <cstdint>
namespace cg = cooperative_groups;

#ifndef DBG_MODE
#define DBG_MODE 0
#endif
#define PA 4
#define PB 8
#define REP0 1
#define REP1 1
#define REP2 1
#define REP3 1
#define REP4 1
#define REP5 1
#define REP6 1
#define REP7 1
#define REPG 1

extern __shared__ __attribute__((aligned(16))) unsigned char g_lds[];
constexpr int TIDTAB_OFF = 160 * 1024 - 256;
__device__ __forceinline__ int tid_opaque() {
    const int slot = __builtin_amdgcn_s_getreg(0x2804) & 63;
    int wv = __builtin_amdgcn_readfirstlane(((const int*)(g_lds + TIDTAB_OFF))[slot]);
    int t = wv * 64 + (int)__builtin_amdgcn_mbcnt_hi(~0u, __builtin_amdgcn_mbcnt_lo(~0u, 0u));
    asm volatile("" : "+v"(t));
    return t;
}
__device__ __forceinline__ void tid_table_init() {
    const int t = threadIdx.x;
    if ((t & 63) == 0) ((int*)(g_lds + TIDTAB_OFF))[__builtin_amdgcn_s_getreg(0x2804) & 63] = t >> 6;
    __syncthreads();
}

namespace pg8 {
#define PG8_LAS __attribute__((address_space(3)))
typedef unsigned short bf16_t;
typedef short bf16x8 __attribute__((ext_vector_type(8)));
typedef float f32x4 __attribute__((ext_vector_type(4)));
typedef unsigned u32x4 __attribute__((ext_vector_type(4)));
constexpr int BM = 256, BK = 64, HALF = 128, HTB = HALF * BK * 2, STAGE_BYTES = 8 * HTB, NXCD = 8, WGM = 8;

__host__ __device__ __forceinline__ int lds_byte(int r, int c) { const int st = (r >> 4) * 2 + (c >> 5), rr = r & 15, cc = c & 31, ob = rr * 64 + cc * 2; return st * 1024 + (ob ^ (((ob >> 9) & 1) << 5)); }
__host__ __device__ __forceinline__ void stage_rc(int b, int& R, int& C) { const int st = b / 1024, sb = b % 1024, swz = sb ^ (((sb >> 9) & 1) << 5); R = (st >> 1) * 16 + swz / 64; C = (st & 1) * 32 + (swz % 64) / 2; }
__host__ __device__ __forceinline__ int perm32(int rho) { const int n = rho >> 4, i = rho & 15; return 8 * (i >> 2) + 4 * n + (i & 3); }

struct Unit { int pm, pn; };
struct Gemm { const bf16_t* A; const bf16_t* Bt; int M, N, K; };

struct StaticOrder {
    int nM, nN, nwg, G, c;
    __host__ __device__ void init(int M, int N, int G_, int c_) { nM = M / BM; nN = N / BM; nwg = nM * nN; G = G_; c = c_; }
    __host__ __device__ bool next(int i, Unit& u) const {
        const long L = (long)i * G + c; if (L >= nwg) return false;
        int wgid = (int)L; { const int q = nwg / NXCD, r = nwg % NXCD, xcd = wgid % NXCD, off = wgid / NXCD; wgid = (xcd < r ? xcd * (q + 1) : r * (q + 1) + (xcd - r) * q) + off; }
        const int nig = WGM * nN, gid = wgid / nig, fm = gid * WGM, gsz = (nM - fm) < WGM ? (nM - fm) : WGM;
        u.pm = fm + ((wgid % nig) % gsz); u.pn = (wgid % nig) / gsz; return true;
    }
    __device__ __forceinline__ void a_ready(const Unit&) const {}
    __device__ __forceinline__ void done(const Unit&) const {}
};

__device__ __forceinline__ unsigned cvt_pk_bf16(float lo, float hi) { unsigned r; asm volatile("v_cvt_pk_bf16_f32 %0, %1, %2" : "=v"(r) : "v"(lo), "v"(hi)); return r; }

template <class F> struct EpiGen {
    static constexpr bool PERM = true, AFTER_DRAIN = false;
    F f;
    __device__ __forceinline__ void operator()(const f32x4 (&acc)[2][2][4][2], const Unit& u, int wr, int wc, int, int) const {
        int ln = (int)__builtin_amdgcn_mbcnt_hi(~0u, __builtin_amdgcn_mbcnt_lo(~0u, 0u)); asm volatile("" : "+v"(ln));
        const int fr = ln & 15, fq = ln >> 4;
        const int row0 = u.pm * BM + wr * 64 + fr, col0 = u.pn * BM + wc * 32 + 8 * fq;
#pragma unroll
        for (int ai = 0; ai < 2; ++ai)
#pragma unroll
            for (int m = 0; m < 4; ++m)
#pragma unroll
                for (int bj = 0; bj < 2; ++bj) f(row0 + ai * HALF + m * 16, col0 + bj * HALF, acc[ai][bj][m][0], acc[ai][bj][m][1]);
    }
};

template <class Epi, class Sched, bool ALIGN_EPI = false, bool SP2 = false>
__device__ __forceinline__ void gemm_phase(PG8_LAS unsigned char* lds, const Gemm g, const Sched& S, const Epi& E) {
    const int tid = tid_opaque(), wid = __builtin_amdgcn_readfirstlane(tid >> 6), lane = tid & 63, wr = wid >> 2, wc = wid & 3, fr = lane & 15, fq = lane >> 4;
    const int K = g.K, nt = K / BK;
    unsigned voffA[2], voffB[2];
#pragma unroll
    for (int i = 0; i < 2; ++i) { int R, C; stage_rc(tid * 16 + i * 8192, R, C); const int Rb = Epi::PERM ? ((R & ~31) + perm32(R & 31)) : R;
        voffA[i] = (unsigned)(R * K + C) * 2u; voffB[i] = (unsigned)(Rb * K + C) * 2u; }
    const size_t kstep = (size_t)(BK * 2);
    const size_t hstep = (size_t)HALF * K * 2;
    const size_t tstep = 2 * hstep;
    const unsigned ldsw = (unsigned)wid * 1024u;
    const int aoff = lds_byte(wr * 64 + fr, fq * 8), boff = lds_byte(wc * 32 + fr, fq * 8);
#define PG8_SA(b, h) (((b) * 2 + (h)) * HTB)
#define PG8_SB(b, h) ((4 + (b) * 2 + (h)) * HTB)
#define PG8_STAGE(bufoff, gbase, voff) do { _Pragma("unroll") for (int _i = 0; _i < 2; ++_i) \
        __builtin_amdgcn_global_load_lds((const unsigned*)((const char*)(gbase) + (voff)[_i]), (PG8_LAS unsigned*)(lds + (bufoff) + ldsw + _i * 8192), 16, 0, 0); } while (0)
#define PG8_LDA(dst, b, h) do { _Pragma("unroll") for (int m = 0; m < 4; ++m) _Pragma("unroll") for (int k = 0; k < 2; ++k) dst[m][k] = *(const PG8_LAS bf16x8*)(lds + PG8_SA(b, h) + aoff + m * 2048 + k * 1024); } while (0)
#define PG8_LDB(dst, b, h) do { _Pragma("unroll") for (int n = 0; n < 2; ++n) _Pragma("unroll") for (int k = 0; k < 2; ++k) dst[n][k] = *(const PG8_LAS bf16x8*)(lds + PG8_SB(b, h) + boff + n * 2048 + k * 1024); } while (0)
#define PG8_MMA(ai, bj, At, Bt) do { __builtin_amdgcn_s_setprio(1); _Pragma("unroll") for (int m = 0; m < 4; ++m) _Pragma("unroll") for (int n = 0; n < 2; ++n) _Pragma("unroll") for (int k = 0; k < 2; ++k) \
        acc[ai][bj][m][n] = __builtin_amdgcn_mfma_f32_16x16x32_bf16(Bt[n][k], At[m][k], acc[ai][bj][m][n], 0, 0, 0); __builtin_amdgcn_s_setprio(0); } while (0)
#define PG8_WAIT_V(n) asm volatile("s_waitcnt vmcnt(" #n ")" ::: "memory")
#define PG8_WAIT_L(n) asm volatile("s_waitcnt lgkmcnt(" #n ")" ::: "memory")
#define PG8_BAR __builtin_amdgcn_s_barrier()
#define PG8_SCHED __builtin_amdgcn_sched_barrier(0)
    Unit cur, nxt; int ui = 0;
    if (!S.next(0, cur)) return;
    f32x4 acc[2][2][4][2];
#pragma unroll
    for (int a = 0; a < 2; ++a)
#pragma unroll
        for (int b = 0; b < 2; ++b)
#pragma unroll
            for (int m = 0; m < 4; ++m)
#pragma unroll
                for (int n = 0; n < 2; ++n) acc[a][b][m][n] = (f32x4){0.f, 0.f, 0.f, 0.f};
    bf16x8 At[4][2], B0[2][2], B1[2][2];
    const char* cA = (const char*)g.A + (size_t)cur.pm * tstep; const char* cB = (const char*)g.Bt + (size_t)cur.pn * tstep;
    S.a_ready(cur);
    if constexpr (SP2) {
        PG8_STAGE(PG8_SB(0, 0), cB, voffB); PG8_STAGE(PG8_SB(0, 1), cB + hstep, voffB); PG8_STAGE(PG8_SA(0, 0), cA, voffA); PG8_STAGE(PG8_SA(0, 1), cA + hstep, voffA);
        if (wr == 1) PG8_BAR;
        PG8_WAIT_V(2); PG8_BAR;
        PG8_STAGE(PG8_SB(1, 0), cB + kstep, voffB); PG8_STAGE(PG8_SA(1, 0), cA + kstep, voffA); PG8_STAGE(PG8_SB(1, 1), cB + hstep + kstep, voffB);
        PG8_WAIT_V(6); PG8_BAR;
    } else {
        PG8_STAGE(PG8_SB(0, 0), cB, voffB); PG8_STAGE(PG8_SA(0, 0), cA, voffA); PG8_STAGE(PG8_SB(0, 1), cB + hstep, voffB); PG8_STAGE(PG8_SA(0, 1), cA + hstep, voffA);
        if (wr == 1) PG8_BAR;
        PG8_WAIT_V(4); PG8_BAR;
        PG8_STAGE(PG8_SB(1, 0), cB + kstep, voffB); PG8_STAGE(PG8_SA(1, 0), cA + kstep, voffA); PG8_STAGE(PG8_SB(1, 1), cB + hstep + kstep, voffB);
        PG8_WAIT_V(6); PG8_BAR;
    }
    for (;;) {
        const bool has_next = S.next(ui + 1, nxt);
        const char* nA = has_next ? (const char*)g.A + (size_t)nxt.pm * tstep : cA; const char* nB = has_next ? (const char*)g.Bt + (size_t)nxt.pn * tstep : cB;
        for (int t = 0; t < nt; t += 2) {
            const bool last = (t == nt - 2);
            const char* a1 = cA + (size_t)(t + 1) * kstep;
            const char* a2 = last ? nA : cA + (size_t)(t + 2) * kstep; const char* b2 = last ? nB : cB + (size_t)(t + 2) * kstep;
            const char* a3 = a2 + kstep; const char* b3 = b2 + kstep;
            if (last && has_next) S.a_ready(nxt);
            if constexpr (SP2) {
            PG8_LDB(B0, 0, 0); PG8_LDB(B1, 0, 1); PG8_SCHED; PG8_LDA(At, 0, 0); PG8_STAGE(PG8_SA(1, 1), a1 + hstep, voffA);
            PG8_WAIT_V(8); PG8_WAIT_L(0); PG8_BAR; PG8_MMA(0, 0, At, B0); PG8_MMA(0, 1, At, B1); PG8_BAR; PG8_SCHED;
            PG8_LDA(At, 0, 1); PG8_STAGE(PG8_SB(0, 0), b2, voffB); PG8_STAGE(PG8_SB(0, 1), b2 + hstep, voffB); PG8_STAGE(PG8_SA(0, 0), a2, voffA);
            PG8_WAIT_V(8); PG8_WAIT_L(0); PG8_BAR; PG8_MMA(1, 0, At, B0); PG8_MMA(1, 1, At, B1); PG8_BAR; PG8_SCHED;
            PG8_LDB(B0, 1, 0); PG8_LDB(B1, 1, 1); PG8_SCHED; PG8_LDA(At, 1, 0); PG8_STAGE(PG8_SA(0, 1), a2 + hstep, voffA);
            PG8_WAIT_V(8); PG8_WAIT_L(0); PG8_BAR; PG8_MMA(0, 0, At, B0); PG8_MMA(0, 1, At, B1); PG8_BAR; PG8_SCHED;
            PG8_LDA(At, 1, 1); PG8_STAGE(PG8_SB(1, 0), b3, voffB); PG8_STAGE(PG8_SB(1, 1), b3 + hstep, voffB); PG8_STAGE(PG8_SA(1, 0), a3, voffA);
            PG8_WAIT_V(8); PG8_WAIT_L(0); PG8_BAR; PG8_MMA(1, 0, At, B0); PG8_MMA(1, 1, At, B1); PG8_BAR; PG8_SCHED;
            } else {
            PG8_LDB(B0, 0, 0); PG8_SCHED; PG8_LDA(At, 0, 0); PG8_STAGE(PG8_SA(1, 1), a1 + hstep, voffA);
            PG8_WAIT_L(8); PG8_BAR; PG8_WAIT_L(0); PG8_MMA(0, 0, At, B0); PG8_BAR; PG8_SCHED;
            PG8_LDB(B1, 0, 1); PG8_STAGE(PG8_SB(0, 0), b2, voffB);
            PG8_BAR; PG8_WAIT_L(0); PG8_MMA(0, 1, At, B1); PG8_BAR;
            PG8_LDA(At, 0, 1); PG8_STAGE(PG8_SA(0, 0), a2, voffA);
            PG8_BAR; PG8_WAIT_L(0); PG8_MMA(1, 0, At, B0); PG8_BAR; PG8_SCHED;
            PG8_STAGE(PG8_SB(0, 1), b2 + hstep, voffB);
            PG8_WAIT_V(6); PG8_BAR; PG8_MMA(1, 1, At, B1); PG8_BAR;
            PG8_LDB(B0, 1, 0); PG8_SCHED; PG8_LDA(At, 1, 0); PG8_STAGE(PG8_SA(0, 1), a2 + hstep, voffA);
            PG8_WAIT_L(8); PG8_BAR; PG8_WAIT_L(0); PG8_MMA(0, 0, At, B0); PG8_BAR; PG8_SCHED;
            PG8_LDB(B1, 1, 1); PG8_STAGE(PG8_SB(1, 0), b3, voffB);
            PG8_BAR; PG8_WAIT_L(0); PG8_MMA(0, 1, At, B1); PG8_BAR;
            PG8_LDA(At, 1, 1); PG8_STAGE(PG8_SA(1, 0), a3, voffA);
            PG8_BAR; PG8_WAIT_L(0); PG8_MMA(1, 0, At, B0); PG8_BAR; PG8_SCHED;
            PG8_STAGE(PG8_SB(1, 1), b3 + hstep, voffB);
            PG8_WAIT_V(6); PG8_BAR; PG8_MMA(1, 1, At, B1); PG8_BAR;
            }
        }
        if constexpr (ALIGN_EPI) { if (wr == 0) PG8_BAR; }
        if constexpr (!Epi::AFTER_DRAIN) { E(acc, cur, wr, wc, fr, fq); S.done(cur); }
        if (!has_next) break;
#pragma unroll
        for (int a = 0; a < 2; ++a)
#pragma unroll
            for (int b = 0; b < 2; ++b)
#pragma unroll
                for (int m = 0; m < 4; ++m)
#pragma unroll
                    for (int n = 0; n < 2; ++n) acc[a][b][m][n] = (f32x4){0.f, 0.f, 0.f, 0.f};
        cur = nxt; cA = nA; cB = nB; ++ui;
        if constexpr (ALIGN_EPI) { if (wr == 1) PG8_BAR; }
    }
    PG8_WAIT_V(0);
    if constexpr (!ALIGN_EPI) { if (wr == 0) PG8_BAR; }
    PG8_BAR;
    if constexpr (Epi::AFTER_DRAIN) { E.fused(acc, cur, wr, wc, fr, fq, lds, wid, lane); S.done(cur); }
#undef PG8_SA
#undef PG8_SB
#undef PG8_STAGE
#undef PG8_LDA
#undef PG8_LDB
#undef PG8_MMA
#undef PG8_WAIT_V
#undef PG8_WAIT_L
#undef PG8_BAR
#undef PG8_SCHED
}
typedef int i32x4 __attribute__((ext_vector_type(4)));
typedef int i32x8 __attribute__((ext_vector_type(8)));
template <class Epi, class Sched, bool ALIGN_EPI = false, bool SP2 = false>
__device__ __forceinline__ void gemm_phase8(PG8_LAS unsigned char* lds, const Gemm g, const Sched& S, const Epi& E) {
    const int tid = tid_opaque(), wid = __builtin_amdgcn_readfirstlane(tid >> 6), lane = tid & 63, wr = wid >> 2, wc = wid & 3, fr = lane & 15, fq = lane >> 4;
    const int K = g.K, nt = K / BK;
    unsigned voffA[2], voffB[2];
#pragma unroll
    for (int i = 0; i < 2; ++i) { int R, C; stage_rc(tid * 16 + i * 8192, R, C); const int Rb = Epi::PERM ? ((R & ~31) + perm32(R & 31)) : R;
        voffA[i] = (unsigned)(R * K + C) * 2u; voffB[i] = (unsigned)(Rb * K + C) * 2u; }
    const size_t rstep64 = (size_t)64 * K * 2;
    const size_t kstep = (size_t)(BK * 2);
    const size_t hstep = (size_t)HALF * K * 2;
    const size_t tstep = 2 * hstep;
    const unsigned ldsw = (unsigned)wid * 1024u;
    const int aoff = lds_byte(wr * 64 + fr, fq * 8), boff = lds_byte(wc * 32 + fr, fq * 8);
#define PG8_SA(b, h) (((b) * 2 + (h)) * HTB)
#define PG8_SB(b, h) ((4 + (b) * 2 + (h)) * HTB)
#define PG8_STAGE(bufoff, gbase, voff) do { _Pragma("unroll") for (int _i = 0; _i < 2; ++_i) \
        __builtin_amdgcn_global_load_lds((const unsigned*)((const char*)(gbase) + (size_t)_i * rstep64 + (voff)[0]), (PG8_LAS unsigned*)(lds + (bufoff) + ldsw + _i * 8192), 16, 0, 0); } while (0)
#define PG8_LD32(p) __builtin_shufflevector(*(const PG8_LAS i32x4*)(p), *(const PG8_LAS i32x4*)((p) + 1024), 0, 1, 2, 3, 4, 5, 6, 7)
#define PG8_LDA(dst, b, h) do { _Pragma("unroll") for (int m = 0; m < 4; ++m) dst[m] = PG8_LD32(lds + PG8_SA(b, h) + aoff + m * 2048); } while (0)
#define PG8_LDB(dst, b, h) do { _Pragma("unroll") for (int n = 0; n < 2; ++n) dst[n] = PG8_LD32(lds + PG8_SB(b, h) + boff + n * 2048); } while (0)
#define PG8_MMA(ai, bj, At, Bt) do { __builtin_amdgcn_s_setprio(1); _Pragma("unroll") for (int m = 0; m < 4; ++m) _Pragma("unroll") for (int n = 0; n < 2; ++n) \
        acc[ai][bj][m][n] = __builtin_amdgcn_mfma_scale_f32_16x16x128_f8f6f4(Bt[n], At[m], acc[ai][bj][m][n], 0, 0, 0, 0, 0, 0);     __builtin_amdgcn_s_setprio(0); } while (0)
#define PG8_WAIT_V(n) asm volatile("s_waitcnt vmcnt(" #n ")" ::: "memory")
#define PG8_WAIT_L(n) asm volatile("s_waitcnt lgkmcnt(" #n ")" ::: "memory")
#define PG8_BAR __builtin_amdgcn_s_barrier()
#define PG8_SCHED __builtin_amdgcn_sched_barrier(0)
    Unit cur, nxt; int ui = 0;
    if (!S.next(0, cur)) return;
    f32x4 acc[2][2][4][2];
#pragma unroll
    for (int a = 0; a < 2; ++a)
#pragma unroll
        for (int b = 0; b < 2; ++b)
#pragma unroll
            for (int m = 0; m < 4; ++m)
#pragma unroll
                for (int n = 0; n < 2; ++n) acc[a][b][m][n] = (f32x4){0.f, 0.f, 0.f, 0.f};
    i32x8 At[4], B0[2], B1[2];
    const char* cA = (const char*)g.A + (size_t)cur.pm * tstep; const char* cB = (const char*)g.Bt + (size_t)cur.pn * tstep;
    S.a_ready(cur);
    if constexpr (SP2) {
        PG8_STAGE(PG8_SB(0, 0), cB, voffB); PG8_STAGE(PG8_SB(0, 1), cB + hstep, voffB); PG8_STAGE(PG8_SA(0, 0), cA, voffA); PG8_STAGE(PG8_SA(0, 1), cA + hstep, voffA);
        if (wr == 1) PG8_BAR;
        PG8_WAIT_V(2); PG8_BAR;
        PG8_STAGE(PG8_SB(1, 0), cB + kstep, voffB); PG8_STAGE(PG8_SA(1, 0), cA + kstep, voffA); PG8_STAGE(PG8_SB(1, 1), cB + hstep + kstep, voffB);
        PG8_WAIT_V(6); PG8_BAR;
    } else {
        PG8_STAGE(PG8_SB(0, 0), cB, voffB); PG8_STAGE(PG8_SA(0, 0), cA, voffA); PG8_STAGE(PG8_SB(0, 1), cB + hstep, voffB); PG8_STAGE(PG8_SA(0, 1), cA + hstep, voffA);
        if (wr == 1) PG8_BAR;
        PG8_WAIT_V(4); PG8_BAR;
        PG8_STAGE(PG8_SB(1, 0), cB + kstep, voffB); PG8_STAGE(PG8_SA(1, 0), cA + kstep, voffA); PG8_STAGE(PG8_SB(1, 1), cB + hstep + kstep, voffB);
        PG8_WAIT_V(6); PG8_BAR;
    }
    for (;;) {
        const bool has_next = S.next(ui + 1, nxt);
        const char* nA = has_next ? (const char*)g.A + (size_t)nxt.pm * tstep : cA; const char* nB = has_next ? (const char*)g.Bt + (size_t)nxt.pn * tstep : cB;
        for (int t = 0; t < nt; t += 2) {
            const bool last = (t == nt - 2);
            const char* a1 = cA + (size_t)(t + 1) * kstep;
            const char* a2 = last ? nA : cA + (size_t)(t + 2) * kstep; const char* b2 = last ? nB : cB + (size_t)(t + 2) * kstep;
            const char* a3 = a2 + kstep; const char* b3 = b2 + kstep;
            if (last && has_next) S.a_ready(nxt);
            if constexpr (SP2) {
            PG8_LDB(B0, 0, 0); PG8_LDB(B1, 0, 1); PG8_SCHED; PG8_LDA(At, 0, 0); PG8_STAGE(PG8_SA(1, 1), a1 + hstep, voffA);
            PG8_WAIT_V(8); PG8_WAIT_L(0); PG8_BAR; PG8_MMA(0, 0, At, B0); PG8_MMA(0, 1, At, B1); PG8_BAR; PG8_SCHED;
            PG8_LDA(At, 0, 1); PG8_STAGE(PG8_SB(0, 0), b2, voffB); PG8_STAGE(PG8_SB(0, 1), b2 + hstep, voffB); PG8_STAGE(PG8_SA(0, 0), a2, voffA);
            PG8_WAIT_V(8); PG8_WAIT_L(0); PG8_BAR; PG8_MMA(1, 0, At, B0); PG8_MMA(1, 1, At, B1); PG8_BAR; PG8_SCHED;
            PG8_LDB(B0, 1, 0); PG8_LDB(B1, 1, 1); PG8_SCHED; PG8_LDA(At, 1, 0); PG8_STAGE(PG8_SA(0, 1), a2 + hstep, voffA);
            PG8_WAIT_V(8); PG8_WAIT_L(0); PG8_BAR; PG8_MMA(0, 0, At, B0); PG8_MMA(0, 1, At, B1); PG8_BAR; PG8_SCHED;
            PG8_LDA(At, 1, 1); PG8_STAGE(PG8_SB(1, 0), b3, voffB); PG8_STAGE(PG8_SB(1, 1), b3 + hstep, voffB); PG8_STAGE(PG8_SA(1, 0), a3, voffA);
            PG8_WAIT_V(8); PG8_WAIT_L(0); PG8_BAR; PG8_MMA(1, 0, At, B0); PG8_MMA(1, 1, At, B1); PG8_BAR; PG8_SCHED;
            } else {
            PG8_LDB(B0, 0, 0); PG8_SCHED; PG8_LDA(At, 0, 0); PG8_STAGE(PG8_SA(1, 1), a1 + hstep, voffA);
            PG8_WAIT_L(8); PG8_BAR; PG8_WAIT_L(0); PG8_MMA(0, 0, At, B0); PG8_BAR; PG8_SCHED;
            PG8_LDB(B1, 0, 1); PG8_STAGE(PG8_SB(0, 0), b2, voffB);
            PG8_BAR; PG8_WAIT_L(0); PG8_MMA(0, 1, At, B1); PG8_BAR;
            PG8_LDA(At, 0, 1); PG8_STAGE(PG8_SA(0, 0), a2, voffA);
            PG8_BAR; PG8_WAIT_L(0); PG8_MMA(1, 0, At, B0); PG8_BAR; PG8_SCHED;
            PG8_STAGE(PG8_SB(0, 1), b2 + hstep, voffB);
            PG8_WAIT_V(6); PG8_BAR; PG8_MMA(1, 1, At, B1); PG8_BAR;
            PG8_LDB(B0, 1, 0); PG8_SCHED; PG8_LDA(At, 1, 0); PG8_STAGE(PG8_SA(0, 1), a2 + hstep, voffA);
            PG8_WAIT_L(8); PG8_BAR; PG8_WAIT_L(0); PG8_MMA(0, 0, At, B0); PG8_BAR; PG8_SCHED;
            PG8_LDB(B1, 1, 1); PG8_STAGE(PG8_SB(1, 0), b3, voffB);
            PG8_BAR; PG8_WAIT_L(0); PG8_MMA(0, 1, At, B1); PG8_BAR;
            PG8_LDA(At, 1, 1); PG8_STAGE(PG8_SA(1, 0), a3, voffA);
            PG8_BAR; PG8_WAIT_L(0); PG8_MMA(1, 0, At, B0); PG8_BAR; PG8_SCHED;
            PG8_STAGE(PG8_SB(1, 1), b3 + hstep, voffB);
            PG8_WAIT_V(6); PG8_BAR; PG8_MMA(1, 1, At, B1); PG8_BAR;
            }
        }
        if constexpr (ALIGN_EPI) { if (wr == 0) PG8_BAR; }
        if constexpr (!Epi::AFTER_DRAIN) { E(acc, cur, wr, wc, fr, fq); S.done(cur); }
        if (!has_next) break;
#pragma unroll
        for (int a = 0; a < 2; ++a)
#pragma unroll
            for (int b = 0; b < 2; ++b)
#pragma unroll
                for (int m = 0; m < 4; ++m)
#pragma unroll
                    for (int n = 0; n < 2; ++n) acc[a][b][m][n] = (f32x4){0.f, 0.f, 0.f, 0.f};
        cur = nxt; cA = nA; cB = nB; ++ui;
        if constexpr (ALIGN_EPI) { if (wr == 1) PG8_BAR; }
    }
    PG8_WAIT_V(0);
    if constexpr (!ALIGN_EPI) { if (wr == 0) PG8_BAR; }
    PG8_BAR;
    if constexpr (Epi::AFTER_DRAIN) { E.fused(acc, cur, wr, wc, fr, fq, lds, wid, lane); S.done(cur); }
#undef PG8_SA
#undef PG8_SB
#undef PG8_STAGE
#undef PG8_LDA
#undef PG8_LDB
#undef PG8_MMA
#undef PG8_LD32
#undef PG8_WAIT_V
#undef PG8_WAIT_L
#undef PG8_BAR
#undef PG8_SCHED
}
}

typedef unsigned short bf16_t;
typedef float f32x4 __attribute__((ext_vector_type(4)));
typedef unsigned u32x4 __attribute__((ext_vector_type(4)));
#define LAS __attribute__((address_space(3)))

constexpr int NT = 512;
constexpr int LDS_BYTES = 160 * 1024;
constexpr int D = 2048, NB = 4, SEQ = 4096, CTXL = 256;
constexpr int MT = NB * SEQ;
constexpr int MC = NB * CTXL;
constexpr int MA = MT + MC;
constexpr int NQKVP = 6400;
constexpr int PQ_LD = 6144;
constexpr int NHY = 6144, NZG = 6144;
constexpr int WT_ROWS = NQKVP + NHY + NZG;
constexpr int WT_HY0 = NQKVP, WT_ZG0 = NQKVP + NHY;
constexpr float ALPHA = 1.189207115002721f;

constexpr size_t MiB = (size_t)1 << 20;
constexpr size_t WS_MOD = 0, WS_HID2 = 1 * MiB, WS_SW = 2 * MiB, WS_HA = 34 * MiB, WS_WT = 102 * MiB, WS_RA = 175 * MiB, WS_RB = 367 * MiB, WS_AB = 580 * MiB, WS_END = 658 * MiB;
constexpr size_t WS_HA8 = 658 * MiB;
constexpr size_t WT8_OFF = (size_t)6144 * 2048 * 2;

struct Args { const float* in[31]; float* out; unsigned char* ws; int ph_lo, ph_hi; int reps[8]; int pad2[2]; };
typedef const __attribute__((address_space(4))) Args* KA;

__device__ __forceinline__ unsigned f2bf(float f) { unsigned u = __float_as_uint(f); return (u + 0x7fffu + ((u >> 16) & 1u)) >> 16; }
__device__ __forceinline__ unsigned pk2(float lo, float hi) { return f2bf(lo) | (f2bf(hi) << 16); }
__device__ __forceinline__ float bflo(unsigned w) { return __uint_as_float(w << 16); }
__device__ __forceinline__ float bfhi(unsigned w) { return __uint_as_float(w & 0xffff0000u); }
__device__ __forceinline__ float bf2f(bf16_t b) { return __uint_as_float(((unsigned)b) << 16); }
__device__ __forceinline__ void unpack8(const u32x4 w, float (&o)[8]) { o[0] = bflo(w.x); o[1] = bfhi(w.x); o[2] = bflo(w.y); o[3] = bfhi(w.y); o[4] = bflo(w.z); o[5] = bfhi(w.z); o[6] = bflo(w.w); o[7] = bfhi(w.w); }
__device__ __forceinline__ u32x4 pack8(const float (&v)[8]) { u32x4 w; w.x = pk2(v[0], v[1]); w.y = pk2(v[2], v[3]); w.z = pk2(v[4], v[5]); w.w = pk2(v[6], v[7]); return w; }
typedef short bf16x8 __attribute__((ext_vector_type(8)));
typedef unsigned u32x2 __attribute__((ext_vector_type(2)));
#define MFMA16(a, b, c) __builtin_amdgcn_mfma_f32_16x16x32_bf16((a), (b), (c), 0, 0, 0)
__device__ __forceinline__ u32x2 pk4(float a, float b, float c, float d) { u32x2 w; w.x = pk2(a, b); w.y = pk2(c, d); return w; }
__device__ __forceinline__ float sigmoidf_(float x) { return 1.0f / (1.0f + expf(-x)); }
__device__ __forceinline__ float siluf_(float x) { return x / (1.0f + expf(-x)); }
__device__ __forceinline__ float rdlane(float v, const int l) { return __builtin_bit_cast(float, __builtin_amdgcn_readlane(__builtin_bit_cast(int, v), l)); }
__device__ __forceinline__ float wave_sum(float v) {
    v += __builtin_bit_cast(float, __builtin_amdgcn_update_dpp(0, __builtin_bit_cast(int, v), 0x128, 0xf, 0xf, false));
    v += __builtin_bit_cast(float, __builtin_amdgcn_update_dpp(0, __builtin_bit_cast(int, v), 0x124, 0xf, 0xf, false));
    v += __builtin_bit_cast(float, __builtin_amdgcn_update_dpp(0, __builtin_bit_cast(int, v), 0x122, 0xf, 0xf, false));
    v += __builtin_bit_cast(float, __builtin_amdgcn_update_dpp(0, __builtin_bit_cast(int, v), 0x121, 0xf, 0xf, false));
    return (rdlane(v, 0) + rdlane(v, 16)) + (rdlane(v, 32) + rdlane(v, 48));
}
__device__ __forceinline__ float wave_max(float v) {
    v = fmaxf(v, __builtin_bit_cast(float, __builtin_amdgcn_update_dpp(0, __builtin_bit_cast(int, v), 0x128, 0xf, 0xf, false)));
    v = fmaxf(v, __builtin_bit_cast(float, __builtin_amdgcn_update_dpp(0, __builtin_bit_cast(int, v), 0x124, 0xf, 0xf, false)));
    v = fmaxf(v, __builtin_bit_cast(float, __builtin_amdgcn_update_dpp(0, __builtin_bit_cast(int, v), 0x122, 0xf, 0xf, false)));
    v = fmaxf(v, __builtin_bit_cast(float, __builtin_amdgcn_update_dpp(0, __builtin_bit_cast(int, v), 0x121, 0xf, 0xf, false)));
    return fmaxf(fmaxf(rdlane(v, 0), rdlane(v, 16)), fmaxf(rdlane(v, 32), rdlane(v, 48)));
}

__device__ void p0_mod_hid2(KA a, float* lf) {
    const int tid = tid_opaque(), bid = blockIdx.x;
    if (bid < 192) {
        const float* c = a->in[1]; const float* cc = a->in[3]; const float* w_ada = a->in[4]; const float* b_ada = a->in[5];
        float* mod = (float*)(a->ws + WS_MOD);
        for (int i = tid; i < 5 * 2048; i += NT) { const int r = i >> 11, k = i & 2047; const float v = (r < 4) ? c[r * 2048 + k] : cc[k]; lf[i] = siluf_(v); }
        __syncthreads();
        const int cl = tid & 63, kg = tid >> 6, col = bid * 64 + cl;
        float a0 = 0.f, a1 = 0.f, a2 = 0.f, a3 = 0.f, a4 = 0.f;
#pragma unroll 32
        for (int k = kg * 256; k < kg * 256 + 256; ++k) {
            const float w = w_ada[(size_t)k * 12288 + col];
            a0 += lf[k] * w; a1 += lf[2048 + k] * w; a2 += lf[4096 + k] * w; a3 += lf[6144 + k] * w; a4 += lf[8192 + k] * w;
        }
        float* red = lf + 5 * 2048;
        red[(kg * 5 + 0) * 64 + cl] = a0; red[(kg * 5 + 1) * 64 + cl] = a1; red[(kg * 5 + 2) * 64 + cl] = a2; red[(kg * 5 + 3) * 64 + cl] = a3; red[(kg * 5 + 4) * 64 + cl] = a4;
        __syncthreads();
        if (tid < 320) { const int r = tid >> 6; float s = 0.f;
#pragma unroll
            for (int g = 0; g < 8; ++g) s += red[(g * 5 + r) * 64 + cl];
            mod[r * 12288 + col] = s + b_ada[col]; }
        __syncthreads();
    } else {
        const float* w1 = a->in[12]; const float* b1 = a->in[13]; const float* w2 = a->in[14]; const float* b2 = a->in[15]; const float* freq = a->in[18];
        float* hid2 = (float*)(a->ws + WS_HID2);
        const int pb = (bid - 192) * 64, j = tid & 63, pl = tid >> 6;
        const float fj = freq[j];
        for (int it = 0; it < 8; ++it) {
            const int pos = pb + it * 8 + pl;
            const float tt = (float)pos * (1.0f / 4095.0f);
            float s1 = tt * w1[j];
            const float base = (6.283185307179586f / 4096.0f) * (float)pos;
            for (int e = 0; e < 16; ++e) {
                const float band = 1e-4f + (float)e * ((15.0f - 1e-4f) / 15.0f);
                const float ang = base * band;
                s1 += cosf(ang) * w1[(1 + e) * 64 + j] - sinf(ang) * w1[(17 + e) * 64 + j];
            }
            lf[pl * 64 + j] = sinf(fj * (s1 + b1[j]));
            __syncthreads();
            float s2 = 0.f;
            for (int i = 0; i < 64; ++i) s2 += lf[pl * 64 + i] * w2[i * 64 + j];
            hid2[pos * 64 + j] = sinf(fj * (s2 + b2[j]));
            __syncthreads();
        }
    }
}

__device__ void transpose_unit(const float* src, int ldn, int n0src, bf16_t* dst, int nb, int kb, float* tile) {
    const int tid = tid_opaque(), r = tid >> 4, c4 = tid & 15;
#pragma unroll
    for (int i = 0; i < 4; ++i) {
        const int kk = i * 32 + r;
        f32x4 v = (f32x4){0.f, 0.f, 0.f, 0.f};
        if (n0src >= 0) v = *(const f32x4*)(src + (size_t)(kb * 128 + kk) * ldn + n0src + c4 * 4);
        float* t = tile + kk * 65 + c4 * 4; t[0] = v.x; t[1] = v.y; t[2] = v.z; t[3] = v.w;
    }
    __syncthreads();
#pragma unroll
    for (int i = 0; i < 2; ++i) {
        const int chunk = tid + i * NT, nr = chunk >> 4, kc = chunk & 15;
        const float* t = tile + (kc * 8) * 65 + nr;
        u32x4 w; w.x = pk2(t[0], t[65]); w.y = pk2(t[130], t[195]); w.z = pk2(t[260], t[325]); w.w = pk2(t[390], t[455]);
        *(u32x4*)(dst + (size_t)(nb * 64 + nr) * 2048 + kb * 128 + kc * 8) = w;
    }
    __syncthreads();
}
__device__ __forceinline__ unsigned pk4_fp8(float a, float b, float c, float d) { int w = __builtin_amdgcn_cvt_pk_fp8_f32(a, b, 0, false); w = __builtin_amdgcn_cvt_pk_fp8_f32(c, d, w, true); return (unsigned)w; }
__device__ void transpose_unit8(const float* src, int ldn, int n0src, unsigned char* dst, int nb, int kb, float* tile) {
    const int tid = tid_opaque(), r = tid >> 4, c4 = tid & 15;
#pragma unroll
    for (int i = 0; i < 4; ++i) {
        const int kk = i * 32 + r;
        f32x4 v = (f32x4){0.f, 0.f, 0.f, 0.f};
        if (n0src >= 0) v = *(const f32x4*)(src + (size_t)(kb * 128 + kk) * ldn + n0src + c4 * 4);
        float* t = tile + kk * 65 + c4 * 4; t[0] = v.x * 64.0f; t[1] = v.y * 64.0f; t[2] = v.z * 64.0f; t[3] = v.w * 64.0f;
    }
    __syncthreads();
    {
        const int nr = tid >> 3, kc = tid & 7;
        const float* t = tile + (kc * 16) * 65 + nr;
        u32x4 w;
        w.x = pk4_fp8(t[0], t[65], t[130], t[195]); w.y = pk4_fp8(t[260], t[325], t[390], t[455]);
        w.z = pk4_fp8(t[520], t[585], t[650], t[715]); w.w = pk4_fp8(t[780], t[845], t[910], t[975]);
        *(u32x4*)(dst + (size_t)(nb * 64 + nr) * 2048 + kb * 128 + kc * 16) = w;
    }
    __syncthreads();
}
__device__ __forceinline__ int win_colmap(int np) {
    if (np < 6144) return np;
    if (np < 6208) return 8192 + (np - 6144);
    if (np < 6400) return -1;
    if (np < 12544) return 8256 + (np - 6400);
    if (np < 14592) return 6144 + (np - 12544);
    return 14400 + (np - 14592);
}
struct TrUnit { const float* src; int ldn, n0src, nb, kb, fp8; unsigned char* dst; };
__device__ __forceinline__ TrUnit tr_unit_of(KA a, int u) {
    bf16_t* WT = (bf16_t*)(a->ws + WS_WT); bf16_t* SW = (bf16_t*)(a->ws + WS_SW);
    const int NU_WT = (WT_ROWS / 64) * 16;
    TrUnit t;
    if (u < NU_WT) { const int nb = u >> 4; t.kb = u & 15; t.src = a->in[6]; t.ldn = 18496; t.n0src = win_colmap(nb * 64);
        if (nb >= 100 && nb < 196) { t.fp8 = 0; t.dst = (unsigned char*)WT; t.nb = nb - 100; }
        else { t.fp8 = 1; t.dst = (unsigned char*)WT + WT8_OFF; t.nb = nb < 100 ? nb : nb - 96; } }
    else { const int v = u - NU_WT, mtx = v >> 9; t.nb = (v >> 4) & 31; t.kb = v & 15; t.fp8 = 0; t.ldn = 2048; t.n0src = t.nb * 64;
        t.src = (mtx == 0) ? a->in[20] : (mtx == 1) ? a->in[21] : (mtx == 2) ? a->in[22] : a->in[25]; t.dst = (unsigned char*)(SW + (size_t)mtx * 2048 * 2048); }
    return t;
}
__device__ void p0_transposes(KA a, float* lf) {
    const int NU = (WT_ROWS / 64) * 16 + 3 * 32 * 16;
    const int tid = tid_opaque(), r = tid >> 4, c4 = tid & 15;
    int u = blockIdx.x;
    f32x4 pre[4];
    if (u < NU) { const TrUnit t = tr_unit_of(a, u);
#pragma unroll
        for (int i = 0; i < 4; ++i) pre[i] = (t.n0src >= 0) ? *(const f32x4*)(t.src + (size_t)(t.kb * 128 + i * 32 + r) * t.ldn + t.n0src + c4 * 4) : (f32x4){0.f, 0.f, 0.f, 0.f}; }
    __syncthreads();
#pragma unroll 1
    for (int k = 0; u < NU; ++k, u += gridDim.x) {
        const TrUnit t = tr_unit_of(a, u);
        float* tile = lf + (k & 1) * (128 * 65);
        const float sc = t.fp8 ? 64.0f : 1.0f;
#pragma unroll
        for (int i = 0; i < 4; ++i) { float* tp = tile + (i * 32 + r) * 65 + c4 * 4; tp[0] = pre[i].x * sc; tp[1] = pre[i].y * sc; tp[2] = pre[i].z * sc; tp[3] = pre[i].w * sc; }
        __syncthreads();
        const int un = u + gridDim.x;
        if (un < NU) { const TrUnit tn = tr_unit_of(a, un);
#pragma unroll
            for (int i = 0; i < 4; ++i) pre[i] = (tn.n0src >= 0) ? *(const f32x4*)(tn.src + (size_t)(tn.kb * 128 + i * 32 + r) * tn.ldn + tn.n0src + c4 * 4) : (f32x4){0.f, 0.f, 0.f, 0.f}; }
        if (t.fp8) {
            const int nr = tid >> 3, kc = tid & 7;
            const float* tp = tile + (kc * 16) * 65 + nr;
            u32x4 w;
            w.x = pk4_fp8(tp[0], tp[65], tp[130], tp[195]); w.y = pk4_fp8(tp[260], tp[325], tp[390], tp[455]);
            w.z = pk4_fp8(tp[520], tp[585], tp[650], tp[715]); w.w = pk4_fp8(tp[780], tp[845], tp[910], tp[975]);
            *(u32x4*)(t.dst + (size_t)(t.nb * 64 + nr) * 2048 + t.kb * 128 + kc * 16) = w;
        } else {
#pragma unroll
            for (int i = 0; i < 2; ++i) {
                const int chunk = tid + i * NT, nr = chunk >> 4, kc = chunk & 15;
                const float* tp = tile + (kc * 8) * 65 + nr;
                u32x4 w; w.x = pk2(tp[0], tp[65]); w.y = pk2(tp[130], tp[195]); w.z = pk2(tp[260], tp[325]); w.w = pk2(tp[390], tp[455]);
                *(u32x4*)((bf16_t*)t.dst + (size_t)(t.nb * 64 + nr) * 2048 + t.kb * 128 + kc * 8) = w;
            }
        }
    }
    __syncthreads();
}

__device__ void p1_ha(KA a) {
    const float* mod = (const float*)(a->ws + WS_MOD); bf16_t* HA = (bf16_t*)(a->ws + WS_HA); unsigned char* HA8 = a->ws + WS_HA8;
    const size_t nthr = (size_t)gridDim.x * NT;
    for (size_t i = (size_t)blockIdx.x * NT + tid_opaque(); i < (size_t)MA * 128; i += nthr) {
        const int row = (int)(i >> 7), k16 = (int)(i & 127) * 16;
        const float* sp; int mr;
        if (row < MT) { sp = a->in[0] + (size_t)row * 2048 + k16; mr = row >> 12; } else { sp = a->in[2] + (size_t)(row - MT) * 2048 + k16; mr = 4; }
        const float* mp = mod + mr * 12288 + k16;
        u32x4 w8, wlo, whi;
#pragma unroll
        for (int j = 0; j < 4; ++j) {
            const f32x4 x = *(const f32x4*)(sp + j * 4), hh = *(const f32x4*)(mp + j * 4), ss = *(const f32x4*)(mp + 2048 + j * 4);
            const float v0 = x[0] * (1.0f + ss[0]) + hh[0], v1 = x[1] * (1.0f + ss[1]) + hh[1], v2 = x[2] * (1.0f + ss[2]) + hh[2], v3 = x[3] * (1.0f + ss[3]) + hh[3];
            w8[j] = pk4_fp8(v0, v1, v2, v3);
            if (j < 2) { wlo[2 * j] = pk2(v0, v1); wlo[2 * j + 1] = pk2(v2, v3); } else { whi[2 * (j - 2)] = pk2(v0, v1); whi[2 * (j - 2) + 1] = pk2(v2, v3); }
        }
        if (row < MT) { *(u32x4*)(HA + (size_t)row * 2048 + k16) = wlo; *(u32x4*)(HA + (size_t)row * 2048 + k16 + 8) = whi; }
        *(u32x4*)(HA8 + (size_t)row * 2048 + k16) = w8;
    }
}

struct FStoreBf16 { bf16_t* O; int ldc; float sc;
    __device__ __forceinline__ void operator()(int row, int col, const f32x4 a0, const f32x4 a1) const {
        const f32x4 v0 = a0 * sc, v1 = a1 * sc;
        u32x4 w; w.x = pg8::cvt_pk_bf16(v0[0], v0[1]); w.y = pg8::cvt_pk_bf16(v0[2], v0[3]); w.z = pg8::cvt_pk_bf16(v1[0], v1[1]); w.w = pg8::cvt_pk_bf16(v1[2], v1[3]);
        *(u32x4*)(O + (size_t)row * ldc + col) = w; } };
struct FStoreQKV { bf16_t* PQ; float* AB; float sc;
    __device__ __forceinline__ void operator()(int row, int col, const f32x4 a0, const f32x4 a1) const {
        const f32x4 v0 = a0 * sc, v1 = a1 * sc;
        if (col < 6144) { u32x4 w; w.x = pg8::cvt_pk_bf16(v0[0], v0[1]); w.y = pg8::cvt_pk_bf16(v0[2], v0[3]); w.z = pg8::cvt_pk_bf16(v1[0], v1[1]); w.w = pg8::cvt_pk_bf16(v1[2], v1[3]);
            *(u32x4*)(PQ + (size_t)row * PQ_LD + col) = w; }
        else if (col < 6208) { float* p = AB + (size_t)row * 64 + (col - 6144); *(f32x4*)p = v0; *(f32x4*)(p + 4) = v1; } } };
struct FStoreF32 { float* O; int ldc;
    __device__ __forceinline__ void operator()(int row, int col, const f32x4 v0, const f32x4 v1) const { float* p = O + (size_t)row * ldc + col; *(f32x4*)p = v0; *(f32x4*)(p + 4) = v1; } };
struct FGatePA { const bf16_t* ZG; bf16_t* MG;
    __device__ __forceinline__ void operator()(int row, int col, const f32x4 v0, const f32x4 v1) const {
        float g[8]; unpack8(*(const u32x4*)(ZG + (size_t)row * NZG + 2048 + col), g);
        float o[8];
#pragma unroll
        for (int e = 0; e < 4; ++e) { o[e] = sigmoidf_(g[e]) * v0[e]; o[4 + e] = sigmoidf_(g[4 + e]) * v1[e]; }
        *(u32x4*)(MG + (size_t)row * 2048 + col) = pack8(o); } };
struct FGatePH { const bf16_t* ZG; bf16_t* MG;
    __device__ __forceinline__ void operator()(int row, int col, const f32x4 v0, const f32x4 v1) const {
        float g[8], t[8]; unpack8(*(const u32x4*)(ZG + (size_t)row * NZG + 4096 + col), g); unpack8(*(const u32x4*)(MG + (size_t)row * 2048 + col), t);
        float o[8];
#pragma unroll
        for (int e = 0; e < 4; ++e) { o[e] = t[e] + sigmoidf_(g[e]) * v0[e]; o[4 + e] = t[4 + e] + sigmoidf_(g[4 + e]) * v1[e]; }
        *(u32x4*)(MG + (size_t)row * 2048 + col) = pack8(o); } };
struct FOut { const float* x; const float* mod; float* T3;
    __device__ __forceinline__ void operator()(int row, int col, const f32x4 v0, const f32x4 v1) const {
        const float* xp = x + (size_t)row * 2048 + col; const float* gp = mod + (row >> 12) * 12288 + 4096 + col;
        const f32x4 x0 = *(const f32x4*)xp, x1 = *(const f32x4*)(xp + 4), g0 = *(const f32x4*)gp, g1 = *(const f32x4*)(gp + 4);
        float* p = T3 + (size_t)row * 2048 + col;
#if DBG_MODE == 1
        *(f32x4*)p = ALPHA * x0; *(f32x4*)(p + 4) = ALPHA * x1;
#else
        *(f32x4*)p = ALPHA * x0 + g0 * v0; *(f32x4*)(p + 4) = ALPHA * x1 + g1 * v1;
#endif
    } };

template <class F> __device__ __forceinline__ void run_gemm8(unsigned char* lds, const unsigned char* A8, const unsigned char* Bt8, int M, int N, const F& f) {
    pg8::Gemm g{(const bf16_t*)A8, (const bf16_t*)Bt8, M, N, 1024}; pg8::StaticOrder S; S.init(M, N, (int)gridDim.x, (int)blockIdx.x);
    pg8::EpiGen<F> E{f};
    pg8::gemm_phase8<pg8::EpiGen<F>, pg8::StaticOrder, true, true>((PG8_LAS unsigned char*)lds, g, S, E);
}
template <class F> __device__ __forceinline__ void run_gemm(unsigned char* lds, const bf16_t* A, const bf16_t* Bt, int M, int N, const F& f) {
    pg8::Gemm g{A, Bt, M, N, 2048}; pg8::StaticOrder S; S.init(M, N, (int)gridDim.x, (int)blockIdx.x);
    pg8::EpiGen<F> E{f};
    pg8::gemm_phase<pg8::EpiGen<F>, pg8::StaticOrder, true, true>((PG8_LAS unsigned char*)lds, g, S, E);
}

typedef float f32x2 __attribute__((ext_vector_type(2)));
constexpr int HY_Z = 0, HY_F = 69632, HY_TW4 = 139264, HY_TW8 = 141312, HY_TW32 = 143360, HY_W3 = 143488;
__device__ __forceinline__ f32x2 cmul(const f32x2 a, const f32x2 b) { return (f32x2){a.x * b.x - a.y * b.y, a.x * b.y + a.y * b.x}; }
__device__ __forceinline__ f32x2 cmulc(const f32x2 a, const f32x2 b) { return (f32x2){a.x * b.x + a.y * b.y, a.y * b.x - a.x * b.y}; }
template <bool INV> __device__ __forceinline__ f32x2 ctw(const f32x2 v, const float wr, const float wi) {
    return INV ? (f32x2){v.x * wr + v.y * wi, v.y * wr - v.x * wi} : (f32x2){v.x * wr - v.y * wi, v.y * wr + v.x * wi};
}
template <bool INV> __device__ __forceinline__ void dft16(f32x2 (&x)[16]) {
    constexpr float C = 0.9238795325112867f, S = 0.3826834323650898f, R = 0.7071067811865476f;
    f32x2 A[4][4];
#pragma unroll
    for (int q0 = 0; q0 < 4; ++q0) {
        const f32x2 a = x[q0], b = x[4 + q0], c = x[8 + q0], d = x[12 + q0];
        const f32x2 t0 = a + c, t1 = a - c, t2 = b + d, t3 = b - d;
        const f32x2 m = (f32x2){t3.y, -t3.x};
        A[q0][0] = t0 + t2; A[q0][2] = t0 - t2;
        A[q0][1] = INV ? (t1 - m) : (t1 + m); A[q0][3] = INV ? (t1 + m) : (t1 - m);
    }
    A[1][1] = ctw<INV>(A[1][1], C, -S); A[1][2] = ctw<INV>(A[1][2], R, -R); A[1][3] = ctw<INV>(A[1][3], S, -C);
    A[2][1] = ctw<INV>(A[2][1], R, -R); A[2][2] = ctw<INV>(A[2][2], 0.f, -1.f); A[2][3] = ctw<INV>(A[2][3], -R, -R);
    A[3][1] = ctw<INV>(A[3][1], S, -C); A[3][2] = ctw<INV>(A[3][2], -R, -R); A[3][3] = ctw<INV>(A[3][3], -C, S);
#pragma unroll
    for (int s = 0; s < 4; ++s) {
        const f32x2 t0 = A[0][s] + A[2][s], t1 = A[0][s] - A[2][s], t2 = A[1][s] + A[3][s], t3 = A[1][s] - A[3][s];
        const f32x2 m = (f32x2){t3.y, -t3.x};
        x[s] = t0 + t2; x[s + 8] = t0 - t2;
        x[s + 4] = INV ? (t1 - m) : (t1 + m); x[s + 12] = INV ? (t1 + m) : (t1 - m);
    }
}
template <bool INV> __device__ __forceinline__ void apply_tw(f32x2 (&x)[16], const f32x2 w) {
    f32x2 wr = w;
#pragma unroll
    for (int r = 1; r < 16; ++r) { x[r] = INV ? cmulc(x[r], wr) : cmul(x[r], wr); if (r < 15) wr = cmul(wr, w); }
}
__device__ __forceinline__ void fft_pass2_fwd(f32x2* B, int t, const f32x2* TW4) {
    const int base = 272 * (t >> 4) + (t & 15); f32x2 x[16];
#pragma unroll
    for (int q = 0; q < 16; ++q) x[q] = B[base + 17 * q];
    dft16<false>(x); apply_tw<false>(x, TW4[16 * (t & 15)]);
#pragma unroll
    for (int q = 0; q < 16; ++q) B[base + 17 * q] = x[q];
}
__device__ __forceinline__ void fft_pass2_inv(f32x2* B, int t, const f32x2* TW4) {
    const int base = 272 * (t >> 4) + (t & 15); f32x2 x[16];
#pragma unroll
    for (int q = 0; q < 16; ++q) x[q] = B[base + 17 * q];
    apply_tw<true>(x, TW4[16 * (t & 15)]); dft16<true>(x);
#pragma unroll
    for (int q = 0; q < 16; ++q) B[base + 17 * q] = x[q];
}
__device__ __forceinline__ float conv3_lane(float c, int lane, float w0, float w1, float w2) {
    (void)lane;
    const float up = __builtin_bit_cast(float, __builtin_amdgcn_update_dpp(0, __builtin_bit_cast(int, c), 0x138, 0xf, 0xf, true));
    const float dn = __builtin_bit_cast(float, __builtin_amdgcn_update_dpp(0, __builtin_bit_cast(int, c), 0x130, 0xf, 0xf, true));
    return w0 * up + w1 * c + w2 * dn;
}
constexpr size_t WS_FILT = 585 * MiB;
__device__ void filt_unit(KA a, int unit, unsigned char* lds) {
    const int tid = tid_opaque(), lane = tid & 63, w = tid >> 6, fr = lane & 15, fq = lane >> 4;
    const int c0 = (unit >> 3) * 64, pc = (unit & 7) * 512;
    bf16_t* Bt = (bf16_t*)lds;
    const float* w3 = a->in[16]; const float* b3 = a->in[17]; const float* hid2 = (const float*)(a->ws + WS_HID2);
    bf16_t* FILT = (bf16_t*)(a->ws + WS_FILT);
    __syncthreads();
#pragma unroll
    for (int i = 0; i < 8; ++i) {
        const int idx = tid + i * NT, k = idx >> 6, q = (idx >> 4) & 3, c4 = idx & 15;
        const f32x4 v = *(const f32x4*)(w3 + (size_t)k * 8192 + (q >> 1) * 4096 + (q & 1) * 2048 + c0 + c4 * 4);
        bf16_t* bp = Bt + (q * 64 + c4 * 4) * 72 + k;
        bp[0] = (bf16_t)f2bf(v.x); bp[72] = (bf16_t)f2bf(v.y); bp[144] = (bf16_t)f2bf(v.z); bp[216] = (bf16_t)f2bf(v.w);
    }
    __syncthreads();
#pragma unroll 1
    for (int it = 0; it < 4; ++it) {
        const int p0 = pc + (it * 8 + w) * 16;
        bf16x8 af[2];
#pragma unroll
        for (int kk = 0; kk < 2; ++kk) { const float* hp = hid2 + (size_t)(p0 + fr) * 64 + kk * 32 + fq * 8; const f32x4 x0 = *(const f32x4*)hp, x1 = *(const f32x4*)(hp + 4);
            u32x4 wv; wv.x = pk2(x0[0], x0[1]); wv.y = pk2(x0[2], x0[3]); wv.z = pk2(x1[0], x1[1]); wv.w = pk2(x1[2], x1[3]); af[kk] = __builtin_bit_cast(bf16x8, wv); }
#pragma unroll 4
        for (int n = 0; n < 16; ++n) {
            f32x4 acc = (f32x4){0.f, 0.f, 0.f, 0.f};
#pragma unroll
            for (int kk = 0; kk < 2; ++kk) acc = MFMA16(af[kk], *(const bf16x8*)(Bt + (n * 16 + fr) * 72 + kk * 32 + fq * 8), acc);
            const int q = n >> 2, c = c0 + (n & 3) * 16 + fr;
            const float bias = b3[(q >> 1) * 4096 + (q & 1) * 2048 + c];
            const float dl = (3.0701134573253944f + 12.280453829301578f * ((float)c * (1.0f / 2047.0f))) * (1.0f / 4095.0f);
            const int pos = p0 + 4 * fq;
            const float e0 = expf(-(float)pos * dl), e1 = expf(-(float)(pos + 1) * dl), e2 = expf(-(float)(pos + 2) * dl), e3 = expf(-(float)(pos + 3) * dl);
            *(u32x2*)(FILT + ((size_t)c * 4 + q) * 4096 + pos) = pk4((acc[0] + bias) * e0, (acc[1] + bias) * e1, (acc[2] + bias) * e2, (acc[3] + bias) * e3);
        }
    }
}
__device__ void wprime_unit(KA a, int unit, unsigned char* lds) {
    const int tid = tid_opaque(), lane = tid & 63, w = tid >> 6, fr = lane & 15, fq = lane >> 4;
    const int hp = unit >> 4, kb = unit & 15;
    bf16_t* Aw = (bf16_t*)lds; bf16_t* Bs = (bf16_t*)(lds + 34816);
    const float* wq = a->in[25]; const float* subk = a->in[26];
    bf16_t* WPT = (bf16_t*)(a->ws + WS_SW) + (size_t)3 * D * D;
    __syncthreads();
#pragma unroll
    for (int i = 0; i < 8; ++i) {
        const int idx = tid + i * NT, r = idx >> 5, c4 = (idx & 31) * 4;
        const f32x4 va = *(const f32x4*)(wq + (size_t)(kb * 128 + r) * 2048 + hp * 128 + c4);
        const f32x4 vb = *(const f32x4*)(subk + (size_t)(hp * 128 + r) * 128 + c4);
        *(u32x2*)(Aw + r * 136 + c4) = pk4(va[0], va[1], va[2], va[3]); *(u32x2*)(Bs + r * 136 + c4) = pk4(vb[0], vb[1], vb[2], vb[3]);
    }
    __syncthreads();
    bf16x8 af[4];
#pragma unroll
    for (int kk = 0; kk < 4; ++kk) af[kk] = *(const bf16x8*)(Aw + (w * 16 + fr) * 136 + kk * 32 + fq * 8);
#pragma unroll
    for (int nt = 0; nt < 8; ++nt) {
        f32x4 acc = (f32x4){0.f, 0.f, 0.f, 0.f};
#pragma unroll
        for (int kk = 0; kk < 4; ++kk) acc = MFMA16(af[kk], *(const bf16x8*)(Bs + (nt * 16 + fr) * 136 + kk * 32 + fq * 8), acc);
        *(u32x2*)(WPT + (size_t)(hp * 128 + nt * 16 + fr) * 2048 + kb * 128 + w * 16 + 4 * fq) = pk4(acc[0], acc[1], acc[2], acc[3]);
    }
}
__device__ void hyena_setup(unsigned char* lds) {
    const int tid = tid_opaque();
    f32x2* TW4 = (f32x2*)(lds + HY_TW4); f32x2* TW8 = (f32x2*)(lds + HY_TW8); f32x2* TW32 = (f32x2*)(lds + HY_TW32);
    if (tid < 256) { const float a4 = -6.283185307179586f * (float)tid * (1.0f / 4096.0f), a8 = -6.283185307179586f * (float)tid * (1.0f / 8192.0f);
        TW4[tid] = (f32x2){cosf(a4), sinf(a4)}; TW8[tid] = (f32x2){cosf(a8), sinf(a8)}; }
    if (tid < 16) { const float a = -6.283185307179586f * (float)tid * (1.0f / 32.0f); TW32[tid] = (f32x2){cosf(a), sinf(a)}; }
    __syncthreads();
}
struct HyCtx { f32x2* Z; f32x2* Fb0; const f32x2* TW4; const f32x2* TW32; const bf16_t* rv; const bf16_t* rx1; const bf16_t* rx2; bf16_t* YTc; float* Y1S;
    f32x2 w8t, w4t; float cv0, cv1, cv2, cx0, cx1, cx2, cy0, cy1, cy2, sk0, sk1; int tid, br, t, lane, p1; };
template <int ORDER> __device__ __forceinline__ void hyena_conv(const HyCtx& K, int pr) {
    f32x2* Z = K.Z; const f32x2* TW4 = K.TW4; const f32x2* TW32 = K.TW32;
    const bf16_t* rv = K.rv; const bf16_t* rx1 = K.rx1; const bf16_t* rx2 = K.rx2; float* Y1S = K.Y1S;
    int tid = K.tid; asm volatile("" : "+v"(tid));
    const f32x2 w8t = K.w8t, w4t = K.w4t; const int br = tid >> 8, t = tid & 255, lane = tid & 63, p1 = t + (t >> 4);
    f32x2* Zb = K.Z + br * 4352; f32x2* Fb = K.Fb0 + br * 4352;
    const float cv0 = K.cv0, cv1 = K.cv1, cv2 = K.cv2, cx0 = K.cx0, cx1 = K.cx1, cx2 = K.cx2, cy0 = K.cy0, cy1 = K.cy1, cy2 = K.cy2, sk0 = K.sk0, sk1 = K.sk1;
        const int ba = 2 * pr * 4096, bb = ba + 4096;
        {
            f32x2 x[16];
#pragma unroll
            for (int q = 0; q < 16; ++q) {
                const int n = t + 256 * q; float ua, ub;
                if (ORDER == 0) { ua = conv3_lane(bf2f(rv[ba + n]), lane, cv0, cv1, cv2); ub = conv3_lane(bf2f(rv[bb + n]), lane, cv0, cv1, cv2); }
                else { ua = Y1S[n]; ub = Y1S[4096 + n]; }
                const f32x2 z = (f32x2){ua, ub};
                x[q] = br ? cmul(z, cmul(w8t, TW32[q])) : z;
            }
            dft16<false>(x); apply_tw<false>(x, w4t);
#pragma unroll
            for (int q = 0; q < 16; ++q) Zb[p1 + 272 * q] = x[q];
        }
        __syncthreads();
        fft_pass2_fwd(Zb, t, TW4);
        __syncthreads();
        {
            f32x2 x[16];
#pragma unroll
            for (int q = 0; q < 16; ++q) x[q] = Zb[17 * t + q];
            dft16<false>(x);
#pragma unroll
            for (int r = 0; r < 16; ++r) {
                const int p = 16 * t + r; int pp;
                if (br) pp = 4095 - p;
                else { const int m = (r << 8) | ((t & 15) << 4) | (t >> 4); const int mp = (4096 - m) & 4095; pp = ((mp & 15) << 8) | (mp & 0xF0) | (mp >> 8); }
                const f32x2 fk = Fb[p + (p >> 4)], fc = Fb[pp + (pp >> 4)];
                f32x2 H;
                if (ORDER == 0) H = (f32x2){0.5f * (fk.x + fc.x), 0.5f * (fk.y - fc.y)};
                else H = (f32x2){0.5f * (fk.y + fc.y), -0.5f * (fk.x - fc.x)};
                x[r] = cmul(x[r], H);
            }
            dft16<true>(x);
#pragma unroll
            for (int q = 0; q < 16; ++q) Zb[17 * t + q] = x[q];
        }
        __syncthreads();
        fft_pass2_inv(Zb, t, TW4);
        __syncthreads();
        {
            f32x2 x[16];
#pragma unroll
            for (int q = 0; q < 16; ++q) x[q] = Zb[p1 + 272 * q];
            apply_tw<true>(x, w4t); dft16<true>(x);
            if (br) {
#pragma unroll
                for (int q = 0; q < 16; ++q) x[q] = cmulc(x[q], cmul(w8t, TW32[q]));
            }
#pragma unroll
            for (int q = 0; q < 16; ++q) Zb[p1 + 272 * q] = x[q];
        }
        __syncthreads();
        {
            float in0[8], in1[8], in2[8], in3[8];
#pragma unroll
            for (int i = 0; i < 8; ++i) {
                const int n = tid + i * NT;
                if (ORDER == 0) { in0[i] = bf2f(rv[ba + n]); in1[i] = bf2f(rv[bb + n]); in2[i] = bf2f(rx1[ba + n]); in3[i] = bf2f(rx1[bb + n]); }
                else { in0[i] = Y1S[n]; in1[i] = Y1S[4096 + n]; in2[i] = bf2f(rx2[ba + n]); in3[i] = bf2f(rx2[bb + n]); }
            }
#pragma unroll
            for (int i = 0; i < 8; ++i) {
                const int n = tid + i * NT, pn = n + (n >> 4);
                const f32x2 e0 = Z[pn], e1 = Z[4352 + pn];
                const float ca = (e0.x + e1.x) * (1.0f / 8192.0f), cb = (e0.y + e1.y) * (1.0f / 8192.0f);
                if (ORDER == 0) {
                    const float va = conv3_lane(in0[i], lane, cv0, cv1, cv2), vb = conv3_lane(in1[i], lane, cv0, cv1, cv2);
                    const float xa = conv3_lane(in2[i], lane, cx0, cx1, cx2), xb = conv3_lane(in3[i], lane, cx0, cx1, cx2);
                    Y1S[n] = xa * (ca + sk0 * va); Y1S[4096 + n] = xb * (cb + sk0 * vb);
                } else {
                    const float xa = conv3_lane(in2[i], lane, cy0, cy1, cy2), xb = conv3_lane(in3[i], lane, cy0, cy1, cy2);
                    K.YTc[ba + n] = (bf16_t)f2bf(xa * (ca + sk1 * in0[i])); K.YTc[bb + n] = (bf16_t)f2bf(xb * (cb + sk1 * in1[i]));
                }
            }
        }
        __syncthreads();
}
__device__ void hyena_item(KA a, int c, unsigned char* lds) {
    f32x2* Z = (f32x2*)(lds + HY_Z); f32x2* F = (f32x2*)(lds + HY_F);
    const f32x2* TW4 = (const f32x2*)(lds + HY_TW4); const f32x2* TW8 = (const f32x2*)(lds + HY_TW8); const f32x2* TW32 = (const f32x2*)(lds + HY_TW32);
    float* W3 = (float*)(lds + HY_W3);
    int tid = tid_opaque(); asm volatile("" : "+v"(tid));
    const int br = tid >> 8, t = tid & 255, lane = tid & 63;
    f32x2* Zb = Z + br * 4352; f32x2* Fb = F + br * 4352;
    const float* hid2 = (const float*)(a->ws + WS_HID2);
    const float* w3 = a->in[16]; const float* b3 = a->in[17]; const float* cw = a->in[11]; const float* skip = a->in[19];
    const bf16_t* PHT = (const bf16_t*)(a->ws + WS_RA);
    bf16_t* YT = (bf16_t*)a->out;
    float* Y1S = a->out + (size_t)16 * 1024 * 1024 + (size_t)blockIdx.x * 16384;
    {
        const bf16_t* fp = (const bf16_t*)(a->ws + WS_FILT) + (size_t)c * 4 * 4096 + tid * 8;
        float f0[8], f1[8], f2[8], f3[8];
        unpack8(*(const u32x4*)fp, f0); unpack8(*(const u32x4*)(fp + 4096), f1); unpack8(*(const u32x4*)(fp + 8192), f2); unpack8(*(const u32x4*)(fp + 12288), f3);
#pragma unroll
        for (int e = 0; e < 8; ++e) { Z[tid * 8 + e] = (f32x2){f0[e], f1[e]}; Z[4096 + tid * 8 + e] = (f32x2){f2[e], f3[e]}; }
    }
    __syncthreads();
    const f32x2 w8t = TW8[t], w4t = TW4[t];
    const int p1 = t + (t >> 4);
    {
        f32x2 x[16];
#pragma unroll
        for (int q = 0; q < 16; ++q) {
            const int n = t + 256 * q;
            const f32x2 av = Z[n]; f32x2 bv = Z[8192 - (n ? n : 1)]; if (n == 0) bv = (f32x2){0.f, 0.f};
            x[q] = br ? cmul(av - bv, cmul(w8t, TW32[q])) : (av + bv);
        }
        dft16<false>(x); apply_tw<false>(x, w4t);
#pragma unroll
        for (int q = 0; q < 16; ++q) Fb[p1 + 272 * q] = x[q];
    }
    __syncthreads();
    fft_pass2_fwd(Fb, t, TW4);
    __syncthreads();
    {   f32x2 x[16];
#pragma unroll
        for (int q = 0; q < 16; ++q) x[q] = Fb[17 * t + q];
        dft16<false>(x);
#pragma unroll
        for (int q = 0; q < 16; ++q) Fb[17 * t + q] = x[q];
    }
    __syncthreads();
    const float cv0 = cw[c], cv1 = cw[6144 + c], cv2 = cw[12288 + c];
    const float cx0 = cw[2048 + c], cx1 = cw[6144 + 2048 + c], cx2 = cw[12288 + 2048 + c];
    const float cy0 = cw[4096 + c], cy1 = cw[6144 + 4096 + c], cy2 = cw[12288 + 4096 + c];
    const float sk0 = skip[c], sk1 = skip[2048 + c];
    const bf16_t* rv = PHT + (size_t)c * MT; const bf16_t* rx1 = PHT + (size_t)(2048 + c) * MT; const bf16_t* rx2 = PHT + (size_t)(4096 + c) * MT;
    HyCtx K; K.Z = Z; K.Fb0 = F; K.TW4 = TW4; K.TW32 = TW32; K.rv = rv; K.rx1 = rx1; K.rx2 = rx2; K.YTc = YT + (size_t)c * MT; K.Y1S = Y1S;
    K.w8t = w8t; K.w4t = w4t; K.cv0 = cv0; K.cv1 = cv1; K.cv2 = cv2; K.cx0 = cx0; K.cx1 = cx1; K.cx2 = cx2; K.cy0 = cy0; K.cy1 = cy1; K.cy2 = cy2; K.sk0 = sk0; K.sk1 = sk1;
    K.tid = tid; K.br = br; K.t = t; K.lane = lane; K.p1 = p1;
#pragma unroll 1
    for (int pr = 0; pr < 2; ++pr) { hyena_conv<0>(K, pr); hyena_conv<1>(K, pr); }
}

constexpr int H2_ZT = 0, H2_YS = 36864, H2_F = 110592, H2_TW8 = 143360, H2_TW32 = 145408;
struct Hy2W { bf16x8 wr[2], wi[2], wn[2]; };
__device__ __forceinline__ bf16x8 h2frag(const bf16_t* plane, int row, int kk, int fq) { return *(const bf16x8*)(plane + row * 72 + kk * 32 + fq * 8); }
template <int WROLE, int CONJ> __device__ __forceinline__ void h2tile(const bf16_t* Pr, const bf16_t* Pi, int row0, const Hy2W& W, int fr, int fq, f32x4& ar, f32x4& ai) {
    ar = (f32x4){0.f, 0.f, 0.f, 0.f}; ai = (f32x4){0.f, 0.f, 0.f, 0.f};
#pragma unroll
    for (int kk = 0; kk < 2; ++kk) {
        const bf16x8 dr = h2frag(Pr, row0 + fr, kk, fq), di = h2frag(Pi, row0 + fr, kk, fq);
        if (WROLE == 0) { ar = MFMA16(dr, W.wr[kk], ar); ar = MFMA16(di, CONJ ? W.wi[kk] : W.wn[kk], ar); ai = MFMA16(dr, CONJ ? W.wn[kk] : W.wi[kk], ai); ai = MFMA16(di, W.wr[kk], ai); }
        else { ar = MFMA16(W.wr[kk], dr, ar); ar = MFMA16(CONJ ? W.wi[kk] : W.wn[kk], di, ar); ai = MFMA16(CONJ ? W.wn[kk] : W.wi[kk], dr, ai); ai = MFMA16(W.wr[kk], di, ai); }
    }
}
struct Hy2T { f32x2 t[4][4]; };
__device__ void hyena2_setup(unsigned char* lds, Hy2W& W, Hy2T& T) {
    const int tid = tid_opaque(), lane = tid & 63, fr = lane & 15, fq = lane >> 4, wt = (tid >> 6) & 3;
    f32x2* TW8 = (f32x2*)(lds + H2_TW8); f32x2* TW32 = (f32x2*)(lds + H2_TW32);
    if (tid < 256) { const float a8 = -6.283185307179586f * (float)tid * (1.0f / 8192.0f); TW8[tid] = (f32x2){cosf(a8), sinf(a8)}; }
    if (tid < 16) { const float a = -6.283185307179586f * (float)tid * (1.0f / 32.0f); TW32[tid] = (f32x2){cosf(a), sinf(a)}; }
#pragma unroll
    for (int kk = 0; kk < 2; ++kk)
#pragma unroll
        for (int j = 0; j < 8; ++j) {
            const int m = ((16 * wt + fr) * (kk * 32 + fq * 8 + j)) & 63;
            const float ang = -6.283185307179586f * (float)m * (1.0f / 64.0f), c = cosf(ang), s = sinf(ang);
            W.wr[kk][j] = (short)f2bf(c); W.wi[kk][j] = (short)f2bf(s); W.wn[kk][j] = (short)f2bf(-s);
        }
#pragma unroll
    for (int mt = 0; mt < 4; ++mt)
#pragma unroll
        for (int r = 0; r < 4; ++r) { const float ang = (float)((16 * wt + fr) * (mt * 16 + 4 * fq + r)) * (6.283185307179586f / 4096.0f); T.t[mt][r] = (f32x2){cosf(ang), sinf(ang)}; }
    __syncthreads();
}
struct Hy2Ctx { unsigned char* lds; const bf16_t* rv; const bf16_t* rx1; const bf16_t* rx2; bf16_t* YTc; float cv0, cv1, cv2, cx0, cx1, cx2, cy0, cy1, cy2, sk0, sk1; };
#define H2BAR() do { asm volatile("s_waitcnt lgkmcnt(0)" ::: "memory"); __builtin_amdgcn_s_barrier(); asm volatile("" ::: "memory"); } while (0)
template <int FMODE> __device__ __forceinline__ void h2_forward(unsigned char* lds, const Hy2W& W, const Hy2T& T, int tid) {
    const int lane = tid & 63, w = tid >> 6, br = w >> 2, wt = w & 3, fr = lane & 15, fq = lane >> 4;
    bf16_t* ZTr = (bf16_t*)(lds + H2_ZT + br * 18432); bf16_t* ZTi = ZTr + 4608;
    bf16_t* Yr = (bf16_t*)(lds + H2_YS + br * 36864); bf16_t* Yi = Yr + 4608; bf16_t* Sr = Yi + 4608; bf16_t* Si = Sr + 4608;
    unsigned* Fq = (unsigned*)(lds + H2_F) + br * 4096;
#pragma unroll
    for (int mt = 0; mt < 4; ++mt) {
        f32x4 ar, ai; h2tile<0, 0>(ZTr, ZTi, mt * 16, W, fr, fq, ar, ai);
        const int k1 = 16 * wt + fr;
        float vr[4], vi[4];
#pragma unroll
        for (int r = 0; r < 4; ++r) { const float c = T.t[mt][r].x, s = T.t[mt][r].y; vr[r] = ar[r] * c + ai[r] * s; vi[r] = ai[r] * c - ar[r] * s; }
        *(u32x2*)(Yr + k1 * 72 + mt * 16 + 4 * fq) = pk4(vr[0], vr[1], vr[2], vr[3]); *(u32x2*)(Yi + k1 * 72 + mt * 16 + 4 * fq) = pk4(vi[0], vi[1], vi[2], vi[3]);
    }
    H2BAR();
#pragma unroll
    for (int nt = 0; nt < 4; ++nt) {
        f32x4 ar, ai; h2tile<1, 0>(Yr, Yi, nt * 16, W, fr, fq, ar, ai);
        const int k1 = nt * 16 + fr;
        if (FMODE == 0) {
#pragma unroll
            for (int r = 0; r < 4; ++r) Fq[k1 + 64 * (16 * wt + 4 * fq + r)] = pk2(ar[r], ai[r]);
        } else {
            float vr[4], vi[4];
#pragma unroll
            for (int r = 0; r < 4; ++r) {
                const int k = k1 + 64 * (16 * wt + 4 * fq + r), kp = br ? (4095 - k) : ((4096 - k) & 4095);
                const unsigned fa = Fq[k], fb = Fq[kp];
                const float fkr = bflo(fa), fki = bfhi(fa), fcr = bflo(fb), fci = bfhi(fb);
                float hr, hi;
                if (FMODE == 1) { hr = 0.5f * (fkr + fcr); hi = 0.5f * (fki - fci); } else { hr = 0.5f * (fki + fci); hi = -0.5f * (fkr - fcr); }
                vr[r] = ar[r] * hr - ai[r] * hi; vi[r] = ar[r] * hi + ai[r] * hr;
            }
            *(u32x2*)(Sr + k1 * 72 + 16 * wt + 4 * fq) = pk4(vr[0], vr[1], vr[2], vr[3]); *(u32x2*)(Si + k1 * 72 + 16 * wt + 4 * fq) = pk4(vi[0], vi[1], vi[2], vi[3]);
        }
    }
    H2BAR();
}
__device__ __forceinline__ void h2_inverse(unsigned char* lds, const Hy2W& W, const Hy2T& T, int tid) {
    const int lane = tid & 63, w = tid >> 6, br = w >> 2, wt = w & 3, fr = lane & 15, fq = lane >> 4;
    const f32x2* TW8 = (const f32x2*)(lds + H2_TW8); const f32x2* TW32 = (const f32x2*)(lds + H2_TW32);
    bf16_t* ZTr = (bf16_t*)(lds + H2_ZT + br * 18432); bf16_t* ZTi = ZTr + 4608;
    bf16_t* Sr = (bf16_t*)(lds + H2_YS + br * 36864) + 9216; bf16_t* Si = Sr + 4608;
#pragma unroll
    for (int mt = 0; mt < 4; ++mt) {
        f32x4 ar, ai; h2tile<0, 1>(Sr, Si, mt * 16, W, fr, fq, ar, ai);
        const int n2 = 16 * wt + fr;
        float vr[4], vi[4];
#pragma unroll
        for (int r = 0; r < 4; ++r) { const float c = T.t[mt][r].x, s = T.t[mt][r].y; vr[r] = ar[r] * c - ai[r] * s; vi[r] = ai[r] * c + ar[r] * s; }
        *(u32x2*)(ZTr + n2 * 72 + mt * 16 + 4 * fq) = pk4(vr[0], vr[1], vr[2], vr[3]); *(u32x2*)(ZTi + n2 * 72 + mt * 16 + 4 * fq) = pk4(vi[0], vi[1], vi[2], vi[3]);
    }
    H2BAR();
    f32x2* E = (f32x2*)(lds + H2_YS);
#pragma unroll
    for (int nt = 0; nt < 4; ++nt) {
        f32x4 ar, ai; h2tile<1, 1>(ZTr, ZTi, nt * 16, W, fr, fq, ar, ai);
#pragma unroll
        for (int r = 0; r < 4; ++r) {
            const int n = 64 * (16 * wt + 4 * fq + r) + nt * 16 + fr;
            f32x2 e = (f32x2){ar[r], ai[r]};
            if (br) e = cmulc(e, cmul(TW8[n & 255], TW32[n >> 8]));
            E[br * 4096 + n] = e;
        }
    }
    H2BAR();
}
__device__ __forceinline__ void h2_pass0(unsigned char* lds, const float (&ua)[8], const float (&ub)[8], int w, int lane) {
    const f32x2* TW8 = (const f32x2*)(lds + H2_TW8); const f32x2* TW32 = (const f32x2*)(lds + H2_TW32);
    bf16_t* ZT = (bf16_t*)(lds + H2_ZT) + lane * 72 + 8 * w;
    float o0[8], o1[8];
#pragma unroll
    for (int i = 0; i < 8; ++i) { const int n = 64 * (8 * w + i) + lane; const f32x2 wv = cmul(TW8[n & 255], TW32[n >> 8]); o0[i] = ua[i] * wv.x - ub[i] * wv.y; o1[i] = ua[i] * wv.y + ub[i] * wv.x; }
    *(u32x4*)ZT = pack8(ua); *(u32x4*)(ZT + 4608) = pack8(ub); *(u32x4*)(ZT + 9216) = pack8(o0); *(u32x4*)(ZT + 13824) = pack8(o1);
}
__device__ __forceinline__ void hyena2_pair(const Hy2Ctx& K, const Hy2W& W, const Hy2T& T, int pr) {
    unsigned char* lds = K.lds;
    int tid = tid_opaque();
    const int lane = tid & 63, w = tid >> 6;
    const int ba = 2 * pr * 4096, bb = ba + 4096;
    const f32x2* E = (const f32x2*)(lds + H2_YS);
    float va[8], vb[8], xa[8], xb[8];
#pragma unroll
    for (int i = 0; i < 8; ++i) { const int n = 64 * (8 * w + i) + lane; va[i] = bf2f(K.rv[ba + n]); vb[i] = bf2f(K.rv[bb + n]); }
#pragma unroll
    for (int i = 0; i < 8; ++i) { va[i] = conv3_lane(va[i], lane, K.cv0, K.cv1, K.cv2); vb[i] = conv3_lane(vb[i], lane, K.cv0, K.cv1, K.cv2); }
    h2_pass0(lds, va, vb, w, lane);
    H2BAR();
#pragma unroll
    for (int i = 0; i < 8; ++i) { const int n = 64 * (8 * w + i) + lane; xa[i] = bf2f(K.rx1[ba + n]); xb[i] = bf2f(K.rx1[bb + n]); }
    h2_forward<1>(lds, W, T, tid);
    h2_inverse(lds, W, T, tid);
    float ya[8], yb[8];
#pragma unroll
    for (int i = 0; i < 8; ++i) {
        const int n = 64 * (8 * w + i) + lane;
        const f32x2 e0 = E[n], e1 = E[4096 + n];
        const float ca = (e0.x + e1.x) * (1.0f / 8192.0f), cb = (e0.y + e1.y) * (1.0f / 8192.0f);
        ya[i] = conv3_lane(xa[i], lane, K.cx0, K.cx1, K.cx2) * (ca + K.sk0 * va[i]); yb[i] = conv3_lane(xb[i], lane, K.cx0, K.cx1, K.cx2) * (cb + K.sk0 * vb[i]);
    }
    h2_pass0(lds, ya, yb, w, lane);
    H2BAR();
    float za[8], zb[8];
#pragma unroll
    for (int i = 0; i < 8; ++i) { const int n = 64 * (8 * w + i) + lane; za[i] = bf2f(K.rx2[ba + n]); zb[i] = bf2f(K.rx2[bb + n]); }
    h2_forward<2>(lds, W, T, tid);
    h2_inverse(lds, W, T, tid);
#pragma unroll
    for (int i = 0; i < 8; ++i) {
        const int n = 64 * (8 * w + i) + lane;
        const f32x2 e0 = E[n], e1 = E[4096 + n];
        const float ca = (e0.x + e1.x) * (1.0f / 8192.0f), cb = (e0.y + e1.y) * (1.0f / 8192.0f);
        K.YTc[ba + n] = (bf16_t)f2bf(conv3_lane(za[i], lane, K.cy0, K.cy1, K.cy2) * (ca + K.sk1 * ya[i]));
        K.YTc[bb + n] = (bf16_t)f2bf(conv3_lane(zb[i], lane, K.cy0, K.cy1, K.cy2) * (cb + K.sk1 * yb[i]));
    }
    H2BAR();
}
__device__ void hyena2_item(KA a, int c, unsigned char* lds, const Hy2W& W, const Hy2T& T) {
    int tid = tid_opaque();
    const int lane = tid & 63, w = tid >> 6;
    const float* cw = a->in[11]; const float* skip = a->in[19];
    const bf16_t* PHT = (const bf16_t*)(a->ws + WS_RA);
    {
        const bf16_t* fp = (const bf16_t*)(a->ws + WS_FILT) + (size_t)c * 4 * 4096;
        float sr[8], si[8], dr[8], di[8];
#pragma unroll
        for (int i = 0; i < 8; ++i) { const int n = 64 * (8 * w + i) + lane, m = n ? (4096 - n) : 0;
            const float a0 = bf2f(fp[n]), a1 = bf2f(fp[4096 + n]); float b0 = bf2f(fp[8192 + m]), b1 = bf2f(fp[12288 + m]);
            if (n == 0) { b0 = 0.f; b1 = 0.f; }
            sr[i] = a0 + b0; si[i] = a1 + b1; dr[i] = a0 - b0; di[i] = a1 - b1; }
        const f32x2* TW8 = (const f32x2*)(lds + H2_TW8); const f32x2* TW32 = (const f32x2*)(lds + H2_TW32);
        bf16_t* ZT = (bf16_t*)(lds + H2_ZT) + lane * 72 + 8 * w;
        float o0[8], o1[8];
#pragma unroll
        for (int i = 0; i < 8; ++i) { const int n = 64 * (8 * w + i) + lane; const f32x2 wv = cmul(TW8[n & 255], TW32[n >> 8]); o0[i] = dr[i] * wv.x - di[i] * wv.y; o1[i] = dr[i] * wv.y + di[i] * wv.x; }
        *(u32x4*)ZT = pack8(sr); *(u32x4*)(ZT + 4608) = pack8(si); *(u32x4*)(ZT + 9216) = pack8(o0); *(u32x4*)(ZT + 13824) = pack8(o1);
    }
    H2BAR();
    h2_forward<0>(lds, W, T, tid);
    Hy2Ctx K; K.lds = lds; K.rv = PHT + (size_t)c * MT; K.rx1 = PHT + (size_t)(2048 + c) * MT; K.rx2 = PHT + (size_t)(4096 + c) * MT;
    K.YTc = (bf16_t*)a->out + (size_t)c * MT;
    K.cv0 = cw[c]; K.cv1 = cw[6144 + c]; K.cv2 = cw[12288 + c]; K.cx0 = cw[2048 + c]; K.cx1 = cw[6144 + 2048 + c]; K.cx2 = cw[12288 + 2048 + c];
    K.cy0 = cw[4096 + c]; K.cy1 = cw[6144 + 4096 + c]; K.cy2 = cw[12288 + 4096 + c]; K.sk0 = skip[c]; K.sk1 = skip[2048 + c];
#pragma unroll 1
    for (int pr = 0; pr < 2; ++pr) hyena2_pair(K, W, T, pr);
}

__device__ void qkvpost_unit(KA a, int unit, unsigned char* lds) {
    const int tid = tid_opaque();
    int ntok, row0, wh;
    if (unit < 12288) { const int gr = unit / 48; wh = unit % 48; ntok = 64; row0 = gr * 64; }
    else { const int uu = unit - 12288; const int b = uu / 48; wh = uu % 48; ntok = 256; row0 = MT + b * 256; }
    const int which = wh >> 4, h = wh & 15, colbase = which * 2048 + h * 128;
    bf16_t* PQ = (bf16_t*)(a->ws + WS_RB);
    bf16_t* raw = (bf16_t*)lds; float* wl = (float*)(lds + 65536);
    const float* cwt = a->in[7];
    for (int i = tid; i < ntok * 16; i += NT) { const int r = i >> 4, c8 = i & 15; *(u32x4*)(raw + r * 128 + c8 * 8) = *(const u32x4*)(PQ + (size_t)(row0 + r) * PQ_LD + colbase + c8 * 8); }
    for (int i = tid; i < 640; i += NT) wl[i] = cwt[(i >> 7) * 6144 + colbase + (i & 127)];
    __syncthreads();
    const int r = tid >> 3, cg = tid & 7;
    for (int rb = 0; rb < ntok / 64; ++rb) {
        const int tok = rb * 64 + r;
        float v[16]; float ss = 0.f;
#pragma unroll
        for (int e = 0; e < 16; ++e) v[e] = 0.f;
#pragma unroll
        for (int j = 0; j < 5; ++j) {
            const int tt = tok + j - 2;
            if (tt >= 0 && tt < ntok) {
                float p0[8], p1[8]; unpack8(*(const u32x4*)(raw + tt * 128 + cg * 16), p0); unpack8(*(const u32x4*)(raw + tt * 128 + cg * 16 + 8), p1);
                const float* wp = wl + j * 128 + cg * 16;
#pragma unroll
                for (int e = 0; e < 8; ++e) { v[e] += wp[e] * p0[e]; v[8 + e] += wp[8 + e] * p1[e]; }
            }
        }
#pragma unroll
        for (int e = 0; e < 16; ++e) { const float s = siluf_(v[e]); v[e] = s; ss += s * s; }
        if (which < 2) {
            ss += __shfl_xor(ss, 1, 64); ss += __shfl_xor(ss, 2, 64); ss += __shfl_xor(ss, 4, 64);
            const float sc = rsqrtf(ss + 1e-6f) * (which == 0 ? 0.08838834764831845f : 1.0f);
#pragma unroll
            for (int e = 0; e < 16; ++e) v[e] *= sc;
        }
        bf16_t* op = PQ + (size_t)(row0 + tok) * PQ_LD + colbase + cg * 16;
        u32x4 w0, w1;
        w0.x = pk2(v[0], v[1]); w0.y = pk2(v[2], v[3]); w0.z = pk2(v[4], v[5]); w0.w = pk2(v[6], v[7]);
        w1.x = pk2(v[8], v[9]); w1.y = pk2(v[10], v[11]); w1.z = pk2(v[12], v[13]); w1.w = pk2(v[14], v[15]);
        *(u32x4*)op = w0; *(u32x4*)(op + 8) = w1;
    }
    __syncthreads();
}

__device__ void qkvpost_latent(KA a, unsigned char* lds) {
    const int tid = tid_opaque(), r = tid >> 3, cg = tid & 7;
    bf16_t* PQ = (bf16_t*)(a->ws + WS_RB); const float* cwt = a->in[7];
    u32x4 pre0, pre1; float pw0, pw1 = 0.f;
    int u = blockIdx.x;
    {
        const int gr = u / 48, wh = u % 48, colbase = (wh >> 4) * 2048 + (wh & 15) * 128, row0 = gr * 64;
        pre0 = *(const u32x4*)(PQ + (size_t)(row0 + (tid >> 4)) * PQ_LD + colbase + (tid & 15) * 8);
        pre1 = *(const u32x4*)(PQ + (size_t)(row0 + 32 + (tid >> 4)) * PQ_LD + colbase + (tid & 15) * 8);
        pw0 = cwt[(tid >> 7) * 6144 + colbase + (tid & 127)]; if (tid < 128) pw1 = cwt[4 * 6144 + colbase + tid];
    }
#pragma unroll 1
    for (int k = 0; u < 12288; ++k, u += gridDim.x) {
        bf16_t* raw = (bf16_t*)(lds + (k & 1) * 16384); float* wl = (float*)(lds + 32768 + (k & 1) * 2560);
        *(u32x4*)(raw + (tid >> 4) * 128 + (tid & 15) * 8) = pre0; *(u32x4*)(raw + (32 + (tid >> 4)) * 128 + (tid & 15) * 8) = pre1;
        wl[tid] = pw0; if (tid < 128) wl[512 + tid] = pw1;
        __syncthreads();
        const int gr = u / 48, wh = u % 48, which = wh >> 4, colbase = which * 2048 + (wh & 15) * 128, row0 = gr * 64;
        const int un = u + gridDim.x;
        if (un < 12288) {
            const int grn = un / 48, whn = un % 48, cbn = (whn >> 4) * 2048 + (whn & 15) * 128, r0n = grn * 64;
            pre0 = *(const u32x4*)(PQ + (size_t)(r0n + (tid >> 4)) * PQ_LD + cbn + (tid & 15) * 8);
            pre1 = *(const u32x4*)(PQ + (size_t)(r0n + 32 + (tid >> 4)) * PQ_LD + cbn + (tid & 15) * 8);
            pw0 = cwt[(tid >> 7) * 6144 + cbn + (tid & 127)]; if (tid < 128) pw1 = cwt[4 * 6144 + cbn + tid];
        }
        float v[16]; float ss = 0.f;
#pragma unroll
        for (int e = 0; e < 16; ++e) v[e] = 0.f;
#pragma unroll
        for (int j = 0; j < 5; ++j) {
            const int tt = r + j - 2;
            if (tt >= 0 && tt < 64) {
                float p0[8], p1[8]; unpack8(*(const u32x4*)(raw + tt * 128 + cg * 16), p0); unpack8(*(const u32x4*)(raw + tt * 128 + cg * 16 + 8), p1);
                const float* wp = wl + j * 128 + cg * 16;
#pragma unroll
                for (int e = 0; e < 8; ++e) { v[e] += wp[e] * p0[e]; v[8 + e] += wp[8 + e] * p1[e]; }
            }
        }
#pragma unroll
        for (int e = 0; e < 16; ++e) { const float s = siluf_(v[e]); v[e] = s; ss += s * s; }
        if (which < 2) {
            ss += __shfl_xor(ss, 1, 64); ss += __shfl_xor(ss, 2, 64); ss += __shfl_xor(ss, 4, 64);
            const float sc = rsqrtf(ss + 1e-6f) * (which == 0 ? 0.08838834764831845f : 1.0f);
#pragma unroll
            for (int e = 0; e < 16; ++e) v[e] *= sc;
        }
        bf16_t* op = PQ + (size_t)(row0 + r) * PQ_LD + colbase + cg * 16;
        u32x4 w0, w1;
        w0.x = pk2(v[0], v[1]); w0.y = pk2(v[2], v[3]); w0.z = pk2(v[4], v[5]); w0.w = pk2(v[6], v[7]);
        w1.x = pk2(v[8], v[9]); w1.y = pk2(v[10], v[11]); w1.z = pk2(v[12], v[13]); w1.w = pk2(v[14], v[15]);
        *(u32x4*)op = w0; *(u32x4*)(op + 8) = w1;
    }
    __syncthreads();
}

typedef short bf16x8 __attribute__((ext_vector_type(8)));
constexpr size_t WS_TS = 585 * MiB, WS_GCB = 653 * MiB;

__device__ void tprep_wave(KA a, int pid, unsigned char* wl) {
    const int lane = tid_opaque() & 63, fr = lane & 15, fq = lane >> 4;
    const int sid = pid / 68, cidx = pid - sid * 68, dir = sid & 1, h = (sid >> 1) & 15, b = sid >> 5;
    bf16_t* kt = (bf16_t*)wl; float* Mf = (float*)wl; float* gcs = (float*)(wl + 17408); float* bes = gcs + 64;
    const bf16_t* PQ = (const bf16_t*)(a->ws + WS_RB); const float* AB = (const float*)(a->ws + WS_AB);
    bf16_t* TS = (bf16_t*)(a->ws + WS_TS) + (size_t)pid * 4096; float* GCB = (float*)(a->ws + WS_GCB) + (size_t)pid * 128;
    int rbase, Tn, p0;
    if (cidx < 4) { rbase = MT + b * CTXL; Tn = CTXL; p0 = cidx * 64; } else { rbase = b * SEQ; Tn = SEQ; p0 = (cidx - 4) * 64; }
    {
        u32x4 kv[16];
#pragma unroll
        for (int it = 0; it < 16; ++it) {
            const int i = it * 4 + fq, p = p0 + i, tok = dir ? (Tn - 1 - p) : p;
            kv[it] = *(const u32x4*)(PQ + (size_t)(rbase + tok) * PQ_LD + 2048 + h * 128 + fr * 8);
        }
#pragma unroll
        for (int it = 0; it < 16; ++it) *(u32x4*)(kt + (it * 4 + fq) * 136 + fr * 8) = kv[it];
    }
    {
        const int p = p0 + lane, tok = dir ? (Tn - 1 - p) : p; const size_t row = (size_t)(rbase + tok);
        const float ab0 = AB[row * 64 + dir * 32 + h], ab1 = AB[row * 64 + dir * 32 + 16 + h];
        const float xx = ab0 + a->in[9][dir * 16 + h]; const float sp = (xx > 20.0f) ? xx : log1pf(expf(xx));
        float gc = -expf(a->in[8][dir * 16 + h]) * sp;
#pragma unroll
        for (int o = 1; o < 64; o <<= 1) { const float tt = __shfl_up(gc, o, 64); if (lane >= o) gc += tt; }
        const float be = sigmoidf_(ab1);
        gcs[lane] = gc; bes[lane] = be; GCB[lane] = gc; GCB[64 + lane] = expf(gc);
    }
    f32x4 acc[10];
#pragma unroll
    for (int i = 0; i < 10; ++i) acc[i] = (f32x4){0.f, 0.f, 0.f, 0.f};
#pragma unroll
    for (int kk = 0; kk < 4; ++kk) {
        bf16x8 fg[4];
#pragma unroll
        for (int ct = 0; ct < 4; ++ct) fg[ct] = *(const bf16x8*)(kt + (ct * 16 + fr) * 136 + kk * 32 + fq * 8);
#pragma unroll
        for (int ct = 0; ct < 4; ++ct)
#pragma unroll
            for (int mt = 0; mt <= ct; ++mt) acc[ct * (ct + 1) / 2 + mt] = MFMA16(fg[ct], fg[mt], acc[ct * (ct + 1) / 2 + mt]);
    }
    float gcr[4][4], ber[4][4];
#pragma unroll
    for (int ct = 0; ct < 4; ++ct)
#pragma unroll
        for (int r = 0; r < 4; ++r) { gcr[ct][r] = gcs[ct * 16 + 4 * fq + r]; ber[ct][r] = bes[ct * 16 + 4 * fq + r]; }
    float gcm[4];
#pragma unroll
    for (int mt = 0; mt < 4; ++mt) gcm[mt] = gcs[mt * 16 + fr];
    asm volatile("s_waitcnt lgkmcnt(0)" ::: "memory");
#pragma unroll
    for (int ct = 0; ct < 4; ++ct)
#pragma unroll
        for (int mt = 0; mt < 4; ++mt)
#pragma unroll
            for (int r = 0; r < 4; ++r) {
                const int c = ct * 16 + 4 * fq + r, m = mt * 16 + fr;
                float val = 0.0f;
                if (mt <= ct) val = (m < c) ? ber[ct][r] * acc[(mt <= ct) ? (ct * (ct + 1) / 2 + mt) : 0][r] * expf(gcr[ct][r] - gcm[mt]) : 0.0f;
                Mf[c * 68 + m] = val;
            }
    asm volatile("s_waitcnt lgkmcnt(0)" ::: "memory");
    {
        float* blk = Mf + (fq * 16) * 68 + fq * 16;
        float t[16];
#pragma unroll
        for (int i = 0; i < 16; ++i) {
            float s = (fr == i) ? 1.0f : 0.0f;
#pragma unroll
            for (int m4 = 0; m4 < i; m4 += 4) {
                const f32x4 mv = *(const f32x4*)(blk + i * 68 + m4);
                s -= mv.x * t[m4];
                if (m4 + 1 < i) s -= mv.y * t[m4 + 1];
                if (m4 + 2 < i) s -= mv.z * t[m4 + 2];
                if (m4 + 3 < i) s -= mv.w * t[m4 + 3];
            }
            t[i] = s;
        }
        asm volatile("s_waitcnt lgkmcnt(0)" ::: "memory");
#pragma unroll
        for (int i = 0; i < 16; ++i) blk[i * 68 + fr] = t[i];
        asm volatile("s_waitcnt lgkmcnt(0)" ::: "memory");
    }
    float* Ysc = (float*)(wl + 17920);
#pragma unroll
    for (int I = 1; I < 4; ++I)
#pragma unroll
        for (int J = 0; J < I; ++J) {
            f32x4 ya = (f32x4){0.f, 0.f, 0.f, 0.f};
#pragma unroll
            for (int K = J; K < I; ++K)
#pragma unroll
                for (int s = 0; s < 4; ++s) ya = __builtin_amdgcn_mfma_f32_16x16x4f32(Mf[(16 * I + fr) * 68 + 16 * K + 4 * s + fq], Mf[(16 * K + 4 * s + fq) * 68 + 16 * J + fr], ya, 0, 0, 0);
#pragma unroll
            for (int r = 0; r < 4; ++r) Ysc[(4 * fq + r) * 16 + fr] = ya[r];
            asm volatile("s_waitcnt lgkmcnt(0)" ::: "memory");
            f32x4 za = (f32x4){0.f, 0.f, 0.f, 0.f};
#pragma unroll
            for (int s = 0; s < 4; ++s) za = __builtin_amdgcn_mfma_f32_16x16x4f32(Mf[(16 * I + fr) * 68 + 16 * I + 4 * s + fq], Ysc[(4 * s + fq) * 16 + fr], za, 0, 0, 0);
#pragma unroll
            for (int r = 0; r < 4; ++r) Mf[(16 * I + 4 * fq + r) * 68 + 16 * J + fr] = -za[r];
            asm volatile("s_waitcnt lgkmcnt(0)" ::: "memory");
        }
#pragma unroll
    for (int it = 0; it < 8; ++it) {
        const int row = it * 8 + (lane >> 3), c8 = (lane & 7) * 8;
        const f32x4 x0 = *(const f32x4*)(Mf + row * 68 + c8) * *(const f32x4*)(bes + c8), x1 = *(const f32x4*)(Mf + row * 68 + c8 + 4) * *(const f32x4*)(bes + c8 + 4);
        u32x4 wv; wv.x = pk2(x0[0], x0[1]); wv.y = pk2(x0[2], x0[3]); wv.z = pk2(x1[0], x1[1]); wv.w = pk2(x1[2], x1[3]);
        *(u32x4*)(TS + row * 64 + c8) = wv;
    }
    asm volatile("s_waitcnt lgkmcnt(0)" ::: "memory");
}

constexpr int DL_QN = 0, DL_KN = 17408, DL_WN = 34816, DL_ST = 52224, DL_KT = 69632, DL_VT = 88064, DL_T1 = 97280, DL_T2 = 106496, DL_AT = 115712, DL_VN = 124928, DL_VD = 134144, DL_GS = 143360;
struct DStage { u32x4 q0, q1, k0, k1, v, t; f32x4 g0, g1, b0, b1; float bi, gl, g63; };
__device__ __forceinline__ void dstage_load(DStage& R, const bf16_t* PQ, const bf16_t* TS, const float* GCB, int sid, int cidx, int dir, int h, int b, int dvh, int tid) {
    const int i = tid >> 3, part = tid & 7;
    int rbase, Tn, p0;
    if (cidx < 4) { rbase = MT + b * CTXL; Tn = CTXL; p0 = cidx * 64; } else { rbase = b * SEQ; Tn = SEQ; p0 = (cidx - 4) * 64; }
    const int p = p0 + i, tok = dir ? (Tn - 1 - p) : p;
    const bf16_t* rp = PQ + (size_t)(rbase + tok) * PQ_LD + h * 128;
    R.q0 = *(const u32x4*)(rp + part * 16); R.q1 = *(const u32x4*)(rp + part * 16 + 8);
    R.k0 = *(const u32x4*)(rp + 2048 + part * 16); R.k1 = *(const u32x4*)(rp + 2048 + part * 16 + 8);
    R.v = *(const u32x4*)(rp + 4096 + dvh * 64 + part * 8);
    const size_t pid = (size_t)sid * 68 + cidx;
    R.t = *(const u32x4*)(TS + pid * 4096 + i * 64 + part * 8);
    const float* gp = GCB + pid * 128;
    R.b0 = *(const f32x4*)(gp + 64 + part * 8); R.b1 = *(const f32x4*)(gp + 64 + part * 8 + 4);
    R.gl = gp[tid & 63]; R.bi = gp[64 + (tid & 63)]; R.g63 = gp[63];
}
__device__ __forceinline__ void dstage_store(const DStage& R, unsigned char* lds, int tid) {
    const int i = tid >> 3, part = tid & 7;
    bf16_t* QN = (bf16_t*)(lds + DL_QN); bf16_t* KN = (bf16_t*)(lds + DL_KN); bf16_t* VNAT = (bf16_t*)(lds + DL_VT);
    bf16_t* T1 = (bf16_t*)(lds + DL_T1); bf16_t* T2 = (bf16_t*)(lds + DL_T2); float* GS = (float*)(lds + DL_GS);
    *(u32x4*)(QN + i * 136 + part * 16) = R.q0; *(u32x4*)(QN + i * 136 + part * 16 + 8) = R.q1;
    *(u32x4*)(KN + i * 136 + part * 16) = R.k0; *(u32x4*)(KN + i * 136 + part * 16 + 8) = R.k1;
    *(u32x4*)(VNAT + i * 72 + part * 8) = R.v;
    float t8[8]; unpack8(R.t, t8);
    const float em[8] = {R.b0.x, R.b0.y, R.b0.z, R.b0.w, R.b1.x, R.b1.y, R.b1.z, R.b1.w};
    float a1[8];
#pragma unroll
    for (int e = 0; e < 8; ++e) a1[e] = t8[e] * em[e];
    *(u32x4*)(T1 + i * 72 + part * 8) = pack8(a1); *(u32x4*)(T2 + i * 72 + part * 8) = R.t;
    if (tid < 64) { GS[tid] = R.gl; GS[64 + tid] = R.bi; GS[128 + tid] = expf(R.g63 - R.gl); }
}
typedef short s16x4 __attribute__((ext_vector_type(4)));
__device__ __forceinline__ void tr_frags2(unsigned a0, unsigned a1, bf16x8& f0, bf16x8& f1) {
    (void)a0; (void)a1; (void)f0; (void)f1;
}
#define TR_READ4(r0, r1, r2, r3, ad0, ad1, ad2, ad3) asm volatile("ds_read_b64_tr_b16 %0, %4\n\tds_read_b64_tr_b16 %1, %5\n\tds_read_b64_tr_b16 %2, %6\n\tds_read_b64_tr_b16 %3, %7\n\ts_waitcnt lgkmcnt(0)" \
    : "=&v"(r0), "=&v"(r1), "=&v"(r2), "=&v"(r3) : "v"(ad0), "v"(ad1), "v"(ad2), "v"(ad3) : "memory")
#define TR_CAT(lo, hi) __builtin_shufflevector((lo), (hi), 0, 1, 2, 3, 4, 5, 6, 7)
#define LBAR() do { asm volatile("s_waitcnt lgkmcnt(0)" ::: "memory"); __builtin_amdgcn_s_barrier(); asm volatile("" ::: "memory"); } while (0)
__device__ void delta_item(KA a, int item, unsigned char* lds) {
    const int tid = tid_opaque(), lane = tid & 63, w = tid >> 6, fr = lane & 15, fq = lane >> 4;
    const int dvh = item & 1, dir = (item >> 1) & 1, h = (item >> 2) & 15, b = item >> 6, sid = (b * 16 + h) * 2 + dir;
    const bf16_t* PQ = (const bf16_t*)(a->ws + WS_RB); const bf16_t* TS = (const bf16_t*)(a->ws + WS_TS); const float* GCB = (const float*)(a->ws + WS_GCB);
    bf16_t* O = (bf16_t*)(a->ws + WS_RA) + (size_t)dir * MT * 2048;
    const bf16_t* QN = (const bf16_t*)(lds + DL_QN); const bf16_t* KN = (const bf16_t*)(lds + DL_KN); bf16_t* WN = (bf16_t*)(lds + DL_WN); bf16_t* ST = (bf16_t*)(lds + DL_ST);
    const bf16_t* KT = (const bf16_t*)(lds + DL_KT); const bf16_t* VT = (const bf16_t*)(lds + DL_VT); const bf16_t* T1 = (const bf16_t*)(lds + DL_T1); const bf16_t* T2 = (const bf16_t*)(lds + DL_T2);
    bf16_t* AT = (bf16_t*)(lds + DL_AT); bf16_t* VN = (bf16_t*)(lds + DL_VN); bf16_t* VD = (bf16_t*)(lds + DL_VD); const float* GS = (const float*)(lds + DL_GS);
    const unsigned lds_base = (unsigned)(size_t)lds;
    __syncthreads();
    for (int i = tid; i < 64 * 136 / 2; i += NT) ((unsigned*)ST)[i] = 0u;
    f32x4 sacc[4];
#pragma unroll
    for (int i = 0; i < 4; ++i) sacc[i] = (f32x4){0.f, 0.f, 0.f, 0.f};
    DStage R;
    dstage_load(R, PQ, TS, GCB, sid, 0, dir, h, b, dvh, tid);
#pragma unroll 1
    for (int cidx = 0; cidx < 68; ++cidx) {
#pragma unroll 1
        for (int rep = 0; rep < a->reps[6]; ++rep) dstage_store(R, lds, tid);
        LBAR();
        if (cidx + 1 < 68) dstage_load(R, PQ, TS, GCB, sid, cidx + 1, dir, h, b, dvh, tid);
        bf16x8 ktf[2];
        {
            const unsigned kb = lds_base + DL_KN + (unsigned)((8 * fq + (fr >> 2)) * 272 + (w * 16 + 4 * (fr & 3)) * 2);
            s16x4 r0, r1, r2, r3;
            TR_READ4(r0, r1, r2, r3, kb, kb + 4 * 272, kb + 32 * 272, kb + 36 * 272);
            __builtin_amdgcn_sched_barrier(0);
            ktf[0] = TR_CAT(r0, r1); ktf[1] = TR_CAT(r2, r3);
        }
#pragma unroll 1
        for (int rep = 0; rep < a->reps[7]; ++rep) {
#pragma unroll
        for (int ti = 0; ti < 2; ++ti) {
            const int idx = w * 2 + ti, mt = idx >> 2, ct = idx & 3;
            f32x4 acc = (f32x4){0.f, 0.f, 0.f, 0.f};
            if (mt <= ct) {
#pragma unroll
                for (int kk = 0; kk < 4; ++kk) {
                    const bf16x8 af = *(const bf16x8*)(KN + (mt * 16 + fr) * 136 + kk * 32 + fq * 8), bfg = *(const bf16x8*)(QN + (ct * 16 + fr) * 136 + kk * 32 + fq * 8);
                    acc = MFMA16(af, bfg, acc);
                }
            }
            const int c = ct * 16 + fr; const float gcc = GS[c];
            float o4[4];
#pragma unroll
            for (int r = 0; r < 4; ++r) { const int m = mt * 16 + 4 * fq + r; o4[r] = (m <= c) ? acc[r] * expf(gcc - GS[m]) : 0.0f; }
            *(u32x2*)(AT + c * 72 + mt * 16 + 4 * fq) = pk4(o4[0], o4[1], o4[2], o4[3]);
        }
        {
            bf16x8 af[2];
            af[0] = ktf[0]; af[1] = ktf[1];
#pragma unroll
            for (int ct = 0; ct < 4; ++ct) {
                f32x4 acc = (f32x4){0.f, 0.f, 0.f, 0.f};
#pragma unroll
                for (int kk = 0; kk < 2; ++kk) acc = MFMA16(af[kk], *(const bf16x8*)(T1 + (ct * 16 + fr) * 72 + kk * 32 + fq * 8), acc);
                *(u32x2*)(WN + (ct * 16 + fr) * 136 + w * 16 + 4 * fq) = pk4(-acc[0], -acc[1], -acc[2], -acc[3]);
            }
        }
        }
        const int ctu = w >> 1, dv0 = 2 * (w & 1);
        f32x4 uacc[2];
        {
            bf16x8 af[2];
#pragma unroll
            for (int kk = 0; kk < 2; ++kk) af[kk] = *(const bf16x8*)(T2 + (ctu * 16 + fr) * 72 + kk * 32 + fq * 8);
#pragma unroll
            for (int j = 0; j < 2; ++j) { uacc[j] = (f32x4){0.f, 0.f, 0.f, 0.f};
                const unsigned vb = lds_base + DL_VT + (unsigned)((8 * fq + (fr >> 2)) * 144 + ((dv0 + j) * 16 + 4 * (fr & 3)) * 2);
                s16x4 r0, r1, r2, r3;
                TR_READ4(r0, r1, r2, r3, vb, vb + 4 * 144, vb + 32 * 144, vb + 36 * 144);
                __builtin_amdgcn_sched_barrier(0);
                uacc[j] = MFMA16(af[0], TR_CAT(r0, r1), uacc[j]); uacc[j] = MFMA16(af[1], TR_CAT(r2, r3), uacc[j]); }
        }
        LBAR();
        {
            bf16x8 af[4];
#pragma unroll
            for (int kk = 0; kk < 4; ++kk) af[kk] = *(const bf16x8*)(WN + (ctu * 16 + fr) * 136 + kk * 32 + fq * 8);
            float ed[4];
#pragma unroll
            for (int r = 0; r < 4; ++r) ed[r] = GS[128 + ctu * 16 + 4 * fq + r];
#pragma unroll
            for (int j = 0; j < 2; ++j) {
#pragma unroll
                for (int kk = 0; kk < 4; ++kk) uacc[j] = MFMA16(af[kk], *(const bf16x8*)(ST + ((dv0 + j) * 16 + fr) * 136 + kk * 32 + fq * 8), uacc[j]);
                const int dv = (dv0 + j) * 16 + fr;
                *(u32x2*)(VN + dv * 72 + ctu * 16 + 4 * fq) = pk4(uacc[j][0], uacc[j][1], uacc[j][2], uacc[j][3]);
                *(u32x2*)(VD + dv * 72 + ctu * 16 + 4 * fq) = pk4(uacc[j][0] * ed[0], uacc[j][1] * ed[1], uacc[j][2] * ed[2], uacc[j][3] * ed[3]);
            }
        }
        LBAR();
        {
            const int dvt = w >> 1, c0 = 2 * (w & 1);
            bf16x8 af[4], vf[2];
#pragma unroll
            for (int kk = 0; kk < 4; ++kk) af[kk] = *(const bf16x8*)(ST + (dvt * 16 + fr) * 136 + kk * 32 + fq * 8);
#pragma unroll
            for (int kk = 0; kk < 2; ++kk) vf[kk] = *(const bf16x8*)(VN + (dvt * 16 + fr) * 72 + kk * 32 + fq * 8);
#pragma unroll
            for (int j = 0; j < 2; ++j) {
                const int c = (c0 + j) * 16 + fr;
                f32x4 acc = (f32x4){0.f, 0.f, 0.f, 0.f};
#pragma unroll
                for (int kk = 0; kk < 4; ++kk) acc = MFMA16(af[kk], *(const bf16x8*)(QN + c * 136 + kk * 32 + fq * 8), acc);
                const float eg = GS[64 + c];
                acc = acc * eg;
#pragma unroll
                for (int kk = 0; kk < 2; ++kk) acc = MFMA16(vf[kk], *(const bf16x8*)(AT + c * 72 + kk * 32 + fq * 8), acc);
                if (cidx >= 4) {
                    const int p = (cidx - 4) * 64 + c, tok = dir ? (SEQ - 1 - p) : p;
                    *(u32x2*)(O + (size_t)(b * SEQ + tok) * 2048 + h * 128 + dvh * 64 + dvt * 16 + 4 * fq) = pk4(acc[0], acc[1], acc[2], acc[3]);
                }
            }
        }
        {
            const float eg63 = GS[64 + 63];
            bf16x8 af[2];
            af[0] = ktf[0]; af[1] = ktf[1];
#pragma unroll
            for (int j = 0; j < 4; ++j) {
                sacc[j] = sacc[j] * eg63;
#pragma unroll
                for (int kk = 0; kk < 2; ++kk) sacc[j] = MFMA16(af[kk], *(const bf16x8*)(VD + (j * 16 + fr) * 72 + kk * 32 + fq * 8), sacc[j]);
            }
        }
        LBAR();
#pragma unroll
        for (int j = 0; j < 4; ++j) *(u32x2*)(ST + (j * 16 + fr) * 136 + w * 16 + 4 * fq) = pk4(sacc[j][0], sacc[j][1], sacc[j][2], sacc[j][3]);
    }
    __syncthreads();
}

__device__ void ytrans_unit(const bf16_t* YT, bf16_t* Y, int unit, bf16_t* tile) {
    const int tid = tid_opaque(), cb = unit & 31, tb = unit >> 5, r = tid >> 3, c8 = (tid & 7) * 8;
    *(u32x4*)(tile + r * 72 + c8) = *(const u32x4*)(YT + (size_t)(cb * 64 + r) * MT + tb * 64 + c8);
    __syncthreads();
    u32x4 w;
    w.x = (unsigned)tile[(c8 + 0) * 72 + r] | ((unsigned)tile[(c8 + 1) * 72 + r] << 16);
    w.y = (unsigned)tile[(c8 + 2) * 72 + r] | ((unsigned)tile[(c8 + 3) * 72 + r] << 16);
    w.z = (unsigned)tile[(c8 + 4) * 72 + r] | ((unsigned)tile[(c8 + 5) * 72 + r] << 16);
    w.w = (unsigned)tile[(c8 + 6) * 72 + r] | ((unsigned)tile[(c8 + 7) * 72 + r] << 16);
    *(u32x4*)(Y + (size_t)(tb * 64 + r) * 2048 + cb * 64 + c8) = w;
    __syncthreads();
}

__device__ void p6_on(KA a) {
    const bf16_t* OF = (const bf16_t*)(a->ws + WS_RA); const bf16_t* OB = OF + (size_t)MT * 2048;
    const bf16_t* ZG = (const bf16_t*)(a->ws + WS_RB); bf16_t* ON = (bf16_t*)(a->ws + WS_HA);
    const float* nw = a->in[10];
    const size_t nthr = (size_t)gridDim.x * NT;
    for (size_t i = (size_t)blockIdx.x * NT + tid_opaque(); i < (size_t)MT * 256; i += nthr) {
        const int row = (int)(i >> 8), c8 = (int)(i & 255) * 8;
        float f[8], g[8], z[8];
        unpack8(*(const u32x4*)(OF + (size_t)row * 2048 + c8), f); unpack8(*(const u32x4*)(OB + (size_t)row * 2048 + c8), g);
        unpack8(*(const u32x4*)(ZG + (size_t)row * NZG + c8), z);
        float ss = 0.f;
#pragma unroll
        for (int e = 0; e < 8; ++e) { f[e] += g[e]; ss += f[e] * f[e]; }
        ss += __shfl_xor(ss, 1, 64); ss += __shfl_xor(ss, 2, 64); ss += __shfl_xor(ss, 4, 64); ss += __shfl_xor(ss, 8, 64);
        const float rs = rsqrtf(ss * (1.0f / 128.0f) + 1e-6f);
        float o[8];
#pragma unroll
        for (int e = 0; e < 8; ++e) o[e] = f[e] * rs * nw[(c8 & 127) + e] * siluf_(z[e]);
        *(u32x4*)(ON + (size_t)row * 2048 + c8) = pack8(o);
    }
}

constexpr size_t PEER_U8 = 0, PEER_V4 = 32 * MiB, PEER_VG = 48 * MiB, PEER_US = 64 * MiB, PEER_VS = 64 * MiB + 65536;
__device__ void p8_tables(KA a) {
    unsigned char* RAb = a->ws + WS_RA;
    const int lane = tid_opaque() & 63, wv = blockIdx.x * 8 + (tid_opaque() >> 6), nwv = gridDim.x * 8;
    for (int r = wv; r < 32768; r += nwv) {
        const int tab = r >> 14, row = r & 16383;
        const float* sp = (tab ? a->in[28] : a->in[27]) + (size_t)row * 2048;
        f32x4 x[8];
#pragma unroll
        for (int i = 0; i < 2; ++i)
#pragma unroll
            for (int j = 0; j < 4; ++j) x[i * 4 + j] = *(const f32x4*)(sp + i * 1024 + lane * 16 + j * 4);
        float gmx[2];
#pragma unroll
        for (int i = 0; i < 2; ++i) { float m = 0.f;
#pragma unroll
            for (int j = 0; j < 4; ++j) m = fmaxf(m, fmaxf(fmaxf(fabsf(x[i * 4 + j][0]), fabsf(x[i * 4 + j][1])), fmaxf(fabsf(x[i * 4 + j][2]), fabsf(x[i * 4 + j][3]))));
            gmx[i] = m; }
        const float mx = wave_max(fmaxf(gmx[0], gmx[1]));
        if (tab == 0) {
            const float sc = (mx > 0.f) ? mx * (1.0f / 127.0f) : 1.0f, inv = 1.0f / sc;
            unsigned char* dp = RAb + PEER_U8 + (size_t)row * 2048;
#pragma unroll
            for (int i = 0; i < 2; ++i) {
                u32x4 w;
#pragma unroll
                for (int j = 0; j < 4; ++j) {
                    const f32x4 v = x[i * 4 + j];
                    const unsigned b0 = (unsigned)__float2int_rn(v[0] * inv), b1 = (unsigned)__float2int_rn(v[1] * inv), b2 = (unsigned)__float2int_rn(v[2] * inv), b3 = (unsigned)__float2int_rn(v[3] * inv);
                    w[j] = (b0 & 255u) | ((b1 & 255u) << 8) | ((b2 & 255u) << 16) | ((b3 & 255u) << 24);
                }
                *(u32x4*)(dp + i * 1024 + lane * 16) = w;
            }
            if (lane == 0) ((float*)(RAb + PEER_US))[row] = sc;
        } else {
            const float rmx = (mx > 0.f) ? mx : 1.0f;
#pragma unroll
            for (int i = 0; i < 2; ++i) {
                int m = (int)ceilf(gmx[i] * (255.0f / rmx)); m = m < 1 ? 1 : (m > 255 ? 255 : m);
                const float inv = (7.0f * 255.0f) / (rmx * (float)m);
                unsigned q[16];
#pragma unroll
                for (int j = 0; j < 4; ++j)
#pragma unroll
                    for (int e = 0; e < 4; ++e) { int c = __float2int_rn(x[i * 4 + j][e] * inv); c = c < -7 ? -7 : (c > 7 ? 7 : c); q[j * 4 + e] = (unsigned)(c + 8); }
                u32x2 w;
                w.x = (q[0] | (q[4] << 4)) | ((q[1] | (q[5] << 4)) << 8) | ((q[2] | (q[6] << 4)) << 16) | ((q[3] | (q[7] << 4)) << 24);
                w.y = (q[8] | (q[12] << 4)) | ((q[9] | (q[13] << 4)) << 8) | ((q[10] | (q[14] << 4)) << 16) | ((q[11] | (q[15] << 4)) << 24);
                *(u32x2*)(RAb + PEER_V4 + (size_t)row * 1024 + i * 512 + lane * 8) = w;
                (RAb + PEER_VG)[(size_t)row * 128 + lane * 2 + i] = (unsigned char)m;
            }
            if (lane == 0) ((float*)(RAb + PEER_VS))[row] = rmx * (1.0f / (7.0f * 255.0f));
        }
    }
}

__device__ void p9_ln1(KA a) {
    const float* mod = (const float*)(a->ws + WS_MOD); bf16_t* H2 = (bf16_t*)(a->ws + WS_RA) + (size_t)2 * MT * 2048;
    const float* g = a->in[23]; const float* bb = a->in[24];
    const int lane = tid_opaque() & 63, wv = blockIdx.x * 8 + (tid_opaque() >> 6), nwv = gridDim.x * 8;
    for (int row = wv; row < MT; row += nwv) {
        float* rp = a->out + (size_t)row * 2048;
        float v[32]; float s = 0.f;
#pragma unroll
        for (int i = 0; i < 4; ++i) { const f32x4 x0 = *(const f32x4*)(rp + i * 512 + lane * 8), x1 = *(const f32x4*)(rp + i * 512 + lane * 8 + 4);
#pragma unroll
            for (int e = 0; e < 4; ++e) { v[i * 8 + e] = x0[e]; v[i * 8 + 4 + e] = x1[e]; s += x0[e] + x1[e]; } }
        const float mu = wave_sum(s) * (1.0f / 2048.0f);
        float q = 0.f;
#pragma unroll
        for (int e = 0; e < 32; ++e) { const float d = v[e] - mu; q += d * d; }
        const float rstd = rsqrtf(wave_sum(q) * (1.0f / 2048.0f) + 1e-5f);
        const float* mp = mod + (row >> 12) * 12288;
#pragma unroll
        for (int i = 0; i < 4; ++i) {
            const int col = i * 512 + lane * 8;
            float xn[8], h[8];
#pragma unroll
            for (int e = 0; e < 8; ++e) { xn[e] = (v[i * 8 + e] - mu) * rstd * g[col + e] + bb[col + e]; h[e] = xn[e] * (1.0f + mp[8192 + col + e]) + mp[6144 + col + e]; }
            *(f32x4*)(rp + col) = (f32x4){xn[0], xn[1], xn[2], xn[3]}; *(f32x4*)(rp + col + 4) = (f32x4){xn[4], xn[5], xn[6], xn[7]};
            *(u32x4*)(H2 + (size_t)row * 2048 + col) = pack8(h);
        }
    }
}

__device__ __forceinline__ float row_max16(float v) {
    v = fmaxf(v, __builtin_bit_cast(float, __builtin_amdgcn_update_dpp(0, __builtin_bit_cast(int, v), 0x128, 0xf, 0xf, false)));
    v = fmaxf(v, __builtin_bit_cast(float, __builtin_amdgcn_update_dpp(0, __builtin_bit_cast(int, v), 0x124, 0xf, 0xf, false)));
    v = fmaxf(v, __builtin_bit_cast(float, __builtin_amdgcn_update_dpp(0, __builtin_bit_cast(int, v), 0x122, 0xf, 0xf, false)));
    v = fmaxf(v, __builtin_bit_cast(float, __builtin_amdgcn_update_dpp(0, __builtin_bit_cast(int, v), 0x121, 0xf, 0xf, false)));
    return v;
}
__device__ __forceinline__ float row_sum16(float v) {
    v += __builtin_bit_cast(float, __builtin_amdgcn_update_dpp(0, __builtin_bit_cast(int, v), 0x128, 0xf, 0xf, false));
    v += __builtin_bit_cast(float, __builtin_amdgcn_update_dpp(0, __builtin_bit_cast(int, v), 0x124, 0xf, 0xf, false));
    v += __builtin_bit_cast(float, __builtin_amdgcn_update_dpp(0, __builtin_bit_cast(int, v), 0x122, 0xf, 0xf, false));
    v += __builtin_bit_cast(float, __builtin_amdgcn_update_dpp(0, __builtin_bit_cast(int, v), 0x121, 0xf, 0xf, false));
    return v;
}
__device__ __forceinline__ int row_sum16i(int v) {
    v += __builtin_amdgcn_update_dpp(0, v, 0x128, 0xf, 0xf, false);
    v += __builtin_amdgcn_update_dpp(0, v, 0x124, 0xf, 0xf, false);
    v += __builtin_amdgcn_update_dpp(0, v, 0x122, 0xf, 0xf, false);
    v += __builtin_amdgcn_update_dpp(0, v, 0x121, 0xf, 0xf, false);
    return v;
}
template <int NCH, int NV> __device__ __forceinline__ void topk16_row16(float (&x)[NCH][NV], int s, int g, float (&rs)[NCH], int (&ri)[NCH]) {
#pragma unroll
    for (int c = 0; c < NCH; ++c) { rs[c] = -INFINITY; ri[c] = 0; }
#pragma unroll 1
    for (int it = 0; it < 16; ++it) {
#pragma unroll
        for (int c = 0; c < NCH; ++c) {
            float m = x[c][0];
#pragma unroll
            for (int j = 1; j < NV; ++j) m = fmaxf(m, x[c][j]);
            const float wm = row_max16(m);
            const unsigned long long bal = __ballot(m == wm);
            const unsigned seg = (unsigned)(bal >> (16 * g)) & 0xffffu;
            const bool iswin = (s == (__ffs((int)seg) - 1));
            int jsel = 0;
#pragma unroll
            for (int j = NV - 1; j >= 0; --j) { const bool e = (x[c][j] == wm); jsel = e ? j : jsel; x[c][j] = (e && iswin) ? -INFINITY : x[c][j]; }
            const int key = row_sum16i(iswin ? (s * NV + jsel) : 0);
            if (s == it) { rs[c] = wm; ri[c] = key; }
        }
    }
}
__device__ void peer_unit(KA a, int unit, unsigned char* lds) {
    const int tid = tid_opaque(), lane = tid & 63, wid = tid >> 6, fr = lane & 15, fq = lane >> 4;
    float* SC = (float*)lds;
    int* IGI = (int*)(lds + 65536); float* IGG = (float*)(lds + 98304);
    float* TL = (float*)(lds + 131072); int* TI = (int*)(lds + 139264);
    const int tok0 = unit * 64;
    const float* Qp = (const float*)(a->ws + WS_RB); const float* subk = a->in[26];
    const bf16_t* H2 = (const bf16_t*)(a->ws + WS_RA) + (size_t)2 * MT * 2048;
    const float* mod = (const float*)(a->ws + WS_MOD);
    int sti[4], stj[4];
#pragma unroll
    for (int q = 0; q < 4; ++q) {
        const int t = fr * 4 + q; int acc = 0, ii = -1, jj = 0;
#pragma unroll
        for (int i = 0; i < 16; ++i) { const int cnt = 16 / (i + 1); if (ii < 0 && t < acc + cnt) { ii = i; jj = t - acc; } acc += cnt; }
        sti[q] = ii; stj[q] = jj;
    }
    float nx[4][8];
#pragma unroll
    for (int c = 0; c < 4; ++c) { const float* sp = Qp + (size_t)(tok0 + wid * 8 + (c >> 1) * 4 + fq) * 2048 + (c & 1) * 128 + fr * 8;
        const f32x4 y0 = *(const f32x4*)sp, y1 = *(const f32x4*)(sp + 4);
        nx[c][0] = y0.x; nx[c][1] = y0.y; nx[c][2] = y0.z; nx[c][3] = y0.w; nx[c][4] = y1.x; nx[c][5] = y1.y; nx[c][6] = y1.z; nx[c][7] = y1.w; }
#pragma unroll 1
    for (int hh = 0; hh < 8 * a->reps[2]; ++hh) { const int h = hh & 7;
        {
            float x[4][8]; float ts[4]; int tix[4];
#pragma unroll
            for (int c = 0; c < 4; ++c)
#pragma unroll
                for (int j = 0; j < 8; ++j) x[c][j] = nx[c][j];
            {
                const int hn = (hh + 1) & 7;
#pragma unroll
                for (int c = 0; c < 4; ++c) { const float* sp = Qp + (size_t)(tok0 + wid * 8 + (c >> 1) * 4 + fq) * 2048 + (hn * 2 + (c & 1)) * 128 + fr * 8;
                    const f32x4 y0 = *(const f32x4*)sp, y1 = *(const f32x4*)(sp + 4);
                    nx[c][0] = y0.x; nx[c][1] = y0.y; nx[c][2] = y0.z; nx[c][3] = y0.w; nx[c][4] = y1.x; nx[c][5] = y1.y; nx[c][6] = y1.z; nx[c][7] = y1.w; }
            }
            topk16_row16<4, 8>(x, fr, fq, ts, tix);
#pragma unroll
            for (int c = 0; c < 4; ++c) { const int tkc = wid * 8 + (c >> 1) * 4 + fq, p = c & 1; TL[(tkc * 2 + p) * 16 + fr] = ts[c]; TI[(tkc * 2 + p) * 16 + fr] = tix[c]; }
            asm volatile("s_waitcnt lgkmcnt(0)" ::: "memory");
            float cnd[2][4]; float bs[2]; int bc[2];
#pragma unroll
            for (int g = 0; g < 2; ++g) { const int tk = wid * 8 + g * 4 + fq;
#pragma unroll
                for (int q = 0; q < 4; ++q) cnd[g][q] = (sti[q] >= 0) ? TL[(tk * 2 + 0) * 16 + (sti[q] & 15)] + TL[(tk * 2 + 1) * 16 + stj[q]] : -INFINITY; }
            topk16_row16<2, 4>(cnd, fr, fq, bs, bc);
#pragma unroll
            for (int g = 0; g < 2; ++g) {
                const int tk = wid * 8 + g * 4 + fq;
                const int src = (lane & 48) + (bc[g] >> 2), qq = bc[g] & 3;
                const int i0 = __shfl(sti[0], src, 64), i1 = __shfl(sti[1], src, 64), i2 = __shfl(sti[2], src, 64), i3 = __shfl(sti[3], src, 64);
                const int j0 = __shfl(stj[0], src, 64), j1 = __shfl(stj[1], src, 64), j2 = __shfl(stj[2], src, 64), j3 = __shfl(stj[3], src, 64);
                const int pi = (qq == 0) ? i0 : (qq == 1) ? i1 : (qq == 2) ? i2 : i3, pj = (qq == 0) ? j0 : (qq == 1) ? j1 : (qq == 2) ? j2 : j3;
                const int e0 = TI[(tk * 2 + 0) * 16 + (pi & 15)], e1 = TI[(tk * 2 + 1) * 16 + (pj & 15)];
                const float mx = row_max16(bs[g]);
                const float ex = expf(bs[g] - mx);
                const float sm = row_sum16(ex);
                IGI[tk * 128 + h * 16 + fr] = e0 * 128 + e1; IGG[tk * 128 + h * 16 + fr] = ex / sm;
            }
            asm volatile("s_waitcnt lgkmcnt(0)" ::: "memory");
        }
    }
    __syncthreads();
    const unsigned char* U8 = a->ws + WS_RA + PEER_U8; const unsigned char* V4 = a->ws + WS_RA + PEER_V4; const unsigned short* VG = (const unsigned short*)(a->ws + WS_RA + PEER_VG);
    const float* US = (const float*)(a->ws + WS_RA + PEER_US); const float* VS = (const float*)(a->ws + WS_RA + PEER_VS);
#pragma unroll 1
    for (int rr = 0; rr < 8; ++rr) {
        const int row = wid * 8 + rr, tok = tok0 + row;
        float hx[32]; float hs = 0.f;
#pragma unroll
        for (int i = 0; i < 2; ++i) {
            float t8[8];
            unpack8(*(const u32x4*)(H2 + (size_t)tok * 2048 + i * 1024 + lane * 16), t8);
#pragma unroll
            for (int e = 0; e < 8; ++e) { hx[i * 16 + e] = t8[e]; hs += t8[e]; }
            unpack8(*(const u32x4*)(H2 + (size_t)tok * 2048 + i * 1024 + lane * 16 + 8), t8);
#pragma unroll
            for (int e = 0; e < 8; ++e) { hx[i * 16 + 8 + e] = t8[e]; hs += t8[e]; }
        }
        float hmx = 0.f;
#pragma unroll
        for (int e = 0; e < 32; ++e) hmx = fmaxf(hmx, fabsf(hx[e]));
        hmx = wave_max(hmx);
        const float shq = (hmx > 0.f) ? hmx * (1.0f / 127.0f) : 1.0f, ihq = 1.0f / shq;
        int hq[8];
#pragma unroll
        for (int w4 = 0; w4 < 8; ++w4) {
            const unsigned b0 = (unsigned)__float2int_rn(hx[w4 * 4 + 0] * ihq) & 255u, b1 = (unsigned)__float2int_rn(hx[w4 * 4 + 1] * ihq) & 255u, b2 = (unsigned)__float2int_rn(hx[w4 * 4 + 2] * ihq) & 255u, b3 = (unsigned)__float2int_rn(hx[w4 * 4 + 3] * ihq) & 255u;
            hq[w4] = (int)(b0 | (b1 << 8) | (b2 << 16) | (b3 << 24));
        }
        (void)hs;
        int yi[32];
#pragma unroll
        for (int e = 0; e < 32; ++e) yi[e] = 0;
        int cs0 = 0, cs1 = 0; float qscale = 0.f;
#if DBG_MODE != 2
        const int* ip = IGI + row * 128; float* gp = IGG + row * 128;
        float cmax = 0.f;
#define TMERGE(a_, b_, k_) ({ const int _s = (lane & (k_)) ? (a_) : (b_); const int _k = (lane & (k_)) ? (b_) : (a_); _k + __shfl_xor(_s, (k_), 64); })
#pragma unroll 1
        for (int half = 0; half < 2; ++half) {
            const int* iph = ip + half * 64;
            u32x4 nu[PA][2];
#pragma unroll
            for (int k = 0; k < PA; ++k) { const int idx = __builtin_amdgcn_readfirstlane(iph[k]); const unsigned char* up = U8 + (size_t)idx * 2048 + lane * 16;
                nu[k][0] = *(const u32x4*)up; nu[k][1] = *(const u32x4*)(up + 1024); }
            int L2 = 0, L3 = 0, L4 = 0, L5 = 0, FIN = 0;
#pragma unroll 1
            for (int it = 0; it < 16; ++it) {
                u32x4 cu[PA][2];
#pragma unroll
                for (int k = 0; k < PA; ++k) { cu[k][0] = nu[k][0]; cu[k][1] = nu[k][1]; }
                if (it + 1 < 16) {
#pragma unroll
                    for (int k = 0; k < PA; ++k) { const int idx = __builtin_amdgcn_readfirstlane(iph[(it + 1) * PA + k]); const unsigned char* up = U8 + (size_t)idx * 2048 + lane * 16;
                        nu[k][0] = *(const u32x4*)up; nu[k][1] = *(const u32x4*)(up + 1024); }
                }
                int ia[PA];
#pragma unroll
                for (int k = 0; k < PA; ++k) { int iacc = 0;
#pragma unroll
                    for (int i = 0; i < 2; ++i)
#pragma unroll
                        for (int j = 0; j < 4; ++j) iacc = __builtin_amdgcn_sdot4((int)cu[k][i][j], hq[i * 4 + j], iacc, false);
                    ia[k] = iacc; }
                const int m01 = TMERGE(ia[0], ia[1], 32), m23 = TMERGE(ia[2], ia[3], 32);
                const int X2 = TMERGE(m01, m23, 16);
                if ((it & 1) == 0) L2 = X2; else { const int X3 = TMERGE(L2, X2, 8);
                    if ((it & 2) == 0) L3 = X3; else { const int X4 = TMERGE(L3, X3, 4);
                        if ((it & 4) == 0) L4 = X4; else { const int X5 = TMERGE(L4, X4, 2);
                            if ((it & 8) == 0) L5 = X5; else FIN = TMERGE(L5, X5, 1); } } }
            }
            {
                const int el = half * 64 + (int)(__builtin_bitreverse32((unsigned)lane) >> 26);
                const int idx = ip[el];
                const float dot = US[idx] * shq * (float)FIN;
                const float c1 = gp[el] * 0.5f * dot * (1.0f + erff(dot * 0.7071067811865476f)) * VS[idx];
                cmax = fmaxf(cmax, wave_max(fabsf(c1)));
                asm volatile("s_waitcnt lgkmcnt(0)" ::: "memory");
                gp[el] = c1;
            }
        }
#undef TMERGE
        asm volatile("s_waitcnt lgkmcnt(0)" ::: "memory");
        qscale = (cmax > 0.f) ? (524287.0f / (cmax * 255.0f)) : 0.f;
        {
            u32x2 nv[PB][2]; unsigned ng[PB];
#pragma unroll
            for (int k = 0; k < PB; ++k) { const int idx = __builtin_amdgcn_readfirstlane(ip[k]); const unsigned char* vp = V4 + (size_t)idx * 1024 + lane * 8;
                nv[k][0] = *(const u32x2*)vp; nv[k][1] = *(const u32x2*)(vp + 512); ng[k] = VG[(size_t)idx * 64 + lane]; }
#pragma unroll 1
            for (int e = 0; e < 128; e += PB) {
                u32x2 cvv[PB][2]; unsigned cg[PB];
#pragma unroll
                for (int k = 0; k < PB; ++k) { cvv[k][0] = nv[k][0]; cvv[k][1] = nv[k][1]; cg[k] = ng[k]; }
                if (e + PB < 128) {
#pragma unroll
                    for (int k = 0; k < PB; ++k) { const int idx = __builtin_amdgcn_readfirstlane(ip[e + PB + k]); const unsigned char* vp = V4 + (size_t)idx * 1024 + lane * 8;
                        nv[k][0] = *(const u32x2*)vp; nv[k][1] = *(const u32x2*)(vp + 512); ng[k] = VG[(size_t)idx * 64 + lane]; }
                }
#pragma unroll
                for (int k = 0; k < PB; ++k) {
                    const float c1s = gp[e + k] * qscale;
#pragma unroll
                    for (int i = 0; i < 2; ++i) {
                        const int cq = __float2int_rn(c1s * (float)((cg[k] >> (8 * i)) & 255u));
                        if (i == 0) cs0 += cq; else cs1 += cq;
#pragma unroll
                        for (int j = 0; j < 2; ++j) { const unsigned wd = cvv[k][i][j]; int* yp = yi + i * 16 + j * 8;
                            yp[0] = __mul24(cq, (int)(wd & 15u)) + yp[0]; yp[4] = __mul24(cq, (int)((wd >> 4) & 15u)) + yp[4];
                            yp[1] = __mul24(cq, (int)((wd >> 8) & 15u)) + yp[1]; yp[5] = __mul24(cq, (int)((wd >> 12) & 15u)) + yp[5];
                            yp[2] = __mul24(cq, (int)((wd >> 16) & 15u)) + yp[2]; yp[6] = __mul24(cq, (int)((wd >> 20) & 15u)) + yp[6];
                            yp[3] = __mul24(cq, (int)((wd >> 24) & 15u)) + yp[3]; yp[7] = __mul24(cq, (int)(wd >> 28)) + yp[7]; }
                    }
                }
            }
        }
#endif
        float yq[32];
        {
            const float inv = (qscale > 0.f) ? (1.0f / qscale) : 0.f;
#pragma unroll
            for (int e = 0; e < 16; ++e) { yq[e] = (float)(yi[e] - 8 * cs0) * inv; yq[16 + e] = (float)(yi[16 + e] - 8 * cs1) * inv; }
        }
        const float csum2[2] = {0.f, 0.f};
        float* rp = a->out + (size_t)tok * 2048; const float* mp = mod + (tok >> 12) * 12288 + 10240;
        float val[32]; float s = 0.f;
#pragma unroll
        for (int i = 0; i < 2; ++i)
#pragma unroll
            for (int j = 0; j < 4; ++j) { const int col = i * 1024 + lane * 16 + j * 4; const f32x4 x0 = *(const f32x4*)(rp + col), g0 = *(const f32x4*)(mp + col);
#pragma unroll
                for (int e = 0; e < 4; ++e) { const float v = ALPHA * x0[e] + g0[e] * (yq[i * 16 + j * 4 + e] - 8.0f * csum2[i]); val[i * 16 + j * 4 + e] = v; s += v; } }
        const float mu = wave_sum(s) * (1.0f / 2048.0f);
        float q = 0.f;
#pragma unroll
        for (int e = 0; e < 32; ++e) { const float d = val[e] - mu; q += d * d; }
        const float rstd = rsqrtf(wave_sum(q) * (1.0f / 2048.0f) + 1e-5f);
        const float* g = a->in[29]; const float* bb = a->in[30];
#pragma unroll
        for (int i = 0; i < 2; ++i)
#pragma unroll
            for (int j = 0; j < 4; ++j) { const int col = i * 1024 + lane * 16 + j * 4; const f32x4 gg = *(const f32x4*)(g + col), bv = *(const f32x4*)(bb + col); f32x4 o;
#pragma unroll
                for (int e = 0; e < 4; ++e) o[e] = (val[i * 16 + j * 4 + e] - mu) * rstd * gg[e] + bv[e];
                *(f32x4*)(rp + col) = o; }
    }
    __syncthreads();
}

constexpr size_t WS_BAR = 699 * MiB;

__device__ __forceinline__ void grid_bar(unsigned* ctr, unsigned target) {
    asm volatile("s_waitcnt vmcnt(0)" ::: "memory");
    __syncthreads();
    if (tid_opaque() == 0) {
        __builtin_amdgcn_fence(__ATOMIC_RELEASE, "agent");
        asm volatile("s_waitcnt vmcnt(0)" ::: "memory");
        __hip_atomic_fetch_add(ctr, 1u, __ATOMIC_RELAXED, __HIP_MEMORY_SCOPE_AGENT);
        while (__hip_atomic_load(ctr, __ATOMIC_RELAXED, __HIP_MEMORY_SCOPE_AGENT) < target) __builtin_amdgcn_s_sleep(2);
        __builtin_amdgcn_fence(__ATOMIC_ACQUIRE, "agent");
        asm volatile("s_waitcnt vmcnt(0)" ::: "memory");
    }
    __syncthreads();
}

__global__ void __launch_bounds__(NT, 2) fwd_mega(Args a_) {
    KA a = (KA)__builtin_amdgcn_kernarg_segment_ptr();
    unsigned char* lds = g_lds;
    tid_table_init();
    cg::grid_group grid = cg::this_grid();
    float* lf = (float*)lds;
    const int lo = a->ph_lo, hi = a->ph_hi;
#define IN(k) (lo <= (k) && (k) < hi)
    unsigned* barctr = (unsigned*)(a->ws + WS_BAR); unsigned nbar = 0;
    if (blockIdx.x == 0 && tid_opaque() == 0) __hip_atomic_store(barctr, 0u, __ATOMIC_RELAXED, __HIP_MEMORY_SCOPE_AGENT);
#define GBAR() do { ++nbar; grid_bar(barctr, nbar * gridDim.x); } while (0)
#define SEAM(k) do { if (IN(k) && IN((k) + 1)) { if ((k) == 0) grid.sync(); else GBAR(); } asm volatile("" : "+s"(a)); } while (0)
    unsigned char* ws = a->ws;
    bf16_t* HA = (bf16_t*)(ws + WS_HA); bf16_t* WT = (bf16_t*)(ws + WS_WT); bf16_t* SW = (bf16_t*)(ws + WS_SW);
    bf16_t* RA = (bf16_t*)(ws + WS_RA); bf16_t* RB = (bf16_t*)(ws + WS_RB);
    const float* mod = (const float*)(ws + WS_MOD);

    if (IN(0)) {
#pragma unroll 1
        for (int rep = 0; rep < a->reps[0]; ++rep) { p0_mod_hid2(a, lf); p0_transposes(a, lf); }
    }
    SEAM(0);
    if (IN(1)) {
#pragma unroll 1
        for (int rep = 0; rep < a->reps[0]; ++rep) { p1_ha(a); for (int u = blockIdx.x; u < 256; u += gridDim.x) filt_unit(a, u, lds); for (int u = blockIdx.x; u < 256; u += gridDim.x) wprime_unit(a, u, lds); }
    }
    SEAM(1);
    if (IN(2)) {
#pragma unroll 1
        for (int rep = 0; rep < a->reps[1]; ++rep) {
        run_gemm(lds, WT, HA, NHY, MT, FStoreBf16{RA, MT, 1.0f});
        run_gemm8(lds, ws + WS_HA8, (const unsigned char*)WT + WT8_OFF, MA, NQKVP, FStoreQKV{RB, (float*)(ws + WS_AB), 1.0f / 64.0f});
        }
    }
    SEAM(2);
    if (IN(3)) {
        { Hy2W HW; Hy2T HT; hyena2_setup(lds, HW, HT);
#pragma unroll 1
        for (int rep = 0; rep < a->reps[3]; ++rep)
        for (int c = blockIdx.x; c < 2048; c += gridDim.x) hyena2_item(a, c, lds, HW, HT);
        __syncthreads(); }
        qkvpost_latent(a, lds);
        for (int u = 12288 + blockIdx.x; u < 12288 + 192; u += gridDim.x) qkvpost_unit(a, u, lds);
    }
    SEAM(3);
    if (IN(4)) {
#pragma unroll 1
        for (int rep = 0; rep < a->reps[4]; ++rep)
        { const int wv = tid_opaque() >> 6; for (int pid = blockIdx.x * 8 + wv; pid < 8704; pid += gridDim.x * 8) tprep_wave(a, pid, lds + wv * 18944); }
        GBAR();
#pragma unroll 1
        for (int rep = 0; rep < a->reps[5]; ++rep)
        for (int it = blockIdx.x; it < 256; it += gridDim.x) delta_item(a, it, lds);
    }
    SEAM(4);
    if (IN(5)) {
        run_gemm8(lds, ws + WS_HA8, (const unsigned char*)WT + WT8_OFF + (size_t)NQKVP * 2048, MT, NZG, FStoreBf16{RB, NZG, 1.0f / 64.0f});
#pragma unroll 1
        for (int rep = 0; rep < a->reps[6]; ++rep)
        for (int u = blockIdx.x; u < 8192; u += gridDim.x) ytrans_unit((const bf16_t*)a->out, RA + (size_t)2 * MT * 2048, u, (bf16_t*)lds);
    }
    SEAM(5);
    if (IN(6)) {
#pragma unroll 1
        for (int rep = 0; rep < a->reps[6]; ++rep) p6_on(a); }
    SEAM(6);
    if (IN(7)) {
        run_gemm(lds, HA  , SW, MT, D, FGatePA{RB, WT  });
        run_gemm(lds, RA + (size_t)2 * MT * 2048  , SW + (size_t)1 * D * D, MT, D, FGatePH{RB, WT  });
    }
    SEAM(7);
    if (IN(8)) {
        run_gemm(lds, WT  , SW + (size_t)2 * D * D, MT, D, FOut{a->in[0], mod, a->out});
#pragma unroll 1
        for (int rep = 0; rep < a->reps[7]; ++rep) p8_tables(a);
    }
    SEAM(8);
    if (IN(9)) { p9_ln1(a); }
    SEAM(9);
    if (IN(10)) { run_gemm(lds, RA + (size_t)2 * MT * 2048  , SW + (size_t)3 * D * D, MT, D, FStoreF32{(float*)(ws + WS_RB), D}); }
    SEAM(10);
    if (IN(11)) { for (int u = blockIdx.x; u < MT / 64; u += gridDim.x) peer_unit(a, u, lds); }
#undef IN
#undef SEAM
}

extern "C" void kernel_launch(void* const* d_in, const int* in_sizes, int n_in, void* d_out, int out_size, void* d_ws, size_t ws_size, hipStream_t stream) {
    static int grid = 0;
    if (grid == 0) {
        if (n_in != 31 || out_size != MT * D || ws_size < WS_BAR + 4096) { fprintf(stderr, "kernel_launch: unexpected problem shape / workspace (%d inputs, out %d, ws %zu)\n", n_in, out_size, ws_size); grid = -1; return; }
        int dev = 0, cus = 0, per_cu = 0;
        (void)hipGetDevice(&dev);
        (void)hipDeviceGetAttribute(&cus, hipDeviceAttributeMultiprocessorCount, dev);
        (void)hipFuncSetAttribute((const void*)fwd_mega, hipFuncAttributeMaxDynamicSharedMemorySize, LDS_BYTES);
        (void)hipOccupancyMaxActiveBlocksPerMultiprocessor(&per_cu, (const void*)fwd_mega, NT, LDS_BYTES);
        if (per_cu < 1) per_cu = 1;
        grid = cus * per_cu;
        (void)hipGetLastError();
    }
    if (grid < 0) return;
    Args a{};
    for (int i = 0; i < 31; ++i) a.in[i] = (const float*)d_in[i];
    a.out = (float*)d_out; a.ws = (unsigned char*)d_ws; a.ph_lo = 0; a.ph_hi = 12; a.reps[0] = REP0; a.reps[1] = REP1; a.reps[2] = REP2; a.reps[3] = REP3; a.reps[4] = REP4; a.reps[5] = REP5; a.reps[6] = REP6; a.reps[7] = REP7; a.pad2[0] = REPG;
    void* args[] = {&a};
    hipError_t e = hipLaunchCooperativeKernel((const void*)fwd_mega, dim3(grid), dim3(NT), args, LDS_BYTES, stream);
    if (e != hipSuccess) fprintf(stderr, "cooperative launch failed: %s (grid %d)\n", hipGetErrorString(e), grid);
}
```

```cpp
#include <hip/hip_runtime.h>
#include <hip/hip_cooperative_groups.h>
#include <cstdio>
#include <cstdint>
namespace cg = cooperative_groups;

#ifndef DBG_MODE
#define DBG_MODE 0
#endif
#define PA 4
#define PB 8
#define REP0 1
#define REP1 1
#define REP2 1
#define REP3 1
#define REP4 1
#define REP5 1
#define REP6 1
#define REP7 1
#define REPG 1

extern __shared__ __attribute__((aligned(16))) unsigned char g_lds[];
constexpr int TIDTAB_OFF = 160 * 1024 - 256;
__device__ __forceinline__ int tid_opaque() {
    const int slot = __builtin_amdgcn_s_getreg(0x2804) & 63;
    int wv = __builtin_amdgcn_readfirstlane(((const int*)(g_lds + TIDTAB_OFF))[slot]);
    int ln; asm volatile("v_mbcnt_lo_u32_b32 %0, -1, 0\n\tv_mbcnt_hi_u32_b32 %0, -1, %0" : "=v"(ln));
    int t = wv * 64 + ln;
    asm volatile("" : "+v"(t));
    return t;
}
__device__ __forceinline__ void tid_table_init() {
    const int t = threadIdx.x;
    if ((t & 63) == 0) ((int*)(g_lds + TIDTAB_OFF))[__builtin_amdgcn_s_getreg(0x2804) & 63] = t >> 6;
    __syncthreads();
}

namespace pg8 {
#define PG8_LAS __attribute__((address_space(3)))
typedef unsigned short bf16_t;
typedef short bf16x8 __attribute__((ext_vector_type(8)));
typedef float f32x4 __attribute__((ext_vector_type(4)));
typedef unsigned u32x4 __attribute__((ext_vector_type(4)));
constexpr int BM = 256, BK = 64, HALF = 128, HTB = HALF * BK * 2, STAGE_BYTES = 8 * HTB, NXCD = 8, WGM = 8;

__host__ __device__ __forceinline__ int lds_byte(int r, int c) { const int st = (r >> 4) * 2 + (c >> 5), rr = r & 15, cc = c & 31, ob = rr * 64 + cc * 2; return st * 1024 + (ob ^ (((ob >> 9) & 1) << 5)); }
__host__ __device__ __forceinline__ void stage_rc(int b, int& R, int& C) { const int st = b / 1024, sb = b % 1024, swz = sb ^ (((sb >> 9) & 1) << 5); R = (st >> 1) * 16 + swz / 64; C = (st & 1) * 32 + (swz % 64) / 2; }
__host__ __device__ __forceinline__ int perm32(int rho) { const int n = rho >> 4, i = rho & 15; return 8 * (i >> 2) + 4 * n + (i & 3); }

struct Unit { int pm, pn; };
struct Gemm { const bf16_t* A; const bf16_t* Bt; int M, N, K; };

struct StaticOrder {
    int nM, nN, nwg, G, c;
    __host__ __device__ void init(int M, int N, int G_, int c_) { nM = M / BM; nN = N / BM; nwg = nM * nN; G = G_; c = c_; }
    __host__ __device__ bool next(int i, Unit& u) const {
        const long L = (long)i * G + c; if (L >= nwg) return false;
        int wgid = (int)L; { const int q = nwg / NXCD, r = nwg % NXCD, xcd = wgid % NXCD, off = wgid / NXCD; wgid = (xcd < r ? xcd * (q + 1) : r * (q + 1) + (xcd - r) * q) + off; }
        const int nig = WGM * nN, gid = wgid / nig, fm = gid * WGM, gsz = (nM - fm) < WGM ? (nM - fm) : WGM;
        u.pm = fm + ((wgid % nig) % gsz); u.pn = (wgid % nig) / gsz; return true;
    }
    __device__ __forceinline__ void a_ready(const Unit&) const {}
    __device__ __forceinline__ void done(const Unit&) const {}
};

__device__ __forceinline__ unsigned cvt_pk_bf16(float lo, float hi) { unsigned r; asm volatile("v_cvt_pk_bf16_f32 %0, %1, %2" : "=v"(r) : "v"(lo), "v"(hi)); return r; }

template <class F> struct EpiGen {
    static constexpr bool PERM = true, AFTER_DRAIN = false;
    F f;
    __device__ __forceinline__ void operator()(const f32x4 (&acc)[2][2][4][2], const Unit& u, int wr, int wc, int, int) const {
        int ln; asm volatile("v_mbcnt_lo_u32_b32 %0, -1, 0\n\tv_mbcnt_hi_u32_b32 %0, -1, %0" : "=v"(ln));
        const int fr = ln & 15, fq = ln >> 4;
        const int row0 = u.pm * BM + wr * 64 + fr, col0 = u.pn * BM + wc * 32 + 8 * fq;
#pragma unroll
        for (int ai = 0; ai < 2; ++ai)
#pragma unroll
            for (int m = 0; m < 4; ++m)
#pragma unroll
                for (int bj = 0; bj < 2; ++bj) f(row0 + ai * HALF + m * 16, col0 + bj * HALF, acc[ai][bj][m][0], acc[ai][bj][m][1]);
    }
};

typedef int i32x4e __attribute__((ext_vector_type(4)));
template <class F> struct EpiGenI {
    static constexpr bool PERM = true, AFTER_DRAIN = false;
    F f; const float* srow; const float* scol;
    __device__ __forceinline__ void operator()(const i32x4e (&acc)[2][2][4][2], const Unit& u, int wr, int wc, int, int) const {
        int ln; asm volatile("v_mbcnt_lo_u32_b32 %0, -1, 0\n\tv_mbcnt_hi_u32_b32 %0, -1, %0" : "=v"(ln));
        const int fr = ln & 15, fq = ln >> 4;
        const int row0 = u.pm * BM + wr * 64 + fr, col0 = u.pn * BM + wc * 32 + 8 * fq;
        float sr[2][4]; f32x4 sc[2][2];
#pragma unroll
        for (int ai = 0; ai < 2; ++ai)
#pragma unroll
            for (int m = 0; m < 4; ++m) sr[ai][m] = srow[row0 + ai * HALF + m * 16];
#pragma unroll
        for (int bj = 0; bj < 2; ++bj) { sc[bj][0] = *(const f32x4*)(scol + col0 + bj * HALF); sc[bj][1] = *(const f32x4*)(scol + col0 + bj * HALF + 4); }
#pragma unroll
        for (int ai = 0; ai < 2; ++ai)
#pragma unroll
            for (int m = 0; m < 4; ++m)
#pragma unroll
                for (int bj = 0; bj < 2; ++bj)
                    f(row0 + ai * HALF + m * 16, col0 + bj * HALF, __builtin_convertvector(acc[ai][bj][m][0], f32x4) * sr[ai][m] * sc[bj][0], __builtin_convertvector(acc[ai][bj][m][1], f32x4) * sr[ai][m] * sc[bj][1]);
    }
};

template <class Epi, class Sched, bool ALIGN_EPI = false, bool SP2 = false>
__device__ __forceinline__ void gemm_phase(PG8_LAS unsigned char* lds, const Gemm g, const Sched& S, const Epi& E) {
    const int tid = tid_opaque(), wid = __builtin_amdgcn_readfirstlane(tid >> 6), lane = tid & 63, wr = wid >> 2, wc = wid & 3, fr = lane & 15, fq = lane >> 4;
    const int K = g.K, nt = K / BK;
    unsigned voffA[2], voffB[2];
#pragma unroll
    for (int i = 0; i < 2; ++i) { int R, C; stage_rc(tid * 16 + i * 8192, R, C); const int Rb = Epi::PERM ? ((R & ~31) + perm32(R & 31)) : R;
        voffA[i] = (unsigned)(R * K + C) * 2u; voffB[i] = (unsigned)(Rb * K + C) * 2u; }
    const size_t kstep = (size_t)(BK * 2);
    const size_t hstep = (size_t)HALF * K * 2;
    const size_t tstep = 2 * hstep;
    const unsigned ldsw = (unsigned)wid * 1024u;
    const int aoff = lds_byte(wr * 64 + fr, fq * 8), boff = lds_byte(wc * 32 + fr, fq * 8);
#define PG8_SA(b, h) (((b) * 2 + (h)) * HTB)
#define PG8_SB(b, h) ((4 + (b) * 2 + (h)) * HTB)
#define PG8_STAGE(bufoff, gbase, voff) do { _Pragma("unroll") for (int _i = 0; _i < 2; ++_i) \
        __builtin_amdgcn_global_load_lds((const unsigned*)((const char*)(gbase) + (voff)[_i]), (PG8_LAS unsigned*)(lds + (bufoff) + ldsw + _i * 8192), 16, 0, 0); } while (0)
#define PG8_LDA(dst, b, h) do { _Pragma("unroll") for (int m = 0; m < 4; ++m) _Pragma("unroll") for (int k = 0; k < 2; ++k) dst[m][k] = *(const PG8_LAS bf16x8*)(lds + PG8_SA(b, h) + aoff + m * 2048 + k * 1024); } while (0)
#define PG8_LDB(dst, b, h) do { _Pragma("unroll") for (int n = 0; n < 2; ++n) _Pragma("unroll") for (int k = 0; k < 2; ++k) dst[n][k] = *(const PG8_LAS bf16x8*)(lds + PG8_SB(b, h) + boff + n * 2048 + k * 1024); } while (0)
#define PG8_MMA(ai, bj, At, Bt) do { __builtin_amdgcn_s_setprio(1); _Pragma("unroll") for (int m = 0; m < 4; ++m) _Pragma("unroll") for (int n = 0; n < 2; ++n) _Pragma("unroll") for (int k = 0; k < 2; ++k) \
        acc[ai][bj][m][n] = __builtin_amdgcn_mfma_f32_16x16x32_bf16(Bt[n][k], At[m][k], acc[ai][bj][m][n], 0, 0, 0); __builtin_amdgcn_s_setprio(0); } while (0)
#define PG8_WAIT_V(n) asm volatile("s_waitcnt vmcnt(" #n ")" ::: "memory")
#define PG8_WAIT_L(n) asm volatile("s_waitcnt lgkmcnt(" #n ")" ::: "memory")
#define PG8_BAR __builtin_amdgcn_s_barrier()
#define PG8_SCHED __builtin_amdgcn_sched_barrier(0)
    Unit cur, nxt; int ui = 0;
    if (!S.next(0, cur)) return;
    f32x4 acc[2][2][4][2];
#pragma unroll
    for (int a = 0; a < 2; ++a)
#pragma unroll
        for (int b = 0; b < 2; ++b)
#pragma unroll
            for (int m = 0; m < 4; ++m)
#pragma unroll
                for (int n = 0; n < 2; ++n) acc[a][b][m][n] = (f32x4){0.f, 0.f, 0.f, 0.f};
    bf16x8 At[4][2], B0[2][2], B1[2][2];
    const char* cA = (const char*)g.A + (size_t)cur.pm * tstep; const char* cB = (const char*)g.Bt + (size_t)cur.pn * tstep;
    S.a_ready(cur);
    if constexpr (SP2) {
        PG8_STAGE(PG8_SB(0, 0), cB, voffB); PG8_STAGE(PG8_SB(0, 1), cB + hstep, voffB); PG8_STAGE(PG8_SA(0, 0), cA, voffA); PG8_STAGE(PG8_SA(0, 1), cA + hstep, voffA);
        if (wr == 1) PG8_BAR;
        PG8_WAIT_V(2); PG8_BAR;
        PG8_STAGE(PG8_SB(1, 0), cB + kstep, voffB); PG8_STAGE(PG8_SA(1, 0), cA + kstep, voffA); PG8_STAGE(PG8_SB(1, 1), cB + hstep + kstep, voffB);
        PG8_WAIT_V(6); PG8_BAR;
    } else {
        PG8_STAGE(PG8_SB(0, 0), cB, voffB); PG8_STAGE(PG8_SA(0, 0), cA, voffA); PG8_STAGE(PG8_SB(0, 1), cB + hstep, voffB); PG8_STAGE(PG8_SA(0, 1), cA + hstep, voffA);
        if (wr == 1) PG8_BAR;
        PG8_WAIT_V(4); PG8_BAR;
        PG8_STAGE(PG8_SB(1, 0), cB + kstep, voffB); PG8_STAGE(PG8_SA(1, 0), cA + kstep, voffA); PG8_STAGE(PG8_SB(1, 1), cB + hstep + kstep, voffB);
        PG8_WAIT_V(6); PG8_BAR;
    }
    for (;;) {
        const bool has_next = S.next(ui + 1, nxt);
        const char* nA = has_next ? (const char*)g.A + (size_t)nxt.pm * tstep : cA; const char* nB = has_next ? (const char*)g.Bt + (size_t)nxt.pn * tstep : cB;
        for (int t = 0; t < nt; t += 2) {
            const bool last = (t == nt - 2);
            const char* a1 = cA + (size_t)(t + 1) * kstep;
            const char* a2 = last ? nA : cA + (size_t)(t + 2) * kstep; const char* b2 = last ? nB : cB + (size_t)(t + 2) * kstep;
            const char* a3 = a2 + kstep; const char* b3 = b2 + kstep;
            if (last && has_next) S.a_ready(nxt);
            if constexpr (SP2) {
            PG8_LDB(B0, 0, 0); PG8_LDB(B1, 0, 1); PG8_SCHED; PG8_LDA(At, 0, 0); PG8_STAGE(PG8_SA(1, 1), a1 + hstep, voffA);
            PG8_WAIT_V(8); PG8_WAIT_L(0); PG8_BAR; PG8_MMA(0, 0, At, B0); PG8_MMA(0, 1, At, B1); PG8_BAR; PG8_SCHED;
            PG8_LDA(At, 0, 1); PG8_STAGE(PG8_SB(0, 0), b2, voffB); PG8_STAGE(PG8_SB(0, 1), b2 + hstep, voffB); PG8_STAGE(PG8_SA(0, 0), a2, voffA);
            PG8_WAIT_V(8); PG8_WAIT_L(0); PG8_BAR; PG8_MMA(1, 0, At, B0); PG8_MMA(1, 1, At, B1); PG8_BAR; PG8_SCHED;
            PG8_LDB(B0, 1, 0); PG8_LDB(B1, 1, 1); PG8_SCHED; PG8_LDA(At, 1, 0); PG8_STAGE(PG8_SA(0, 1), a2 + hstep, voffA);
            PG8_WAIT_V(8); PG8_WAIT_L(0); PG8_BAR; PG8_MMA(0, 0, At, B0); PG8_MMA(0, 1, At, B1); PG8_BAR; PG8_SCHED;
            PG8_LDA(At, 1, 1); PG8_STAGE(PG8_SB(1, 0), b3, voffB); PG8_STAGE(PG8_SB(1, 1), b3 + hstep, voffB); PG8_STAGE(PG8_SA(1, 0), a3, voffA);
            PG8_WAIT_V(8); PG8_WAIT_L(0); PG8_BAR; PG8_MMA(1, 0, At, B0); PG8_MMA(1, 1, At, B1); PG8_BAR; PG8_SCHED;
            } else {
            PG8_LDB(B0, 0, 0); PG8_SCHED; PG8_LDA(At, 0, 0); PG8_STAGE(PG8_SA(1, 1), a1 + hstep, voffA);
            PG8_WAIT_L(8); PG8_BAR; PG8_WAIT_L(0); PG8_MMA(0, 0, At, B0); PG8_BAR; PG8_SCHED;
            PG8_LDB(B1, 0, 1); PG8_STAGE(PG8_SB(0, 0), b2, voffB);
            PG8_BAR; PG8_WAIT_L(0); PG8_MMA(0, 1, At, B1); PG8_BAR;
            PG8_LDA(At, 0, 1); PG8_STAGE(PG8_SA(0, 0), a2, voffA);
            PG8_BAR; PG8_WAIT_L(0); PG8_MMA(1, 0, At, B0); PG8_BAR; PG8_SCHED;
            PG8_STAGE(PG8_SB(0, 1), b2 + hstep, voffB);
            PG8_WAIT_V(6); PG8_BAR; PG8_MMA(1, 1, At, B1); PG8_BAR;
            PG8_LDB(B0, 1, 0); PG8_SCHED; PG8_LDA(At, 1, 0); PG8_STAGE(PG8_SA(0, 1), a2 + hstep, voffA);
            PG8_WAIT_L(8); PG8_BAR; PG8_WAIT_L(0); PG8_MMA(0, 0, At, B0); PG8_BAR; PG8_SCHED;
            PG8_LDB(B1, 1, 1); PG8_STAGE(PG8_SB(1, 0), b3, voffB);
            PG8_BAR; PG8_WAIT_L(0); PG8_MMA(0, 1, At, B1); PG8_BAR;
            PG8_LDA(At, 1, 1); PG8_STAGE(PG8_SA(1, 0), a3, voffA);
            PG8_BAR; PG8_WAIT_L(0); PG8_MMA(1, 0, At, B0); PG8_BAR; PG8_SCHED;
            PG8_STAGE(PG8_SB(1, 1), b3 + hstep, voffB);
            PG8_WAIT_V(6); PG8_BAR; PG8_MMA(1, 1, At, B1); PG8_BAR;
            }
        }
        if constexpr (ALIGN_EPI) { if (wr == 0) PG8_BAR; }
        if constexpr (!Epi::AFTER_DRAIN) { E(acc, cur, wr, wc, fr, fq); S.done(cur); }
        if (!has_next) break;
#pragma unroll
        for (int a = 0; a < 2; ++a)
#pragma unroll
            for (int b = 0; b < 2; ++b)
#pragma unroll
                for (int m = 0; m < 4; ++m)
#pragma unroll
                    for (int n = 0; n < 2; ++n) acc[a][b][m][n] = (f32x4){0.f, 0.f, 0.f, 0.f};
        cur = nxt; cA = nA; cB = nB; ++ui;
        if constexpr (ALIGN_EPI) { if (wr == 1) PG8_BAR; }
    }
    PG8_WAIT_V(0);
    if constexpr (!ALIGN_EPI) { if (wr == 0) PG8_BAR; }
    PG8_BAR;
    if constexpr (Epi::AFTER_DRAIN) { E.fused(acc, cur, wr, wc, fr, fq, lds, wid, lane); S.done(cur); }
#undef PG8_SA
#undef PG8_SB
#undef PG8_STAGE
#undef PG8_LDA
#undef PG8_LDB
#undef PG8_MMA
#undef PG8_WAIT_V
#undef PG8_WAIT_L
#undef PG8_BAR
#undef PG8_SCHED
}
typedef int i32x4 __attribute__((ext_vector_type(4)));
typedef int i32x8 __attribute__((ext_vector_type(8)));
template <class Epi, class Sched, bool ALIGN_EPI = false, bool SP2 = false>
__device__ __forceinline__ void gemm_phase8(PG8_LAS unsigned char* lds, const Gemm g, const Sched& S, const Epi& E) {
    const int tid = tid_opaque(), wid = __builtin_amdgcn_readfirstlane(tid >> 6), lane = tid & 63, wr = wid >> 2, wc = wid & 3, fr = lane & 15, fq = lane >> 4;
    const int K = g.K, nt = K / BK;
    unsigned voffA[2], voffB[2];
#pragma unroll
    for (int i = 0; i < 2; ++i) { int R, C; stage_rc(tid * 16 + i * 8192, R, C); const int Rb = Epi::PERM ? ((R & ~31) + perm32(R & 31)) : R;
        voffA[i] = (unsigned)(R * K + C) * 2u; voffB[i] = (unsigned)(Rb * K + C) * 2u; }
    const size_t rstep64 = (size_t)64 * K * 2;
    const size_t kstep = (size_t)(BK * 2);
    const size_t hstep = (size_t)HALF * K * 2;
    const size_t tstep = 2 * hstep;
    const unsigned ldsw = (unsigned)wid * 1024u;
    const int aoff = lds_byte(wr * 64 + fr, fq * 8), boff = lds_byte(wc * 32 + fr, fq * 8);
#define PG8_SA(b, h) (((b) * 2 + (h)) * HTB)
#define PG8_SB(b, h) ((4 + (b) * 2 + (h)) * HTB)
#define PG8_STAGE(bufoff, gbase, voff) do { _Pragma("unroll") for (int _i = 0; _i < 2; ++_i) \
        __builtin_amdgcn_global_load_lds((const unsigned*)((const char*)(gbase) + (size_t)_i * rstep64 + (voff)[0]), (PG8_LAS unsigned*)(lds + (bufoff) + ldsw + _i * 8192), 16, 0, 0); } while (0)
#define PG8_LD32(p) __builtin_shufflevector(*(const PG8_LAS i32x4*)(p), *(const PG8_LAS i32x4*)((p) + 1024), 0, 1, 2, 3, 4, 5, 6, 7)
#define PG8_LDA(dst, b, h) do { _Pragma("unroll") for (int m = 0; m < 4; ++m) dst[m] = PG8_LD32(lds + PG8_SA(b, h) + aoff + m * 2048); } while (0)
#define PG8_LDB(dst, b, h) do { _Pragma("unroll") for (int n = 0; n < 2; ++n) dst[n] = PG8_LD32(lds + PG8_SB(b, h) + boff + n * 2048); } while (0)
#define PG8_LO4(x) __builtin_shufflevector((x), (x), 0, 1, 2, 3)
#define PG8_HI4(x) __builtin_shufflevector((x), (x), 4, 5, 6, 7)
#define PG8_MMA(ai, bj, At, Bt) do { __builtin_amdgcn_s_setprio(1); \
        _Pragma("unroll") for (int m = 0; m < 4; ++m) _Pragma("unroll") for (int n = 0; n < 2; ++n) acc[ai][bj][m][n] = __builtin_amdgcn_mfma_i32_16x16x64_i8(PG8_LO4(Bt[n]), PG8_LO4(At[m]), acc[ai][bj][m][n], 0, 0, 0); \
        _Pragma("unroll") for (int m = 0; m < 4; ++m) _Pragma("unroll") for (int n = 0; n < 2; ++n) acc[ai][bj][m][n] = __builtin_amdgcn_mfma_i32_16x16x64_i8(PG8_HI4(Bt[n]), PG8_HI4(At[m]), acc[ai][bj][m][n], 0, 0, 0); \
        __builtin_amdgcn_s_setprio(0); } while (0)
#define PG8_WAIT_V(n) asm volatile("s_waitcnt vmcnt(" #n ")" ::: "memory")
#define PG8_WAIT_L(n) asm volatile("s_waitcnt lgkmcnt(" #n ")" ::: "memory")
#define PG8_BAR __builtin_amdgcn_s_barrier()
#define PG8_SCHED __builtin_amdgcn_sched_barrier(0)
    Unit cur, nxt; int ui = 0;
    if (!S.next(0, cur)) return;
    i32x4 acc[2][2][4][2];
#pragma unroll
    for (int a = 0; a < 2; ++a)
#pragma unroll
        for (int b = 0; b < 2; ++b)
#pragma unroll
            for (int m = 0; m < 4; ++m)
#pragma unroll
                for (int n = 0; n < 2; ++n) acc[a][b][m][n] = (i32x4){0, 0, 0, 0};
    i32x8 At[4], B0[2], B1[2];
    const char* cA = (const char*)g.A + (size_t)cur.pm * tstep; const char* cB = (const char*)g.Bt + (size_t)cur.pn * tstep;
    S.a_ready(cur);
    if constexpr (SP2) {
        PG8_STAGE(PG8_SB(0, 0), cB, voffB); PG8_STAGE(PG8_SB(0, 1), cB + hstep, voffB); PG8_STAGE(PG8_SA(0, 0), cA, voffA); PG8_STAGE(PG8_SA(0, 1), cA + hstep, voffA);
        if (wr == 1) PG8_BAR;
        PG8_WAIT_V(2); PG8_BAR;
        PG8_STAGE(PG8_SB(1, 0), cB + kstep, voffB); PG8_STAGE(PG8_SA(1, 0), cA + kstep, voffA); PG8_STAGE(PG8_SB(1, 1), cB + hstep + kstep, voffB);
        PG8_WAIT_V(6); PG8_BAR;
    } else {
        PG8_STAGE(PG8_SB(0, 0), cB, voffB); PG8_STAGE(PG8_SA(0, 0), cA, voffA); PG8_STAGE(PG8_SB(0, 1), cB + hstep, voffB); PG8_STAGE(PG8_SA(0, 1), cA + hstep, voffA);
        if (wr == 1) PG8_BAR;
        PG8_WAIT_V(4); PG8_BAR;
        PG8_STAGE(PG8_SB(1, 0), cB + kstep, voffB); PG8_STAGE(PG8_SA(1, 0), cA + kstep, voffA); PG8_STAGE(PG8_SB(1, 1), cB + hstep + kstep, voffB);
        PG8_WAIT_V(6); PG8_BAR;
    }
    for (;;) {
        const bool has_next = S.next(ui + 1, nxt);
        const char* nA = has_next ? (const char*)g.A + (size_t)nxt.pm * tstep : cA; const char* nB = has_next ? (const char*)g.Bt + (size_t)nxt.pn * tstep : cB;
        for (int t = 0; t < nt; t += 2) {
            const bool last = (t == nt - 2);
            const char* a1 = cA + (size_t)(t + 1) * kstep;
            const char* a2 = last ? nA : cA + (size_t)(t + 2) * kstep; const char* b2 = last ? nB : cB + (size_t)(t + 2) * kstep;
            const char* a3 = a2 + kstep; const char* b3 = b2 + kstep;
            if (last && has_next) S.a_ready(nxt);
            if constexpr (SP2) {
            PG8_LDB(B0, 0, 0); PG8_LDB(B1, 0, 1); PG8_SCHED; PG8_LDA(At, 0, 0); PG8_STAGE(PG8_SA(1, 1), a1 + hstep, voffA);
            PG8_WAIT_V(8); PG8_WAIT_L(0); PG8_BAR; PG8_MMA(0, 0, At, B0); PG8_MMA(0, 1, At, B1); PG8_BAR; PG8_SCHED;
            PG8_LDA(At, 0, 1); PG8_STAGE(PG8_SB(0, 0), b2, voffB); PG8_STAGE(PG8_SB(0, 1), b2 + hstep, voffB); PG8_STAGE(PG8_SA(0, 0), a2, voffA);
            PG8_WAIT_V(8); PG8_WAIT_L(0); PG8_BAR; PG8_MMA(1, 0, At, B0); PG8_MMA(1, 1, At, B1); PG8_BAR; PG8_SCHED;
            PG8_LDB(B0, 1, 0); PG8_LDB(B1, 1, 1); PG8_SCHED; PG8_LDA(At, 1, 0); PG8_STAGE(PG8_SA(0, 1), a2 + hstep, voffA);
            PG8_WAIT_V(8); PG8_WAIT_L(0); PG8_BAR; PG8_MMA(0, 0, At, B0); PG8_MMA(0, 1, At, B1); PG8_BAR; PG8_SCHED;
            PG8_LDA(At, 1, 1); PG8_STAGE(PG8_SB(1, 0), b3, voffB); PG8_STAGE(PG8_SB(1, 1), b3 + hstep, voffB); PG8_STAGE(PG8_SA(1, 0), a3, voffA);
            PG8_WAIT_V(8); PG8_WAIT_L(0); PG8_BAR; PG8_MMA(1, 0, At, B0); PG8_MMA(1, 1, At, B1); PG8_BAR; PG8_SCHED;
            } else {
            PG8_LDB(B0, 0, 0); PG8_SCHED; PG8_LDA(At, 0, 0); PG8_STAGE(PG8_SA(1, 1), a1 + hstep, voffA);
            PG8_WAIT_L(8); PG8_BAR; PG8_WAIT_L(0); PG8_MMA(0, 0, At, B0); PG8_BAR; PG8_SCHED;
            PG8_LDB(B1, 0, 1); PG8_STAGE(PG8_SB(0, 0), b2, voffB);
            PG8_BAR; PG8_WAIT_L(0); PG8_MMA(0, 1, At, B1); PG8_BAR;
            PG8_LDA(At, 0, 1); PG8_STAGE(PG8_SA(0, 0), a2, voffA);
            PG8_BAR; PG8_WAIT_L(0); PG8_MMA(1, 0, At, B0); PG8_BAR; PG8_SCHED;
            PG8_STAGE(PG8_SB(0, 1), b2 + hstep, voffB);
            PG8_WAIT_V(6); PG8_BAR; PG8_MMA(1, 1, At, B1); PG8_BAR;
            PG8_LDB(B0, 1, 0); PG8_SCHED; PG8_LDA(At, 1, 0); PG8_STAGE(PG8_SA(0, 1), a2 + hstep, voffA);
            PG8_WAIT_L(8); PG8_BAR; PG8_WAIT_L(0); PG8_MMA(0, 0, At, B0); PG8_BAR; PG8_SCHED;
            PG8_LDB(B1, 1, 1); PG8_STAGE(PG8_SB(1, 0), b3, voffB);
            PG8_BAR; PG8_WAIT_L(0); PG8_MMA(0, 1, At, B1); PG8_BAR;
            PG8_LDA(At, 1, 1); PG8_STAGE(PG8_SA(1, 0), a3, voffA);
            PG8_BAR; PG8_WAIT_L(0); PG8_MMA(1, 0, At, B0); PG8_BAR; PG8_SCHED;
            PG8_STAGE(PG8_SB(1, 1), b3 + hstep, voffB);
            PG8_WAIT_V(6); PG8_BAR; PG8_MMA(1, 1, At, B1); PG8_BAR;
            }
        }
        if constexpr (ALIGN_EPI) { if (wr == 0) PG8_BAR; }
        if constexpr (!Epi::AFTER_DRAIN) { E(acc, cur, wr, wc, fr, fq); S.done(cur); }
        if (!has_next) break;
#pragma unroll
        for (int a = 0; a < 2; ++a)
#pragma unroll
            for (int b = 0; b < 2; ++b)
#pragma unroll
                for (int m = 0; m < 4; ++m)
#pragma unroll
                    for (int n = 0; n < 2; ++n) acc[a][b][m][n] = (i32x4){0, 0, 0, 0};
        cur = nxt; cA = nA; cB = nB; ++ui;
        if constexpr (ALIGN_EPI) { if (wr == 1) PG8_BAR; }
    }
    PG8_WAIT_V(0);
    if constexpr (!ALIGN_EPI) { if (wr == 0) PG8_BAR; }
    PG8_BAR;
    if constexpr (Epi::AFTER_DRAIN) { E.fused(acc, cur, wr, wc, fr, fq, lds, wid, lane); S.done(cur); }
#undef PG8_SA
#undef PG8_SB
#undef PG8_STAGE
#undef PG8_LDA
#undef PG8_LDB
#undef PG8_MMA
#undef PG8_LD32
#undef PG8_LO4
#undef PG8_HI4
#undef PG8_WAIT_V
#undef PG8_WAIT_L
#undef PG8_BAR
#undef PG8_SCHED
}
}

typedef unsigned short bf16_t;
typedef float f32x4 __attribute__((ext_vector_type(4)));
typedef unsigned u32x4 __attribute__((ext_vector_type(4)));
#define LAS __attribute__((address_space(3)))

constexpr int NT = 512;
constexpr int LDS_BYTES = 160 * 1024;
constexpr int D = 2048, NB = 4, SEQ = 4096, CTXL = 256;
constexpr int MT = NB * SEQ;
constexpr int MC = NB * CTXL;
constexpr int MA = MT + MC;
constexpr int NQKVP = 6400;
constexpr int PQ_LD = 6144;
constexpr int NHY = 6144, NZG = 6144;
constexpr int WT_ROWS = NQKVP + NHY + NZG;
constexpr int WT_HY0 = NQKVP, WT_ZG0 = NQKVP + NHY;
constexpr float ALPHA = 1.189207115002721f;

constexpr size_t MiB = (size_t)1 << 20;
constexpr size_t WS_MOD = 0, WS_HID2 = 1 * MiB, WS_SW = 2 * MiB, WS_HA = 34 * MiB, WS_WT = 102 * MiB, WS_RA = 175 * MiB, WS_RB = 367 * MiB, WS_AB = 580 * MiB, WS_END = 658 * MiB;
constexpr size_t WS_HA8 = 658 * MiB;
constexpr size_t WS_SA = WS_MOD + 512 * 1024, WS_SON = WS_MOD + 600 * 1024, WS_SY = WS_MOD + 680 * 1024, WS_WMAX = WS_MOD + 768 * 1024, WS_SWF = WS_MOD + 896 * 1024;
constexpr int NWROWS = 18688 + 2048;
constexpr size_t WS_WQ8 = WS_HA;
constexpr size_t WS_WSW8 = WS_HA + (size_t)18688 * 2048;
constexpr size_t WS_WP8 = WS_WSW8 + (size_t)2048 * 2048;
constexpr size_t WS_WPMAX = WS_MOD + 256 * 1024;
constexpr size_t WS_XN = WS_RB + 128 * MiB;
constexpr size_t WS_SH2 = WS_SY;
constexpr size_t WT8_OFF = (size_t)6144 * 2048 * 2;

struct Args { const float* in[31]; float* out; unsigned char* ws; int ph_lo, ph_hi; int reps[8]; int pad2[2]; };
typedef const __attribute__((address_space(4))) Args* KA;

__device__ __forceinline__ unsigned f2bf(float f) { unsigned u = __float_as_uint(f); return (u + 0x7fffu + ((u >> 16) & 1u)) >> 16; }
typedef float f32x2 __attribute__((ext_vector_type(2)));
typedef __bf16 bf2_t __attribute__((ext_vector_type(2)));
__device__ __forceinline__ unsigned pk2(float lo, float hi) { const f32x2 v = {lo, hi}; return __builtin_bit_cast(unsigned, __builtin_convertvector(v, bf2_t)); }
__device__ __forceinline__ float bflo(unsigned w) { return __uint_as_float(w << 16); }
__device__ __forceinline__ float bfhi(unsigned w) { return __uint_as_float(w & 0xffff0000u); }
__device__ __forceinline__ float bf2f(bf16_t b) { return __uint_as_float(((unsigned)b) << 16); }
__device__ __forceinline__ void unpack8(const u32x4 w, float (&o)[8]) { o[0] = bflo(w.x); o[1] = bfhi(w.x); o[2] = bflo(w.y); o[3] = bfhi(w.y); o[4] = bflo(w.z); o[5] = bfhi(w.z); o[6] = bflo(w.w); o[7] = bfhi(w.w); }
__device__ __forceinline__ u32x4 pack8(const float (&v)[8]) { u32x4 w; w.x = pk2(v[0], v[1]); w.y = pk2(v[2], v[3]); w.z = pk2(v[4], v[5]); w.w = pk2(v[6], v[7]); return w; }
typedef short bf16x8 __attribute__((ext_vector_type(8)));
typedef unsigned u32x2 __attribute__((ext_vector_type(2)));
#define MFMA16(a, b, c) __builtin_amdgcn_mfma_f32_16x16x32_bf16((a), (b), (c), 0, 0, 0)
__device__ __forceinline__ u32x2 pk4(float a, float b, float c, float d) { u32x2 w; w.x = pk2(a, b); w.y = pk2(c, d); return w; }
__device__ __forceinline__ float fexpf_(float x) { return __builtin_amdgcn_exp2f(x * 1.4426950408889634f); }
__device__ __forceinline__ float sigmoidf_(float x) { return __builtin_amdgcn_rcpf(1.0f + fexpf_(-x)); }
__device__ __forceinline__ float siluf_(float x) { return x * __builtin_amdgcn_rcpf(1.0f + fexpf_(-x)); }
__device__ __forceinline__ float rdlane(float v, const int l) { return __builtin_bit_cast(float, __builtin_amdgcn_readlane(__builtin_bit_cast(int, v), l)); }
__device__ __forceinline__ float wave_sum(float v) {
    v += __builtin_bit_cast(float, __builtin_amdgcn_update_dpp(0, __builtin_bit_cast(int, v), 0x128, 0xf, 0xf, false));
    v += __builtin_bit_cast(float, __builtin_amdgcn_update_dpp(0, __builtin_bit_cast(int, v), 0x124, 0xf, 0xf, false));
    v += __builtin_bit_cast(float, __builtin_amdgcn_update_dpp(0, __builtin_bit_cast(int, v), 0x122, 0xf, 0xf, false));
    v += __builtin_bit_cast(float, __builtin_amdgcn_update_dpp(0, __builtin_bit_cast(int, v), 0x121, 0xf, 0xf, false));
    return (rdlane(v, 0) + rdlane(v, 16)) + (rdlane(v, 32) + rdlane(v, 48));
}
__device__ __forceinline__ float wave_max(float v) {
    v = fmaxf(v, __builtin_bit_cast(float, __builtin_amdgcn_update_dpp(0, __builtin_bit_cast(int, v), 0x128, 0xf, 0xf, false)));
    v = fmaxf(v, __builtin_bit_cast(float, __builtin_amdgcn_update_dpp(0, __builtin_bit_cast(int, v), 0x124, 0xf, 0xf, false)));
    v = fmaxf(v, __builtin_bit_cast(float, __builtin_amdgcn_update_dpp(0, __builtin_bit_cast(int, v), 0x122, 0xf, 0xf, false)));
    v = fmaxf(v, __builtin_bit_cast(float, __builtin_amdgcn_update_dpp(0, __builtin_bit_cast(int, v), 0x121, 0xf, 0xf, false)));
    return fmaxf(fmaxf(rdlane(v, 0), rdlane(v, 16)), fmaxf(rdlane(v, 32), rdlane(v, 48)));
}

__device__ __attribute__((always_inline)) void p0_mod_hid2(KA a, float* lf) {
    const int tid = tid_opaque(), bid = blockIdx.x;
    if (bid < 192) {
        const float* c = a->in[1]; const float* cc = a->in[3]; const float* w_ada = a->in[4]; const float* b_ada = a->in[5];
        float* mod = (float*)(a->ws + WS_MOD);
        for (int i = tid; i < 5 * 2048; i += NT) { const int r = i >> 11, k = i & 2047; const float v = (r < 4) ? c[r * 2048 + k] : cc[k]; lf[i] = siluf_(v); }
        __syncthreads();
        const int cl = tid & 63, kg = tid >> 6, col = bid * 64 + cl;
        float a0 = 0.f, a1 = 0.f, a2 = 0.f, a3 = 0.f, a4 = 0.f;
#pragma unroll 32
        for (int k = kg * 256; k < kg * 256 + 256; ++k) {
            const float w = __builtin_nontemporal_load(w_ada + (size_t)k * 12288 + col);
            a0 += lf[k] * w; a1 += lf[2048 + k] * w; a2 += lf[4096 + k] * w; a3 += lf[6144 + k] * w; a4 += lf[8192 + k] * w;
        }
        float* red = lf + 5 * 2048;
        red[(kg * 5 + 0) * 64 + cl] = a0; red[(kg * 5 + 1) * 64 + cl] = a1; red[(kg * 5 + 2) * 64 + cl] = a2; red[(kg * 5 + 3) * 64 + cl] = a3; red[(kg * 5 + 4) * 64 + cl] = a4;
        __syncthreads();
        if (tid < 320) { const int r = tid >> 6; float s = 0.f;
#pragma unroll
            for (int g = 0; g < 8; ++g) s += red[(g * 5 + r) * 64 + cl];
            mod[r * 12288 + col] = s + b_ada[col]; }
        __syncthreads();
    } else {
        const float* w1 = a->in[12]; const float* b1 = a->in[13]; const float* w2 = a->in[14]; const float* b2 = a->in[15]; const float* freq = a->in[18];
        float* hid2 = (float*)(a->ws + WS_HID2);
        const int pb = (bid - 192) * 64, j = tid & 63, pl = tid >> 6;
        const float fj = freq[j];
        for (int it = 0; it < 8; ++it) {
            const int pos = pb + it * 8 + pl;
            const float tt = (float)pos * (1.0f / 4095.0f);
            float s1 = tt * w1[j];
            for (int e = 0; e < 16; ++e) {
                const float band = 1e-4f + (float)e * ((15.0f - 1e-4f) / 15.0f);
                const float rev = __builtin_amdgcn_fractf((float)pos * band * (1.0f / 4096.0f));
                s1 += __builtin_amdgcn_cosf(rev) * w1[(1 + e) * 64 + j] - __builtin_amdgcn_sinf(rev) * w1[(17 + e) * 64 + j];
            }
            lf[pl * 64 + j] = __builtin_amdgcn_sinf(__builtin_amdgcn_fractf(fj * (s1 + b1[j]) * 0.15915494309189535f));
            __syncthreads();
            float s2 = 0.f;
            for (int i = 0; i < 64; ++i) s2 += lf[pl * 64 + i] * w2[i * 64 + j];
            hid2[pos * 64 + j] = __builtin_amdgcn_sinf(__builtin_amdgcn_fractf(fj * (s2 + b2[j]) * 0.15915494309189535f));
            __syncthreads();
        }
    }
}

__device__ __attribute__((always_inline)) void transpose_unit(const float* src, int ldn, int n0src, bf16_t* dst, int nb, int kb, float* tile) {
    const int tid = tid_opaque(), r = tid >> 4, c4 = tid & 15;
#pragma unroll
    for (int i = 0; i < 4; ++i) {
        const int kk = i * 32 + r;
        f32x4 v = (f32x4){0.f, 0.f, 0.f, 0.f};
        if (n0src >= 0) v = *(const f32x4*)(src + (size_t)(kb * 128 + kk) * ldn + n0src + c4 * 4);
        float* t = tile + kk * 65 + c4 * 4; t[0] = v.x; t[1] = v.y; t[2] = v.z; t[3] = v.w;
    }
    __syncthreads();
#pragma unroll
    for (int i = 0; i < 2; ++i) {
        const int chunk = tid + i * NT, nr = chunk >> 4, kc = chunk & 15;
        const float* t = tile + (kc * 8) * 65 + nr;
        u32x4 w; w.x = pk2(t[0], t[65]); w.y = pk2(t[130], t[195]); w.z = pk2(t[260], t[325]); w.w = pk2(t[390], t[455]);
        *(u32x4*)(dst + (size_t)(nb * 64 + nr) * 2048 + kb * 128 + kc * 8) = w;
    }
    __syncthreads();
}
__device__ __forceinline__ float clamp_e4m3(float x) { return __builtin_amdgcn_fmed3f(x, -448.0f, 448.0f); }
__device__ __forceinline__ unsigned pk4_fp8(float a, float b, float c, float d) { int w = __builtin_amdgcn_cvt_pk_fp8_f32(clamp_e4m3(a), clamp_e4m3(b), 0, false); w = __builtin_amdgcn_cvt_pk_fp8_f32(clamp_e4m3(c), clamp_e4m3(d), w, true); return (unsigned)w; }
__device__ __attribute__((always_inline)) void transpose_unit8(const float* src, int ldn, int n0src, unsigned char* dst, int nb, int kb, float* tile) {
    const int tid = tid_opaque(), r = tid >> 4, c4 = tid & 15;
#pragma unroll
    for (int i = 0; i < 4; ++i) {
        const int kk = i * 32 + r;
        f32x4 v = (f32x4){0.f, 0.f, 0.f, 0.f};
        if (n0src >= 0) v = *(const f32x4*)(src + (size_t)(kb * 128 + kk) * ldn + n0src + c4 * 4);
        float* t = tile + kk * 65 + c4 * 4; t[0] = v.x * 64.0f; t[1] = v.y * 64.0f; t[2] = v.z * 64.0f; t[3] = v.w * 64.0f;
    }
    __syncthreads();
    {
        const int nr = tid >> 3, kc = tid & 7;
        const float* t = tile + (kc * 16) * 65 + nr;
        u32x4 w;
        w.x = pk4_fp8(t[0], t[65], t[130], t[195]); w.y = pk4_fp8(t[260], t[325], t[390], t[455]);
        w.z = pk4_fp8(t[520], t[585], t[650], t[715]); w.w = pk4_fp8(t[780], t[845], t[910], t[975]);
        *(u32x4*)(dst + (size_t)(nb * 64 + nr) * 2048 + kb * 128 + kc * 16) = w;
    }
    __syncthreads();
}
__device__ __forceinline__ int win_colmap(int np) {
    if (np < 6144) return np;
    if (np < 6208) return 8192 + (np - 6144);
    if (np < 6400) return -1;
    if (np < 12544) return 8256 + (np - 6400);
    if (np < 14592) return 6144 + (np - 12544);
    return 14400 + (np - 14592);
}
struct TrUnit { const float* src; int ldn, n0src, nb, kb, fp8; unsigned char* dst; };
__device__ __forceinline__ TrUnit tr_unit_of(KA a, int u) {
    bf16_t* WT = (bf16_t*)(a->ws + WS_WT); bf16_t* SW = (bf16_t*)(a->ws + WS_SW);
    const int NU_WT = (WT_ROWS / 64) * 16;
    TrUnit t;
    if (u < NU_WT) { const int nb = u >> 4; t.kb = u & 15; t.src = a->in[6]; t.ldn = 18496; t.n0src = win_colmap(nb * 64);
        t.fp8 = nb * 64;   t.dst = (unsigned char*)WT; t.nb = nb; }
    else { const int v = u - NU_WT, mtx = v >> 9; t.nb = (v >> 4) & 31; t.kb = v & 15; t.fp8 = 18688 + mtx * 2048 + t.nb * 64; t.ldn = 2048; t.n0src = t.nb * 64;
        t.src = (mtx == 0) ? a->in[20] : (mtx == 1) ? a->in[21] : (mtx == 2) ? a->in[22] : a->in[25]; t.dst = (unsigned char*)(SW + (size_t)mtx * 2048 * 2048); }
    return t;
}
__device__ __forceinline__ float row_max16(float v);
__device__ __forceinline__ float row_sum16(float v);
__device__ __attribute__((always_inline)) void p0_transposes(KA a, float* lf) {
    const int NU = (WT_ROWS / 64) * 16 + 3 * 32 * 16;
    const int tid = tid_opaque(), r = tid >> 4, c4 = tid & 15;
    float* wmaxp = (float*)(a->ws + WS_RB);
    int u = blockIdx.x;
    f32x4 pre[4];
    if (u < NU) { const TrUnit t = tr_unit_of(a, u);
#pragma unroll
        for (int i = 0; i < 4; ++i) pre[i] = (t.n0src >= 0) ? __builtin_nontemporal_load((const f32x4*)(t.src + (size_t)(t.kb * 128 + i * 32 + r) * t.ldn + t.n0src + c4 * 4)) : (f32x4){0.f, 0.f, 0.f, 0.f}; }
    __syncthreads();
#pragma unroll 1
    for (int k = 0; u < NU; ++k, u += gridDim.x) {
        const TrUnit t = tr_unit_of(a, u);
        float* tile = lf + (k & 1) * (128 * 65);
#pragma unroll
        for (int i = 0; i < 4; ++i) { float* tp = tile + (i * 32 + r) * 65 + c4 * 4; tp[0] = pre[i].x; tp[1] = pre[i].y; tp[2] = pre[i].z; tp[3] = pre[i].w; }
        __syncthreads();
        const int un = u + gridDim.x;
        if (un < NU) { const TrUnit tn = tr_unit_of(a, un);
#pragma unroll
            for (int i = 0; i < 4; ++i) pre[i] = (tn.n0src >= 0) ? __builtin_nontemporal_load((const f32x4*)(tn.src + (size_t)(tn.kb * 128 + i * 32 + r) * tn.ldn + tn.n0src + c4 * 4)) : (f32x4){0.f, 0.f, 0.f, 0.f}; }
#pragma unroll
        for (int i = 0; i < 2; ++i) {
            const int chunk = tid + i * NT, nr = chunk >> 4, kc = chunk & 15;
            const float* tp = tile + (kc * 8) * 65 + nr;
            u32x4 w; w.x = pk2(tp[0], tp[65]); w.y = pk2(tp[130], tp[195]); w.z = pk2(tp[260], tp[325]); w.w = pk2(tp[390], tp[455]);
            *(u32x4*)((bf16_t*)t.dst + (size_t)(t.nb * 64 + nr) * 2048 + t.kb * 128 + kc * 8) = w;
            float m = fmaxf(fmaxf(fmaxf(fabsf(tp[0]), fabsf(tp[65])), fmaxf(fabsf(tp[130]), fabsf(tp[195]))), fmaxf(fmaxf(fabsf(tp[260]), fabsf(tp[325])), fmaxf(fabsf(tp[390]), fabsf(tp[455]))));
            m = row_max16(m);
            if (kc == 0) wmaxp[(size_t)(t.fp8 + nr) * 16 + t.kb] = m;
        }
    }
    __syncthreads();
}

__device__ __forceinline__ unsigned pk4_i8(float a, float b, float c, float d) {
    const int ia = __float2int_rn(a), ib = __float2int_rn(b), ic = __float2int_rn(c), id = __float2int_rn(d);
    return (unsigned)(ia & 255) | ((unsigned)(ib & 255) << 8) | ((unsigned)(ic & 255) << 16) | ((unsigned)id << 24);
}
__device__ __attribute__((always_inline)) void p1_ha(KA a) {
    const float* mod = (const float*)(a->ws + WS_MOD); unsigned char* HA8 = a->ws + WS_HA8; float* SA = (float*)(a->ws + WS_SA);
    const int lane = tid_opaque() & 63, wv = blockIdx.x * 8 + (tid_opaque() >> 6), nwv = gridDim.x * 8;
    float* PM = (float*)g_lds;
    __syncthreads();
    for (int i = tid_opaque(); i < 5 * 1024; i += NT) { const int r = i >> 10, c4 = (i & 1023) * 4; *(f32x4*)(PM + r * 4096 + c4) = *(const f32x4*)(mod + r * 12288 + c4); }
    __syncthreads();
    f32x4 nx[8];
    if (wv < MA) { const float* sp = (wv < MT) ? a->in[0] + (size_t)wv * 2048 : a->in[2] + (size_t)(wv - MT) * 2048;
#pragma unroll
        for (int j = 0; j < 8; ++j) nx[j] = __builtin_nontemporal_load((const f32x4*)(sp + j * 256 + lane * 4)); }
#pragma unroll 1
    for (int row = wv; row < MA; row += nwv) {
        f32x4 x[8];
#pragma unroll
        for (int j = 0; j < 8; ++j) x[j] = nx[j];
        const int rn = row + nwv;
        if (rn < MA) { const float* sp = (rn < MT) ? a->in[0] + (size_t)rn * 2048 : a->in[2] + (size_t)(rn - MT) * 2048;
#pragma unroll
            for (int j = 0; j < 8; ++j) nx[j] = __builtin_nontemporal_load((const f32x4*)(sp + j * 256 + lane * 4)); }
        const float* mp = PM + ((row < MT) ? (row >> 12) : 4) * 4096;
        float m = 0.f;
#pragma unroll
        for (int j = 0; j < 8; ++j) { const f32x4 hh = *(const f32x4*)(mp + j * 256 + lane * 4), ss = *(const f32x4*)(mp + 2048 + j * 256 + lane * 4);
#pragma unroll
            for (int e = 0; e < 4; ++e) { x[j][e] = x[j][e] * (1.0f + ss[e]) + hh[e]; m = fmaxf(m, fabsf(x[j][e])); } }
        m = wave_max(m);
        const float sc = (m > 0.f) ? m * (1.0f / 127.0f) : 1.0f, inv = 1.0f / sc;
#pragma unroll
        for (int j = 0; j < 8; ++j) *(unsigned*)(HA8 + (size_t)row * 2048 + j * 256 + lane * 4) = pk4_i8(x[j][0] * inv, x[j][1] * inv, x[j][2] * inv, x[j][3] * inv);
        if (lane == 0) SA[row] = sc;
    }
}
__device__ __attribute__((always_inline)) void p1_wquant(KA a) {
    const float* wmaxp = (const float*)(a->ws + WS_RB); float* swf = (float*)(a->ws + WS_SWF);
    const bf16_t* WT = (const bf16_t*)(a->ws + WS_WT); const bf16_t* SW = (const bf16_t*)(a->ws + WS_SW); unsigned char* WQ = a->ws + WS_WQ8;
    const int lane = tid_opaque() & 63, wv = blockIdx.x * 8 + (tid_opaque() >> 6), nwv = gridDim.x * 8;
#pragma unroll 1
    for (int r0 = wv; r0 < NWROWS; r0 += 2 * nwv) {
        u32x4 w[2][4]; float mx[2]; bool ok[2];
#pragma unroll
        for (int q = 0; q < 2; ++q) { const int r = r0 + q * nwv; ok[q] = r < NWROWS; const int rc = ok[q] ? r : r0;
            const bf16_t* sp = (rc < 18688) ? WT + (size_t)rc * 2048 : SW + (size_t)(rc - 18688) * 2048;
#pragma unroll
            for (int j = 0; j < 4; ++j) w[q][j] = *(const u32x4*)(sp + j * 512 + lane * 8);
            const f32x4 p0 = *(const f32x4*)(wmaxp + (size_t)rc * 16), p1 = *(const f32x4*)(wmaxp + (size_t)rc * 16 + 4), p2 = *(const f32x4*)(wmaxp + (size_t)rc * 16 + 8), p3 = *(const f32x4*)(wmaxp + (size_t)rc * 16 + 12);
            mx[q] = fmaxf(fmaxf(fmaxf(fmaxf(p0[0], p0[1]), fmaxf(p0[2], p0[3])), fmaxf(fmaxf(p1[0], p1[1]), fmaxf(p1[2], p1[3]))), fmaxf(fmaxf(fmaxf(p2[0], p2[1]), fmaxf(p2[2], p2[3])), fmaxf(fmaxf(p3[0], p3[1]), fmaxf(p3[2], p3[3])))); }
#pragma unroll
        for (int q = 0; q < 2; ++q) {
            if (!ok[q]) continue;
            const int r = r0 + q * nwv;
            const float sc = (mx[q] > 0.f) ? mx[q] * (1.0f / 127.0f) : 1.0f, inv = 1.0f / sc;
#pragma unroll
            for (int j = 0; j < 4; ++j) { float v[8]; unpack8(w[q][j], v);
                u32x2 o; o.x = pk4_i8(v[0] * inv, v[1] * inv, v[2] * inv, v[3] * inv); o.y = pk4_i8(v[4] * inv, v[5] * inv, v[6] * inv, v[7] * inv);
                *(u32x2*)(WQ + (size_t)r * 2048 + j * 512 + lane * 8) = o; }
            if (lane == 0) swf[r] = sc;
        }
    }
}

struct FStoreBf16 { bf16_t* O; int ldc; float sc;
    __device__ __forceinline__ void operator()(int row, int col, const f32x4 a0, const f32x4 a1) const {
        const f32x4 v0 = a0 * sc, v1 = a1 * sc;
        u32x4 w; w.x = pg8::cvt_pk_bf16(v0[0], v0[1]); w.y = pg8::cvt_pk_bf16(v0[2], v0[3]); w.z = pg8::cvt_pk_bf16(v1[0], v1[1]); w.w = pg8::cvt_pk_bf16(v1[2], v1[3]);
        *(u32x4*)(O + (size_t)row * ldc + col) = w; } };
struct FStoreQKV { bf16_t* PQ; float* AB;
    __device__ __forceinline__ void operator()(int row, int col, const f32x4 v0, const f32x4 v1) const {
        if (col < 6144) { u32x4 w; w.x = pg8::cvt_pk_bf16(v0[0], v0[1]); w.y = pg8::cvt_pk_bf16(v0[2], v0[3]); w.z = pg8::cvt_pk_bf16(v1[0], v1[1]); w.w = pg8::cvt_pk_bf16(v1[2], v1[3]);
            *(u32x4*)(PQ + (size_t)row * PQ_LD + col) = w; }
        else if (col < 6208) { float* p = AB + (size_t)row * 64 + (col - 6144); *(f32x4*)p = v0; *(f32x4*)(p + 4) = v1; } } };
struct FStoreF32 { float* O; int ldc;
    __device__ __forceinline__ void operator()(int row, int col, const f32x4 v0, const f32x4 v1) const { float* p = O + (size_t)row * ldc + col; *(f32x4*)p = v0; *(f32x4*)(p + 4) = v1; } };
struct FGatePA { const bf16_t* ZG; bf16_t* MG;
    __device__ __forceinline__ void operator()(int row, int col, const f32x4 v0, const f32x4 v1) const {
        float g[8]; unpack8(*(const u32x4*)(ZG + (size_t)row * NZG + 2048 + col), g);
        float o[8];
#pragma unroll
        for (int e = 0; e < 4; ++e) { o[e] = sigmoidf_(g[e]) * v0[e]; o[4 + e] = sigmoidf_(g[4 + e]) * v1[e]; }
        *(u32x4*)(MG + (size_t)row * 2048 + col) = pack8(o); } };
struct FGatePH { const bf16_t* ZG; bf16_t* MG;
    __device__ __forceinline__ void operator()(int row, int col, const f32x4 v0, const f32x4 v1) const {
        float g[8], t[8]; unpack8(*(const u32x4*)(ZG + (size_t)row * NZG + 4096 + col), g); unpack8(*(const u32x4*)(MG + (size_t)row * 2048 + col), t);
        float o[8];
#pragma unroll
        for (int e = 0; e < 4; ++e) { o[e] = t[e] + sigmoidf_(g[e]) * v0[e]; o[4 + e] = t[4 + e] + sigmoidf_(g[4 + e]) * v1[e]; }
        *(u32x4*)(MG + (size_t)row * 2048 + col) = pack8(o); } };
struct FOut { const float* x; const float* mod; bf16_t* T3;
    __device__ __forceinline__ void operator()(int row, int col, const f32x4 v0, const f32x4 v1) const {
        const float* xp = x + (size_t)row * 2048 + col; const float* gp = mod + (row >> 12) * 12288 + 4096 + col;
        const f32x4 x0 = *(const f32x4*)xp, x1 = *(const f32x4*)(xp + 4), g0 = *(const f32x4*)gp, g1 = *(const f32x4*)(gp + 4);
        const f32x4 t0 = ALPHA * x0 + g0 * v0, t1 = ALPHA * x1 + g1 * v1;
        u32x4 w; w.x = pk2(t0[0], t0[1]); w.y = pk2(t0[2], t0[3]); w.z = pk2(t1[0], t1[1]); w.w = pk2(t1[2], t1[3]);
        *(u32x4*)(T3 + (size_t)row * 2048 + col) = w;
    } };

template <class F> __device__ __forceinline__ void run_gemm8(unsigned char* lds, const unsigned char* A8, const unsigned char* Bt8, int M, int N, const float* srow, const float* scol, const F& f) {
    pg8::Gemm g{(const bf16_t*)A8, (const bf16_t*)Bt8, M, N, 1024}; pg8::StaticOrder S; S.init(M, N, (int)gridDim.x, (int)blockIdx.x);
    pg8::EpiGenI<F> E{f, srow, scol};
    pg8::gemm_phase8<pg8::EpiGenI<F>, pg8::StaticOrder, true, true>((PG8_LAS unsigned char*)lds, g, S, E);
}
template <class F> __device__ __forceinline__ void run_gemm(unsigned char* lds, const bf16_t* A, const bf16_t* Bt, int M, int N, const F& f) {
    pg8::Gemm g{A, Bt, M, N, 2048}; pg8::StaticOrder S; S.init(M, N, (int)gridDim.x, (int)blockIdx.x);
    pg8::EpiGen<F> E{f};
    pg8::gemm_phase<pg8::EpiGen<F>, pg8::StaticOrder, true, true>((PG8_LAS unsigned char*)lds, g, S, E);
}

constexpr int HY_Z = 0, HY_F = 69632, HY_TW4 = 139264, HY_TW8 = 141312, HY_TW32 = 143360, HY_W3 = 143488;
__device__ __forceinline__ f32x2 cmul(const f32x2 a, const f32x2 b) { return (f32x2){a.x * b.x - a.y * b.y, a.x * b.y + a.y * b.x}; }
__device__ __forceinline__ f32x2 cmulc(const f32x2 a, const f32x2 b) { return (f32x2){a.x * b.x + a.y * b.y, a.y * b.x - a.x * b.y}; }
template <bool INV> __device__ __forceinline__ f32x2 ctw(const f32x2 v, const float wr, const float wi) {
    return INV ? (f32x2){v.x * wr + v.y * wi, v.y * wr - v.x * wi} : (f32x2){v.x * wr - v.y * wi, v.y * wr + v.x * wi};
}
template <bool INV> __device__ __forceinline__ void dft16(f32x2 (&x)[16]) {
    constexpr float C = 0.9238795325112867f, S = 0.3826834323650898f, R = 0.7071067811865476f;
    f32x2 A[4][4];
#pragma unroll
    for (int q0 = 0; q0 < 4; ++q0) {
        const f32x2 a = x[q0], b = x[4 + q0], c = x[8 + q0], d = x[12 + q0];
        const f32x2 t0 = a + c, t1 = a - c, t2 = b + d, t3 = b - d;
        const f32x2 m = (f32x2){t3.y, -t3.x};
        A[q0][0] = t0 + t2; A[q0][2] = t0 - t2;
        A[q0][1] = INV ? (t1 - m) : (t1 + m); A[q0][3] = INV ? (t1 + m) : (t1 - m);
    }
    A[1][1] = ctw<INV>(A[1][1], C, -S); A[1][2] = ctw<INV>(A[1][2], R, -R); A[1][3] = ctw<INV>(A[1][3], S, -C);
    A[2][1] = ctw<INV>(A[2][1], R, -R); A[2][2] = ctw<INV>(A[2][2], 0.f, -1.f); A[2][3] = ctw<INV>(A[2][3], -R, -R);
    A[3][1] = ctw<INV>(A[3][1], S, -C); A[3][2] = ctw<INV>(A[3][2], -R, -R); A[3][3] = ctw<INV>(A[3][3], -C, S);
#pragma unroll
    for (int s = 0; s < 4; ++s) {
        const f32x2 t0 = A[0][s] + A[2][s], t1 = A[0][s] - A[2][s], t2 = A[1][s] + A[3][s], t3 = A[1][s] - A[3][s];
        const f32x2 m = (f32x2){t3.y, -t3.x};
        x[s] = t0 + t2; x[s + 8] = t0 - t2;
        x[s + 4] = INV ? (t1 - m) : (t1 + m); x[s + 12] = INV ? (t1 + m) : (t1 - m);
    }
}
template <bool INV> __device__ __forceinline__ void apply_tw(f32x2 (&x)[16], const f32x2 w) {
    f32x2 wr = w;
#pragma unroll
    for (int r = 1; r < 16; ++r) { x[r] = INV ? cmulc(x[r], wr) : cmul(x[r], wr); if (r < 15) wr = cmul(wr, w); }
}
__device__ __forceinline__ void fft_pass2_fwd(f32x2* B, int t, const f32x2* TW4) {
    const int base = 272 * (t >> 4) + (t & 15); f32x2 x[16];
#pragma unroll
    for (int q = 0; q < 16; ++q) x[q] = B[base + 17 * q];
    dft16<false>(x); apply_tw<false>(x, TW4[16 * (t & 15)]);
#pragma unroll
    for (int q = 0; q < 16; ++q) B[base + 17 * q] = x[q];
}
__device__ __forceinline__ void fft_pass2_inv(f32x2* B, int t, const f32x2* TW4) {
    const int base = 272 * (t >> 4) + (t & 15); f32x2 x[16];
#pragma unroll
    for (int q = 0; q < 16; ++q) x[q] = B[base + 17 * q];
    apply_tw<true>(x, TW4[16 * (t & 15)]); dft16<true>(x);
#pragma unroll
    for (int q = 0; q < 16; ++q) B[base + 17 * q] = x[q];
}
__device__ __forceinline__ float conv3_lane(float c, int lane, float w0, float w1, float w2) {
    (void)lane;
    const float up = __builtin_bit_cast(float, __builtin_amdgcn_update_dpp(0, __builtin_bit_cast(int, c), 0x138, 0xf, 0xf, true));
    const float dn = __builtin_bit_cast(float, __builtin_amdgcn_update_dpp(0, __builtin_bit_cast(int, c), 0x130, 0xf, 0xf, true));
    return w0 * up + w1 * c + w2 * dn;
}
constexpr size_t WS_FILT = 585 * MiB;
__device__ __attribute__((always_inline)) void filt_unit(KA a, int unit, unsigned char* lds) {
    const int tid = tid_opaque(), lane = tid & 63, w = tid >> 6, fr = lane & 15, fq = lane >> 4;
    const int c0 = (unit >> 3) * 64, pc = (unit & 7) * 512;
    bf16_t* Bt = (bf16_t*)lds;
    const float* w3 = a->in[16]; const float* b3 = a->in[17]; const float* hid2 = (const float*)(a->ws + WS_HID2);
    bf16_t* FILT = (bf16_t*)(a->ws + WS_FILT);
    __syncthreads();
#pragma unroll
    for (int i = 0; i < 8; ++i) {
        const int idx = tid + i * NT, k = idx >> 6, q = (idx >> 4) & 3, c4 = idx & 15;
        const f32x4 v = *(const f32x4*)(w3 + (size_t)k * 8192 + (q >> 1) * 4096 + (q & 1) * 2048 + c0 + c4 * 4);
        bf16_t* bp = Bt + (q * 64 + c4 * 4) * 72 + k;
        bp[0] = (bf16_t)f2bf(v.x); bp[72] = (bf16_t)f2bf(v.y); bp[144] = (bf16_t)f2bf(v.z); bp[216] = (bf16_t)f2bf(v.w);
    }
    __syncthreads();
#pragma unroll 1
    for (int it = 0; it < 4; ++it) {
        const int p0 = pc + (it * 8 + w) * 16;
        bf16x8 af[2];
#pragma unroll
        for (int kk = 0; kk < 2; ++kk) { const float* hp = hid2 + (size_t)(p0 + fr) * 64 + kk * 32 + fq * 8; const f32x4 x0 = *(const f32x4*)hp, x1 = *(const f32x4*)(hp + 4);
            u32x4 wv; wv.x = pk2(x0[0], x0[1]); wv.y = pk2(x0[2], x0[3]); wv.z = pk2(x1[0], x1[1]); wv.w = pk2(x1[2], x1[3]); af[kk] = __builtin_bit_cast(bf16x8, wv); }
#pragma unroll 4
        for (int n = 0; n < 16; ++n) {
            f32x4 acc = (f32x4){0.f, 0.f, 0.f, 0.f};
#pragma unroll
            for (int kk = 0; kk < 2; ++kk) acc = MFMA16(af[kk], *(const bf16x8*)(Bt + (n * 16 + fr) * 72 + kk * 32 + fq * 8), acc);
            const int q = n >> 2, c = c0 + (n & 3) * 16 + fr;
            const float bias = b3[(q >> 1) * 4096 + (q & 1) * 2048 + c];
            const float dl = (3.0701134573253944f + 12.280453829301578f * ((float)c * (1.0f / 2047.0f))) * (1.0f / 4095.0f);
            const int pos = p0 + 4 * fq;
            const float e0 = fexpf_(-(float)pos * dl), e1 = fexpf_(-(float)(pos + 1) * dl), e2 = fexpf_(-(float)(pos + 2) * dl), e3 = fexpf_(-(float)(pos + 3) * dl);
            *(u32x2*)(FILT + ((size_t)c * 4 + q) * 4096 + pos) = pk4((acc[0] + bias) * e0, (acc[1] + bias) * e1, (acc[2] + bias) * e2, (acc[3] + bias) * e3);
        }
    }
}
__device__ __attribute__((always_inline)) void wprime_unit(KA a, int unit, unsigned char* lds) {
    const int tid = tid_opaque(), lane = tid & 63, w = tid >> 6, fr = lane & 15, fq = lane >> 4;
    const int hp = unit >> 4, kb = unit & 15;
    bf16_t* Aw = (bf16_t*)lds; bf16_t* Bs = (bf16_t*)(lds + 34816);
    float* pm = (float*)(lds + 69632);
    const float* wq = a->in[25]; const float* subk = a->in[26];
    bf16_t* WPT = (bf16_t*)(a->ws + WS_SW) + (size_t)3 * D * D;
    __syncthreads();
#pragma unroll
    for (int i = 0; i < 8; ++i) {
        const int idx = tid + i * NT, r = idx >> 5, c4 = (idx & 31) * 4;
        const f32x4 va = *(const f32x4*)(wq + (size_t)(kb * 128 + r) * 2048 + hp * 128 + c4);
        const f32x4 vb = *(const f32x4*)(subk + (size_t)(hp * 128 + r) * 128 + c4);
        *(u32x2*)(Aw + r * 136 + c4) = pk4(va[0], va[1], va[2], va[3]); *(u32x2*)(Bs + r * 136 + c4) = pk4(vb[0], vb[1], vb[2], vb[3]);
    }
    __syncthreads();
    bf16x8 af[4];
#pragma unroll
    for (int kk = 0; kk < 4; ++kk) af[kk] = *(const bf16x8*)(Aw + (w * 16 + fr) * 136 + kk * 32 + fq * 8);
#pragma unroll
    for (int nt = 0; nt < 8; ++nt) {
        f32x4 acc = (f32x4){0.f, 0.f, 0.f, 0.f};
#pragma unroll
        for (int kk = 0; kk < 4; ++kk) acc = MFMA16(af[kk], *(const bf16x8*)(Bs + (nt * 16 + fr) * 136 + kk * 32 + fq * 8), acc);
        *(u32x2*)(WPT + (size_t)(hp * 128 + nt * 16 + fr) * 2048 + kb * 128 + w * 16 + 4 * fq) = pk4(acc[0], acc[1], acc[2], acc[3]);
        float m = fmaxf(fmaxf(fabsf(acc[0]), fabsf(acc[1])), fmaxf(fabsf(acc[2]), fabsf(acc[3])));
        m = fmaxf(m, __shfl_xor(m, 16, 64)); m = fmaxf(m, __shfl_xor(m, 32, 64));
        if (fq == 0) pm[w * 128 + nt * 16 + fr] = m;
    }
    __syncthreads();
    if (tid < 128) { float m = pm[tid];
#pragma unroll
        for (int ww = 1; ww < 8; ++ww) m = fmaxf(m, pm[ww * 128 + tid]);
        ((float*)(a->ws + WS_WPMAX))[(size_t)(hp * 128 + tid) * 16 + kb] = m; }
}
__device__ __attribute__((always_inline)) void hyena_setup(unsigned char* lds) {
    const int tid = tid_opaque();
    f32x2* TW4 = (f32x2*)(lds + HY_TW4); f32x2* TW8 = (f32x2*)(lds + HY_TW8); f32x2* TW32 = (f32x2*)(lds + HY_TW32);
    if (tid < 256) { const float a4 = -6.283185307179586f * (float)tid * (1.0f / 4096.0f), a8 = -6.283185307179586f * (float)tid * (1.0f / 8192.0f);
        TW4[tid] = (f32x2){cosf(a4), sinf(a4)}; TW8[tid] = (f32x2){cosf(a8), sinf(a8)}; }
    if (tid < 16) { const float a = -6.283185307179586f * (float)tid * (1.0f / 32.0f); TW32[tid] = (f32x2){cosf(a), sinf(a)}; }
    __syncthreads();
}
struct HyCtx { f32x2* Z; f32x2* Fb0; const f32x2* TW4; const f32x2* TW32; const bf16_t* rv; const bf16_t* rx1; const bf16_t* rx2; bf16_t* YTc; float* Y1S;
    f32x2 w8t, w4t; float cv0, cv1, cv2, cx0, cx1, cx2, cy0, cy1, cy2, sk0, sk1; int tid, br, t, lane, p1; };
template <int ORDER> __device__ __forceinline__ void hyena_conv(const HyCtx& K, int pr) {
    f32x2* Z = K.Z; const f32x2* TW4 = K.TW4; const f32x2* TW32 = K.TW32;
    const bf16_t* rv = K.rv; const bf16_t* rx1 = K.rx1; const bf16_t* rx2 = K.rx2; float* Y1S = K.Y1S;
    int tid = K.tid; asm volatile("" : "+v"(tid));
    const f32x2 w8t = K.w8t, w4t = K.w4t; const int br = tid >> 8, t = tid & 255, lane = tid & 63, p1 = t + (t >> 4);
    f32x2* Zb = K.Z + br * 4352; f32x2* Fb = K.Fb0 + br * 4352;
    const float cv0 = K.cv0, cv1 = K.cv1, cv2 = K.cv2, cx0 = K.cx0, cx1 = K.cx1, cx2 = K.cx2, cy0 = K.cy0, cy1 = K.cy1, cy2 = K.cy2, sk0 = K.sk0, sk1 = K.sk1;
        const int ba = 2 * pr * 4096, bb = ba + 4096;
        {
            f32x2 x[16];
#pragma unroll
            for (int q = 0; q < 16; ++q) {
                const int n = t + 256 * q; float ua, ub;
                if (ORDER == 0) { ua = conv3_lane(bf2f(rv[ba + n]), lane, cv0, cv1, cv2); ub = conv3_lane(bf2f(rv[bb + n]), lane, cv0, cv1, cv2); }
                else { ua = Y1S[n]; ub = Y1S[4096 + n]; }
                const f32x2 z = (f32x2){ua, ub};
                x[q] = br ? cmul(z, cmul(w8t, TW32[q])) : z;
            }
            dft16<false>(x); apply_tw<false>(x, w4t);
#pragma unroll
            for (int q = 0; q < 16; ++q) Zb[p1 + 272 * q] = x[q];
        }
        __syncthreads();
        fft_pass2_fwd(Zb, t, TW4);
        __syncthreads();
        {
            f32x2 x[16];
#pragma unroll
            for (int q = 0; q < 16; ++q) x[q] = Zb[17 * t + q];
            dft16<false>(x);
#pragma unroll
            for (int r = 0; r < 16; ++r) {
                const int p = 16 * t + r; int pp;
                if (br) pp = 4095 - p;
                else { const int m = (r << 8) | ((t & 15) << 4) | (t >> 4); const int mp = (4096 - m) & 4095; pp = ((mp & 15) << 8) | (mp & 0xF0) | (mp >> 8); }
                const f32x2 fk = Fb[p + (p >> 4)], fc = Fb[pp + (pp >> 4)];
                f32x2 H;
                if (ORDER == 0) H = (f32x2){0.5f * (fk.x + fc.x), 0.5f * (fk.y - fc.y)};
                else H = (f32x2){0.5f * (fk.y + fc.y), -0.5f * (fk.x - fc.x)};
                x[r] = cmul(x[r], H);
            }
            dft16<true>(x);
#pragma unroll
            for (int q = 0; q < 16; ++q) Zb[17 * t + q] = x[q];
        }
        __syncthreads();
        fft_pass2_inv(Zb, t, TW4);
        __syncthreads();
        {
            f32x2 x[16];
#pragma unroll
            for (int q = 0; q < 16; ++q) x[q] = Zb[p1 + 272 * q];
            apply_tw<true>(x, w4t); dft16<true>(x);
            if (br) {
#pragma unroll
                for (int q = 0; q < 16; ++q) x[q] = cmulc(x[q], cmul(w8t, TW32[q]));
            }
#pragma unroll
            for (int q = 0; q < 16; ++q) Zb[p1 + 272 * q] = x[q];
        }
        __syncthreads();
        {
            float in0[8], in1[8], in2[8], in3[8];
#pragma unroll
            for (int i = 0; i < 8; ++i) {
                const int n = tid + i * NT;
                if (ORDER == 0) { in0[i] = bf2f(rv[ba + n]); in1[i] = bf2f(rv[bb + n]); in2[i] = bf2f(rx1[ba + n]); in3[i] = bf2f(rx1[bb + n]); }
                else { in0[i] = Y1S[n]; in1[i] = Y1S[4096 + n]; in2[i] = bf2f(rx2[ba + n]); in3[i] = bf2f(rx2[bb + n]); }
            }
#pragma unroll
            for (int i = 0; i < 8; ++i) {
                const int n = tid + i * NT, pn = n + (n >> 4);
                const f32x2 e0 = Z[pn], e1 = Z[4352 + pn];
                const float ca = (e0.x + e1.x) * (1.0f / 8192.0f), cb = (e0.y + e1.y) * (1.0f / 8192.0f);
                if (ORDER == 0) {
                    const float va = conv3_lane(in0[i], lane, cv0, cv1, cv2), vb = conv3_lane(in1[i], lane, cv0, cv1, cv2);
                    const float xa = conv3_lane(in2[i], lane, cx0, cx1, cx2), xb = conv3_lane(in3[i], lane, cx0, cx1, cx2);
                    Y1S[n] = xa * (ca + sk0 * va); Y1S[4096 + n] = xb * (cb + sk0 * vb);
                } else {
                    const float xa = conv3_lane(in2[i], lane, cy0, cy1, cy2), xb = conv3_lane(in3[i], lane, cy0, cy1, cy2);
                    K.YTc[ba + n] = (bf16_t)f2bf(xa * (ca + sk1 * in0[i])); K.YTc[bb + n] = (bf16_t)f2bf(xb * (cb + sk1 * in1[i]));
                }
            }
        }
        __syncthreads();
}
__device__ __attribute__((always_inline)) void hyena_item(KA a, int c, unsigned char* lds) {
    f32x2* Z = (f32x2*)(lds + HY_Z); f32x2* F = (f32x2*)(lds + HY_F);
    const f32x2* TW4 = (const f32x2*)(lds + HY_TW4); const f32x2* TW8 = (const f32x2*)(lds + HY_TW8); const f32x2* TW32 = (const f32x2*)(lds + HY_TW32);
    float* W3 = (float*)(lds + HY_W3);
    int tid = tid_opaque(); asm volatile("" : "+v"(tid));
    const int br = tid >> 8, t = tid & 255, lane = tid & 63;
    f32x2* Zb = Z + br * 4352; f32x2* Fb = F + br * 4352;
    const float* hid2 = (const float*)(a->ws + WS_HID2);
    const float* w3 = a->in[16]; const float* b3 = a->in[17]; const float* cw = a->in[11]; const float* skip = a->in[19];
    const bf16_t* PHT = (const bf16_t*)(a->ws + WS_RA);
    bf16_t* YT = (bf16_t*)a->out;
    float* Y1S = a->out + (size_t)16 * 1024 * 1024 + (size_t)blockIdx.x * 16384;
    {
        const bf16_t* fp = (const bf16_t*)(a->ws + WS_FILT) + (size_t)c * 4 * 4096 + tid * 8;
        float f0[8], f1[8], f2[8], f3[8];
        unpack8(*(const u32x4*)fp, f0); unpack8(*(const u32x4*)(fp + 4096), f1); unpack8(*(const u32x4*)(fp + 8192), f2); unpack8(*(const u32x4*)(fp + 12288), f3);
#pragma unroll
        for (int e = 0; e < 8; ++e) { Z[tid * 8 + e] = (f32x2){f0[e], f1[e]}; Z[4096 + tid * 8 + e] = (f32x2){f2[e], f3[e]}; }
    }
    __syncthreads();
    const f32x2 w8t = TW8[t], w4t = TW4[t];
    const int p1 = t + (t >> 4);
    {
        f32x2 x[16];
#pragma unroll
        for (int q = 0; q < 16; ++q) {
            const int n = t + 256 * q;
            const f32x2 av = Z[n]; f32x2 bv = Z[8192 - (n ? n : 1)]; if (n == 0) bv = (f32x2){0.f, 0.f};
            x[q] = br ? cmul(av - bv, cmul(w8t, TW32[q])) : (av + bv);
        }
        dft16<false>(x); apply_tw<false>(x, w4t);
#pragma unroll
        for (int q = 0; q < 16; ++q) Fb[p1 + 272 * q] = x[q];
    }
    __syncthreads();
    fft_pass2_fwd(Fb, t, TW4);
    __syncthreads();
    {   f32x2 x[16];
#pragma unroll
        for (int q = 0; q < 16; ++q) x[q] = Fb[17 * t + q];
        dft16<false>(x);
#pragma unroll
        for (int q = 0; q < 16; ++q) Fb[17 * t + q] = x[q];
    }
    __syncthreads();
    const float cv0 = cw[c], cv1 = cw[6144 + c], cv2 = cw[12288 + c];
    const float cx0 = cw[2048 + c], cx1 = cw[6144 + 2048 + c], cx2 = cw[12288 + 2048 + c];
    const float cy0 = cw[4096 + c], cy1 = cw[6144 + 4096 + c], cy2 = cw[12288 + 4096 + c];
    const float sk0 = skip[c], sk1 = skip[2048 + c];
    const bf16_t* rv = PHT + (size_t)c * MT; const bf16_t* rx1 = PHT + (size_t)(2048 + c) * MT; const bf16_t* rx2 = PHT + (size_t)(4096 + c) * MT;
    HyCtx K; K.Z = Z; K.Fb0 = F; K.TW4 = TW4; K.TW32 = TW32; K.rv = rv; K.rx1 = rx1; K.rx2 = rx2; K.YTc = YT + (size_t)c * MT; K.Y1S = Y1S;
    K.w8t = w8t; K.w4t = w4t; K.cv0 = cv0; K.cv1 = cv1; K.cv2 = cv2; K.cx0 = cx0; K.cx1 = cx1; K.cx2 = cx2; K.cy0 = cy0; K.cy1 = cy1; K.cy2 = cy2; K.sk0 = sk0; K.sk1 = sk1;
    K.tid = tid; K.br = br; K.t = t; K.lane = lane; K.p1 = p1;
#pragma unroll 1
    for (int pr = 0; pr < 2; ++pr) { hyena_conv<0>(K, pr); hyena_conv<1>(K, pr); }
}

constexpr int H2_ZT = 0, H2_YS = 36864, H2_F = 110592, H2_FS = 4097, H2_TW8 = 143368, H2_TW32 = 145416;
struct Hy2W { bf16x8 wr[2], wi[2], wn[2]; };
__device__ __forceinline__ bf16x8 h2frag(const bf16_t* plane, int row, int kk, int fq) { return *(const bf16x8*)(plane + row * 72 + kk * 32 + fq * 8); }
template <int WROLE, int CONJ> __device__ __forceinline__ void h2tile(const bf16_t* Pr, const bf16_t* Pi, int row0, const Hy2W& W, int fr, int fq, f32x4& ar, f32x4& ai) {
    ar = (f32x4){0.f, 0.f, 0.f, 0.f}; ai = (f32x4){0.f, 0.f, 0.f, 0.f};
#pragma unroll
    for (int kk = 0; kk < 2; ++kk) {
        const bf16x8 dr = h2frag(Pr, row0 + fr, kk, fq), di = h2frag(Pi, row0 + fr, kk, fq);
        if (WROLE == 0) { ar = MFMA16(dr, W.wr[kk], ar); ar = MFMA16(di, CONJ ? W.wi[kk] : W.wn[kk], ar); ai = MFMA16(dr, CONJ ? W.wn[kk] : W.wi[kk], ai); ai = MFMA16(di, W.wr[kk], ai); }
        else { ar = MFMA16(W.wr[kk], dr, ar); ar = MFMA16(CONJ ? W.wi[kk] : W.wn[kk], di, ar); ai = MFMA16(CONJ ? W.wn[kk] : W.wi[kk], dr, ai); ai = MFMA16(W.wr[kk], di, ai); }
    }
}
struct Hy2T { f32x2 t[4][4]; };
__device__ __attribute__((always_inline)) void hyena2_setup(unsigned char* lds, Hy2W& W, Hy2T& T) {
    const int tid = tid_opaque(), lane = tid & 63, fr = lane & 15, fq = lane >> 4, wt = (tid >> 6) & 3;
    f32x2* TW8 = (f32x2*)(lds + H2_TW8); f32x2* TW32 = (f32x2*)(lds + H2_TW32);
    if (tid < 256) { const float a8 = -6.283185307179586f * (float)tid * (1.0f / 8192.0f); TW8[tid] = (f32x2){cosf(a8), sinf(a8)}; }
    if (tid < 16) { const float a = -6.283185307179586f * (float)tid * (1.0f / 32.0f); TW32[tid] = (f32x2){cosf(a), sinf(a)}; }
#pragma unroll
    for (int kk = 0; kk < 2; ++kk)
#pragma unroll
        for (int j = 0; j < 8; ++j) {
            const int m = ((16 * wt + fr) * (kk * 32 + fq * 8 + j)) & 63;
            const float ang = -6.283185307179586f * (float)m * (1.0f / 64.0f), c = cosf(ang), s = sinf(ang);
            W.wr[kk][j] = (short)f2bf(c); W.wi[kk][j] = (short)f2bf(s); W.wn[kk][j] = (short)f2bf(-s);
        }
#pragma unroll
    for (int mt = 0; mt < 4; ++mt)
#pragma unroll
        for (int r = 0; r < 4; ++r) { const float ang = (float)((16 * wt + fr) * (mt * 16 + 4 * fq + r)) * (6.283185307179586f / 4096.0f); T.t[mt][r] = (f32x2){cosf(ang), sinf(ang)}; }
    __syncthreads();
}
struct Hy2Ctx { unsigned char* lds; const bf16_t* rv; const bf16_t* rx1; const bf16_t* rx2; bf16_t* YTc; float cv0, cv1, cv2, cx0, cx1, cx2, cy0, cy1, cy2, sk0, sk1; };
#define H2BAR() do { asm volatile("s_waitcnt lgkmcnt(0)" ::: "memory"); __builtin_amdgcn_s_barrier(); asm volatile("" ::: "memory"); } while (0)
template <int FMODE> __device__ __forceinline__ void h2_forward(unsigned char* lds, const Hy2W& W, const Hy2T& T, int tid) {
    const int lane = tid & 63, w = tid >> 6, br = w >> 2, wt = w & 3, fr = lane & 15, fq = lane >> 4;
    bf16_t* ZTr = (bf16_t*)(lds + H2_ZT + br * 18432); bf16_t* ZTi = ZTr + 4608;
    bf16_t* Yr = (bf16_t*)(lds + H2_YS + br * 36864); bf16_t* Yi = Yr + 4608; bf16_t* Sr = Yi + 4608; bf16_t* Si = Sr + 4608;
    unsigned* Fq = (unsigned*)(lds + H2_F) + br * H2_FS;
    const unsigned* Fk = Fq + 64 * (16 * wt + 4 * fq) + fr; const unsigned* Fm = Fq + ((br ? 4095 : 4096) - (64 * (16 * wt + 4 * fq) + fr)) - 240;
#pragma unroll
    for (int mt = 0; mt < 4; ++mt) {
        f32x4 ar, ai; h2tile<0, 0>(ZTr, ZTi, mt * 16, W, fr, fq, ar, ai);
        const int k1 = 16 * wt + fr;
        float vr[4], vi[4];
#pragma unroll
        for (int r = 0; r < 4; ++r) { const float c = T.t[mt][r].x, s = T.t[mt][r].y; vr[r] = ar[r] * c + ai[r] * s; vi[r] = ai[r] * c - ar[r] * s; }
        *(u32x2*)(Yr + k1 * 72 + mt * 16 + 4 * fq) = pk4(vr[0], vr[1], vr[2], vr[3]); *(u32x2*)(Yi + k1 * 72 + mt * 16 + 4 * fq) = pk4(vi[0], vi[1], vi[2], vi[3]);
    }
    H2BAR();
#pragma unroll
    for (int nt = 0; nt < 4; ++nt) {
        f32x4 ar, ai; h2tile<1, 0>(Yr, Yi, nt * 16, W, fr, fq, ar, ai);
        const int k1 = nt * 16 + fr;
        if (FMODE == 0) {
#pragma unroll
            for (int r = 0; r < 4; ++r) { const int k = k1 + 64 * (16 * wt + 4 * fq + r); const unsigned v = pk2(ar[r], ai[r]); Fq[k] = v; if (k == 0) Fq[4096] = v; }
        } else {
            float vr[4], vi[4];
#pragma unroll
            for (int r = 0; r < 4; ++r) {
                const unsigned fa = Fk[64 * r + 16 * nt], fb = Fm[240 - 64 * r - 16 * nt];
                const float fkr = bflo(fa), fki = bfhi(fa), fcr = bflo(fb), fci = bfhi(fb);
                float hr, hi;
                if (FMODE == 1) { hr = 0.5f * (fkr + fcr); hi = 0.5f * (fki - fci); } else { hr = 0.5f * (fki + fci); hi = -0.5f * (fkr - fcr); }
                vr[r] = ar[r] * hr - ai[r] * hi; vi[r] = ar[r] * hi + ai[r] * hr;
            }
            *(u32x2*)(Sr + k1 * 72 + 16 * wt + 4 * fq) = pk4(vr[0], vr[1], vr[2], vr[3]); *(u32x2*)(Si + k1 * 72 + 16 * wt + 4 * fq) = pk4(vi[0], vi[1], vi[2], vi[3]);
        }
    }
    H2BAR();
}
__device__ __forceinline__ void h2_inverse(unsigned char* lds, const Hy2W& W, const Hy2T& T, int tid) {
    const int lane = tid & 63, w = tid >> 6, br = w >> 2, wt = w & 3, fr = lane & 15, fq = lane >> 4;
    const f32x2* TW8 = (const f32x2*)(lds + H2_TW8); const f32x2* TW32 = (const f32x2*)(lds + H2_TW32);
    bf16_t* ZTr = (bf16_t*)(lds + H2_ZT + br * 18432); bf16_t* ZTi = ZTr + 4608;
    bf16_t* Sr = (bf16_t*)(lds + H2_YS + br * 36864) + 9216; bf16_t* Si = Sr + 4608;
#pragma unroll
    for (int mt = 0; mt < 4; ++mt) {
        f32x4 ar, ai; h2tile<0, 1>(Sr, Si, mt * 16, W, fr, fq, ar, ai);
        const int n2 = 16 * wt + fr;
        float vr[4], vi[4];
#pragma unroll
        for (int r = 0; r < 4; ++r) { const float c = T.t[mt][r].x, s = T.t[mt][r].y; vr[r] = ar[r] * c - ai[r] * s; vi[r] = ai[r] * c + ar[r] * s; }
        *(u32x2*)(ZTr + n2 * 72 + mt * 16 + 4 * fq) = pk4(vr[0], vr[1], vr[2], vr[3]); *(u32x2*)(ZTi + n2 * 72 + mt * 16 + 4 * fq) = pk4(vi[0], vi[1], vi[2], vi[3]);
    }
    H2BAR();
    f32x2* E = (f32x2*)(lds + H2_YS);
#pragma unroll
    for (int nt = 0; nt < 4; ++nt) {
        f32x4 ar, ai; h2tile<1, 1>(ZTr, ZTi, nt * 16, W, fr, fq, ar, ai);
#pragma unroll
        for (int r = 0; r < 4; ++r) {
            const int n = 64 * (16 * wt + 4 * fq + r) + nt * 16 + fr;
            f32x2 e = (f32x2){ar[r], ai[r]};
            if (br) e = cmulc(e, cmul(TW8[n & 255], TW32[n >> 8]));
            E[br * 4096 + n] = e;
        }
    }
    H2BAR();
}
__device__ __forceinline__ void h2_pass0(unsigned char* lds, const float (&ua)[8], const float (&ub)[8], int w, int lane) {
    const f32x2* TW8 = (const f32x2*)(lds + H2_TW8); const f32x2* TW32 = (const f32x2*)(lds + H2_TW32);
    bf16_t* ZT = (bf16_t*)(lds + H2_ZT) + lane * 72 + 8 * w;
    float o0[8], o1[8];
#pragma unroll
    for (int i = 0; i < 8; ++i) { const int n = 64 * (8 * w + i) + lane; const f32x2 wv = cmul(TW8[n & 255], TW32[n >> 8]); o0[i] = ua[i] * wv.x - ub[i] * wv.y; o1[i] = ua[i] * wv.y + ub[i] * wv.x; }
    *(u32x4*)ZT = pack8(ua); *(u32x4*)(ZT + 4608) = pack8(ub); *(u32x4*)(ZT + 9216) = pack8(o0); *(u32x4*)(ZT + 13824) = pack8(o1);
}
__device__ __forceinline__ void hyena2_pair(const Hy2Ctx& K, const Hy2W& W, const Hy2T& T, int pr) {
    unsigned char* lds = K.lds;
    int tid = tid_opaque();
    const int lane = tid & 63, w = tid >> 6;
    const int ba = 2 * pr * 4096, bb = ba + 4096;
    const f32x2* E = (const f32x2*)(lds + H2_YS);
    float va[8], vb[8], xa[8], xb[8];
#pragma unroll
    for (int i = 0; i < 8; ++i) { const int n = 64 * (8 * w + i) + lane; va[i] = bf2f(K.rv[ba + n]); vb[i] = bf2f(K.rv[bb + n]); }
#pragma unroll
    for (int i = 0; i < 8; ++i) { va[i] = conv3_lane(va[i], lane, K.cv0, K.cv1, K.cv2); vb[i] = conv3_lane(vb[i], lane, K.cv0, K.cv1, K.cv2); }
    h2_pass0(lds, va, vb, w, lane);
    H2BAR();
#pragma unroll
    for (int i = 0; i < 8; ++i) { const int n = 64 * (8 * w + i) + lane; xa[i] = bf2f(K.rx1[ba + n]); xb[i] = bf2f(K.rx1[bb + n]); }
    h2_forward<1>(lds, W, T, tid);
    h2_inverse(lds, W, T, tid);
    float ya[8], yb[8];
#pragma unroll
    for (int i = 0; i < 8; ++i) {
        const int n = 64 * (8 * w + i) + lane;
        const f32x2 e0 = E[n], e1 = E[4096 + n];
        const float ca = (e0.x + e1.x) * (1.0f / 8192.0f), cb = (e0.y + e1.y) * (1.0f / 8192.0f);
        ya[i] = conv3_lane(xa[i], lane, K.cx0, K.cx1, K.cx2) * (ca + K.sk0 * va[i]); yb[i] = conv3_lane(xb[i], lane, K.cx0, K.cx1, K.cx2) * (cb + K.sk0 * vb[i]);
    }
    h2_pass0(lds, ya, yb, w, lane);
    H2BAR();
    float za[8], zb[8];
#pragma unroll
    for (int i = 0; i < 8; ++i) { const int n = 64 * (8 * w + i) + lane; za[i] = bf2f(K.rx2[ba + n]); zb[i] = bf2f(K.rx2[bb + n]); }
    h2_forward<2>(lds, W, T, tid);
    h2_inverse(lds, W, T, tid);
#pragma unroll
    for (int i = 0; i < 8; ++i) {
        const int n = 64 * (8 * w + i) + lane;
        const f32x2 e0 = E[n], e1 = E[4096 + n];
        const float ca = (e0.x + e1.x) * (1.0f / 8192.0f), cb = (e0.y + e1.y) * (1.0f / 8192.0f);
        K.YTc[ba + n] = (bf16_t)f2bf(conv3_lane(za[i], lane, K.cy0, K.cy1, K.cy2) * (ca + K.sk1 * ya[i]));
        K.YTc[bb + n] = (bf16_t)f2bf(conv3_lane(zb[i], lane, K.cy0, K.cy1, K.cy2) * (cb + K.sk1 * yb[i]));
    }
    H2BAR();
}
__device__ __attribute__((always_inline)) void hyena2_item(KA a, int c, unsigned char* lds, const Hy2W& W, const Hy2T& T) {
    int tid = tid_opaque();
    const int lane = tid & 63, w = tid >> 6;
    const float* cw = a->in[11]; const float* skip = a->in[19];
    const bf16_t* PHT = (const bf16_t*)(a->ws + WS_RA);
    {
        const bf16_t* fp = (const bf16_t*)(a->ws + WS_FILT) + (size_t)c * 4 * 4096;
        float sr[8], si[8], dr[8], di[8];
#pragma unroll
        for (int i = 0; i < 8; ++i) { const int n = 64 * (8 * w + i) + lane, m = n ? (4096 - n) : 0;
            const float a0 = bf2f(fp[n]), a1 = bf2f(fp[4096 + n]); float b0 = bf2f(fp[8192 + m]), b1 = bf2f(fp[12288 + m]);
            if (n == 0) { b0 = 0.f; b1 = 0.f; }
            sr[i] = a0 + b0; si[i] = a1 + b1; dr[i] = a0 - b0; di[i] = a1 - b1; }
        const f32x2* TW8 = (const f32x2*)(lds + H2_TW8); const f32x2* TW32 = (const f32x2*)(lds + H2_TW32);
        bf16_t* ZT = (bf16_t*)(lds + H2_ZT) + lane * 72 + 8 * w;
        float o0[8], o1[8];
#pragma unroll
        for (int i = 0; i < 8; ++i) { const int n = 64 * (8 * w + i) + lane; const f32x2 wv = cmul(TW8[n & 255], TW32[n >> 8]); o0[i] = dr[i] * wv.x - di[i] * wv.y; o1[i] = dr[i] * wv.y + di[i] * wv.x; }
        *(u32x4*)ZT = pack8(sr); *(u32x4*)(ZT + 4608) = pack8(si); *(u32x4*)(ZT + 9216) = pack8(o0); *(u32x4*)(ZT + 13824) = pack8(o1);
    }
    H2BAR();
    h2_forward<0>(lds, W, T, tid);
    Hy2Ctx K; K.lds = lds; K.rv = PHT + (size_t)c * MT; K.rx1 = PHT + (size_t)(2048 + c) * MT; K.rx2 = PHT + (size_t)(4096 + c) * MT;
    K.YTc = (bf16_t*)a->out + (size_t)c * MT;
    K.cv0 = cw[c]; K.cv1 = cw[6144 + c]; K.cv2 = cw[12288 + c]; K.cx0 = cw[2048 + c]; K.cx1 = cw[6144 + 2048 + c]; K.cx2 = cw[12288 + 2048 + c];
    K.cy0 = cw[4096 + c]; K.cy1 = cw[6144 + 4096 + c]; K.cy2 = cw[12288 + 4096 + c]; K.sk0 = skip[c]; K.sk1 = skip[2048 + c];
#pragma unroll 1
    for (int pr = 0; pr < 2; ++pr) hyena2_pair(K, W, T, pr);
}

__device__ __attribute__((always_inline)) void qkvpost_unit(KA a, int unit, unsigned char* lds) {
    const int tid = tid_opaque();
    int ntok, row0, wh;
    if (unit < 12288) { const int gr = unit / 48; wh = unit % 48; ntok = 64; row0 = gr * 64; }
    else { const int uu = unit - 12288; const int b = uu / 48; wh = uu % 48; ntok = 256; row0 = MT + b * 256; }
    const int which = wh >> 4, h = wh & 15, colbase = which * 2048 + h * 128;
    bf16_t* PQ = (bf16_t*)(a->ws + WS_RB);
    bf16_t* raw = (bf16_t*)lds; float* wl = (float*)(lds + 65536);
    const float* cwt = a->in[7];
    for (int i = tid; i < ntok * 16; i += NT) { const int r = i >> 4, c8 = i & 15; *(u32x4*)(raw + r * 128 + c8 * 8) = *(const u32x4*)(PQ + (size_t)(row0 + r) * PQ_LD + colbase + c8 * 8); }
    for (int i = tid; i < 640; i += NT) wl[i] = cwt[(i >> 7) * 6144 + colbase + (i & 127)];
    __syncthreads();
    const int r = tid >> 3, cg = tid & 7;
    for (int rb = 0; rb < ntok / 64; ++rb) {
        const int tok = rb * 64 + r;
        float v[16]; float ss = 0.f;
#pragma unroll
        for (int e = 0; e < 16; ++e) v[e] = 0.f;
#pragma unroll
        for (int j = 0; j < 5; ++j) {
            const int tt = tok + j - 2;
            if (tt >= 0 && tt < ntok) {
                float p0[8], p1[8]; unpack8(*(const u32x4*)(raw + tt * 128 + cg * 16), p0); unpack8(*(const u32x4*)(raw + tt * 128 + cg * 16 + 8), p1);
                const float* wp = wl + j * 128 + cg * 16;
#pragma unroll
                for (int e = 0; e < 8; ++e) { v[e] += wp[e] * p0[e]; v[8 + e] += wp[8 + e] * p1[e]; }
            }
        }
#pragma unroll
        for (int e = 0; e < 16; ++e) { const float s = siluf_(v[e]); v[e] = s; ss += s * s; }
        if (which < 2) {
            ss += __shfl_xor(ss, 1, 64); ss += __shfl_xor(ss, 2, 64); ss += __shfl_xor(ss, 4, 64);
            const float sc = rsqrtf(ss + 1e-6f) * (which == 0 ? 0.08838834764831845f : 1.0f);
#pragma unroll
            for (int e = 0; e < 16; ++e) v[e] *= sc;
        }
        bf16_t* op = PQ + (size_t)(row0 + tok) * PQ_LD + colbase + cg * 16;
        u32x4 w0, w1;
        w0.x = pk2(v[0], v[1]); w0.y = pk2(v[2], v[3]); w0.z = pk2(v[4], v[5]); w0.w = pk2(v[6], v[7]);
        w1.x = pk2(v[8], v[9]); w1.y = pk2(v[10], v[11]); w1.z = pk2(v[12], v[13]); w1.w = pk2(v[14], v[15]);
        *(u32x4*)op = w0; *(u32x4*)(op + 8) = w1;
    }
    __syncthreads();
}

__device__ __attribute__((always_inline)) void qkvpost_latent(KA a, unsigned char* lds) {
    const int tid = tid_opaque(), r = tid >> 3, cg = tid & 7;
    bf16_t* PQ = (bf16_t*)(a->ws + WS_RB); const float* cwt = a->in[7];
    const int G = gridDim.x;
    u32x4 pA0, pA1, pB0, pB1, pC0, pC1; float wA0, wA1 = 0.f, wB0, wB1 = 0.f, wC0, wC1 = 0.f;
#define QP_LOAD(P0_, P1_, W0_, W1_, u_) do { if ((u_) < 12288) { \
        const int gr_ = (u_) / 48, wh_ = (u_) % 48, cb_ = (wh_ >> 4) * 2048 + (wh_ & 15) * 128, r0_ = gr_ * 64; \
        P0_ = *(const u32x4*)(PQ + (size_t)(r0_ + (tid >> 4)) * PQ_LD + cb_ + (tid & 15) * 8); \
        P1_ = *(const u32x4*)(PQ + (size_t)(r0_ + 32 + (tid >> 4)) * PQ_LD + cb_ + (tid & 15) * 8); \
        W0_ = cwt[(tid >> 7) * 6144 + cb_ + (tid & 127)]; if (tid < 128) W1_ = cwt[4 * 6144 + cb_ + tid]; } } while (0)
#define QP_BODY(P0_, P1_, W0_, W1_, u_, k_) do { \
        bf16_t* raw = (bf16_t*)(lds + ((k_) & 1) * 16384); float* wl = (float*)(lds + 32768 + ((k_) & 1) * 2560); \
        *(u32x4*)(raw + (tid >> 4) * 128 + (tid & 15) * 8) = P0_; *(u32x4*)(raw + (32 + (tid >> 4)) * 128 + (tid & 15) * 8) = P1_; \
        wl[tid] = W0_; if (tid < 128) wl[512 + tid] = W1_; \
        __syncthreads(); \
        const int gr = (u_) / 48, wh = (u_) % 48, which = wh >> 4, colbase = which * 2048 + (wh & 15) * 128, row0 = gr * 64; \
        QP_LOAD(P0_, P1_, W0_, W1_, (u_) + 3 * G); \
        float v[16]; float ss = 0.f; \
        _Pragma("unroll") for (int e = 0; e < 16; ++e) v[e] = 0.f; \
        _Pragma("unroll") for (int j = 0; j < 5; ++j) { \
            const int tt = r + j - 2; \
            if (tt >= 0 && tt < 64) { \
                float p0[8], p1[8]; unpack8(*(const u32x4*)(raw + tt * 128 + cg * 16), p0); unpack8(*(const u32x4*)(raw + tt * 128 + cg * 16 + 8), p1); \
                const float* wp = wl + j * 128 + cg * 16; \
                _Pragma("unroll") for (int e = 0; e < 8; ++e) { v[e] += wp[e] * p0[e]; v[8 + e] += wp[8 + e] * p1[e]; } \
            } \
        } \
        _Pragma("unroll") for (int e = 0; e < 16; ++e) { const float sv = siluf_(v[e]); v[e] = sv; ss += sv * sv; } \
        if (which < 2) { \
            ss += __shfl_xor(ss, 1, 64); ss += __shfl_xor(ss, 2, 64); ss += __shfl_xor(ss, 4, 64); \
            const float sc = rsqrtf(ss + 1e-6f) * (which == 0 ? 0.08838834764831845f : 1.0f); \
            _Pragma("unroll") for (int e = 0; e < 16; ++e) v[e] *= sc; \
        } \
        bf16_t* op = PQ + (size_t)(row0 + r) * PQ_LD + colbase + cg * 16; \
        u32x4 w0, w1; \
        w0.x = pk2(v[0], v[1]); w0.y = pk2(v[2], v[3]); w0.z = pk2(v[4], v[5]); w0.w = pk2(v[6], v[7]); \
        w1.x = pk2(v[8], v[9]); w1.y = pk2(v[10], v[11]); w1.z = pk2(v[12], v[13]); w1.w = pk2(v[14], v[15]); \
        *(u32x4*)op = w0; *(u32x4*)(op + 8) = w1; } while (0)
    int u = blockIdx.x;
    QP_LOAD(pA0, pA1, wA0, wA1, u); QP_LOAD(pB0, pB1, wB0, wB1, u + G); QP_LOAD(pC0, pC1, wC0, wC1, u + 2 * G);
#pragma unroll 1
    for (int k = 0; u < 12288; k += 3, u += 3 * G) {
        QP_BODY(pA0, pA1, wA0, wA1, u, k);
        if (u + G < 12288) QP_BODY(pB0, pB1, wB0, wB1, u + G, k + 1);
        if (u + 2 * G < 12288) QP_BODY(pC0, pC1, wC0, wC1, u + 2 * G, k + 2);
    }
#undef QP_LOAD
#undef QP_BODY
    __syncthreads();
}

typedef short bf16x8 __attribute__((ext_vector_type(8)));
constexpr size_t WS_TS = 585 * MiB, WS_GCB = 653 * MiB;

__device__ __attribute__((always_inline)) void tprep_wave(KA a, int pid, unsigned char* wl) {
    const int lane = tid_opaque() & 63, fr = lane & 15, fq = lane >> 4;
    const int sid = pid / 68, cidx = pid - sid * 68, dir = sid & 1, h = (sid >> 1) & 15, b = sid >> 5;
    bf16_t* kt = (bf16_t*)wl; float* Mf = (float*)wl; float* gcs = (float*)(wl + 17408); float* bes = gcs + 64;
    const bf16_t* PQ = (const bf16_t*)(a->ws + WS_RB); const float* AB = (const float*)(a->ws + WS_AB);
    bf16_t* TS = (bf16_t*)(a->ws + WS_TS) + (size_t)pid * 4096; float* GCB = (float*)(a->ws + WS_GCB) + (size_t)pid * 128;
    int rbase, Tn, p0;
    if (cidx < 4) { rbase = MT + b * CTXL; Tn = CTXL; p0 = cidx * 64; } else { rbase = b * SEQ; Tn = SEQ; p0 = (cidx - 4) * 64; }
    {
        u32x4 kv[16];
#pragma unroll
        for (int it = 0; it < 16; ++it) {
            const int i = it * 4 + fq, p = p0 + i, tok = dir ? (Tn - 1 - p) : p;
            kv[it] = *(const u32x4*)(PQ + (size_t)(rbase + tok) * PQ_LD + 2048 + h * 128 + fr * 8);
        }
#pragma unroll
        for (int it = 0; it < 16; ++it) *(u32x4*)(kt + (it * 4 + fq) * 136 + fr * 8) = kv[it];
    }
    {
        const int p = p0 + lane, tok = dir ? (Tn - 1 - p) : p; const size_t row = (size_t)(rbase + tok);
        const float ab0 = AB[row * 64 + dir * 32 + h], ab1 = AB[row * 64 + dir * 32 + 16 + h];
        const float xx = ab0 + a->in[9][dir * 16 + h]; const float sp = (xx > 20.0f) ? xx : log1pf(expf(xx));
        float gc = -expf(a->in[8][dir * 16 + h]) * sp;
#pragma unroll
        for (int o = 1; o < 64; o <<= 1) { const float tt = __shfl_up(gc, o, 64); if (lane >= o) gc += tt; }
        const float be = sigmoidf_(ab1);
        gcs[lane] = gc; bes[lane] = be; GCB[lane] = gc; GCB[64 + lane] = expf(gc);
    }
    f32x4 acc[10];
#pragma unroll
    for (int i = 0; i < 10; ++i) acc[i] = (f32x4){0.f, 0.f, 0.f, 0.f};
#pragma unroll
    for (int kk = 0; kk < 4; ++kk) {
        bf16x8 fg[4];
#pragma unroll
        for (int ct = 0; ct < 4; ++ct) fg[ct] = *(const bf16x8*)(kt + (ct * 16 + fr) * 136 + kk * 32 + fq * 8);
#pragma unroll
        for (int ct = 0; ct < 4; ++ct)
#pragma unroll
            for (int mt = 0; mt <= ct; ++mt) acc[ct * (ct + 1) / 2 + mt] = MFMA16(fg[ct], fg[mt], acc[ct * (ct + 1) / 2 + mt]);
    }
    float gcr[4][4], ber[4][4];
#pragma unroll
    for (int ct = 0; ct < 4; ++ct)
#pragma unroll
        for (int r = 0; r < 4; ++r) { gcr[ct][r] = gcs[ct * 16 + 4 * fq + r]; ber[ct][r] = bes[ct * 16 + 4 * fq + r]; }
    float gcm[4];
#pragma unroll
    for (int mt = 0; mt < 4; ++mt) gcm[mt] = gcs[mt * 16 + fr];
    asm volatile("s_waitcnt lgkmcnt(0)" ::: "memory");
#pragma unroll
    for (int ct = 0; ct < 4; ++ct)
#pragma unroll
        for (int mt = 0; mt < 4; ++mt)
#pragma unroll
            for (int r = 0; r < 4; ++r) {
                const int c = ct * 16 + 4 * fq + r, m = mt * 16 + fr;
                float val = 0.0f;
                if (mt <= ct) val = (m < c) ? ber[ct][r] * acc[(mt <= ct) ? (ct * (ct + 1) / 2 + mt) : 0][r] * fexpf_(gcr[ct][r] - gcm[mt]) : 0.0f;
                Mf[c * 68 + m] = val;
            }
    asm volatile("s_waitcnt lgkmcnt(0)" ::: "memory");
    {
        float* blk = Mf + (fq * 16) * 68 + fq * 16;
        float t[16];
#pragma unroll
        for (int i = 0; i < 16; ++i) {
            float s = (fr == i) ? 1.0f : 0.0f;
#pragma unroll
            for (int m4 = 0; m4 < i; m4 += 4) {
                const f32x4 mv = *(const f32x4*)(blk + i * 68 + m4);
                s -= mv.x * t[m4];
                if (m4 + 1 < i) s -= mv.y * t[m4 + 1];
                if (m4 + 2 < i) s -= mv.z * t[m4 + 2];
                if (m4 + 3 < i) s -= mv.w * t[m4 + 3];
            }
            t[i] = s;
        }
        asm volatile("s_waitcnt lgkmcnt(0)" ::: "memory");
#pragma unroll
        for (int i = 0; i < 16; ++i) blk[i * 68 + fr] = t[i];
        asm volatile("s_waitcnt lgkmcnt(0)" ::: "memory");
    }
    float* Ysc = (float*)(wl + 17920);
#pragma unroll
    for (int I = 1; I < 4; ++I)
#pragma unroll
        for (int J = 0; J < I; ++J) {
            f32x4 ya = (f32x4){0.f, 0.f, 0.f, 0.f};
#pragma unroll
            for (int K = J; K < I; ++K)
#pragma unroll
                for (int s = 0; s < 4; ++s) ya = __builtin_amdgcn_mfma_f32_16x16x4f32(Mf[(16 * I + fr) * 68 + 16 * K + 4 * s + fq], Mf[(16 * K + 4 * s + fq) * 68 + 16 * J + fr], ya, 0, 0, 0);
#pragma unroll
            for (int r = 0; r < 4; ++r) Ysc[(4 * fq + r) * 16 + fr] = ya[r];
            asm volatile("s_waitcnt lgkmcnt(0)" ::: "memory");
            f32x4 za = (f32x4){0.f, 0.f, 0.f, 0.f};
#pragma unroll
            for (int s = 0; s < 4; ++s) za = __builtin_amdgcn_mfma_f32_16x16x4f32(Mf[(16 * I + fr) * 68 + 16 * I + 4 * s + fq], Ysc[(4 * s + fq) * 16 + fr], za, 0, 0, 0);
#pragma unroll
            for (int r = 0; r < 4; ++r) Mf[(16 * I + 4 * fq + r) * 68 + 16 * J + fr] = -za[r];
            asm volatile("s_waitcnt lgkmcnt(0)" ::: "memory");
        }
#pragma unroll
    for (int it = 0; it < 8; ++it) {
        const int row = it * 8 + (lane >> 3), c8 = (lane & 7) * 8;
        const f32x4 x0 = *(const f32x4*)(Mf + row * 68 + c8) * *(const f32x4*)(bes + c8), x1 = *(const f32x4*)(Mf + row * 68 + c8 + 4) * *(const f32x4*)(bes + c8 + 4);
        u32x4 wv; wv.x = pk2(x0[0], x0[1]); wv.y = pk2(x0[2], x0[3]); wv.z = pk2(x1[0], x1[1]); wv.w = pk2(x1[2], x1[3]);
        *(u32x4*)(TS + row * 64 + c8) = wv;
    }
    asm volatile("s_waitcnt lgkmcnt(0)" ::: "memory");
}

constexpr int DL_QN = 0, DL_KN = 17408, DL_WN = 34816, DL_ST = 52224, DL_KT = 69632, DL_VT = 88064, DL_T1 = 97280, DL_T2 = 106496, DL_AT = 115712, DL_VN = 124928, DL_VD = 134144, DL_GS = 143360;
struct DStage { u32x4 q0, q1, k0, k1, v, t; f32x4 g0, g1, b0, b1; float bi, gl, g63; };
__device__ __forceinline__ void dstage_load(DStage& R, const bf16_t* PQ, const bf16_t* TS, const float* GCB, int sid, int cidx, int dir, int h, int b, int dvh, int tid) {
    const int i = tid >> 3, part = tid & 7;
    int rbase, Tn, p0;
    if (cidx < 4) { rbase = MT + b * CTXL; Tn = CTXL; p0 = cidx * 64; } else { rbase = b * SEQ; Tn = SEQ; p0 = (cidx - 4) * 64; }
    const int p = p0 + i, tok = dir ? (Tn - 1 - p) : p;
    const bf16_t* rp = PQ + (size_t)(rbase + tok) * PQ_LD + h * 128;
    R.q0 = *(const u32x4*)(rp + part * 16); R.q1 = *(const u32x4*)(rp + part * 16 + 8);
    R.k0 = *(const u32x4*)(rp + 2048 + part * 16); R.k1 = *(const u32x4*)(rp + 2048 + part * 16 + 8);
    R.v = *(const u32x4*)(rp + 4096 + dvh * 64 + part * 8);
    const size_t pid = (size_t)sid * 68 + cidx;
    R.t = *(const u32x4*)(TS + pid * 4096 + i * 64 + part * 8);
    const float* gp = GCB + pid * 128;
    R.b0 = *(const f32x4*)(gp + 64 + part * 8); R.b1 = *(const f32x4*)(gp + 64 + part * 8 + 4);
    R.gl = gp[tid & 63]; R.bi = gp[64 + (tid & 63)]; R.g63 = gp[63];
}
constexpr int DL_QN1 = DL_KT, DL_GS1 = DL_KT + 17408, DL_ST1 = DL_GS + 768;
__device__ __forceinline__ void dstage_store(const DStage& R, unsigned char* lds, int tid, int par) {
    const int i = tid >> 3, part = tid & 7;
    bf16_t* QN = (bf16_t*)(lds + (par ? DL_QN1 : DL_QN)); bf16_t* KN = (bf16_t*)(lds + DL_KN); bf16_t* VNAT = (bf16_t*)(lds + DL_VT);
    bf16_t* T1 = (bf16_t*)(lds + DL_T1); bf16_t* T2 = (bf16_t*)(lds + DL_T2); float* GS = (float*)(lds + (par ? DL_GS1 : DL_GS));
    *(u32x4*)(QN + i * 136 + part * 16) = R.q0; *(u32x4*)(QN + i * 136 + part * 16 + 8) = R.q1;
    *(u32x4*)(KN + i * 136 + part * 16) = R.k0; *(u32x4*)(KN + i * 136 + part * 16 + 8) = R.k1;
    *(u32x4*)(VNAT + i * 72 + part * 8) = R.v;
    float t8[8]; unpack8(R.t, t8);
    const float em[8] = {R.b0.x, R.b0.y, R.b0.z, R.b0.w, R.b1.x, R.b1.y, R.b1.z, R.b1.w};
    float a1[8];
#pragma unroll
    for (int e = 0; e < 8; ++e) a1[e] = t8[e] * em[e];
    *(u32x4*)(T1 + i * 72 + part * 8) = pack8(a1); *(u32x4*)(T2 + i * 72 + part * 8) = R.t;
    if (tid < 64) { GS[tid] = R.gl; GS[64 + tid] = R.bi; GS[128 + tid] = fexpf_(R.g63 - R.gl); }
}
typedef short s16x4 __attribute__((ext_vector_type(4)));
__device__ __forceinline__ void tr_frags2(unsigned a0, unsigned a1, bf16x8& f0, bf16x8& f1) {
    (void)a0; (void)a1; (void)f0; (void)f1;
}
#define TR_READ4(r0, r1, r2, r3, ad0, ad1, ad2, ad3) asm volatile("ds_read_b64_tr_b16 %0, %4\n\tds_read_b64_tr_b16 %1, %5\n\tds_read_b64_tr_b16 %2, %6\n\tds_read_b64_tr_b16 %3, %7\n\ts_waitcnt lgkmcnt(0)" \
    : "=&v"(r0), "=&v"(r1), "=&v"(r2), "=&v"(r3) : "v"(ad0), "v"(ad1), "v"(ad2), "v"(ad3) : "memory")
#define TR_CAT(lo, hi) __builtin_shufflevector((lo), (hi), 0, 1, 2, 3, 4, 5, 6, 7)
#define LBAR() do { asm volatile("s_waitcnt lgkmcnt(0)" ::: "memory"); __builtin_amdgcn_s_barrier(); asm volatile("" ::: "memory"); } while (0)
__device__ __attribute__((always_inline)) void delta_item(KA a, int item, unsigned char* lds) {
    const int tid = tid_opaque(), lane = tid & 63, w = tid >> 6, fr = lane & 15, fq = lane >> 4;
    const int dvh = item & 1, dir = (item >> 1) & 1, h = (item >> 2) & 15, b = item >> 6, sid = (b * 16 + h) * 2 + dir;
    const bf16_t* PQ = (const bf16_t*)(a->ws + WS_RB); const bf16_t* TS = (const bf16_t*)(a->ws + WS_TS); const float* GCB = (const float*)(a->ws + WS_GCB);
    bf16_t* O = (bf16_t*)(a->ws + WS_RA) + (size_t)dir * MT * 2048;
    const bf16_t* KN = (const bf16_t*)(lds + DL_KN); bf16_t* WN = (bf16_t*)(lds + DL_WN);
    const bf16_t* T1 = (const bf16_t*)(lds + DL_T1); const bf16_t* T2 = (const bf16_t*)(lds + DL_T2);
    bf16_t* AT = (bf16_t*)(lds + DL_AT); bf16_t* VN = (bf16_t*)(lds + DL_VN); bf16_t* VD = (bf16_t*)(lds + DL_VD);
    const unsigned lds_base = (unsigned)(size_t)lds;
    __syncthreads();
    for (int i = tid; i < 64 * 136 / 2; i += NT) ((unsigned*)(lds + DL_ST))[i] = 0u;
    f32x4 sacc[4];
#pragma unroll
    for (int i = 0; i < 4; ++i) sacc[i] = (f32x4){0.f, 0.f, 0.f, 0.f};
    DStage R;
    dstage_load(R, PQ, TS, GCB, sid, 0, dir, h, b, dvh, tid);
    dstage_store(R, lds, tid, 0);
    dstage_load(R, PQ, TS, GCB, sid, 1, dir, h, b, dvh, tid);
#pragma unroll 1
    for (int cidx = 0; cidx < 68; ++cidx) {
        const int par = cidx & 1;
        const bf16_t* QN = (const bf16_t*)(lds + (par ? DL_QN1 : DL_QN)); const float* GS = (const float*)(lds + (par ? DL_GS1 : DL_GS));
        const bf16_t* ST = (const bf16_t*)(lds + (par ? DL_ST1 : DL_ST)); bf16_t* STn = (bf16_t*)(lds + (par ? DL_ST : DL_ST1));
        LBAR();
        bf16x8 ktf[2];
        {
            const unsigned kb = lds_base + DL_KN + (unsigned)((8 * fq + (fr >> 2)) * 272 + (w * 16 + 4 * (fr & 3)) * 2);
            s16x4 r0, r1, r2, r3;
            TR_READ4(r0, r1, r2, r3, kb, kb + 4 * 272, kb + 32 * 272, kb + 36 * 272);
            __builtin_amdgcn_sched_barrier(0);
            ktf[0] = TR_CAT(r0, r1); ktf[1] = TR_CAT(r2, r3);
        }
        {
#pragma unroll
        for (int ti = 0; ti < 2; ++ti) {
            const int idx = w * 2 + ti, mt = idx >> 2, ct = idx & 3;
            f32x4 acc = (f32x4){0.f, 0.f, 0.f, 0.f};
            if (mt <= ct) {
#pragma unroll
                for (int kk = 0; kk < 4; ++kk) {
                    const bf16x8 af = *(const bf16x8*)(KN + (mt * 16 + fr) * 136 + kk * 32 + fq * 8), bfg = *(const bf16x8*)(QN + (ct * 16 + fr) * 136 + kk * 32 + fq * 8);
                    acc = MFMA16(af, bfg, acc);
                }
            }
            const int c = ct * 16 + fr; const float gcc = GS[c];
            float o4[4];
#pragma unroll
            for (int r = 0; r < 4; ++r) { const int m = mt * 16 + 4 * fq + r; o4[r] = (m <= c) ? acc[r] * fexpf_(gcc - GS[m]) : 0.0f; }
            *(u32x2*)(AT + c * 72 + mt * 16 + 4 * fq) = pk4(o4[0], o4[1], o4[2], o4[3]);
        }
        {
            bf16x8 af[2];
            af[0] = ktf[0]; af[1] = ktf[1];
#pragma unroll
            for (int ct = 0; ct < 4; ++ct) {
                f32x4 acc = (f32x4){0.f, 0.f, 0.f, 0.f};
#pragma unroll
                for (int kk = 0; kk < 2; ++kk) acc = MFMA16(af[kk], *(const bf16x8*)(T1 + (ct * 16 + fr) * 72 + kk * 32 + fq * 8), acc);
                *(u32x2*)(WN + (ct * 16 + fr) * 136 + w * 16 + 4 * fq) = pk4(-acc[0], -acc[1], -acc[2], -acc[3]);
            }
        }
        }
        const int ctu = w >> 1, dv0 = 2 * (w & 1);
        f32x4 uacc[2];
        {
            bf16x8 af[2];
#pragma unroll
            for (int kk = 0; kk < 2; ++kk) af[kk] = *(const bf16x8*)(T2 + (ctu * 16 + fr) * 72 + kk * 32 + fq * 8);
#pragma unroll
            for (int j = 0; j < 2; ++j) { uacc[j] = (f32x4){0.f, 0.f, 0.f, 0.f};
                const unsigned vb = lds_base + DL_VT + (unsigned)((8 * fq + (fr >> 2)) * 144 + ((dv0 + j) * 16 + 4 * (fr & 3)) * 2);
                s16x4 r0, r1, r2, r3;
                TR_READ4(r0, r1, r2, r3, vb, vb + 4 * 144, vb + 32 * 144, vb + 36 * 144);
                __builtin_amdgcn_sched_barrier(0);
                uacc[j] = MFMA16(af[0], TR_CAT(r0, r1), uacc[j]); uacc[j] = MFMA16(af[1], TR_CAT(r2, r3), uacc[j]); }
        }
        LBAR();
        if (cidx + 1 < 68) {
            dstage_store(R, lds, tid, par ^ 1);
            if (cidx + 2 < 68) dstage_load(R, PQ, TS, GCB, sid, cidx + 2, dir, h, b, dvh, tid);
        }
        {
            bf16x8 af[4];
#pragma unroll
            for (int kk = 0; kk < 4; ++kk) af[kk] = *(const bf16x8*)(WN + (ctu * 16 + fr) * 136 + kk * 32 + fq * 8);
            float ed[4];
#pragma unroll
            for (int r = 0; r < 4; ++r) ed[r] = GS[128 + ctu * 16 + 4 * fq + r];
#pragma unroll
            for (int j = 0; j < 2; ++j) {
#pragma unroll
                for (int kk = 0; kk < 4; ++kk) uacc[j] = MFMA16(af[kk], *(const bf16x8*)(ST + ((dv0 + j) * 16 + fr) * 136 + kk * 32 + fq * 8), uacc[j]);
                const int dv = (dv0 + j) * 16 + fr;
                *(u32x2*)(VN + dv * 72 + ctu * 16 + 4 * fq) = pk4(uacc[j][0], uacc[j][1], uacc[j][2], uacc[j][3]);
                *(u32x2*)(VD + dv * 72 + ctu * 16 + 4 * fq) = pk4(uacc[j][0] * ed[0], uacc[j][1] * ed[1], uacc[j][2] * ed[2], uacc[j][3] * ed[3]);
            }
        }
        LBAR();
        {
            const int dvt = w >> 1, c0 = 2 * (w & 1);
            bf16x8 af[4], vf[2];
#pragma unroll
            for (int kk = 0; kk < 4; ++kk) af[kk] = *(const bf16x8*)(ST + (dvt * 16 + fr) * 136 + kk * 32 + fq * 8);
#pragma unroll
            for (int kk = 0; kk < 2; ++kk) vf[kk] = *(const bf16x8*)(VN + (dvt * 16 + fr) * 72 + kk * 32 + fq * 8);
#pragma unroll
            for (int j = 0; j < 2; ++j) {
                const int c = (c0 + j) * 16 + fr;
                f32x4 acc = (f32x4){0.f, 0.f, 0.f, 0.f};
#pragma unroll
                for (int kk = 0; kk < 4; ++kk) acc = MFMA16(af[kk], *(const bf16x8*)(QN + c * 136 + kk * 32 + fq * 8), acc);
                const float eg = GS[64 + c];
                acc = acc * eg;
#pragma unroll
                for (int kk = 0; kk < 2; ++kk) acc = MFMA16(vf[kk], *(const bf16x8*)(AT + c * 72 + kk * 32 + fq * 8), acc);
                if (cidx >= 4) {
                    const int p = (cidx - 4) * 64 + c, tok = dir ? (SEQ - 1 - p) : p;
                    *(u32x2*)(O + (size_t)(b * SEQ + tok) * 2048 + h * 128 + dvh * 64 + dvt * 16 + 4 * fq) = pk4(acc[0], acc[1], acc[2], acc[3]);
                }
            }
        }
        {
            const float eg63 = GS[64 + 63];
            bf16x8 af[2];
            af[0] = ktf[0]; af[1] = ktf[1];
#pragma unroll
            for (int j = 0; j < 4; ++j) {
                sacc[j] = sacc[j] * eg63;
#pragma unroll
                for (int kk = 0; kk < 2; ++kk) sacc[j] = MFMA16(af[kk], *(const bf16x8*)(VD + (j * 16 + fr) * 72 + kk * 32 + fq * 8), sacc[j]);
            }
#pragma unroll
            for (int j = 0; j < 4; ++j) *(u32x2*)(STn + (j * 16 + fr) * 136 + w * 16 + 4 * fq) = pk4(sacc[j][0], sacc[j][1], sacc[j][2], sacc[j][3]);
        }
    }
    __syncthreads();
}

__device__ __attribute__((always_inline)) void ytrans_all(const bf16_t* YT, bf16_t* Y, bf16_t* tile) {
    const int tid = tid_opaque(), r = tid >> 3, c8 = (tid & 7) * 8, G = gridDim.x;
    int su = blockIdx.x;
    u32x4 pre[4];
    if (su < 2048) { const int cb = su & 31, tq = su >> 5;
#pragma unroll
        for (int j = 0; j < 4; ++j) pre[j] = __builtin_nontemporal_load((const u32x4*)(YT + (size_t)(cb * 64 + r) * MT + (tq * 4 + j) * 64 + c8)); }
    __syncthreads();
#pragma unroll 1
    for (; su < 2048; su += G) {
        const int cb = su & 31, tq = su >> 5;
#pragma unroll
        for (int j = 0; j < 4; ++j) *(u32x4*)(tile + j * 4608 + r * 72 + c8) = pre[j];
        __syncthreads();
        const int sn = su + G;
        if (sn < 2048) { const int cbn = sn & 31, tqn = sn >> 5;
#pragma unroll
            for (int j = 0; j < 4; ++j) pre[j] = __builtin_nontemporal_load((const u32x4*)(YT + (size_t)(cbn * 64 + r) * MT + (tqn * 4 + j) * 64 + c8)); }
#pragma unroll
        for (int j = 0; j < 4; ++j) {
            const bf16_t* t = tile + j * 4608;
            u32x4 w;
            w.x = (unsigned)t[(c8 + 0) * 72 + r] | ((unsigned)t[(c8 + 1) * 72 + r] << 16);
            w.y = (unsigned)t[(c8 + 2) * 72 + r] | ((unsigned)t[(c8 + 3) * 72 + r] << 16);
            w.z = (unsigned)t[(c8 + 4) * 72 + r] | ((unsigned)t[(c8 + 5) * 72 + r] << 16);
            w.w = (unsigned)t[(c8 + 6) * 72 + r] | ((unsigned)t[(c8 + 7) * 72 + r] << 16);
            *(u32x4*)(Y + (size_t)((tq * 4 + j) * 64 + r) * 2048 + cb * 64 + c8) = w;
        }
        __syncthreads();
    }
}

__device__ __attribute__((always_inline)) void p6_on(KA a) {
    const bf16_t* OF = (const bf16_t*)(a->ws + WS_RA); const bf16_t* OB = OF + (size_t)MT * 2048;
    const bf16_t* ZG = (const bf16_t*)(a->ws + WS_RB); unsigned char* ON8 = a->ws + WS_HA8; float* SON = (float*)(a->ws + WS_SON);
    const float* nw = a->in[10];
    const int lane = tid_opaque() & 63, wv = blockIdx.x * 8 + (tid_opaque() >> 6), nwv = gridDim.x * 8;
    float nwr[8];
#pragma unroll
    for (int e = 0; e < 8; ++e) nwr[e] = nw[(lane & 15) * 8 + e];
    u32x4 nf[4], ng[4], nz[4];
    if (wv < MT) {
#pragma unroll
        for (int j = 0; j < 4; ++j) { nf[j] = __builtin_nontemporal_load((const u32x4*)(OF + (size_t)wv * 2048 + j * 512 + lane * 8)); ng[j] = __builtin_nontemporal_load((const u32x4*)(OB + (size_t)wv * 2048 + j * 512 + lane * 8)); nz[j] = *(const u32x4*)(ZG + (size_t)wv * NZG + j * 512 + lane * 8); } }
#pragma unroll 1
    for (int row = wv; row < MT; row += nwv) {
        u32x4 lf[4], lg[4], lz[4];
#pragma unroll
        for (int j = 0; j < 4; ++j) { lf[j] = nf[j]; lg[j] = ng[j]; lz[j] = nz[j]; }
        const int rn = row + nwv;
        if (rn < MT) {
#pragma unroll
            for (int j = 0; j < 4; ++j) { nf[j] = __builtin_nontemporal_load((const u32x4*)(OF + (size_t)rn * 2048 + j * 512 + lane * 8)); ng[j] = __builtin_nontemporal_load((const u32x4*)(OB + (size_t)rn * 2048 + j * 512 + lane * 8)); nz[j] = *(const u32x4*)(ZG + (size_t)rn * NZG + j * 512 + lane * 8); } }
        float o[32]; float m = 0.f;
#pragma unroll
        for (int j = 0; j < 4; ++j) { float f[8], g[8], z[8]; unpack8(lf[j], f); unpack8(lg[j], g); unpack8(lz[j], z);
            float ss = 0.f;
#pragma unroll
            for (int e = 0; e < 8; ++e) { f[e] += g[e]; ss += f[e] * f[e]; }
            ss = row_sum16(ss);
            const float rs = rsqrtf(ss * (1.0f / 128.0f) + 1e-6f);
#pragma unroll
            for (int e = 0; e < 8; ++e) { const float v = f[e] * rs * nwr[e] * siluf_(z[e]); o[j * 8 + e] = v; m = fmaxf(m, fabsf(v)); } }
        m = wave_max(m);
        const float sc = (m > 0.f) ? m * (1.0f / 127.0f) : 1.0f, inv = 1.0f / sc;
#pragma unroll
        for (int j = 0; j < 4; ++j) { u32x2 w; w.x = pk4_i8(o[j * 8] * inv, o[j * 8 + 1] * inv, o[j * 8 + 2] * inv, o[j * 8 + 3] * inv); w.y = pk4_i8(o[j * 8 + 4] * inv, o[j * 8 + 5] * inv, o[j * 8 + 6] * inv, o[j * 8 + 7] * inv);
            *(u32x2*)(ON8 + (size_t)row * 2048 + j * 512 + lane * 8) = w; }
        if (lane == 0) SON[row] = sc;
    }
}
__device__ __attribute__((always_inline)) void y_quant(KA a) {
    const bf16_t* Y = (const bf16_t*)(a->ws + WS_RA) + (size_t)2 * MT * 2048; unsigned char* Y8 = a->ws + WS_WQ8; float* SY = (float*)(a->ws + WS_SY);
    const int lane = tid_opaque() & 63, wv = blockIdx.x * 8 + (tid_opaque() >> 6), nwv = gridDim.x * 8;
#pragma unroll 1
    for (int r0 = wv; r0 < MT; r0 += 2 * nwv) {
        u32x4 w[2][4]; bool ok[2];
#pragma unroll
        for (int q = 0; q < 2; ++q) { const int r = r0 + q * nwv; ok[q] = r < MT; const int rc = ok[q] ? r : r0;
#pragma unroll
            for (int j = 0; j < 4; ++j) w[q][j] = *(const u32x4*)(Y + (size_t)rc * 2048 + lane * 32 + j * 8); }
#pragma unroll
        for (int q = 0; q < 2; ++q) {
            const int r = r0 + q * nwv;
            float v[32]; float m = 0.f;
#pragma unroll
            for (int j = 0; j < 4; ++j) { float t[8]; unpack8(w[q][j], t);
#pragma unroll
                for (int e = 0; e < 8; ++e) { v[j * 8 + e] = t[e]; m = fmaxf(m, fabsf(t[e])); } }
            m = wave_max(m);
            const float sc = (m > 0.f) ? m * (1.0f / 127.0f) : 1.0f, inv = 1.0f / sc;
            u32x4 w0, w1;
#pragma unroll
            for (int p = 0; p < 4; ++p) { w0[p] = pk4_i8(v[p * 4] * inv, v[p * 4 + 1] * inv, v[p * 4 + 2] * inv, v[p * 4 + 3] * inv); w1[p] = pk4_i8(v[16 + p * 4] * inv, v[16 + p * 4 + 1] * inv, v[16 + p * 4 + 2] * inv, v[16 + p * 4 + 3] * inv); }
            if (ok[q]) { *(u32x4*)(Y8 + (size_t)r * 2048 + lane * 32) = w0; *(u32x4*)(Y8 + (size_t)r * 2048 + lane * 32 + 16) = w1; if (lane == 0) SY[r] = sc; }
        }
    }
}

constexpr size_t PEER_U8 = 0, PEER_V4 = 32 * MiB, PEER_VG = 48 * MiB, PEER_US = 64 * MiB, PEER_VS = 64 * MiB + 65536;
__device__ __attribute__((always_inline)) void p8_tables(KA a) {
    unsigned char* RAb = a->ws + WS_RA;
    const int lane = tid_opaque() & 63, wv = blockIdx.x * 8 + (tid_opaque() >> 6), nwv = gridDim.x * 8;
    {
        const float* U = a->in[27];
        f32x4 nx[8];
        if (wv < 16384) {
#pragma unroll
            for (int jj = 0; jj < 8; ++jj) nx[jj] = __builtin_nontemporal_load((const f32x4*)(U + (size_t)wv * 2048 + jj * 256 + lane * 4)); }
#pragma unroll 1
        for (int row = wv; row < 16384; row += nwv) {
            f32x4 x[8];
#pragma unroll
            for (int jj = 0; jj < 8; ++jj) x[jj] = nx[jj];
            if (row + nwv < 16384) {
#pragma unroll
                for (int jj = 0; jj < 8; ++jj) nx[jj] = __builtin_nontemporal_load((const f32x4*)(U + (size_t)(row + nwv) * 2048 + jj * 256 + lane * 4)); }
            float m = 0.f;
#pragma unroll
            for (int jj = 0; jj < 8; ++jj) m = fmaxf(m, fmaxf(fmaxf(fabsf(x[jj][0]), fabsf(x[jj][1])), fmaxf(fabsf(x[jj][2]), fabsf(x[jj][3]))));
            const float mx = wave_max(m);
            float sc = (mx > 0.f) ? mx * (1.0f / 7.0f) : 1.0f;
            {
                const float base = sc; float best = 3.0e38f;
#pragma unroll 1
                for (int k = 0; k < 7; ++k) {
                    const float sck = base * (1.0f - 0.09f * (float)k), ik = 1.0f / sck; float err = 0.f;
#pragma unroll
                    for (int j = 0; j < 8; j += 3)
#pragma unroll
                        for (int e = 0; e < 4; ++e) { float c = rintf(x[j][e] * ik); c = fminf(fmaxf(c, -7.0f), 7.0f); const float d = x[j][e] - c * sck; err += d * d; }
                    err = wave_sum(err);
                    if (err < best) { best = err; sc = sck; }
                }
            }
            const float inv = 1.0f / sc;
            unsigned char* dp = RAb + PEER_U8 + (size_t)row * 1024;
#pragma unroll
            for (int jj = 0; jj < 4; ++jj) {
                unsigned acc = 0;
#pragma unroll
                for (int e = 0; e < 4; ++e) {
                    int c0 = __float2int_rn(x[jj][e] * inv), c1 = __float2int_rn(x[4 + jj][e] * inv);
                    c0 = c0 < -7 ? -7 : (c0 > 7 ? 7 : c0); c1 = c1 < -7 ? -7 : (c1 > 7 ? 7 : c1);
                    acc |= (((unsigned)(c0 + 8)) | (((unsigned)c1 & 15u) << 4)) << (8 * e);
                }
                *(unsigned*)(dp + jj * 256 + lane * 4) = acc;
            }
            if (lane == 0) ((float*)(RAb + PEER_US))[row * 2] = sc;
        }
    }
    {
        const float* V = a->in[28];
        f32x4 nx[8];
        if (wv < 16384) {
#pragma unroll
            for (int i = 0; i < 2; ++i)
#pragma unroll
                for (int j = 0; j < 4; ++j) nx[i * 4 + j] = __builtin_nontemporal_load((const f32x4*)(V + (size_t)wv * 2048 + (4 * i + j) * 256 + lane * 4)); }
#pragma unroll 1
        for (int row = wv; row < 16384; row += nwv) {
            f32x4 x[8];
#pragma unroll
            for (int jj = 0; jj < 8; ++jj) x[jj] = nx[jj];
            if (row + nwv < 16384) {
#pragma unroll
                for (int i = 0; i < 2; ++i)
#pragma unroll
                    for (int j = 0; j < 4; ++j) nx[i * 4 + j] = __builtin_nontemporal_load((const f32x4*)(V + (size_t)(row + nwv) * 2048 + (4 * i + j) * 256 + lane * 4)); }
            float gmx[2];
#pragma unroll
            for (int i = 0; i < 2; ++i) { float m = 0.f;
#pragma unroll
                for (int j = 0; j < 4; ++j) m = fmaxf(m, fmaxf(fmaxf(fabsf(x[i * 4 + j][0]), fabsf(x[i * 4 + j][1])), fmaxf(fabsf(x[i * 4 + j][2]), fabsf(x[i * 4 + j][3]))));
                gmx[i] = m; }
            const float mx = wave_max(fmaxf(gmx[0], gmx[1]));
            const float rmx = (mx > 0.f) ? mx : 1.0f;
#pragma unroll
            for (int i = 0; i < 2; ++i) {
                int m = (int)ceilf(gmx[i] * (255.0f / rmx)); m = m < 1 ? 1 : (m > 255 ? 255 : m);
                const float inv = (7.0f * 255.0f) / (rmx * (float)m);
                unsigned q[16];
#pragma unroll
                for (int j = 0; j < 4; ++j)
#pragma unroll
                    for (int e = 0; e < 4; ++e) { int c = __float2int_rn(x[i * 4 + j][e] * inv); c = c < -7 ? -7 : (c > 7 ? 7 : c); q[j * 4 + e] = (unsigned)(c + 8); }
                u32x2 w;
                w.x = (q[0] | ((q[4] ^ 8u) << 4)) | ((q[1] | ((q[5] ^ 8u) << 4)) << 8) | ((q[2] | ((q[6] ^ 8u) << 4)) << 16) | ((q[3] | ((q[7] ^ 8u) << 4)) << 24);
                w.y = (q[8] | ((q[12] ^ 8u) << 4)) | ((q[9] | ((q[13] ^ 8u) << 4)) << 8) | ((q[10] | ((q[14] ^ 8u) << 4)) << 16) | ((q[11] | ((q[15] ^ 8u) << 4)) << 24);
                *(u32x2*)(RAb + PEER_V4 + (size_t)row * 1024 + i * 512 + lane * 8) = w;
                (RAb + PEER_VG)[(size_t)row * 128 + lane * 2 + i] = (unsigned char)m;
            }
            if (lane == 0) ((float*)(RAb + PEER_US))[row * 2 + 1] = rmx * (1.0f / (7.0f * 255.0f));
        }
    }
}

__device__ __attribute__((always_inline)) void p9_ln1(KA a) {
    const float* mod = (const float*)(a->ws + WS_MOD); unsigned char* H8 = a->ws + WS_RA + (size_t)2 * MT * 2048 * 2; float* SH2 = (float*)(a->ws + WS_SH2);
    const int lane = tid_opaque() & 63, wv = blockIdx.x * 8 + (tid_opaque() >> 6), nwv = gridDim.x * 8;
    float* P9 = (float*)g_lds;
    __syncthreads();
    for (int i = tid_opaque(); i < 10 * 512; i += NT) { const int r = i >> 9, c4 = (i & 511) * 4;
        const float* src = (r == 0) ? a->in[23] + c4 : (r == 1) ? a->in[24] + c4 : mod + ((r - 2) >> 1) * 12288 + (((r - 2) & 1) ? 8192 : 6144) + c4;
        *(f32x4*)(P9 + r * 2048 + c4) = *(const f32x4*)src; }
    __syncthreads();
    for (int row = wv; row < MT; row += nwv) {
        bf16_t* rp = (bf16_t*)(a->ws + WS_XN) + (size_t)row * 2048;
        float v[32]; float s = 0.f;
#pragma unroll
        for (int i = 0; i < 4; ++i) { float t8[8]; unpack8(*(const u32x4*)(rp + i * 512 + lane * 8), t8);
#pragma unroll
            for (int e = 0; e < 8; ++e) { v[i * 8 + e] = t8[e]; s += t8[e]; } }
        const float mu = wave_sum(s) * (1.0f / 2048.0f);
        float q = 0.f;
#pragma unroll
        for (int e = 0; e < 32; ++e) { const float d = v[e] - mu; q += d * d; }
        const float rstd = rsqrtf(wave_sum(q) * (1.0f / 2048.0f) + 1e-5f);
        const float* psh = P9 + (2 + 2 * (row >> 12)) * 2048; const float* psc = psh + 2048;
        float hm = 0.f;
#pragma unroll
        for (int i = 0; i < 4; ++i) {
            const int col = i * 512 + lane * 8;
            float xn[8];
            const f32x4 g0 = *(const f32x4*)(P9 + col), g1 = *(const f32x4*)(P9 + col + 4), b0 = *(const f32x4*)(P9 + 2048 + col), b1 = *(const f32x4*)(P9 + 2048 + col + 4);
            const f32x4 c0 = *(const f32x4*)(psc + col), c1 = *(const f32x4*)(psc + col + 4), h0 = *(const f32x4*)(psh + col), h1 = *(const f32x4*)(psh + col + 4);
#pragma unroll
            for (int e = 0; e < 8; ++e) { const float gg = e < 4 ? g0[e & 3] : g1[e & 3], bv = e < 4 ? b0[e & 3] : b1[e & 3], cc = e < 4 ? c0[e & 3] : c1[e & 3], hh = e < 4 ? h0[e & 3] : h1[e & 3];
                xn[e] = (v[i * 8 + e] - mu) * rstd * gg + bv; const float h = xn[e] * (1.0f + cc) + hh; v[i * 8 + e] = h; hm = fmaxf(hm, fabsf(h)); }
            *(u32x4*)(rp + col) = pack8(xn);
        }
        hm = wave_max(hm);
        const float sc = (hm > 0.f) ? hm * (1.0f / 127.0f) : 1.0f, inv = 1.0f / sc;
#pragma unroll
        for (int i = 0; i < 4; ++i) { u32x2 o; o.x = pk4_i8(v[i * 8] * inv, v[i * 8 + 1] * inv, v[i * 8 + 2] * inv, v[i * 8 + 3] * inv); o.y = pk4_i8(v[i * 8 + 4] * inv, v[i * 8 + 5] * inv, v[i * 8 + 6] * inv, v[i * 8 + 7] * inv);
            *(u32x2*)(H8 + (size_t)row * 2048 + i * 512 + lane * 8) = o; }
        if (lane == 0) SH2[row] = sc;
    }
    {
        const bf16_t* WPT = (const bf16_t*)(a->ws + WS_SW) + (size_t)3 * D * D; unsigned char* WP8 = a->ws + WS_WP8; const float* pmx = (const float*)(a->ws + WS_WPMAX); float* swf = (float*)(a->ws + WS_SWF) + 18688 + 2048;
        for (int r = wv; r < 2048; r += nwv) {
            float m = (lane < 16) ? pmx[(size_t)r * 16 + lane] : 0.f; m = wave_max(m);
            const float sc = (m > 0.f) ? m * (1.0f / 127.0f) : 1.0f, inv = 1.0f / sc;
#pragma unroll
            for (int j = 0; j < 4; ++j) { float t[8]; unpack8(*(const u32x4*)(WPT + (size_t)r * 2048 + j * 512 + lane * 8), t);
                u32x2 o; o.x = pk4_i8(t[0] * inv, t[1] * inv, t[2] * inv, t[3] * inv); o.y = pk4_i8(t[4] * inv, t[5] * inv, t[6] * inv, t[7] * inv);
                *(u32x2*)(WP8 + (size_t)r * 2048 + j * 512 + lane * 8) = o; }
            if (lane == 0) swf[r] = sc;
        }
    }
}

__device__ __forceinline__ float row_max16(float v) {
    v = fmaxf(v, __builtin_bit_cast(float, __builtin_amdgcn_update_dpp(0, __builtin_bit_cast(int, v), 0x128, 0xf, 0xf, false)));
    v = fmaxf(v, __builtin_bit_cast(float, __builtin_amdgcn_update_dpp(0, __builtin_bit_cast(int, v), 0x124, 0xf, 0xf, false)));
    v = fmaxf(v, __builtin_bit_cast(float, __builtin_amdgcn_update_dpp(0, __builtin_bit_cast(int, v), 0x122, 0xf, 0xf, false)));
    v = fmaxf(v, __builtin_bit_cast(float, __builtin_amdgcn_update_dpp(0, __builtin_bit_cast(int, v), 0x121, 0xf, 0xf, false)));
    return v;
}
__device__ __forceinline__ float row_sum16(float v) {
    v += __builtin_bit_cast(float, __builtin_amdgcn_update_dpp(0, __builtin_bit_cast(int, v), 0x128, 0xf, 0xf, false));
    v += __builtin_bit_cast(float, __builtin_amdgcn_update_dpp(0, __builtin_bit_cast(int, v), 0x124, 0xf, 0xf, false));
    v += __builtin_bit_cast(float, __builtin_amdgcn_update_dpp(0, __builtin_bit_cast(int, v), 0x122, 0xf, 0xf, false));
    v += __builtin_bit_cast(float, __builtin_amdgcn_update_dpp(0, __builtin_bit_cast(int, v), 0x121, 0xf, 0xf, false));
    return v;
}
__device__ __forceinline__ int row_sum16i(int v) {
    v += __builtin_amdgcn_update_dpp(0, v, 0x128, 0xf, 0xf, false);
    v += __builtin_amdgcn_update_dpp(0, v, 0x124, 0xf, 0xf, false);
    v += __builtin_amdgcn_update_dpp(0, v, 0x122, 0xf, 0xf, false);
    v += __builtin_amdgcn_update_dpp(0, v, 0x121, 0xf, 0xf, false);
    return v;
}
template <int NCH, int NV> __device__ __forceinline__ void topk16_row16(float (&x)[NCH][NV], int s, int g, float (&rs)[NCH], int (&ri)[NCH]) {
#pragma unroll
    for (int c = 0; c < NCH; ++c) { rs[c] = -INFINITY; ri[c] = 0; }
#pragma unroll 1
    for (int it = 0; it < 16; ++it) {
#pragma unroll
        for (int c = 0; c < NCH; ++c) {
            float m = x[c][0];
#pragma unroll
            for (int j = 1; j < NV; ++j) m = fmaxf(m, x[c][j]);
            const float wm = row_max16(m);
            const unsigned long long bal = __ballot(m == wm);
            const unsigned seg = (unsigned)(bal >> (16 * g)) & 0xffffu;
            const bool iswin = (s == (__ffs((int)seg) - 1));
            int jsel = 0;
#pragma unroll
            for (int j = NV - 1; j >= 0; --j) { const bool e = (x[c][j] == wm); jsel = e ? j : jsel; x[c][j] = (e && iswin) ? -INFINITY : x[c][j]; }
            const int key = row_sum16i(iswin ? (s * NV + jsel) : 0);
            if (s == it) { rs[c] = wm; ri[c] = key; }
        }
    }
}
template <int NV> __device__ __forceinline__ void lane_sort_desc(float (&x)[NV]);
template <> __device__ __forceinline__ void lane_sort_desc<8>(float (&x)[8]) {
#define CE_(i, j) do { const float _a = x[i], _b = x[j]; x[i] = fmaxf(_a, _b); x[j] = fminf(_a, _b); } while (0)
    CE_(0, 1); CE_(2, 3); CE_(4, 5); CE_(6, 7); CE_(0, 2); CE_(1, 3); CE_(4, 6); CE_(5, 7); CE_(1, 2); CE_(5, 6);
    CE_(0, 4); CE_(1, 5); CE_(2, 6); CE_(3, 7); CE_(2, 4); CE_(3, 5); CE_(1, 2); CE_(3, 4); CE_(5, 6);
}
template <> __device__ __forceinline__ void lane_sort_desc<4>(float (&x)[4]) {
    CE_(0, 1); CE_(2, 3); CE_(0, 2); CE_(1, 3); CE_(1, 2);
#undef CE_
}
template <int NCH, int NV> __device__ __forceinline__ void topk16_sorted(float (&x)[NCH][NV], int s, float (&rs)[NCH]) {
#pragma unroll
    for (int c = 0; c < NCH; ++c) { lane_sort_desc<NV>(x[c]); rs[c] = -INFINITY; }
#pragma unroll 1
    for (int it = 0; it < 16; ++it) {
#pragma unroll
        for (int c = 0; c < NCH; ++c) {
            const float wm = row_max16(x[c][0]);
            const bool win = (x[c][0] == wm);
#pragma unroll
            for (int j = 0; j < NV - 1; ++j) x[c][j] = win ? x[c][j + 1] : x[c][j];
            x[c][NV - 1] = win ? -INFINITY : x[c][NV - 1];
            if (s == it) rs[c] = wm;
        }
    }
}
__device__ __forceinline__ float embed_idx(float v, unsigned idx, unsigned mask) { return __uint_as_float((__float_as_uint(v) & ~mask) | idx); }
__device__ __forceinline__ int fkey(float v) { const int b = __float_as_int(v); return b ^ ((b >> 31) & 0x7fffffff); }
__device__ __forceinline__ float fkey_inv(int k) { return __int_as_float(k ^ ((k >> 31) & 0x7fffffff)); }
__device__ __forceinline__ int imax_(int a, int b) { return a > b ? a : b; }
__device__ __forceinline__ int imin_(int a, int b) { return a < b ? a : b; }
__device__ __forceinline__ int row_max16i(int v) {
    v = imax_(v, __builtin_amdgcn_update_dpp((int)0x80000000, v, 0x128, 0xf, 0xf, false));
    v = imax_(v, __builtin_amdgcn_update_dpp((int)0x80000000, v, 0x124, 0xf, 0xf, false));
    v = imax_(v, __builtin_amdgcn_update_dpp((int)0x80000000, v, 0x122, 0xf, 0xf, false));
    v = imax_(v, __builtin_amdgcn_update_dpp((int)0x80000000, v, 0x121, 0xf, 0xf, false));
    return v;
}
template <int NV> __device__ __forceinline__ void lane_sort_desc_i(int (&x)[NV]);
template <> __device__ __forceinline__ void lane_sort_desc_i<8>(int (&x)[8]) {
#define CE_(i, j) do { const int _a = x[i], _b = x[j]; x[i] = imax_(_a, _b); x[j] = imin_(_a, _b); } while (0)
    CE_(0, 1); CE_(2, 3); CE_(4, 5); CE_(6, 7); CE_(0, 2); CE_(1, 3); CE_(4, 6); CE_(5, 7); CE_(1, 2); CE_(5, 6);
    CE_(0, 4); CE_(1, 5); CE_(2, 6); CE_(3, 7); CE_(2, 4); CE_(3, 5); CE_(1, 2); CE_(3, 4); CE_(5, 6);
}
template <> __device__ __forceinline__ void lane_sort_desc_i<4>(int (&x)[4]) {
    CE_(0, 1); CE_(2, 3); CE_(0, 2); CE_(1, 3); CE_(1, 2);
#undef CE_
}
template <int NCH, int NV> __device__ __forceinline__ void topk16_sorted_i(int (&x)[NCH][NV], int s, int (&rs)[NCH]) {
#pragma unroll
    for (int c = 0; c < NCH; ++c) { lane_sort_desc_i<NV>(x[c]); rs[c] = (int)0x80000000; }
#pragma unroll 1
    for (int it = 0; it < 16; ++it) {
#pragma unroll
        for (int c = 0; c < NCH; ++c) {
            const int wm = row_max16i(x[c][0]);
            const bool win = (x[c][0] == wm);
#pragma unroll
            for (int j = 0; j < NV - 1; ++j) x[c][j] = win ? x[c][j + 1] : x[c][j];
            x[c][NV - 1] = win ? (int)0x80000000 : x[c][NV - 1];
            if (s == it) rs[c] = wm;
        }
    }
}
__device__ __attribute__((always_inline)) void peer_unit(KA a, int unit, unsigned char* lds) {
    const int tid = tid_opaque(), lane = tid & 63, wid = tid >> 6, fr = lane & 15, fq = lane >> 4;
    float* SC = (float*)lds;
    int* IGI = (int*)(lds + 65536); float* IGG = (float*)(lds + 98304);
    float* TL = (float*)(lds + 131072); int* TI = (int*)(lds + 139264);
    const int tok0 = unit * 64;
    const bf16_t* Qp = (const bf16_t*)(a->ws + WS_RB); const float* subk = a->in[26]; (void)subk;
    const unsigned char* H8 = a->ws + WS_RA + (size_t)2 * MT * 2048 * 2; const float* SH2 = (const float*)(a->ws + WS_SH2);
    const float* mod = (const float*)(a->ws + WS_MOD);
    int sti[4], stj[4];
#pragma unroll
    for (int q = 0; q < 4; ++q) {
        const int t = fr * 4 + q; int acc = 0, ii = -1, jj = 0;
#pragma unroll
        for (int i = 0; i < 16; ++i) { const int cnt = 16 / (i + 1); if (ii < 0 && t < acc + cnt) { ii = i; jj = t - acc; } acc += cnt; }
        sti[q] = ii; stj[q] = jj;
    }
    int* STP = (int*)(lds + 16384);
    float* PV = (float*)(lds + 20480);
    { const float* g2p = mod + (tok0 >> 12) * 12288 + 10240; const float* gmp = a->in[29]; const float* btp = a->in[30];
      for (int c = tid; c < 2048; c += NT) { PV[c] = g2p[c]; PV[2048 + c] = gmp[c]; PV[4096 + c] = btp[c]; } }
    if (tid < 16) {
#pragma unroll
        for (int q = 0; q < 4; ++q) STP[fr * 4 + q] = (sti[q] & 15) | (stj[q] << 4);
    }
    __syncthreads();
    float nx[4][8];
#pragma unroll
    for (int c = 0; c < 4; ++c) { const bf16_t* sp = Qp + (size_t)(tok0 + wid * 8 + (c >> 1) * 4 + fq) * 2048 + (c & 1) * 128 + fr * 8;
        unpack8(*(const u32x4*)sp, nx[c]); }
#pragma unroll 1
    for (int hh = 0; hh < 8; ++hh) { const int h = hh;
        {
            int x[4][8]; int ts[4];
#pragma unroll
            for (int c = 0; c < 4; ++c)
#pragma unroll
                for (int j = 0; j < 8; ++j) x[c][j] = (fkey(nx[c][j]) & ~127) | (fr * 8 + j);
            {
                const int hn = (hh + 1) & 7;
#pragma unroll
                for (int c = 0; c < 4; ++c) { const bf16_t* sp = Qp + (size_t)(tok0 + wid * 8 + (c >> 1) * 4 + fq) * 2048 + (hn * 2 + (c & 1)) * 128 + fr * 8;
                    unpack8(*(const u32x4*)sp, nx[c]); }
            }
            topk16_sorted_i<4, 8>(x, fr, ts);
#pragma unroll
            for (int c = 0; c < 4; ++c) { const int tkc = wid * 8 + (c >> 1) * 4 + fq, p = c & 1; TL[(tkc * 2 + p) * 16 + fr] = fkey_inv(ts[c]); TI[(tkc * 2 + p) * 16 + fr] = ts[c] & 127; }
            asm volatile("s_waitcnt lgkmcnt(0)" ::: "memory");
            int cnd[2][4]; int bsi[2]; float bs[2]; int bc[2];
#pragma unroll
            for (int g = 0; g < 2; ++g) { const int tk = wid * 8 + g * 4 + fq;
#pragma unroll
                for (int q = 0; q < 4; ++q) cnd[g][q] = (sti[q] >= 0) ? ((fkey(TL[(tk * 2 + 0) * 16 + (sti[q] & 15)] + TL[(tk * 2 + 1) * 16 + stj[q]]) & ~63) | (fr * 4 + q)) : (int)0x80000000; }
            topk16_sorted_i<2, 4>(cnd, fr, bsi);
#pragma unroll
            for (int g = 0; g < 2; ++g) { bc[g] = bsi[g] & 63; bs[g] = fkey_inv(bsi[g]); }
#pragma unroll
            for (int g = 0; g < 2; ++g) {
                const int tk = wid * 8 + g * 4 + fq;
                const int pij = STP[bc[g]], pi = pij & 15, pj = pij >> 4;
                const int e0 = TI[(tk * 2 + 0) * 16 + pi], e1 = TI[(tk * 2 + 1) * 16 + pj];
                const float mx = fkey_inv(row_max16i(bsi[g]));
                const float ex = fexpf_(bs[g] - mx);
                const float sm = row_sum16(ex);
                IGI[tk * 128 + h * 16 + fr] = e0 * 128 + e1; IGG[tk * 128 + h * 16 + fr] = ex * __builtin_amdgcn_rcpf(sm);
            }
            asm volatile("s_waitcnt lgkmcnt(0)" ::: "memory");
        }
    }
    const unsigned char* U8 = a->ws + WS_RA + PEER_U8; const unsigned char* V4 = a->ws + WS_RA + PEER_V4; const unsigned short* VG = (const unsigned short*)(a->ws + WS_RA + PEER_VG);
    const f32x2* USV = (const f32x2*)(a->ws + WS_RA + PEER_US);
#pragma unroll 1
    for (int rr = 0; rr < 8; ++rr) {
        const int row = wid * 8 + rr, tok = tok0 + row;
        int hq[8];
        { const u32x4 q0 = *(const u32x4*)(H8 + (size_t)tok * 2048 + lane * 16), q1 = *(const u32x4*)(H8 + (size_t)tok * 2048 + 1024 + lane * 16);
          hq[0] = (int)q0.x; hq[1] = (int)q0.y; hq[2] = (int)q0.z; hq[3] = (int)q0.w; hq[4] = (int)q1.x; hq[5] = (int)q1.y; hq[6] = (int)q1.z; hq[7] = (int)q1.w; }
        const float shq = SH2[tok];
        int yl[16], yf[16];
#pragma unroll
        for (int e = 0; e < 16; ++e) { yl[e] = 0; yf[e] = 0; }
        int cs0 = 0, cs1 = 0; float qscale = 0.f;
#if DBG_MODE != 2
        const int* ip = IGI + row * 128; float* gp = IGG + row * 128;
        float cmax = 0.f;
        {
            typedef int v4i __attribute__((ext_vector_type(4)));
            unsigned char* HQ = lds + wid * 2048;
            *(v4i*)(HQ + lane * 16) = (v4i){hq[0], hq[1], hq[2], hq[3]}; *(v4i*)(HQ + 1024 + lane * 16) = (v4i){hq[4], hq[5], hq[6], hq[7]};
            const int el0 = 4 * fr + fq;
            const int ix0 = ip[el0], ix1 = ip[el0 + 64];
            const f32x2 sv0 = USV[ix0], sv1 = USV[ix1]; const float us0 = sv0.x, us1 = sv1.x, vs0 = sv0.y, vs1 = sv1.y;
            const int hoff = 64 * fq + 16 * (lane & 3), ea = (lane >> 2) & 3;
            const int hslo = (int)wave_sum((float)__builtin_amdgcn_sdot4(hq[0], 0x01010101, __builtin_amdgcn_sdot4(hq[1], 0x01010101, __builtin_amdgcn_sdot4(hq[2], 0x01010101, __builtin_amdgcn_sdot4(hq[3], 0x01010101, 0, false), false), false), false));
            v4i Bf[8];
#pragma unroll
            for (int t = 0; t < 8; ++t) Bf[t] = *(const v4i*)(HQ + 256 * t + hoff);
            v4i A0[4], A1[4], A2[4], A3[4];
#define PEER_LD(A_, g_) do { const unsigned char* p_ = U8 + (unsigned)(ip[4 * (g_) + ea] * 1024 + hoff); _Pragma("unroll") for (int t = 0; t < 4; ++t) A_[t] = *(const v4i*)(p_ + 256 * t); } while (0)
            PEER_LD(A0, 0); PEER_LD(A1, 1); PEER_LD(A2, 2);
            int m0 = 0, m1 = 0;
#define PEER_MM(A_) ({ v4i c0_ = {0, 0, 0, 0}, c1_ = {0, 0, 0, 0}; \
                v4i c2_ = {0, 0, 0, 0};   \
                _Pragma("unroll") for (int t = 0; t < 4; ++t) { const v4i hi_m = A_[t] & (int)0xF0F0F0F0u; c0_ = __builtin_amdgcn_mfma_i32_16x16x64_i8(A_[t], Bf[t], c0_, 0, 0, 0); c1_ = __builtin_amdgcn_mfma_i32_16x16x64_i8(hi_m, Bf[4 + t], c1_, 0, 0, 0); c2_ = __builtin_amdgcn_mfma_i32_16x16x64_i8(hi_m, Bf[t], c2_, 0, 0, 0); } \
                c0_ += (c1_ >> 4) - c2_; const int lo_ = (lane & 1) ? c0_[1] : c0_[0], hi_ = (lane & 1) ? c0_[3] : c0_[2]; int v_ = (lane & 2) ? hi_ : lo_; \
                v_ += __builtin_amdgcn_update_dpp(0, v_, 0xB1, 0xf, 0xf, false); v_ += __builtin_amdgcn_update_dpp(0, v_, 0x4E, 0xf, 0xf, false); v_; })
#pragma unroll 1
            for (int gi = 0; gi < 32; gi += 4) {
                PEER_LD(A3, gi + 3);
                const int v0 = PEER_MM(A0);
                if (gi + 4 < 32) PEER_LD(A0, gi + 4);
                const int v1 = PEER_MM(A1);
                if (gi + 4 < 32) PEER_LD(A1, gi + 5);
                const int v2 = PEER_MM(A2);
                if (gi + 4 < 32) PEER_LD(A2, gi + 6);
                const int v3 = PEER_MM(A3);
                const int gl = gi & 15; int mm = (gi < 16) ? m0 : m1;
                mm = (gl == fr) ? v0 : mm; mm = (gl + 1 == fr) ? v1 : mm; mm = (gl + 2 == fr) ? v2 : mm; mm = (gl + 3 == fr) ? v3 : mm;
                if (gi < 16) m0 = mm; else m1 = mm;
            }
#undef PEER_LD
#undef PEER_MM
            const float dot0 = us0 * shq * (float)(m0 - 8 * hslo), dot1 = us1 * shq * (float)(m1 - 8 * hslo);
            const float c1a = gp[el0] * 0.5f * dot0 * (1.0f + erff(dot0 * 0.7071067811865476f)) * vs0, c1b = gp[el0 + 64] * 0.5f * dot1 * (1.0f + erff(dot1 * 0.7071067811865476f)) * vs1;
            cmax = wave_max(fmaxf(fabsf(c1a), fabsf(c1b)));
            asm volatile("s_waitcnt lgkmcnt(0)" ::: "memory");
            gp[el0] = c1a; gp[el0 + 64] = c1b;
        }
        asm volatile("s_waitcnt lgkmcnt(0)" ::: "memory");
        qscale = (cmax > 0.f) ? (127.0f / (cmax * 255.0f)) : 0.f;
        {
            const float qk = qscale * (256.0f / 32767.0f);
            u32x2 va[PB][2], vb[PB][2]; unsigned ga[PB], gb[PB];
#define PEER_LOADV(V_, G_, e_) do { _Pragma("unroll") for (int k = 0; k < PB; ++k) { const int idx_ = __builtin_amdgcn_readfirstlane(ip[(e_) + k]); const unsigned char* vp_ = V4 + (unsigned)(idx_ * 1024 + lane * 8);     \
                V_[k][0] = *(const u32x2*)vp_; V_[k][1] = *(const u32x2*)(vp_ + 512); G_[k] = *(const unsigned short*)((const unsigned char*)VG + (unsigned)(idx_ * 128 + lane * 2)); } } while (0)
#define PEER_MATHV(V_, G_, e_) do { _Pragma("unroll") for (int qd = 0; qd < PB / 4; ++qd) { \
                const f32x4 c4 = *(const f32x4*)(gp + (e_) + qd * 4); \
                float cq4[4]; _Pragma("unroll") for (int k = 0; k < 4; ++k) cq4[k] = c4[k] * qk; \
                _Pragma("unroll") for (int i = 0; i < 2; ++i) { \
                      \
                    float f[4]; _Pragma("unroll") for (int k = 0; k < 4; ++k) f[k] = fmaf(cq4[k], (float)((G_[qd * 4 + k] >> (8 * i)) & 255u), 128.0f / 32767.0f); \
                    const unsigned d01 = __builtin_bit_cast(unsigned, __builtin_amdgcn_cvt_pknorm_i16(f[0], f[1])), d23 = __builtin_bit_cast(unsigned, __builtin_amdgcn_cvt_pknorm_i16(f[2], f[3])); \
                    const int C = (int)__builtin_amdgcn_perm(d23, d01, 0x07050301u); \
                    if (i == 0) cs0 = __builtin_amdgcn_sdot4(C, 0x01010101, cs0, false); else cs1 = __builtin_amdgcn_sdot4(C, 0x01010101, cs1, false); \
                    _Pragma("unroll") for (int j = 0; j < 2; ++j) { \
                        const unsigned W0 = V_[qd * 4 + 0][i][j], W1 = V_[qd * 4 + 1][i][j], W2 = V_[qd * 4 + 2][i][j], W3 = V_[qd * 4 + 3][i][j]; \
                        const unsigned p01a = __builtin_amdgcn_perm(W1, W0, 0x05010400u), p01b = __builtin_amdgcn_perm(W1, W0, 0x07030602u); \
                        const unsigned p23a = __builtin_amdgcn_perm(W3, W2, 0x05010400u), p23b = __builtin_amdgcn_perm(W3, W2, 0x07030602u); \
                        unsigned T[4]; \
                        T[0] = __builtin_amdgcn_perm(p23a, p01a, 0x05040100u); T[1] = __builtin_amdgcn_perm(p23a, p01a, 0x07060302u); \
                        T[2] = __builtin_amdgcn_perm(p23b, p01b, 0x05040100u); T[3] = __builtin_amdgcn_perm(p23b, p01b, 0x07060302u); \
                        _Pragma("unroll") for (int b = 0; b < 4; ++b) { \
                            yf[(i * 2 + j) * 4 + b] = __builtin_amdgcn_sdot4((int)T[b], C, yf[(i * 2 + j) * 4 + b], false); \
                            yl[(i * 2 + j) * 4 + b] = __builtin_amdgcn_sdot4((int)(T[b] & 0x0F0F0F0Fu), C, yl[(i * 2 + j) * 4 + b], false); } } } } } while (0)
            PEER_LOADV(va, ga, 0); PEER_LOADV(vb, gb, PB);
#pragma unroll 1
            for (int e = 0; e < 128; e += 2 * PB) {
                PEER_MATHV(va, ga, e);
                if (e + 2 * PB < 128) PEER_LOADV(va, ga, e + 2 * PB);
                PEER_MATHV(vb, gb, e + PB);
                if (e + 3 * PB < 128) PEER_LOADV(vb, gb, e + 3 * PB);
            }
#undef PEER_LOADV
#undef PEER_MATHV
        }
#endif
        float yq[32];
        {
            const float inv = (qscale > 0.f) ? (1.0f / qscale) : 0.f;
#pragma unroll
            for (int i = 0; i < 2; ++i)
#pragma unroll
                for (int j = 0; j < 2; ++j)
#pragma unroll
                    for (int b = 0; b < 4; ++b) { const int t = (i * 2 + j) * 4 + b;
                        yq[i * 16 + j * 8 + b] = (float)(yl[t] - 8 * (i ? cs1 : cs0)) * inv; yq[i * 16 + j * 8 + 4 + b] = (float)(yf[t] - yl[t]) * (inv * 0.0625f); }
        }
        const float csum2[2] = {0.f, 0.f};
        float* rp = a->out + (size_t)tok * 2048; const bf16_t* xp = (const bf16_t*)(a->ws + WS_XN) + (size_t)tok * 2048;
        float val[32]; float s = 0.f;
#pragma unroll
        for (int i = 0; i < 2; ++i)
#pragma unroll
            for (int j = 0; j < 4; ++j) { const int col = (4 * i + j) * 256 + lane * 4; const u32x2 xw = __builtin_nontemporal_load((const u32x2*)(xp + col)); const f32x4 x0 = (f32x4){bflo(xw.x), bfhi(xw.x), bflo(xw.y), bfhi(xw.y)}, g0 = *(const f32x4*)(PV + col);
#pragma unroll
                for (int e = 0; e < 4; ++e) { const float v = ALPHA * x0[e] + g0[e] * (yq[i * 16 + j * 4 + e] - 8.0f * csum2[i]); val[i * 16 + j * 4 + e] = v; s += v; } }
        const float mu = wave_sum(s) * (1.0f / 2048.0f);
        float q = 0.f;
#pragma unroll
        for (int e = 0; e < 32; ++e) { const float d = val[e] - mu; q += d * d; }
        const float rstd = rsqrtf(wave_sum(q) * (1.0f / 2048.0f) + 1e-5f);
#pragma unroll
        for (int i = 0; i < 2; ++i)
#pragma unroll
            for (int j = 0; j < 4; ++j) { const int col = (4 * i + j) * 256 + lane * 4; const f32x4 gg = *(const f32x4*)(PV + 2048 + col), bv = *(const f32x4*)(PV + 4096 + col); f32x4 o;
#pragma unroll
                for (int e = 0; e < 4; ++e) o[e] = (val[i * 16 + j * 4 + e] - mu) * rstd * gg[e] + bv[e];
                __builtin_nontemporal_store(o, (f32x4*)(rp + col)); }
    }
    __syncthreads();
}

constexpr size_t WS_BAR = 699 * MiB;

constexpr int XB_TMO = 128, XB_TOP = 3328, XB_TOPGEN = 3392, XCD_BAR_WORDS = 3456;
#define XB_XCNT(j) (256 + 64 * (j))
#define XB_XSUB(j) (1280 + 64 * (j))
#define XB_XGEN(j) (2304 + 64 * (j))
constexpr int XB_ST_OFF = TIDTAB_OFF - 16;
constexpr unsigned XB_SPIN_CAP = 1u << 18;
__device__ __forceinline__ unsigned xb_ld(unsigned* p) { return __hip_atomic_load(p, __ATOMIC_RELAXED, __HIP_MEMORY_SCOPE_AGENT); }
__device__ __forceinline__ unsigned xb_add(unsigned* p, unsigned v) { return __hip_atomic_fetch_add(p, v, __ATOMIC_RELAXED, __HIP_MEMORY_SCOPE_AGENT); }
__device__ __forceinline__ unsigned xb_xcc_id() { return (unsigned)__builtin_amdgcn_s_getreg((3 << 11) | 20) & 0xFu; }
#define XB_SPIN(cond, bar) do { unsigned _sp = 0; while (cond) { __builtin_amdgcn_s_sleep(1); \
    if ((++_sp & 255u) == 0u) { if (xb_ld(&(bar)[XB_TMO])) break; if (_sp > XB_SPIN_CAP) { xb_add(&(bar)[XB_TMO], 1u); break; } } } } while (0)
__device__ __forceinline__ void xcd_census_post(unsigned* bar) { if (tid_opaque() == 0) (void)xb_add(&bar[XB_XCNT(xb_xcc_id())], 1u); }
__device__ __forceinline__ void xcd_barrier_complete(unsigned* bar, unsigned x, unsigned& nloc, unsigned& nx) {
    const unsigned G = gridDim.x;
    unsigned sum, cnt, mine, sp = 0u;
    for (;;) {
        sum = 0u; cnt = 0u; mine = 0u;
#pragma unroll
        for (unsigned j = 0; j < 16; ++j) { const unsigned c = xb_ld(&bar[XB_XCNT(j)]); sum += c; cnt += (c > 0u) ? 1u : 0u; mine = (j == x) ? c : mine; }
        if (sum == G) break;
        __builtin_amdgcn_s_sleep(1);
        if ((++sp & 255u) == 0u) { if (xb_ld(&bar[XB_TMO])) break; if (sp > XB_SPIN_CAP) { xb_add(&bar[XB_TMO], 1u); break; } }
    }
    nloc = mine > 0u ? mine : 1u; nx = cnt > 0u ? cnt : 1u;
}
__device__ __forceinline__ void grid_bar(unsigned* bar) {
    asm volatile("s_waitcnt vmcnt(0)" ::: "memory");
    __syncthreads();
    if (tid_opaque() == 0) {
        volatile unsigned* st = (volatile unsigned*)(g_lds + XB_ST_OFF);
        const unsigned x = xb_xcc_id();
        __builtin_amdgcn_s_waitcnt(0);
        unsigned nloc = st[0], nx = st[1];
        if (nloc == 0u) { xcd_barrier_complete(bar, x, nloc, nx); st[0] = nloc; st[1] = nx; }
        const unsigned old = xb_add(&bar[XB_XSUB(x)], 1u);
        const unsigned gen = old / nloc;
        if (old + 1u == (gen + 1u) * nloc) {
            __builtin_amdgcn_fence(__ATOMIC_RELEASE, "agent");
            asm volatile("s_waitcnt vmcnt(0)" ::: "memory");
            const unsigned og = xb_add(&bar[XB_TOP], 1u);
            const unsigned tg = og / nx;
            if (og + 1u == (tg + 1u) * nx) xb_add(&bar[XB_TOPGEN], 1u);
            else XB_SPIN(xb_ld(&bar[XB_TOPGEN]) == tg, bar);
            __builtin_amdgcn_fence(__ATOMIC_ACQUIRE, "agent");
            xb_add(&bar[XB_XGEN(x)], 1u);
            asm volatile("s_waitcnt vmcnt(0)" ::: "memory");
        } else {
            XB_SPIN(xb_ld(&bar[XB_XGEN(x)]) == gen, bar);
            __builtin_amdgcn_fence(__ATOMIC_ACQUIRE, "agent");
            asm volatile("s_waitcnt vmcnt(0)" ::: "memory");
        }
    }
    __syncthreads();
}

__global__ void __launch_bounds__(NT, 2) fwd_mega(Args a_) {
    KA a = (KA)__builtin_amdgcn_kernarg_segment_ptr();
    unsigned char* lds = g_lds;
    if (threadIdx.x == 0) { ((volatile unsigned*)(g_lds + XB_ST_OFF))[0] = 0u; ((volatile unsigned*)(g_lds + XB_ST_OFF))[1] = 0u; }
    tid_table_init();
    cg::grid_group grid = cg::this_grid();
    float* lf = (float*)lds;
    const int lo = a->ph_lo, hi = a->ph_hi;
#define IN(k) (lo <= (k) && (k) < hi)
    unsigned* barctr = (unsigned*)(a->ws + WS_BAR); unsigned nbar = 0;
    if (blockIdx.x == 0) { for (int i = tid_opaque(); i < XCD_BAR_WORDS; i += NT) __hip_atomic_store(barctr + i, 0u, __ATOMIC_RELAXED, __HIP_MEMORY_SCOPE_AGENT); }
    (void)nbar;
#define GBAR() do { grid_bar((unsigned*)(a->ws + WS_BAR)); } while (0)
#define SEAM(k) do { if (IN(k) && IN((k) + 1)) { if ((k) == 0) { grid.sync(); xcd_census_post((unsigned*)(a->ws + WS_BAR)); } else GBAR(); } asm volatile("" : "+s"(a)); } while (0)
    unsigned char* ws = a->ws;
    bf16_t* HA = (bf16_t*)(ws + WS_HA); bf16_t* WT = (bf16_t*)(ws + WS_WT); bf16_t* SW = (bf16_t*)(ws + WS_SW);
    bf16_t* RA = (bf16_t*)(ws + WS_RA); bf16_t* RB = (bf16_t*)(ws + WS_RB);
    const float* mod = (const float*)(ws + WS_MOD); const float* sa = (const float*)(ws + WS_SA); const float* swf = (const float*)(ws + WS_SWF);

    if (IN(0)) {
#pragma unroll 1
        for (int rep = 0; rep < a->reps[0]; ++rep) { p0_mod_hid2(a, lf); p0_transposes(a, lf); }
    }
    SEAM(0);
    if (IN(1)) {
#pragma unroll 1
        for (int rep = 0; rep < a->reps[0]; ++rep) { p1_ha(a); p1_wquant(a); for (int u = blockIdx.x; u < 256; u += gridDim.x) filt_unit(a, u, lds); for (int u = blockIdx.x; u < 256; u += gridDim.x) wprime_unit(a, u, lds); }
    }
    SEAM(1);
    if (IN(2)) {
#pragma unroll 1
        for (int rep = 0; rep < a->reps[1]; ++rep) {
        run_gemm8(lds, ws + WS_WQ8 + (size_t)WT_HY0 * 2048, ws + WS_HA8, NHY, MT, swf + WT_HY0, sa, FStoreBf16{RA, MT, 1.0f});
        run_gemm8(lds, ws + WS_HA8, ws + WS_WQ8, MA, NQKVP, sa, swf, FStoreQKV{RB, (float*)(ws + WS_AB)});
        }
    }
    SEAM(2);
    if (IN(3)) {
        { Hy2W HW; Hy2T HT; hyena2_setup(lds, HW, HT);
#pragma unroll 1
        for (int rep = 0; rep < a->reps[3]; ++rep)
        for (int c = blockIdx.x; c < 2048; c += gridDim.x) hyena2_item(a, c, lds, HW, HT);
        __syncthreads(); }
        qkvpost_latent(a, lds);
        for (int u = 12288 + blockIdx.x; u < 12288 + 192; u += gridDim.x) qkvpost_unit(a, u, lds);
    }
    SEAM(3);
    if (IN(4)) {
#pragma unroll 1
        for (int rep = 0; rep < a->reps[4]; ++rep)
        { const int wv = tid_opaque() >> 6; const int nw = gridDim.x * 8, nround = 8704 / nw, rem = 8704 - nround * nw, per = (rem + (int)gridDim.x - 1) / (int)gridDim.x;
#pragma unroll 1
          for (int k = 0; k <= nround; ++k) {
              const int pid = (k < nround) ? (k * nw + blockIdx.x * 8 + wv) : ((wv < per) ? (nround * nw + blockIdx.x * per + wv) : 8704);
              if (pid < 8704) tprep_wave(a, pid, lds + wv * 18944);
          } }
        GBAR();
#pragma unroll 1
        for (int rep = 0; rep < a->reps[5]; ++rep)
        for (int it = blockIdx.x; it < 256; it += gridDim.x) delta_item(a, it, lds);
    }
    SEAM(4);
    if (IN(5)) {
        run_gemm8(lds, ws + WS_HA8, ws + WS_WQ8 + (size_t)WT_ZG0 * 2048, MT, NZG, sa, swf + WT_ZG0, FStoreBf16{RB, NZG, 1.0f});
#pragma unroll 1
        for (int rep = 0; rep < a->reps[6]; ++rep)
        ytrans_all((const bf16_t*)a->out, RA + (size_t)2 * MT * 2048, (bf16_t*)lds);
    }
    SEAM(5);
    if (IN(6)) {
#pragma unroll 1
        for (int rep = 0; rep < a->reps[6]; ++rep) { p6_on(a); } }
    SEAM(6);
    if (IN(7)) {
        run_gemm8(lds, ws + WS_HA8  , ws + WS_WSW8, MT, D, (const float*)(ws + WS_SON), swf + 18688, FGatePA{RB, WT  });
        run_gemm(lds, RA + (size_t)2 * MT * 2048  , SW + (size_t)1 * D * D, MT, D, FGatePH{RB, WT  });
    }
    SEAM(7);
    if (IN(8)) {
        run_gemm(lds, WT  , SW + (size_t)2 * D * D, MT, D, FOut{a->in[0], mod, (bf16_t*)(ws + WS_XN)});
#pragma unroll 1
        for (int rep = 0; rep < a->reps[7]; ++rep) p8_tables(a);
    }
    SEAM(8);
    if (IN(9)) { p9_ln1(a); }
    SEAM(9);
    if (IN(10)) { run_gemm8(lds, ws + WS_RA + (size_t)2 * MT * 2048 * 2  , ws + WS_WP8, MT, D, (const float*)(ws + WS_SH2), swf + 18688 + 2048, FStoreBf16{RB, D, 1.0f});     }
    SEAM(10);
    if (IN(11)) { for (int u = blockIdx.x; u < MT / 64; u += gridDim.x) peer_unit(a, u, lds); }
#undef IN
#undef SEAM
}

extern "C" void kernel_launch(void* const* d_in, const int* in_sizes, int n_in, void* d_out, int out_size, void* d_ws, size_t ws_size, hipStream_t stream) {
    static int grid = 0;
    if (grid == 0) {
        if (n_in != 31 || out_size != MT * D || ws_size < WS_BAR + 16384) { fprintf(stderr, "kernel_launch: unexpected problem shape / workspace (%d inputs, out %d, ws %zu)\n", n_in, out_size, ws_size); grid = -1; return; }
        int dev = 0, cus = 0, per_cu = 0;
        (void)hipGetDevice(&dev);
        (void)hipDeviceGetAttribute(&cus, hipDeviceAttributeMultiprocessorCount, dev);
        (void)hipFuncSetAttribute((const void*)fwd_mega, hipFuncAttributeMaxDynamicSharedMemorySize, LDS_BYTES);
        (void)hipOccupancyMaxActiveBlocksPerMultiprocessor(&per_cu, (const void*)fwd_mega, NT, LDS_BYTES);
        if (per_cu < 1) per_cu = 1;
        grid = cus * per_cu;
        (void)hipGetLastError();
    }
    if (grid < 0) return;
    Args a{};
    for (int i = 0; i < 31; ++i) a.in[i] = (const float*)d_in[i];
    a.out = (float*)d_out; a.ws = (unsigned char*)d_ws; a.ph_lo = 0; a.ph_hi = 12; a.reps[0] = REP0; a.reps[1] = REP1; a.reps[2] = REP2; a.reps[3] = REP3; a.reps[4] = REP4; a.reps[5] = REP5; a.reps[6] = REP6; a.reps[7] = REP7; a.pad2[0] = REPG;
    void* args[] = {&a};
    hipError_t e = hipLaunchCooperativeKernel((const void*)fwd_mega, dim3(grid), dim3(NT), args, LDS_BYTES, stream);
    if (e != hipSuccess) fprintf(stderr, "cooperative launch failed: %s (grid %d)\n", hipGetErrorString(e), grid);
}
```

```cpp
#include <hip/hip_runtime.h>
#include <hip/hip_cooperative_groups.h>
#include <cstdio>
#include <cstdint>
namespace cg = cooperative_groups;

#ifndef DBG_MODE
#define DBG_MODE 0
#endif
#define PA 4
#define PB 8
#define REP0 1
#define REP1 1
#define REP2 1
#define REP3 1
#define REP4 1
#define REP5 1
#define REP6 1
#define REP7 1
#define REPG 1

extern __shared__ __attribute__((aligned(16))) unsigned char g_lds[];
constexpr int TIDTAB_OFF = 160 * 1024 - 256;
__device__ __forceinline__ int tid_opaque() {
    const int slot = __builtin_amdgcn_s_getreg(0x2804) & 63;
    int wv = __builtin_amdgcn_readfirstlane(((const int*)(g_lds + TIDTAB_OFF))[slot]);
    int ln; asm volatile("v_mbcnt_lo_u32_b32 %0, -1, 0\n\tv_mbcnt_hi_u32_b32 %0, -1, %0" : "=v"(ln));
    int t = wv * 64 + ln;
    asm volatile("" : "+v"(t));
    return t;
}
__device__ __forceinline__ void tid_table_init() {
    const int t = threadIdx.x;
    if ((t & 63) == 0) ((int*)(g_lds + TIDTAB_OFF))[__builtin_amdgcn_s_getreg(0x2804) & 63] = t >> 6;
    __syncthreads();
}

namespace pg8 {
#define PG8_LAS __attribute__((address_space(3)))
typedef unsigned short bf16_t;
typedef short bf16x8 __attribute__((ext_vector_type(8)));
typedef float f32x4 __attribute__((ext_vector_type(4)));
typedef unsigned u32x4 __attribute__((ext_vector_type(4)));
constexpr int BM = 256, BK = 64, HALF = 128, HTB = HALF * BK * 2, STAGE_BYTES = 8 * HTB, NXCD = 8, WGM = 8;

__host__ __device__ __forceinline__ int lds_byte(int r, int c) { const int st = (r >> 4) * 2 + (c >> 5), rr = r & 15, cc = c & 31, ob = rr * 64 + cc * 2; return st * 1024 + (ob ^ (((ob >> 9) & 1) << 5)); }
__host__ __device__ __forceinline__ void stage_rc(int b, int& R, int& C) { const int st = b / 1024, sb = b % 1024, swz = sb ^ (((sb >> 9) & 1) << 5); R = (st >> 1) * 16 + swz / 64; C = (st & 1) * 32 + (swz % 64) / 2; }
__host__ __device__ __forceinline__ int perm32(int rho) { const int n = rho >> 4, i = rho & 15; return 8 * (i >> 2) + 4 * n + (i & 3); }

struct Unit { int pm, pn; };
struct Gemm { const bf16_t* A; const bf16_t* Bt; int M, N, K; };

struct StaticOrder {
    int nM, nN, nwg, G, c;
    __host__ __device__ void init(int M, int N, int G_, int c_) { nM = M / BM; nN = N / BM; nwg = nM * nN; G = G_; c = c_; }
    __host__ __device__ bool next(int i, Unit& u) const {
        const long L = (long)i * G + c; if (L >= nwg) return false;
        int wgid = (int)L; { const int q = nwg / NXCD, r = nwg % NXCD, xcd = wgid % NXCD, off = wgid / NXCD; wgid = (xcd < r ? xcd * (q + 1) : r * (q + 1) + (xcd - r) * q) + off; }
        const int nig = WGM * nN, gid = wgid / nig, fm = gid * WGM, gsz = (nM - fm) < WGM ? (nM - fm) : WGM;
        u.pm = fm + ((wgid % nig) % gsz); u.pn = (wgid % nig) / gsz; return true;
    }
    __device__ __forceinline__ void a_ready(const Unit&) const {}
    __device__ __forceinline__ void done(const Unit&) const {}
};

__device__ __forceinline__ unsigned cvt_pk_bf16(float lo, float hi) { unsigned r; asm volatile("v_cvt_pk_bf16_f32 %0, %1, %2" : "=v"(r) : "v"(lo), "v"(hi)); return r; }

template <class F> struct EpiGen {
    static constexpr bool PERM = true, AFTER_DRAIN = false;
    F f;
    __device__ __forceinline__ void operator()(const f32x4 (&acc)[2][2][4][2], const Unit& u, int wr, int wc, int, int) const {
        int ln; asm volatile("v_mbcnt_lo_u32_b32 %0, -1, 0\n\tv_mbcnt_hi_u32_b32 %0, -1, %0" : "=v"(ln));
        const int fr = ln & 15, fq = ln >> 4;
        const int row0 = u.pm * BM + wr * 64 + fr, col0 = u.pn * BM + wc * 32 + 8 * fq;
#pragma unroll
        for (int ai = 0; ai < 2; ++ai)
#pragma unroll
            for (int m = 0; m < 4; ++m)
#pragma unroll
                for (int bj = 0; bj < 2; ++bj) f(row0 + ai * HALF + m * 16, col0 + bj * HALF, acc[ai][bj][m][0], acc[ai][bj][m][1]);
    }
};

typedef int i32x4e __attribute__((ext_vector_type(4)));
template <class F> struct EpiGenI {
    static constexpr bool PERM = true, AFTER_DRAIN = false;
    F f; const float* srow; const float* scol;
    __device__ __forceinline__ void operator()(const i32x4e (&acc)[2][2][4][2], const Unit& u, int wr, int wc, int, int) const {
        int ln; asm volatile("v_mbcnt_lo_u32_b32 %0, -1, 0\n\tv_mbcnt_hi_u32_b32 %0, -1, %0" : "=v"(ln));
        const int fr = ln & 15, fq = ln >> 4;
        const int row0 = u.pm * BM + wr * 64 + fr, col0 = u.pn * BM + wc * 32 + 8 * fq;
        float sr[2][4]; f32x4 sc[2][2];
#pragma unroll
        for (int ai = 0; ai < 2; ++ai)
#pragma unroll
            for (int m = 0; m < 4; ++m) sr[ai][m] = srow[row0 + ai * HALF + m * 16];
#pragma unroll
        for (int bj = 0; bj < 2; ++bj) { sc[bj][0] = *(const f32x4*)(scol + col0 + bj * HALF); sc[bj][1] = *(const f32x4*)(scol + col0 + bj * HALF + 4); }
#pragma unroll
        for (int ai = 0; ai < 2; ++ai)
#pragma unroll
            for (int m = 0; m < 4; ++m)
#pragma unroll
                for (int bj = 0; bj < 2; ++bj)
                    f(row0 + ai * HALF + m * 16, col0 + bj * HALF, __builtin_convertvector(acc[ai][bj][m][0], f32x4) * sr[ai][m] * sc[bj][0], __builtin_convertvector(acc[ai][bj][m][1], f32x4) * sr[ai][m] * sc[bj][1]);
    }
};

template <class Epi, class Sched, bool ALIGN_EPI = false, bool SP2 = false>
__device__ __forceinline__ void gemm_phase(PG8_LAS unsigned char* lds, const Gemm g, const Sched& S, const Epi& E) {
    const int tid = tid_opaque(), wid = __builtin_amdgcn_readfirstlane(tid >> 6), lane = tid & 63, wr = wid >> 2, wc = wid & 3, fr = lane & 15, fq = lane >> 4;
    const int K = g.K, nt = K / BK;
    unsigned voffA[2], voffB[2];
#pragma unroll
    for (int i = 0; i < 2; ++i) { int R, C; stage_rc(tid * 16 + i * 8192, R, C); const int Rb = Epi::PERM ? ((R & ~31) + perm32(R & 31)) : R;
        voffA[i] = (unsigned)(R * K + C) * 2u; voffB[i] = (unsigned)(Rb * K + C) * 2u; }
    const size_t kstep = (size_t)(BK * 2);
    const size_t hstep = (size_t)HALF * K * 2;
    const size_t tstep = 2 * hstep;
    const unsigned ldsw = (unsigned)wid * 1024u;
    const int aoff = lds_byte(wr * 64 + fr, fq * 8), boff = lds_byte(wc * 32 + fr, fq * 8);
#define PG8_SA(b, h) (((b) * 2 + (h)) * HTB)
#define PG8_SB(b, h) ((4 + (b) * 2 + (h)) * HTB)
#define PG8_STAGE(bufoff, gbase, voff) do { _Pragma("unroll") for (int _i = 0; _i < 2; ++_i) \
        __builtin_amdgcn_global_load_lds((const unsigned*)((const char*)(gbase) + (voff)[_i]), (PG8_LAS unsigned*)(lds + (bufoff) + ldsw + _i * 8192), 16, 0, 0); } while (0)
#define PG8_LDA(dst, b, h) do { _Pragma("unroll") for (int m = 0; m < 4; ++m) _Pragma("unroll") for (int k = 0; k < 2; ++k) dst[m][k] = *(const PG8_LAS bf16x8*)(lds + PG8_SA(b, h) + aoff + m * 2048 + k * 1024); } while (0)
#define PG8_LDB(dst, b, h) do { _Pragma("unroll") for (int n = 0; n < 2; ++n) _Pragma("unroll") for (int k = 0; k < 2; ++k) dst[n][k] = *(const PG8_LAS bf16x8*)(lds + PG8_SB(b, h) + boff + n * 2048 + k * 1024); } while (0)
#define PG8_MMA(ai, bj, At, Bt) do { __builtin_amdgcn_s_setprio(1); _Pragma("unroll") for (int m = 0; m < 4; ++m) _Pragma("unroll") for (int n = 0; n < 2; ++n) _Pragma("unroll") for (int k = 0; k < 2; ++k) \
        acc[ai][bj][m][n] = __builtin_amdgcn_mfma_f32_16x16x32_bf16(Bt[n][k], At[m][k], acc[ai][bj][m][n], 0, 0, 0); __builtin_amdgcn_s_setprio(0); } while (0)
#define PG8_WAIT_V(n) asm volatile("s_waitcnt vmcnt(" #n ")" ::: "memory")
#define PG8_WAIT_L(n) asm volatile("s_waitcnt lgkmcnt(" #n ")" ::: "memory")
#define PG8_BAR __builtin_amdgcn_s_barrier()
#define PG8_SCHED __builtin_amdgcn_sched_barrier(0)
    Unit cur, nxt; int ui = 0;
    if (!S.next(0, cur)) return;
    f32x4 acc[2][2][4][2];
#pragma unroll
    for (int a = 0; a < 2; ++a)
#pragma unroll
        for (int b = 0; b < 2; ++b)
#pragma unroll
            for (int m = 0; m < 4; ++m)
#pragma unroll
                for (int n = 0; n < 2; ++n) acc[a][b][m][n] = (f32x4){0.f, 0.f, 0.f, 0.f};
    bf16x8 At[4][2], B0[2][2], B1[2][2];
    const char* cA = (const char*)g.A + (size_t)cur.pm * tstep; const char* cB = (const char*)g.Bt + (size_t)cur.pn * tstep;
    S.a_ready(cur);
    if constexpr (SP2) {
        PG8_STAGE(PG8_SB(0, 0), cB, voffB); PG8_STAGE(PG8_SB(0, 1), cB + hstep, voffB); PG8_STAGE(PG8_SA(0, 0), cA, voffA); PG8_STAGE(PG8_SA(0, 1), cA + hstep, voffA);
        if (wr == 1) PG8_BAR;
        PG8_WAIT_V(2); PG8_BAR;
        PG8_STAGE(PG8_SB(1, 0), cB + kstep, voffB); PG8_STAGE(PG8_SA(1, 0), cA + kstep, voffA); PG8_STAGE(PG8_SB(1, 1), cB + hstep + kstep, voffB);
        PG8_WAIT_V(6); PG8_BAR;
    } else {
        PG8_STAGE(PG8_SB(0, 0), cB, voffB); PG8_STAGE(PG8_SA(0, 0), cA, voffA); PG8_STAGE(PG8_SB(0, 1), cB + hstep, voffB); PG8_STAGE(PG8_SA(0, 1), cA + hstep, voffA);
        if (wr == 1) PG8_BAR;
        PG8_WAIT_V(4); PG8_BAR;
        PG8_STAGE(PG8_SB(1, 0), cB + kstep, voffB); PG8_STAGE(PG8_SA(1, 0), cA + kstep, voffA); PG8_STAGE(PG8_SB(1, 1), cB + hstep + kstep, voffB);
        PG8_WAIT_V(6); PG8_BAR;
    }
    for (;;) {
        const bool has_next = S.next(ui + 1, nxt);
        const char* nA = has_next ? (const char*)g.A + (size_t)nxt.pm * tstep : cA; const char* nB = has_next ? (const char*)g.Bt + (size_t)nxt.pn * tstep : cB;
        for (int t = 0; t < nt; t += 2) {
            const bool last = (t == nt - 2);
            const char* a1 = cA + (size_t)(t + 1) * kstep;
            const char* a2 = last ? nA : cA + (size_t)(t + 2) * kstep; const char* b2 = last ? nB : cB + (size_t)(t + 2) * kstep;
            const char* a3 = a2 + kstep; const char* b3 = b2 + kstep;
            if (last && has_next) S.a_ready(nxt);
            if constexpr (SP2) {
            PG8_LDB(B0, 0, 0); PG8_LDB(B1, 0, 1); PG8_SCHED; PG8_LDA(At, 0, 0); PG8_STAGE(PG8_SA(1, 1), a1 + hstep, voffA);
            PG8_WAIT_V(8); PG8_WAIT_L(0); PG8_BAR; PG8_MMA(0, 0, At, B0); PG8_MMA(0, 1, At, B1); PG8_BAR; PG8_SCHED;
            PG8_LDA(At, 0, 1); PG8_STAGE(PG8_SB(0, 0), b2, voffB); PG8_STAGE(PG8_SB(0, 1), b2 + hstep, voffB); PG8_STAGE(PG8_SA(0, 0), a2, voffA);
            PG8_WAIT_V(8); PG8_WAIT_L(0); PG8_BAR; PG8_MMA(1, 0, At, B0); PG8_MMA(1, 1, At, B1); PG8_BAR; PG8_SCHED;
            PG8_LDB(B0, 1, 0); PG8_LDB(B1, 1, 1); PG8_SCHED; PG8_LDA(At, 1, 0); PG8_STAGE(PG8_SA(0, 1), a2 + hstep, voffA);
            PG8_WAIT_V(8); PG8_WAIT_L(0); PG8_BAR; PG8_MMA(0, 0, At, B0); PG8_MMA(0, 1, At, B1); PG8_BAR; PG8_SCHED;
            PG8_LDA(At, 1, 1); PG8_STAGE(PG8_SB(1, 0), b3, voffB); PG8_STAGE(PG8_SB(1, 1), b3 + hstep, voffB); PG8_STAGE(PG8_SA(1, 0), a3, voffA);
            PG8_WAIT_V(8); PG8_WAIT_L(0); PG8_BAR; PG8_MMA(1, 0, At, B0); PG8_MMA(1, 1, At, B1); PG8_BAR; PG8_SCHED;
            } else {
            PG8_LDB(B0, 0, 0); PG8_SCHED; PG8_LDA(At, 0, 0); PG8_STAGE(PG8_SA(1, 1), a1 + hstep, voffA);
            PG8_WAIT_L(8); PG8_BAR; PG8_WAIT_L(0); PG8_MMA(0, 0, At, B0); PG8_BAR; PG8_SCHED;
            PG8_LDB(B1, 0, 1); PG8_STAGE(PG8_SB(0, 0), b2, voffB);
            PG8_BAR; PG8_WAIT_L(0); PG8_MMA(0, 1, At, B1); PG8_BAR;
            PG8_LDA(At, 0, 1); PG8_STAGE(PG8_SA(0, 0), a2, voffA);
            PG8_BAR; PG8_WAIT_L(0); PG8_MMA(1, 0, At, B0); PG8_BAR; PG8_SCHED;
            PG8_STAGE(PG8_SB(0, 1), b2 + hstep, voffB);
            PG8_WAIT_V(6); PG8_BAR; PG8_MMA(1, 1, At, B1); PG8_BAR;
            PG8_LDB(B0, 1, 0); PG8_SCHED; PG8_LDA(At, 1, 0); PG8_STAGE(PG8_SA(0, 1), a2 + hstep, voffA);
            PG8_WAIT_L(8); PG8_BAR; PG8_WAIT_L(0); PG8_MMA(0, 0, At, B0); PG8_BAR; PG8_SCHED;
            PG8_LDB(B1, 1, 1); PG8_STAGE(PG8_SB(1, 0), b3, voffB);
            PG8_BAR; PG8_WAIT_L(0); PG8_MMA(0, 1, At, B1); PG8_BAR;
            PG8_LDA(At, 1, 1); PG8_STAGE(PG8_SA(1, 0), a3, voffA);
            PG8_BAR; PG8_WAIT_L(0); PG8_MMA(1, 0, At, B0); PG8_BAR; PG8_SCHED;
            PG8_STAGE(PG8_SB(1, 1), b3 + hstep, voffB);
            PG8_WAIT_V(6); PG8_BAR; PG8_MMA(1, 1, At, B1); PG8_BAR;
            }
        }
        if constexpr (ALIGN_EPI) { if (wr == 0) PG8_BAR; }
        if constexpr (!Epi::AFTER_DRAIN) { E(acc, cur, wr, wc, fr, fq); S.done(cur); }
        if (!has_next) break;
#pragma unroll
        for (int a = 0; a < 2; ++a)
#pragma unroll
            for (int b = 0; b < 2; ++b)
#pragma unroll
                for (int m = 0; m < 4; ++m)
#pragma unroll
                    for (int n = 0; n < 2; ++n) acc[a][b][m][n] = (f32x4){0.f, 0.f, 0.f, 0.f};
        cur = nxt; cA = nA; cB = nB; ++ui;
        if constexpr (ALIGN_EPI) { if (wr == 1) PG8_BAR; }
    }
    PG8_WAIT_V(0);
    if constexpr (!ALIGN_EPI) { if (wr == 0) PG8_BAR; }
    PG8_BAR;
    if constexpr (Epi::AFTER_DRAIN) { E.fused(acc, cur, wr, wc, fr, fq, lds, wid, lane); S.done(cur); }
#undef PG8_SA
#undef PG8_SB
#undef PG8_STAGE
#undef PG8_LDA
#undef PG8_LDB
#undef PG8_MMA
#undef PG8_WAIT_V
#undef PG8_WAIT_L
#undef PG8_BAR
#undef PG8_SCHED
}
typedef int i32x4 __attribute__((ext_vector_type(4)));
typedef int i32x8 __attribute__((ext_vector_type(8)));
template <class Epi, class Sched, bool ALIGN_EPI = false, bool SP2 = false>
__device__ __forceinline__ void gemm_phase8(PG8_LAS unsigned char* lds, const Gemm g, const Sched& S, const Epi& E) {
    const int tid = tid_opaque(), wid = __builtin_amdgcn_readfirstlane(tid >> 6), lane = tid & 63, wr = wid >> 2, wc = wid & 3, fr = lane & 15, fq = lane >> 4;
    const int K = g.K, nt = K / BK;
    unsigned voffA[2], voffB[2];
#pragma unroll
    for (int i = 0; i < 2; ++i) { int R, C; stage_rc(tid * 16 + i * 8192, R, C); const int Rb = Epi::PERM ? ((R & ~31) + perm32(R & 31)) : R;
        voffA[i] = (unsigned)(R * K + C) * 2u; voffB[i] = (unsigned)(Rb * K + C) * 2u; }
    const size_t rstep64 = (size_t)64 * K * 2;
    const size_t kstep = (size_t)(BK * 2);
    const size_t hstep = (size_t)HALF * K * 2;
    const size_t tstep = 2 * hstep;
    const unsigned ldsw = (unsigned)wid * 1024u;
    const int aoff = lds_byte(wr * 64 + fr, fq * 8), boff = lds_byte(wc * 32 + fr, fq * 8);
#define PG8_SA(b, h) (((b) * 2 + (h)) * HTB)
#define PG8_SB(b, h) ((4 + (b) * 2 + (h)) * HTB)
#define PG8_STAGE(bufoff, gbase, voff) do { _Pragma("unroll") for (int _i = 0; _i < 2; ++_i) \
        __builtin_amdgcn_global_load_lds((const unsigned*)((const char*)(gbase) + (size_t)_i * rstep64 + (voff)[0]), (PG8_LAS unsigned*)(lds + (bufoff) + ldsw + _i * 8192), 16, 0, 0); } while (0)
#define PG8_LD32(p) __builtin_shufflevector(*(const PG8_LAS i32x4*)(p), *(const PG8_LAS i32x4*)((p) + 1024), 0, 1, 2, 3, 4, 5, 6, 7)
#define PG8_LDA(dst, b, h) do { _Pragma("unroll") for (int m = 0; m < 4; ++m) dst[m] = PG8_LD32(lds + PG8_SA(b, h) + aoff + m * 2048); } while (0)
#define PG8_LDB(dst, b, h) do { _Pragma("unroll") for (int n = 0; n < 2; ++n) dst[n] = PG8_LD32(lds + PG8_SB(b, h) + boff + n * 2048); } while (0)
#define PG8_LO4(x) __builtin_shufflevector((x), (x), 0, 1, 2, 3)
#define PG8_HI4(x) __builtin_shufflevector((x), (x), 4, 5, 6, 7)
#define PG8_MMA(ai, bj, At, Bt) do { __builtin_amdgcn_s_setprio(1); \
        _Pragma("unroll") for (int m = 0; m < 4; ++m) _Pragma("unroll") for (int n = 0; n < 2; ++n) acc[ai][bj][m][n] = __builtin_amdgcn_mfma_i32_16x16x64_i8(PG8_LO4(Bt[n]), PG8_LO4(At[m]), acc[ai][bj][m][n], 0, 0, 0); \
        _Pragma("unroll") for (int m = 0; m < 4; ++m) _Pragma("unroll") for (int n = 0; n < 2; ++n) acc[ai][bj][m][n] = __builtin_amdgcn_mfma_i32_16x16x64_i8(PG8_HI4(Bt[n]), PG8_HI4(At[m]), acc[ai][bj][m][n], 0, 0, 0); \
        __builtin_amdgcn_s_setprio(0); } while (0)
#define PG8_WAIT_V(n) asm volatile("s_waitcnt vmcnt(" #n ")" ::: "memory")
#define PG8_WAIT_L(n) asm volatile("s_waitcnt lgkmcnt(" #n ")" ::: "memory")
#define PG8_BAR __builtin_amdgcn_s_barrier()
#define PG8_SCHED __builtin_amdgcn_sched_barrier(0)
    Unit cur, nxt; int ui = 0;
    if (!S.next(0, cur)) return;
    i32x4 acc[2][2][4][2];
#pragma unroll
    for (int a = 0; a < 2; ++a)
#pragma unroll
        for (int b = 0; b < 2; ++b)
#pragma unroll
            for (int m = 0; m < 4; ++m)
#pragma unroll
                for (int n = 0; n < 2; ++n) acc[a][b][m][n] = (i32x4){0, 0, 0, 0};
    i32x8 At[4], B0[2], B1[2];
    const char* cA = (const char*)g.A + (size_t)cur.pm * tstep; const char* cB = (const char*)g.Bt + (size_t)cur.pn * tstep;
    S.a_ready(cur);
    if constexpr (SP2) {
        PG8_STAGE(PG8_SB(0, 0), cB, voffB); PG8_STAGE(PG8_SB(0, 1), cB + hstep, voffB); PG8_STAGE(PG8_SA(0, 0), cA, voffA); PG8_STAGE(PG8_SA(0, 1), cA + hstep, voffA);
        if (wr == 1) PG8_BAR;
        PG8_WAIT_V(2); PG8_BAR;
        PG8_STAGE(PG8_SB(1, 0), cB + kstep, voffB); PG8_STAGE(PG8_SA(1, 0), cA + kstep, voffA); PG8_STAGE(PG8_SB(1, 1), cB + hstep + kstep, voffB);
        PG8_WAIT_V(6); PG8_BAR;
    } else {
        PG8_STAGE(PG8_SB(0, 0), cB, voffB); PG8_STAGE(PG8_SA(0, 0), cA, voffA); PG8_STAGE(PG8_SB(0, 1), cB + hstep, voffB); PG8_STAGE(PG8_SA(0, 1), cA + hstep, voffA);
        if (wr == 1) PG8_BAR;
        PG8_WAIT_V(4); PG8_BAR;
        PG8_STAGE(PG8_SB(1, 0), cB + kstep, voffB); PG8_STAGE(PG8_SA(1, 0), cA + kstep, voffA); PG8_STAGE(PG8_SB(1, 1), cB + hstep + kstep, voffB);
        PG8_WAIT_V(6); PG8_BAR;
    }
    for (;;) {
        const bool has_next = S.next(ui + 1, nxt);
        const char* nA = has_next ? (const char*)g.A + (size_t)nxt.pm * tstep : cA; const char* nB = has_next ? (const char*)g.Bt + (size_t)nxt.pn * tstep : cB;
        for (int t = 0; t < nt; t += 2) {
            const bool last = (t == nt - 2);
            const char* a1 = cA + (size_t)(t + 1) * kstep;
            const char* a2 = last ? nA : cA + (size_t)(t + 2) * kstep; const char* b2 = last ? nB : cB + (size_t)(t + 2) * kstep;
            const char* a3 = a2 + kstep; const char* b3 = b2 + kstep;
            if (last && has_next) S.a_ready(nxt);
            if constexpr (SP2) {
            PG8_LDB(B0, 0, 0); PG8_LDB(B1, 0, 1); PG8_SCHED; PG8_LDA(At, 0, 0); PG8_STAGE(PG8_SA(1, 1), a1 + hstep, voffA);
            PG8_WAIT_V(8); PG8_WAIT_L(0); PG8_BAR; PG8_MMA(0, 0, At, B0); PG8_MMA(0, 1, At, B1); PG8_BAR; PG8_SCHED;
            PG8_LDA(At, 0, 1); PG8_STAGE(PG8_SB(0, 0), b2, voffB); PG8_STAGE(PG8_SB(0, 1), b2 + hstep, voffB); PG8_STAGE(PG8_SA(0, 0), a2, voffA);
            PG8_WAIT_V(8); PG8_WAIT_L(0); PG8_BAR; PG8_MMA(1, 0, At, B0); PG8_MMA(1, 1, At, B1); PG8_BAR; PG8_SCHED;
            PG8_LDB(B0, 1, 0); PG8_LDB(B1, 1, 1); PG8_SCHED; PG8_LDA(At, 1, 0); PG8_STAGE(PG8_SA(0, 1), a2 + hstep, voffA);
            PG8_WAIT_V(8); PG8_WAIT_L(0); PG8_BAR; PG8_MMA(0, 0, At, B0); PG8_MMA(0, 1, At, B1); PG8_BAR; PG8_SCHED;
            PG8_LDA(At, 1, 1); PG8_STAGE(PG8_SB(1, 0), b3, voffB); PG8_STAGE(PG8_SB(1, 1), b3 + hstep, voffB); PG8_STAGE(PG8_SA(1, 0), a3, voffA);
            PG8_WAIT_V(8); PG8_WAIT_L(0); PG8_BAR; PG8_MMA(1, 0, At, B0); PG8_MMA(1, 1, At, B1); PG8_BAR; PG8_SCHED;
            } else {
            PG8_LDB(B0, 0, 0); PG8_SCHED; PG8_LDA(At, 0, 0); PG8_STAGE(PG8_SA(1, 1), a1 + hstep, voffA);
            PG8_WAIT_L(8); PG8_BAR; PG8_WAIT_L(0); PG8_MMA(0, 0, At, B0); PG8_BAR; PG8_SCHED;
            PG8_LDB(B1, 0, 1); PG8_STAGE(PG8_SB(0, 0), b2, voffB);
            PG8_BAR; PG8_WAIT_L(0); PG8_MMA(0, 1, At, B1); PG8_BAR;
            PG8_LDA(At, 0, 1); PG8_STAGE(PG8_SA(0, 0), a2, voffA);
            PG8_BAR; PG8_WAIT_L(0); PG8_MMA(1, 0, At, B0); PG8_BAR; PG8_SCHED;
            PG8_STAGE(PG8_SB(0, 1), b2 + hstep, voffB);
            PG8_WAIT_V(6); PG8_BAR; PG8_MMA(1, 1, At, B1); PG8_BAR;
            PG8_LDB(B0, 1, 0); PG8_SCHED; PG8_LDA(At, 1, 0); PG8_STAGE(PG8_SA(0, 1), a2 + hstep, voffA);
            PG8_WAIT_L(8); PG8_BAR; PG8_WAIT_L(0); PG8_MMA(0, 0, At, B0); PG8_BAR; PG8_SCHED;
            PG8_LDB(B1, 1, 1); PG8_STAGE(PG8_SB(1, 0), b3, voffB);
            PG8_BAR; PG8_WAIT_L(0); PG8_MMA(0, 1, At, B1); PG8_BAR;
            PG8_LDA(At, 1, 1); PG8_STAGE(PG8_SA(1, 0), a3, voffA);
            PG8_BAR; PG8_WAIT_L(0); PG8_MMA(1, 0, At, B0); PG8_BAR; PG8_SCHED;
            PG8_STAGE(PG8_SB(1, 1), b3 + hstep, voffB);
            PG8_WAIT_V(6); PG8_BAR; PG8_MMA(1, 1, At, B1); PG8_BAR;
            }
        }
        if constexpr (ALIGN_EPI) { if (wr == 0) PG8_BAR; }
        if constexpr (!Epi::AFTER_DRAIN) { E(acc, cur, wr, wc, fr, fq); S.done(cur); }
        if (!has_next) break;
#pragma unroll
        for (int a = 0; a < 2; ++a)
#pragma unroll
            for (int b = 0; b < 2; ++b)
#pragma unroll
                for (int m = 0; m < 4; ++m)
#pragma unroll
                    for (int n = 0; n < 2; ++n) acc[a][b][m][n] = (i32x4){0, 0, 0, 0};
        cur = nxt; cA = nA; cB = nB; ++ui;
        if constexpr (ALIGN_EPI) { if (wr == 1) PG8_BAR; }
    }
    PG8_WAIT_V(0);
    if constexpr (!ALIGN_EPI) { if (wr == 0) PG8_BAR; }
    PG8_BAR;
    if constexpr (Epi::AFTER_DRAIN) { E.fused(acc, cur, wr, wc, fr, fq, lds, wid, lane); S.done(cur); }
#undef PG8_SA
#undef PG8_SB
#undef PG8_STAGE
#undef PG8_LDA
#undef PG8_LDB
#undef PG8_MMA
#undef PG8_LD32
#undef PG8_LO4
#undef PG8_HI4
#undef PG8_WAIT_V
#undef PG8_WAIT_L
#undef PG8_BAR
#undef PG8_SCHED
}
}

typedef unsigned short bf16_t;
typedef float f32x4 __attribute__((ext_vector_type(4)));
typedef unsigned u32x4 __attribute__((ext_vector_type(4)));
#define LAS __attribute__((address_space(3)))

constexpr int NT = 512;
constexpr int LDS_BYTES = 160 * 1024;
constexpr int D = 2048, NB = 4, SEQ = 4096, CTXL = 256;
constexpr int MT = NB * SEQ;
constexpr int MC = NB * CTXL;
constexpr int MA = MT + MC;
constexpr int NQKVP = 6400;
constexpr int PQ_LD = 6144;
constexpr int NHY = 6144, NZG = 6144;
constexpr int WT_ROWS = NQKVP + NHY + NZG;
constexpr int WT_HY0 = NQKVP, WT_ZG0 = NQKVP + NHY;
constexpr float ALPHA = 1.189207115002721f;

constexpr size_t MiB = (size_t)1 << 20;
constexpr size_t WS_MOD = 0, WS_HID2 = 1 * MiB, WS_SW = 2 * MiB, WS_HA = 34 * MiB, WS_WT = 102 * MiB, WS_RA = 175 * MiB, WS_RB = 367 * MiB, WS_AB = 580 * MiB, WS_END = 658 * MiB;
constexpr size_t WS_HA8 = 658 * MiB;
constexpr size_t WS_SA = WS_MOD + 512 * 1024, WS_SON = WS_MOD + 600 * 1024, WS_SY = WS_MOD + 680 * 1024, WS_WMAX = WS_MOD + 768 * 1024, WS_SWF = WS_MOD + 896 * 1024;
constexpr int NWROWS = 18688 + 2048;
constexpr size_t WS_WQ8 = WS_HA;
constexpr size_t WS_WSW8 = WS_HA + (size_t)18688 * 2048;
constexpr size_t WS_WP8 = WS_WSW8 + (size_t)2048 * 2048;
constexpr size_t WS_WPMAX = WS_MOD + 256 * 1024;
constexpr size_t WS_XN = WS_RB + 128 * MiB;
constexpr size_t WS_SH2 = WS_SY;
constexpr size_t WT8_OFF = (size_t)6144 * 2048 * 2;

struct Args { const float* in[31]; float* out; unsigned char* ws; int ph_lo, ph_hi; int reps[8]; int pad2[2]; };
typedef const __attribute__((address_space(4))) Args* KA;

__device__ __forceinline__ unsigned f2bf(float f) { unsigned u = __float_as_uint(f); return (u + 0x7fffu + ((u >> 16) & 1u)) >> 16; }
typedef float f32x2 __attribute__((ext_vector_type(2)));
typedef __bf16 bf2_t __attribute__((ext_vector_type(2)));
__device__ __forceinline__ unsigned pk2(float lo, float hi) { const f32x2 v = {lo, hi}; return __builtin_bit_cast(unsigned, __builtin_convertvector(v, bf2_t)); }
__device__ __forceinline__ float bflo(unsigned w) { return __uint_as_float(w << 16); }
__device__ __forceinline__ float bfhi(unsigned w) { return __uint_as_float(w & 0xffff0000u); }
__device__ __forceinline__ float bf2f(bf16_t b) { return __uint_as_float(((unsigned)b) << 16); }
__device__ __forceinline__ void unpack8(const u32x4 w, float (&o)[8]) { o[0] = bflo(w.x); o[1] = bfhi(w.x); o[2] = bflo(w.y); o[3] = bfhi(w.y); o[4] = bflo(w.z); o[5] = bfhi(w.z); o[6] = bflo(w.w); o[7] = bfhi(w.w); }
__device__ __forceinline__ u32x4 pack8(const float (&v)[8]) { u32x4 w; w.x = pk2(v[0], v[1]); w.y = pk2(v[2], v[3]); w.z = pk2(v[4], v[5]); w.w = pk2(v[6], v[7]); return w; }
typedef short bf16x8 __attribute__((ext_vector_type(8)));
typedef unsigned u32x2 __attribute__((ext_vector_type(2)));
#define MFMA16(a, b, c) __builtin_amdgcn_mfma_f32_16x16x32_bf16((a), (b), (c), 0, 0, 0)
__device__ __forceinline__ u32x2 pk4(float a, float b, float c, float d) { u32x2 w; w.x = pk2(a, b); w.y = pk2(c, d); return w; }
__device__ __forceinline__ float fexpf_(float x) { return __builtin_amdgcn_exp2f(x * 1.4426950408889634f); }
__device__ __forceinline__ float sigmoidf_(float x) { return __builtin_amdgcn_rcpf(1.0f + fexpf_(-x)); }
__device__ __forceinline__ float siluf_(float x) { return x * __builtin_amdgcn_rcpf(1.0f + fexpf_(-x)); }
__device__ __forceinline__ float rdlane(float v, const int l) { return __builtin_bit_cast(float, __builtin_amdgcn_readlane(__builtin_bit_cast(int, v), l)); }
__device__ __forceinline__ float wave_sum(float v) {
    v += __builtin_bit_cast(float, __builtin_amdgcn_update_dpp(0, __builtin_bit_cast(int, v), 0x128, 0xf, 0xf, false));
    v += __builtin_bit_cast(float, __builtin_amdgcn_update_dpp(0, __builtin_bit_cast(int, v), 0x124, 0xf, 0xf, false));
    v += __builtin_bit_cast(float, __builtin_amdgcn_update_dpp(0, __builtin_bit_cast(int, v), 0x122, 0xf, 0xf, false));
    v += __builtin_bit_cast(float, __builtin_amdgcn_update_dpp(0, __builtin_bit_cast(int, v), 0x121, 0xf, 0xf, false));
    return (rdlane(v, 0) + rdlane(v, 16)) + (rdlane(v, 32) + rdlane(v, 48));
}
__device__ __forceinline__ float wave_max(float v) {
    v = fmaxf(v, __builtin_bit_cast(float, __builtin_amdgcn_update_dpp(0, __builtin_bit_cast(int, v), 0x128, 0xf, 0xf, false)));
    v = fmaxf(v, __builtin_bit_cast(float, __builtin_amdgcn_update_dpp(0, __builtin_bit_cast(int, v), 0x124, 0xf, 0xf, false)));
    v = fmaxf(v, __builtin_bit_cast(float, __builtin_amdgcn_update_dpp(0, __builtin_bit_cast(int, v), 0x122, 0xf, 0xf, false)));
    v = fmaxf(v, __builtin_bit_cast(float, __builtin_amdgcn_update_dpp(0, __builtin_bit_cast(int, v), 0x121, 0xf, 0xf, false)));
    return fmaxf(fmaxf(rdlane(v, 0), rdlane(v, 16)), fmaxf(rdlane(v, 32), rdlane(v, 48)));
}

__device__ __attribute__((always_inline)) void p0_mod_hid2(KA a, float* lf) {
    const int tid = tid_opaque(), bid = blockIdx.x;
    if (bid < 192) {
        const float* c = a->in[1]; const float* cc = a->in[3]; const float* w_ada = a->in[4]; const float* b_ada = a->in[5];
        float* mod = (float*)(a->ws + WS_MOD);
        for (int i = tid; i < 5 * 2048; i += NT) { const int r = i >> 11, k = i & 2047; const float v = (r < 4) ? c[r * 2048 + k] : cc[k]; lf[i] = siluf_(v); }
        __syncthreads();
        const int cl = tid & 63, kg = tid >> 6, col = bid * 64 + cl;
        float a0 = 0.f, a1 = 0.f, a2 = 0.f, a3 = 0.f, a4 = 0.f;
#pragma unroll 32
        for (int k = kg * 256; k < kg * 256 + 256; ++k) {
            const float w = __builtin_nontemporal_load(w_ada + (size_t)k * 12288 + col);
            a0 += lf[k] * w; a1 += lf[2048 + k] * w; a2 += lf[4096 + k] * w; a3 += lf[6144 + k] * w; a4 += lf[8192 + k] * w;
        }
        float* red = lf + 5 * 2048;
        red[(kg * 5 + 0) * 64 + cl] = a0; red[(kg * 5 + 1) * 64 + cl] = a1; red[(kg * 5 + 2) * 64 + cl] = a2; red[(kg * 5 + 3) * 64 + cl] = a3; red[(kg * 5 + 4) * 64 + cl] = a4;
        __syncthreads();
        if (tid < 320) { const int r = tid >> 6; float s = 0.f;
#pragma unroll
            for (int g = 0; g < 8; ++g) s += red[(g * 5 + r) * 64 + cl];
            mod[r * 12288 + col] = s + b_ada[col]; }
        __syncthreads();
    } else {
        const float* w1 = a->in[12]; const float* b1 = a->in[13]; const float* w2 = a->in[14]; const float* b2 = a->in[15]; const float* freq = a->in[18];
        float* hid2 = (float*)(a->ws + WS_HID2);
        const int pb = (bid - 192) * 64, j = tid & 63, pl = tid >> 6;
        const float fj = freq[j];
        for (int it = 0; it < 8; ++it) {
            const int pos = pb + it * 8 + pl;
            const float tt = (float)pos * (1.0f / 4095.0f);
            float s1 = tt * w1[j];
            for (int e = 0; e < 16; ++e) {
                const float band = 1e-4f + (float)e * ((15.0f - 1e-4f) / 15.0f);
                const float rev = __builtin_amdgcn_fractf((float)pos * band * (1.0f / 4096.0f));
                s1 += __builtin_amdgcn_cosf(rev) * w1[(1 + e) * 64 + j] - __builtin_amdgcn_sinf(rev) * w1[(17 + e) * 64 + j];
            }
            lf[pl * 64 + j] = __builtin_amdgcn_sinf(__builtin_amdgcn_fractf(fj * (s1 + b1[j]) * 0.15915494309189535f));
            __syncthreads();
            float s2 = 0.f;
            for (int i = 0; i < 64; ++i) s2 += lf[pl * 64 + i] * w2[i * 64 + j];
            hid2[pos * 64 + j] = __builtin_amdgcn_sinf(__builtin_amdgcn_fractf(fj * (s2 + b2[j]) * 0.15915494309189535f));
            __syncthreads();
        }
    }
}

__device__ __attribute__((always_inline)) void transpose_unit(const float* src, int ldn, int n0src, bf16_t* dst, int nb, int kb, float* tile) {
    const int tid = tid_opaque(), r = tid >> 4, c4 = tid & 15;
#pragma unroll
    for (int i = 0; i < 4; ++i) {
        const int kk = i * 32 + r;
        f32x4 v = (f32x4){0.f, 0.f, 0.f, 0.f};
        if (n0src >= 0) v = *(const f32x4*)(src + (size_t)(kb * 128 + kk) * ldn + n0src + c4 * 4);
        float* t = tile + kk * 65 + c4 * 4; t[0] = v.x; t[1] = v.y; t[2] = v.z; t[3] = v.w;
    }
    __syncthreads();
#pragma unroll
    for (int i = 0; i < 2; ++i) {
        const int chunk = tid + i * NT, nr = chunk >> 4, kc = chunk & 15;
        const float* t = tile + (kc * 8) * 65 + nr;
        u32x4 w; w.x = pk2(t[0], t[65]); w.y = pk2(t[130], t[195]); w.z = pk2(t[260], t[325]); w.w = pk2(t[390], t[455]);
        *(u32x4*)(dst + (size_t)(nb * 64 + nr) * 2048 + kb * 128 + kc * 8) = w;
    }
    __syncthreads();
}
__device__ __forceinline__ float clamp_e4m3(float x) { return __builtin_amdgcn_fmed3f(x, -448.0f, 448.0f); }
__device__ __forceinline__ unsigned pk4_fp8(float a, float b, float c, float d) { int w = __builtin_amdgcn_cvt_pk_fp8_f32(clamp_e4m3(a), clamp_e4m3(b), 0, false); w = __builtin_amdgcn_cvt_pk_fp8_f32(clamp_e4m3(c), clamp_e4m3(d), w, true); return (unsigned)w; }
__device__ __attribute__((always_inline)) void transpose_unit8(const float* src, int ldn, int n0src, unsigned char* dst, int nb, int kb, float* tile) {
    const int tid = tid_opaque(), r = tid >> 4, c4 = tid & 15;
#pragma unroll
    for (int i = 0; i < 4; ++i) {
        const int kk = i * 32 + r;
        f32x4 v = (f32x4){0.f, 0.f, 0.f, 0.f};
        if (n0src >= 0) v = *(const f32x4*)(src + (size_t)(kb * 128 + kk) * ldn + n0src + c4 * 4);
        float* t = tile + kk * 65 + c4 * 4; t[0] = v.x * 64.0f; t[1] = v.y * 64.0f; t[2] = v.z * 64.0f; t[3] = v.w * 64.0f;
    }
    __syncthreads();
    {
        const int nr = tid >> 3, kc = tid & 7;
        const float* t = tile + (kc * 16) * 65 + nr;
        u32x4 w;
        w.x = pk4_fp8(t[0], t[65], t[130], t[195]); w.y = pk4_fp8(t[260], t[325], t[390], t[455]);
        w.z = pk4_fp8(t[520], t[585], t[650], t[715]); w.w = pk4_fp8(t[780], t[845], t[910], t[975]);
        *(u32x4*)(dst + (size_t)(nb * 64 + nr) * 2048 + kb * 128 + kc * 16) = w;
    }
    __syncthreads();
}
__device__ __forceinline__ int win_colmap(int np) {
    if (np < 6144) return np;
    if (np < 6208) return 8192 + (np - 6144);
    if (np < 6400) return -1;
    if (np < 12544) return 8256 + (np - 6400);
    if (np < 14592) return 6144 + (np - 12544);
    return 14400 + (np - 14592);
}
struct TrUnit { const float* src; int ldn, n0src, nb, kb, fp8; unsigned char* dst; };
__device__ __forceinline__ TrUnit tr_unit_of(KA a, int u) {
    bf16_t* WT = (bf16_t*)(a->ws + WS_WT); bf16_t* SW = (bf16_t*)(a->ws + WS_SW);
    const int NU_WT = (WT_ROWS / 64) * 16;
    TrUnit t;
    if (u < NU_WT) { const int nb = u >> 4; t.kb = u & 15; t.src = a->in[6]; t.ldn = 18496; t.n0src = win_colmap(nb * 64);
        t.fp8 = nb * 64;   t.dst = (unsigned char*)WT; t.nb = nb; }
    else { const int v = u - NU_WT, mtx = v >> 9; t.nb = (v >> 4) & 31; t.kb = v & 15; t.fp8 = 18688 + mtx * 2048 + t.nb * 64; t.ldn = 2048; t.n0src = t.nb * 64;
        t.src = (mtx == 0) ? a->in[20] : (mtx == 1) ? a->in[21] : (mtx == 2) ? a->in[22] : a->in[25]; t.dst = (unsigned char*)(SW + (size_t)mtx * 2048 * 2048); }
    return t;
}
__device__ __forceinline__ float row_max16(float v);
__device__ __forceinline__ float row_sum16(float v);
__device__ __attribute__((always_inline)) void p0_transposes(KA a, float* lf) {
    const int NU = (WT_ROWS / 64) * 16 + 3 * 32 * 16;
    const int tid = tid_opaque(), r = tid >> 4, c4 = tid & 15;
    float* wmaxp = (float*)(a->ws + WS_RB);
    int u = blockIdx.x;
    f32x4 pre[4];
    if (u < NU) { const TrUnit t = tr_unit_of(a, u);
#pragma unroll
        for (int i = 0; i < 4; ++i) pre[i] = (t.n0src >= 0) ? __builtin_nontemporal_load((const f32x4*)(t.src + (size_t)(t.kb * 128 + i * 32 + r) * t.ldn + t.n0src + c4 * 4)) : (f32x4){0.f, 0.f, 0.f, 0.f}; }
    __syncthreads();
#pragma unroll 1
    for (int k = 0; u < NU; ++k, u += gridDim.x) {
        const TrUnit t = tr_unit_of(a, u);
        float* tile = lf + (k & 1) * (128 * 65);
#pragma unroll
        for (int i = 0; i < 4; ++i) { float* tp = tile + (i * 32 + r) * 65 + c4 * 4; tp[0] = pre[i].x; tp[1] = pre[i].y; tp[2] = pre[i].z; tp[3] = pre[i].w; }
        __syncthreads();
        const int un = u + gridDim.x;
        if (un < NU) { const TrUnit tn = tr_unit_of(a, un);
#pragma unroll
            for (int i = 0; i < 4; ++i) pre[i] = (tn.n0src >= 0) ? __builtin_nontemporal_load((const f32x4*)(tn.src + (size_t)(tn.kb * 128 + i * 32 + r) * tn.ldn + tn.n0src + c4 * 4)) : (f32x4){0.f, 0.f, 0.f, 0.f}; }
#pragma unroll
        for (int i = 0; i < 2; ++i) {
            const int chunk = tid + i * NT, nr = chunk >> 4, kc = chunk & 15;
            const float* tp = tile + (kc * 8) * 65 + nr;
            u32x4 w; w.x = pk2(tp[0], tp[65]); w.y = pk2(tp[130], tp[195]); w.z = pk2(tp[260], tp[325]); w.w = pk2(tp[390], tp[455]);
            *(u32x4*)((bf16_t*)t.dst + (size_t)(t.nb * 64 + nr) * 2048 + t.kb * 128 + kc * 8) = w;
            float m = fmaxf(fmaxf(fmaxf(fabsf(tp[0]), fabsf(tp[65])), fmaxf(fabsf(tp[130]), fabsf(tp[195]))), fmaxf(fmaxf(fabsf(tp[260]), fabsf(tp[325])), fmaxf(fabsf(tp[390]), fabsf(tp[455]))));
            m = row_max16(m);
            if (kc == 0) wmaxp[(size_t)(t.fp8 + nr) * 16 + t.kb] = m;
        }
    }
    __syncthreads();
}

__device__ __forceinline__ unsigned pk4_i8(float a, float b, float c, float d) {
    const int ia = __float2int_rn(a), ib = __float2int_rn(b), ic = __float2int_rn(c), id = __float2int_rn(d);
    return (unsigned)(ia & 255) | ((unsigned)(ib & 255) << 8) | ((unsigned)(ic & 255) << 16) | ((unsigned)id << 24);
}
__device__ __attribute__((always_inline)) void p1_ha(KA a) {
    const float* mod = (const float*)(a->ws + WS_MOD); unsigned char* HA8 = a->ws + WS_HA8; float* SA = (float*)(a->ws + WS_SA);
    const int lane = tid_opaque() & 63, wv = blockIdx.x * 8 + (tid_opaque() >> 6), nwv = gridDim.x * 8;
    float* PM = (float*)g_lds;
    __syncthreads();
    for (int i = tid_opaque(); i < 5 * 1024; i += NT) { const int r = i >> 10, c4 = (i & 1023) * 4; *(f32x4*)(PM + r * 4096 + c4) = *(const f32x4*)(mod + r * 12288 + c4); }
    __syncthreads();
    f32x4 nx[8];
    if (wv < MA) { const float* sp = (wv < MT) ? a->in[0] + (size_t)wv * 2048 : a->in[2] + (size_t)(wv - MT) * 2048;
#pragma unroll
        for (int j = 0; j < 8; ++j) nx[j] = __builtin_nontemporal_load((const f32x4*)(sp + j * 256 + lane * 4)); }
#pragma unroll 1
    for (int row = wv; row < MA; row += nwv) {
        f32x4 x[8];
#pragma unroll
        for (int j = 0; j < 8; ++j) x[j] = nx[j];
        const int rn = row + nwv;
        if (rn < MA) { const float* sp = (rn < MT) ? a->in[0] + (size_t)rn * 2048 : a->in[2] + (size_t)(rn - MT) * 2048;
#pragma unroll
            for (int j = 0; j < 8; ++j) nx[j] = __builtin_nontemporal_load((const f32x4*)(sp + j * 256 + lane * 4)); }
        const float* mp = PM + ((row < MT) ? (row >> 12) : 4) * 4096;
        float m = 0.f;
#pragma unroll
        for (int j = 0; j < 8; ++j) { const f32x4 hh = *(const f32x4*)(mp + j * 256 + lane * 4), ss = *(const f32x4*)(mp + 2048 + j * 256 + lane * 4);
#pragma unroll
            for (int e = 0; e < 4; ++e) { x[j][e] = x[j][e] * (1.0f + ss[e]) + hh[e]; m = fmaxf(m, fabsf(x[j][e])); } }
        m = wave_max(m);
        const float sc = (m > 0.f) ? m * (1.0f / 127.0f) : 1.0f, inv = 1.0f / sc;
#pragma unroll
        for (int j = 0; j < 8; ++j) *(unsigned*)(HA8 + (size_t)row * 2048 + j * 256 + lane * 4) = pk4_i8(x[j][0] * inv, x[j][1] * inv, x[j][2] * inv, x[j][3] * inv);
        if (lane == 0) SA[row] = sc;
    }
}
__device__ __attribute__((always_inline)) void p1_wquant(KA a) {
    const float* wmaxp = (const float*)(a->ws + WS_RB); float* swf = (float*)(a->ws + WS_SWF);
    const bf16_t* WT = (const bf16_t*)(a->ws + WS_WT); const bf16_t* SW = (const bf16_t*)(a->ws + WS_SW); unsigned char* WQ = a->ws + WS_WQ8;
    const int lane = tid_opaque() & 63, wv = blockIdx.x * 8 + (tid_opaque() >> 6), nwv = gridDim.x * 8;
#pragma unroll 1
    for (int r0 = wv; r0 < NWROWS; r0 += 2 * nwv) {
        u32x4 w[2][4]; float mx[2]; bool ok[2];
#pragma unroll
        for (int q = 0; q < 2; ++q) { const int r = r0 + q * nwv; ok[q] = r < NWROWS; const int rc = ok[q] ? r : r0;
            const bf16_t* sp = (rc < 18688) ? WT + (size_t)rc * 2048 : SW + (size_t)(rc - 18688) * 2048;
#pragma unroll
            for (int j = 0; j < 4; ++j) w[q][j] = *(const u32x4*)(sp + j * 512 + lane * 8);
            const f32x4 p0 = *(const f32x4*)(wmaxp + (size_t)rc * 16), p1 = *(const f32x4*)(wmaxp + (size_t)rc * 16 + 4), p2 = *(const f32x4*)(wmaxp + (size_t)rc * 16 + 8), p3 = *(const f32x4*)(wmaxp + (size_t)rc * 16 + 12);
            mx[q] = fmaxf(fmaxf(fmaxf(fmaxf(p0[0], p0[1]), fmaxf(p0[2], p0[3])), fmaxf(fmaxf(p1[0], p1[1]), fmaxf(p1[2], p1[3]))), fmaxf(fmaxf(fmaxf(p2[0], p2[1]), fmaxf(p2[2], p2[3])), fmaxf(fmaxf(p3[0], p3[1]), fmaxf(p3[2], p3[3])))); }
#pragma unroll
        for (int q = 0; q < 2; ++q) {
            if (!ok[q]) continue;
            const int r = r0 + q * nwv;
            const float sc = (mx[q] > 0.f) ? mx[q] * (1.0f / 127.0f) : 1.0f, inv = 1.0f / sc;
#pragma unroll
            for (int j = 0; j < 4; ++j) { float v[8]; unpack8(w[q][j], v);
                u32x2 o; o.x = pk4_i8(v[0] * inv, v[1] * inv, v[2] * inv, v[3] * inv); o.y = pk4_i8(v[4] * inv, v[5] * inv, v[6] * inv, v[7] * inv);
                *(u32x2*)(WQ + (size_t)r * 2048 + j * 512 + lane * 8) = o; }
            if (lane == 0) swf[r] = sc;
        }
    }
}

struct FStoreBf16 { bf16_t* O; int ldc; float sc;
    __device__ __forceinline__ void operator()(int row, int col, const f32x4 a0, const f32x4 a1) const {
        const f32x4 v0 = a0 * sc, v1 = a1 * sc;
        u32x4 w; w.x = pg8::cvt_pk_bf16(v0[0], v0[1]); w.y = pg8::cvt_pk_bf16(v0[2], v0[3]); w.z = pg8::cvt_pk_bf16(v1[0], v1[1]); w.w = pg8::cvt_pk_bf16(v1[2], v1[3]);
        *(u32x4*)(O + (size_t)row * ldc + col) = w; } };
struct FStoreQKV { bf16_t* PQ; float* AB;
    __device__ __forceinline__ void operator()(int row, int col, const f32x4 v0, const f32x4 v1) const {
        if (col < 6144) { u32x4 w; w.x = pg8::cvt_pk_bf16(v0[0], v0[1]); w.y = pg8::cvt_pk_bf16(v0[2], v0[3]); w.z = pg8::cvt_pk_bf16(v1[0], v1[1]); w.w = pg8::cvt_pk_bf16(v1[2], v1[3]);
            *(u32x4*)(PQ + (size_t)row * PQ_LD + col) = w; }
        else if (col < 6208) { float* p = AB + (size_t)row * 64 + (col - 6144); *(f32x4*)p = v0; *(f32x4*)(p + 4) = v1; } } };
struct FStoreF32 { float* O; int ldc;
    __device__ __forceinline__ void operator()(int row, int col, const f32x4 v0, const f32x4 v1) const { float* p = O + (size_t)row * ldc + col; *(f32x4*)p = v0; *(f32x4*)(p + 4) = v1; } };
struct FGatePA { const bf16_t* ZG; bf16_t* MG;
    __device__ __forceinline__ void operator()(int row, int col, const f32x4 v0, const f32x4 v1) const {
        float g[8]; unpack8(*(const u32x4*)(ZG + (size_t)row * NZG + 2048 + col), g);
        float o[8];
#pragma unroll
        for (int e = 0; e < 4; ++e) { o[e] = sigmoidf_(g[e]) * v0[e]; o[4 + e] = sigmoidf_(g[4 + e]) * v1[e]; }
        *(u32x4*)(MG + (size_t)row * 2048 + col) = pack8(o); } };
struct FGatePH { const bf16_t* ZG; bf16_t* MG;
    __device__ __forceinline__ void operator()(int row, int col, const f32x4 v0, const f32x4 v1) const {
        float g[8], t[8]; unpack8(*(const u32x4*)(ZG + (size_t)row * NZG + 4096 + col), g); unpack8(*(const u32x4*)(MG + (size_t)row * 2048 + col), t);
        float o[8];
#pragma unroll
        for (int e = 0; e < 4; ++e) { o[e] = t[e] + sigmoidf_(g[e]) * v0[e]; o[4 + e] = t[4 + e] + sigmoidf_(g[4 + e]) * v1[e]; }
        *(u32x4*)(MG + (size_t)row * 2048 + col) = pack8(o); } };
struct FOut { const float* x; const float* mod; bf16_t* T3;
    __device__ __forceinline__ void operator()(int row, int col, const f32x4 v0, const f32x4 v1) const {
        const float* xp = x + (size_t)row * 2048 + col; const float* gp = mod + (row >> 12) * 12288 + 4096 + col;
        const f32x4 x0 = *(const f32x4*)xp, x1 = *(const f32x4*)(xp + 4), g0 = *(const f32x4*)gp, g1 = *(const f32x4*)(gp + 4);
        const f32x4 t0 = ALPHA * x0 + g0 * v0, t1 = ALPHA * x1 + g1 * v1;
        u32x4 w; w.x = pk2(t0[0], t0[1]); w.y = pk2(t0[2], t0[3]); w.z = pk2(t1[0], t1[1]); w.w = pk2(t1[2], t1[3]);
        *(u32x4*)(T3 + (size_t)row * 2048 + col) = w;
    } };

template <class F> __device__ __forceinline__ void run_gemm8(unsigned char* lds, const unsigned char* A8, const unsigned char* Bt8, int M, int N, const float* srow, const float* scol, const F& f) {
    pg8::Gemm g{(const bf16_t*)A8, (const bf16_t*)Bt8, M, N, 1024}; pg8::StaticOrder S; S.init(M, N, (int)gridDim.x, (int)blockIdx.x);
    pg8::EpiGenI<F> E{f, srow, scol};
    pg8::gemm_phase8<pg8::EpiGenI<F>, pg8::StaticOrder, true, true>((PG8_LAS unsigned char*)lds, g, S, E);
}
template <class F> __device__ __forceinline__ void run_gemm(unsigned char* lds, const bf16_t* A, const bf16_t* Bt, int M, int N, const F& f) {
    pg8::Gemm g{A, Bt, M, N, 2048}; pg8::StaticOrder S; S.init(M, N, (int)gridDim.x, (int)blockIdx.x);
    pg8::EpiGen<F> E{f};
    pg8::gemm_phase<pg8::EpiGen<F>, pg8::StaticOrder, true, true>((PG8_LAS unsigned char*)lds, g, S, E);
}

constexpr int HY_Z = 0, HY_F = 69632, HY_TW4 = 139264, HY_TW8 = 141312, HY_TW32 = 143360, HY_W3 = 143488;
__device__ __forceinline__ f32x2 cmul(const f32x2 a, const f32x2 b) { return (f32x2){a.x * b.x - a.y * b.y, a.x * b.y + a.y * b.x}; }
__device__ __forceinline__ f32x2 cmulc(const f32x2 a, const f32x2 b) { return (f32x2){a.x * b.x + a.y * b.y, a.y * b.x - a.x * b.y}; }
template <bool INV> __device__ __forceinline__ f32x2 ctw(const f32x2 v, const float wr, const float wi) {
    return INV ? (f32x2){v.x * wr + v.y * wi, v.y * wr - v.x * wi} : (f32x2){v.x * wr - v.y * wi, v.y * wr + v.x * wi};
}
template <bool INV> __device__ __forceinline__ void dft16(f32x2 (&x)[16]) {
    constexpr float C = 0.9238795325112867f, S = 0.3826834323650898f, R = 0.7071067811865476f;
    f32x2 A[4][4];
#pragma unroll
    for (int q0 = 0; q0 < 4; ++q0) {
        const f32x2 a = x[q0], b = x[4 + q0], c = x[8 + q0], d = x[12 + q0];
        const f32x2 t0 = a + c, t1 = a - c, t2 = b + d, t3 = b - d;
        const f32x2 m = (f32x2){t3.y, -t3.x};
        A[q0][0] = t0 + t2; A[q0][2] = t0 - t2;
        A[q0][1] = INV ? (t1 - m) : (t1 + m); A[q0][3] = INV ? (t1 + m) : (t1 - m);
    }
    A[1][1] = ctw<INV>(A[1][1], C, -S); A[1][2] = ctw<INV>(A[1][2], R, -R); A[1][3] = ctw<INV>(A[1][3], S, -C);
    A[2][1] = ctw<INV>(A[2][1], R, -R); A[2][2] = ctw<INV>(A[2][2], 0.f, -1.f); A[2][3] = ctw<INV>(A[2][3], -R, -R);
    A[3][1] = ctw<INV>(A[3][1], S, -C); A[3][2] = ctw<INV>(A[3][2], -R, -R); A[3][3] = ctw<INV>(A[3][3], -C, S);
#pragma unroll
    for (int s = 0; s < 4; ++s) {
        const f32x2 t0 = A[0][s] + A[2][s], t1 = A[0][s] - A[2][s], t2 = A[1][s] + A[3][s], t3 = A[1][s] - A[3][s];
        const f32x2 m = (f32x2){t3.y, -t3.x};
        x[s] = t0 + t2; x[s + 8] = t0 - t2;
        x[s + 4] = INV ? (t1 - m) : (t1 + m); x[s + 12] = INV ? (t1 + m) : (t1 - m);
    }
}
template <bool INV> __device__ __forceinline__ void apply_tw(f32x2 (&x)[16], const f32x2 w) {
    f32x2 wr = w;
#pragma unroll
    for (int r = 1; r < 16; ++r) { x[r] = INV ? cmulc(x[r], wr) : cmul(x[r], wr); if (r < 15) wr = cmul(wr, w); }
}
__device__ __forceinline__ void fft_pass2_fwd(f32x2* B, int t, const f32x2* TW4) {
    const int base = 272 * (t >> 4) + (t & 15); f32x2 x[16];
#pragma unroll
    for (int q = 0; q < 16; ++q) x[q] = B[base + 17 * q];
    dft16<false>(x); apply_tw<false>(x, TW4[16 * (t & 15)]);
#pragma unroll
    for (int q = 0; q < 16; ++q) B[base + 17 * q] = x[q];
}
__device__ __forceinline__ void fft_pass2_inv(f32x2* B, int t, const f32x2* TW4) {
    const int base = 272 * (t >> 4) + (t & 15); f32x2 x[16];
#pragma unroll
    for (int q = 0; q < 16; ++q) x[q] = B[base + 17 * q];
    apply_tw<true>(x, TW4[16 * (t & 15)]); dft16<true>(x);
#pragma unroll
    for (int q = 0; q < 16; ++q) B[base + 17 * q] = x[q];
}
__device__ __forceinline__ float conv3_lane(float c, int lane, float w0, float w1, float w2) {
    (void)lane;
    const float up = __builtin_bit_cast(float, __builtin_amdgcn_update_dpp(0, __builtin_bit_cast(int, c), 0x138, 0xf, 0xf, true));
    const float dn = __builtin_bit_cast(float, __builtin_amdgcn_update_dpp(0, __builtin_bit_cast(int, c), 0x130, 0xf, 0xf, true));
    return w0 * up + w1 * c + w2 * dn;
}
constexpr size_t WS_FILT = 585 * MiB;
__device__ __attribute__((always_inline)) void filt_unit(KA a, int unit, unsigned char* lds) {
    const int tid = tid_opaque(), lane = tid & 63, w = tid >> 6, fr = lane & 15, fq = lane >> 4;
    const int c0 = (unit >> 3) * 64, pc = (unit & 7) * 512;
    bf16_t* Bt = (bf16_t*)lds;
    const float* w3 = a->in[16]; const float* b3 = a->in[17]; const float* hid2 = (const float*)(a->ws + WS_HID2);
    bf16_t* FILT = (bf16_t*)(a->ws + WS_FILT);
    __syncthreads();
#pragma unroll
    for (int i = 0; i < 8; ++i) {
        const int idx = tid + i * NT, k = idx >> 6, q = (idx >> 4) & 3, c4 = idx & 15;
        const f32x4 v = *(const f32x4*)(w3 + (size_t)k * 8192 + (q >> 1) * 4096 + (q & 1) * 2048 + c0 + c4 * 4);
        bf16_t* bp = Bt + (q * 64 + c4 * 4) * 72 + k;
        bp[0] = (bf16_t)f2bf(v.x); bp[72] = (bf16_t)f2bf(v.y); bp[144] = (bf16_t)f2bf(v.z); bp[216] = (bf16_t)f2bf(v.w);
    }
    __syncthreads();
#pragma unroll 1
    for (int it = 0; it < 4; ++it) {
        const int p0 = pc + (it * 8 + w) * 16;
        bf16x8 af[2];
#pragma unroll
        for (int kk = 0; kk < 2; ++kk) { const float* hp = hid2 + (size_t)(p0 + fr) * 64 + kk * 32 + fq * 8; const f32x4 x0 = *(const f32x4*)hp, x1 = *(const f32x4*)(hp + 4);
            u32x4 wv; wv.x = pk2(x0[0], x0[1]); wv.y = pk2(x0[2], x0[3]); wv.z = pk2(x1[0], x1[1]); wv.w = pk2(x1[2], x1[3]); af[kk] = __builtin_bit_cast(bf16x8, wv); }
#pragma unroll 4
        for (int n = 0; n < 16; ++n) {
            f32x4 acc = (f32x4){0.f, 0.f, 0.f, 0.f};
#pragma unroll
            for (int kk = 0; kk < 2; ++kk) acc = MFMA16(af[kk], *(const bf16x8*)(Bt + (n * 16 + fr) * 72 + kk * 32 + fq * 8), acc);
            const int q = n >> 2, c = c0 + (n & 3) * 16 + fr;
            const float bias = b3[(q >> 1) * 4096 + (q & 1) * 2048 + c];
            const float dl = (3.0701134573253944f + 12.280453829301578f * ((float)c * (1.0f / 2047.0f))) * (1.0f / 4095.0f);
            const int pos = p0 + 4 * fq;
            const float e0 = fexpf_(-(float)pos * dl), e1 = fexpf_(-(float)(pos + 1) * dl), e2 = fexpf_(-(float)(pos + 2) * dl), e3 = fexpf_(-(float)(pos + 3) * dl);
            *(u32x2*)(FILT + ((size_t)c * 4 + q) * 4096 + pos) = pk4((acc[0] + bias) * e0, (acc[1] + bias) * e1, (acc[2] + bias) * e2, (acc[3] + bias) * e3);
        }
    }
}
__device__ __attribute__((always_inline)) void wprime_unit(KA a, int unit, unsigned char* lds) {
    const int tid = tid_opaque(), lane = tid & 63, w = tid >> 6, fr = lane & 15, fq = lane >> 4;
    const int hp = unit >> 4, kb = unit & 15;
    bf16_t* Aw = (bf16_t*)lds; bf16_t* Bs = (bf16_t*)(lds + 34816);
    float* pm = (float*)(lds + 69632);
    const float* wq = a->in[25]; const float* subk = a->in[26];
    bf16_t* WPT = (bf16_t*)(a->ws + WS_SW) + (size_t)3 * D * D;
    __syncthreads();
#pragma unroll
    for (int i = 0; i < 8; ++i) {
        const int idx = tid + i * NT, r = idx >> 5, c4 = (idx & 31) * 4;
        const f32x4 va = *(const f32x4*)(wq + (size_t)(kb * 128 + r) * 2048 + hp * 128 + c4);
        const f32x4 vb = *(const f32x4*)(subk + (size_t)(hp * 128 + r) * 128 + c4);
        *(u32x2*)(Aw + r * 136 + c4) = pk4(va[0], va[1], va[2], va[3]); *(u32x2*)(Bs + r * 136 + c4) = pk4(vb[0], vb[1], vb[2], vb[3]);
    }
    __syncthreads();
    bf16x8 af[4];
#pragma unroll
    for (int kk = 0; kk < 4; ++kk) af[kk] = *(const bf16x8*)(Aw + (w * 16 + fr) * 136 + kk * 32 + fq * 8);
#pragma unroll
    for (int nt = 0; nt < 8; ++nt) {
        f32x4 acc = (f32x4){0.f, 0.f, 0.f, 0.f};
#pragma unroll
        for (int kk = 0; kk < 4; ++kk) acc = MFMA16(af[kk], *(const bf16x8*)(Bs + (nt * 16 + fr) * 136 + kk * 32 + fq * 8), acc);
        *(u32x2*)(WPT + (size_t)(hp * 128 + nt * 16 + fr) * 2048 + kb * 128 + w * 16 + 4 * fq) = pk4(acc[0], acc[1], acc[2], acc[3]);
        float m = fmaxf(fmaxf(fabsf(acc[0]), fabsf(acc[1])), fmaxf(fabsf(acc[2]), fabsf(acc[3])));
        m = fmaxf(m, __shfl_xor(m, 16, 64)); m = fmaxf(m, __shfl_xor(m, 32, 64));
        if (fq == 0) pm[w * 128 + nt * 16 + fr] = m;
    }
    __syncthreads();
    if (tid < 128) { float m = pm[tid];
#pragma unroll
        for (int ww = 1; ww < 8; ++ww) m = fmaxf(m, pm[ww * 128 + tid]);
        ((float*)(a->ws + WS_WPMAX))[(size_t)(hp * 128 + tid) * 16 + kb] = m; }
}
__device__ __attribute__((always_inline)) void hyena_setup(unsigned char* lds) {
    const int tid = tid_opaque();
    f32x2* TW4 = (f32x2*)(lds + HY_TW4); f32x2* TW8 = (f32x2*)(lds + HY_TW8); f32x2* TW32 = (f32x2*)(lds + HY_TW32);
    if (tid < 256) { const float a4 = -6.283185307179586f * (float)tid * (1.0f / 4096.0f), a8 = -6.283185307179586f * (float)tid * (1.0f / 8192.0f);
        TW4[tid] = (f32x2){cosf(a4), sinf(a4)}; TW8[tid] = (f32x2){cosf(a8), sinf(a8)}; }
    if (tid < 16) { const float a = -6.283185307179586f * (float)tid * (1.0f / 32.0f); TW32[tid] = (f32x2){cosf(a), sinf(a)}; }
    __syncthreads();
}
struct HyCtx { f32x2* Z; f32x2* Fb0; const f32x2* TW4; const f32x2* TW32; const bf16_t* rv; const bf16_t* rx1; const bf16_t* rx2; bf16_t* YTc; float* Y1S;
    f32x2 w8t, w4t; float cv0, cv1, cv2, cx0, cx1, cx2, cy0, cy1, cy2, sk0, sk1; int tid, br, t, lane, p1; };
template <int ORDER> __device__ __forceinline__ void hyena_conv(const HyCtx& K, int pr) {
    f32x2* Z = K.Z; const f32x2* TW4 = K.TW4; const f32x2* TW32 = K.TW32;
    const bf16_t* rv = K.rv; const bf16_t* rx1 = K.rx1; const bf16_t* rx2 = K.rx2; float* Y1S = K.Y1S;
    int tid = K.tid; asm volatile("" : "+v"(tid));
    const f32x2 w8t = K.w8t, w4t = K.w4t; const int br = tid >> 8, t = tid & 255, lane = tid & 63, p1 = t + (t >> 4);
    f32x2* Zb = K.Z + br * 4352; f32x2* Fb = K.Fb0 + br * 4352;
    const float cv0 = K.cv0, cv1 = K.cv1, cv2 = K.cv2, cx0 = K.cx0, cx1 = K.cx1, cx2 = K.cx2, cy0 = K.cy0, cy1 = K.cy1, cy2 = K.cy2, sk0 = K.sk0, sk1 = K.sk1;
        const int ba = 2 * pr * 4096, bb = ba + 4096;
        {
            f32x2 x[16];
#pragma unroll
            for (int q = 0; q < 16; ++q) {
                const int n = t + 256 * q; float ua, ub;
                if (ORDER == 0) { ua = conv3_lane(bf2f(rv[ba + n]), lane, cv0, cv1, cv2); ub = conv3_lane(bf2f(rv[bb + n]), lane, cv0, cv1, cv2); }
                else { ua = Y1S[n]; ub = Y1S[4096 + n]; }
                const f32x2 z = (f32x2){ua, ub};
                x[q] = br ? cmul(z, cmul(w8t, TW32[q])) : z;
            }
            dft16<false>(x); apply_tw<false>(x, w4t);
#pragma unroll
            for (int q = 0; q < 16; ++q) Zb[p1 + 272 * q] = x[q];
        }
        __syncthreads();
        fft_pass2_fwd(Zb, t, TW4);
        __syncthreads();
        {
            f32x2 x[16];
#pragma unroll
            for (int q = 0; q < 16; ++q) x[q] = Zb[17 * t + q];
            dft16<false>(x);
#pragma unroll
            for (int r = 0; r < 16; ++r) {
                const int p = 16 * t + r; int pp;
                if (br) pp = 4095 - p;
                else { const int m = (r << 8) | ((t & 15) << 4) | (t >> 4); const int mp = (4096 - m) & 4095; pp = ((mp & 15) << 8) | (mp & 0xF0) | (mp >> 8); }
                const f32x2 fk = Fb[p + (p >> 4)], fc = Fb[pp + (pp >> 4)];
                f32x2 H;
                if (ORDER == 0) H = (f32x2){0.5f * (fk.x + fc.x), 0.5f * (fk.y - fc.y)};
                else H = (f32x2){0.5f * (fk.y + fc.y), -0.5f * (fk.x - fc.x)};
                x[r] = cmul(x[r], H);
            }
            dft16<true>(x);
#pragma unroll
            for (int q = 0; q < 16; ++q) Zb[17 * t + q] = x[q];
        }
        __syncthreads();
        fft_pass2_inv(Zb, t, TW4);
        __syncthreads();
        {
            f32x2 x[16];
#pragma unroll
            for (int q = 0; q < 16; ++q) x[q] = Zb[p1 + 272 * q];
            apply_tw<true>(x, w4t); dft16<true>(x);
            if (br) {
#pragma unroll
                for (int q = 0; q < 16; ++q) x[q] = cmulc(x[q], cmul(w8t, TW32[q]));
            }
#pragma unroll
            for (int q = 0; q < 16; ++q) Zb[p1 + 272 * q] = x[q];
        }
        __syncthreads();
        {
            float in0[8], in1[8], in2[8], in3[8];
#pragma unroll
            for (int i = 0; i < 8; ++i) {
                const int n = tid + i * NT;
                if (ORDER == 0) { in0[i] = bf2f(rv[ba + n]); in1[i] = bf2f(rv[bb + n]); in2[i] = bf2f(rx1[ba + n]); in3[i] = bf2f(rx1[bb + n]); }
                else { in0[i] = Y1S[n]; in1[i] = Y1S[4096 + n]; in2[i] = bf2f(rx2[ba + n]); in3[i] = bf2f(rx2[bb + n]); }
            }
#pragma unroll
            for (int i = 0; i < 8; ++i) {
                const int n = tid + i * NT, pn = n + (n >> 4);
                const f32x2 e0 = Z[pn], e1 = Z[4352 + pn];
                const float ca = (e0.x + e1.x) * (1.0f / 8192.0f), cb = (e0.y + e1.y) * (1.0f / 8192.0f);
                if (ORDER == 0) {
                    const float va = conv3_lane(in0[i], lane, cv0, cv1, cv2), vb = conv3_lane(in1[i], lane, cv0, cv1, cv2);
                    const float xa = conv3_lane(in2[i], lane, cx0, cx1, cx2), xb = conv3_lane(in3[i], lane, cx0, cx1, cx2);
                    Y1S[n] = xa * (ca + sk0 * va); Y1S[4096 + n] = xb * (cb + sk0 * vb);
                } else {
                    const float xa = conv3_lane(in2[i], lane, cy0, cy1, cy2), xb = conv3_lane(in3[i], lane, cy0, cy1, cy2);
                    K.YTc[ba + n] = (bf16_t)f2bf(xa * (ca + sk1 * in0[i])); K.YTc[bb + n] = (bf16_t)f2bf(xb * (cb + sk1 * in1[i]));
                }
            }
        }
        __syncthreads();
}
__device__ __attribute__((always_inline)) void hyena_item(KA a, int c, unsigned char* lds) {
    f32x2* Z = (f32x2*)(lds + HY_Z); f32x2* F = (f32x2*)(lds + HY_F);
    const f32x2* TW4 = (const f32x2*)(lds + HY_TW4); const f32x2* TW8 = (const f32x2*)(lds + HY_TW8); const f32x2* TW32 = (const f32x2*)(lds + HY_TW32);
    float* W3 = (float*)(lds + HY_W3);
    int tid = tid_opaque(); asm volatile("" : "+v"(tid));
    const int br = tid >> 8, t = tid & 255, lane = tid & 63;
    f32x2* Zb = Z + br * 4352; f32x2* Fb = F + br * 4352;
    const float* hid2 = (const float*)(a->ws + WS_HID2);
    const float* w3 = a->in[16]; const float* b3 = a->in[17]; const float* cw = a->in[11]; const float* skip = a->in[19];
    const bf16_t* PHT = (const bf16_t*)(a->ws + WS_RA);
    bf16_t* YT = (bf16_t*)a->out;
    float* Y1S = a->out + (size_t)16 * 1024 * 1024 + (size_t)blockIdx.x * 16384;
    {
        const bf16_t* fp = (const bf16_t*)(a->ws + WS_FILT) + (size_t)c * 4 * 4096 + tid * 8;
        float f0[8], f1[8], f2[8], f3[8];
        unpack8(*(const u32x4*)fp, f0); unpack8(*(const u32x4*)(fp + 4096), f1); unpack8(*(const u32x4*)(fp + 8192), f2); unpack8(*(const u32x4*)(fp + 12288), f3);
#pragma unroll
        for (int e = 0; e < 8; ++e) { Z[tid * 8 + e] = (f32x2){f0[e], f1[e]}; Z[4096 + tid * 8 + e] = (f32x2){f2[e], f3[e]}; }
    }
    __syncthreads();
    const f32x2 w8t = TW8[t], w4t = TW4[t];
    const int p1 = t + (t >> 4);
    {
        f32x2 x[16];
#pragma unroll
        for (int q = 0; q < 16; ++q) {
            const int n = t + 256 * q;
            const f32x2 av = Z[n]; f32x2 bv = Z[8192 - (n ? n : 1)]; if (n == 0) bv = (f32x2){0.f, 0.f};
            x[q] = br ? cmul(av - bv, cmul(w8t, TW32[q])) : (av + bv);
        }
        dft16<false>(x); apply_tw<false>(x, w4t);
#pragma unroll
        for (int q = 0; q < 16; ++q) Fb[p1 + 272 * q] = x[q];
    }
    __syncthreads();
    fft_pass2_fwd(Fb, t, TW4);
    __syncthreads();
    {   f32x2 x[16];
#pragma unroll
        for (int q = 0; q < 16; ++q) x[q] = Fb[17 * t + q];
        dft16<false>(x);
#pragma unroll
        for (int q = 0; q < 16; ++q) Fb[17 * t + q] = x[q];
    }
    __syncthreads();
    const float cv0 = cw[c], cv1 = cw[6144 + c], cv2 = cw[12288 + c];
    const float cx0 = cw[2048 + c], cx1 = cw[6144 + 2048 + c], cx2 = cw[12288 + 2048 + c];
    const float cy0 = cw[4096 + c], cy1 = cw[6144 + 4096 + c], cy2 = cw[12288 + 4096 + c];
    const float sk0 = skip[c], sk1 = skip[2048 + c];
    const bf16_t* rv = PHT + (size_t)c * MT; const bf16_t* rx1 = PHT + (size_t)(2048 + c) * MT; const bf16_t* rx2 = PHT + (size_t)(4096 + c) * MT;
    HyCtx K; K.Z = Z; K.Fb0 = F; K.TW4 = TW4; K.TW32 = TW32; K.rv = rv; K.rx1 = rx1; K.rx2 = rx2; K.YTc = YT + (size_t)c * MT; K.Y1S = Y1S;
    K.w8t = w8t; K.w4t = w4t; K.cv0 = cv0; K.cv1 = cv1; K.cv2 = cv2; K.cx0 = cx0; K.cx1 = cx1; K.cx2 = cx2; K.cy0 = cy0; K.cy1 = cy1; K.cy2 = cy2; K.sk0 = sk0; K.sk1 = sk1;
    K.tid = tid; K.br = br; K.t = t; K.lane = lane; K.p1 = p1;
#pragma unroll 1
    for (int pr = 0; pr < 2; ++pr) { hyena_conv<0>(K, pr); hyena_conv<1>(K, pr); }
}

constexpr int H2_ZT = 0, H2_YS = 36864, H2_F = 110592, H2_FS = 4097, H2_TW8 = 143368, H2_TW32 = 145416;
struct Hy2W { bf16x8 wr[2], wi[2], wn[2]; };
__device__ __forceinline__ bf16x8 h2frag(const bf16_t* plane, int row, int kk, int fq) { return *(const bf16x8*)(plane + row * 72 + kk * 32 + fq * 8); }
template <int WROLE, int CONJ> __device__ __forceinline__ void h2tile(const bf16_t* Pr, const bf16_t* Pi, int row0, const Hy2W& W, int fr, int fq, f32x4& ar, f32x4& ai) {
    ar = (f32x4){0.f, 0.f, 0.f, 0.f}; ai = (f32x4){0.f, 0.f, 0.f, 0.f};
#pragma unroll
    for (int kk = 0; kk < 2; ++kk) {
        const bf16x8 dr = h2frag(Pr, row0 + fr, kk, fq), di = h2frag(Pi, row0 + fr, kk, fq);
        if (WROLE == 0) { ar = MFMA16(dr, W.wr[kk], ar); ar = MFMA16(di, CONJ ? W.wi[kk] : W.wn[kk], ar); ai = MFMA16(dr, CONJ ? W.wn[kk] : W.wi[kk], ai); ai = MFMA16(di, W.wr[kk], ai); }
        else { ar = MFMA16(W.wr[kk], dr, ar); ar = MFMA16(CONJ ? W.wi[kk] : W.wn[kk], di, ar); ai = MFMA16(CONJ ? W.wn[kk] : W.wi[kk], dr, ai); ai = MFMA16(W.wr[kk], di, ai); }
    }
}
struct Hy2T { f32x2 t[4][4]; };
__device__ __attribute__((always_inline)) void hyena2_setup(unsigned char* lds, Hy2W& W, Hy2T& T) {
    const int tid = tid_opaque(), lane = tid & 63, fr = lane & 15, fq = lane >> 4, wt = (tid >> 6) & 3;
    f32x2* TW8 = (f32x2*)(lds + H2_TW8); f32x2* TW32 = (f32x2*)(lds + H2_TW32);
    if (tid < 256) { const float a8 = -6.283185307179586f * (float)tid * (1.0f / 8192.0f); TW8[tid] = (f32x2){cosf(a8), sinf(a8)}; }
    if (tid < 16) { const float a = -6.283185307179586f * (float)tid * (1.0f / 32.0f); TW32[tid] = (f32x2){cosf(a), sinf(a)}; }
#pragma unroll
    for (int kk = 0; kk < 2; ++kk)
#pragma unroll
        for (int j = 0; j < 8; ++j) {
            const int m = ((16 * wt + fr) * (kk * 32 + fq * 8 + j)) & 63;
            const float ang = -6.283185307179586f * (float)m * (1.0f / 64.0f), c = cosf(ang), s = sinf(ang);
            W.wr[kk][j] = (short)f2bf(c); W.wi[kk][j] = (short)f2bf(s); W.wn[kk][j] = (short)f2bf(-s);
        }
#pragma unroll
    for (int mt = 0; mt < 4; ++mt)
#pragma unroll
        for (int r = 0; r < 4; ++r) { const float ang = (float)((16 * wt + fr) * (mt * 16 + 4 * fq + r)) * (6.283185307179586f / 4096.0f); T.t[mt][r] = (f32x2){cosf(ang), sinf(ang)}; }
    __syncthreads();
}
struct Hy2Ctx { unsigned char* lds; const bf16_t* rv; const bf16_t* rx1; const bf16_t* rx2; bf16_t* YTc; float cv0, cv1, cv2, cx0, cx1, cx2, cy0, cy1, cy2, sk0, sk1; };
#define H2BAR() do { asm volatile("s_waitcnt lgkmcnt(0)" ::: "memory"); __builtin_amdgcn_s_barrier(); asm volatile("" ::: "memory"); } while (0)
template <int FMODE> __device__ __forceinline__ void h2_forward(unsigned char* lds, const Hy2W& W, const Hy2T& T, int tid) {
    const int lane = tid & 63, w = tid >> 6, br = w >> 2, wt = w & 3, fr = lane & 15, fq = lane >> 4;
    bf16_t* ZTr = (bf16_t*)(lds + H2_ZT + br * 18432); bf16_t* ZTi = ZTr + 4608;
    bf16_t* Yr = (bf16_t*)(lds + H2_YS + br * 36864); bf16_t* Yi = Yr + 4608; bf16_t* Sr = Yi + 4608; bf16_t* Si = Sr + 4608;
    unsigned* Fq = (unsigned*)(lds + H2_F) + br * H2_FS;
    const unsigned* Fk = Fq + 64 * (16 * wt + 4 * fq) + fr; const unsigned* Fm = Fq + ((br ? 4095 : 4096) - (64 * (16 * wt + 4 * fq) + fr)) - 240;
#pragma unroll
    for (int mt = 0; mt < 4; ++mt) {
        f32x4 ar, ai; h2tile<0, 0>(ZTr, ZTi, mt * 16, W, fr, fq, ar, ai);
        const int k1 = 16 * wt + fr;
        float vr[4], vi[4];
#pragma unroll
        for (int r = 0; r < 4; ++r) { const float c = T.t[mt][r].x, s = T.t[mt][r].y; vr[r] = ar[r] * c + ai[r] * s; vi[r] = ai[r] * c - ar[r] * s; }
        *(u32x2*)(Yr + k1 * 72 + mt * 16 + 4 * fq) = pk4(vr[0], vr[1], vr[2], vr[3]); *(u32x2*)(Yi + k1 * 72 + mt * 16 + 4 * fq) = pk4(vi[0], vi[1], vi[2], vi[3]);
    }
    H2BAR();
#pragma unroll
    for (int nt = 0; nt < 4; ++nt) {
        f32x4 ar, ai; h2tile<1, 0>(Yr, Yi, nt * 16, W, fr, fq, ar, ai);
        const int k1 = nt * 16 + fr;
        if (FMODE == 0) {
#pragma unroll
            for (int r = 0; r < 4; ++r) { const int k = k1 + 64 * (16 * wt + 4 * fq + r); const unsigned v = pk2(ar[r], ai[r]); Fq[k] = v; if (k == 0) Fq[4096] = v; }
        } else {
            float vr[4], vi[4];
#pragma unroll
            for (int r = 0; r < 4; ++r) {
                const unsigned fa = Fk[64 * r + 16 * nt], fb = Fm[240 - 64 * r - 16 * nt];
                const float fkr = bflo(fa), fki = bfhi(fa), fcr = bflo(fb), fci = bfhi(fb);
                float hr, hi;
                if (FMODE == 1) { hr = 0.5f * (fkr + fcr); hi = 0.5f * (fki - fci); } else { hr = 0.5f * (fki + fci); hi = -0.5f * (fkr - fcr); }
                vr[r] = ar[r] * hr - ai[r] * hi; vi[r] = ar[r] * hi + ai[r] * hr;
            }
            *(u32x2*)(Sr + k1 * 72 + 16 * wt + 4 * fq) = pk4(vr[0], vr[1], vr[2], vr[3]); *(u32x2*)(Si + k1 * 72 + 16 * wt + 4 * fq) = pk4(vi[0], vi[1], vi[2], vi[3]);
        }
    }
    H2BAR();
}
__device__ __forceinline__ void h2_inverse(unsigned char* lds, const Hy2W& W, const Hy2T& T, int tid) {
    const int lane = tid & 63, w = tid >> 6, br = w >> 2, wt = w & 3, fr = lane & 15, fq = lane >> 4;
    const f32x2* TW8 = (const f32x2*)(lds + H2_TW8); const f32x2* TW32 = (const f32x2*)(lds + H2_TW32);
    bf16_t* ZTr = (bf16_t*)(lds + H2_ZT + br * 18432); bf16_t* ZTi = ZTr + 4608;
    bf16_t* Sr = (bf16_t*)(lds + H2_YS + br * 36864) + 9216; bf16_t* Si = Sr + 4608;
#pragma unroll
    for (int mt = 0; mt < 4; ++mt) {
        f32x4 ar, ai; h2tile<0, 1>(Sr, Si, mt * 16, W, fr, fq, ar, ai);
        const int n2 = 16 * wt + fr;
        float vr[4], vi[4];
#pragma unroll
        for (int r = 0; r < 4; ++r) { const float c = T.t[mt][r].x, s = T.t[mt][r].y; vr[r] = ar[r] * c - ai[r] * s; vi[r] = ai[r] * c + ar[r] * s; }
        *(u32x2*)(ZTr + n2 * 72 + mt * 16 + 4 * fq) = pk4(vr[0], vr[1], vr[2], vr[3]); *(u32x2*)(ZTi + n2 * 72 + mt * 16 + 4 * fq) = pk4(vi[0], vi[1], vi[2], vi[3]);
    }
    H2BAR();
    f32x2* E = (f32x2*)(lds + H2_YS);
#pragma unroll
    for (int nt = 0; nt < 4; ++nt) {
        f32x4 ar, ai; h2tile<1, 1>(ZTr, ZTi, nt * 16, W, fr, fq, ar, ai);
#pragma unroll
        for (int r = 0; r < 4; ++r) {
            const int n = 64 * (16 * wt + 4 * fq + r) + nt * 16 + fr;
            f32x2 e = (f32x2){ar[r], ai[r]};
            if (br) e = cmulc(e, cmul(TW8[n & 255], TW32[n >> 8]));
            E[br * 4096 + n] = e;
        }
    }
    H2BAR();
}
__device__ __forceinline__ void h2_pass0(unsigned char* lds, const float (&ua)[8], const float (&ub)[8], int w, int lane) {
    const f32x2* TW8 = (const f32x2*)(lds + H2_TW8); const f32x2* TW32 = (const f32x2*)(lds + H2_TW32);
    bf16_t* ZT = (bf16_t*)(lds + H2_ZT) + lane * 72 + 8 * w;
    float o0[8], o1[8];
#pragma unroll
    for (int i = 0; i < 8; ++i) { const int n = 64 * (8 * w + i) + lane; const f32x2 wv = cmul(TW8[n & 255], TW32[n >> 8]); o0[i] = ua[i] * wv.x - ub[i] * wv.y; o1[i] = ua[i] * wv.y + ub[i] * wv.x; }
    *(u32x4*)ZT = pack8(ua); *(u32x4*)(ZT + 4608) = pack8(ub); *(u32x4*)(ZT + 9216) = pack8(o0); *(u32x4*)(ZT + 13824) = pack8(o1);
}
__device__ __forceinline__ void hyena2_pair(const Hy2Ctx& K, const Hy2W& W, const Hy2T& T, int pr) {
    unsigned char* lds = K.lds;
    int tid = tid_opaque();
    const int lane = tid & 63, w = tid >> 6;
    const int ba = 2 * pr * 4096, bb = ba + 4096;
    const f32x2* E = (const f32x2*)(lds + H2_YS);
    float va[8], vb[8], xa[8], xb[8];
#pragma unroll
    for (int i = 0; i < 8; ++i) { const int n = 64 * (8 * w + i) + lane; va[i] = bf2f(K.rv[ba + n]); vb[i] = bf2f(K.rv[bb + n]); }
#pragma unroll
    for (int i = 0; i < 8; ++i) { va[i] = conv3_lane(va[i], lane, K.cv0, K.cv1, K.cv2); vb[i] = conv3_lane(vb[i], lane, K.cv0, K.cv1, K.cv2); }
    h2_pass0(lds, va, vb, w, lane);
    H2BAR();
#pragma unroll
    for (int i = 0; i < 8; ++i) { const int n = 64 * (8 * w + i) + lane; xa[i] = bf2f(K.rx1[ba + n]); xb[i] = bf2f(K.rx1[bb + n]); }
    h2_forward<1>(lds, W, T, tid);
    h2_inverse(lds, W, T, tid);
    float ya[8], yb[8];
#pragma unroll
    for (int i = 0; i < 8; ++i) {
        const int n = 64 * (8 * w + i) + lane;
        const f32x2 e0 = E[n], e1 = E[4096 + n];
        const float ca = (e0.x + e1.x) * (1.0f / 8192.0f), cb = (e0.y + e1.y) * (1.0f / 8192.0f);
        ya[i] = conv3_lane(xa[i], lane, K.cx0, K.cx1, K.cx2) * (ca + K.sk0 * va[i]); yb[i] = conv3_lane(xb[i], lane, K.cx0, K.cx1, K.cx2) * (cb + K.sk0 * vb[i]);
    }
    h2_pass0(lds, ya, yb, w, lane);
    H2BAR();
    float za[8], zb[8];
#pragma unroll
    for (int i = 0; i < 8; ++i) { const int n = 64 * (8 * w + i) + lane; za[i] = bf2f(K.rx2[ba + n]); zb[i] = bf2f(K.rx2[bb + n]); }
    h2_forward<2>(lds, W, T, tid);
    h2_inverse(lds, W, T, tid);
#pragma unroll
    for (int i = 0; i < 8; ++i) {
        const int n = 64 * (8 * w + i) + lane;
        const f32x2 e0 = E[n], e1 = E[4096 + n];
        const float ca = (e0.x + e1.x) * (1.0f / 8192.0f), cb = (e0.y + e1.y) * (1.0f / 8192.0f);
        K.YTc[ba + n] = (bf16_t)f2bf(conv3_lane(za[i], lane, K.cy0, K.cy1, K.cy2) * (ca + K.sk1 * ya[i]));
        K.YTc[bb + n] = (bf16_t)f2bf(conv3_lane(zb[i], lane, K.cy0, K.cy1, K.cy2) * (cb + K.sk1 * yb[i]));
    }
    H2BAR();
}
__device__ __attribute__((always_inline)) void hyena2_item(KA a, int c, unsigned char* lds, const Hy2W& W, const Hy2T& T) {
    int tid = tid_opaque();
    const int lane = tid & 63, w = tid >> 6;
    const float* cw = a->in[11]; const float* skip = a->in[19];
    const bf16_t* PHT = (const bf16_t*)(a->ws + WS_RA);
    {
        const bf16_t* fp = (const bf16_t*)(a->ws + WS_FILT) + (size_t)c * 4 * 4096;
        float sr[8], si[8], dr[8], di[8];
#pragma unroll
        for (int i = 0; i < 8; ++i) { const int n = 64 * (8 * w + i) + lane, m = n ? (4096 - n) : 0;
            const float a0 = bf2f(fp[n]), a1 = bf2f(fp[4096 + n]); float b0 = bf2f(fp[8192 + m]), b1 = bf2f(fp[12288 + m]);
            if (n == 0) { b0 = 0.f; b1 = 0.f; }
            sr[i] = a0 + b0; si[i] = a1 + b1; dr[i] = a0 - b0; di[i] = a1 - b1; }
        const f32x2* TW8 = (const f32x2*)(lds + H2_TW8); const f32x2* TW32 = (const f32x2*)(lds + H2_TW32);
        bf16_t* ZT = (bf16_t*)(lds + H2_ZT) + lane * 72 + 8 * w;
        float o0[8], o1[8];
#pragma unroll
        for (int i = 0; i < 8; ++i) { const int n = 64 * (8 * w + i) + lane; const f32x2 wv = cmul(TW8[n & 255], TW32[n >> 8]); o0[i] = dr[i] * wv.x - di[i] * wv.y; o1[i] = dr[i] * wv.y + di[i] * wv.x; }
        *(u32x4*)ZT = pack8(sr); *(u32x4*)(ZT + 4608) = pack8(si); *(u32x4*)(ZT + 9216) = pack8(o0); *(u32x4*)(ZT + 13824) = pack8(o1);
    }
    H2BAR();
    h2_forward<0>(lds, W, T, tid);
    Hy2Ctx K; K.lds = lds; K.rv = PHT + (size_t)c * MT; K.rx1 = PHT + (size_t)(2048 + c) * MT; K.rx2 = PHT + (size_t)(4096 + c) * MT;
    K.YTc = (bf16_t*)a->out + (size_t)c * MT;
    K.cv0 = cw[c]; K.cv1 = cw[6144 + c]; K.cv2 = cw[12288 + c]; K.cx0 = cw[2048 + c]; K.cx1 = cw[6144 + 2048 + c]; K.cx2 = cw[12288 + 2048 + c];
    K.cy0 = cw[4096 + c]; K.cy1 = cw[6144 + 4096 + c]; K.cy2 = cw[12288 + 4096 + c]; K.sk0 = skip[c]; K.sk1 = skip[2048 + c];
#pragma unroll 1
    for (int pr = 0; pr < 2; ++pr) hyena2_pair(K, W, T, pr);
}

__device__ __attribute__((always_inline)) void qkvpost_unit(KA a, int unit, unsigned char* lds) {
    const int tid = tid_opaque();
    int ntok, row0, wh;
    if (unit < 12288) { const int gr = unit / 48; wh = unit % 48; ntok = 64; row0 = gr * 64; }
    else { const int uu = unit - 12288; const int b = uu / 48; wh = uu % 48; ntok = 256; row0 = MT + b * 256; }
    const int which = wh >> 4, h = wh & 15, colbase = which * 2048 + h * 128;
    bf16_t* PQ = (bf16_t*)(a->ws + WS_RB);
    bf16_t* raw = (bf16_t*)lds; float* wl = (float*)(lds + 65536);
    const float* cwt = a->in[7];
    for (int i = tid; i < ntok * 16; i += NT) { const int r = i >> 4, c8 = i & 15; *(u32x4*)(raw + r * 128 + c8 * 8) = *(const u32x4*)(PQ + (size_t)(row0 + r) * PQ_LD + colbase + c8 * 8); }
    for (int i = tid; i < 640; i += NT) wl[i] = cwt[(i >> 7) * 6144 + colbase + (i & 127)];
    __syncthreads();
    const int r = tid >> 3, cg = tid & 7;
    for (int rb = 0; rb < ntok / 64; ++rb) {
        const int tok = rb * 64 + r;
        float v[16]; float ss = 0.f;
#pragma unroll
        for (int e = 0; e < 16; ++e) v[e] = 0.f;
#pragma unroll
        for (int j = 0; j < 5; ++j) {
            const int tt = tok + j - 2;
            if (tt >= 0 && tt < ntok) {
                float p0[8], p1[8]; unpack8(*(const u32x4*)(raw + tt * 128 + cg * 16), p0); unpack8(*(const u32x4*)(raw + tt * 128 + cg * 16 + 8), p1);
                const float* wp = wl + j * 128 + cg * 16;
#pragma unroll
                for (int e = 0; e < 8; ++e) { v[e] += wp[e] * p0[e]; v[8 + e] += wp[8 + e] * p1[e]; }
            }
        }
#pragma unroll
        for (int e = 0; e < 16; ++e) { const float s = siluf_(v[e]); v[e] = s; ss += s * s; }
        if (which < 2) {
            ss += __shfl_xor(ss, 1, 64); ss += __shfl_xor(ss, 2, 64); ss += __shfl_xor(ss, 4, 64);
            const float sc = rsqrtf(ss + 1e-6f) * (which == 0 ? 0.08838834764831845f : 1.0f);
#pragma unroll
            for (int e = 0; e < 16; ++e) v[e] *= sc;
        }
        bf16_t* op = PQ + (size_t)(row0 + tok) * PQ_LD + colbase + cg * 16;
        u32x4 w0, w1;
        w0.x = pk2(v[0], v[1]); w0.y = pk2(v[2], v[3]); w0.z = pk2(v[4], v[5]); w0.w = pk2(v[6], v[7]);
        w1.x = pk2(v[8], v[9]); w1.y = pk2(v[10], v[11]); w1.z = pk2(v[12], v[13]); w1.w = pk2(v[14], v[15]);
        *(u32x4*)op = w0; *(u32x4*)(op + 8) = w1;
    }
    __syncthreads();
}

__device__ __attribute__((always_inline)) void qkvpost_latent(KA a, unsigned char* lds) {
    const int tid = tid_opaque(), r = tid >> 3, cg = tid & 7;
    bf16_t* PQ = (bf16_t*)(a->ws + WS_RB); const float* cwt = a->in[7];
    const int G = gridDim.x;
    u32x4 pA0, pA1, pB0, pB1, pC0, pC1; float wA0, wA1 = 0.f, wB0, wB1 = 0.f, wC0, wC1 = 0.f;
#define QP_LOAD(P0_, P1_, W0_, W1_, u_) do { if ((u_) < 12288) { \
        const int gr_ = (u_) / 48, wh_ = (u_) % 48, cb_ = (wh_ >> 4) * 2048 + (wh_ & 15) * 128, r0_ = gr_ * 64; \
        P0_ = *(const u32x4*)(PQ + (size_t)(r0_ + (tid >> 4)) * PQ_LD + cb_ + (tid & 15) * 8); \
        P1_ = *(const u32x4*)(PQ + (size_t)(r0_ + 32 + (tid >> 4)) * PQ_LD + cb_ + (tid & 15) * 8); \
        W0_ = cwt[(tid >> 7) * 6144 + cb_ + (tid & 127)]; if (tid < 128) W1_ = cwt[4 * 6144 + cb_ + tid]; } } while (0)
#define QP_BODY(P0_, P1_, W0_, W1_, u_, k_) do { \
        bf16_t* raw = (bf16_t*)(lds + ((k_) & 1) * 16384); float* wl = (float*)(lds + 32768 + ((k_) & 1) * 2560); \
        *(u32x4*)(raw + (tid >> 4) * 128 + (tid & 15) * 8) = P0_; *(u32x4*)(raw + (32 + (tid >> 4)) * 128 + (tid & 15) * 8) = P1_; \
        wl[tid] = W0_; if (tid < 128) wl[512 + tid] = W1_; \
        __syncthreads(); \
        const int gr = (u_) / 48, wh = (u_) % 48, which = wh >> 4, colbase = which * 2048 + (wh & 15) * 128, row0 = gr * 64; \
        QP_LOAD(P0_, P1_, W0_, W1_, (u_) + 3 * G); \
        float v[16]; float ss = 0.f; \
        _Pragma("unroll") for (int e = 0; e < 16; ++e) v[e] = 0.f; \
        _Pragma("unroll") for (int j = 0; j < 5; ++j) { \
            const int tt = r + j - 2; \
            if (tt >= 0 && tt < 64) { \
                float p0[8], p1[8]; unpack8(*(const u32x4*)(raw + tt * 128 + cg * 16), p0); unpack8(*(const u32x4*)(raw + tt * 128 + cg * 16 + 8), p1); \
                const float* wp = wl + j * 128 + cg * 16; \
                _Pragma("unroll") for (int e = 0; e < 8; ++e) { v[e] += wp[e] * p0[e]; v[8 + e] += wp[8 + e] * p1[e]; } \
            } \
        } \
        _Pragma("unroll") for (int e = 0; e < 16; ++e) { const float sv = siluf_(v[e]); v[e] = sv; ss += sv * sv; } \
        if (which < 2) { \
            ss += __shfl_xor(ss, 1, 64); ss += __shfl_xor(ss, 2, 64); ss += __shfl_xor(ss, 4, 64); \
            const float sc = rsqrtf(ss + 1e-6f) * (which == 0 ? 0.08838834764831845f : 1.0f); \
            _Pragma("unroll") for (int e = 0; e < 16; ++e) v[e] *= sc; \
        } \
        bf16_t* op = PQ + (size_t)(row0 + r) * PQ_LD + colbase + cg * 16; \
        u32x4 w0, w1; \
        w0.x = pk2(v[0], v[1]); w0.y = pk2(v[2], v[3]); w0.z = pk2(v[4], v[5]); w0.w = pk2(v[6], v[7]); \
        w1.x = pk2(v[8], v[9]); w1.y = pk2(v[10], v[11]); w1.z = pk2(v[12], v[13]); w1.w = pk2(v[14], v[15]); \
        *(u32x4*)op = w0; *(u32x4*)(op + 8) = w1; } while (0)
    int u = blockIdx.x;
    QP_LOAD(pA0, pA1, wA0, wA1, u); QP_LOAD(pB0, pB1, wB0, wB1, u + G); QP_LOAD(pC0, pC1, wC0, wC1, u + 2 * G);
#pragma unroll 1
    for (int k = 0; u < 12288; k += 3, u += 3 * G) {
        QP_BODY(pA0, pA1, wA0, wA1, u, k);
        if (u + G < 12288) QP_BODY(pB0, pB1, wB0, wB1, u + G, k + 1);
        if (u + 2 * G < 12288) QP_BODY(pC0, pC1, wC0, wC1, u + 2 * G, k + 2);
    }
#undef QP_LOAD
#undef QP_BODY
    __syncthreads();
}

typedef short bf16x8 __attribute__((ext_vector_type(8)));
constexpr size_t WS_TS = 585 * MiB, WS_GCB = 653 * MiB;

__device__ __attribute__((always_inline)) void tprep_wave(KA a, int pid, unsigned char* wl) {
    const int lane = tid_opaque() & 63, fr = lane & 15, fq = lane >> 4;
    const int sid = pid / 68, cidx = pid - sid * 68, dir = sid & 1, h = (sid >> 1) & 15, b = sid >> 5;
    bf16_t* kt = (bf16_t*)wl; float* Mf = (float*)wl; float* gcs = (float*)(wl + 17408); float* bes = gcs + 64;
    const bf16_t* PQ = (const bf16_t*)(a->ws + WS_RB); const float* AB = (const float*)(a->ws + WS_AB);
    bf16_t* TS = (bf16_t*)(a->ws + WS_TS) + (size_t)pid * 4096; float* GCB = (float*)(a->ws + WS_GCB) + (size_t)pid * 128;
    int rbase, Tn, p0;
    if (cidx < 4) { rbase = MT + b * CTXL; Tn = CTXL; p0 = cidx * 64; } else { rbase = b * SEQ; Tn = SEQ; p0 = (cidx - 4) * 64; }
    {
        u32x4 kv[16];
#pragma unroll
        for (int it = 0; it < 16; ++it) {
            const int i = it * 4 + fq, p = p0 + i, tok = dir ? (Tn - 1 - p) : p;
            kv[it] = *(const u32x4*)(PQ + (size_t)(rbase + tok) * PQ_LD + 2048 + h * 128 + fr * 8);
        }
#pragma unroll
        for (int it = 0; it < 16; ++it) *(u32x4*)(kt + (it * 4 + fq) * 136 + fr * 8) = kv[it];
    }
    {
        const int p = p0 + lane, tok = dir ? (Tn - 1 - p) : p; const size_t row = (size_t)(rbase + tok);
        const float ab0 = AB[row * 64 + dir * 32 + h], ab1 = AB[row * 64 + dir * 32 + 16 + h];
        const float xx = ab0 + a->in[9][dir * 16 + h]; const float sp = (xx > 20.0f) ? xx : log1pf(expf(xx));
        float gc = -expf(a->in[8][dir * 16 + h]) * sp;
#pragma unroll
        for (int o = 1; o < 64; o <<= 1) { const float tt = __shfl_up(gc, o, 64); if (lane >= o) gc += tt; }
        const float be = sigmoidf_(ab1);
        gcs[lane] = gc; bes[lane] = be; GCB[lane] = gc; GCB[64 + lane] = expf(gc);
    }
    f32x4 acc[10];
#pragma unroll
    for (int i = 0; i < 10; ++i) acc[i] = (f32x4){0.f, 0.f, 0.f, 0.f};
#pragma unroll
    for (int kk = 0; kk < 4; ++kk) {
        bf16x8 fg[4];
#pragma unroll
        for (int ct = 0; ct < 4; ++ct) fg[ct] = *(const bf16x8*)(kt + (ct * 16 + fr) * 136 + kk * 32 + fq * 8);
#pragma unroll
        for (int ct = 0; ct < 4; ++ct)
#pragma unroll
            for (int mt = 0; mt <= ct; ++mt) acc[ct * (ct + 1) / 2 + mt] = MFMA16(fg[ct], fg[mt], acc[ct * (ct + 1) / 2 + mt]);
    }
    float gcr[4][4], ber[4][4];
#pragma unroll
    for (int ct = 0; ct < 4; ++ct)
#pragma unroll
        for (int r = 0; r < 4; ++r) { gcr[ct][r] = gcs[ct * 16 + 4 * fq + r]; ber[ct][r] = bes[ct * 16 + 4 * fq + r]; }
    float gcm[4];
#pragma unroll
    for (int mt = 0; mt < 4; ++mt) gcm[mt] = gcs[mt * 16 + fr];
    asm volatile("s_waitcnt lgkmcnt(0)" ::: "memory");
#pragma unroll
    for (int ct = 0; ct < 4; ++ct)
#pragma unroll
        for (int mt = 0; mt < 4; ++mt)
#pragma unroll
            for (int r = 0; r < 4; ++r) {
                const int c = ct * 16 + 4 * fq + r, m = mt * 16 + fr;
                float val = 0.0f;
                if (mt <= ct) val = (m < c) ? ber[ct][r] * acc[(mt <= ct) ? (ct * (ct + 1) / 2 + mt) : 0][r] * fexpf_(gcr[ct][r] - gcm[mt]) : 0.0f;
                Mf[c * 68 + m] = val;
            }
    asm volatile("s_waitcnt lgkmcnt(0)" ::: "memory");
    {
        float* blk = Mf + (fq * 16) * 68 + fq * 16;
        float t[16];
#pragma unroll
        for (int i = 0; i < 16; ++i) {
            float s = (fr == i) ? 1.0f : 0.0f;
#pragma unroll
            for (int m4 = 0; m4 < i; m4 += 4) {
                const f32x4 mv = *(const f32x4*)(blk + i * 68 + m4);
                s -= mv.x * t[m4];
                if (m4 + 1 < i) s -= mv.y * t[m4 + 1];
                if (m4 + 2 < i) s -= mv.z * t[m4 + 2];
                if (m4 + 3 < i) s -= mv.w * t[m4 + 3];
            }
            t[i] = s;
        }
        asm volatile("s_waitcnt lgkmcnt(0)" ::: "memory");
#pragma unroll
        for (int i = 0; i < 16; ++i) blk[i * 68 + fr] = t[i];
        asm volatile("s_waitcnt lgkmcnt(0)" ::: "memory");
    }
    float* Ysc = (float*)(wl + 17920);
#pragma unroll
    for (int I = 1; I < 4; ++I)
#pragma unroll
        for (int J = 0; J < I; ++J) {
            f32x4 ya = (f32x4){0.f, 0.f, 0.f, 0.f};
#pragma unroll
            for (int K = J; K < I; ++K)
#pragma unroll
                for (int s = 0; s < 4; ++s) ya = __builtin_amdgcn_mfma_f32_16x16x4f32(Mf[(16 * I + fr) * 68 + 16 * K + 4 * s + fq], Mf[(16 * K + 4 * s + fq) * 68 + 16 * J + fr], ya, 0, 0, 0);
#pragma unroll
            for (int r = 0; r < 4; ++r) Ysc[(4 * fq + r) * 16 + fr] = ya[r];
            asm volatile("s_waitcnt lgkmcnt(0)" ::: "memory");
            f32x4 za = (f32x4){0.f, 0.f, 0.f, 0.f};
#pragma unroll
            for (int s = 0; s < 4; ++s) za = __builtin_amdgcn_mfma_f32_16x16x4f32(Mf[(16 * I + fr) * 68 + 16 * I + 4 * s + fq], Ysc[(4 * s + fq) * 16 + fr], za, 0, 0, 0);
#pragma unroll
            for (int r = 0; r < 4; ++r) Mf[(16 * I + 4 * fq + r) * 68 + 16 * J + fr] = -za[r];
            asm volatile("s_waitcnt lgkmcnt(0)" ::: "memory");
        }
#pragma unroll
    for (int it = 0; it < 8; ++it) {
        const int row = it * 8 + (lane >> 3), c8 = (lane & 7) * 8;
        const f32x4 x0 = *(const f32x4*)(Mf + row * 68 + c8) * *(const f32x4*)(bes + c8), x1 = *(const f32x4*)(Mf + row * 68 + c8 + 4) * *(const f32x4*)(bes + c8 + 4);
        u32x4 wv; wv.x = pk2(x0[0], x0[1]); wv.y = pk2(x0[2], x0[3]); wv.z = pk2(x1[0], x1[1]); wv.w = pk2(x1[2], x1[3]);
        *(u32x4*)(TS + row * 64 + c8) = wv;
    }
    asm volatile("s_waitcnt lgkmcnt(0)" ::: "memory");
}

constexpr int DL_QN = 0, DL_KN = 17408, DL_WN = 34816, DL_ST = 52224, DL_KT = 69632, DL_VT = 88064, DL_T1 = 97280, DL_T2 = 106496, DL_AT = 115712, DL_VN = 124928, DL_VD = 134144, DL_GS = 143360;
struct DStage { u32x4 q0, q1, k0, k1, v, t; f32x4 g0, g1, b0, b1; float bi, gl, g63; };
__device__ __forceinline__ void dstage_load(DStage& R, const bf16_t* PQ, const bf16_t* TS, const float* GCB, int sid, int cidx, int dir, int h, int b, int dvh, int tid) {
    const int i = tid >> 3, part = tid & 7;
    int rbase, Tn, p0;
    if (cidx < 4) { rbase = MT + b * CTXL; Tn = CTXL; p0 = cidx * 64; } else { rbase = b * SEQ; Tn = SEQ; p0 = (cidx - 4) * 64; }
    const int p = p0 + i, tok = dir ? (Tn - 1 - p) : p;
    const bf16_t* rp = PQ + (size_t)(rbase + tok) * PQ_LD + h * 128;
    R.q0 = *(const u32x4*)(rp + part * 8); R.q1 = *(const u32x4*)(rp + 64 + part * 8);
    R.k0 = *(const u32x4*)(rp + 2048 + part * 8); R.k1 = *(const u32x4*)(rp + 2048 + 64 + part * 8);
    R.v = *(const u32x4*)(rp + 4096 + dvh * 64 + part * 8);
    const size_t pid = (size_t)sid * 68 + cidx;
    R.t = *(const u32x4*)(TS + pid * 4096 + i * 64 + part * 8);
    const float* gp = GCB + pid * 128;
    R.b0 = *(const f32x4*)(gp + 64 + part * 8); R.b1 = *(const f32x4*)(gp + 64 + part * 8 + 4);
    R.gl = gp[tid & 63]; R.bi = gp[64 + (tid & 63)]; R.g63 = gp[63];
}
constexpr int DL_QN1 = DL_KT, DL_GS1 = DL_KT + 17408, DL_ST1 = DL_GS + 768;
__device__ __forceinline__ void dstage_store(const DStage& R, unsigned char* lds, int tid, int par) {
    const int i = tid >> 3, part = tid & 7;
    bf16_t* QN = (bf16_t*)(lds + (par ? DL_QN1 : DL_QN)); bf16_t* KN = (bf16_t*)(lds + DL_KN); bf16_t* VNAT = (bf16_t*)(lds + DL_VT);
    bf16_t* T1 = (bf16_t*)(lds + DL_T1); bf16_t* T2 = (bf16_t*)(lds + DL_T2); float* GS = (float*)(lds + (par ? DL_GS1 : DL_GS));
    *(u32x4*)(QN + i * 136 + part * 8) = R.q0; *(u32x4*)(QN + i * 136 + 64 + part * 8) = R.q1;
    *(u32x4*)(KN + i * 136 + part * 8) = R.k0; *(u32x4*)(KN + i * 136 + 64 + part * 8) = R.k1;
    *(u32x4*)(VNAT + i * 72 + part * 8) = R.v;
    float t8[8]; unpack8(R.t, t8);
    const float em[8] = {R.b0.x, R.b0.y, R.b0.z, R.b0.w, R.b1.x, R.b1.y, R.b1.z, R.b1.w};
    float a1[8];
#pragma unroll
    for (int e = 0; e < 8; ++e) a1[e] = t8[e] * em[e];
    *(u32x4*)(T1 + i * 72 + part * 8) = pack8(a1); *(u32x4*)(T2 + i * 72 + part * 8) = R.t;
    if (tid < 64) { GS[tid] = R.gl; GS[64 + tid] = R.bi; GS[128 + tid] = fexpf_(R.g63 - R.gl); }
}
typedef short s16x4 __attribute__((ext_vector_type(4)));
__device__ __forceinline__ void tr_frags2(unsigned a0, unsigned a1, bf16x8& f0, bf16x8& f1) {
    (void)a0; (void)a1; (void)f0; (void)f1;
}
#define TR_READ4(r0, r1, r2, r3, ad0, ad1, ad2, ad3) asm volatile("ds_read_b64_tr_b16 %0, %4\n\tds_read_b64_tr_b16 %1, %5\n\tds_read_b64_tr_b16 %2, %6\n\tds_read_b64_tr_b16 %3, %7\n\ts_waitcnt lgkmcnt(0)" \
    : "=&v"(r0), "=&v"(r1), "=&v"(r2), "=&v"(r3) : "v"(ad0), "v"(ad1), "v"(ad2), "v"(ad3) : "memory")
#define TR_CAT(lo, hi) __builtin_shufflevector((lo), (hi), 0, 1, 2, 3, 4, 5, 6, 7)
#define LBAR() do { asm volatile("s_waitcnt lgkmcnt(0)" ::: "memory"); __builtin_amdgcn_s_barrier(); asm volatile("" ::: "memory"); } while (0)
__device__ __attribute__((always_inline)) void delta_item(KA a, int item, unsigned char* lds) {
    const int tid = tid_opaque(), lane = tid & 63, w = tid >> 6, fr = lane & 15, fq = lane >> 4;
    const int dvh = item & 1, dir = (item >> 1) & 1, h = (item >> 2) & 15, b = item >> 6, sid = (b * 16 + h) * 2 + dir;
    const bf16_t* PQ = (const bf16_t*)(a->ws + WS_RB); const bf16_t* TS = (const bf16_t*)(a->ws + WS_TS); const float* GCB = (const float*)(a->ws + WS_GCB);
    bf16_t* O = (bf16_t*)(a->ws + WS_RA) + (size_t)dir * MT * 2048;
    const bf16_t* KN = (const bf16_t*)(lds + DL_KN); bf16_t* WN = (bf16_t*)(lds + DL_WN);
    const bf16_t* T1 = (const bf16_t*)(lds + DL_T1); const bf16_t* T2 = (const bf16_t*)(lds + DL_T2);
    bf16_t* AT = (bf16_t*)(lds + DL_AT); bf16_t* VN = (bf16_t*)(lds + DL_VN); bf16_t* VD = (bf16_t*)(lds + DL_VD);
    const unsigned lds_base = (unsigned)(size_t)lds;
    __syncthreads();
    for (int i = tid; i < 64 * 136 / 2; i += NT) ((unsigned*)(lds + DL_ST))[i] = 0u;
    f32x4 sacc[4];
#pragma unroll
    for (int i = 0; i < 4; ++i) sacc[i] = (f32x4){0.f, 0.f, 0.f, 0.f};
    DStage R;
    dstage_load(R, PQ, TS, GCB, sid, 0, dir, h, b, dvh, tid);
    dstage_store(R, lds, tid, 0);
    dstage_load(R, PQ, TS, GCB, sid, 1, dir, h, b, dvh, tid);
#pragma unroll 1
    for (int cidx = 0; cidx < 68; ++cidx) {
        const int par = cidx & 1;
        const bf16_t* QN = (const bf16_t*)(lds + (par ? DL_QN1 : DL_QN)); const float* GS = (const float*)(lds + (par ? DL_GS1 : DL_GS));
        const bf16_t* ST = (const bf16_t*)(lds + (par ? DL_ST1 : DL_ST)); bf16_t* STn = (bf16_t*)(lds + (par ? DL_ST : DL_ST1));
        LBAR();
        bf16x8 ktf[2];
        {
            const unsigned kb = lds_base + DL_KN + (unsigned)((8 * fq + (fr >> 2)) * 272 + (w * 16 + 4 * (fr & 3)) * 2);
            s16x4 r0, r1, r2, r3;
            TR_READ4(r0, r1, r2, r3, kb, kb + 4 * 272, kb + 32 * 272, kb + 36 * 272);
            __builtin_amdgcn_sched_barrier(0);
            ktf[0] = TR_CAT(r0, r1); ktf[1] = TR_CAT(r2, r3);
        }
        {
#pragma unroll
        for (int ti = 0; ti < 2; ++ti) {
            const int idx = w * 2 + ti, mt = idx >> 2, ct = idx & 3;
            f32x4 acc = (f32x4){0.f, 0.f, 0.f, 0.f};
            if (mt <= ct) {
#pragma unroll
                for (int kk = 0; kk < 4; ++kk) {
                    const bf16x8 af = *(const bf16x8*)(KN + (mt * 16 + fr) * 136 + kk * 32 + fq * 8), bfg = *(const bf16x8*)(QN + (ct * 16 + fr) * 136 + kk * 32 + fq * 8);
                    acc = MFMA16(af, bfg, acc);
                }
            }
            const int c = ct * 16 + fr; const float gcc = GS[c];
            float o4[4];
#pragma unroll
            for (int r = 0; r < 4; ++r) { const int m = mt * 16 + 4 * fq + r; o4[r] = (m <= c) ? acc[r] * fexpf_(gcc - GS[m]) : 0.0f; }
            *(u32x2*)(AT + c * 72 + mt * 16 + 4 * fq) = pk4(o4[0], o4[1], o4[2], o4[3]);
        }
        {
            bf16x8 af[2];
            af[0] = ktf[0]; af[1] = ktf[1];
#pragma unroll
            for (int ct = 0; ct < 4; ++ct) {
                f32x4 acc = (f32x4){0.f, 0.f, 0.f, 0.f};
#pragma unroll
                for (int kk = 0; kk < 2; ++kk) acc = MFMA16(af[kk], *(const bf16x8*)(T1 + (ct * 16 + fr) * 72 + kk * 32 + fq * 8), acc);
                *(u32x2*)(WN + (ct * 16 + fr) * 136 + w * 16 + 4 * fq) = pk4(-acc[0], -acc[1], -acc[2], -acc[3]);
            }
        }
        }
        const int ctu = w >> 1, dv0 = 2 * (w & 1);
        f32x4 uacc[2];
        {
            bf16x8 af[2];
#pragma unroll
            for (int kk = 0; kk < 2; ++kk) af[kk] = *(const bf16x8*)(T2 + (ctu * 16 + fr) * 72 + kk * 32 + fq * 8);
#pragma unroll
            for (int j = 0; j < 2; ++j) { uacc[j] = (f32x4){0.f, 0.f, 0.f, 0.f};
                const unsigned vb = lds_base + DL_VT + (unsigned)((8 * fq + (fr >> 2)) * 144 + ((dv0 + j) * 16 + 4 * (fr & 3)) * 2);
                s16x4 r0, r1, r2, r3;
                TR_READ4(r0, r1, r2, r3, vb, vb + 4 * 144, vb + 32 * 144, vb + 36 * 144);
                __builtin_amdgcn_sched_barrier(0);
                uacc[j] = MFMA16(af[0], TR_CAT(r0, r1), uacc[j]); uacc[j] = MFMA16(af[1], TR_CAT(r2, r3), uacc[j]); }
        }
        LBAR();
        if (cidx + 1 < 68) {
            dstage_store(R, lds, tid, par ^ 1);
            if (cidx + 2 < 68) dstage_load(R, PQ, TS, GCB, sid, cidx + 2, dir, h, b, dvh, tid);
        }
        {
            bf16x8 af[4];
#pragma unroll
            for (int kk = 0; kk < 4; ++kk) af[kk] = *(const bf16x8*)(WN + (ctu * 16 + fr) * 136 + kk * 32 + fq * 8);
            float ed[4];
#pragma unroll
            for (int r = 0; r < 4; ++r) ed[r] = GS[128 + ctu * 16 + 4 * fq + r];
#pragma unroll
            for (int j = 0; j < 2; ++j) {
#pragma unroll
                for (int kk = 0; kk < 4; ++kk) uacc[j] = MFMA16(af[kk], *(const bf16x8*)(ST + ((dv0 + j) * 16 + fr) * 136 + kk * 32 + fq * 8), uacc[j]);
                const int dv = (dv0 + j) * 16 + fr;
                *(u32x2*)(VN + dv * 72 + ctu * 16 + 4 * fq) = pk4(uacc[j][0], uacc[j][1], uacc[j][2], uacc[j][3]);
                *(u32x2*)(VD + dv * 72 + ctu * 16 + 4 * fq) = pk4(uacc[j][0] * ed[0], uacc[j][1] * ed[1], uacc[j][2] * ed[2], uacc[j][3] * ed[3]);
            }
        }
        LBAR();
        {
            const int dvt = w >> 1, c0 = 2 * (w & 1);
            bf16x8 af[4], vf[2];
#pragma unroll
            for (int kk = 0; kk < 4; ++kk) af[kk] = *(const bf16x8*)(ST + (dvt * 16 + fr) * 136 + kk * 32 + fq * 8);
#pragma unroll
            for (int kk = 0; kk < 2; ++kk) vf[kk] = *(const bf16x8*)(VN + (dvt * 16 + fr) * 72 + kk * 32 + fq * 8);
#pragma unroll
            for (int j = 0; j < 2; ++j) {
                const int c = (c0 + j) * 16 + fr;
                f32x4 acc = (f32x4){0.f, 0.f, 0.f, 0.f};
#pragma unroll
                for (int kk = 0; kk < 4; ++kk) acc = MFMA16(af[kk], *(const bf16x8*)(QN + c * 136 + kk * 32 + fq * 8), acc);
                const float eg = GS[64 + c];
                acc = acc * eg;
#pragma unroll
                for (int kk = 0; kk < 2; ++kk) acc = MFMA16(vf[kk], *(const bf16x8*)(AT + c * 72 + kk * 32 + fq * 8), acc);
                if (cidx >= 4) {
                    const int p = (cidx - 4) * 64 + c, tok = dir ? (SEQ - 1 - p) : p;
                    *(u32x2*)(O + (size_t)(b * SEQ + tok) * 2048 + h * 128 + dvh * 64 + dvt * 16 + 4 * fq) = pk4(acc[0], acc[1], acc[2], acc[3]);
                }
            }
        }
        {
            const float eg63 = GS[64 + 63];
            bf16x8 af[2];
            af[0] = ktf[0]; af[1] = ktf[1];
#pragma unroll
            for (int j = 0; j < 4; ++j) {
                sacc[j] = sacc[j] * eg63;
#pragma unroll
                for (int kk = 0; kk < 2; ++kk) sacc[j] = MFMA16(af[kk], *(const bf16x8*)(VD + (j * 16 + fr) * 72 + kk * 32 + fq * 8), sacc[j]);
            }
#pragma unroll
            for (int j = 0; j < 4; ++j) *(u32x2*)(STn + (j * 16 + fr) * 136 + w * 16 + 4 * fq) = pk4(sacc[j][0], sacc[j][1], sacc[j][2], sacc[j][3]);
        }
    }
    __syncthreads();
}

__device__ __attribute__((always_inline)) void ytrans_all(const bf16_t* YT, bf16_t* Y, bf16_t* tile) {
    const int tid = tid_opaque(), r = tid >> 3, c8 = (tid & 7) * 8, G = gridDim.x;
    int su = blockIdx.x;
    u32x4 pre[4];
    if (su < 2048) { const int cb = su & 31, tq = su >> 5;
#pragma unroll
        for (int j = 0; j < 4; ++j) pre[j] = __builtin_nontemporal_load((const u32x4*)(YT + (size_t)(cb * 64 + r) * MT + (tq * 4 + j) * 64 + c8)); }
    __syncthreads();
#pragma unroll 1
    for (; su < 2048; su += G) {
        const int cb = su & 31, tq = su >> 5;
#pragma unroll
        for (int j = 0; j < 4; ++j) *(u32x4*)(tile + j * 4608 + r * 72 + c8) = pre[j];
        __syncthreads();
        const int sn = su + G;
        if (sn < 2048) { const int cbn = sn & 31, tqn = sn >> 5;
#pragma unroll
            for (int j = 0; j < 4; ++j) pre[j] = __builtin_nontemporal_load((const u32x4*)(YT + (size_t)(cbn * 64 + r) * MT + (tqn * 4 + j) * 64 + c8)); }
#pragma unroll
        for (int j = 0; j < 4; ++j) {
            const bf16_t* t = tile + j * 4608;
            u32x4 w;
            w.x = (unsigned)t[(c8 + 0) * 72 + r] | ((unsigned)t[(c8 + 1) * 72 + r] << 16);
            w.y = (unsigned)t[(c8 + 2) * 72 + r] | ((unsigned)t[(c8 + 3) * 72 + r] << 16);
            w.z = (unsigned)t[(c8 + 4) * 72 + r] | ((unsigned)t[(c8 + 5) * 72 + r] << 16);
            w.w = (unsigned)t[(c8 + 6) * 72 + r] | ((unsigned)t[(c8 + 7) * 72 + r] << 16);
            *(u32x4*)(Y + (size_t)((tq * 4 + j) * 64 + r) * 2048 + cb * 64 + c8) = w;
        }
        __syncthreads();
    }
}

__device__ __attribute__((always_inline)) void p6_on(KA a) {
    const bf16_t* OF = (const bf16_t*)(a->ws + WS_RA); const bf16_t* OB = OF + (size_t)MT * 2048;
    const bf16_t* ZG = (const bf16_t*)(a->ws + WS_RB); unsigned char* ON8 = a->ws + WS_HA8; float* SON = (float*)(a->ws + WS_SON);
    const float* nw = a->in[10];
    const int lane = tid_opaque() & 63, wv = blockIdx.x * 8 + (tid_opaque() >> 6), nwv = gridDim.x * 8;
    float nwr[8];
#pragma unroll
    for (int e = 0; e < 8; ++e) nwr[e] = nw[(lane & 15) * 8 + e];
    u32x4 nf[4], ng[4], nz[4];
    if (wv < MT) {
#pragma unroll
        for (int j = 0; j < 4; ++j) { nf[j] = __builtin_nontemporal_load((const u32x4*)(OF + (size_t)wv * 2048 + j * 512 + lane * 8)); ng[j] = __builtin_nontemporal_load((const u32x4*)(OB + (size_t)wv * 2048 + j * 512 + lane * 8)); nz[j] = *(const u32x4*)(ZG + (size_t)wv * NZG + j * 512 + lane * 8); } }
#pragma unroll 1
    for (int row = wv; row < MT; row += nwv) {
        u32x4 lf[4], lg[4], lz[4];
#pragma unroll
        for (int j = 0; j < 4; ++j) { lf[j] = nf[j]; lg[j] = ng[j]; lz[j] = nz[j]; }
        const int rn = row + nwv;
        if (rn < MT) {
#pragma unroll
            for (int j = 0; j < 4; ++j) { nf[j] = __builtin_nontemporal_load((const u32x4*)(OF + (size_t)rn * 2048 + j * 512 + lane * 8)); ng[j] = __builtin_nontemporal_load((const u32x4*)(OB + (size_t)rn * 2048 + j * 512 + lane * 8)); nz[j] = *(const u32x4*)(ZG + (size_t)rn * NZG + j * 512 + lane * 8); } }
        float o[32]; float m = 0.f;
#pragma unroll
        for (int j = 0; j < 4; ++j) { float f[8], g[8], z[8]; unpack8(lf[j], f); unpack8(lg[j], g); unpack8(lz[j], z);
            float ss = 0.f;
#pragma unroll
            for (int e = 0; e < 8; ++e) { f[e] += g[e]; ss += f[e] * f[e]; }
            ss = row_sum16(ss);
            const float rs = rsqrtf(ss * (1.0f / 128.0f) + 1e-6f);
#pragma unroll
            for (int e = 0; e < 8; ++e) { const float v = f[e] * rs * nwr[e] * siluf_(z[e]); o[j * 8 + e] = v; m = fmaxf(m, fabsf(v)); } }
        m = wave_max(m);
        const float sc = (m > 0.f) ? m * (1.0f / 127.0f) : 1.0f, inv = 1.0f / sc;
#pragma unroll
        for (int j = 0; j < 4; ++j) { u32x2 w; w.x = pk4_i8(o[j * 8] * inv, o[j * 8 + 1] * inv, o[j * 8 + 2] * inv, o[j * 8 + 3] * inv); w.y = pk4_i8(o[j * 8 + 4] * inv, o[j * 8 + 5] * inv, o[j * 8 + 6] * inv, o[j * 8 + 7] * inv);
            *(u32x2*)(ON8 + (size_t)row * 2048 + j * 512 + lane * 8) = w; }
        if (lane == 0) SON[row] = sc;
    }
}
__device__ __attribute__((always_inline)) void y_quant(KA a) {
    const bf16_t* Y = (const bf16_t*)(a->ws + WS_RA) + (size_t)2 * MT * 2048; unsigned char* Y8 = a->ws + WS_WQ8; float* SY = (float*)(a->ws + WS_SY);
    const int lane = tid_opaque() & 63, wv = blockIdx.x * 8 + (tid_opaque() >> 6), nwv = gridDim.x * 8;
#pragma unroll 1
    for (int r0 = wv; r0 < MT; r0 += 2 * nwv) {
        u32x4 w[2][4]; bool ok[2];
#pragma unroll
        for (int q = 0; q < 2; ++q) { const int r = r0 + q * nwv; ok[q] = r < MT; const int rc = ok[q] ? r : r0;
#pragma unroll
            for (int j = 0; j < 4; ++j) w[q][j] = *(const u32x4*)(Y + (size_t)rc * 2048 + lane * 32 + j * 8); }
#pragma unroll
        for (int q = 0; q < 2; ++q) {
            const int r = r0 + q * nwv;
            float v[32]; float m = 0.f;
#pragma unroll
            for (int j = 0; j < 4; ++j) { float t[8]; unpack8(w[q][j], t);
#pragma unroll
                for (int e = 0; e < 8; ++e) { v[j * 8 + e] = t[e]; m = fmaxf(m, fabsf(t[e])); } }
            m = wave_max(m);
            const float sc = (m > 0.f) ? m * (1.0f / 127.0f) : 1.0f, inv = 1.0f / sc;
            u32x4 w0, w1;
#pragma unroll
            for (int p = 0; p < 4; ++p) { w0[p] = pk4_i8(v[p * 4] * inv, v[p * 4 + 1] * inv, v[p * 4 + 2] * inv, v[p * 4 + 3] * inv); w1[p] = pk4_i8(v[16 + p * 4] * inv, v[16 + p * 4 + 1] * inv, v[16 + p * 4 + 2] * inv, v[16 + p * 4 + 3] * inv); }
            if (ok[q]) { *(u32x4*)(Y8 + (size_t)r * 2048 + lane * 32) = w0; *(u32x4*)(Y8 + (size_t)r * 2048 + lane * 32 + 16) = w1; if (lane == 0) SY[r] = sc; }
        }
    }
}

constexpr size_t PEER_U8 = 0, PEER_V4 = 32 * MiB, PEER_VG = 48 * MiB, PEER_US = 64 * MiB, PEER_VS = 64 * MiB + 65536;
__device__ __attribute__((always_inline)) void p8_tables(KA a) {
    unsigned char* RAb = a->ws + WS_RA;
    const int lane = tid_opaque() & 63, wv = blockIdx.x * 8 + (tid_opaque() >> 6), nwv = gridDim.x * 8;
    {
        const float* U = a->in[27];
        f32x4 nx[8];
        if (wv < 16384) {
#pragma unroll
            for (int jj = 0; jj < 8; ++jj) nx[jj] = __builtin_nontemporal_load((const f32x4*)(U + (size_t)wv * 2048 + jj * 256 + lane * 4)); }
#pragma unroll 1
        for (int row = wv; row < 16384; row += nwv) {
            f32x4 x[8];
#pragma unroll
            for (int jj = 0; jj < 8; ++jj) x[jj] = nx[jj];
            if (row + nwv < 16384) {
#pragma unroll
                for (int jj = 0; jj < 8; ++jj) nx[jj] = __builtin_nontemporal_load((const f32x4*)(U + (size_t)(row + nwv) * 2048 + jj * 256 + lane * 4)); }
            float m = 0.f;
#pragma unroll
            for (int jj = 0; jj < 8; ++jj) m = fmaxf(m, fmaxf(fmaxf(fabsf(x[jj][0]), fabsf(x[jj][1])), fmaxf(fabsf(x[jj][2]), fabsf(x[jj][3]))));
            const float mx = wave_max(m);
            float sc = (mx > 0.f) ? mx * (1.0f / 7.0f) : 1.0f;
            {
                const float base = sc; float best = 3.0e38f;
#pragma unroll 1
                for (int k = 0; k < 7; ++k) {
                    const float sck = base * (1.0f - 0.09f * (float)k), ik = 1.0f / sck; float err = 0.f;
#pragma unroll
                    for (int j = 0; j < 8; j += 3)
#pragma unroll
                        for (int e = 0; e < 4; ++e) { float c = rintf(x[j][e] * ik); c = fminf(fmaxf(c, -7.0f), 7.0f); const float d = x[j][e] - c * sck; err += d * d; }
                    err = wave_sum(err);
                    if (err < best) { best = err; sc = sck; }
                }
            }
            const float inv = 1.0f / sc;
            unsigned char* dp = RAb + PEER_U8 + (size_t)row * 1024;
#pragma unroll
            for (int jj = 0; jj < 4; ++jj) {
                unsigned acc = 0;
#pragma unroll
                for (int e = 0; e < 4; ++e) {
                    int c0 = __float2int_rn(x[jj][e] * inv), c1 = __float2int_rn(x[4 + jj][e] * inv);
                    c0 = c0 < -7 ? -7 : (c0 > 7 ? 7 : c0); c1 = c1 < -7 ? -7 : (c1 > 7 ? 7 : c1);
                    acc |= (((unsigned)(c0 + 8)) | (((unsigned)c1 & 15u) << 4)) << (8 * e);
                }
                *(unsigned*)(dp + jj * 256 + lane * 4) = acc;
            }
            if (lane == 0) ((float*)(RAb + PEER_US))[row * 2] = sc;
        }
    }
    {
        const float* V = a->in[28];
        f32x4 nx[8];
        if (wv < 16384) {
#pragma unroll
            for (int i = 0; i < 2; ++i)
#pragma unroll
                for (int j = 0; j < 4; ++j) nx[i * 4 + j] = __builtin_nontemporal_load((const f32x4*)(V + (size_t)wv * 2048 + (4 * i + j) * 256 + lane * 4)); }
#pragma unroll 1
        for (int row = wv; row < 16384; row += nwv) {
            f32x4 x[8];
#pragma unroll
            for (int jj = 0; jj < 8; ++jj) x[jj] = nx[jj];
            if (row + nwv < 16384) {
#pragma unroll
                for (int i = 0; i < 2; ++i)
#pragma unroll
                    for (int j = 0; j < 4; ++j) nx[i * 4 + j] = __builtin_nontemporal_load((const f32x4*)(V + (size_t)(row + nwv) * 2048 + (4 * i + j) * 256 + lane * 4)); }
            float gmx[2];
#pragma unroll
            for (int i = 0; i < 2; ++i) { float m = 0.f;
#pragma unroll
                for (int j = 0; j < 4; ++j) m = fmaxf(m, fmaxf(fmaxf(fabsf(x[i * 4 + j][0]), fabsf(x[i * 4 + j][1])), fmaxf(fabsf(x[i * 4 + j][2]), fabsf(x[i * 4 + j][3]))));
                gmx[i] = m; }
            const float mx = wave_max(fmaxf(gmx[0], gmx[1]));
            const float rmx = (mx > 0.f) ? mx : 1.0f;
#pragma unroll
            for (int i = 0; i < 2; ++i) {
                int m = (int)ceilf(gmx[i] * (255.0f / rmx)); m = m < 1 ? 1 : (m > 255 ? 255 : m);
                const float inv = (7.0f * 255.0f) / (rmx * (float)m);
                unsigned q[16];
#pragma unroll
                for (int j = 0; j < 4; ++j)
#pragma unroll
                    for (int e = 0; e < 4; ++e) { int c = __float2int_rn(x[i * 4 + j][e] * inv); c = c < -7 ? -7 : (c > 7 ? 7 : c); q[j * 4 + e] = (unsigned)(c + 8); }
                u32x2 w;
                w.x = (q[0] | ((q[4] ^ 8u) << 4)) | ((q[1] | ((q[5] ^ 8u) << 4)) << 8) | ((q[2] | ((q[6] ^ 8u) << 4)) << 16) | ((q[3] | ((q[7] ^ 8u) << 4)) << 24);
                w.y = (q[8] | ((q[12] ^ 8u) << 4)) | ((q[9] | ((q[13] ^ 8u) << 4)) << 8) | ((q[10] | ((q[14] ^ 8u) << 4)) << 16) | ((q[11] | ((q[15] ^ 8u) << 4)) << 24);
                *(u32x2*)(RAb + PEER_V4 + (size_t)row * 1024 + lane * 16 + i * 8) = w;
                (RAb + PEER_VG)[(size_t)row * 128 + lane * 2 + i] = (unsigned char)m;
            }
            if (lane == 0) ((float*)(RAb + PEER_US))[row * 2 + 1] = rmx * (1.0f / (7.0f * 255.0f));
        }
    }
}

__device__ __attribute__((always_inline)) void p9_ln1(KA a) {
    const float* mod = (const float*)(a->ws + WS_MOD); unsigned char* H8 = a->ws + WS_RA + (size_t)2 * MT * 2048 * 2; float* SH2 = (float*)(a->ws + WS_SH2);
    const int lane = tid_opaque() & 63, wv = blockIdx.x * 8 + (tid_opaque() >> 6), nwv = gridDim.x * 8;
    float* P9 = (float*)g_lds;
    __syncthreads();
    for (int i = tid_opaque(); i < 10 * 512; i += NT) { const int r = i >> 9, c4 = (i & 511) * 4;
        const float* src = (r == 0) ? a->in[23] + c4 : (r == 1) ? a->in[24] + c4 : mod + ((r - 2) >> 1) * 12288 + (((r - 2) & 1) ? 8192 : 6144) + c4;
        *(f32x4*)(P9 + r * 2048 + c4) = *(const f32x4*)src; }
    __syncthreads();
    for (int row = wv; row < MT; row += nwv) {
        bf16_t* rp = (bf16_t*)(a->ws + WS_XN) + (size_t)row * 2048;
        float v[32]; float s = 0.f;
#pragma unroll
        for (int i = 0; i < 4; ++i) { float t8[8]; unpack8(*(const u32x4*)(rp + i * 512 + lane * 8), t8);
#pragma unroll
            for (int e = 0; e < 8; ++e) { v[i * 8 + e] = t8[e]; s += t8[e]; } }
        const float mu = wave_sum(s) * (1.0f / 2048.0f);
        float q = 0.f;
#pragma unroll
        for (int e = 0; e < 32; ++e) { const float d = v[e] - mu; q += d * d; }
        const float rstd = rsqrtf(wave_sum(q) * (1.0f / 2048.0f) + 1e-5f);
        const float* psh = P9 + (2 + 2 * (row >> 12)) * 2048; const float* psc = psh + 2048;
        float hm = 0.f;
#pragma unroll
        for (int i = 0; i < 4; ++i) {
            const int col = i * 512 + lane * 8;
            float xn[8];
            const f32x4 g0 = *(const f32x4*)(P9 + col), g1 = *(const f32x4*)(P9 + col + 4), b0 = *(const f32x4*)(P9 + 2048 + col), b1 = *(const f32x4*)(P9 + 2048 + col + 4);
            const f32x4 c0 = *(const f32x4*)(psc + col), c1 = *(const f32x4*)(psc + col + 4), h0 = *(const f32x4*)(psh + col), h1 = *(const f32x4*)(psh + col + 4);
#pragma unroll
            for (int e = 0; e < 8; ++e) { const float gg = e < 4 ? g0[e & 3] : g1[e & 3], bv = e < 4 ? b0[e & 3] : b1[e & 3], cc = e < 4 ? c0[e & 3] : c1[e & 3], hh = e < 4 ? h0[e & 3] : h1[e & 3];
                xn[e] = (v[i * 8 + e] - mu) * rstd * gg + bv; const float h = xn[e] * (1.0f + cc) + hh; v[i * 8 + e] = h; hm = fmaxf(hm, fabsf(h)); }
            *(u32x4*)(rp + col) = pack8(xn);
        }
        hm = wave_max(hm);
        const float sc = (hm > 0.f) ? hm * (1.0f / 127.0f) : 1.0f, inv = 1.0f / sc;
#pragma unroll
        for (int i = 0; i < 4; ++i) { u32x2 o; o.x = pk4_i8(v[i * 8] * inv, v[i * 8 + 1] * inv, v[i * 8 + 2] * inv, v[i * 8 + 3] * inv); o.y = pk4_i8(v[i * 8 + 4] * inv, v[i * 8 + 5] * inv, v[i * 8 + 6] * inv, v[i * 8 + 7] * inv);
            *(u32x2*)(H8 + (size_t)row * 2048 + i * 512 + lane * 8) = o; }
        if (lane == 0) SH2[row] = sc;
    }
    {
        const bf16_t* WPT = (const bf16_t*)(a->ws + WS_SW) + (size_t)3 * D * D; unsigned char* WP8 = a->ws + WS_WP8; const float* pmx = (const float*)(a->ws + WS_WPMAX); float* swf = (float*)(a->ws + WS_SWF) + 18688 + 2048;
        for (int r = wv; r < 2048; r += nwv) {
            float m = (lane < 16) ? pmx[(size_t)r * 16 + lane] : 0.f; m = wave_max(m);
            const float sc = (m > 0.f) ? m * (1.0f / 127.0f) : 1.0f, inv = 1.0f / sc;
#pragma unroll
            for (int j = 0; j < 4; ++j) { float t[8]; unpack8(*(const u32x4*)(WPT + (size_t)r * 2048 + j * 512 + lane * 8), t);
                u32x2 o; o.x = pk4_i8(t[0] * inv, t[1] * inv, t[2] * inv, t[3] * inv); o.y = pk4_i8(t[4] * inv, t[5] * inv, t[6] * inv, t[7] * inv);
                *(u32x2*)(WP8 + (size_t)r * 2048 + j * 512 + lane * 8) = o; }
            if (lane == 0) swf[r] = sc;
        }
    }
}

__device__ __forceinline__ float row_max16(float v) {
    v = fmaxf(v, __builtin_bit_cast(float, __builtin_amdgcn_update_dpp(0, __builtin_bit_cast(int, v), 0x128, 0xf, 0xf, false)));
    v = fmaxf(v, __builtin_bit_cast(float, __builtin_amdgcn_update_dpp(0, __builtin_bit_cast(int, v), 0x124, 0xf, 0xf, false)));
    v = fmaxf(v, __builtin_bit_cast(float, __builtin_amdgcn_update_dpp(0, __builtin_bit_cast(int, v), 0x122, 0xf, 0xf, false)));
    v = fmaxf(v, __builtin_bit_cast(float, __builtin_amdgcn_update_dpp(0, __builtin_bit_cast(int, v), 0x121, 0xf, 0xf, false)));
    return v;
}
__device__ __forceinline__ float row_sum16(float v) {
    v += __builtin_bit_cast(float, __builtin_amdgcn_update_dpp(0, __builtin_bit_cast(int, v), 0x128, 0xf, 0xf, false));
    v += __builtin_bit_cast(float, __builtin_amdgcn_update_dpp(0, __builtin_bit_cast(int, v), 0x124, 0xf, 0xf, false));
    v += __builtin_bit_cast(float, __builtin_amdgcn_update_dpp(0, __builtin_bit_cast(int, v), 0x122, 0xf, 0xf, false));
    v += __builtin_bit_cast(float, __builtin_amdgcn_update_dpp(0, __builtin_bit_cast(int, v), 0x121, 0xf, 0xf, false));
    return v;
}
__device__ __forceinline__ int row_sum16i(int v) {
    v += __builtin_amdgcn_update_dpp(0, v, 0x128, 0xf, 0xf, false);
    v += __builtin_amdgcn_update_dpp(0, v, 0x124, 0xf, 0xf, false);
    v += __builtin_amdgcn_update_dpp(0, v, 0x122, 0xf, 0xf, false);
    v += __builtin_amdgcn_update_dpp(0, v, 0x121, 0xf, 0xf, false);
    return v;
}
template <int NCH, int NV> __device__ __forceinline__ void topk16_row16(float (&x)[NCH][NV], int s, int g, float (&rs)[NCH], int (&ri)[NCH]) {
#pragma unroll
    for (int c = 0; c < NCH; ++c) { rs[c] = -INFINITY; ri[c] = 0; }
#pragma unroll 1
    for (int it = 0; it < 16; ++it) {
#pragma unroll
        for (int c = 0; c < NCH; ++c) {
            float m = x[c][0];
#pragma unroll
            for (int j = 1; j < NV; ++j) m = fmaxf(m, x[c][j]);
            const float wm = row_max16(m);
            const unsigned long long bal = __ballot(m == wm);
            const unsigned seg = (unsigned)(bal >> (16 * g)) & 0xffffu;
            const bool iswin = (s == (__ffs((int)seg) - 1));
            int jsel = 0;
#pragma unroll
            for (int j = NV - 1; j >= 0; --j) { const bool e = (x[c][j] == wm); jsel = e ? j : jsel; x[c][j] = (e && iswin) ? -INFINITY : x[c][j]; }
            const int key = row_sum16i(iswin ? (s * NV + jsel) : 0);
            if (s == it) { rs[c] = wm; ri[c] = key; }
        }
    }
}
template <int NV> __device__ __forceinline__ void lane_sort_desc(float (&x)[NV]);
template <> __device__ __forceinline__ void lane_sort_desc<8>(float (&x)[8]) {
#define CE_(i, j) do { const float _a = x[i], _b = x[j]; x[i] = fmaxf(_a, _b); x[j] = fminf(_a, _b); } while (0)
    CE_(0, 1); CE_(2, 3); CE_(4, 5); CE_(6, 7); CE_(0, 2); CE_(1, 3); CE_(4, 6); CE_(5, 7); CE_(1, 2); CE_(5, 6);
    CE_(0, 4); CE_(1, 5); CE_(2, 6); CE_(3, 7); CE_(2, 4); CE_(3, 5); CE_(1, 2); CE_(3, 4); CE_(5, 6);
}
template <> __device__ __forceinline__ void lane_sort_desc<4>(float (&x)[4]) {
    CE_(0, 1); CE_(2, 3); CE_(0, 2); CE_(1, 3); CE_(1, 2);
#undef CE_
}
template <int NCH, int NV> __device__ __forceinline__ void topk16_sorted(float (&x)[NCH][NV], int s, float (&rs)[NCH]) {
#pragma unroll
    for (int c = 0; c < NCH; ++c) { lane_sort_desc<NV>(x[c]); rs[c] = -INFINITY; }
#pragma unroll 1
    for (int it = 0; it < 16; ++it) {
#pragma unroll
        for (int c = 0; c < NCH; ++c) {
            const float wm = row_max16(x[c][0]);
            const bool win = (x[c][0] == wm);
#pragma unroll
            for (int j = 0; j < NV - 1; ++j) x[c][j] = win ? x[c][j + 1] : x[c][j];
            x[c][NV - 1] = win ? -INFINITY : x[c][NV - 1];
            if (s == it) rs[c] = wm;
        }
    }
}
__device__ __forceinline__ float embed_idx(float v, unsigned idx, unsigned mask) { return __uint_as_float((__float_as_uint(v) & ~mask) | idx); }
__device__ __forceinline__ int fkey(float v) { const int b = __float_as_int(v); return b ^ ((b >> 31) & 0x7fffffff); }
__device__ __forceinline__ float fkey_inv(int k) { return __int_as_float(k ^ ((k >> 31) & 0x7fffffff)); }
__device__ __forceinline__ int imax_(int a, int b) { return a > b ? a : b; }
__device__ __forceinline__ int imin_(int a, int b) { return a < b ? a : b; }
__device__ __forceinline__ int row_max16i(int v) {
    v = imax_(v, __builtin_amdgcn_update_dpp((int)0x80000000, v, 0x128, 0xf, 0xf, false));
    v = imax_(v, __builtin_amdgcn_update_dpp((int)0x80000000, v, 0x124, 0xf, 0xf, false));
    v = imax_(v, __builtin_amdgcn_update_dpp((int)0x80000000, v, 0x122, 0xf, 0xf, false));
    v = imax_(v, __builtin_amdgcn_update_dpp((int)0x80000000, v, 0x121, 0xf, 0xf, false));
    return v;
}
template <int NV> __device__ __forceinline__ void lane_sort_desc_i(int (&x)[NV]);
template <> __device__ __forceinline__ void lane_sort_desc_i<8>(int (&x)[8]) {
#define CE_(i, j) do { const int _a = x[i], _b = x[j]; x[i] = imax_(_a, _b); x[j] = imin_(_a, _b); } while (0)
    CE_(0, 1); CE_(2, 3); CE_(4, 5); CE_(6, 7); CE_(0, 2); CE_(1, 3); CE_(4, 6); CE_(5, 7); CE_(1, 2); CE_(5, 6);
    CE_(0, 4); CE_(1, 5); CE_(2, 6); CE_(3, 7); CE_(2, 4); CE_(3, 5); CE_(1, 2); CE_(3, 4); CE_(5, 6);
}
template <> __device__ __forceinline__ void lane_sort_desc_i<4>(int (&x)[4]) {
    CE_(0, 1); CE_(2, 3); CE_(0, 2); CE_(1, 3); CE_(1, 2);
#undef CE_
}
template <int NCH, int NV> __device__ __forceinline__ void topk16_sorted_i(int (&x)[NCH][NV], int s, int (&rs)[NCH]) {
#pragma unroll
    for (int c = 0; c < NCH; ++c) { lane_sort_desc_i<NV>(x[c]); rs[c] = (int)0x80000000; }
#pragma unroll 1
    for (int it = 0; it < 16; ++it) {
#pragma unroll
        for (int c = 0; c < NCH; ++c) {
            const int wm = row_max16i(x[c][0]);
            const bool win = (x[c][0] == wm);
#pragma unroll
            for (int j = 0; j < NV - 1; ++j) x[c][j] = win ? x[c][j + 1] : x[c][j];
            x[c][NV - 1] = win ? (int)0x80000000 : x[c][NV - 1];
            if (s == it) rs[c] = wm;
        }
    }
}
__device__ __attribute__((always_inline)) void peer_unit(KA a, int unit, unsigned char* lds) {
    const int tid = tid_opaque(), lane = tid & 63, wid = tid >> 6, fr = lane & 15, fq = lane >> 4;
    float* SC = (float*)lds;
    int* IGI = (int*)(lds + 65536); float* IGG = (float*)(lds + 98304);
    float* TL = (float*)(lds + 131072); int* TI = (int*)(lds + 139264);
    const int tok0 = unit * 64;
    const bf16_t* Qp = (const bf16_t*)(a->ws + WS_RB); const float* subk = a->in[26]; (void)subk;
    const unsigned char* H8 = a->ws + WS_RA + (size_t)2 * MT * 2048 * 2; const float* SH2 = (const float*)(a->ws + WS_SH2);
    const float* mod = (const float*)(a->ws + WS_MOD);
    int sti[4], stj[4];
#pragma unroll
    for (int q = 0; q < 4; ++q) {
        const int t = fr * 4 + q; int acc = 0, ii = -1, jj = 0;
#pragma unroll
        for (int i = 0; i < 16; ++i) { const int cnt = 16 / (i + 1); if (ii < 0 && t < acc + cnt) { ii = i; jj = t - acc; } acc += cnt; }
        sti[q] = ii; stj[q] = jj;
    }
    int* STP = (int*)(lds + 16384);
    float* PV = (float*)(lds + 20480);
    { const float* g2p = mod + (tok0 >> 12) * 12288 + 10240; const float* gmp = a->in[29]; const float* btp = a->in[30];
      for (int c = tid; c < 2048; c += NT) { PV[c] = g2p[c]; PV[2048 + c] = gmp[c]; PV[4096 + c] = btp[c]; } }
    if (tid < 16) {
#pragma unroll
        for (int q = 0; q < 4; ++q) STP[fr * 4 + q] = (sti[q] & 15) | (stj[q] << 4);
    }
    __syncthreads();
    float nx[4][8];
#pragma unroll
    for (int c = 0; c < 4; ++c) { const bf16_t* sp = Qp + (size_t)(tok0 + wid * 8 + (c >> 1) * 4 + fq) * 2048 + (c & 1) * 128 + fr * 8;
        unpack8(*(const u32x4*)sp, nx[c]); }
#pragma unroll 1
    for (int hh = 0; hh < 8; ++hh) { const int h = hh;
        {
            int x[4][8]; int ts[4];
#pragma unroll
            for (int c = 0; c < 4; ++c)
#pragma unroll
                for (int j = 0; j < 8; ++j) x[c][j] = (fkey(nx[c][j]) & ~127) | (fr * 8 + j);
            {
                const int hn = (hh + 1) & 7;
#pragma unroll
                for (int c = 0; c < 4; ++c) { const bf16_t* sp = Qp + (size_t)(tok0 + wid * 8 + (c >> 1) * 4 + fq) * 2048 + (hn * 2 + (c & 1)) * 128 + fr * 8;
                    unpack8(*(const u32x4*)sp, nx[c]); }
            }
            topk16_sorted_i<4, 8>(x, fr, ts);
#pragma unroll
            for (int c = 0; c < 4; ++c) { const int tkc = wid * 8 + (c >> 1) * 4 + fq, p = c & 1; TL[(tkc * 2 + p) * 16 + fr] = fkey_inv(ts[c]); TI[(tkc * 2 + p) * 16 + fr] = ts[c] & 127; }
            asm volatile("s_waitcnt lgkmcnt(0)" ::: "memory");
            int cnd[2][4]; int bsi[2]; float bs[2]; int bc[2];
#pragma unroll
            for (int g = 0; g < 2; ++g) { const int tk = wid * 8 + g * 4 + fq;
#pragma unroll
                for (int q = 0; q < 4; ++q) cnd[g][q] = (sti[q] >= 0) ? ((fkey(TL[(tk * 2 + 0) * 16 + (sti[q] & 15)] + TL[(tk * 2 + 1) * 16 + stj[q]]) & ~63) | (fr * 4 + q)) : (int)0x80000000; }
            topk16_sorted_i<2, 4>(cnd, fr, bsi);
#pragma unroll
            for (int g = 0; g < 2; ++g) { bc[g] = bsi[g] & 63; bs[g] = fkey_inv(bsi[g]); }
#pragma unroll
            for (int g = 0; g < 2; ++g) {
                const int tk = wid * 8 + g * 4 + fq;
                const int pij = STP[bc[g]], pi = pij & 15, pj = pij >> 4;
                const int e0 = TI[(tk * 2 + 0) * 16 + pi], e1 = TI[(tk * 2 + 1) * 16 + pj];
                const float mx = fkey_inv(row_max16i(bsi[g]));
                const float ex = fexpf_(bs[g] - mx);
                const float sm = row_sum16(ex);
                IGI[tk * 128 + h * 16 + fr] = e0 * 128 + e1; IGG[tk * 128 + h * 16 + fr] = ex * __builtin_amdgcn_rcpf(sm);
            }
            asm volatile("s_waitcnt lgkmcnt(0)" ::: "memory");
        }
    }
    const unsigned char* U8 = a->ws + WS_RA + PEER_U8; const unsigned char* V4 = a->ws + WS_RA + PEER_V4; const unsigned short* VG = (const unsigned short*)(a->ws + WS_RA + PEER_VG);
    const f32x2* USV = (const f32x2*)(a->ws + WS_RA + PEER_US);
#pragma unroll 1
    for (int rr = 0; rr < 8; ++rr) {
        const int row = wid * 8 + rr, tok = tok0 + row;
        int hq[8];
        { const u32x4 q0 = *(const u32x4*)(H8 + (size_t)tok * 2048 + lane * 16), q1 = *(const u32x4*)(H8 + (size_t)tok * 2048 + 1024 + lane * 16);
          hq[0] = (int)q0.x; hq[1] = (int)q0.y; hq[2] = (int)q0.z; hq[3] = (int)q0.w; hq[4] = (int)q1.x; hq[5] = (int)q1.y; hq[6] = (int)q1.z; hq[7] = (int)q1.w; }
        const float shq = SH2[tok];
        int yl[16], yf[16];
#pragma unroll
        for (int e = 0; e < 16; ++e) { yl[e] = 0; yf[e] = 0; }
        int cs0 = 0, cs1 = 0; float qscale = 0.f;
#if DBG_MODE != 2
        const int* ip = IGI + row * 128; float* gp = IGG + row * 128;
        float cmax = 0.f;
        {
            typedef int v4i __attribute__((ext_vector_type(4)));
            unsigned char* HQ = lds + wid * 2048;
            *(v4i*)(HQ + lane * 16) = (v4i){hq[0], hq[1], hq[2], hq[3]}; *(v4i*)(HQ + 1024 + lane * 16) = (v4i){hq[4], hq[5], hq[6], hq[7]};
            const int el0 = 4 * fr + fq;
            const int ix0 = ip[el0], ix1 = ip[el0 + 64];
            const f32x2 sv0 = USV[ix0], sv1 = USV[ix1]; const float us0 = sv0.x, us1 = sv1.x, vs0 = sv0.y, vs1 = sv1.y;
            const int hoff = 64 * fq + 16 * (lane & 3), ea = (lane >> 2) & 3;
            const int hslo = (int)wave_sum((float)__builtin_amdgcn_sdot4(hq[0], 0x01010101, __builtin_amdgcn_sdot4(hq[1], 0x01010101, __builtin_amdgcn_sdot4(hq[2], 0x01010101, __builtin_amdgcn_sdot4(hq[3], 0x01010101, 0, false), false), false), false));
            v4i Bf[8];
#pragma unroll
            for (int t = 0; t < 8; ++t) Bf[t] = *(const v4i*)(HQ + 256 * t + hoff);
            v4i A0[4], A1[4], A2[4], A3[4];
#define PEER_LD(A_, g_) do { const unsigned char* p_ = U8 + (unsigned)(ip[4 * (g_) + ea] * 1024 + hoff); _Pragma("unroll") for (int t = 0; t < 4; ++t) A_[t] = *(const v4i*)(p_ + 256 * t); } while (0)
            PEER_LD(A0, 0); PEER_LD(A1, 1); PEER_LD(A2, 2);
            int m0 = 0, m1 = 0;
#define PEER_MM(A_) ({ v4i c0_ = {0, 0, 0, 0}, c1_ = {0, 0, 0, 0}; \
                v4i c2_ = {0, 0, 0, 0};   \
                _Pragma("unroll") for (int t = 0; t < 4; ++t) { const v4i hi_m = A_[t] & (int)0xF0F0F0F0u; c0_ = __builtin_amdgcn_mfma_i32_16x16x64_i8(A_[t], Bf[t], c0_, 0, 0, 0); c1_ = __builtin_amdgcn_mfma_i32_16x16x64_i8(hi_m, Bf[4 + t], c1_, 0, 0, 0); c2_ = __builtin_amdgcn_mfma_i32_16x16x64_i8(hi_m, Bf[t], c2_, 0, 0, 0); } \
                c0_ += (c1_ >> 4) - c2_; const int lo_ = (lane & 1) ? c0_[1] : c0_[0], hi_ = (lane & 1) ? c0_[3] : c0_[2]; int v_ = (lane & 2) ? hi_ : lo_; \
                v_ += __builtin_amdgcn_update_dpp(0, v_, 0xB1, 0xf, 0xf, false); v_ += __builtin_amdgcn_update_dpp(0, v_, 0x4E, 0xf, 0xf, false); v_; })
#pragma unroll 1
            for (int gi = 0; gi < 32; gi += 4) {
                PEER_LD(A3, gi + 3);
                const int v0 = PEER_MM(A0);
                if (gi + 4 < 32) PEER_LD(A0, gi + 4);
                const int v1 = PEER_MM(A1);
                if (gi + 4 < 32) PEER_LD(A1, gi + 5);
                const int v2 = PEER_MM(A2);
                if (gi + 4 < 32) PEER_LD(A2, gi + 6);
                const int v3 = PEER_MM(A3);
                const int gl = gi & 15; int mm = (gi < 16) ? m0 : m1;
                mm = (gl == fr) ? v0 : mm; mm = (gl + 1 == fr) ? v1 : mm; mm = (gl + 2 == fr) ? v2 : mm; mm = (gl + 3 == fr) ? v3 : mm;
                if (gi < 16) m0 = mm; else m1 = mm;
            }
#undef PEER_LD
#undef PEER_MM
            const float dot0 = us0 * shq * (float)(m0 - 8 * hslo), dot1 = us1 * shq * (float)(m1 - 8 * hslo);
            const float c1a = gp[el0] * 0.5f * dot0 * (1.0f + erff(dot0 * 0.7071067811865476f)) * vs0, c1b = gp[el0 + 64] * 0.5f * dot1 * (1.0f + erff(dot1 * 0.7071067811865476f)) * vs1;
            cmax = wave_max(fmaxf(fabsf(c1a), fabsf(c1b)));
            asm volatile("s_waitcnt lgkmcnt(0)" ::: "memory");
            gp[el0] = c1a; gp[el0 + 64] = c1b;
        }
        asm volatile("s_waitcnt lgkmcnt(0)" ::: "memory");
        qscale = (cmax > 0.f) ? (127.0f / (cmax * 255.0f)) : 0.f;
        {
            const float qk = qscale * (256.0f / 32767.0f);
            u32x2 va[PB][2], vb[PB][2]; unsigned ga[PB], gb[PB];
#define PEER_LOADV(V_, G_, e_) do { _Pragma("unroll") for (int k = 0; k < PB; ++k) { const int idx_ = __builtin_amdgcn_readfirstlane(ip[(e_) + k]); const unsigned char* vp_ = V4 + (unsigned)(idx_ * 1024 + lane * 16);     \
                { const u32x4 vv_ = *(const u32x4*)vp_; V_[k][0] = (u32x2){vv_.x, vv_.y}; V_[k][1] = (u32x2){vv_.z, vv_.w}; } G_[k] = *(const unsigned short*)((const unsigned char*)VG + (unsigned)(idx_ * 128 + lane * 2)); } } while (0)
#define PEER_MATHV(V_, G_, e_) do { _Pragma("unroll") for (int qd = 0; qd < PB / 4; ++qd) { \
                const f32x4 c4 = *(const f32x4*)(gp + (e_) + qd * 4); \
                float cq4[4]; _Pragma("unroll") for (int k = 0; k < 4; ++k) cq4[k] = c4[k] * qk; \
                _Pragma("unroll") for (int i = 0; i < 2; ++i) { \
                      \
                    float f[4]; _Pragma("unroll") for (int k = 0; k < 4; ++k) f[k] = fmaf(cq4[k], (float)((G_[qd * 4 + k] >> (8 * i)) & 255u), 128.0f / 32767.0f); \
                    const unsigned d01 = __builtin_bit_cast(unsigned, __builtin_amdgcn_cvt_pknorm_i16(f[0], f[1])), d23 = __builtin_bit_cast(unsigned, __builtin_amdgcn_cvt_pknorm_i16(f[2], f[3])); \
                    const int C = (int)__builtin_amdgcn_perm(d23, d01, 0x07050301u); \
                    if (i == 0) cs0 = __builtin_amdgcn_sdot4(C, 0x01010101, cs0, false); else cs1 = __builtin_amdgcn_sdot4(C, 0x01010101, cs1, false); \
                    _Pragma("unroll") for (int j = 0; j < 2; ++j) { \
                        const unsigned W0 = V_[qd * 4 + 0][i][j], W1 = V_[qd * 4 + 1][i][j], W2 = V_[qd * 4 + 2][i][j], W3 = V_[qd * 4 + 3][i][j]; \
                        const unsigned p01a = __builtin_amdgcn_perm(W1, W0, 0x05010400u), p01b = __builtin_amdgcn_perm(W1, W0, 0x07030602u); \
                        const unsigned p23a = __builtin_amdgcn_perm(W3, W2, 0x05010400u), p23b = __builtin_amdgcn_perm(W3, W2, 0x07030602u); \
                        unsigned T[4]; \
                        T[0] = __builtin_amdgcn_perm(p23a, p01a, 0x05040100u); T[1] = __builtin_amdgcn_perm(p23a, p01a, 0x07060302u); \
                        T[2] = __builtin_amdgcn_perm(p23b, p01b, 0x05040100u); T[3] = __builtin_amdgcn_perm(p23b, p01b, 0x07060302u); \
                        _Pragma("unroll") for (int b = 0; b < 4; ++b) { \
                            yf[(i * 2 + j) * 4 + b] = __builtin_amdgcn_sdot4((int)T[b], C, yf[(i * 2 + j) * 4 + b], false); \
                            yl[(i * 2 + j) * 4 + b] = __builtin_amdgcn_sdot4((int)(T[b] & 0x0F0F0F0Fu), C, yl[(i * 2 + j) * 4 + b], false); } } } } } while (0)
            PEER_LOADV(va, ga, 0); PEER_LOADV(vb, gb, PB);
#pragma unroll 1
            for (int e = 0; e < 128; e += 2 * PB) {
                PEER_MATHV(va, ga, e);
                if (e + 2 * PB < 128) PEER_LOADV(va, ga, e + 2 * PB);
                PEER_MATHV(vb, gb, e + PB);
                if (e + 3 * PB < 128) PEER_LOADV(vb, gb, e + 3 * PB);
            }
#undef PEER_LOADV
#undef PEER_MATHV
        }
#endif
        float yq[32];
        {
            const float inv = (qscale > 0.f) ? (1.0f / qscale) : 0.f;
#pragma unroll
            for (int i = 0; i < 2; ++i)
#pragma unroll
                for (int j = 0; j < 2; ++j)
#pragma unroll
                    for (int b = 0; b < 4; ++b) { const int t = (i * 2 + j) * 4 + b;
                        yq[i * 16 + j * 8 + b] = (float)(yl[t] - 8 * (i ? cs1 : cs0)) * inv; yq[i * 16 + j * 8 + 4 + b] = (float)(yf[t] - yl[t]) * (inv * 0.0625f); }
        }
        const float csum2[2] = {0.f, 0.f};
        float* rp = a->out + (size_t)tok * 2048; const bf16_t* xp = (const bf16_t*)(a->ws + WS_XN) + (size_t)tok * 2048;
        float val[32]; float s = 0.f;
#pragma unroll
        for (int i = 0; i < 2; ++i)
#pragma unroll
            for (int j = 0; j < 4; ++j) { const int col = (4 * i + j) * 256 + lane * 4; const u32x2 xw = *(const u32x2*)(xp + col); const f32x4 x0 = (f32x4){bflo(xw.x), bfhi(xw.x), bflo(xw.y), bfhi(xw.y)}, g0 = *(const f32x4*)(PV + col);
#pragma unroll
                for (int e = 0; e < 4; ++e) { const float v = ALPHA * x0[e] + g0[e] * (yq[i * 16 + j * 4 + e] - 8.0f * csum2[i]); val[i * 16 + j * 4 + e] = v; s += v; } }
        const float mu = wave_sum(s) * (1.0f / 2048.0f);
        float q = 0.f;
#pragma unroll
        for (int e = 0; e < 32; ++e) { const float d = val[e] - mu; q += d * d; }
        const float rstd = rsqrtf(wave_sum(q) * (1.0f / 2048.0f) + 1e-5f);
#pragma unroll
        for (int i = 0; i < 2; ++i)
#pragma unroll
            for (int j = 0; j < 4; ++j) { const int col = (4 * i + j) * 256 + lane * 4; const f32x4 gg = *(const f32x4*)(PV + 2048 + col), bv = *(const f32x4*)(PV + 4096 + col); f32x4 o;
#pragma unroll
                for (int e = 0; e < 4; ++e) o[e] = (val[i * 16 + j * 4 + e] - mu) * rstd * gg[e] + bv[e];
                *(f32x4*)(rp + col) = o; }
    }
    __syncthreads();
}

constexpr size_t WS_BAR = 699 * MiB;

constexpr int XB_TMO = 128, XB_TOP = 3328, XB_TOPGEN = 3392, XCD_BAR_WORDS = 3456;
#define XB_XCNT(j) (256 + 64 * (j))
#define XB_XSUB(j) (1280 + 64 * (j))
#define XB_XGEN(j) (2304 + 64 * (j))
constexpr int XB_ST_OFF = TIDTAB_OFF - 16;
constexpr unsigned XB_SPIN_CAP = 1u << 18;
__device__ __forceinline__ unsigned xb_ld(unsigned* p) { return __hip_atomic_load(p, __ATOMIC_RELAXED, __HIP_MEMORY_SCOPE_AGENT); }
__device__ __forceinline__ unsigned xb_add(unsigned* p, unsigned v) { return __hip_atomic_fetch_add(p, v, __ATOMIC_RELAXED, __HIP_MEMORY_SCOPE_AGENT); }
__device__ __forceinline__ unsigned xb_xcc_id() { return (unsigned)__builtin_amdgcn_s_getreg((3 << 11) | 20) & 0xFu; }
#define XB_SPIN(cond, bar) do { unsigned _sp = 0; while (cond) { __builtin_amdgcn_s_sleep(1); \
    if ((++_sp & 255u) == 0u) { if (xb_ld(&(bar)[XB_TMO])) break; if (_sp > XB_SPIN_CAP) { xb_add(&(bar)[XB_TMO], 1u); break; } } } } while (0)
__device__ __forceinline__ void xcd_census_post(unsigned* bar) { if (tid_opaque() == 0) (void)xb_add(&bar[XB_XCNT(xb_xcc_id())], 1u); }
__device__ __forceinline__ void xcd_barrier_complete(unsigned* bar, unsigned x, unsigned& nloc, unsigned& nx) {
    const unsigned G = gridDim.x;
    unsigned sum, cnt, mine, sp = 0u;
    for (;;) {
        sum = 0u; cnt = 0u; mine = 0u;
#pragma unroll
        for (unsigned j = 0; j < 16; ++j) { const unsigned c = xb_ld(&bar[XB_XCNT(j)]); sum += c; cnt += (c > 0u) ? 1u : 0u; mine = (j == x) ? c : mine; }
        if (sum == G) break;
        __builtin_amdgcn_s_sleep(1);
        if ((++sp & 255u) == 0u) { if (xb_ld(&bar[XB_TMO])) break; if (sp > XB_SPIN_CAP) { xb_add(&bar[XB_TMO], 1u); break; } }
    }
    nloc = mine > 0u ? mine : 1u; nx = cnt > 0u ? cnt : 1u;
}
__device__ __forceinline__ void grid_bar(unsigned* bar) {
    asm volatile("s_waitcnt vmcnt(0)" ::: "memory");
    __syncthreads();
    if (tid_opaque() == 0) {
        volatile unsigned* st = (volatile unsigned*)(g_lds + XB_ST_OFF);
        const unsigned x = xb_xcc_id();
        __builtin_amdgcn_s_waitcnt(0);
        unsigned nloc = st[0], nx = st[1];
        if (nloc == 0u) { xcd_barrier_complete(bar, x, nloc, nx); st[0] = nloc; st[1] = nx; }
        const unsigned old = xb_add(&bar[XB_XSUB(x)], 1u);
        const unsigned gen = old / nloc;
        if (old + 1u == (gen + 1u) * nloc) {
            __builtin_amdgcn_fence(__ATOMIC_RELEASE, "agent");
            asm volatile("s_waitcnt vmcnt(0)" ::: "memory");
            const unsigned og = xb_add(&bar[XB_TOP], 1u);
            const unsigned tg = og / nx;
            if (og + 1u == (tg + 1u) * nx) xb_add(&bar[XB_TOPGEN], 1u);
            else XB_SPIN(xb_ld(&bar[XB_TOPGEN]) == tg, bar);
            __builtin_amdgcn_fence(__ATOMIC_ACQUIRE, "agent");
            xb_add(&bar[XB_XGEN(x)], 1u);
            asm volatile("s_waitcnt vmcnt(0)" ::: "memory");
        } else {
            XB_SPIN(xb_ld(&bar[XB_XGEN(x)]) == gen, bar);
            __builtin_amdgcn_fence(__ATOMIC_ACQUIRE, "agent");
            asm volatile("s_waitcnt vmcnt(0)" ::: "memory");
        }
    }
    __syncthreads();
}

__global__ void __launch_bounds__(NT, 2) fwd_mega(Args a_) {
    KA a = (KA)__builtin_amdgcn_kernarg_segment_ptr();
    unsigned char* lds = g_lds;
    if (threadIdx.x == 0) { ((volatile unsigned*)(g_lds + XB_ST_OFF))[0] = 0u; ((volatile unsigned*)(g_lds + XB_ST_OFF))[1] = 0u; }
    tid_table_init();
    cg::grid_group grid = cg::this_grid();
    float* lf = (float*)lds;
    const int lo = a->ph_lo, hi = a->ph_hi;
#define IN(k) (lo <= (k) && (k) < hi)
    unsigned* barctr = (unsigned*)(a->ws + WS_BAR); unsigned nbar = 0;
    if (blockIdx.x == 0) { for (int i = tid_opaque(); i < XCD_BAR_WORDS; i += NT) __hip_atomic_store(barctr + i, 0u, __ATOMIC_RELAXED, __HIP_MEMORY_SCOPE_AGENT); }
    (void)nbar;
#define GBAR() do { grid_bar((unsigned*)(a->ws + WS_BAR)); } while (0)
#define SEAM(k) do { if (IN(k) && IN((k) + 1)) { if ((k) == 0) { grid.sync(); xcd_census_post((unsigned*)(a->ws + WS_BAR)); } else GBAR(); } asm volatile("" : "+s"(a)); } while (0)
    unsigned char* ws = a->ws;
    bf16_t* HA = (bf16_t*)(ws + WS_HA); bf16_t* WT = (bf16_t*)(ws + WS_WT); bf16_t* SW = (bf16_t*)(ws + WS_SW);
    bf16_t* RA = (bf16_t*)(ws + WS_RA); bf16_t* RB = (bf16_t*)(ws + WS_RB);
    const float* mod = (const float*)(ws + WS_MOD); const float* sa = (const float*)(ws + WS_SA); const float* swf = (const float*)(ws + WS_SWF);

    if (IN(0)) {
#pragma unroll 1
        for (int rep = 0; rep < a->reps[0]; ++rep) { p0_mod_hid2(a, lf); p0_transposes(a, lf); }
    }
    SEAM(0);
    if (IN(1)) {
#pragma unroll 1
        for (int rep = 0; rep < a->reps[0]; ++rep) { p1_ha(a); p1_wquant(a); for (int u = blockIdx.x; u < 256; u += gridDim.x) filt_unit(a, u, lds); for (int u = blockIdx.x; u < 256; u += gridDim.x) wprime_unit(a, u, lds); }
    }
    SEAM(1);
    if (IN(2)) {
#pragma unroll 1
        for (int rep = 0; rep < a->reps[1]; ++rep) {
        run_gemm8(lds, ws + WS_WQ8 + (size_t)WT_HY0 * 2048, ws + WS_HA8, NHY, MT, swf + WT_HY0, sa, FStoreBf16{RA, MT, 1.0f});
        run_gemm8(lds, ws + WS_HA8, ws + WS_WQ8, MA, NQKVP, sa, swf, FStoreQKV{RB, (float*)(ws + WS_AB)});
        }
    }
    SEAM(2);
    if (IN(3)) {
        { Hy2W HW; Hy2T HT; hyena2_setup(lds, HW, HT);
#pragma unroll 1
        for (int rep = 0; rep < a->reps[3]; ++rep)
        for (int c = blockIdx.x; c < 2048; c += gridDim.x) hyena2_item(a, c, lds, HW, HT);
        __syncthreads(); }
        qkvpost_latent(a, lds);
        for (int u = 12288 + blockIdx.x; u < 12288 + 192; u += gridDim.x) qkvpost_unit(a, u, lds);
    }
    SEAM(3);
    if (IN(4)) {
#pragma unroll 1
        for (int rep = 0; rep < a->reps[4]; ++rep)
        { const int wv = tid_opaque() >> 6; const int nw = gridDim.x * 8, nround = 8704 / nw, rem = 8704 - nround * nw, per = (rem + (int)gridDim.x - 1) / (int)gridDim.x;
#pragma unroll 1
          for (int k = 0; k <= nround; ++k) {
              const int pid = (k < nround) ? (k * nw + blockIdx.x * 8 + wv) : ((wv < per) ? (nround * nw + blockIdx.x * per + wv) : 8704);
              if (pid < 8704) tprep_wave(a, pid, lds + wv * 18944);
          } }
        GBAR();
#pragma unroll 1
        for (int rep = 0; rep < a->reps[5]; ++rep)
        for (int it = blockIdx.x; it < 256; it += gridDim.x) delta_item(a, it, lds);
    }
    SEAM(4);
    if (IN(5)) {
        run_gemm8(lds, ws + WS_HA8, ws + WS_WQ8 + (size_t)WT_ZG0 * 2048, MT, NZG, sa, swf + WT_ZG0, FStoreBf16{RB, NZG, 1.0f});
#pragma unroll 1
        for (int rep = 0; rep < a->reps[6]; ++rep)
        ytrans_all((const bf16_t*)a->out, RA + (size_t)2 * MT * 2048, (bf16_t*)lds);
    }
    SEAM(5);
    if (IN(6)) {
#pragma unroll 1
        for (int rep = 0; rep < a->reps[6]; ++rep) { p6_on(a); } }
    SEAM(6);
    if (IN(7)) {
        run_gemm8(lds, ws + WS_HA8  , ws + WS_WSW8, MT, D, (const float*)(ws + WS_SON), swf + 18688, FGatePA{RB, WT  });
        run_gemm(lds, RA + (size_t)2 * MT * 2048  , SW + (size_t)1 * D * D, MT, D, FGatePH{RB, WT  });
    }
    SEAM(7);
    if (IN(8)) {
        run_gemm(lds, WT  , SW + (size_t)2 * D * D, MT, D, FOut{a->in[0], mod, (bf16_t*)(ws + WS_XN)});
#pragma unroll 1
        for (int rep = 0; rep < a->reps[7]; ++rep) p8_tables(a);
    }
    SEAM(8);
    if (IN(9)) { p9_ln1(a); }
    SEAM(9);
    if (IN(10)) { run_gemm8(lds, ws + WS_RA + (size_t)2 * MT * 2048 * 2  , ws + WS_WP8, MT, D, (const float*)(ws + WS_SH2), swf + 18688 + 2048, FStoreBf16{RB, D, 1.0f});     }
    SEAM(10);
    if (IN(11)) { for (int u = blockIdx.x; u < MT / 64; u += gridDim.x) peer_unit(a, u, lds); }
#undef IN
#undef SEAM
}

extern "C" void kernel_launch(void* const* d_in, const int* in_sizes, int n_in, void* d_out, int out_size, void* d_ws, size_t ws_size, hipStream_t stream) {
    static int grid = 0;
    if (grid == 0) {
        if (n_in != 31 || out_size != MT * D || ws_size < WS_BAR + 16384) { fprintf(stderr, "kernel_launch: unexpected problem shape / workspace (%d inputs, out %d, ws %zu)\n", n_in, out_size, ws_size); grid = -1; return; }
        int dev = 0, cus = 0, per_cu = 0;
        (void)hipGetDevice(&dev);
        (void)hipDeviceGetAttribute(&cus, hipDeviceAttributeMultiprocessorCount, dev);
        (void)hipFuncSetAttribute((const void*)fwd_mega, hipFuncAttributeMaxDynamicSharedMemorySize, LDS_BYTES);
        (void)hipOccupancyMaxActiveBlocksPerMultiprocessor(&per_cu, (const void*)fwd_mega, NT, LDS_BYTES);
        if (per_cu < 1) per_cu = 1;
        grid = cus * per_cu;
        (void)hipGetLastError();
    }
    if (grid < 0) return;
    Args a{};
    for (int i = 0; i < 31; ++i) a.in[i] = (const float*)d_in[i];
    a.out = (float*)d_out; a.ws = (unsigned char*)d_ws; a.ph_lo = 0; a.ph_hi = 12; a.reps[0] = REP0; a.reps[1] = REP1; a.reps[2] = REP2; a.reps[3] = REP3; a.reps[4] = REP4; a.reps[5] = REP5; a.reps[6] = REP6; a.reps[7] = REP7; a.pad2[0] = REPG;
    void* args[] = {&a};
    hipError_t e = hipLaunchCooperativeKernel((const void*)fwd_mega, dim3(grid), dim3(NT), args, LDS_BYTES, stream);
    if (e != hipSuccess) fprintf(stderr, "cooperative launch failed: %s (grid %d)\n", hipGetErrorString(e), grid);
}
```
